# Optimizing an MI355X kernel written in HIP

```python
import math
import jax
import jax.numpy as jnp
from jax import lax
import numpy as np


D_MODEL = 2048
BATCH = 4
SEQ = 4096
DEPTH = 2

N_A_LAYERS = DEPTH // 2
N_B_LAYERS = DEPTH - N_A_LAYERS
HEAD_DIM = 128
N_HEADS = D_MODEL // HEAD_DIM
HGRN_CHUNK = 64
MOBA_BLOCK = 256
MOBA_TOP_K = 3
MOBA_Q_CHUNK = 16
ROPE_THETA = 10000.0
N_GROUPS = 4
EXPERTS_PER_GROUP = 8
N_EXPERTS = N_GROUPS * EXPERTS_PER_GROUP
TOP_K_IN_GROUP = 2
EXPERT_FF = D_MODEL // 4
EXPERT_ROW_BLOCK = 128
RMS_EPS = 1e-6

kernel_name = 'hgrn2_moba_yoco_hmoe'


def rms_norm(x, gain):
    xf = x.astype(jnp.float32)
    y = xf * lax.rsqrt(jnp.mean(xf * xf, axis=-1, keepdims=True) + RMS_EPS)
    return (y * gain.astype(jnp.float32)).astype(x.dtype)


def apply_rope(x):
    T, dh = x.shape[1], x.shape[-1]
    half = dh // 2
    inv_freq = ROPE_THETA ** (-jnp.arange(0, dh, 2, dtype=jnp.float32) / dh)
    ang = jnp.arange(T, dtype=jnp.float32)[:, None] * inv_freq[None, :]
    cos = jnp.cos(ang)[None, :, None, :]
    sin = jnp.sin(ang)[None, :, None, :]
    xf = x.astype(jnp.float32)
    x1, x2 = xf[..., :half], xf[..., half:]
    out = jnp.concatenate([x1 * cos - x2 * sin, x2 * cos + x1 * sin], axis=-1)
    return out.astype(x.dtype)


def _hgrn2_chunk_step(S, xs):
    q, k, v, g = xs
    C = q.shape[2]
    G = jnp.cumsum(g, axis=2)
    o_inter = jnp.einsum('bhtk,bhkv->bhtv', q * jnp.exp(G), S)
    causal = jnp.tril(jnp.ones((C, C), dtype=bool))
    diff = G[:, :, :, None, :] - G[:, :, None, :, :]
    decay = jnp.where(causal[None, None, :, :, None], jnp.exp(jnp.minimum(diff, 0.0)), 0.0)
    scores = jnp.einsum('bhtk,bhsk,bhtsk->bhts', q, k, decay)
    o_intra = jnp.einsum('bhts,bhsv->bhtv', scores, v)
    G_end = G[:, :, -1, :]
    S_new = jnp.exp(G_end)[..., None] * S + jnp.einsum(
        'bhsk,bhsv->bhkv', k * jnp.exp(G_end[:, :, None, :] - G), v)
    return S_new, o_inter + o_intra


def hgrn2_mixer(h, w_in, lower_bound, o_gain, w_out):
    B, T, D = h.shape
    C = HGRN_CHUNK
    z = jnp.einsum('btd,de->bte', h, w_in)
    zq, zf, zi, zg = jnp.split(z, 4, axis=-1)
    lb = lower_bound.astype(jnp.float32)
    f = lb + (1.0 - lb) * jax.nn.sigmoid(zf.astype(jnp.float32))

    def heads(t):
        t = t.astype(jnp.float32).reshape(B, T // C, C, N_HEADS, HEAD_DIM)
        return t.transpose(1, 0, 3, 2, 4)

    q, k, v, g = heads(zq), heads(1.0 - f), heads(zi), heads(jnp.log(f))
    S0 = jnp.zeros((B, N_HEADS, HEAD_DIM, HEAD_DIM), jnp.float32)
    _, o = lax.scan(_hgrn2_chunk_step, S0, (q, k, v, g))
    o = o.transpose(1, 0, 3, 2, 4).reshape(B, T, N_HEADS, HEAD_DIM)
    o = rms_norm(o, o_gain) * jax.nn.silu(zg.astype(jnp.float32)).reshape(B, T, N_HEADS, HEAD_DIM)
    o = o.reshape(B, T, D).astype(h.dtype)
    return jnp.einsum('btd,de->bte', o, w_out)


def shared_kv(x, kv_norm, kv_w, k_norm):
    B, T, D = x.shape
    h = rms_norm(x, kv_norm)
    kv = jnp.einsum('btd,de->bte', h, kv_w)
    k, v = jnp.split(kv, 2, axis=-1)
    k = apply_rope(rms_norm(k.reshape(B, T, N_HEADS, HEAD_DIM), k_norm))
    v = v.reshape(B, T, N_HEADS, HEAD_DIM)
    Tp = ((T + MOBA_BLOCK - 1) // MOBA_BLOCK) * MOBA_BLOCK
    pad = ((0, 0), (0, 0), (0, Tp - T), (0, 0))
    k = jnp.pad(k.transpose(0, 2, 1, 3), pad)
    v = jnp.pad(v.transpose(0, 2, 1, 3), pad)
    k_mean = jnp.mean(k.reshape(B, N_HEADS, Tp // MOBA_BLOCK, MOBA_BLOCK, HEAD_DIM).astype(jnp.float32),
                      axis=3).astype(k.dtype)
    return k, v, k_mean


def moba_attention(q, k, v, k_mean):
    B, H, Tp, dh = q.shape
    NB = Tp // MOBA_BLOCK
    QC = MOBA_Q_CHUNK
    nq = Tp // QC
    kk = min(MOBA_TOP_K, NB)
    scale = HEAD_DIM ** -0.5
    q_blk = jnp.arange(Tp) // MOBA_BLOCK
    gate = jnp.einsum('bhtd,bhnd->bhtn', q, k_mean).astype(jnp.float32)
    fully_past = jnp.arange(NB)[None, :] < q_blk[:, None]
    gate = jnp.where(fully_past[None, None], gate, -jnp.inf)
    _, sel = lax.top_k(gate, kk)
    valid = sel < q_blk[None, None, :, None]
    kb = k.reshape(B, H, NB, MOBA_BLOCK, dh)
    vb = v.reshape(B, H, NB, MOBA_BLOCK, dh)
    b_idx = jnp.arange(B)[:, None, None, None]
    h_idx = jnp.arange(H)[None, :, None, None]

    def to_chunks(t):
        return t.reshape((B, H, nq, QC) + t.shape[3:]).transpose((2, 0, 1, 3) + tuple(range(4, t.ndim + 1)))

    def attend_chunk(args):
        qc, selc, validc, ci = args
        q0 = ci * QC
        blk = q0 // MOBA_BLOCK
        q_pos = q0 + jnp.arange(QC)
        k_own = lax.dynamic_index_in_dim(kb, blk, axis=2, keepdims=False)
        v_own = lax.dynamic_index_in_dim(vb, blk, axis=2, keepdims=False)
        key_pos = blk * MOBA_BLOCK + jnp.arange(MOBA_BLOCK)
        s_own = jnp.einsum('bhqd,bhjd->bhqj', qc, k_own).astype(jnp.float32) * scale
        s_own = jnp.where(key_pos[None, :] <= q_pos[:, None], s_own, -jnp.inf)
        k_sel = kb[b_idx, h_idx, selc]
        v_sel = vb[b_idx, h_idx, selc]
        s_sel = jnp.einsum('bhqd,bhqnjd->bhqnj', qc, k_sel).astype(jnp.float32) * scale
        s_sel = jnp.where(validc[..., None], s_sel, -jnp.inf)
        s = jnp.concatenate([s_own, s_sel.reshape(B, H, QC, kk * MOBA_BLOCK)], axis=-1)
        p = jax.nn.softmax(s, axis=-1).astype(qc.dtype)
        p_own = p[..., :MOBA_BLOCK]
        p_sel = p[..., MOBA_BLOCK:].reshape(B, H, QC, kk, MOBA_BLOCK)
        return (jnp.einsum('bhqj,bhjd->bhqd', p_own, v_own)
                + jnp.einsum('bhqnj,bhqnjd->bhqd', p_sel, v_sel))

    o = lax.map(attend_chunk, (to_chunks(q), to_chunks(sel), to_chunks(valid),
                               jnp.arange(nq, dtype=jnp.int32)))
    return o.transpose(1, 2, 0, 3, 4).reshape(B, H, Tp, dh)


def moba_mixer(h, w_q, q_norm, w_out, k, v, k_mean):
    B, T, D = h.shape
    Tp = k.shape[2]
    q = jnp.einsum('btd,de->bte', h, w_q).reshape(B, T, N_HEADS, HEAD_DIM)
    q = apply_rope(rms_norm(q, q_norm)).transpose(0, 2, 1, 3)
    q = jnp.pad(q, ((0, 0), (0, 0), (0, Tp - T), (0, 0)))
    o = moba_attention(q, k, v, k_mean)[:, :, :T]
    o = o.transpose(0, 2, 1, 3).reshape(B, T, D)
    return jnp.einsum('btd,de->bte', o, w_out)


def routed_experts(xf, expert_id, weight, w_gate, w_up, w_down):
    N, D = xf.shape
    E = w_gate.shape[0]
    R = EXPERT_ROW_BLOCK
    K = expert_id.shape[1]
    A = N * K
    flat_e = expert_id.reshape(-1)
    flat_w = weight.reshape(-1)
    order = jnp.argsort(flat_e)
    e_sorted = flat_e[order]
    tok = order // K
    counts = jnp.bincount(flat_e, length=E)
    padded = (counts + R - 1) // R * R
    pad_end = jnp.cumsum(padded)
    pad_start = pad_end - padded
    start = jnp.cumsum(counts) - counts
    dest = pad_start[e_sorted] + jnp.arange(A) - start[e_sorted]
    P = ((A + E * (R - 1) + R - 1) // R) * R
    n_blk = P // R
    rows = jnp.zeros((P, D), xf.dtype).at[dest].set(xf[tok])
    blk_e = jnp.minimum(jnp.searchsorted(pad_end, jnp.arange(n_blk) * R, side='right'), E - 1)

    def expert_block(args):
        xb, e = args
        return (jax.nn.silu(xb @ w_gate[e]) * (xb @ w_up[e])) @ w_down[e]

    out = lax.map(expert_block, (rows.reshape(n_blk, R, D), blk_e)).reshape(P, D)
    y = jnp.zeros((N, D), jnp.float32).at[tok].add(
        flat_w[order][:, None] * out[dest].astype(jnp.float32))
    return y.astype(xf.dtype)


def hier_moe(h, w_group, b_group, w_expert, b_expert, w_gate, w_up, w_down):
    B, T, D = h.shape
    xf = h.reshape(B * T, D)
    g_logits = (xf @ w_group + b_group).astype(jnp.float32)
    g_top_p, g_top = lax.top_k(jax.nn.softmax(g_logits, axis=-1), 1)
    e_logits = (xf @ w_expert + b_expert).astype(jnp.float32).reshape(-1, N_GROUPS, EXPERTS_PER_GROUP)
    e_logits = jnp.take_along_axis(e_logits, g_top[:, :, None], axis=1)[:, 0]
    e_top_p, e_top = lax.top_k(jax.nn.softmax(e_logits, axis=-1), TOP_K_IN_GROUP)
    weight = g_top_p * e_top_p / jnp.sum(e_top_p, axis=-1, keepdims=True)
    expert_id = g_top * EXPERTS_PER_GROUP + e_top
    y = routed_experts(xf, expert_id, weight, w_gate, w_up, w_down)
    return y.reshape(B, T, D)


def setup_inputs(seed: int = 0) -> dict:
    key = jax.random.key(seed)
    ks = jax.random.split(key, 21)
    f32 = jnp.float32
    D = D_MODEL

    def w(k, shape, fan_in):
        return jax.random.normal(k, shape, f32) * (fan_in ** -0.5)

    def gain(k, shape):
        return 1.0 + 0.05 * jax.random.normal(k, shape, f32)

    return {
        'x': jax.random.normal(ks[0], (BATCH, SEQ, D), f32),
        'norm_mix': gain(ks[1], (DEPTH, D)),
        'norm_ffn': gain(ks[2], (DEPTH, D)),
        'a_w_in': w(ks[3], (N_A_LAYERS, D, 4 * D), D),
        'a_lb_logits': 0.5 * jax.random.normal(ks[4], (DEPTH + 1, D), f32),
        'a_o_gain': gain(ks[5], (N_A_LAYERS, HEAD_DIM)),
        'a_w_out': w(ks[6], (N_A_LAYERS, D, D), D),
        'kv_norm': gain(ks[7], (D,)),
        'kv_w': w(ks[8], (D, 2 * D), D),
        'k_norm': gain(ks[9], (HEAD_DIM,)),
        'b_w_q': w(ks[10], (N_B_LAYERS, D, D), D),
        'b_q_norm': gain(ks[11], (N_B_LAYERS, HEAD_DIM)),
        'b_w_out': w(ks[12], (N_B_LAYERS, D, D), D),
        'moe_w_group': w(ks[13], (DEPTH, D, N_GROUPS), D),
        'moe_b_group': 0.01 * jax.random.normal(ks[14], (DEPTH, N_GROUPS), f32),
        'moe_w_expert': w(ks[15], (DEPTH, D, N_EXPERTS), D),
        'moe_b_expert': 0.01 * jax.random.normal(ks[16], (DEPTH, N_EXPERTS), f32),
        'moe_w_gate': w(ks[17], (DEPTH, N_EXPERTS, D, EXPERT_FF), D),
        'moe_w_up': w(ks[18], (DEPTH, N_EXPERTS, D, EXPERT_FF), D),
        'moe_w_down': w(ks[19], (DEPTH, N_EXPERTS, EXPERT_FF, D), EXPERT_FF),
    }


def reference(x, norm_mix, norm_ffn, a_w_in, a_lb_logits, a_o_gain, a_w_out,
              kv_norm, kv_w, k_norm, b_w_q, b_q_norm, b_w_out,
              moe_w_group, moe_b_group, moe_w_expert, moe_b_expert,
              moe_w_gate, moe_w_up, moe_w_down):
    lower_bounds = jnp.cumsum(jax.nn.softmax(a_lb_logits.astype(jnp.float32), axis=0), axis=0)
    k_sh = v_sh = km_sh = None
    for l in range(DEPTH):
        if l < N_A_LAYERS:
            h = rms_norm(x, norm_mix[l])
            x = x + hgrn2_mixer(h, a_w_in[l], lower_bounds[l], a_o_gain[l], a_w_out[l])
        else:
            if l == N_A_LAYERS:
                k_sh, v_sh, km_sh = shared_kv(x, kv_norm, kv_w, k_norm)
            b = l - N_A_LAYERS
            h = rms_norm(x, norm_mix[l])
            x = x + moba_mixer(h, b_w_q[b], b_q_norm[b], b_w_out[b], k_sh, v_sh, km_sh)
        h = rms_norm(x, norm_ffn[l])
        x = x + hier_moe(h, moe_w_group[l], moe_b_group[l], moe_w_expert[l], moe_b_expert[l],
                         moe_w_gate[l], moe_w_up[l], moe_w_down[l])
    return x
```

```cpp
#include <hip/hip_runtime.h>
#include <cstdio>
#include <cstdint>

#define GAS __attribute__((address_space(1)))
#define LAS __attribute__((address_space(3)))
typedef unsigned short bf16;
typedef short bf16x8 __attribute__((ext_vector_type(8)));
typedef float f32x4 __attribute__((ext_vector_type(4)));
typedef float f32x2 __attribute__((ext_vector_type(2)));
typedef unsigned u32x4 __attribute__((ext_vector_type(4)));
typedef unsigned u32x2 __attribute__((ext_vector_type(2)));

constexpr int BATCH = 4, T = 4096, D = 2048, M = BATCH * T, H = 16, HD = 128;
constexpr int NBLK = 16, MBLK = 256;
constexpr int NG = 4, EPG = 8, NE = 32, FF = 512;
constexpr float RMS_EPS = 1e-6f;
constexpr int NWAVES = 8, NTHR = 512;
constexpr int LIST_CAP = 16384;
constexpr int MAXRB = 160;

constexpr size_t MiB = 1u << 20;
constexpr size_t WS_CTL = 0, CTL_ZERO_BYTES = 1 * MiB;
constexpr size_t WS_LISTS = 1 * MiB;
constexpr size_t WS_TOKREC = 3 * MiB;
constexpr size_t WS_LB = 4 * MiB;
constexpr size_t WS_RT = 4 * MiB + 65536;
constexpr size_t WS_ROPE = 5 * MiB;
constexpr size_t WS_KMEAN = 7 * MiB;
constexpr size_t WS_WIN = 8 * MiB, WS_WOA = 40 * MiB, WS_WQKV = 48 * MiB, WS_WOB = 72 * MiB;
constexpr size_t WS_WGU = 80 * MiB, WS_WD = 208 * MiB;
constexpr size_t WS_XN = 272 * MiB;
constexpr size_t WS_ACT = 336 * MiB;
constexpr size_t WS_R = 376 * MiB;
constexpr size_t WS_ZQ = WS_R, WS_ZK = WS_R + 64 * MiB, WS_ZG = WS_R + 128 * MiB, WS_ZV = WS_R + 192 * MiB, WS_ZGATE = WS_R + 256 * MiB;
constexpr size_t WS_ORAW = WS_R + 320 * MiB;
constexpr size_t WS_OH = WS_R + 448 * MiB;
constexpr size_t WS_OUTB = WS_R;
constexpr size_t WS_Q = WS_R, WS_K = WS_R + 64 * MiB, WS_V = WS_R + 128 * MiB, WS_VT = WS_R + 192 * MiB, WS_OA = WS_R + 256 * MiB;
constexpr size_t WS_XR = WS_R + 192 * MiB;
constexpr size_t WS_OPART = WS_R + 320 * MiB;
constexpr size_t WS_LPART = WS_R + 576 * MiB;
constexpr size_t WS_ALIST = WS_R + 584 * MiB;
constexpr int ALIST_CAP = 3840;
constexpr size_t WS_END = WS_R + 604 * MiB;
constexpr int CW_TMO = 0;
constexpr int CW_BAR = 4096;
constexpr int CW_CNT = 8192;
constexpr int CW_ACNT = 16384;
constexpr int CW_DYN = 20480;

constexpr int RING_BYTES = 159744;
constexpr int LDSCTL_OFF = RING_BYTES;
constexpr int LT_BLKE = LDSCTL_OFF + 64;
constexpr int LT_BLKSTART = LT_BLKE + MAXRB * 4;
constexpr int LT_CNT = LT_BLKSTART + 36 * 4;
constexpr int LT_END = LT_CNT + 32 * 4;
constexpr int LDS_BYTES = 163840;
static_assert(LT_END <= LDS_BYTES, "LDS map");

__device__ __forceinline__ unsigned f2bf(float f) { unsigned u = __builtin_bit_cast(unsigned, f); return (u + 0x7fffu + ((u >> 16) & 1u)) >> 16; }
__device__ __forceinline__ unsigned pk2(float lo, float hi) { return f2bf(lo) | (f2bf(hi) << 16); }
__device__ __forceinline__ float bf2f(unsigned b) { return __builtin_bit_cast(float, b << 16); }
__device__ __forceinline__ float bflo(unsigned w) { return __builtin_bit_cast(float, w << 16); }
__device__ __forceinline__ float bfhi(unsigned w) { return __builtin_bit_cast(float, w & 0xffff0000u); }
__device__ __forceinline__ float wave_sum(float v) {
#pragma unroll
    for (int o = 1; o < 64; o <<= 1) v += __shfl_xor(v, o);
    return v;
}
#ifndef FP8_QKV
#define FP8_QKV 1
#endif
#ifndef FP8_OUTB
#define FP8_OUTB 1
#endif
#ifndef FP8_MOE1
#define FP8_MOE1 1
#endif
#ifndef FP8_MOE0
#define FP8_MOE0 1
#endif
#ifndef OUT8_L0
#define OUT8_L0 1
#endif
#ifndef OUT8_L1
#define OUT8_L1 1
#endif
constexpr float SC_XN = 16.f, SC_W = 1024.f, SC_ACT = 8.f, SC_WD = 512.f, SC_OA = 64.f, SC_PART = 64.f, SC_OUT = 32.f, SC_QKV = 32.f;
__device__ __forceinline__ unsigned pk4_fp8(float a, float b, float c, float d) {
    a = __builtin_amdgcn_fmed3f(a, -448.f, 448.f); b = __builtin_amdgcn_fmed3f(b, -448.f, 448.f); c = __builtin_amdgcn_fmed3f(c, -448.f, 448.f); d = __builtin_amdgcn_fmed3f(d, -448.f, 448.f);
    int p = __builtin_amdgcn_cvt_pk_fp8_f32(a, b, 0, false); p = __builtin_amdgcn_cvt_pk_fp8_f32(c, d, p, true); return (unsigned)p; }
__device__ __forceinline__ int lane_id() { int l; asm volatile("v_mbcnt_lo_u32_b32 %0, -1, 0\n\tv_mbcnt_hi_u32_b32 %0, -1, %0" : "=v"(l)); return l; }
__device__ __forceinline__ int make_tid(int wv) { return wv * 64 + lane_id(); }
__device__ __forceinline__ void fp8x4_to_f32(unsigned w, float (&o)[4]) { const f32x2 lo = __builtin_amdgcn_cvt_pk_f32_fp8((int)w, false), hi = __builtin_amdgcn_cvt_pk_f32_fp8((int)w, true); o[0] = lo.x; o[1] = lo.y; o[2] = hi.x; o[3] = hi.y; }
#define LDS_WAIT() asm volatile("s_waitcnt lgkmcnt(0)" ::: "memory")
#define VM_WAIT() asm volatile("s_waitcnt vmcnt(0)" ::: "memory")

namespace pg8 {
constexpr int BM = 256, BK = 64, HALF = 128, HTB = HALF * BK * 2, STAGE_BYTES = 8 * HTB, NXCD = 8, WGM = 8;
__host__ __device__ __forceinline__ int lds_byte(int r, int c) { const int st = (r >> 4) * 2 + (c >> 5), rr = r & 15, cc = c & 31, ob = rr * 64 + cc * 2; return st * 1024 + (ob ^ (((ob >> 9) & 1) << 5)); }
__host__ __device__ __forceinline__ void stage_rc(int b, int& R, int& C) { const int st = b / 1024, sb = b % 1024, swz = sb ^ (((sb >> 9) & 1) << 5); R = (st >> 1) * 16 + swz / 64; C = (st & 1) * 32 + (swz % 64) / 2; }
__host__ __device__ __forceinline__ int perm32(int rho) { const int n = rho >> 4, i = rho & 15; return 8 * (i >> 2) + 4 * n + (i & 3); }

struct Unit { int pm, pn; const char* a; const char* b; int e0, lbase, cnt; };

struct DenseOrder {
    static constexpr bool GATHER = false, DYNAMIC = false;
    const char* A; const char* B; int K, RB; int nM, nN, nwg, G, c, wv;
    __device__ void init(const void* A_, const void* B_, int M_, int N_, int K_, int G_, int c_, int wv_, bool fp8 = false) { wv = wv_; A = (const char*)A_; B = (const char*)B_; K = K_; RB = fp8 ? K_ : 2 * K_; nM = M_ / BM; nN = N_ / BM; nwg = nM * nN; G = G_; c = c_; }
    __device__ __forceinline__ bool next(int i, Unit& u) const {
        const int L = i * G + c; if (L >= nwg) return false;
        int wgid = (int)L; { const int q = nwg / NXCD, r = nwg % NXCD, xcd = wgid % NXCD, off = wgid / NXCD; wgid = (xcd < r ? xcd * (q + 1) : r * (q + 1) + (xcd - r) * q) + off; }
        const int nig = WGM * nN, gid = wgid / nig, fm = gid * WGM, gsz = (nM - fm) < WGM ? (nM - fm) : WGM;
        u.pm = fm + ((wgid % nig) % gsz); u.pn = (wgid % nig) / gsz;
        u.a = A + (size_t)u.pm * BM * RB; u.b = B + (size_t)u.pn * BM * RB; u.e0 = 0; u.lbase = 0; u.cnt = 0; return true;
    }
    __device__ __forceinline__ unsigned row_off(const Unit&, int) const { return 0u; }
};
struct DynOrder {
    static constexpr bool GATHER = false, DYNAMIC = true;
    const char* A; const char* B; int K, RB; int nM, nN, nwg, wv; unsigned* counter; LAS int* slot;
    __device__ void init(const void* A_, const void* B_, int M_, int N_, int K_, int wv_, unsigned* counter_, LAS int* slot_, bool fp8 = false) { wv = wv_; A = (const char*)A_; B = (const char*)B_; K = K_; RB = fp8 ? K_ : 2 * K_; nM = M_ / BM; nN = N_ / BM; nwg = nM * nN; counter = counter_; slot = slot_; }
    __device__ __forceinline__ void map(int L, Unit& u) const {
        int wgid = L; { const int q = nwg / NXCD, r = nwg % NXCD, xcd = wgid % NXCD, off = wgid / NXCD; wgid = (xcd < r ? xcd * (q + 1) : r * (q + 1) + (xcd - r) * q) + off; }
        const int nig = WGM * nN, gid = wgid / nig, fm = gid * WGM, gsz = (nM - fm) < WGM ? (nM - fm) : WGM;
        u.pm = fm + ((wgid % nig) % gsz); u.pn = (wgid % nig) / gsz;
        u.a = A + (size_t)u.pm * BM * RB; u.b = B + (size_t)u.pn * BM * RB; u.e0 = 0; u.lbase = 0; u.cnt = 0;
    }
    __device__ __forceinline__ int fetch() const { return (int)__hip_atomic_fetch_add(counter, 1u, __ATOMIC_RELAXED, __HIP_MEMORY_SCOPE_AGENT); }
    __device__ __forceinline__ bool next(int, Unit&) const { return false; }
    __device__ __forceinline__ unsigned row_off(const Unit&, int) const { return 0u; }
};
template <bool GATHER_> struct MoeOrder {
    static constexpr bool GATHER = GATHER_, DYNAMIC = false;
    const char* A; const char* B; size_t estride; int K, RB, NT, total, G, c, wv;
    const LAS int* blk_e; const LAS int* blkstart; const LAS int* cnt; const int* list;
    __device__ __forceinline__ bool next(int i, Unit& u) const {
        const int L = i * G + c; if (L >= total) return false;
        const int rb = (int)L / NT, pn = (int)L % NT, e = blk_e[rb];
        u.pm = rb; u.pn = pn; u.e0 = e; u.lbase = (rb - blkstart[e]) * BM; u.cnt = cnt[e];
        u.a = GATHER ? A : A + (size_t)rb * BM * RB; u.b = B + (size_t)e * estride + (size_t)pn * BM * RB; return true;
    }
    __device__ __forceinline__ unsigned row_off(const Unit& u, int r) const { const int loc = u.lbase + r; const int t = list[u.e0 * LIST_CAP + (loc < u.cnt ? loc : 0)]; return (unsigned)t * (unsigned)RB; }
};

typedef __bf16 bf16n2 __attribute__((ext_vector_type(2)));
__device__ __forceinline__ unsigned cvt_pk_bf16_n(float lo, float hi) { const f32x2 v = {lo, hi}; return __builtin_bit_cast(unsigned, __builtin_convertvector(v, bf16n2)); }
__device__ __forceinline__ unsigned cvt_pk_bf16(float lo, float hi) { unsigned r; asm volatile("v_cvt_pk_bf16_f32 %0, %1, %2" : "=v"(r) : "v"(lo), "v"(hi)); return r; }

struct EpiBf16 {
    static constexpr bool PERM = true;
    bf16* O; int ldc; int split_cols; size_t split_stride; float osc;
    __device__ __forceinline__ void operator()(const f32x4 (&acc)[2][2][4][2], const Unit& u, int wr, int wc, int fr, int fq) const {
        const int row0 = u.pm * BM + wr * 64 + fr; int colt = u.pn * BM; bf16* base = O;
        if (split_cols) { const int t = colt / split_cols; base += (size_t)t * split_stride; colt -= t * split_cols; }
        const int col0 = colt + wc * 32 + 8 * fq;
#pragma unroll
        for (int ai = 0; ai < 2; ++ai)
#pragma unroll
            for (int m = 0; m < 4; ++m) { bf16* rowp = base + (size_t)(row0 + ai * HALF + m * 16) * ldc + col0;
#pragma unroll
                for (int bj = 0; bj < 2; ++bj) { const f32x4 v0 = acc[ai][bj][m][0] * osc, v1 = acc[ai][bj][m][1] * osc;
                    u32x4 w; w.x = cvt_pk_bf16(v0[0], v0[1]); w.y = cvt_pk_bf16(v0[2], v0[3]); w.z = cvt_pk_bf16(v1[0], v1[1]); w.w = cvt_pk_bf16(v1[2], v1[3]);
                    *(u32x4*)(rowp + bj * HALF) = w; } }
    }
};
struct EpiResF32 {
    static constexpr bool PERM = false;
    float* C; const float* R; int ldc; float osc;
    __device__ __forceinline__ void operator()(const f32x4 (&acc)[2][2][4][2], const Unit& u, int wr, int wc, int fr, int fq) const {
        const int row0 = u.pm * BM + wr * 64 + fr, col0 = u.pn * BM + wc * 32 + 4 * fq;
#pragma unroll
        for (int ai = 0; ai < 2; ++ai)
#pragma unroll
            for (int m = 0; m < 4; ++m) { const size_t ro = (size_t)(row0 + ai * HALF + m * 16) * ldc + col0;
#pragma unroll
                for (int bj = 0; bj < 2; ++bj)
#pragma unroll
                    for (int n = 0; n < 2; ++n) { const f32x4 r = *(const f32x4*)(R + ro + bj * HALF + n * 16); *(f32x4*)(C + ro + bj * HALF + n * 16) = acc[ai][bj][m][n] * osc + r; } }
    }
};
struct EpiOut8 {
    static constexpr bool PERM = true;
    unsigned char* O; int ldc; float osc;
    __device__ __forceinline__ void operator()(const f32x4 (&acc)[2][2][4][2], const Unit& u, int wr, int wc, int fr, int fq) const {
        const int row0 = u.pm * BM + wr * 64 + fr, col0 = u.pn * BM + wc * 32 + 8 * fq;
#pragma unroll
        for (int ai = 0; ai < 2; ++ai)
#pragma unroll
            for (int m = 0; m < 4; ++m) { unsigned char* rowp = O + (size_t)(row0 + ai * HALF + m * 16) * ldc + col0;
#pragma unroll
                for (int bj = 0; bj < 2; ++bj) { const f32x4 v0 = acc[ai][bj][m][0] * osc, v1 = acc[ai][bj][m][1] * osc;
                    u32x2 w; w.x = pk4_fp8(v0[0], v0[1], v0[2], v0[3]); w.y = pk4_fp8(v1[0], v1[1], v1[2], v1[3]);
                    *(u32x2*)(rowp + bj * HALF) = w; } }
    }
};
template <bool SRC32> struct EpiRes16 {
    static constexpr bool PERM = true;
    bf16* XR; const float* R32; float osc;
    __device__ __forceinline__ void operator()(const f32x4 (&acc)[2][2][4][2], const Unit& u, int wr, int wc, int fr, int fq) const {
        const int row0 = u.pm * BM + wr * 64 + fr, col0 = u.pn * BM + wc * 32 + 8 * fq;
#pragma unroll
        for (int ai = 0; ai < 2; ++ai)
#pragma unroll
            for (int m = 0; m < 4; ++m) { const size_t ro = (size_t)(row0 + ai * HALF + m * 16) * D + col0;
#pragma unroll
                for (int bj = 0; bj < 2; ++bj) { float r[8];
                    if (SRC32) { const f32x4 a = *(const f32x4*)(R32 + ro + bj * HALF), b = *(const f32x4*)(R32 + ro + bj * HALF + 4);
#pragma unroll
                        for (int j = 0; j < 4; ++j) { r[j] = a[j]; r[4 + j] = b[j]; } }
                    else { const u32x4 w = *(const u32x4*)(XR + ro + bj * HALF); r[0] = bflo(w.x); r[1] = bfhi(w.x); r[2] = bflo(w.y); r[3] = bfhi(w.y); r[4] = bflo(w.z); r[5] = bfhi(w.z); r[6] = bflo(w.w); r[7] = bfhi(w.w); }
                    const f32x4 v0 = acc[ai][bj][m][0] * osc, v1 = acc[ai][bj][m][1] * osc;
                    u32x4 o; o.x = cvt_pk_bf16(v0[0] + r[0], v0[1] + r[1]); o.y = cvt_pk_bf16(v0[2] + r[2], v0[3] + r[3]); o.z = cvt_pk_bf16(v1[0] + r[4], v1[1] + r[5]); o.w = cvt_pk_bf16(v1[2] + r[6], v1[3] + r[7]);
                    *(u32x4*)(XR + ro + bj * HALF) = o; } }
    }
};
__device__ __forceinline__ float sigmoidf_(float z) { return __builtin_amdgcn_rcpf(1.0f + __expf(-z)); }
template <bool OUT8> struct EpiSwiGLU {
    static constexpr bool PERM = true;
    bf16* O; float osc;
    __device__ __forceinline__ void operator()(const f32x4 (&acc)[2][2][4][2], const Unit& u, int wr, int wc, int fr, int fq) const {
        const int row0 = u.pm * BM + wr * 64 + fr, col0 = u.pn * HALF + wc * 32 + 8 * fq;
#pragma unroll
        for (int ai = 0; ai < 2; ++ai)
#pragma unroll
            for (int m = 0; m < 4; ++m) { const size_t eo = (size_t)(row0 + ai * HALF + m * 16) * FF + col0;
                float o[8];
#pragma unroll
                for (int n = 0; n < 2; ++n)
#pragma unroll
                    for (int j = 0; j < 4; ++j) { const float g = acc[ai][0][m][n][j] * osc, up = acc[ai][1][m][n][j] * osc; o[4 * n + j] = g * sigmoidf_(g) * up; }
                if (OUT8) { u32x2 w; w.x = pk4_fp8(o[0] * SC_ACT, o[1] * SC_ACT, o[2] * SC_ACT, o[3] * SC_ACT); w.y = pk4_fp8(o[4] * SC_ACT, o[5] * SC_ACT, o[6] * SC_ACT, o[7] * SC_ACT); *(u32x2*)((unsigned char*)O + eo) = w; }
                else { u32x4 w; w.x = cvt_pk_bf16(o[0], o[1]); w.y = cvt_pk_bf16(o[2], o[3]); w.z = cvt_pk_bf16(o[4], o[5]); w.w = cvt_pk_bf16(o[6], o[7]); *(u32x4*)(O + eo) = w; } }
    }
};
typedef _Float16 h8 __attribute__((ext_vector_type(8)));
struct EpiHgrnIn {
    static constexpr bool PERM = true;
    unsigned char* zb; const float* lb;
    __device__ __forceinline__ void operator()(const f32x4 (&acc)[2][2][4][2], const Unit& u, int wr, int wc, int fr, int fq) const {
        const int quarter = u.pn >> 3, row0 = u.pm * BM + wr * 64 + fr, col0 = (u.pn & 7) * BM + wc * 32 + 8 * fq;
        if (quarter == 1) {
            float lbv[2][8];
#pragma unroll
            for (int bj = 0; bj < 2; ++bj) { const f32x4 a = *(const f32x4*)(lb + col0 + bj * HALF), b = *(const f32x4*)(lb + col0 + bj * HALF + 4);
#pragma unroll
                for (int j = 0; j < 4; ++j) { lbv[bj][j] = a[j]; lbv[bj][4 + j] = b[j]; } }
#pragma unroll
            for (int ai = 0; ai < 2; ++ai)
#pragma unroll
                for (int m = 0; m < 4; ++m) { const size_t ro = (size_t)(row0 + ai * HALF + m * 16) * D + col0;
#pragma unroll
                    for (int bj = 0; bj < 2; ++bj) { float kk[8]; h8 hv;
#pragma unroll
                        for (int n = 0; n < 2; ++n)
#pragma unroll
                            for (int j = 0; j < 4; ++j) { const float z = acc[ai][bj][m][n][j], l = lbv[bj][4 * n + j];
                                const float k1 = (1.0f - l) * __builtin_amdgcn_rcpf(1.0f + __expf(z));
                                kk[4 * n + j] = k1; hv[4 * n + j] = (_Float16)__logf(1.0f - k1); }
                        u32x4 w; w.x = cvt_pk_bf16(kk[0], kk[1]); w.y = cvt_pk_bf16(kk[2], kk[3]); w.z = cvt_pk_bf16(kk[4], kk[5]); w.w = cvt_pk_bf16(kk[6], kk[7]);
                        *(u32x4*)((bf16*)(zb + (64u << 20)) + ro + bj * HALF) = w;
                        *(h8*)((_Float16*)(zb + (128u << 20)) + ro + bj * HALF) = hv; } }
        } else {
            const size_t zo = quarter == 0 ? 0u : (quarter == 2 ? (size_t)(192u << 20) : (size_t)(256u << 20)); bf16* dst = (bf16*)(zb + zo);
#pragma unroll
            for (int ai = 0; ai < 2; ++ai)
#pragma unroll
                for (int m = 0; m < 4; ++m) { const size_t ro = (size_t)(row0 + ai * HALF + m * 16) * D + col0;
#pragma unroll
                    for (int bj = 0; bj < 2; ++bj) { float o[8];
#pragma unroll
                        for (int n = 0; n < 2; ++n)
#pragma unroll
                            for (int j = 0; j < 4; ++j) { const float z = acc[ai][bj][m][n][j]; o[4 * n + j] = (quarter == 3) ? z * sigmoidf_(z) : z; }
                        u32x4 w; w.x = cvt_pk_bf16(o[0], o[1]); w.y = cvt_pk_bf16(o[2], o[3]); w.z = cvt_pk_bf16(o[4], o[5]); w.w = cvt_pk_bf16(o[6], o[7]);
                        *(u32x4*)(dst + ro + bj * HALF) = w; } }
        }
    }
};

struct EpiQKV {
    static constexpr bool PERM = true;
    bf16* Q; bf16* Kd; bf16* V; const float* qg; const float* kg; const f32x2* rope; float* kmean; LAS unsigned char* xl; float osc; int wv;
    __device__ __forceinline__ void operator()(const f32x4 (&acc)[2][2][4][2], const Unit& u, int wr, int wc, int fr, int fq) const {
        const int sec = u.pn >> 3, row0 = u.pm * BM + wr * 64 + fr;
        if (sec == 2) {
            const int col0 = (u.pn & 7) * BM + wc * 32 + 8 * fq; const float vs = osc * SC_QKV;
#pragma unroll
            for (int ai = 0; ai < 2; ++ai)
#pragma unroll
                for (int m = 0; m < 4; ++m) { unsigned char* rowp = (unsigned char*)V + (size_t)(row0 + ai * HALF + m * 16) * D + col0;
#pragma unroll
                    for (int bj = 0; bj < 2; ++bj) { const f32x4 v0 = acc[ai][bj][m][0] * vs, v1 = acc[ai][bj][m][1] * vs;
                        u32x2 w; w.x = pk4_fp8(v0[0], v0[1], v0[2], v0[3]); w.y = pk4_fp8(v1[0], v1[1], v1[2], v1[3]);
                        *(u32x2*)(rowp + bj * HALF) = w; } }
            return;
        }
        LAS float* X = (LAS float*)xl;
        LAS float* Y = (LAS float*)(xl + 8192);
#pragma unroll
        for (int ai = 0; ai < 2; ++ai)
#pragma unroll
            for (int m = 0; m < 4; ++m)
#pragma unroll
                for (int bj = 0; bj < 2; ++bj) { const f32x4 a = acc[ai][bj][m][0], b = acc[ai][bj][m][1];
                    float s = ((a[0] * a[0] + a[1] * a[1]) + (a[2] * a[2] + a[3] * a[3]) + (b[0] * b[0] + b[1] * b[1]) + (b[2] * b[2] + b[3] * b[3])) * (osc * osc);
                    s += __shfl_xor(s, 16); s += __shfl_xor(s, 32);
                    if (fq == 0) X[((ai * HALF + wr * 64 + m * 16 + fr) * 2 + bj) * 4 + wc] = s; }
        asm volatile("s_waitcnt lgkmcnt(0)" ::: "memory"); __builtin_amdgcn_s_barrier(); asm volatile("" ::: "memory");
        const float* gain = sec ? kg : qg; bf16* dst = sec ? Kd : Q;
#pragma unroll
        for (int ai = 0; ai < 2; ++ai)
#pragma unroll
            for (int m = 0; m < 4; ++m) { const int rl = ai * HALF + wr * 64 + m * 16 + fr, pos = (u.pm & 15) * BM + rl;
                const f32x4 g0 = *(const f32x4*)(gain + 16 * wc + 4 * fq), g1 = *(const f32x4*)(gain + 64 + 16 * wc + 4 * fq);
                const f32x4 r0 = *(const f32x4*)(rope + pos * 64 + 16 * wc + 4 * fq), r1 = *(const f32x4*)(rope + pos * 64 + 16 * wc + 4 * fq + 2);
                const float cc[4] = {r0[0], r0[2], r1[0], r1[2]}, sn[4] = {r0[1], r0[3], r1[1], r1[3]};
#pragma unroll
                for (int bj = 0; bj < 2; ++bj) { const f32x4 p = *(const LAS f32x4*)(X + (rl * 2 + bj) * 4);
                    const float rstd = __builtin_amdgcn_rsqf(((p[0] + p[1]) + (p[2] + p[3])) * (1.f / 128) + RMS_EPS);
                    float o[8];
#pragma unroll
                    for (int j = 0; j < 4; ++j) { const float y1 = acc[ai][bj][m][0][j] * (rstd * osc) * g0[j], y2 = acc[ai][bj][m][1][j] * (rstd * osc) * g1[j]; o[j] = y1 * cc[j] - y2 * sn[j]; o[4 + j] = y2 * cc[j] + y1 * sn[j]; }
                    unsigned char* p0 = (unsigned char*)dst + (size_t)(u.pm * BM + rl) * D + ((u.pn & 7) * 2 + bj) * 128 + 16 * wc + 4 * fq;
                    *(unsigned*)p0 = pk4_fp8(o[0] * SC_QKV, o[1] * SC_QKV, o[2] * SC_QKV, o[3] * SC_QKV); *(unsigned*)(p0 + 64) = pk4_fp8(o[4] * SC_QKV, o[5] * SC_QKV, o[6] * SC_QKV, o[7] * SC_QKV);
                    if (sec == 1) {
#pragma unroll
                        for (int j = 0; j < 8; ++j) { float sv = o[j]; sv += __shfl_xor(sv, 1); sv += __shfl_xor(sv, 2); sv += __shfl_xor(sv, 4); sv += __shfl_xor(sv, 8); o[j] = sv; }
                        if (fr == 0) { LAS float* yp = Y + ((((wr * 2 + ai) * 4 + m) * 2 + bj) * 128) + 16 * wc + 4 * fq; *(LAS f32x4*)yp = (f32x4){o[0], o[1], o[2], o[3]}; *(LAS f32x4*)(yp + 64) = (f32x4){o[4], o[5], o[6], o[7]}; }
                    } }
                asm volatile("" ::: "memory"); }
        if (sec == 1) {
            asm volatile("s_waitcnt lgkmcnt(0)" ::: "memory"); __builtin_amdgcn_s_barrier(); asm volatile("" ::: "memory");
            const int tid = make_tid(wv);
            if (tid < 256) { const int bj = tid >> 7, d = tid & 127; const int b = u.pm >> 4, nb = u.pm & 15, head = (u.pn & 7) * 2 + bj;
                float sm = 0.f;
#pragma unroll
                for (int q = 0; q < 16; ++q) sm += Y[(q * 2 + bj) * 128 + d];
                float* kmb = kmean; asm volatile("" : "+s"(kmb));
                ((GAS float*)kmb)[((b * H + head) * NBLK + nb) * HD + d] = sm * (1.0f / 256); }
        }
    }
};

__device__ __forceinline__ void glds_saddr(const char* sbase, unsigned voff, unsigned lds_dst) {
    unsigned keep;
    asm volatile("s_mov_b32 %0, m0\n\ts_mov_b32 m0, %3\n\ts_nop 4\n\tglobal_load_lds_dwordx4 %1, %2\n\ts_mov_b32 m0, %0" : "=&s"(keep) : "v"(voff), "s"(sbase), "s"(lds_dst) : "memory");
}
typedef int i32x4 __attribute__((ext_vector_type(4)));
typedef int i32x8 __attribute__((ext_vector_type(8)));
__device__ __forceinline__ i32x8 cat8(bf16x8 lo, bf16x8 hi) { const i32x4 a = __builtin_bit_cast(i32x4, lo), b = __builtin_bit_cast(i32x4, hi); return __builtin_shufflevector(a, b, 0, 1, 2, 3, 4, 5, 6, 7); }
template <class Epi, class Sched, bool ALIGN_EPI, bool FP8 = false>
__device__ __forceinline__ void gemm_phase(LAS unsigned char* lds, const Sched& S, const Epi& E) {
    const int tid = make_tid(S.wv), wid = __builtin_amdgcn_readfirstlane(tid >> 6), lane = tid & 63, wr = wid >> 2, wc = wid & 3, fr = lane & 15, fq = lane >> 4;
    const int K = S.K, RB = S.RB, nt = RB / (BK * 2);
    unsigned voffA[2], voffB[2];
#pragma unroll
    for (int i = 0; i < 2; ++i) { int R, C; stage_rc(tid * 16 + i * 8192, R, C); const int Rb = Epi::PERM ? ((R & ~31) + perm32(R & 31)) : R;
        voffA[i] = (unsigned)(R * RB + C * 2); voffB[i] = (unsigned)(Rb * RB + C * 2); }
    const size_t kstep = (size_t)(BK * 2);
    const size_t hstep = (size_t)HALF * RB;
    const unsigned ldsw = (unsigned)wid * 1024u, ldsb = (unsigned)(size_t)lds;
    const int aoff = lds_byte(wr * 64 + fr, fq * 8), boff = lds_byte(wc * 32 + fr, fq * 8);
#define PG8_SA(b, h) (((b) * 2 + (h)) * HTB)
#define PG8_SB(b, h) ((4 + (b) * 2 + (h)) * HTB)
#define PG8_STAGE(bufoff, gbase, voff) do { _Pragma("unroll") for (int _i = 0; _i < 2; ++_i) glds_saddr((const char*)(gbase), (voff)[_i], ldsb + (unsigned)(bufoff) + ldsw + _i * 8192u); } while (0)
#define PG8_GOFS(pp, h, i) (gofs + ((((pp) * 2 + (h)) * 2 + (i)) * 512))
#define PG8_STAGE_A(bufoff, sel, h, ko) do { if constexpr (Sched::GATHER) { const int _pp = (sel) ? (pc ^ 1) : pc; unsigned _v[2]; _v[0] = PG8_GOFS(_pp, h, 0)[tid]; _v[1] = PG8_GOFS(_pp, h, 1)[tid]; PG8_STAGE(bufoff, S.A + (ko), _v); } \
        else { PG8_STAGE(bufoff, ((sel) ? nA : cA) + (h) * hstep + (ko), voffA); } } while (0)
#define PG8_LDA(dst, b, h) do { _Pragma("unroll") for (int m = 0; m < 4; ++m) { if constexpr (FP8) dst##8[m] = cat8(*(const LAS bf16x8*)(lds + PG8_SA(b, h) + aoff + m * 2048), *(const LAS bf16x8*)(lds + PG8_SA(b, h) + aoff + m * 2048 + 1024)); \
        else { _Pragma("unroll") for (int k = 0; k < 2; ++k) dst[m][k] = *(const LAS bf16x8*)(lds + PG8_SA(b, h) + aoff + m * 2048 + k * 1024); } } } while (0)
#define PG8_LDB(dst, b, h) do { _Pragma("unroll") for (int n = 0; n < 2; ++n) { if constexpr (FP8) dst##8[n] = cat8(*(const LAS bf16x8*)(lds + PG8_SB(b, h) + boff + n * 2048), *(const LAS bf16x8*)(lds + PG8_SB(b, h) + boff + n * 2048 + 1024)); \
        else { _Pragma("unroll") for (int k = 0; k < 2; ++k) dst[n][k] = *(const LAS bf16x8*)(lds + PG8_SB(b, h) + boff + n * 2048 + k * 1024); } } } while (0)
#define PG8_MMA(ai, bj, At, Bt) do { __builtin_amdgcn_s_setprio(1); _Pragma("unroll") for (int m = 0; m < 4; ++m) _Pragma("unroll") for (int n = 0; n < 2; ++n) { if constexpr (FP8) { \
        acc[ai][bj][m][n] = __builtin_amdgcn_mfma_scale_f32_16x16x128_f8f6f4(Bt##8[n], At##8[m], acc[ai][bj][m][n], 0, 0, 0, 0, 0, 0); } else { _Pragma("unroll") for (int k = 0; k < 2; ++k) \
        acc[ai][bj][m][n] = __builtin_amdgcn_mfma_f32_16x16x32_bf16(Bt[n][k], At[m][k], acc[ai][bj][m][n], 0, 0, 0); } } __builtin_amdgcn_s_setprio(0); } while (0)
#define PG8_WAIT_V(n) asm volatile("s_waitcnt vmcnt(" #n ")" ::: "memory")
#define PG8_WAIT_L(n) asm volatile("s_waitcnt lgkmcnt(" #n ")" ::: "memory")
#define PG8_BAR __builtin_amdgcn_s_barrier()
#define PG8_SCHED __builtin_amdgcn_sched_barrier(0)
    Unit cur, nxt; int ui = 0; int dyn_pend = 0;
    if constexpr (Sched::DYNAMIC) {
        if (wid == 0) { int v2 = 0; if (lane == 0) { const int v0 = S.fetch(), v1 = S.fetch(); v2 = S.fetch(); S.slot[0] = v0; S.slot[1] = v1; } dyn_pend = __builtin_amdgcn_readfirstlane(v2); }
        PG8_WAIT_L(0); PG8_BAR;
        const int L0 = __builtin_amdgcn_readfirstlane(S.slot[0]); if (L0 >= S.nwg) return;
        S.map(L0, cur);
    } else { if (!S.next(0, cur)) return; }
    LAS unsigned* gofs = (LAS unsigned*)(lds + 131072); int pc = 0;
#define PG8_WRITE_GOFS(pp, U) do { int _t = tid; asm volatile("" : "+v"(_t)); _Pragma("unroll") for (int _i = 0; _i < 2; ++_i) { int _R, _C; stage_rc(_t * 16 + _i * 8192, _R, _C); \
        _Pragma("unroll") for (int _h = 0; _h < 2; ++_h) PG8_GOFS(pp, _h, _i)[_t] = S.row_off(U, _h * HALF + _R) + (unsigned)_C * 2u; } } while (0)
    if constexpr (Sched::GATHER) PG8_WRITE_GOFS(0, cur);
    f32x4 acc[2][2][4][2];
#pragma unroll
    for (int a = 0; a < 2; ++a)
#pragma unroll
        for (int b = 0; b < 2; ++b)
#pragma unroll
            for (int m = 0; m < 4; ++m)
#pragma unroll
                for (int n = 0; n < 2; ++n) acc[a][b][m][n] = (f32x4){0.f, 0.f, 0.f, 0.f};
    bf16x8 At[4][2], B0[2][2], B1[2][2]; i32x8 At8[4], B08[2], B18[2];
    const char* cA = cur.a; const char* cB = cur.b; const char* nA = cA; const char* nB = cB;
    PG8_STAGE(PG8_SB(0, 0), cB, voffB); PG8_STAGE(PG8_SB(0, 1), cB + hstep, voffB); PG8_STAGE_A(PG8_SA(0, 0), false, 0, 0); PG8_STAGE_A(PG8_SA(0, 1), false, 1, 0);
    if (wr == 1) PG8_BAR;
    PG8_WAIT_V(2); PG8_BAR;
    PG8_STAGE(PG8_SB(1, 0), cB + kstep, voffB); PG8_STAGE_A(PG8_SA(1, 0), false, 0, kstep); PG8_STAGE(PG8_SB(1, 1), cB + hstep + kstep, voffB);
    PG8_WAIT_V(6); PG8_BAR;
    for (;;) {
        bool has_next = true;
        if constexpr (Sched::DYNAMIC) {
            if (ui >= 1 && wid == 0) { int v = 0; if (lane == 0) { S.slot[(ui + 1) % 3] = dyn_pend; v = S.fetch(); } dyn_pend = __builtin_amdgcn_readfirstlane(v); }
        } else { has_next = S.next(ui + 1, nxt); nA = has_next ? nxt.a : cA; nB = has_next ? nxt.b : cB; }
        if constexpr (Sched::GATHER) { if (has_next) PG8_WRITE_GOFS(pc ^ 1, nxt); else PG8_WRITE_GOFS(pc ^ 1, cur); }
        for (int t = 0; t < nt; t += 2) {
            const bool last = (t == nt - 2);
            if constexpr (Sched::DYNAMIC) { if (last) { const int Ln = __builtin_amdgcn_readfirstlane(S.slot[(ui + 1) % 3]); has_next = Ln < S.nwg; if (has_next) S.map(Ln, nxt); nA = has_next ? nxt.a : cA; nB = has_next ? nxt.b : cB; } }
            const size_t k1 = (size_t)(t + 1) * kstep;
            const size_t k2 = last ? 0 : (size_t)(t + 2) * kstep, k3 = k2 + kstep;
            const char* b2 = (last ? nB : cB) + k2; const char* b3 = b2 + kstep;
            PG8_LDB(B0, 0, 0); PG8_LDB(B1, 0, 1); PG8_SCHED; PG8_LDA(At, 0, 0); PG8_STAGE_A(PG8_SA(1, 1), false, 1, k1);
            PG8_WAIT_V(8); PG8_WAIT_L(0); PG8_BAR; PG8_MMA(0, 0, At, B0); PG8_MMA(0, 1, At, B1); PG8_BAR; PG8_SCHED;
            PG8_LDA(At, 0, 1); PG8_STAGE(PG8_SB(0, 0), b2, voffB); PG8_STAGE(PG8_SB(0, 1), b2 + hstep, voffB); PG8_STAGE_A(PG8_SA(0, 0), last, 0, k2);
            PG8_WAIT_V(8); PG8_WAIT_L(0); PG8_BAR; PG8_MMA(1, 0, At, B0); PG8_MMA(1, 1, At, B1); PG8_BAR; PG8_SCHED;
            PG8_LDB(B0, 1, 0); PG8_LDB(B1, 1, 1); PG8_SCHED; PG8_LDA(At, 1, 0); PG8_STAGE_A(PG8_SA(0, 1), last, 1, k2);
            PG8_WAIT_V(8); PG8_WAIT_L(0); PG8_BAR; PG8_MMA(0, 0, At, B0); PG8_MMA(0, 1, At, B1); PG8_BAR; PG8_SCHED;
            PG8_LDA(At, 1, 1); PG8_STAGE(PG8_SB(1, 0), b3, voffB); PG8_STAGE(PG8_SB(1, 1), b3 + hstep, voffB); PG8_STAGE_A(PG8_SA(1, 0), last, 0, k3);
            PG8_WAIT_V(8); PG8_WAIT_L(0); PG8_BAR; PG8_MMA(1, 0, At, B0); PG8_MMA(1, 1, At, B1); PG8_BAR; PG8_SCHED;
        }
        if constexpr (ALIGN_EPI) { if (wr == 0) PG8_BAR; }
        { const int l2_ = lane_id(); E(acc, cur, wr, wc, l2_ & 15, l2_ >> 4); }
        if (!has_next) break;
#pragma unroll
        for (int a = 0; a < 2; ++a)
#pragma unroll
            for (int b = 0; b < 2; ++b)
#pragma unroll
                for (int m = 0; m < 4; ++m)
#pragma unroll
                    for (int n = 0; n < 2; ++n) acc[a][b][m][n] = (f32x4){0.f, 0.f, 0.f, 0.f};
        cur = nxt; cA = nA; cB = nB; ++ui;
        pc ^= 1;
        if constexpr (ALIGN_EPI) { if (wr == 1) PG8_BAR; }
    }
    PG8_WAIT_V(0);
    if constexpr (!ALIGN_EPI) { if (wr == 0) PG8_BAR; }
    PG8_BAR;
#undef PG8_SA
#undef PG8_SB
#undef PG8_STAGE
#undef PG8_STAGE_A
#undef PG8_GOFS
#undef PG8_WRITE_GOFS
#undef PG8_LDA
#undef PG8_LDB
#undef PG8_MMA
#undef PG8_WAIT_V
#undef PG8_WAIT_L
#undef PG8_BAR
#undef PG8_SCHED
}
}

#define XB_TMO      128
#define XB_XCNT(j)  (256  + 64 * (j))
#define XB_XSUB(j)  (1280 + 64 * (j))
#define XB_XGEN(j)  (2304 + 64 * (j))
#define XB_TOP      3328
#define XB_TOPGEN   3392
#define XCD_BAR_WORDS 3456
#define XB_SPIN_CAP (1u << 18)
__device__ __forceinline__ unsigned xb_ld(unsigned* p)              { return __hip_atomic_load(p, __ATOMIC_RELAXED, __HIP_MEMORY_SCOPE_AGENT); }
__device__ __forceinline__ unsigned xb_add(unsigned* p, unsigned v) { return __hip_atomic_fetch_add(p, v, __ATOMIC_RELAXED, __HIP_MEMORY_SCOPE_AGENT); }
__device__ __forceinline__ unsigned xb_xcc_id() { return (unsigned)__builtin_amdgcn_s_getreg((3 << 11) | 20) & 0xFu; }
#define XB_SPIN(cond, bar) do { unsigned _sp = 0; while (cond) { __builtin_amdgcn_s_sleep(1); \
    if ((++_sp & 255u) == 0u) { if (xb_ld(&(bar)[XB_TMO])) break; if (_sp > XB_SPIN_CAP) { atomicAdd(&(bar)[XB_TMO], 1u); break; } } } } while (0)
struct XcdBarrier { unsigned* bar; unsigned x; volatile LAS unsigned* st; };
__device__ __forceinline__ XcdBarrier xcd_barrier_post(unsigned* bar, volatile LAS unsigned* st, int tid0) {
    XcdBarrier b; b.bar = bar; b.x = xb_xcc_id(); b.st = st;
    if (tid0 == 0) (void)xb_add(&bar[XB_XCNT(b.x)], 1u);
    return b;
}
__device__ __forceinline__ void xcd_barrier_complete(unsigned* bar, unsigned x, unsigned& nloc, unsigned& nx) {
    const unsigned G = gridDim.x * gridDim.y * gridDim.z;
    unsigned sum, cnt, mine, sp = 0u;
    for (;;) {
        sum = 0u; cnt = 0u; mine = 0u;
#pragma unroll
        for (unsigned j = 0; j < 16; ++j) { const unsigned c = xb_ld(&bar[XB_XCNT(j)]); sum += c; cnt += (c > 0u) ? 1u : 0u; mine = (j == x) ? c : mine; }
        if (sum == G) break;
        __builtin_amdgcn_s_sleep(1);
        if ((++sp & 255u) == 0u) { if (xb_ld(&bar[XB_TMO])) break; if (sp > XB_SPIN_CAP) { atomicAdd(&bar[XB_TMO], 1u); break; } }
    }
    nloc = mine > 0u ? mine : 1u; nx = cnt > 0u ? cnt : 1u;
}
__device__ __forceinline__ void xcd_barrier(const XcdBarrier& b, int tid0) {
    asm volatile("s_waitcnt vmcnt(0)" ::: "memory");
    __syncthreads();
    if (tid0 == 0) {
        unsigned* bar = b.bar;
        __builtin_amdgcn_s_waitcnt(0);
        unsigned nloc = b.st[0], nx = b.st[1];
        if (nloc == 0u) { xcd_barrier_complete(bar, b.x, nloc, nx); b.st[0] = nloc; b.st[1] = nx; }
        const unsigned old = xb_add(&bar[XB_XSUB(b.x)], 1u);
        const unsigned gen = old / nloc;
        if (old + 1u == (gen + 1u) * nloc) {
            __builtin_amdgcn_fence(__ATOMIC_RELEASE, "agent");
            asm volatile("s_waitcnt vmcnt(0)" ::: "memory");
            const unsigned og = xb_add(&bar[XB_TOP], 1u);
            const unsigned tg = og / nx;
            if (og + 1u == (tg + 1u) * nx) xb_add(&bar[XB_TOPGEN], 1u);
            else XB_SPIN(xb_ld(&bar[XB_TOPGEN]) == tg, bar);
            __builtin_amdgcn_fence(__ATOMIC_ACQUIRE, "agent");
            xb_add(&bar[XB_XGEN(b.x)], 1u);
            asm volatile("s_waitcnt vmcnt(0)" ::: "memory");
        } else {
            XB_SPIN(xb_ld(&bar[XB_XGEN(b.x)]) == gen, bar);
            __builtin_amdgcn_fence(__ATOMIC_ACQUIRE, "agent");
            asm volatile("s_waitcnt vmcnt(0)" ::: "memory");
        }
    }
    __syncthreads();
}

struct Args { const float* in[20]; float* out; unsigned char* ws; int ph_lo, ph_hi; };
typedef const __attribute__((address_space(4))) Args CArgs;
enum { I_X = 0, I_NORM_MIX, I_NORM_FFN, I_A_W_IN, I_A_LB, I_A_OGAIN, I_A_W_OUT, I_KV_NORM, I_KV_W, I_K_NORM, I_B_W_Q, I_B_Q_NORM, I_B_W_OUT,
       I_W_GROUP, I_B_GROUP, I_W_EXPERT, I_B_EXPERT, I_W_GATE, I_W_UP, I_W_DOWN };
struct Frame {
    LAS unsigned char* lds; unsigned char* ws; unsigned* ctl;
    int tid, lane, wave, vcu, G, gw, NGW;
};

template <bool PERMQK = false, bool OUT8 = false> __device__ __forceinline__ void transpose_item(const float* __restrict__ W, int K, int N, bf16* __restrict__ WT, int kb, int nb, int dst_row0, const float* __restrict__ kscale, LAS float* scr, int lane, float osc = 1.0f) {
    const int k0 = 64 * kb, n0 = 32 * nb;
#pragma unroll 8
    for (int i = 0; i < 32; ++i) { const int kk = 2 * i + (lane >> 5); float w = W[(size_t)(k0 + kk) * N + n0 + (lane & 31)]; if (kscale) w *= kscale[k0 + kk]; scr[kk * 33 + (lane & 31)] = w; }
    LDS_WAIT(); asm volatile("" ::: "memory");
    const int c = lane & 7;
#pragma unroll
    for (int j = 0; j < 4; ++j) { const int n = (lane >> 3) + 8 * j; const LAS float* s = scr + (8 * c) * 33 + n;
        u32x4 o; o.x = pk2(s[0 * 33], s[1 * 33]); o.y = pk2(s[2 * 33], s[3 * 33]); o.z = pk2(s[4 * 33], s[5 * 33]); o.w = pk2(s[6 * 33], s[7 * 33]);
        int drow = dst_row0 + n;
        if (PERMQK) { const int cidx = (n0 + n), d = cidx & 127; drow = (dst_row0 - n0) + (cidx & ~127) + 32 * ((d & 63) >> 4) + 8 * ((d & 15) >> 2) + 4 * (d >> 6) + (d & 3); }
        if (OUT8) { u32x2 o8; o8.x = pk4_fp8(s[0 * 33] * osc, s[1 * 33] * osc, s[2 * 33] * osc, s[3 * 33] * osc); o8.y = pk4_fp8(s[4 * 33] * osc, s[5 * 33] * osc, s[6 * 33] * osc, s[7 * 33] * osc);
            *(u32x2*)((unsigned char*)WT + (size_t)drow * K + k0 + 8 * c) = o8; }
        else *(u32x4*)(WT + (size_t)drow * K + k0 + 8 * c) = o; }
    LDS_WAIT(); asm volatile("" ::: "memory");
}
constexpr size_t WGU_LSTRIDE = 64 * MiB, WD_LSTRIDE = 32 * MiB;
static_assert((FP8_MOE0 != 0) && (FP8_MOE1 != 0), "the two-layer weight residency assumes e4m3 expert weights");
template <bool OUT8> __device__ __forceinline__ void convert_moe_item(CArgs& a, unsigned char* ws, int layer, int item, LAS float* scr, int lane) {
    const int e = item / 1536, r = item % 1536, which = r / 512, q = r % 512;
    const size_t eo = (size_t)(layer * NE + e);
    if (which < 2) {
        const float* W = (which == 0 ? a.in[I_W_GATE] : a.in[I_W_UP]) + eo * (size_t)D * FF;
        const int kb = q / 16, nb = q % 16, n0 = nb * 32;
        transpose_item<false, OUT8>(W, D, FF, (bf16*)(ws + WS_WGU + (OUT8 ? (size_t)layer * WGU_LSTRIDE : 0) + (size_t)e * 1024 * D * (OUT8 ? 1 : 2)), kb, nb, (n0 >> 7) * 256 + which * 128 + (n0 & 127), nullptr, scr, lane, OUT8 ? SC_W : 1.0f);
    } else {
        const float* W = a.in[I_W_DOWN] + eo * (size_t)FF * D;
        const int kb = q / 64, nb = q % 64;
        transpose_item<false, OUT8>(W, FF, D, (bf16*)(ws + WS_WD + (OUT8 ? (size_t)layer * WD_LSTRIDE : 0) + (size_t)e * D * FF * (OUT8 ? 1 : 2)), kb, nb, nb * 32, nullptr, scr, lane, OUT8 ? SC_WD : 1.0f);
    }
}
__device__ __forceinline__ void rms_row_to_bf16(const float* xrow, bf16* orow, int lane) {
    const f32x4* xr = (const f32x4*)xrow + lane;
    f32x4 v[8]; float s = 0.f;
#pragma unroll
    for (int j = 0; j < 8; ++j) { v[j] = xr[64 * j]; s += (v[j].x * v[j].x + v[j].y * v[j].y) + (v[j].z * v[j].z + v[j].w * v[j].w); }
    const float rstd = __builtin_amdgcn_rsqf(wave_sum(s) * (1.f / D) + RMS_EPS);
    u32x2* o8 = (u32x2*)orow + lane;
#pragma unroll
    for (int j = 0; j < 8; ++j) { u32x2 w; w.x = pk2(v[j].x * rstd, v[j].y * rstd); w.y = pk2(v[j].z * rstd, v[j].w * rstd); o8[64 * j] = w; }
}

__device__ __forceinline__ int moe_tables(Frame& F, int layer) {
    LAS int* blk_e = (LAS int*)(F.lds + LT_BLKE); LAS int* blkstart = (LAS int*)(F.lds + LT_BLKSTART); LAS int* cntl = (LAS int*)(F.lds + LT_CNT);
    __syncthreads();
    if (F.wave == 0) {
        const int e = F.lane & 31;
        const int c = (int)__hip_atomic_load(F.ctl + CW_CNT + 64 * layer + e, __ATOMIC_RELAXED, __HIP_MEMORY_SCOPE_AGENT);
        const int nb = (c + 255) >> 8;
        int incl = nb;
#pragma unroll
        for (int o = 1; o < 32; o <<= 1) { const int t = __shfl_up(incl, o, 32); if ((F.lane & 31) >= o) incl += t; }
        const int excl = incl - nb;
        if (F.lane < 32) { blkstart[e] = excl; cntl[e] = c; for (int r = 0; r < nb; ++r) blk_e[excl + r] = e; if (e == 31) blkstart[32] = incl; }
    }
    __syncthreads();
    return blkstart[32];
}

typedef const GAS char* gcptr;
__device__ __forceinline__ gcptr opaque_s(const void* p) { asm volatile("" : "+s"(p)); return (gcptr)p; }
__device__ __forceinline__ float wave_reduce4(const float (&p)[4], int lane) {
    const bool b0 = lane & 1, b1 = lane & 2;
    float a0 = b0 ? p[1] : p[0], x0 = b0 ? p[0] : p[1]; a0 += __shfl_xor(x0, 1);
    float a1 = b0 ? p[3] : p[2], x1 = b0 ? p[2] : p[3]; a1 += __shfl_xor(x1, 1);
    float c = b1 ? a1 : a0, d = b1 ? a0 : a1; c += __shfl_xor(d, 2);
    c += __shfl_xor(c, 4); c += __shfl_xor(c, 8); c += __shfl_xor(c, 16); c += __shfl_xor(c, 32);
    return c;
}
__device__ __forceinline__ float wave_reduce8(const float (&p)[8], int lane) {
    const bool b2 = lane & 4;
    const float lo[4] = {p[0], p[1], p[2], p[3]}, hi[4] = {p[4], p[5], p[6], p[7]};
    float q[4];
#pragma unroll
    for (int i = 0; i < 4; ++i) { const float keep = b2 ? hi[i] : lo[i], give = b2 ? lo[i] : hi[i]; q[i] = keep + __shfl_xor(give, 4); }
    const bool b0 = lane & 1, b1 = lane & 2;
    float a0 = b0 ? q[1] : q[0], x0 = b0 ? q[0] : q[1]; a0 += __shfl_xor(x0, 1);
    float a1 = b0 ? q[3] : q[2], x1 = b0 ? q[2] : q[3]; a1 += __shfl_xor(x1, 1);
    float c = b1 ? a1 : a0, d = b1 ? a0 : a1; c += __shfl_xor(d, 2);
    c += __shfl_xor(c, 8); c += __shfl_xor(c, 16); c += __shfl_xor(c, 32);
    return c;
}
template <bool DRY, bool OUT8> __device__ __forceinline__ void route_token(Frame& F, CArgs& a, int layer, int t) {
    const bf16* xrow = (const bf16*)(F.ws + WS_XR) + (size_t)t * D;
    const unsigned l16 = (unsigned)F.lane * 16u;
    gcptr xb = opaque_s(xrow); gcptr gb = opaque_s(a.in[I_NORM_FFN] + layer * D);
    f32x4 v[8]; float s = 0.f;
#pragma unroll
    for (int j = 0; j < 8; ++j) { const u32x2 xw_ = *(const GAS u32x2*)(xb + j * 512 + (l16 >> 1)); v[j] = (f32x4){bflo(xw_.x), bfhi(xw_.x), bflo(xw_.y), bfhi(xw_.y)}; s += (v[j].x * v[j].x + v[j].y * v[j].y) + (v[j].z * v[j].z + v[j].w * v[j].w); }
    const float rstd = __builtin_amdgcn_rsqf(wave_sum(s) * (1.f / D) + RMS_EPS);
    u32x2* o8 = (u32x2*)((bf16*)(F.ws + (DRY ? WS_OPART : WS_XN)) + (size_t)t * D) + F.lane;
#pragma unroll
    for (int j = 0; j < 8; ++j) { const f32x4 g = *(const GAS f32x4*)(gb + j * 1024 + l16); v[j].x *= rstd * g.x; v[j].y *= rstd * g.y; v[j].z *= rstd * g.z; v[j].w *= rstd * g.w;
        if (OUT8) ((unsigned*)(F.ws + (DRY ? WS_OPART : WS_XN)) + (size_t)t * (D / 4))[64 * j + F.lane] = pk4_fp8(v[j].x * SC_XN, v[j].y * SC_XN, v[j].z * SC_XN, v[j].w * SC_XN);
        else { u32x2 w; w.x = pk2(v[j].x, v[j].y); w.y = pk2(v[j].z, v[j].w); o8[64 * j] = w; } }
    const float* RT = (const float*)(F.ws + WS_RT) + (size_t)layer * 36 * D;
    float gl[4];
    { float pp[4];
#pragma unroll
      for (int r = 0; r < 4; ++r) { gcptr wb = opaque_s(RT + r * D); float p = 0.f;
#pragma unroll
        for (int j = 0; j < 8; ++j) { const f32x4 w = *(const GAS f32x4*)(wb + j * 1024 + l16); p += (v[j].x * w.x + v[j].y * w.y) + (v[j].z * w.z + v[j].w * w.w); }
        pp[r] = p; if (r & 1) __builtin_amdgcn_sched_barrier(0); }
      const float red = wave_reduce4(pp, F.lane);
#pragma unroll
      for (int r = 0; r < 4; ++r) gl[r] = __builtin_bit_cast(float, __builtin_amdgcn_readlane(__builtin_bit_cast(int, red), r)) + a.in[I_B_GROUP][layer * NG + r]; }
    int g = 0; float gm = gl[0];
#pragma unroll
    for (int r = 1; r < 4; ++r) if (gl[r] > gm) { gm = gl[r]; g = r; }
    float gs = 0.f;
#pragma unroll
    for (int r = 0; r < 4; ++r) gs += __expf(gl[r] - gm);
    const float gp = 1.0f / gs;
    g = __builtin_amdgcn_readfirstlane(g);
    float el[8];
    { float pp[8];
#pragma unroll
      for (int r = 0; r < 8; ++r) { gcptr wb = opaque_s(RT + (size_t)(4 + g * 8 + r) * D); float p = 0.f;
#pragma unroll
        for (int j = 0; j < 8; ++j) { const f32x4 w = *(const GAS f32x4*)(wb + j * 1024 + l16); p += (v[j].x * w.x + v[j].y * w.y) + (v[j].z * w.z + v[j].w * w.w); }
        pp[r] = p; if (r & 1) __builtin_amdgcn_sched_barrier(0); }
      const float red = wave_reduce8(pp, F.lane);
#pragma unroll
      for (int r = 0; r < 8; ++r) el[r] = __builtin_bit_cast(float, __builtin_amdgcn_readlane(__builtin_bit_cast(int, red), r)) + a.in[I_B_EXPERT][layer * NE + g * 8 + r]; }
    int i0 = 0; float m0 = el[0];
#pragma unroll
    for (int r = 1; r < 8; ++r) if (el[r] > m0) { m0 = el[r]; i0 = r; }
    int i1 = -1; float m1 = -INFINITY;
#pragma unroll
    for (int r = 0; r < 8; ++r) if (r != i0 && el[r] > m1) { m1 = el[r]; i1 = r; }
    const float q1 = __expf(m1 - m0), w0 = gp / (1.0f + q1), w1 = gp * q1 / (1.0f + q1);
    if (DRY && w0 + w1 < -1.0f) ((float*)(F.ws + WS_OPART))[0] = w0;
    if (F.lane == 0 && !DRY) {
        const int e0 = g * 8 + i0, e1 = g * 8 + i1;
        const int r0 = (int)atomicAdd(F.ctl + CW_CNT + 64 * layer + e0, 1u), r1 = (int)atomicAdd(F.ctl + CW_CNT + 64 * layer + e1, 1u);
        int* lists = (int*)(F.ws + WS_LISTS); lists[e0 * LIST_CAP + r0] = t; lists[e1 * LIST_CAP + r1] = t;
        int* rec = (int*)(F.ws + WS_TOKREC) + (size_t)t * 8;
        rec[0] = e0; rec[1] = r0; rec[2] = __builtin_bit_cast(int, w0); rec[3] = e1; rec[4] = r1; rec[5] = __builtin_bit_cast(int, w1);
    }
}

template <bool NORM, bool DRY, bool OUT8> __device__ __forceinline__ void combine_token(Frame& F, CArgs& a, int t) {
    const LAS int* blkstart = (const LAS int*)(F.lds + LT_BLKSTART);
    const int* rec = (const int*)(F.ws + WS_TOKREC) + (size_t)t * 8;
    const int e0 = rec[0], r0 = rec[1], e1 = rec[3], r1 = rec[4]; const float w0 = __builtin_bit_cast(float, rec[2]), w1 = __builtin_bit_cast(float, rec[5]);
    const size_t row0 = (size_t)blkstart[e0] * 256 + r0, row1 = (size_t)blkstart[e1] * 256 + r1;
    const u32x2* p0 = (const u32x2*)((const bf16*)(F.ws + WS_OUTB) + row0 * D) + F.lane; const u32x2* p1 = (const u32x2*)((const bf16*)(F.ws + WS_OUTB) + row1 * D) + F.lane;
    const unsigned* q0 = (const unsigned*)(F.ws + WS_OUTB + row0 * D) + F.lane; const unsigned* q1 = (const unsigned*)(F.ws + WS_OUTB + row1 * D) + F.lane;
    u32x2* xr = (u32x2*)((bf16*)(F.ws + WS_XR) + (size_t)t * D) + F.lane; f32x4* xo = (f32x4*)(a.out + (size_t)t * D) + F.lane;
    f32x4 v[8]; float s = 0.f;
#pragma unroll
    for (int j = 0; j < 8; ++j) { const u32x2 xb_ = xr[64 * j]; f32x4 x = (f32x4){bflo(xb_.x), bfhi(xb_.x), bflo(xb_.y), bfhi(xb_.y)};
        if (OUT8) { const unsigned b0 = q0[64 * j], b1 = q1[64 * j]; const float u0 = w0 * (1.0f / SC_OUT), u1 = w1 * (1.0f / SC_OUT);
            const f32x2 l0 = __builtin_amdgcn_cvt_pk_f32_fp8((int)b0, false), h0 = __builtin_amdgcn_cvt_pk_f32_fp8((int)b0, true), l1 = __builtin_amdgcn_cvt_pk_f32_fp8((int)b1, false), h1 = __builtin_amdgcn_cvt_pk_f32_fp8((int)b1, true);
            x.x += u0 * l0.x + u1 * l1.x; x.y += u0 * l0.y + u1 * l1.y; x.z += u0 * h0.x + u1 * h1.x; x.w += u0 * h0.y + u1 * h1.y; }
        else { const u32x2 a0 = p0[64 * j], a1 = p1[64 * j];
            x.x += w0 * bflo(a0.x) + w1 * bflo(a1.x); x.y += w0 * bfhi(a0.x) + w1 * bfhi(a1.x); x.z += w0 * bflo(a0.y) + w1 * bflo(a1.y); x.w += w0 * bfhi(a0.y) + w1 * bfhi(a1.y); }
        v[j] = x; if (NORM) { if (!DRY) { u32x2 w_; w_.x = pk2(x.x, x.y); w_.y = pk2(x.z, x.w); xr[64 * j] = w_; } } else xo[64 * j] = x; s += (x.x * x.x + x.y * x.y) + (x.z * x.z + x.w * x.w); }
    if (NORM) {
        const float rstd = __builtin_amdgcn_rsqf(wave_sum(s) * (1.f / D) + RMS_EPS);
        u32x2* o8 = (u32x2*)((bf16*)(F.ws + (DRY ? WS_OPART + 128 * MiB : WS_XN)) + (size_t)t * D) + F.lane;
#pragma unroll
        for (int j = 0; j < 8; ++j) {
            if (FP8_QKV) ((unsigned*)(F.ws + (DRY ? WS_OPART + 128 * MiB : WS_XN)) + (size_t)t * (D / 4))[64 * j + F.lane] = pk4_fp8(v[j].x * (rstd * SC_XN), v[j].y * (rstd * SC_XN), v[j].z * (rstd * SC_XN), v[j].w * (rstd * SC_XN));
            else { u32x2 w; w.x = pk2(v[j].x * rstd, v[j].y * rstd); w.y = pk2(v[j].z * rstd, v[j].w * rstd); o8[64 * j] = w; } }
    }
}

__device__ __forceinline__ void hgrn_naive_item(Frame& F, int item) {
    const int b = item >> 6, h = (item >> 2) & 15, sl = item & 3;
    const bf16* Zq = (const bf16*)(F.ws + WS_ZQ); const bf16* Zk = (const bf16*)(F.ws + WS_ZK); const _Float16* Zg = (const _Float16*)(F.ws + WS_ZG); const bf16* Zv = (const bf16*)(F.ws + WS_ZV);
    float* Oraw = (float*)(F.ws + WS_ORAW);
    LAS float* fq = (LAS float*)F.lds; LAS float* fk = fq + 16 * 128; LAS float* ff = fk + 16 * 128; LAS float* fv = ff + 16 * 128; LAS float* part = fv + 16 * 32;
    const int dv = F.tid & 31, dkg = F.tid >> 5;
    float S[8];
#pragma unroll
    for (int j = 0; j < 8; ++j) S[j] = 0.f;
    const size_t tok0 = (size_t)b * T;
    for (int c = 0; c < T / 16; ++c) {
        __syncthreads();
#pragma unroll
        for (int i = 0; i < 4; ++i) { const int idx = F.tid + i * 512, st = idx >> 7, dk = idx & 127; const size_t g = (tok0 + c * 16 + st) * D + h * HD + dk;
            fq[idx] = bf2f(Zq[g]); fk[idx] = bf2f(Zk[g]); ff[idx] = __expf((float)Zg[g]); }
        { const int st = F.tid >> 5; fv[F.tid] = bf2f(Zv[(tok0 + c * 16 + st) * D + h * HD + sl * 32 + dv]); }
        __syncthreads();
#pragma unroll 4
        for (int st = 0; st < 16; ++st) {
            const float v = fv[st * 32 + dv];
            const f32x4 q0 = *(const LAS f32x4*)(fq + st * 128 + dkg * 8), q1 = *(const LAS f32x4*)(fq + st * 128 + dkg * 8 + 4);
            const f32x4 k0 = *(const LAS f32x4*)(fk + st * 128 + dkg * 8), k1 = *(const LAS f32x4*)(fk + st * 128 + dkg * 8 + 4);
            const f32x4 f0 = *(const LAS f32x4*)(ff + st * 128 + dkg * 8), f1 = *(const LAS f32x4*)(ff + st * 128 + dkg * 8 + 4);
            float po = 0.f;
#pragma unroll
            for (int j = 0; j < 4; ++j) { S[j] = f0[j] * S[j] + k0[j] * v; po += q0[j] * S[j]; S[4 + j] = f1[j] * S[4 + j] + k1[j] * v; po += q1[j] * S[4 + j]; }
            part[(st * 16 + dkg) * 32 + dv] = po;
        }
        __syncthreads();
        { const int st = F.tid >> 5; float o = 0.f;
#pragma unroll
            for (int g = 0; g < 16; ++g) o += part[(st * 16 + g) * 32 + dv];
            Oraw[(tok0 + c * 16 + st) * D + h * HD + sl * 32 + dv] = o; }
    }
    __syncthreads();
}
__device__ __forceinline__ void hgrn_norm_token(Frame& F, CArgs& a, int t) {
    const float* o = (const float*)(F.ws + WS_ORAW) + (size_t)t * D + F.lane * 32;
    const bf16* zg = (const bf16*)(F.ws + WS_ZGATE) + (size_t)t * D + F.lane * 32;
    const float* gain = a.in[I_A_OGAIN] + (F.lane & 3) * 32;
    f32x4 v[8]; float s = 0.f;
#pragma unroll
    for (int j = 0; j < 8; ++j) { v[j] = ((const f32x4*)o)[j]; s += (v[j].x * v[j].x + v[j].y * v[j].y) + (v[j].z * v[j].z + v[j].w * v[j].w); }
    s += __shfl_xor(s, 1); s += __shfl_xor(s, 2);
    const float rstd = 1.0f / sqrtf(s * (1.f / HD) + RMS_EPS);
    bf16* out = (bf16*)(F.ws + WS_OH) + (size_t)t * D + F.lane * 32;
#pragma unroll
    for (int j = 0; j < 4; ++j) { const u32x4 g = ((const u32x4*)zg)[j]; const f32x4 ga = ((const f32x4*)gain)[2 * j], gb = ((const f32x4*)gain)[2 * j + 1]; const f32x4 va = v[2 * j], vb = v[2 * j + 1];
        u32x4 w; w.x = pk2(va.x * rstd * ga.x * bflo(g.x), va.y * rstd * ga.y * bfhi(g.x)); w.y = pk2(va.z * rstd * ga.z * bflo(g.y), va.w * rstd * ga.w * bfhi(g.y));
        w.z = pk2(vb.x * rstd * gb.x * bflo(g.z), vb.y * rstd * gb.y * bfhi(g.z)); w.w = pk2(vb.z * rstd * gb.z * bflo(g.w), vb.w * rstd * gb.w * bfhi(g.w));
        ((u32x4*)out)[j] = w; }
}

template <bool DRY> __device__ __forceinline__ void qk_post_item(Frame& F, CArgs& a, int item) {
    const int b = item >> 6, n = (item >> 2) & 15, hq = item & 3;
    const int hl = F.lane >> 4, sb = F.lane & 15, h = hq * 4 + hl;
    bf16* Q = (bf16*)(F.ws + WS_Q); bf16* Kb = (bf16*)(F.ws + WS_K);
    const f32x2* rope = (const f32x2*)(F.ws + WS_ROPE);
    const f32x4 gq0 = *(const f32x4*)(a.in[I_B_Q_NORM] + 4 * sb), gq1 = *(const f32x4*)(a.in[I_B_Q_NORM] + 64 + 4 * sb);
    const f32x4 gk0 = *(const f32x4*)(a.in[I_K_NORM] + 4 * sb), gk1 = *(const f32x4*)(a.in[I_K_NORM] + 64 + 4 * sb);
    float ks[8];
#pragma unroll
    for (int j = 0; j < 8; ++j) ks[j] = 0.f;
    for (int i = 0; i < 32; ++i) {
        const int pos = n * MBLK + F.wave * 32 + i; const size_t tok = (size_t)b * T + pos;
        f32x2 cs[4];
#pragma unroll
        for (int j = 0; j < 4; ++j) cs[j] = rope[pos * 64 + 4 * sb + j];
#pragma unroll
        for (int which = 0; which < 2; ++which) {
            bf16* p = (which ? Kb : Q) + tok * D + h * HD + 4 * sb;
            const u32x2 lo = *(const u32x2*)p, hi = *(const u32x2*)(p + 64);
            float x1[4] = {bflo(lo.x), bfhi(lo.x), bflo(lo.y), bfhi(lo.y)}, x2[4] = {bflo(hi.x), bfhi(hi.x), bflo(hi.y), bfhi(hi.y)};
            float s = 0.f;
#pragma unroll
            for (int j = 0; j < 4; ++j) s += x1[j] * x1[j] + x2[j] * x2[j];
            s += __shfl_xor(s, 1); s += __shfl_xor(s, 2); s += __shfl_xor(s, 4); s += __shfl_xor(s, 8);
            const float rstd = 1.0f / sqrtf(s * (1.f / HD) + RMS_EPS);
            const f32x4 g0 = which ? gk0 : gq0, g1 = which ? gk1 : gq1;
            float o1[4], o2[4];
#pragma unroll
            for (int j = 0; j < 4; ++j) { const float y1 = x1[j] * rstd * g0[j], y2 = x2[j] * rstd * g1[j]; o1[j] = y1 * cs[j].x - y2 * cs[j].y; o2[j] = y2 * cs[j].x + y1 * cs[j].y; }
            u32x2 wlo, whi; wlo.x = pk2(o1[0], o1[1]); wlo.y = pk2(o1[2], o1[3]); whi.x = pk2(o2[0], o2[1]); whi.y = pk2(o2[2], o2[3]);
            { bf16* pw = DRY ? p + (WS_OPART - WS_Q) / 2 : p; *(u32x2*)pw = wlo; *(u32x2*)(pw + 64) = whi; }
            if (which) {
#pragma unroll
                for (int j = 0; j < 4; ++j) { ks[j] += o1[j]; ks[4 + j] += o2[j]; } }
        }
    }
    LAS float* red = (LAS float*)F.lds;
    __syncthreads();
#pragma unroll
    for (int j = 0; j < 8; ++j) red[(F.wave * 64 + F.lane) * 8 + j] = ks[j];
    __syncthreads();
    { const int l = F.tid >> 3, j = F.tid & 7; float s = 0.f;
#pragma unroll
        for (int w = 0; w < 8; ++w) s += red[(w * 64 + l) * 8 + j];
        const int hh = hq * 4 + (l >> 4), s2 = l & 15, d = (j < 4) ? 4 * s2 + j : 64 + 4 * s2 + (j - 4);
        ((float*)(F.ws + (DRY ? WS_OPART + 200 * MiB : WS_KMEAN)))[(((size_t)b * H + hh) * NBLK + n) * HD + d] = s * (1.0f / MBLK); }
    const bf16* V = (const bf16*)(F.ws + WS_V); bf16* Vt = (bf16*)(F.ws + (DRY ? WS_OPART + 128 * MiB : WS_VT));
    LAS bf16* vl = (LAS bf16*)(F.lds + 32768);
    for (int hh = 0; hh < 4; ++hh) {
        const int hv = hq * 4 + hh;
        __syncthreads();
#pragma unroll
        for (int i = 0; i < 8; ++i) { const int ch = F.tid + i * 512, r = ch >> 4, cc = ch & 15;
            const u32x4 w = *(const u32x4*)(V + ((size_t)b * T + n * MBLK + r) * D + hv * HD + cc * 8);
            *(LAS u32x4*)(vl + r * 136 + cc * 8) = w; }
        __syncthreads();
#pragma unroll
        for (int i = 0; i < 8; ++i) { const int idx = F.tid + i * 512, d = idx & 127, tg = idx >> 7;
            unsigned short e[8];
#pragma unroll
            for (int j = 0; j < 8; ++j) e[j] = vl[(tg * 8 + j) * 136 + d];
            u32x4 w; w.x = e[0] | ((unsigned)e[1] << 16); w.y = e[2] | ((unsigned)e[3] << 16); w.z = e[4] | ((unsigned)e[5] << 16); w.w = e[6] | ((unsigned)e[7] << 16);
            *(u32x4*)(Vt + (((size_t)b * H + hv) * HD + d) * T + n * MBLK + tg * 8) = w; }
    }
    __syncthreads();
}

__device__ __forceinline__ void attn_v0_item(Frame& F, int item) {
    const int b = item >> 8, h = (item >> 4) & 15, jb = item & 15;
    const bf16* Q = (const bf16*)(F.ws + WS_Q); const bf16* Kb = (const bf16*)(F.ws + WS_K); const bf16* Vt = (const bf16*)(F.ws + WS_VT); bf16* OA = (bf16*)(F.ws + WS_OA);
    const float* kmean = (const float*)(F.ws + WS_KMEAN) + ((size_t)b * H + h) * NBLK * HD;
    const int lane = F.lane, fr = lane & 15, fq = lane >> 4;
    const size_t tokw = (size_t)b * T + jb * MBLK + F.wave * 32;
    LAS unsigned* maskl = (LAS unsigned*)(F.lds + F.wave * 8192);
    LAS bf16* pl = (LAS bf16*)(F.lds + F.wave * 8192 + 256);
    {
        const int row = lane & 31, half = lane >> 5;
        float g[8];
#pragma unroll
        for (int i = 0; i < 8; ++i) g[i] = 0.f;
        const bf16* qrow = Q + (tokw + row) * D + h * HD;
        for (int dc = 0; dc < 16; ++dc) {
            const u32x4 w = *(const u32x4*)(qrow + dc * 8);
            const float qv[8] = {bflo(w.x), bfhi(w.x), bflo(w.y), bfhi(w.y), bflo(w.z), bfhi(w.z), bflo(w.w), bfhi(w.w)};
#pragma unroll
            for (int i = 0; i < 8; ++i) { const float* km = kmean + (2 * i + half) * HD + dc * 8;
#pragma unroll
                for (int e = 0; e < 8; ++e) g[i] += qv[e] * km[e]; }
        }
        float ga[16];
#pragma unroll
        for (int i = 0; i < 8; ++i) { const float o = __shfl_xor(g[i], 32); ga[2 * i] = half ? o : g[i]; ga[2 * i + 1] = half ? g[i] : o; }
        unsigned mask = 0u;
#pragma unroll
        for (int pick = 0; pick < 3; ++pick) { float best = -INFINITY; int bi = -1;
#pragma unroll
            for (int n = 0; n < 16; ++n) { const bool ok = (n < jb) && !((mask >> n) & 1u); if (ok && ga[n] > best) { best = ga[n]; bi = n; } }
            if (bi >= 0) mask |= 1u << bi; }
        if (half == 0) maskl[row] = mask;
    }
    LDS_WAIT(); __builtin_amdgcn_wave_barrier();
    unsigned rmask[2][4]; unsigned anym = 0u;
#pragma unroll
    for (int rt = 0; rt < 2; ++rt)
#pragma unroll
        for (int r = 0; r < 4; ++r) { rmask[rt][r] = maskl[rt * 16 + 4 * fq + r]; }
    { unsigned m = maskl[lane & 31];
#pragma unroll
      for (int o = 1; o < 32; o <<= 1) m |= __shfl_xor(m, o);
      anym = __builtin_amdgcn_readfirstlane(m); }
    bf16x8 qf[2][4];
#pragma unroll
    for (int rt = 0; rt < 2; ++rt)
#pragma unroll
        for (int ks = 0; ks < 4; ++ks) qf[rt][ks] = *(const bf16x8*)(Q + (tokw + rt * 16 + fr) * D + h * HD + ks * 32 + 8 * fq);
    f32x4 oacc[2][8];
#pragma unroll
    for (int rt = 0; rt < 2; ++rt)
#pragma unroll
        for (int dt = 0; dt < 8; ++dt) oacc[rt][dt] = (f32x4){0.f, 0.f, 0.f, 0.f};
    float lsum[2][4];
#pragma unroll
    for (int rt = 0; rt < 2; ++rt)
#pragma unroll
        for (int r = 0; r < 4; ++r) lsum[rt][r] = 0.f;
    const float c2 = 0.08838834764831845f * 1.4426950408889634f;
    const int nkt = 4 * jb + 4;
    for (int kt = 0; kt < nkt; ++kt) {
        const int n = kt >> 2; const bool own = (n == jb);
        if (!own && !((anym >> n) & 1u)) continue;
        if (own && (kt & 3) * 64 > F.wave * 32 + 31) continue;
        const size_t key0 = (size_t)b * T + kt * 64;
        f32x4 sacc[2][4];
#pragma unroll
        for (int ct = 0; ct < 4; ++ct) {
            bf16x8 kf[4];
#pragma unroll
            for (int ks = 0; ks < 4; ++ks) kf[ks] = *(const bf16x8*)(Kb + (key0 + ct * 16 + fr) * D + h * HD + ks * 32 + 8 * fq);
#pragma unroll
            for (int rt = 0; rt < 2; ++rt) { f32x4 s = (f32x4){0.f, 0.f, 0.f, 0.f};
#pragma unroll
                for (int ks = 0; ks < 4; ++ks) s = __builtin_amdgcn_mfma_f32_16x16x32_bf16(qf[rt][ks], kf[ks], s, 0, 0, 0);
                sacc[rt][ct] = s; }
        }
#pragma unroll
        for (int rt = 0; rt < 2; ++rt)
#pragma unroll
            for (int ct = 0; ct < 4; ++ct)
#pragma unroll
                for (int r = 0; r < 4; ++r) {
                    const int qrow = rt * 16 + 4 * fq + r, kcol = ct * 16 + fr;
                    const bool ok = own ? ((kt & 3) * 64 + kcol <= F.wave * 32 + qrow) : ((rmask[rt][r] >> n) & 1u);
                    const float p = ok ? __builtin_amdgcn_exp2f(sacc[rt][ct][r] * c2) : 0.f;
                    lsum[rt][r] += p;
                    pl[qrow * 72 + kcol] = (bf16)f2bf(p);
                }
        LDS_WAIT(); __builtin_amdgcn_wave_barrier();
        bf16x8 pf[2][2];
#pragma unroll
        for (int rt = 0; rt < 2; ++rt)
#pragma unroll
            for (int k2 = 0; k2 < 2; ++k2) pf[rt][k2] = *(const LAS bf16x8*)(pl + (rt * 16 + fr) * 72 + k2 * 32 + 8 * fq);
#pragma unroll
        for (int dt = 0; dt < 8; ++dt) {
            bf16x8 vf[2];
#pragma unroll
            for (int k2 = 0; k2 < 2; ++k2) vf[k2] = *(const bf16x8*)(Vt + (((size_t)b * H + h) * HD + dt * 16 + fr) * T + kt * 64 + k2 * 32 + 8 * fq);
#pragma unroll
            for (int rt = 0; rt < 2; ++rt)
#pragma unroll
                for (int k2 = 0; k2 < 2; ++k2) oacc[rt][dt] = __builtin_amdgcn_mfma_f32_16x16x32_bf16(pf[rt][k2], vf[k2], oacc[rt][dt], 0, 0, 0);
        }
        LDS_WAIT(); __builtin_amdgcn_wave_barrier();
    }
#pragma unroll
    for (int rt = 0; rt < 2; ++rt)
#pragma unroll
        for (int r = 0; r < 4; ++r) { float s = lsum[rt][r]; s += __shfl_xor(s, 1); s += __shfl_xor(s, 2); s += __shfl_xor(s, 4); s += __shfl_xor(s, 8); const float inv = 1.0f / s;
            bf16* orow = OA + (tokw + rt * 16 + 4 * fq + r) * D + h * HD + fr;
#pragma unroll
            for (int dt = 0; dt < 8; ++dt) orow[dt * 16] = (bf16)f2bf(oacc[rt][dt][r] * inv); }
}

typedef float f32x16 __attribute__((ext_vector_type(16)));
template <bool DRY> __device__ __forceinline__ void moba_gate_item(Frame& F, int item) {
    const int bh = item >> 3, p = item & 7, b = bh >> 4, h = bh & 15;
    LAS float* km = (LAS float*)F.lds;
    __syncthreads();
    { const f32x4 v = ((const f32x4*)((const float*)(F.ws + WS_KMEAN) + (size_t)bh * NBLK * HD))[F.tid]; ((LAS f32x4*)km)[F.tid] = v; }
    __syncthreads();
    const int j = 2 * p + (F.wave >> 2), t = j * MBLK + (F.wave & 3) * 64 + F.lane;
    if (j == 0) return;
    const unsigned char* qrow = F.ws + WS_Q + ((size_t)b * T + t) * D + h * HD;
    float g[16];
#pragma unroll
    for (int n = 0; n < 16; ++n) g[n] = 0.f;
    for (int dc = 0; dc < 8; ++dc) {
        const u32x4 w = *(const u32x4*)(qrow + dc * 16);
        float qv[16]; { float t4[4]; fp8x4_to_f32(w.x, t4); qv[0] = t4[0]; qv[1] = t4[1]; qv[2] = t4[2]; qv[3] = t4[3]; fp8x4_to_f32(w.y, t4); qv[4] = t4[0]; qv[5] = t4[1]; qv[6] = t4[2]; qv[7] = t4[3];
            fp8x4_to_f32(w.z, t4); qv[8] = t4[0]; qv[9] = t4[1]; qv[10] = t4[2]; qv[11] = t4[3]; fp8x4_to_f32(w.w, t4); qv[12] = t4[0]; qv[13] = t4[1]; qv[14] = t4[2]; qv[15] = t4[3]; }
#pragma unroll
        for (int n = 0; n < 15; ++n) if (n < j) {
#pragma unroll
            for (int q4 = 0; q4 < 4; ++q4) { const f32x4 k0 = *(const LAS f32x4*)(km + n * HD + dc * 16 + 4 * q4);
                g[n] += (qv[4 * q4] * k0.x + qv[4 * q4 + 1] * k0.y) + (qv[4 * q4 + 2] * k0.z + qv[4 * q4 + 3] * k0.w); } }
    }
    int pk[3];
    unsigned mask = 0u;
#pragma unroll
    for (int pick = 0; pick < 3; ++pick) { float best = -INFINITY; int bi = -1;
#pragma unroll
        for (int n = 0; n < 15; ++n) { const bool ok = (n < j) && !((mask >> n) & 1u); if (ok && g[n] > best) { best = g[n]; bi = n; } }
        if (bi >= 0) mask |= 1u << bi;
        pk[pick] = bi; }
    unsigned* acnt = F.ctl + CW_ACNT + bh * 16; int* alist = (int*)(F.ws + WS_ALIST) + (size_t)bh * 16 * ALIST_CAP;
    unsigned mycnt = 0u;
#pragma unroll
    for (int n = 0; n < 15; ++n) if (n < j) { const unsigned long long bal = __ballot((mask >> n) & 1u); mycnt = (F.lane == n) ? (unsigned)__popcll(bal) : mycnt; }
    unsigned mybase = 0u;
    if (F.lane < 15 && mycnt > 0u && !DRY) mybase = atomicAdd(acnt + F.lane, mycnt);
#pragma unroll
    for (int n = 0; n < 15; ++n) if (n < j) {
        const bool sel = (mask >> n) & 1u; const int slot = (pk[0] == n) ? 0 : ((pk[1] == n) ? 1 : 2);
        const unsigned long long bal = __ballot(sel);
        if (bal) { const unsigned base = (unsigned)__builtin_amdgcn_readlane((int)mybase, n);
            const int rank = __popcll(bal & ((1ull << F.lane) - 1ull));
            if (sel) (DRY ? (int*)(F.ws + WS_OPART) : alist)[n * ALIST_CAP + base + rank] = t | (slot << 16); }
    }
}

constexpr int AL_K = 0, AL_V = 36864; constexpr float SC_P = 4.f;
typedef int i32x8v __attribute__((ext_vector_type(8)));
__device__ __forceinline__ i32x8v ld32(const LAS unsigned char* p) { const u32x4 a = *(const LAS u32x4*)p, b = *(const LAS u32x4*)(p + 16); i32x8v r; r[0] = a.x; r[1] = a.y; r[2] = a.z; r[3] = a.w; r[4] = b.x; r[5] = b.y; r[6] = b.z; r[7] = b.w; return r; }
template <bool OWN> __device__ __forceinline__ void attn_chunk(Frame& F, int b, int h, int n, int c, int cnt, const int* lst) {
    const int lane = F.lane, qi = lane & 31, hh = lane >> 5, w = F.wave;
    const int rem = OWN ? MBLK : cnt - c * 256;
    if (w * 32 >= rem) return;
    int t, slot; bool valid = true;
    if (OWN) { t = n * MBLK + w * 32 + qi; slot = 3; }
    else { const int idx = w * 32 + qi; valid = idx < rem; const int e = lst[c * 256 + (valid ? idx : 0)]; t = e & 0xffff; slot = e >> 16; }
    const size_t tok = (size_t)b * T + t;
    const unsigned char* qrow = F.ws + WS_Q + tok * D + h * HD;
    i32x8v qf[2];
#pragma unroll
    for (int ks = 0; ks < 2; ++ks) { const u32x4 a = *(const u32x4*)(qrow + 64 * ks + 32 * hh), bq = *(const u32x4*)(qrow + 64 * ks + 32 * hh + 16);
        qf[ks][0] = a.x; qf[ks][1] = a.y; qf[ks][2] = a.z; qf[ks][3] = a.w; qf[ks][4] = bq.x; qf[ks][5] = bq.y; qf[ks][6] = bq.z; qf[ks][7] = bq.w; }
    const LAS unsigned char* Kl = F.lds + AL_K; const LAS unsigned char* Vl = F.lds + AL_V;
    f32x16 oacc[4];
#pragma unroll
    for (int dt = 0; dt < 4; ++dt)
#pragma unroll
        for (int r = 0; r < 16; ++r) oacc[dt][r] = 0.f;
    float lsum = 0.f, mrun = -1e30f;
    const float c2 = 0.08838834764831845f * 1.4426950408889634f / (SC_QKV * SC_QKV);
    const int ngrp = OWN ? ((w >> 1) + 1) : 4;
#pragma unroll
    for (int G = 0; G < 4; ++G) {
        if (G >= ngrp) break;
        f32x16 sa, sb;
#pragma unroll
        for (int r = 0; r < 16; ++r) { sa[r] = 0.f; sb[r] = 0.f; }
#pragma unroll
        for (int ks = 0; ks < 2; ++ks) {
            const i32x8v ka = ld32(Kl + (64 * G + qi) * 144 + 64 * ks + 32 * hh), kb = ld32(Kl + (64 * G + 32 + qi) * 144 + 64 * ks + 32 * hh);
            sa = __builtin_amdgcn_mfma_scale_f32_32x32x64_f8f6f4(ka, qf[ks], sa, 0, 0, 0, 0, 0, 0);
            sb = __builtin_amdgcn_mfma_scale_f32_32x32x64_f8f6f4(kb, qf[ks], sb, 0, 0, 0, 0, 0, 0);
        }
        float tv[32];
#pragma unroll
        for (int r = 0; r < 16; ++r) { tv[r] = sa[r]; tv[16 + r] = sb[r]; }
        if (OWN && G == (w >> 1)) {
#pragma unroll
            for (int p = 0; p < 32; ++p) { const int key = 64 * G + 32 * (p >> 4) + (p & 3) + 8 * ((p >> 2) & 3) + 4 * hh; tv[p] = (key <= w * 32 + qi) ? tv[p] : -3e38f; }
        }
        float ml = tv[0];
#pragma unroll
        for (int p = 1; p < 32; ++p) ml = fmaxf(ml, tv[p]);
        ml = fmaxf(ml, __shfl_xor(ml, 32)) * c2;
        const float mnew = (ml > mrun + 6.0f) ? ml : mrun;
        const bool moved = (mnew != mrun);
        const float alpha = __builtin_amdgcn_exp2f(mrun - mnew);
        mrun = mnew;
        float ps = 0.f; i32x8v pf;
#pragma unroll
        for (int q4 = 0; q4 < 8; ++q4) { float e4[4];
#pragma unroll
            for (int j = 0; j < 4; ++j) { e4[j] = __builtin_amdgcn_exp2f(__builtin_fmaf(tv[4 * q4 + j], c2, -mnew)); ps += e4[j]; }
            int pw_ = __builtin_amdgcn_cvt_pk_fp8_f32(e4[0] * SC_P, e4[1] * SC_P, 0, false); pw_ = __builtin_amdgcn_cvt_pk_fp8_f32(e4[2] * SC_P, e4[3] * SC_P, pw_, true); pf[q4] = pw_; }
        lsum = lsum * alpha + ps;
        if (G > 0 && __any(moved)) {
#pragma unroll
            for (int dt = 0; dt < 4; ++dt)
#pragma unroll
                for (int r = 0; r < 16; ++r) oacc[dt][r] *= alpha;
        }
#pragma unroll
        for (int dt = 0; dt < 4; ++dt) {
            const i32x8v vf = ld32(Vl + (32 * dt + qi) * 272 + 64 * G + 32 * hh);
            oacc[dt] = __builtin_amdgcn_mfma_scale_f32_32x32x64_f8f6f4(vf, pf, oacc[dt], 0, 0, 0, 0, 0, 0);
        }
    }
    lsum += __shfl_xor(lsum, 32);
    if (valid) {
        unsigned char* op = F.ws + WS_OPART + ((size_t)slot * M + tok) * D + h * HD;
        const float pinv = __builtin_amdgcn_rcpf(lsum) * (SC_PART / (SC_QKV * SC_P));
        unsigned wq[4][4];
#pragma unroll
        for (int dt = 0; dt < 4; ++dt)
#pragma unroll
            for (int g4 = 0; g4 < 4; ++g4) wq[dt][g4] = pk4_fp8(oacc[dt][4 * g4 + 0] * pinv, oacc[dt][4 * g4 + 1] * pinv, oacc[dt][4 * g4 + 2] * pinv, oacc[dt][4 * g4 + 3] * pinv);
        u32x4 st[4];
#pragma unroll
        for (int d2 = 0; d2 < 2; ++d2)
#pragma unroll
            for (int g4 = 0; g4 < 4; ++g4) { const unsigned give = hh ? wq[d2][g4] : wq[2 + d2][g4], keep = hh ? wq[2 + d2][g4] : wq[d2][g4];
                const unsigned got = (unsigned)__shfl_xor((int)give, 32);
                const unsigned w_even = hh ? got : keep, w_odd = hh ? keep : got;
                st[2 * d2 + (g4 >> 1)][2 * (g4 & 1)] = w_even; st[2 * d2 + (g4 >> 1)][2 * (g4 & 1) + 1] = w_odd; }
#pragma unroll
        for (int q = 0; q < 4; ++q) *(u32x4*)(op + 64 * hh + 16 * q) = st[q];
        if (hh == 0) { f32x2 lm; lm.x = lsum; lm.y = mrun; ((f32x2*)(F.ws + WS_LPART))[((size_t)slot * M + tok) * H + h] = lm; }
    }
}
__device__ __forceinline__ void attn_group(Frame& F, int bh, int n) {
    const int b = bh >> 4, h = bh & 15;
    const gcptr Kg = opaque_s(F.ws + WS_K + ((size_t)b * T + n * MBLK) * D + h * HD);
    const gcptr Vg = opaque_s(F.ws + WS_V + ((size_t)b * T + n * MBLK) * D + h * HD);
    const int tg = make_tid(F.wave);
    __syncthreads();
#pragma unroll
    for (int i = 0; i < 4; ++i) { const int ch = tg + i * 512;
        { const int r = ch >> 3, cc = ch & 7; *(LAS u32x4*)(F.lds + AL_K + r * 144 + cc * 16) = *(const GAS u32x4*)(Kg + (unsigned)(r * D + cc * 16)); }
        { const int rl = ch & 63, cc = (ch >> 6) & 7, G = ch >> 9, r = 64 * G + rl;
          const u32x4 vv = *(const GAS u32x4*)(Vg + (unsigned)(r * D + cc * 16)); const unsigned vw[4] = {vv.x, vv.y, vv.z, vv.w};
          LAS unsigned char* vd = F.lds + AL_V + (16 * cc) * 272 + 64 * G + 32 * ((rl >> 2) & 1) + 4 * (rl >> 3) + (rl & 3);
#pragma unroll
          for (int e = 0; e < 16; ++e) vd[e * 272] = (unsigned char)(vw[e >> 2] >> (8 * (e & 3))); }
    }
    __syncthreads();
    attn_chunk<true>(F, b, h, n, 0, 0, nullptr);
    if (n < 15) {
        const int cnt = (int)__hip_atomic_load(F.ctl + CW_ACNT + bh * 16 + n, __ATOMIC_RELAXED, __HIP_MEMORY_SCOPE_AGENT);
        const int* lst = (const int*)(F.ws + WS_ALIST) + ((size_t)bh * 16 + n) * ALIST_CAP;
        for (int c = 0; c * 256 < cnt; ++c) attn_chunk<false>(F, b, h, n, c, cnt, lst);
    }
}
__device__ __forceinline__ void attn_combine_token(Frame& F, int tok) {
    const int j = (tok & (T - 1)) >> 8, nsl = j < 3 ? j : 3, hd = F.lane >> 2;
    f32x2 lm[4]; float mx = -1e30f;
#pragma unroll
    for (int s4 = 0; s4 < 4; ++s4) { const int s_ = (s4 == 0) ? 3 : s4 - 1; lm[s4] = (f32x2){0.f, -1e30f};
        if (s4 == 0 || s4 - 1 < nsl) { lm[s4] = ((const f32x2*)(F.ws + WS_LPART))[((size_t)s_ * M + tok) * H + hd]; mx = fmaxf(mx, lm[s4].y); } }
    float acc[32]; float l = 0.f;
#pragma unroll
    for (int i = 0; i < 32; ++i) acc[i] = 0.f;
#pragma unroll
    for (int s4 = 0; s4 < 4; ++s4) { const int s_ = (s4 == 0) ? 3 : s4 - 1;
        if (s4 == 0 || s4 - 1 < nsl) {
            const u32x4* p = (const u32x4*)(F.ws + WS_OPART + ((size_t)s_ * M + tok) * D + F.lane * 32);
            const float ls = lm[s4].x * __builtin_amdgcn_exp2f(lm[s4].y - mx);
            const u32x4 w0 = p[0], w1 = p[1]; const unsigned wd[8] = {w0.x, w0.y, w0.z, w0.w, w1.x, w1.y, w1.z, w1.w};
#pragma unroll
            for (int i = 0; i < 8; ++i) { const f32x2 lo = __builtin_amdgcn_cvt_pk_f32_fp8((int)wd[i], false), hi = __builtin_amdgcn_cvt_pk_f32_fp8((int)wd[i], true);
                acc[4 * i] += lo.x * ls; acc[4 * i + 1] += lo.y * ls; acc[4 * i + 2] += hi.x * ls; acc[4 * i + 3] += hi.y * ls; }
            l += ls; } }
    const float inv = __builtin_amdgcn_rcpf(l) * (1.0f / SC_PART);
    if (FP8_OUTB) { const float iv = inv * SC_OA; u32x4* o8 = (u32x4*)(F.ws + WS_OA + (size_t)tok * D + F.lane * 32);
#pragma unroll
        for (int i = 0; i < 2; ++i) { u32x4 w; w.x = pk4_fp8(acc[16 * i] * iv, acc[16 * i + 1] * iv, acc[16 * i + 2] * iv, acc[16 * i + 3] * iv); w.y = pk4_fp8(acc[16 * i + 4] * iv, acc[16 * i + 5] * iv, acc[16 * i + 6] * iv, acc[16 * i + 7] * iv);
            w.z = pk4_fp8(acc[16 * i + 8] * iv, acc[16 * i + 9] * iv, acc[16 * i + 10] * iv, acc[16 * i + 11] * iv); w.w = pk4_fp8(acc[16 * i + 12] * iv, acc[16 * i + 13] * iv, acc[16 * i + 14] * iv, acc[16 * i + 15] * iv); o8[i] = w; }
        return; }
    u32x4* o = (u32x4*)((bf16*)(F.ws + WS_OA) + (size_t)tok * D + F.lane * 32);
#pragma unroll
    for (int i = 0; i < 4; ++i) { u32x4 w; w.x = pk2(acc[8 * i] * inv, acc[8 * i + 1] * inv); w.y = pk2(acc[8 * i + 2] * inv, acc[8 * i + 3] * inv); w.z = pk2(acc[8 * i + 4] * inv, acc[8 * i + 5] * inv); w.w = pk2(acc[8 * i + 6] * inv, acc[8 * i + 7] * inv); o[i] = w; }
}
constexpr size_t WS_SLOC = WS_ORAW;
constexpr size_t WS_DLOG = WS_ORAW + 16 * MiB;
constexpr int HL_A = 0, HL_BM = 17408, HL_BMT = 34816, HL_VT = 53248, HL_SPT = 71680, HL_P = 106496, HL_EGR = 115712, HL_EEND = 116224, HL_QSUM = 116736, HL_SSQ = 118784,
              HL_STQ = HL_SPT, HL_STK = HL_SPT + 17408, HL_STG = 119808, HL_STV = 119808 + 17408;
#define HG_BAR() do { asm volatile("s_waitcnt lgkmcnt(0)" ::: "memory"); __builtin_amdgcn_s_barrier(); asm volatile("" ::: "memory"); } while (0)
template <bool FULL> __device__ __forceinline__ void hgrn_item(Frame& F, CArgs& a, int item) {
    const int bh = item >> 2, seg = item & 3, b = bh >> 4, h = bh & 15;
    if (!FULL && seg == 3) return;
    const int lane = F.lane, qi = lane & 31, hh = lane >> 5, w = F.wave;
    const int kk = F.tid & 127, tq = F.tid >> 7;
    const int vt = w & 3, ktb = 2 * (w >> 2);
    const bf16* Zq = (const bf16*)(F.ws + WS_ZQ); const bf16* Zk = (const bf16*)(F.ws + WS_ZK); const _Float16* Zg = (const _Float16*)(F.ws + WS_ZG); const bf16* Zv = (const bf16*)(F.ws + WS_ZV);
    LAS unsigned char* L = F.lds;
    LAS float* eGr = (LAS float*)(L + HL_EGR); LAS float* eEnd = (LAS float*)(L + HL_EEND); LAS float* qsum = (LAS float*)(L + HL_QSUM); LAS float* ssq = (LAS float*)(L + HL_SSQ);
    f32x16 S[2];
#pragma unroll
    for (int i = 0; i < 2; ++i)
#pragma unroll
        for (int r = 0; r < 16; ++r) S[i][r] = 0.f;
    if (FULL && seg > 0) {
        const float* sl = (const float*)(F.ws + WS_SLOC) + (size_t)bh * 3 * HD * HD; const float* dl = (const float*)(F.ws + WS_DLOG) + (size_t)bh * 3 * HD;
        LAS float* tile = (LAS float*)L; LAS float* fac = (LAS float*)(L + 65536);
        float dsum = 0.f;
        for (int s_ = seg - 1; s_ >= 0; --s_) {
            __syncthreads();
            const f32x4* src = (const f32x4*)(sl + (size_t)s_ * HD * HD);
#pragma unroll
            for (int i = 0; i < 8; ++i) ((LAS f32x4*)tile)[F.tid + i * 512] = src[F.tid + i * 512];
            if (F.tid < 128) { fac[F.tid] = __expf(dsum); dsum += dl[s_ * HD + F.tid]; }
            __syncthreads();
            const LAS float* tl = tile + (4 * hh) * HD + 32 * vt + qi; const LAS float* fl = fac + 4 * hh;
#pragma unroll
            for (int i = 0; i < 2; ++i)
#pragma unroll
                for (int r = 0; r < 16; ++r) { const int dkc = 32 * (ktb + i) + (r & 3) + 8 * (r >> 2); S[i][r] += fl[dkc] * tl[dkc * HD]; }
        }
    }
    float gtot = 0.f;
    u32x4 rq[2], rk[2], rg[2], rv[2];
#define HG_PREFETCH(cc) do { const size_t tk_ = (size_t)b * T + (size_t)(seg * 16 + (cc)) * 64; _Pragma("unroll") for (int i_ = 0; i_ < 2; ++i_) { const int row_ = 16 * (w >> 1) + (lane >> 3) + 8 * i_, ch_ = 8 * (w & 1) + (lane & 7); const size_t go_ = (tk_ + row_) * D + h * HD + ch_ * 8; \
        rk[i_] = *(const u32x4*)(Zk + go_); rg[i_] = *(const u32x4*)((const bf16*)Zg + go_); rv[i_] = *(const u32x4*)(Zv + go_); if (FULL) rq[i_] = *(const u32x4*)(Zq + go_); } } while (0)
    HG_PREFETCH(0);
    __syncthreads();
    for (int c = 0; c < 16; ++c) {
        const size_t tok0 = (size_t)b * T + (size_t)(seg * 16 + c) * 64;
#pragma unroll
        for (int i = 0; i < 2; ++i) { const int so = (16 * (w >> 1) + (lane >> 3) + 8 * i) * 272 + (8 * (w & 1) + (lane & 7)) * 16;
            *(LAS u32x4*)(L + HL_STK + so) = rk[i]; *(LAS u32x4*)(L + HL_STG + so) = rg[i]; *(LAS u32x4*)(L + HL_STV + so) = rv[i]; if (FULL) *(LAS u32x4*)(L + HL_STQ + so) = rq[i]; }
        LDS_WAIT();
        float gl[16];
        { float run = 0.f;
#pragma unroll
            for (int i = 0; i < 16; ++i) { run += (float)*(const LAS _Float16*)(L + HL_STG + (16 * tq + i) * 272 + kk * 2); gl[i] = run; }
            qsum[tq * 128 + kk] = run; }
        HG_BAR();
        {
            const float q0 = qsum[kk], q1 = qsum[128 + kk], q2 = qsum[256 + kk], q3 = qsum[384 + kk];
            const float pre = (tq > 0 ? q0 : 0.f) + (tq > 1 ? q1 : 0.f) + (tq > 2 ? q2 : 0.f), Gr = q0 + q1, Gend = (q0 + q1) + (q2 + q3);
            unsigned bt[8], vtw[8];
#pragma unroll
            for (int i = 0; i < 16; i += 2) {
                const int t0 = 16 * tq + i;
                const float G0 = pre + gl[i], G1 = pre + gl[i + 1];
                const float eb0 = __expf(Gr - G0), eb1 = __expf(Gr - G1);
                const float b0 = bf2f(*(const LAS bf16*)(L + HL_STK + t0 * 272 + kk * 2)) * eb0, b1 = bf2f(*(const LAS bf16*)(L + HL_STK + (t0 + 1) * 272 + kk * 2)) * eb1;
                bt[i >> 1] = pk2(b0, b1);
                vtw[i >> 1] = (unsigned)*(const LAS bf16*)(L + HL_STV + t0 * 272 + kk * 2) | ((unsigned)*(const LAS bf16*)(L + HL_STV + (t0 + 1) * 272 + kk * 2) << 16);
                if (FULL) { const float ea0 = __expf(G0 - Gr), ea1 = __expf(G1 - Gr);
                    const float qa = bf2f(*(const LAS bf16*)(L + HL_STQ + t0 * 272 + kk * 2)), qb = bf2f(*(const LAS bf16*)(L + HL_STQ + (t0 + 1) * 272 + kk * 2));
                    *(LAS bf16*)(L + HL_A + t0 * 272 + kk * 2) = (bf16)f2bf(qa * ea0); *(LAS bf16*)(L + HL_A + (t0 + 1) * 272 + kk * 2) = (bf16)f2bf(qb * ea1);
                    *(LAS bf16*)(L + HL_BM + t0 * 272 + kk * 2) = (bf16)(bt[i >> 1] & 0xffffu); *(LAS bf16*)(L + HL_BM + (t0 + 1) * 272 + kk * 2) = (bf16)(bt[i >> 1] >> 16); }
                __builtin_amdgcn_sched_barrier(0);
            }
            *(LAS u32x4*)(L + HL_BMT + kk * 144 + tq * 32) = (u32x4){bt[0], bt[1], bt[2], bt[3]}; *(LAS u32x4*)(L + HL_BMT + kk * 144 + tq * 32 + 16) = (u32x4){bt[4], bt[5], bt[6], bt[7]};
            *(LAS u32x4*)(L + HL_VT + kk * 144 + tq * 32) = (u32x4){vtw[0], vtw[1], vtw[2], vtw[3]}; *(LAS u32x4*)(L + HL_VT + kk * 144 + tq * 32 + 16) = (u32x4){vtw[4], vtw[5], vtw[6], vtw[7]};
            if (tq == 0) { eGr[kk] = __expf(Gr); eEnd[kk] = __expf(Gend - Gr); }
            gtot += Gend;
        }
        HG_BAR();
        if (c + 1 < 16) HG_PREFETCH(c + 1);
#pragma unroll
        for (int i = 0; i < 2; ++i)
#pragma unroll
            for (int g4 = 0; g4 < 4; ++g4) { const int dk0 = 32 * (ktb + i) + 8 * g4 + 4 * hh; const f32x4 e = *(const LAS f32x4*)(eGr + dk0);
#pragma unroll
                for (int j = 0; j < 4; ++j) S[i][4 * g4 + j] *= e[j];
                if (FULL) { u32x2 wv; wv.x = pg8::cvt_pk_bf16_n(S[i][4 * g4], S[i][4 * g4 + 1]); wv.y = pg8::cvt_pk_bf16_n(S[i][4 * g4 + 2], S[i][4 * g4 + 3]);
                    *(LAS u32x2*)(L + HL_SPT + (32 * vt + qi) * 272 + dk0 * 2) = wv; } }
        if (FULL && w < 3) {
            const int st = (w == 2) ? 1 : 0, tt = (w == 0) ? 0 : 1;
            f32x16 sc;
#pragma unroll
            for (int r = 0; r < 16; ++r) sc[r] = 0.f;
#pragma unroll
            for (int ks = 0; ks < 8; ++ks) { const bf16x8 af = *(const LAS bf16x8*)(L + HL_BM + (32 * st + qi) * 272 + (16 * ks + 8 * hh) * 2); const bf16x8 bfr = *(const LAS bf16x8*)(L + HL_A + (32 * tt + qi) * 272 + (16 * ks + 8 * hh) * 2);
                sc = __builtin_amdgcn_mfma_f32_32x32x16_bf16(af, bfr, sc, 0, 0, 0); }
#pragma unroll
            for (int g4 = 0; g4 < 4; ++g4) { const int s0 = 32 * st + 8 * g4 + 4 * hh, t = 32 * tt + qi; float p[4];
#pragma unroll
                for (int j = 0; j < 4; ++j) p[j] = sc[4 * g4 + j] * __builtin_amdgcn_fmed3f((float)(t - (s0 + j) + 1), 0.f, 1.f);
                u32x2 wv; wv.x = pg8::cvt_pk_bf16_n(p[0], p[1]); wv.y = pg8::cvt_pk_bf16_n(p[2], p[3]);
                *(LAS u32x2*)(L + HL_P + t * 144 + s0 * 2) = wv; }
        }
#pragma unroll
        for (int ks2 = 0; ks2 < 4; ++ks2) { const bf16x8 vf = *(const LAS bf16x8*)(L + HL_VT + (32 * vt + qi) * 144 + (16 * ks2 + 8 * hh) * 2);
#pragma unroll
            for (int i = 0; i < 2; ++i) { const bf16x8 bf_ = *(const LAS bf16x8*)(L + HL_BMT + (32 * (ktb + i) + qi) * 144 + (16 * ks2 + 8 * hh) * 2);
                S[i] = __builtin_amdgcn_mfma_f32_32x32x16_bf16(bf_, vf, S[i], 0, 0, 0); } }
#pragma unroll
        for (int i = 0; i < 2; ++i)
#pragma unroll
            for (int g4 = 0; g4 < 4; ++g4) { const int dk0 = 32 * (ktb + i) + 8 * g4 + 4 * hh; const f32x4 e = *(const LAS f32x4*)(eEnd + dk0);
#pragma unroll
                for (int j = 0; j < 4; ++j) S[i][4 * g4 + j] *= e[j]; }
        if (FULL) {
            HG_BAR();
            const int tt = w & 1, dt = w >> 1, t = 32 * tt + qi;
            f32x16 o;
#pragma unroll
            for (int r = 0; r < 16; ++r) o[r] = 0.f;
#pragma unroll
            for (int ks = 0; ks < 8; ++ks) { const bf16x8 af = *(const LAS bf16x8*)(L + HL_SPT + (32 * dt + qi) * 272 + (16 * ks + 8 * hh) * 2); const bf16x8 bfr = *(const LAS bf16x8*)(L + HL_A + t * 272 + (16 * ks + 8 * hh) * 2);
                o = __builtin_amdgcn_mfma_f32_32x32x16_bf16(af, bfr, o, 0, 0, 0); }
#pragma unroll
            for (int ks2 = 0; ks2 < 4; ++ks2) if (ks2 < 2 * (tt + 1)) { const bf16x8 af = *(const LAS bf16x8*)(L + HL_VT + (32 * dt + qi) * 144 + (16 * ks2 + 8 * hh) * 2); const bf16x8 bfr = *(const LAS bf16x8*)(L + HL_P + t * 144 + (16 * ks2 + 8 * hh) * 2);
                o = __builtin_amdgcn_mfma_f32_32x32x16_bf16(af, bfr, o, 0, 0, 0); }
            float sq = 0.f;
#pragma unroll
            for (int r = 0; r < 16; ++r) sq += o[r] * o[r];
            sq += __shfl_xor(sq, 32);
            if (hh == 0) ssq[dt * 64 + t] = sq;
            HG_BAR();
            const float tot = (ssq[t] + ssq[64 + t]) + (ssq[128 + t] + ssq[192 + t]);
            const float rstd = __builtin_amdgcn_rsqf(tot * (1.f / HD) + RMS_EPS);
            const size_t ro = (tok0 + t) * D + h * HD;
#pragma unroll
            for (int g4 = 0; g4 < 4; ++g4) { const int dv0 = 32 * dt + 8 * g4 + 4 * hh;
                const u32x2 gt = *(const u32x2*)((const bf16*)(F.ws + WS_ZGATE) + ro + dv0); const f32x4 gn = *(const f32x4*)(a.in[I_A_OGAIN] + dv0);
                u32x2 wv; wv.x = pg8::cvt_pk_bf16_n(o[4 * g4] * rstd * gn.x * bflo(gt.x), o[4 * g4 + 1] * rstd * gn.y * bfhi(gt.x)); wv.y = pg8::cvt_pk_bf16_n(o[4 * g4 + 2] * rstd * gn.z * bflo(gt.y), o[4 * g4 + 3] * rstd * gn.w * bfhi(gt.y));
                *(u32x2*)((bf16*)(F.ws + WS_OH) + ro + dv0) = wv; }
        }
    }
#undef HG_PREFETCH
    if (!FULL) {
        float* sl = (float*)(F.ws + WS_SLOC) + ((size_t)bh * 3 + seg) * HD * HD;
#pragma unroll
        for (int i = 0; i < 2; ++i)
#pragma unroll
            for (int r = 0; r < 16; ++r) { const int dk = 32 * (ktb + i) + (r & 3) + 8 * (r >> 2) + 4 * hh; sl[(size_t)dk * HD + 32 * vt + qi] = S[i][r]; }
        if (tq == 0) ((float*)(F.ws + WS_DLOG))[((size_t)bh * 3 + seg) * HD + kk] = gtot;
    }
    __syncthreads();
}

constexpr int N_PHASES = 19;
#ifndef REP_MASK
#define REP_MASK 0
#endif
#define NREP(k) ((((REP_MASK) >> (k)) & 1) ? 2 : 1)
__global__ void __launch_bounds__(NTHR, 2) fwd(Args args_kernarg) {
    extern __shared__ __attribute__((aligned(16))) unsigned char lds_raw[];
    Frame F;
    CArgs* pa = (CArgs*)__builtin_amdgcn_kernarg_segment_ptr();
#define args (*pa)
    F.lds = (LAS unsigned char*)lds_raw; F.ws = args.ws; F.ctl = (unsigned*)(args.ws + WS_CTL);
    F.wave = __builtin_amdgcn_readfirstlane((int)threadIdx.x >> 6); F.tid = make_tid(F.wave); F.lane = F.tid & 63;
    F.G = gridDim.x; { const int bx = blockIdx.x; F.vcu = (F.G % 8 == 0) ? (bx % 8) * (F.G / 8) + bx / 8 : bx; }
    F.gw = F.vcu * NWAVES + F.wave; F.NGW = F.G * NWAVES;
    for (int u = F.tid; u < (LDS_BYTES - LDSCTL_OFF) / 4; u += NTHR) ((LAS unsigned*)(F.lds + LDSCTL_OFF))[u] = 0u;
    __syncthreads();
    const int lo = args.ph_lo, hi = args.ph_hi;
    const bool multi = (hi - lo) > 1;
    XcdBarrier bar; bar.bar = F.ctl + CW_BAR; bar.x = 0; bar.st = nullptr;
    if (multi) bar = xcd_barrier_post(F.ctl + CW_BAR, (volatile LAS unsigned*)(F.lds + LDSCTL_OFF), F.tid);
#define REFRESH() do { pa = (CArgs*)__builtin_amdgcn_kernarg_segment_ptr(); asm volatile("" : "+s"(pa)); ws = args.ws; F.ws = ws; F.ctl = (unsigned*)(ws + WS_CTL); const int t_ = make_tid(F.wave); F.tid = t_; F.lane = t_ & 63; F.gw = F.vcu * NWAVES + F.wave; } while (0)
#define IN(k) (lo <= (k) && (k) < hi)
#define SEAM(k) do { if (IN(k) && IN((k) + 1)) xcd_barrier(bar, make_tid(F.wave)); } while (0)
    unsigned char* ws = args.ws;
    (void)args_kernarg;
    const int GT = F.NGW * 64;

    if (IN(0)) _Pragma("unroll") for (int rep_ = 0; rep_ < NREP(0); ++rep_) { REFRESH();
        const int gtid = F.gw * 64 + F.lane;
        LAS float* scr = (LAS float*)(F.lds + F.wave * 16384);
        constexpr int J0 = 32 * 256;
        for (int it = F.gw; it < J0; it += F.NGW) transpose_item(args.in[I_A_W_IN], D, 4 * D, (bf16*)(ws + WS_WIN), it / 256, it % 256, (it % 256) * 32, args.in[I_NORM_MIX], scr, F.lane);
        for (int c = gtid; c < D; c += GT) { const float* L = args.in[I_A_LB]; const float l0 = L[c], l1 = L[D + c], l2 = L[2 * D + c]; const float mx = fmaxf(l0, fmaxf(l1, l2));
            const float e0 = expf(l0 - mx), e1 = expf(l1 - mx), e2 = expf(l2 - mx); ((float*)(ws + WS_LB))[c] = e0 / (e0 + e1 + e2); }
        for (int i = gtid; i < 2 * 36 * D; i += GT) { const int l = i / (36 * D), r = (i / D) % 36, k = i % D;
            ((float*)(ws + WS_RT))[i] = r < 4 ? args.in[I_W_GROUP][((size_t)l * D + k) * NG + r] : args.in[I_W_EXPERT][((size_t)l * D + k) * NE + (r - 4)]; }
        { const int fi = gtid & 63; const float inv = exp2f(-(float)fi * (13.287712379549449f / 64.0f));
          for (int i = gtid; i < T * 64; i += GT) { const float ang = (float)(i >> 6) * inv; float sn_, cs_; sincosf(ang, &sn_, &cs_); ((f32x2*)(ws + WS_ROPE))[i] = (f32x2){cs_, sn_}; } }
        for (int m = F.gw; m < M; m += F.NGW) rms_row_to_bf16(args.in[I_X] + (size_t)m * D, (bf16*)(ws + WS_XN) + (size_t)m * D, F.lane);
    }
    SEAM(0);
    if (IN(1)) _Pragma("unroll") for (int rep_ = 0; rep_ < NREP(1); ++rep_) { REFRESH();
        constexpr int NCV = 112, J1 = 32 * 64, J2 = 32 * 128, J3 = 32 * 64, J4 = 32 * 64, J5 = 32 * 1536;
        if ((int)blockIdx.x < NCV) {
            LAS float* scr = (LAS float*)(F.lds + F.wave * 16384);
            for (int it = (int)blockIdx.x * NWAVES + F.wave; it < J1 + J2 + J3 + J4 + J5; it += NCV * NWAVES) {
                int r = it;
                if (r < J1) { transpose_item(args.in[I_A_W_OUT], D, D, (bf16*)(ws + WS_WOA), r / 64, r % 64, (r % 64) * 32, nullptr, scr, F.lane); continue; } r -= J1;
                if (r < J2) { if ((r % 128) < 64) transpose_item<true, FP8_QKV>(args.in[I_KV_W], D, 2 * D, (bf16*)(ws + WS_WQKV), r / 128, r % 128, D + (r % 128) * 32, args.in[I_KV_NORM], scr, F.lane, FP8_QKV ? SC_W : 1.f);
                              else transpose_item<false, FP8_QKV>(args.in[I_KV_W], D, 2 * D, (bf16*)(ws + WS_WQKV), r / 128, r % 128, D + (r % 128) * 32, args.in[I_KV_NORM], scr, F.lane, FP8_QKV ? SC_W : 1.f); continue; } r -= J2;
                if (r < J3) { transpose_item<true, FP8_QKV>(args.in[I_B_W_Q], D, D, (bf16*)(ws + WS_WQKV), r / 64, r % 64, (r % 64) * 32, args.in[I_NORM_MIX] + D, scr, F.lane, FP8_QKV ? SC_W : 1.f); continue; } r -= J3;
                if (r < J4) { transpose_item<false, FP8_OUTB>(args.in[I_B_W_OUT], D, D, (bf16*)(ws + WS_WOB), r / 64, r % 64, (r % 64) * 32, nullptr, scr, F.lane, FP8_OUTB ? SC_W : 1.f); continue; } r -= J4;
                convert_moe_item<FP8_MOE0>(args, ws, 0, r, scr, F.lane);
            }
            __syncthreads();
        }
        pg8::DynOrder S; S.init(ws + WS_XN, ws + WS_WIN, M, 4 * D, D, F.wave, F.ctl + CW_DYN, (LAS int*)(F.lds + LDSCTL_OFF + 32));
        pg8::EpiHgrnIn E{ws + WS_R, (const float*)(ws + WS_LB)};
        pg8::gemm_phase<pg8::EpiHgrnIn, pg8::DynOrder, true>(F.lds, S, E);
    }
    SEAM(1);
    if (IN(2)) _Pragma("unroll") for (int rep_ = 0; rep_ < NREP(2); ++rep_) { REFRESH(); for (int it = F.vcu; it < 256; it += F.G) hgrn_item<false>(F, args, it); }
    SEAM(2);
    if (IN(3)) _Pragma("unroll") for (int rep_ = 0; rep_ < NREP(3); ++rep_) { REFRESH(); for (int it = F.vcu; it < 256; it += F.G) hgrn_item<true>(F, args, it); }
    SEAM(3);
    if (IN(4)) _Pragma("unroll") for (int rep_ = 0; rep_ < NREP(4); ++rep_) { REFRESH();
        pg8::DenseOrder S; S.init(ws + WS_OH, ws + WS_WOA, M, D, D, F.G, (int)blockIdx.x, F.wave);
        pg8::EpiRes16<true> E{(bf16*)(ws + WS_XR), args.in[I_X], 1.0f};
        pg8::gemm_phase<pg8::EpiRes16<true>, pg8::DenseOrder, true>(F.lds, S, E);
    }
    SEAM(4);
#define MOE_LAYER(P, layer, F8, O8) \
    if (IN(P)) { REFRESH(); REFRESH(); if (NREP(P) == 2) { for (int t = F.gw; t < M; t += F.NGW) route_token<true, F8>(F, args, layer, t); } for (int t = F.gw; t < M; t += F.NGW) route_token<false, F8>(F, args, layer, t); } \
    SEAM(P); \
    if (IN((P) + 1)) _Pragma("unroll") for (int rep_ = 0; rep_ < NREP((P) + 1); ++rep_) { REFRESH(); const int nrb = __builtin_amdgcn_readfirstlane(moe_tables(F, layer)); \
        pg8::MoeOrder<true> S; S.A = (const char*)(ws + WS_XN); S.B = (const char*)(ws + WS_WGU + (size_t)(layer) * WGU_LSTRIDE); S.estride = (size_t)1024 * D * (F8 ? 1 : 2); S.K = D; S.RB = F8 ? D : 2 * D; S.NT = 4; S.total = nrb * 4; S.G = F.G; S.c = F.vcu; S.wv = F.wave; \
        S.blk_e = (const LAS int*)(F.lds + LT_BLKE); S.blkstart = (const LAS int*)(F.lds + LT_BLKSTART); S.cnt = (const LAS int*)(F.lds + LT_CNT); S.list = (const int*)(ws + WS_LISTS); \
        pg8::EpiSwiGLU<F8> E{(bf16*)(ws + WS_ACT), F8 ? 1.0f / (SC_XN * SC_W) : 1.0f}; \
        pg8::gemm_phase<pg8::EpiSwiGLU<F8>, pg8::MoeOrder<true>, true, F8>(F.lds, S, E); } \
    SEAM((P) + 1); \
    if (IN((P) + 2)) _Pragma("unroll") for (int rep_ = 0; rep_ < NREP((P) + 2); ++rep_) { REFRESH(); const int nrb = __builtin_amdgcn_readfirstlane(moe_tables(F, layer)); \
        pg8::MoeOrder<false> S; S.A = (const char*)(ws + WS_ACT); S.B = (const char*)(ws + WS_WD + (size_t)(layer) * WD_LSTRIDE); S.estride = (size_t)D * FF * (F8 ? 1 : 2); S.K = FF; S.RB = F8 ? FF : 2 * FF; S.NT = 8; S.total = nrb * 8; S.G = F.G; S.c = F.vcu; S.wv = F.wave; \
        S.blk_e = (const LAS int*)(F.lds + LT_BLKE); S.blkstart = (const LAS int*)(F.lds + LT_BLKSTART); S.cnt = (const LAS int*)(F.lds + LT_CNT); S.list = (const int*)(ws + WS_LISTS); \
        if constexpr (O8) { pg8::EpiOut8 E{ws + WS_OUTB, D, (F8 ? 1.0f / (SC_ACT * SC_WD) : 1.0f) * SC_OUT}; pg8::gemm_phase<pg8::EpiOut8, pg8::MoeOrder<false>, true, F8>(F.lds, S, E); } \
        else { pg8::EpiBf16 E{(bf16*)(ws + WS_OUTB), D, 0, 0, F8 ? 1.0f / (SC_ACT * SC_WD) : 1.0f}; pg8::gemm_phase<pg8::EpiBf16, pg8::MoeOrder<false>, true, F8>(F.lds, S, E); } } \
    SEAM((P) + 2);
    MOE_LAYER(5, 0, FP8_MOE0, OUT8_L0)
    if (IN(8)) { REFRESH();
        (void)moe_tables(F, 0);
        if (NREP(8) == 2) { for (int t = F.gw; t < M; t += F.NGW) combine_token<true, true, OUT8_L0>(F, args, t); }
        for (int t = F.gw; t < M; t += F.NGW) combine_token<true, false, OUT8_L0>(F, args, t);
    }
    SEAM(8);
    if (IN(9)) _Pragma("unroll") for (int rep_ = 0; rep_ < NREP(9); ++rep_) { REFRESH();
        constexpr int NCV2 = 112;
        if ((int)blockIdx.x < NCV2) {
            LAS float* scr = (LAS float*)(F.lds + F.wave * 16384);
            for (int it = (int)blockIdx.x * NWAVES + F.wave; it < 32 * 1536; it += NCV2 * NWAVES) convert_moe_item<FP8_MOE1>(args, ws, 1, it, scr, F.lane);
            __syncthreads();
        }
        pg8::DynOrder S; S.init(ws + WS_XN, ws + WS_WQKV, M, 3 * D, D, F.wave, F.ctl + CW_DYN + 64, (LAS int*)(F.lds + LDSCTL_OFF + 32), FP8_QKV);
        pg8::EpiQKV E{(bf16*)(ws + WS_Q), (bf16*)(ws + WS_K), (bf16*)(ws + WS_V), args.in[I_B_Q_NORM], args.in[I_K_NORM], (const f32x2*)(ws + WS_ROPE), (float*)(ws + WS_KMEAN), F.lds + 131072, FP8_QKV ? 1.0f / (SC_XN * SC_W) : 1.0f, F.wave};
        pg8::gemm_phase<pg8::EpiQKV, pg8::DynOrder, true, FP8_QKV>(F.lds, S, E);
    }
    SEAM(9);
    if (IN(11)) { REFRESH(); if (NREP(11) == 2) { for (int it = F.vcu; it < 64 * 8; it += F.G) moba_gate_item<true>(F, it); } for (int it = F.vcu; it < 64 * 8; it += F.G) moba_gate_item<false>(F, it); }
    SEAM(11);
    if (IN(12)) _Pragma("unroll") for (int rep_ = 0; rep_ < NREP(12); ++rep_) { REFRESH();
        for (int v = F.vcu; v < 256; v += F.G) { const int bh = v >> 2, q = v & 3;
            _Pragma("unroll 1") for (int gi = 0; gi < 4; ++gi) { const int n = (gi == 0) ? q : ((gi == 1) ? 7 - q : ((gi == 2) ? 8 + q : 15 - q)); attn_group(F, bh, n); } }
    }
    SEAM(12);
    if (IN(13)) _Pragma("unroll") for (int rep_ = 0; rep_ < NREP(13); ++rep_) { REFRESH(); for (int t = F.gw; t < M; t += F.NGW) attn_combine_token(F, t); }
    SEAM(13);
    if (IN(14)) { REFRESH();
        pg8::DenseOrder S; S.init(ws + WS_OA, ws + WS_WOB, M, D, D, F.G, (int)blockIdx.x, F.wave, FP8_OUTB);
        pg8::EpiRes16<false> E{(bf16*)(ws + WS_XR), nullptr, FP8_OUTB ? 1.0f / (SC_OA * SC_W) : 1.0f};
        pg8::gemm_phase<pg8::EpiRes16<false>, pg8::DenseOrder, true, FP8_OUTB>(F.lds, S, E);
    }
    SEAM(14);
    MOE_LAYER(15, 1, FP8_MOE1, OUT8_L1)
    if (IN(18)) { REFRESH(); (void)moe_tables(F, 1); for (int t = F.gw; t < M; t += F.NGW) combine_token<false, false, OUT8_L1>(F, args, t); }
#undef IN
#undef SEAM
#undef MOE_LAYER
#undef args
}

#ifndef MK_N_LAUNCHES
#define MK_N_LAUNCHES 1
#endif
#ifndef DBG_STOP
#define DBG_STOP N_PHASES
#endif
extern "C" void kernel_launch(void* const* d_in, const int* in_sizes, int n_in, void* d_out, int out_size, void* d_ws, size_t ws_size, hipStream_t stream) {
    static int grid = 0;
    if (grid == 0) {
        if (n_in != 20 || in_sizes[0] != M * D || out_size != M * D || ws_size < WS_END) { fprintf(stderr, "kernel_launch: unexpected shapes (n_in %d, in0 %d, out %d, ws %zu < %zu); nothing launched\n", n_in, n_in > 0 ? in_sizes[0] : -1, out_size, ws_size, (size_t)WS_END); grid = -1; return; }
        int dev = 0, cus = 0, per_cu = 0;
        if (hipGetDevice(&dev) != hipSuccess || hipDeviceGetAttribute(&cus, hipDeviceAttributeMultiprocessorCount, dev) != hipSuccess) { grid = -1; return; }
        if (hipFuncSetAttribute((const void*)fwd, hipFuncAttributeMaxDynamicSharedMemorySize, LDS_BYTES) != hipSuccess) { fprintf(stderr, "kernel_launch: hipFuncSetAttribute failed\n"); grid = -1; return; }
        if (hipOccupancyMaxActiveBlocksPerMultiprocessor(&per_cu, (const void*)fwd, NTHR, LDS_BYTES) != hipSuccess || per_cu < 1) { fprintf(stderr, "kernel_launch: occupancy query says %d blocks per CU\n", per_cu); }
        (void)hipGetLastError();
        grid = cus;
    }
    if (grid < 0) return;
    (void)hipMemsetAsync((char*)d_ws + WS_CTL, 0, CTL_ZERO_BYTES, stream);
    Args a{};
    for (int i = 0; i < 20; ++i) a.in[i] = (const float*)d_in[i];
    a.out = (float*)d_out; a.ws = (unsigned char*)d_ws;
    if (MK_N_LAUNCHES == 1) { a.ph_lo = 0; a.ph_hi = N_PHASES; hipLaunchKernelGGL(fwd, dim3(grid), dim3(NTHR), LDS_BYTES, stream, a); }
    else for (int p = 0; p < DBG_STOP; ++p) { a.ph_lo = p; a.ph_hi = p + 1; hipLaunchKernelGGL(fwd, dim3(grid), dim3(NTHR), LDS_BYTES, stream, a); }
}
```

```cpp
#include <hip/hip_runtime.h>
#include <cstdio>
#include <cstdint>

#define GAS __attribute__((address_space(1)))
#define LAS __attribute__((address_space(3)))
typedef unsigned short bf16;
typedef short bf16x8 __attribute__((ext_vector_type(8)));
typedef float f32x4 __attribute__((ext_vector_type(4)));
typedef float f32x2 __attribute__((ext_vector_type(2)));
typedef unsigned u32x4 __attribute__((ext_vector_type(4)));
typedef unsigned u32x2 __attribute__((ext_vector_type(2)));

constexpr int BATCH = 4, T = 4096, D = 2048, M = BATCH * T, H = 16, HD = 128;
constexpr int NBLK = 16, MBLK = 256;
constexpr int NG = 4, EPG = 8, NE = 32, FF = 512;
constexpr float RMS_EPS = 1e-6f;
constexpr int NWAVES = 8, NTHR = 512;
constexpr int LIST_CAP = 16384;
constexpr int MAXRB = 160;

constexpr size_t MiB = 1u << 20;
constexpr size_t WS_CTL = 0, CTL_ZERO_BYTES = 1 * MiB;
constexpr size_t WS_LISTS = 1 * MiB;
constexpr size_t WS_TOKREC = 3 * MiB;
constexpr size_t WS_LB = 4 * MiB;
constexpr size_t WS_RT = 4 * MiB + 65536;
constexpr size_t WS_ROPE = 5 * MiB;
constexpr size_t WS_KMEAN = 7 * MiB;
constexpr size_t WS_WIN = 8 * MiB, WS_WOA = 40 * MiB, WS_WQKV = 48 * MiB, WS_WOB = 72 * MiB;
constexpr size_t WS_WGU = 80 * MiB, WS_WD = 208 * MiB;
constexpr size_t WS_XN = 272 * MiB;
constexpr size_t WS_ACT = 336 * MiB;
constexpr size_t WS_R = 376 * MiB;
constexpr size_t WS_ZQ = WS_R, WS_ZK = WS_R + 64 * MiB, WS_ZG = WS_R + 128 * MiB, WS_ZV = WS_R + 192 * MiB, WS_ZGATE = WS_R + 256 * MiB;
constexpr size_t WS_ORAW = WS_R + 320 * MiB;
constexpr size_t WS_OH = WS_R + 448 * MiB;
constexpr size_t WS_OUTB = WS_R;
constexpr size_t WS_Q = WS_R, WS_K = WS_R + 64 * MiB, WS_V = WS_R + 128 * MiB, WS_VT = WS_R + 192 * MiB, WS_OA = WS_R + 256 * MiB;
constexpr size_t WS_XR = WS_R + 192 * MiB;
constexpr size_t WS_OPART = WS_R + 320 * MiB;
constexpr size_t WS_LPART = WS_R + 576 * MiB;
constexpr size_t WS_ALIST = WS_R + 584 * MiB;
constexpr int ALIST_CAP = 3840;
constexpr size_t WS_END = WS_R + 604 * MiB;
constexpr int CW_TMO = 0;
constexpr int CW_BAR = 4096;
constexpr int CW_CNT = 8192;
constexpr int CW_ACNT = 16384;
constexpr int CW_DYN = 20480;

constexpr int RING_BYTES = 159744;
constexpr int LDSCTL_OFF = RING_BYTES;
constexpr int LT_BLKE = LDSCTL_OFF + 64;
constexpr int LT_BLKSTART = LT_BLKE + MAXRB * 4;
constexpr int LT_CNT = LT_BLKSTART + 36 * 4;
constexpr int LT_END = LT_CNT + 32 * 4;
constexpr int LDS_BYTES = 163840;
static_assert(LT_END <= LDS_BYTES, "LDS map");

__device__ __forceinline__ unsigned f2bf(float f) { unsigned u = __builtin_bit_cast(unsigned, f); return (u + 0x7fffu + ((u >> 16) & 1u)) >> 16; }
__device__ __forceinline__ unsigned pk2(float lo, float hi) { return f2bf(lo) | (f2bf(hi) << 16); }
__device__ __forceinline__ float bf2f(unsigned b) { return __builtin_bit_cast(float, b << 16); }
__device__ __forceinline__ float bflo(unsigned w) { return __builtin_bit_cast(float, w << 16); }
__device__ __forceinline__ float bfhi(unsigned w) { return __builtin_bit_cast(float, w & 0xffff0000u); }
__device__ __forceinline__ float wave_sum(float v) {
#pragma unroll
    for (int o = 1; o < 64; o <<= 1) v += __shfl_xor(v, o);
    return v;
}
#ifndef FP8_QKV
#define FP8_QKV 1
#endif
#ifndef FP8_OUTB
#define FP8_OUTB 1
#endif
#ifndef FP8_MOE1
#define FP8_MOE1 1
#endif
#ifndef FP8_MOE0
#define FP8_MOE0 1
#endif
#ifndef OUT8_L0
#define OUT8_L0 1
#endif
#ifndef OUT8_L1
#define OUT8_L1 1
#endif
constexpr float SC_XN = 16.f, SC_W = 1024.f, SC_ACT = 8.f, SC_WD = 512.f, SC_OA = 64.f, SC_PART = 64.f, SC_OUT = 32.f, SC_QKV = 32.f;
__device__ __forceinline__ unsigned pk4_fp8(float a, float b, float c, float d) {
    a = __builtin_amdgcn_fmed3f(a, -448.f, 448.f); b = __builtin_amdgcn_fmed3f(b, -448.f, 448.f); c = __builtin_amdgcn_fmed3f(c, -448.f, 448.f); d = __builtin_amdgcn_fmed3f(d, -448.f, 448.f);
    int p = __builtin_amdgcn_cvt_pk_fp8_f32(a, b, 0, false); p = __builtin_amdgcn_cvt_pk_fp8_f32(c, d, p, true); return (unsigned)p; }
__device__ __forceinline__ int lane_id() { int l; asm volatile("v_mbcnt_lo_u32_b32 %0, -1, 0\n\tv_mbcnt_hi_u32_b32 %0, -1, %0" : "=v"(l)); return l; }
__device__ __forceinline__ int make_tid(int wv) { return wv * 64 + lane_id(); }
__device__ __forceinline__ void fp8x4_to_f32(unsigned w, float (&o)[4]) { const f32x2 lo = __builtin_amdgcn_cvt_pk_f32_fp8((int)w, false), hi = __builtin_amdgcn_cvt_pk_f32_fp8((int)w, true); o[0] = lo.x; o[1] = lo.y; o[2] = hi.x; o[3] = hi.y; }
#define LDS_WAIT() asm volatile("s_waitcnt lgkmcnt(0)" ::: "memory")
#define VM_WAIT() asm volatile("s_waitcnt vmcnt(0)" ::: "memory")

namespace pg8 {
constexpr int BM = 256, BK = 64, HALF = 128, HTB = HALF * BK * 2, STAGE_BYTES = 8 * HTB, NXCD = 8, WGM = 8;
__host__ __device__ __forceinline__ int lds_byte(int r, int c) { const int st = (r >> 4) * 2 + (c >> 5), rr = r & 15, cc = c & 31, ob = rr * 64 + cc * 2; return st * 1024 + (ob ^ (((ob >> 9) & 1) << 5)); }
__host__ __device__ __forceinline__ void stage_rc(int b, int& R, int& C) { const int st = b / 1024, sb = b % 1024, swz = sb ^ (((sb >> 9) & 1) << 5); R = (st >> 1) * 16 + swz / 64; C = (st & 1) * 32 + (swz % 64) / 2; }
__host__ __device__ __forceinline__ int perm32(int rho) { const int n = rho >> 4, i = rho & 15; return 8 * (i >> 2) + 4 * n + (i & 3); }

struct Unit { int pm, pn; const char* a; const char* b; int e0, lbase, cnt; };

struct DenseOrder {
    static constexpr bool GATHER = false, DYNAMIC = false;
    const char* A; const char* B; int K, RB; int nM, nN, nwg, G, c, wv;
    __device__ void init(const void* A_, const void* B_, int M_, int N_, int K_, int G_, int c_, int wv_, bool fp8 = false) { wv = wv_; A = (const char*)A_; B = (const char*)B_; K = K_; RB = fp8 ? K_ : 2 * K_; nM = M_ / BM; nN = N_ / BM; nwg = nM * nN; G = G_; c = c_; }
    __device__ __forceinline__ bool next(int i, Unit& u) const {
        const int L = i * G + c; if (L >= nwg) return false;
        int wgid = (int)L; { const int q = nwg / NXCD, r = nwg % NXCD, xcd = wgid % NXCD, off = wgid / NXCD; wgid = (xcd < r ? xcd * (q + 1) : r * (q + 1) + (xcd - r) * q) + off; }
        const int nig = WGM * nN, gid = wgid / nig, fm = gid * WGM, gsz = (nM - fm) < WGM ? (nM - fm) : WGM;
        u.pm = fm + ((wgid % nig) % gsz); u.pn = (wgid % nig) / gsz;
        u.a = A + (size_t)u.pm * BM * RB; u.b = B + (size_t)u.pn * BM * RB; u.e0 = 0; u.lbase = 0; u.cnt = 0; return true;
    }
    __device__ __forceinline__ unsigned row_off(const Unit&, int) const { return 0u; }
};
struct DynOrder {
    static constexpr bool GATHER = false, DYNAMIC = true;
    const char* A; const char* B; int K, RB; int nM, nN, nwg, wv; unsigned* counter; LAS int* slot;
    __device__ void init(const void* A_, const void* B_, int M_, int N_, int K_, int wv_, unsigned* counter_, LAS int* slot_, bool fp8 = false) { wv = wv_; A = (const char*)A_; B = (const char*)B_; K = K_; RB = fp8 ? K_ : 2 * K_; nM = M_ / BM; nN = N_ / BM; nwg = nM * nN; counter = counter_; slot = slot_; }
    __device__ __forceinline__ void map(int L, Unit& u) const {
        int wgid = L; { const int q = nwg / NXCD, r = nwg % NXCD, xcd = wgid % NXCD, off = wgid / NXCD; wgid = (xcd < r ? xcd * (q + 1) : r * (q + 1) + (xcd - r) * q) + off; }
        const int nig = WGM * nN, gid = wgid / nig, fm = gid * WGM, gsz = (nM - fm) < WGM ? (nM - fm) : WGM;
        u.pm = fm + ((wgid % nig) % gsz); u.pn = (wgid % nig) / gsz;
        u.a = A + (size_t)u.pm * BM * RB; u.b = B + (size_t)u.pn * BM * RB; u.e0 = 0; u.lbase = 0; u.cnt = 0;
    }
    __device__ __forceinline__ int fetch() const { return (int)__hip_atomic_fetch_add(counter, 1u, __ATOMIC_RELAXED, __HIP_MEMORY_SCOPE_AGENT); }
    __device__ __forceinline__ bool next(int, Unit&) const { return false; }
    __device__ __forceinline__ unsigned row_off(const Unit&, int) const { return 0u; }
};
template <bool GATHER_> struct MoeOrder {
    static constexpr bool GATHER = GATHER_, DYNAMIC = false;
    const char* A; const char* B; size_t estride; int K, RB, NT, total, G, c, wv;
    const LAS int* blk_e; const LAS int* blkstart; const LAS int* cnt; const int* list;
    __device__ __forceinline__ bool next(int i, Unit& u) const {
        const int L = i * G + c; if (L >= total) return false;
        const int rb = (int)L / NT, pn = (int)L % NT, e = blk_e[rb];
        u.pm = rb; u.pn = pn; u.e0 = e; u.lbase = (rb - blkstart[e]) * BM; u.cnt = cnt[e];
        u.a = GATHER ? A : A + (size_t)rb * BM * RB; u.b = B + (size_t)e * estride + (size_t)pn * BM * RB; return true;
    }
    __device__ __forceinline__ unsigned row_off(const Unit& u, int r) const { const int loc = u.lbase + r; const int t = list[u.e0 * LIST_CAP + (loc < u.cnt ? loc : 0)]; return (unsigned)t * (unsigned)RB; }
};

typedef __bf16 bf16n2 __attribute__((ext_vector_type(2)));
__device__ __forceinline__ unsigned cvt_pk_bf16_n(float lo, float hi) { const f32x2 v = {lo, hi}; return __builtin_bit_cast(unsigned, __builtin_convertvector(v, bf16n2)); }
__device__ __forceinline__ unsigned cvt_pk_bf16(float lo, float hi) { unsigned r; asm volatile("v_cvt_pk_bf16_f32 %0, %1, %2" : "=v"(r) : "v"(lo), "v"(hi)); return r; }

struct EpiBf16 {
    static constexpr bool PERM = true;
    bf16* O; int ldc; int split_cols; size_t split_stride; float osc;
    __device__ __forceinline__ void operator()(const f32x4 (&acc)[2][2][4][2], const Unit& u, int wr, int wc, int fr, int fq) const {
        const int row0 = u.pm * BM + wr * 64 + fr; int colt = u.pn * BM; bf16* base = O;
        if (split_cols) { const int t = colt / split_cols; base += (size_t)t * split_stride; colt -= t * split_cols; }
        const int col0 = colt + wc * 32 + 8 * fq;
#pragma unroll
        for (int ai = 0; ai < 2; ++ai)
#pragma unroll
            for (int m = 0; m < 4; ++m) { bf16* rowp = base + (size_t)(row0 + ai * HALF + m * 16) * ldc + col0;
#pragma unroll
                for (int bj = 0; bj < 2; ++bj) { const f32x4 v0 = acc[ai][bj][m][0] * osc, v1 = acc[ai][bj][m][1] * osc;
                    u32x4 w; w.x = cvt_pk_bf16(v0[0], v0[1]); w.y = cvt_pk_bf16(v0[2], v0[3]); w.z = cvt_pk_bf16(v1[0], v1[1]); w.w = cvt_pk_bf16(v1[2], v1[3]);
                    *(u32x4*)(rowp + bj * HALF) = w; } }
    }
};
struct EpiResF32 {
    static constexpr bool PERM = false;
    float* C; const float* R; int ldc; float osc;
    __device__ __forceinline__ void operator()(const f32x4 (&acc)[2][2][4][2], const Unit& u, int wr, int wc, int fr, int fq) const {
        const int row0 = u.pm * BM + wr * 64 + fr, col0 = u.pn * BM + wc * 32 + 4 * fq;
#pragma unroll
        for (int ai = 0; ai < 2; ++ai)
#pragma unroll
            for (int m = 0; m < 4; ++m) { const size_t ro = (size_t)(row0 + ai * HALF + m * 16) * ldc + col0;
#pragma unroll
                for (int bj = 0; bj < 2; ++bj)
#pragma unroll
                    for (int n = 0; n < 2; ++n) { const f32x4 r = *(const f32x4*)(R + ro + bj * HALF + n * 16); *(f32x4*)(C + ro + bj * HALF + n * 16) = acc[ai][bj][m][n] * osc + r; } }
    }
};
struct EpiOut8 {
    static constexpr bool PERM = true;
    unsigned char* O; int ldc; float osc;
    __device__ __forceinline__ void operator()(const f32x4 (&acc)[2][2][4][2], const Unit& u, int wr, int wc, int fr, int fq) const {
        const int row0 = u.pm * BM + wr * 64 + fr, col0 = u.pn * BM + wc * 32 + 8 * fq;
#pragma unroll
        for (int ai = 0; ai < 2; ++ai)
#pragma unroll
            for (int m = 0; m < 4; ++m) { unsigned char* rowp = O + (size_t)(row0 + ai * HALF + m * 16) * ldc + col0;
#pragma unroll
                for (int bj = 0; bj < 2; ++bj) { const f32x4 v0 = acc[ai][bj][m][0] * osc, v1 = acc[ai][bj][m][1] * osc;
                    u32x2 w; w.x = pk4_fp8(v0[0], v0[1], v0[2], v0[3]); w.y = pk4_fp8(v1[0], v1[1], v1[2], v1[3]);
                    *(u32x2*)(rowp + bj * HALF) = w; } }
    }
};
template <bool SRC32> struct EpiRes16 {
    static constexpr bool PERM = true;
    bf16* XR; const float* R32; float osc;
    __device__ __forceinline__ void operator()(const f32x4 (&acc)[2][2][4][2], const Unit& u, int wr, int wc, int fr, int fq) const {
        const int row0 = u.pm * BM + wr * 64 + fr, col0 = u.pn * BM + wc * 32 + 8 * fq;
#pragma unroll
        for (int ai = 0; ai < 2; ++ai)
#pragma unroll
            for (int m = 0; m < 4; ++m) { const size_t ro = (size_t)(row0 + ai * HALF + m * 16) * D + col0;
#pragma unroll
                for (int bj = 0; bj < 2; ++bj) { float r[8];
                    if (SRC32) { const f32x4 a = *(const f32x4*)(R32 + ro + bj * HALF), b = *(const f32x4*)(R32 + ro + bj * HALF + 4);
#pragma unroll
                        for (int j = 0; j < 4; ++j) { r[j] = a[j]; r[4 + j] = b[j]; } }
                    else { const u32x4 w = *(const u32x4*)(XR + ro + bj * HALF); r[0] = bflo(w.x); r[1] = bfhi(w.x); r[2] = bflo(w.y); r[3] = bfhi(w.y); r[4] = bflo(w.z); r[5] = bfhi(w.z); r[6] = bflo(w.w); r[7] = bfhi(w.w); }
                    const f32x4 v0 = acc[ai][bj][m][0] * osc, v1 = acc[ai][bj][m][1] * osc;
                    u32x4 o; o.x = cvt_pk_bf16(v0[0] + r[0], v0[1] + r[1]); o.y = cvt_pk_bf16(v0[2] + r[2], v0[3] + r[3]); o.z = cvt_pk_bf16(v1[0] + r[4], v1[1] + r[5]); o.w = cvt_pk_bf16(v1[2] + r[6], v1[3] + r[7]);
                    *(u32x4*)(XR + ro + bj * HALF) = o; } }
    }
};
__device__ __forceinline__ float sigmoidf_(float z) { return __builtin_amdgcn_rcpf(1.0f + __expf(-z)); }
template <bool OUT8> struct EpiSwiGLU {
    static constexpr bool PERM = true;
    bf16* O; float osc;
    __device__ __forceinline__ void operator()(const f32x4 (&acc)[2][2][4][2], const Unit& u, int wr, int wc, int fr, int fq) const {
        const int row0 = u.pm * BM + wr * 64 + fr, col0 = u.pn * HALF + wc * 32 + 8 * fq;
#pragma unroll
        for (int ai = 0; ai < 2; ++ai)
#pragma unroll
            for (int m = 0; m < 4; ++m) { const size_t eo = (size_t)(row0 + ai * HALF + m * 16) * FF + col0;
                float o[8];
#pragma unroll
                for (int n = 0; n < 2; ++n)
#pragma unroll
                    for (int j = 0; j < 4; ++j) { const float g = acc[ai][0][m][n][j] * osc, up = acc[ai][1][m][n][j] * osc; o[4 * n + j] = g * sigmoidf_(g) * up; }
                if (OUT8) { u32x2 w; w.x = pk4_fp8(o[0] * SC_ACT, o[1] * SC_ACT, o[2] * SC_ACT, o[3] * SC_ACT); w.y = pk4_fp8(o[4] * SC_ACT, o[5] * SC_ACT, o[6] * SC_ACT, o[7] * SC_ACT); *(u32x2*)((unsigned char*)O + eo) = w; }
                else { u32x4 w; w.x = cvt_pk_bf16(o[0], o[1]); w.y = cvt_pk_bf16(o[2], o[3]); w.z = cvt_pk_bf16(o[4], o[5]); w.w = cvt_pk_bf16(o[6], o[7]); *(u32x4*)(O + eo) = w; } }
    }
};
typedef _Float16 h8 __attribute__((ext_vector_type(8)));
struct EpiHgrnIn {
    static constexpr bool PERM = true;
    unsigned char* zb; const float* lb;
    __device__ __forceinline__ void operator()(const f32x4 (&acc)[2][2][4][2], const Unit& u, int wr, int wc, int fr, int fq) const {
        const int quarter = u.pn >> 3, row0 = u.pm * BM + wr * 64 + fr, col0 = (u.pn & 7) * BM + wc * 32 + 8 * fq;
        if (quarter == 1) {
            float lbv[2][8];
#pragma unroll
            for (int bj = 0; bj < 2; ++bj) { const f32x4 a = *(const f32x4*)(lb + col0 + bj * HALF), b = *(const f32x4*)(lb + col0 + bj * HALF + 4);
#pragma unroll
                for (int j = 0; j < 4; ++j) { lbv[bj][j] = a[j]; lbv[bj][4 + j] = b[j]; } }
#pragma unroll
            for (int ai = 0; ai < 2; ++ai)
#pragma unroll
                for (int m = 0; m < 4; ++m) { const size_t ro = (size_t)(row0 + ai * HALF + m * 16) * D + col0;
#pragma unroll
                    for (int bj = 0; bj < 2; ++bj) { float kk[8]; h8 hv;
#pragma unroll
                        for (int n = 0; n < 2; ++n)
#pragma unroll
                            for (int j = 0; j < 4; ++j) { const float z = acc[ai][bj][m][n][j], l = lbv[bj][4 * n + j];
                                const float k1 = (1.0f - l) * __builtin_amdgcn_rcpf(1.0f + __expf(z));
                                kk[4 * n + j] = k1; hv[4 * n + j] = (_Float16)__logf(1.0f - k1); }
                        u32x4 w; w.x = cvt_pk_bf16(kk[0], kk[1]); w.y = cvt_pk_bf16(kk[2], kk[3]); w.z = cvt_pk_bf16(kk[4], kk[5]); w.w = cvt_pk_bf16(kk[6], kk[7]);
                        *(u32x4*)((bf16*)(zb + (64u << 20)) + ro + bj * HALF) = w;
                        *(h8*)((_Float16*)(zb + (128u << 20)) + ro + bj * HALF) = hv; } }
        } else {
            const size_t zo = quarter == 0 ? 0u : (quarter == 2 ? (size_t)(192u << 20) : (size_t)(256u << 20)); bf16* dst = (bf16*)(zb + zo);
#pragma unroll
            for (int ai = 0; ai < 2; ++ai)
#pragma unroll
                for (int m = 0; m < 4; ++m) { const size_t ro = (size_t)(row0 + ai * HALF + m * 16) * D + col0;
#pragma unroll
                    for (int bj = 0; bj < 2; ++bj) { float o[8];
#pragma unroll
                        for (int n = 0; n < 2; ++n)
#pragma unroll
                            for (int j = 0; j < 4; ++j) { const float z = acc[ai][bj][m][n][j]; o[4 * n + j] = (quarter == 3) ? z * sigmoidf_(z) : z; }
                        u32x4 w; w.x = cvt_pk_bf16(o[0], o[1]); w.y = cvt_pk_bf16(o[2], o[3]); w.z = cvt_pk_bf16(o[4], o[5]); w.w = cvt_pk_bf16(o[6], o[7]);
                        *(u32x4*)(dst + ro + bj * HALF) = w; } }
        }
    }
};

struct EpiQKV {
    static constexpr bool PERM = true;
    bf16* Q; bf16* Kd; bf16* V; const float* qg; const float* kg; const f32x2* rope; float* kmean; LAS unsigned char* xl; float osc; int wv;
    __device__ __forceinline__ void operator()(const f32x4 (&acc)[2][2][4][2], const Unit& u, int wr, int wc, int fr, int fq) const {
        const int sec = u.pn >> 3, row0 = u.pm * BM + wr * 64 + fr;
        if (sec == 2) {
            const int col0 = (u.pn & 7) * BM + wc * 32 + 8 * fq; const float vs = osc * SC_QKV;
#pragma unroll
            for (int ai = 0; ai < 2; ++ai)
#pragma unroll
                for (int m = 0; m < 4; ++m) { unsigned char* rowp = (unsigned char*)V + (size_t)(row0 + ai * HALF + m * 16) * D + col0;
#pragma unroll
                    for (int bj = 0; bj < 2; ++bj) { const f32x4 v0 = acc[ai][bj][m][0] * vs, v1 = acc[ai][bj][m][1] * vs;
                        u32x2 w; w.x = pk4_fp8(v0[0], v0[1], v0[2], v0[3]); w.y = pk4_fp8(v1[0], v1[1], v1[2], v1[3]);
                        *(u32x2*)(rowp + bj * HALF) = w; } }
            return;
        }
        LAS float* X = (LAS float*)xl;
        LAS float* Y = (LAS float*)(xl + 8192);
#pragma unroll
        for (int ai = 0; ai < 2; ++ai)
#pragma unroll
            for (int m = 0; m < 4; ++m)
#pragma unroll
                for (int bj = 0; bj < 2; ++bj) { const f32x4 a = acc[ai][bj][m][0], b = acc[ai][bj][m][1];
                    float s = ((a[0] * a[0] + a[1] * a[1]) + (a[2] * a[2] + a[3] * a[3]) + (b[0] * b[0] + b[1] * b[1]) + (b[2] * b[2] + b[3] * b[3])) * (osc * osc);
                    s += __shfl_xor(s, 16); s += __shfl_xor(s, 32);
                    if (fq == 0) X[((ai * HALF + wr * 64 + m * 16 + fr) * 2 + bj) * 4 + wc] = s; }
        asm volatile("s_waitcnt lgkmcnt(0)" ::: "memory"); __builtin_amdgcn_s_barrier(); asm volatile("" ::: "memory");
        const float* gain = sec ? kg : qg; bf16* dst = sec ? Kd : Q;
#pragma unroll
        for (int ai = 0; ai < 2; ++ai)
#pragma unroll
            for (int m = 0; m < 4; ++m) { const int rl = ai * HALF + wr * 64 + m * 16 + fr, pos = (u.pm & 15) * BM + rl;
                const f32x4 g0 = *(const f32x4*)(gain + 16 * wc + 4 * fq), g1 = *(const f32x4*)(gain + 64 + 16 * wc + 4 * fq);
                const f32x4 r0 = *(const f32x4*)(rope + pos * 64 + 16 * wc + 4 * fq), r1 = *(const f32x4*)(rope + pos * 64 + 16 * wc + 4 * fq + 2);
                const float cc[4] = {r0[0], r0[2], r1[0], r1[2]}, sn[4] = {r0[1], r0[3], r1[1], r1[3]};
#pragma unroll
                for (int bj = 0; bj < 2; ++bj) { const f32x4 p = *(const LAS f32x4*)(X + (rl * 2 + bj) * 4);
                    const float rstd = __builtin_amdgcn_rsqf(((p[0] + p[1]) + (p[2] + p[3])) * (1.f / 128) + RMS_EPS);
                    float o[8];
#pragma unroll
                    for (int j = 0; j < 4; ++j) { const float y1 = acc[ai][bj][m][0][j] * (rstd * osc) * g0[j], y2 = acc[ai][bj][m][1][j] * (rstd * osc) * g1[j]; o[j] = y1 * cc[j] - y2 * sn[j]; o[4 + j] = y2 * cc[j] + y1 * sn[j]; }
                    unsigned char* p0 = (unsigned char*)dst + (size_t)(u.pm * BM + rl) * D + ((u.pn & 7) * 2 + bj) * 128 + 16 * wc + 4 * fq;
                    *(unsigned*)p0 = pk4_fp8(o[0] * SC_QKV, o[1] * SC_QKV, o[2] * SC_QKV, o[3] * SC_QKV); *(unsigned*)(p0 + 64) = pk4_fp8(o[4] * SC_QKV, o[5] * SC_QKV, o[6] * SC_QKV, o[7] * SC_QKV);
                    if (sec == 1) {
#pragma unroll
                        for (int j = 0; j < 8; ++j) { float sv = o[j]; sv += __shfl_xor(sv, 1); sv += __shfl_xor(sv, 2); sv += __shfl_xor(sv, 4); sv += __shfl_xor(sv, 8); o[j] = sv; }
                        if (fr == 0) { LAS float* yp = Y + ((((wr * 2 + ai) * 4 + m) * 2 + bj) * 128) + 16 * wc + 4 * fq; *(LAS f32x4*)yp = (f32x4){o[0], o[1], o[2], o[3]}; *(LAS f32x4*)(yp + 64) = (f32x4){o[4], o[5], o[6], o[7]}; }
                    } }
                asm volatile("" ::: "memory"); }
        if (sec == 1) {
            asm volatile("s_waitcnt lgkmcnt(0)" ::: "memory"); __builtin_amdgcn_s_barrier(); asm volatile("" ::: "memory");
            const int tid = make_tid(wv);
            if (tid < 256) { const int bj = tid >> 7, d = tid & 127; const int b = u.pm >> 4, nb = u.pm & 15, head = (u.pn & 7) * 2 + bj;
                float sm = 0.f;
#pragma unroll
                for (int q = 0; q < 16; ++q) sm += Y[(q * 2 + bj) * 128 + d];
                float* kmb = kmean; asm volatile("" : "+s"(kmb));
                ((GAS float*)kmb)[((b * H + head) * NBLK + nb) * HD + d] = sm * (1.0f / 256); }
        }
    }
};

__device__ __forceinline__ void glds_saddr(const char* sbase, unsigned voff, unsigned lds_dst) {
    unsigned keep;
    asm volatile("s_mov_b32 %0, m0\n\ts_mov_b32 m0, %3\n\ts_nop 4\n\tglobal_load_lds_dwordx4 %1, %2\n\ts_mov_b32 m0, %0" : "=&s"(keep) : "v"(voff), "s"(sbase), "s"(lds_dst) : "memory");
}
typedef int i32x4 __attribute__((ext_vector_type(4)));
typedef int i32x8 __attribute__((ext_vector_type(8)));
__device__ __forceinline__ i32x8 cat8(bf16x8 lo, bf16x8 hi) { const i32x4 a = __builtin_bit_cast(i32x4, lo), b = __builtin_bit_cast(i32x4, hi); return __builtin_shufflevector(a, b, 0, 1, 2, 3, 4, 5, 6, 7); }
template <class Epi, class Sched, bool ALIGN_EPI, bool FP8 = false>
__device__ __forceinline__ void gemm_phase(LAS unsigned char* lds, const Sched& S, const Epi& E) {
    const int tid = make_tid(S.wv), wid = __builtin_amdgcn_readfirstlane(tid >> 6), lane = tid & 63, wr = wid >> 2, wc = wid & 3, fr = lane & 15, fq = lane >> 4;
    const int K = S.K, RB = S.RB, nt = RB / (BK * 2);
    unsigned voffA[2], voffB[2];
#pragma unroll
    for (int i = 0; i < 2; ++i) { int R, C; stage_rc(tid * 16 + i * 8192, R, C); const int Rb = Epi::PERM ? ((R & ~31) + perm32(R & 31)) : R;
        voffA[i] = (unsigned)(R * RB + C * 2); voffB[i] = (unsigned)(Rb * RB + C * 2); }
    const size_t kstep = (size_t)(BK * 2);
    const size_t hstep = (size_t)HALF * RB;
    const unsigned ldsw = (unsigned)wid * 1024u, ldsb = (unsigned)(size_t)lds;
    const int aoff = lds_byte(wr * 64 + fr, fq * 8), boff = lds_byte(wc * 32 + fr, fq * 8);
#define PG8_SA(b, h) (((b) * 2 + (h)) * HTB)
#define PG8_SB(b, h) ((4 + (b) * 2 + (h)) * HTB)
#define PG8_STAGE(bufoff, gbase, voff) do { _Pragma("unroll") for (int _i = 0; _i < 2; ++_i) glds_saddr((const char*)(gbase), (voff)[_i], ldsb + (unsigned)(bufoff) + ldsw + _i * 8192u); } while (0)
#define PG8_GOFS(pp, h, i) (gofs + ((((pp) * 2 + (h)) * 2 + (i)) * 512))
#define PG8_STAGE_A(bufoff, sel, h, ko) do { if constexpr (Sched::GATHER) { const int _pp = (sel) ? (pc ^ 1) : pc; unsigned _v[2]; _v[0] = PG8_GOFS(_pp, h, 0)[tid]; _v[1] = PG8_GOFS(_pp, h, 1)[tid]; PG8_STAGE(bufoff, S.A + (ko), _v); } \
        else { PG8_STAGE(bufoff, ((sel) ? nA : cA) + (h) * hstep + (ko), voffA); } } while (0)
#define PG8_LDA(dst, b, h) do { _Pragma("unroll") for (int m = 0; m < 4; ++m) { if constexpr (FP8) dst##8[m] = cat8(*(const LAS bf16x8*)(lds + PG8_SA(b, h) + aoff + m * 2048), *(const LAS bf16x8*)(lds + PG8_SA(b, h) + aoff + m * 2048 + 1024)); \
        else { _Pragma("unroll") for (int k = 0; k < 2; ++k) dst[m][k] = *(const LAS bf16x8*)(lds + PG8_SA(b, h) + aoff + m * 2048 + k * 1024); } } } while (0)
#define PG8_LDB(dst, b, h) do { _Pragma("unroll") for (int n = 0; n < 2; ++n) { if constexpr (FP8) dst##8[n] = cat8(*(const LAS bf16x8*)(lds + PG8_SB(b, h) + boff + n * 2048), *(const LAS bf16x8*)(lds + PG8_SB(b, h) + boff + n * 2048 + 1024)); \
        else { _Pragma("unroll") for (int k = 0; k < 2; ++k) dst[n][k] = *(const LAS bf16x8*)(lds + PG8_SB(b, h) + boff + n * 2048 + k * 1024); } } } while (0)
#define PG8_MMA(ai, bj, At, Bt) do { __builtin_amdgcn_s_setprio(1); _Pragma("unroll") for (int m = 0; m < 4; ++m) _Pragma("unroll") for (int n = 0; n < 2; ++n) { if constexpr (FP8) { \
        acc[ai][bj][m][n] = __builtin_amdgcn_mfma_scale_f32_16x16x128_f8f6f4(Bt##8[n], At##8[m], acc[ai][bj][m][n], 0, 0, 0, 0, 0, 0); } else { _Pragma("unroll") for (int k = 0; k < 2; ++k) \
        acc[ai][bj][m][n] = __builtin_amdgcn_mfma_f32_16x16x32_bf16(Bt[n][k], At[m][k], acc[ai][bj][m][n], 0, 0, 0); } } __builtin_amdgcn_s_setprio(0); } while (0)
#define PG8_WAIT_V(n) asm volatile("s_waitcnt vmcnt(" #n ")" ::: "memory")
#define PG8_WAIT_L(n) asm volatile("s_waitcnt lgkmcnt(" #n ")" ::: "memory")
#define PG8_BAR __builtin_amdgcn_s_barrier()
#define PG8_SCHED __builtin_amdgcn_sched_barrier(0)
    Unit cur, nxt; int ui = 0; int dyn_pend = 0;
    if constexpr (Sched::DYNAMIC) {
        if (wid == 0) { int v2 = 0; if (lane == 0) { const int v0 = S.fetch(), v1 = S.fetch(); v2 = S.fetch(); S.slot[0] = v0; S.slot[1] = v1; } dyn_pend = __builtin_amdgcn_readfirstlane(v2); }
        PG8_WAIT_L(0); PG8_BAR;
        const int L0 = __builtin_amdgcn_readfirstlane(S.slot[0]); if (L0 >= S.nwg) return;
        S.map(L0, cur);
    } else { if (!S.next(0, cur)) return; }
    LAS unsigned* gofs = (LAS unsigned*)(lds + 131072); int pc = 0;
#define PG8_WRITE_GOFS(pp, U) do { int _t = tid; asm volatile("" : "+v"(_t)); _Pragma("unroll") for (int _i = 0; _i < 2; ++_i) { int _R, _C; stage_rc(_t * 16 + _i * 8192, _R, _C); \
        _Pragma("unroll") for (int _h = 0; _h < 2; ++_h) PG8_GOFS(pp, _h, _i)[_t] = S.row_off(U, _h * HALF + _R) + (unsigned)_C * 2u; } } while (0)
    if constexpr (Sched::GATHER) PG8_WRITE_GOFS(0, cur);
    f32x4 acc[2][2][4][2];
#pragma unroll
    for (int a = 0; a < 2; ++a)
#pragma unroll
        for (int b = 0; b < 2; ++b)
#pragma unroll
            for (int m = 0; m < 4; ++m)
#pragma unroll
                for (int n = 0; n < 2; ++n) acc[a][b][m][n] = (f32x4){0.f, 0.f, 0.f, 0.f};
    bf16x8 At[4][2], B0[2][2], B1[2][2]; i32x8 At8[4], B08[2], B18[2];
    const char* cA = cur.a; const char* cB = cur.b; const char* nA = cA; const char* nB = cB;
    PG8_STAGE(PG8_SB(0, 0), cB, voffB); PG8_STAGE(PG8_SB(0, 1), cB + hstep, voffB); PG8_STAGE_A(PG8_SA(0, 0), false, 0, 0); PG8_STAGE_A(PG8_SA(0, 1), false, 1, 0);
    if (wr == 1) PG8_BAR;
    PG8_WAIT_V(2); PG8_BAR;
    PG8_STAGE(PG8_SB(1, 0), cB + kstep, voffB); PG8_STAGE_A(PG8_SA(1, 0), false, 0, kstep); PG8_STAGE(PG8_SB(1, 1), cB + hstep + kstep, voffB);
    PG8_WAIT_V(6); PG8_BAR;
    for (;;) {
        bool has_next = true;
        if constexpr (Sched::DYNAMIC) {
            if (ui >= 1 && wid == 0) { int v = 0; if (lane == 0) { S.slot[(ui + 1) % 3] = dyn_pend; v = S.fetch(); } dyn_pend = __builtin_amdgcn_readfirstlane(v); }
        } else { has_next = S.next(ui + 1, nxt); nA = has_next ? nxt.a : cA; nB = has_next ? nxt.b : cB; }
        if constexpr (Sched::GATHER) { if (has_next) PG8_WRITE_GOFS(pc ^ 1, nxt); else PG8_WRITE_GOFS(pc ^ 1, cur); }
        for (int t = 0; t < nt; t += 2) {
            const bool last = (t == nt - 2);
            if constexpr (Sched::DYNAMIC) { if (last) { const int Ln = __builtin_amdgcn_readfirstlane(S.slot[(ui + 1) % 3]); has_next = Ln < S.nwg; if (has_next) S.map(Ln, nxt); nA = has_next ? nxt.a : cA; nB = has_next ? nxt.b : cB; } }
            const size_t k1 = (size_t)(t + 1) * kstep;
            const size_t k2 = last ? 0 : (size_t)(t + 2) * kstep, k3 = k2 + kstep;
            const char* b2 = (last ? nB : cB) + k2; const char* b3 = b2 + kstep;
            PG8_LDB(B0, 0, 0); PG8_LDB(B1, 0, 1); PG8_SCHED; PG8_LDA(At, 0, 0); PG8_STAGE_A(PG8_SA(1, 1), false, 1, k1);
            PG8_WAIT_V(8); PG8_WAIT_L(0); PG8_BAR; PG8_MMA(0, 0, At, B0); PG8_MMA(0, 1, At, B1); PG8_BAR; PG8_SCHED;
            PG8_LDA(At, 0, 1); PG8_STAGE(PG8_SB(0, 0), b2, voffB); PG8_STAGE(PG8_SB(0, 1), b2 + hstep, voffB); PG8_STAGE_A(PG8_SA(0, 0), last, 0, k2);
            PG8_WAIT_V(8); PG8_WAIT_L(0); PG8_BAR; PG8_MMA(1, 0, At, B0); PG8_MMA(1, 1, At, B1); PG8_BAR; PG8_SCHED;
            PG8_LDB(B0, 1, 0); PG8_LDB(B1, 1, 1); PG8_SCHED; PG8_LDA(At, 1, 0); PG8_STAGE_A(PG8_SA(0, 1), last, 1, k2);
            PG8_WAIT_V(8); PG8_WAIT_L(0); PG8_BAR; PG8_MMA(0, 0, At, B0); PG8_MMA(0, 1, At, B1); PG8_BAR; PG8_SCHED;
            PG8_LDA(At, 1, 1); PG8_STAGE(PG8_SB(1, 0), b3, voffB); PG8_STAGE(PG8_SB(1, 1), b3 + hstep, voffB); PG8_STAGE_A(PG8_SA(1, 0), last, 0, k3);
            PG8_WAIT_V(8); PG8_WAIT_L(0); PG8_BAR; PG8_MMA(1, 0, At, B0); PG8_MMA(1, 1, At, B1); PG8_BAR; PG8_SCHED;
        }
        if constexpr (ALIGN_EPI) { if (wr == 0) PG8_BAR; }
        { const int l2_ = lane_id(); E(acc, cur, wr, wc, l2_ & 15, l2_ >> 4); }
        if (!has_next) break;
#pragma unroll
        for (int a = 0; a < 2; ++a)
#pragma unroll
            for (int b = 0; b < 2; ++b)
#pragma unroll
                for (int m = 0; m < 4; ++m)
#pragma unroll
                    for (int n = 0; n < 2; ++n) acc[a][b][m][n] = (f32x4){0.f, 0.f, 0.f, 0.f};
        cur = nxt; cA = nA; cB = nB; ++ui;
        pc ^= 1;
        if constexpr (ALIGN_EPI) { if (wr == 1) PG8_BAR; }
    }
    PG8_WAIT_V(0);
    if constexpr (!ALIGN_EPI) { if (wr == 0) PG8_BAR; }
    PG8_BAR;
#undef PG8_SA
#undef PG8_SB
#undef PG8_STAGE
#undef PG8_STAGE_A
#undef PG8_GOFS
#undef PG8_WRITE_GOFS
#undef PG8_LDA
#undef PG8_LDB
#undef PG8_MMA
#undef PG8_WAIT_V
#undef PG8_WAIT_L
#undef PG8_BAR
#undef PG8_SCHED
}
}

#define XB_TMO      128
#define XB_XCNT(j)  (256  + 64 * (j))
#define XB_XSUB(j)  (1280 + 64 * (j))
#define XB_XGEN(j)  (2304 + 64 * (j))
#define XB_TOP      3328
#define XB_TOPGEN   3392
#define XCD_BAR_WORDS 3456
#define XB_SPIN_CAP (1u << 18)
__device__ __forceinline__ unsigned xb_ld(unsigned* p)              { return __hip_atomic_load(p, __ATOMIC_RELAXED, __HIP_MEMORY_SCOPE_AGENT); }
__device__ __forceinline__ unsigned xb_add(unsigned* p, unsigned v) { return __hip_atomic_fetch_add(p, v, __ATOMIC_RELAXED, __HIP_MEMORY_SCOPE_AGENT); }
__device__ __forceinline__ unsigned xb_xcc_id() { return (unsigned)__builtin_amdgcn_s_getreg((3 << 11) | 20) & 0xFu; }
#define XB_SPIN(cond, bar) do { unsigned _sp = 0; while (cond) { __builtin_amdgcn_s_sleep(1); \
    if ((++_sp & 255u) == 0u) { if (xb_ld(&(bar)[XB_TMO])) break; if (_sp > XB_SPIN_CAP) { atomicAdd(&(bar)[XB_TMO], 1u); break; } } } } while (0)
struct XcdBarrier { unsigned* bar; unsigned x; volatile LAS unsigned* st; };
__device__ __forceinline__ XcdBarrier xcd_barrier_post(unsigned* bar, volatile LAS unsigned* st, int tid0) {
    XcdBarrier b; b.bar = bar; b.x = xb_xcc_id(); b.st = st;
    if (tid0 == 0) (void)xb_add(&bar[XB_XCNT(b.x)], 1u);
    return b;
}
__device__ __forceinline__ void xcd_barrier_complete(unsigned* bar, unsigned x, unsigned& nloc, unsigned& nx) {
    const unsigned G = gridDim.x * gridDim.y * gridDim.z;
    unsigned sum, cnt, mine, sp = 0u;
    for (;;) {
        sum = 0u; cnt = 0u; mine = 0u;
#pragma unroll
        for (unsigned j = 0; j < 16; ++j) { const unsigned c = xb_ld(&bar[XB_XCNT(j)]); sum += c; cnt += (c > 0u) ? 1u : 0u; mine = (j == x) ? c : mine; }
        if (sum == G) break;
        __builtin_amdgcn_s_sleep(1);
        if ((++sp & 255u) == 0u) { if (xb_ld(&bar[XB_TMO])) break; if (sp > XB_SPIN_CAP) { atomicAdd(&bar[XB_TMO], 1u); break; } }
    }
    nloc = mine > 0u ? mine : 1u; nx = cnt > 0u ? cnt : 1u;
}
__device__ __forceinline__ void xcd_barrier(const XcdBarrier& b, int tid0) {
    asm volatile("s_waitcnt vmcnt(0)" ::: "memory");
    __syncthreads();
    if (tid0 == 0) {
        unsigned* bar = b.bar;
        __builtin_amdgcn_s_waitcnt(0);
        unsigned nloc = b.st[0], nx = b.st[1];
        if (nloc == 0u) { xcd_barrier_complete(bar, b.x, nloc, nx); b.st[0] = nloc; b.st[1] = nx; }
        const unsigned old = xb_add(&bar[XB_XSUB(b.x)], 1u);
        const unsigned gen = old / nloc;
        if (old + 1u == (gen + 1u) * nloc) {
            __builtin_amdgcn_fence(__ATOMIC_RELEASE, "agent");
            asm volatile("s_waitcnt vmcnt(0)" ::: "memory");
            const unsigned og = xb_add(&bar[XB_TOP], 1u);
            const unsigned tg = og / nx;
            if (og + 1u == (tg + 1u) * nx) xb_add(&bar[XB_TOPGEN], 1u);
            else XB_SPIN(xb_ld(&bar[XB_TOPGEN]) == tg, bar);
            __builtin_amdgcn_fence(__ATOMIC_ACQUIRE, "agent");
            xb_add(&bar[XB_XGEN(b.x)], 1u);
            asm volatile("s_waitcnt vmcnt(0)" ::: "memory");
        } else {
            XB_SPIN(xb_ld(&bar[XB_XGEN(b.x)]) == gen, bar);
            __builtin_amdgcn_fence(__ATOMIC_ACQUIRE, "agent");
            asm volatile("s_waitcnt vmcnt(0)" ::: "memory");
        }
    }
    __syncthreads();
}

struct Args { const float* in[20]; float* out; unsigned char* ws; int ph_lo, ph_hi; };
typedef const __attribute__((address_space(4))) Args CArgs;
enum { I_X = 0, I_NORM_MIX, I_NORM_FFN, I_A_W_IN, I_A_LB, I_A_OGAIN, I_A_W_OUT, I_KV_NORM, I_KV_W, I_K_NORM, I_B_W_Q, I_B_Q_NORM, I_B_W_OUT,
       I_W_GROUP, I_B_GROUP, I_W_EXPERT, I_B_EXPERT, I_W_GATE, I_W_UP, I_W_DOWN };
struct Frame {
    LAS unsigned char* lds; unsigned char* ws; unsigned* ctl;
    int tid, lane, wave, vcu, G, gw, NGW;
};

struct TrItem { const float* src; const float* ksc; unsigned char* dst; int N, K, k0, n0, drow0, flags; float osc; };
struct TrRegs { f32x4 v[16]; f32x4 ks[2]; };
constexpr int TR_SCR_BYTES = 128 * 33 * 4;
__device__ __forceinline__ void tr_load(const TrItem& it, TrRegs& r, int lane) {
    const float* p = it.src + (size_t)(it.k0 + (lane >> 3)) * it.N + it.n0 + 4 * (lane & 7);
    const size_t st = (size_t)8 * it.N;
#pragma unroll
    for (int i = 0; i < 16; ++i) r.v[i] = *(const f32x4*)(p + i * st);
    if (it.ksc) { const f32x4* q = (const f32x4*)(it.ksc + it.k0 + 8 * (lane >> 3)); r.ks[0] = q[0]; r.ks[1] = q[1]; }
    else { r.ks[0] = (f32x4){1.f, 1.f, 1.f, 1.f}; r.ks[1] = r.ks[0]; }
}
__device__ __forceinline__ void tr_to_lds(const TrRegs& r, LAS float* scr, int lane) {
    LAS float* d = scr + (lane >> 3) * 33 + 4 * (lane & 7);
#pragma unroll
    for (int i = 0; i < 16; ++i) { d[(8 * i) * 33 + 0] = r.v[i][0]; d[(8 * i) * 33 + 1] = r.v[i][1]; d[(8 * i) * 33 + 2] = r.v[i][2]; d[(8 * i) * 33 + 3] = r.v[i][3]; }
}
__device__ __forceinline__ void tr_store(const TrItem& it, f32x4 ka, f32x4 kb, const LAS float* scr, int lane) {
#pragma unroll
    for (int jh = 0; jh < 2; ++jh) {
        const int c = (lane >> 3) + 8 * jh;
        if (jh == 1 && it.ksc) { const f32x4* q = (const f32x4*)(it.ksc + it.k0 + 8 * c); ka = q[0]; kb = q[1]; }
        const float o = it.osc;
        const float s0 = ka[0] * o, s1 = ka[1] * o, s2 = ka[2] * o, s3 = ka[3] * o, s4 = kb[0] * o, s5 = kb[1] * o, s6 = kb[2] * o, s7 = kb[3] * o;
#pragma unroll
        for (int jn = 0; jn < 4; ++jn) {
            const int n = (lane & 7) + 8 * jn; const LAS float* s = scr + (8 * c) * 33 + n;
            const float w0 = s[0 * 33] * s0, w1 = s[1 * 33] * s1, w2 = s[2 * 33] * s2, w3 = s[3 * 33] * s3, w4 = s[4 * 33] * s4, w5 = s[5 * 33] * s5, w6 = s[6 * 33] * s6, w7 = s[7 * 33] * s7;
            int drow = it.drow0 + n;
            if (it.flags & 1) { const int cidx = it.n0 + n, d = cidx & 127; drow = (it.drow0 - it.n0) + (cidx & ~127) + 32 * ((d & 63) >> 4) + 8 * ((d & 15) >> 2) + 4 * (d >> 6) + (d & 3); }
            const size_t eo = (size_t)drow * it.K + it.k0 + 8 * c;
            if (it.flags & 2) { u32x2 o8; o8.x = pk4_fp8(w0, w1, w2, w3); o8.y = pk4_fp8(w4, w5, w6, w7); *(u32x2*)(it.dst + eo) = o8; }
            else { u32x4 o16; o16.x = pk2(w0, w1); o16.y = pk2(w2, w3); o16.z = pk2(w4, w5); o16.w = pk2(w6, w7); *(u32x4*)(it.dst + eo * 2) = o16; }
        }
    }
}
template <class Dec> __device__ __forceinline__ void tr_run(Dec dec, int first, int total, int stride, LAS float* scr, int lane) {
    if (first >= total) return;
    TrRegs r; TrItem cur = dec(first); tr_load(cur, r, lane);
    for (int i = first; i < total; i += stride) {
        tr_to_lds(r, scr, lane);
        const f32x4 ka = r.ks[0], kb = r.ks[1];
        TrItem nxt = cur; const bool more = i + stride < total;
        if (more) { nxt = dec(i + stride); tr_load(nxt, r, lane); }
        LDS_WAIT(); asm volatile("" ::: "memory");
        tr_store(cur, ka, kb, scr, lane);
        LDS_WAIT(); asm volatile("" ::: "memory");
        cur = nxt;
    }
}
constexpr size_t WGU_LSTRIDE = 64 * MiB, WD_LSTRIDE = 32 * MiB;
static_assert((FP8_MOE0 != 0) && (FP8_MOE1 != 0), "the two-layer weight residency assumes e4m3 expert weights");
constexpr int MOE_CV_ITEMS = 32 * 768;
__device__ __forceinline__ TrItem moe_cv_item(CArgs& a, unsigned char* ws, int layer, int item) {
    const int e = item / 768, r = item % 768, which = r / 256, q = r % 256;
    const size_t eo = (size_t)(layer * NE + e);
    TrItem t; t.ksc = nullptr; t.flags = 2;
    if (which < 2) {
        const int kb = q / 16, nb = q % 16, n0 = nb * 32;
        t.src = (which == 0 ? a.in[I_W_GATE] : a.in[I_W_UP]) + eo * (size_t)D * FF; t.N = FF; t.K = D; t.k0 = 128 * kb; t.n0 = n0;
        t.dst = ws + WS_WGU + (size_t)layer * WGU_LSTRIDE + (size_t)e * 1024 * D; t.drow0 = (n0 >> 7) * 256 + which * 128 + (n0 & 127); t.osc = SC_W;
    } else {
        const int kb = q / 64, nb = q % 64;
        t.src = a.in[I_W_DOWN] + eo * (size_t)FF * D; t.N = D; t.K = FF; t.k0 = 128 * kb; t.n0 = nb * 32;
        t.dst = ws + WS_WD + (size_t)layer * WD_LSTRIDE + (size_t)e * D * FF; t.drow0 = nb * 32; t.osc = SC_WD;
    }
    return t;
}
__device__ __forceinline__ void rms_row_to_bf16(const float* xrow, bf16* orow, int lane) {
    const f32x4* xr = (const f32x4*)xrow + lane;
    f32x4 v[8]; float s = 0.f;
#pragma unroll
    for (int j = 0; j < 8; ++j) { v[j] = xr[64 * j]; s += (v[j].x * v[j].x + v[j].y * v[j].y) + (v[j].z * v[j].z + v[j].w * v[j].w); }
    const float rstd = __builtin_amdgcn_rsqf(wave_sum(s) * (1.f / D) + RMS_EPS);
    u32x2* o8 = (u32x2*)orow + lane;
#pragma unroll
    for (int j = 0; j < 8; ++j) { u32x2 w; w.x = pk2(v[j].x * rstd, v[j].y * rstd); w.y = pk2(v[j].z * rstd, v[j].w * rstd); o8[64 * j] = w; }
}

__device__ __forceinline__ int moe_tables(Frame& F, int layer) {
    LAS int* blk_e = (LAS int*)(F.lds + LT_BLKE); LAS int* blkstart = (LAS int*)(F.lds + LT_BLKSTART); LAS int* cntl = (LAS int*)(F.lds + LT_CNT);
    __syncthreads();
    if (F.wave == 0) {
        const int e = F.lane & 31;
        const int c = (int)__hip_atomic_load(F.ctl + CW_CNT + 64 * layer + e, __ATOMIC_RELAXED, __HIP_MEMORY_SCOPE_AGENT);
        const int nb = (c + 255) >> 8;
        int incl = nb;
#pragma unroll
        for (int o = 1; o < 32; o <<= 1) { const int t = __shfl_up(incl, o, 32); if ((F.lane & 31) >= o) incl += t; }
        const int excl = incl - nb;
        if (F.lane < 32) { blkstart[e] = excl; cntl[e] = c; for (int r = 0; r < nb; ++r) blk_e[excl + r] = e; if (e == 31) blkstart[32] = incl; }
    }
    __syncthreads();
    return blkstart[32];
}

typedef const GAS char* gcptr;
__device__ __forceinline__ gcptr opaque_s(const void* p) { asm volatile("" : "+s"(p)); return (gcptr)p; }
__device__ __forceinline__ float wave_reduce4(const float (&p)[4], int lane) {
    const bool b0 = lane & 1, b1 = lane & 2;
    float a0 = b0 ? p[1] : p[0], x0 = b0 ? p[0] : p[1]; a0 += __shfl_xor(x0, 1);
    float a1 = b0 ? p[3] : p[2], x1 = b0 ? p[2] : p[3]; a1 += __shfl_xor(x1, 1);
    float c = b1 ? a1 : a0, d = b1 ? a0 : a1; c += __shfl_xor(d, 2);
    c += __shfl_xor(c, 4); c += __shfl_xor(c, 8); c += __shfl_xor(c, 16); c += __shfl_xor(c, 32);
    return c;
}
__device__ __forceinline__ float wave_reduce8(const float (&p)[8], int lane) {
    const bool b2 = lane & 4;
    const float lo[4] = {p[0], p[1], p[2], p[3]}, hi[4] = {p[4], p[5], p[6], p[7]};
    float q[4];
#pragma unroll
    for (int i = 0; i < 4; ++i) { const float keep = b2 ? hi[i] : lo[i], give = b2 ? lo[i] : hi[i]; q[i] = keep + __shfl_xor(give, 4); }
    const bool b0 = lane & 1, b1 = lane & 2;
    float a0 = b0 ? q[1] : q[0], x0 = b0 ? q[0] : q[1]; a0 += __shfl_xor(x0, 1);
    float a1 = b0 ? q[3] : q[2], x1 = b0 ? q[2] : q[3]; a1 += __shfl_xor(x1, 1);
    float c = b1 ? a1 : a0, d = b1 ? a0 : a1; c += __shfl_xor(d, 2);
    c += __shfl_xor(c, 8); c += __shfl_xor(c, 16); c += __shfl_xor(c, 32);
    return c;
}
template <bool DRY, bool OUT8> __device__ __forceinline__ void route_token(Frame& F, CArgs& a, int layer, int t) {
    const bf16* xrow = (const bf16*)(F.ws + WS_XR) + (size_t)t * D;
    const unsigned l16 = (unsigned)F.lane * 16u;
    gcptr xb = opaque_s(xrow); gcptr gb = opaque_s(a.in[I_NORM_FFN] + layer * D);
    f32x4 v[8]; float s = 0.f;
#pragma unroll
    for (int j = 0; j < 8; ++j) { const u32x2 xw_ = *(const GAS u32x2*)(xb + j * 512 + (l16 >> 1)); v[j] = (f32x4){bflo(xw_.x), bfhi(xw_.x), bflo(xw_.y), bfhi(xw_.y)}; s += (v[j].x * v[j].x + v[j].y * v[j].y) + (v[j].z * v[j].z + v[j].w * v[j].w); }
    const float rstd = __builtin_amdgcn_rsqf(wave_sum(s) * (1.f / D) + RMS_EPS);
    u32x2* o8 = (u32x2*)((bf16*)(F.ws + (DRY ? WS_OPART : WS_XN)) + (size_t)t * D) + F.lane;
#pragma unroll
    for (int j = 0; j < 8; ++j) { const f32x4 g = *(const GAS f32x4*)(gb + j * 1024 + l16); v[j].x *= rstd * g.x; v[j].y *= rstd * g.y; v[j].z *= rstd * g.z; v[j].w *= rstd * g.w;
        if (OUT8) ((unsigned*)(F.ws + (DRY ? WS_OPART : WS_XN)) + (size_t)t * (D / 4))[64 * j + F.lane] = pk4_fp8(v[j].x * SC_XN, v[j].y * SC_XN, v[j].z * SC_XN, v[j].w * SC_XN);
        else { u32x2 w; w.x = pk2(v[j].x, v[j].y); w.y = pk2(v[j].z, v[j].w); o8[64 * j] = w; } }
    const float* RT = (const float*)(F.ws + WS_RT) + (size_t)layer * 36 * D;
    float gl[4];
    { float pp[4];
#pragma unroll
      for (int r = 0; r < 4; ++r) { gcptr wb = opaque_s(RT + r * D); float p = 0.f;
#pragma unroll
        for (int j = 0; j < 8; ++j) { const f32x4 w = *(const GAS f32x4*)(wb + j * 1024 + l16); p += (v[j].x * w.x + v[j].y * w.y) + (v[j].z * w.z + v[j].w * w.w); }
        pp[r] = p; if (r & 1) __builtin_amdgcn_sched_barrier(0); }
      const float red = wave_reduce4(pp, F.lane);
#pragma unroll
      for (int r = 0; r < 4; ++r) gl[r] = __builtin_bit_cast(float, __builtin_amdgcn_readlane(__builtin_bit_cast(int, red), r)) + a.in[I_B_GROUP][layer * NG + r]; }
    int g = 0; float gm = gl[0];
#pragma unroll
    for (int r = 1; r < 4; ++r) if (gl[r] > gm) { gm = gl[r]; g = r; }
    float gs = 0.f;
#pragma unroll
    for (int r = 0; r < 4; ++r) gs += __expf(gl[r] - gm);
    const float gp = 1.0f / gs;
    g = __builtin_amdgcn_readfirstlane(g);
    float el[8];
    { float pp[8];
#pragma unroll
      for (int r = 0; r < 8; ++r) { gcptr wb = opaque_s(RT + (size_t)(4 + g * 8 + r) * D); float p = 0.f;
#pragma unroll
        for (int j = 0; j < 8; ++j) { const f32x4 w = *(const GAS f32x4*)(wb + j * 1024 + l16); p += (v[j].x * w.x + v[j].y * w.y) + (v[j].z * w.z + v[j].w * w.w); }
        pp[r] = p; if (r & 1) __builtin_amdgcn_sched_barrier(0); }
      const float red = wave_reduce8(pp, F.lane);
#pragma unroll
      for (int r = 0; r < 8; ++r) el[r] = __builtin_bit_cast(float, __builtin_amdgcn_readlane(__builtin_bit_cast(int, red), r)) + a.in[I_B_EXPERT][layer * NE + g * 8 + r]; }
    int i0 = 0; float m0 = el[0];
#pragma unroll
    for (int r = 1; r < 8; ++r) if (el[r] > m0) { m0 = el[r]; i0 = r; }
    int i1 = -1; float m1 = -INFINITY;
#pragma unroll
    for (int r = 0; r < 8; ++r) if (r != i0 && el[r] > m1) { m1 = el[r]; i1 = r; }
    const float q1 = __expf(m1 - m0), w0 = gp / (1.0f + q1), w1 = gp * q1 / (1.0f + q1);
    if (DRY && w0 + w1 < -1.0f) ((float*)(F.ws + WS_OPART))[0] = w0;
    if (F.lane == 0 && !DRY) {
        const int e0 = g * 8 + i0, e1 = g * 8 + i1;
        const int r0 = (int)atomicAdd(F.ctl + CW_CNT + 64 * layer + e0, 1u), r1 = (int)atomicAdd(F.ctl + CW_CNT + 64 * layer + e1, 1u);
        int* lists = (int*)(F.ws + WS_LISTS); lists[e0 * LIST_CAP + r0] = t; lists[e1 * LIST_CAP + r1] = t;
        int* rec = (int*)(F.ws + WS_TOKREC) + (size_t)t * 8;
        rec[0] = e0; rec[1] = r0; rec[2] = __builtin_bit_cast(int, w0); rec[3] = e1; rec[4] = r1; rec[5] = __builtin_bit_cast(int, w1);
    }
}

template <bool NORM, bool DRY, bool OUT8> __device__ __forceinline__ void combine_token(Frame& F, CArgs& a, int t) {
    const LAS int* blkstart = (const LAS int*)(F.lds + LT_BLKSTART);
    const int* rec = (const int*)(F.ws + WS_TOKREC) + (size_t)t * 8;
    const int e0 = rec[0], r0 = rec[1], e1 = rec[3], r1 = rec[4]; const float w0 = __builtin_bit_cast(float, rec[2]), w1 = __builtin_bit_cast(float, rec[5]);
    const size_t row0 = (size_t)blkstart[e0] * 256 + r0, row1 = (size_t)blkstart[e1] * 256 + r1;
    const u32x2* p0 = (const u32x2*)((const bf16*)(F.ws + WS_OUTB) + row0 * D) + F.lane; const u32x2* p1 = (const u32x2*)((const bf16*)(F.ws + WS_OUTB) + row1 * D) + F.lane;
    const unsigned* q0 = (const unsigned*)(F.ws + WS_OUTB + row0 * D) + F.lane; const unsigned* q1 = (const unsigned*)(F.ws + WS_OUTB + row1 * D) + F.lane;
    u32x2* xr = (u32x2*)((bf16*)(F.ws + WS_XR) + (size_t)t * D) + F.lane; f32x4* xo = (f32x4*)(a.out + (size_t)t * D) + F.lane;
    f32x4 v[8]; float s = 0.f;
#pragma unroll
    for (int j = 0; j < 8; ++j) { const u32x2 xb_ = xr[64 * j]; f32x4 x = (f32x4){bflo(xb_.x), bfhi(xb_.x), bflo(xb_.y), bfhi(xb_.y)};
        if (OUT8) { const unsigned b0 = q0[64 * j], b1 = q1[64 * j]; const float u0 = w0 * (1.0f / SC_OUT), u1 = w1 * (1.0f / SC_OUT);
            const f32x2 l0 = __builtin_amdgcn_cvt_pk_f32_fp8((int)b0, false), h0 = __builtin_amdgcn_cvt_pk_f32_fp8((int)b0, true), l1 = __builtin_amdgcn_cvt_pk_f32_fp8((int)b1, false), h1 = __builtin_amdgcn_cvt_pk_f32_fp8((int)b1, true);
            x.x += u0 * l0.x + u1 * l1.x; x.y += u0 * l0.y + u1 * l1.y; x.z += u0 * h0.x + u1 * h1.x; x.w += u0 * h0.y + u1 * h1.y; }
        else { const u32x2 a0 = p0[64 * j], a1 = p1[64 * j];
            x.x += w0 * bflo(a0.x) + w1 * bflo(a1.x); x.y += w0 * bfhi(a0.x) + w1 * bfhi(a1.x); x.z += w0 * bflo(a0.y) + w1 * bflo(a1.y); x.w += w0 * bfhi(a0.y) + w1 * bfhi(a1.y); }
        v[j] = x; if (NORM) { if (!DRY) { u32x2 w_; w_.x = pk2(x.x, x.y); w_.y = pk2(x.z, x.w); xr[64 * j] = w_; } } else xo[64 * j] = x; s += (x.x * x.x + x.y * x.y) + (x.z * x.z + x.w * x.w); }
    if (NORM) {
        const float rstd = __builtin_amdgcn_rsqf(wave_sum(s) * (1.f / D) + RMS_EPS);
        u32x2* o8 = (u32x2*)((bf16*)(F.ws + (DRY ? WS_OPART + 128 * MiB : WS_XN)) + (size_t)t * D) + F.lane;
#pragma unroll
        for (int j = 0; j < 8; ++j) {
            if (FP8_QKV) ((unsigned*)(F.ws + (DRY ? WS_OPART + 128 * MiB : WS_XN)) + (size_t)t * (D / 4))[64 * j + F.lane] = pk4_fp8(v[j].x * (rstd * SC_XN), v[j].y * (rstd * SC_XN), v[j].z * (rstd * SC_XN), v[j].w * (rstd * SC_XN));
            else { u32x2 w; w.x = pk2(v[j].x * rstd, v[j].y * rstd); w.y = pk2(v[j].z * rstd, v[j].w * rstd); o8[64 * j] = w; } }
    }
}

__device__ __forceinline__ void hgrn_naive_item(Frame& F, int item) {
    const int b = item >> 6, h = (item >> 2) & 15, sl = item & 3;
    const bf16* Zq = (const bf16*)(F.ws + WS_ZQ); const bf16* Zk = (const bf16*)(F.ws + WS_ZK); const _Float16* Zg = (const _Float16*)(F.ws + WS_ZG); const bf16* Zv = (const bf16*)(F.ws + WS_ZV);
    float* Oraw = (float*)(F.ws + WS_ORAW);
    LAS float* fq = (LAS float*)F.lds; LAS float* fk = fq + 16 * 128; LAS float* ff = fk + 16 * 128; LAS float* fv = ff + 16 * 128; LAS float* part = fv + 16 * 32;
    const int dv = F.tid & 31, dkg = F.tid >> 5;
    float S[8];
#pragma unroll
    for (int j = 0; j < 8; ++j) S[j] = 0.f;
    const size_t tok0 = (size_t)b * T;
    for (int c = 0; c < T / 16; ++c) {
        __syncthreads();
#pragma unroll
        for (int i = 0; i < 4; ++i) { const int idx = F.tid + i * 512, st = idx >> 7, dk = idx & 127; const size_t g = (tok0 + c * 16 + st) * D + h * HD + dk;
            fq[idx] = bf2f(Zq[g]); fk[idx] = bf2f(Zk[g]); ff[idx] = __expf((float)Zg[g]); }
        { const int st = F.tid >> 5; fv[F.tid] = bf2f(Zv[(tok0 + c * 16 + st) * D + h * HD + sl * 32 + dv]); }
        __syncthreads();
#pragma unroll 4
        for (int st = 0; st < 16; ++st) {
            const float v = fv[st * 32 + dv];
            const f32x4 q0 = *(const LAS f32x4*)(fq + st * 128 + dkg * 8), q1 = *(const LAS f32x4*)(fq + st * 128 + dkg * 8 + 4);
            const f32x4 k0 = *(const LAS f32x4*)(fk + st * 128 + dkg * 8), k1 = *(const LAS f32x4*)(fk + st * 128 + dkg * 8 + 4);
            const f32x4 f0 = *(const LAS f32x4*)(ff + st * 128 + dkg * 8), f1 = *(const LAS f32x4*)(ff + st * 128 + dkg * 8 + 4);
            float po = 0.f;
#pragma unroll
            for (int j = 0; j < 4; ++j) { S[j] = f0[j] * S[j] + k0[j] * v; po += q0[j] * S[j]; S[4 + j] = f1[j] * S[4 + j] + k1[j] * v; po += q1[j] * S[4 + j]; }
            part[(st * 16 + dkg) * 32 + dv] = po;
        }
        __syncthreads();
        { const int st = F.tid >> 5; float o = 0.f;
#pragma unroll
            for (int g = 0; g < 16; ++g) o += part[(st * 16 + g) * 32 + dv];
            Oraw[(tok0 + c * 16 + st) * D + h * HD + sl * 32 + dv] = o; }
    }
    __syncthreads();
}
__device__ __forceinline__ void hgrn_norm_token(Frame& F, CArgs& a, int t) {
    const float* o = (const float*)(F.ws + WS_ORAW) + (size_t)t * D + F.lane * 32;
    const bf16* zg = (const bf16*)(F.ws + WS_ZGATE) + (size_t)t * D + F.lane * 32;
    const float* gain = a.in[I_A_OGAIN] + (F.lane & 3) * 32;
    f32x4 v[8]; float s = 0.f;
#pragma unroll
    for (int j = 0; j < 8; ++j) { v[j] = ((const f32x4*)o)[j]; s += (v[j].x * v[j].x + v[j].y * v[j].y) + (v[j].z * v[j].z + v[j].w * v[j].w); }
    s += __shfl_xor(s, 1); s += __shfl_xor(s, 2);
    const float rstd = 1.0f / sqrtf(s * (1.f / HD) + RMS_EPS);
    bf16* out = (bf16*)(F.ws + WS_OH) + (size_t)t * D + F.lane * 32;
#pragma unroll
    for (int j = 0; j < 4; ++j) { const u32x4 g = ((const u32x4*)zg)[j]; const f32x4 ga = ((const f32x4*)gain)[2 * j], gb = ((const f32x4*)gain)[2 * j + 1]; const f32x4 va = v[2 * j], vb = v[2 * j + 1];
        u32x4 w; w.x = pk2(va.x * rstd * ga.x * bflo(g.x), va.y * rstd * ga.y * bfhi(g.x)); w.y = pk2(va.z * rstd * ga.z * bflo(g.y), va.w * rstd * ga.w * bfhi(g.y));
        w.z = pk2(vb.x * rstd * gb.x * bflo(g.z), vb.y * rstd * gb.y * bfhi(g.z)); w.w = pk2(vb.z * rstd * gb.z * bflo(g.w), vb.w * rstd * gb.w * bfhi(g.w));
        ((u32x4*)out)[j] = w; }
}

template <bool DRY> __device__ __forceinline__ void qk_post_item(Frame& F, CArgs& a, int item) {
    const int b = item >> 6, n = (item >> 2) & 15, hq = item & 3;
    const int hl = F.lane >> 4, sb = F.lane & 15, h = hq * 4 + hl;
    bf16* Q = (bf16*)(F.ws + WS_Q); bf16* Kb = (bf16*)(F.ws + WS_K);
    const f32x2* rope = (const f32x2*)(F.ws + WS_ROPE);
    const f32x4 gq0 = *(const f32x4*)(a.in[I_B_Q_NORM] + 4 * sb), gq1 = *(const f32x4*)(a.in[I_B_Q_NORM] + 64 + 4 * sb);
    const f32x4 gk0 = *(const f32x4*)(a.in[I_K_NORM] + 4 * sb), gk1 = *(const f32x4*)(a.in[I_K_NORM] + 64 + 4 * sb);
    float ks[8];
#pragma unroll
    for (int j = 0; j < 8; ++j) ks[j] = 0.f;
    for (int i = 0; i < 32; ++i) {
        const int pos = n * MBLK + F.wave * 32 + i; const size_t tok = (size_t)b * T + pos;
        f32x2 cs[4];
#pragma unroll
        for (int j = 0; j < 4; ++j) cs[j] = rope[pos * 64 + 4 * sb + j];
#pragma unroll
        for (int which = 0; which < 2; ++which) {
            bf16* p = (which ? Kb : Q) + tok * D + h * HD + 4 * sb;
            const u32x2 lo = *(const u32x2*)p, hi = *(const u32x2*)(p + 64);
            float x1[4] = {bflo(lo.x), bfhi(lo.x), bflo(lo.y), bfhi(lo.y)}, x2[4] = {bflo(hi.x), bfhi(hi.x), bflo(hi.y), bfhi(hi.y)};
            float s = 0.f;
#pragma unroll
            for (int j = 0; j < 4; ++j) s += x1[j] * x1[j] + x2[j] * x2[j];
            s += __shfl_xor(s, 1); s += __shfl_xor(s, 2); s += __shfl_xor(s, 4); s += __shfl_xor(s, 8);
            const float rstd = 1.0f / sqrtf(s * (1.f / HD) + RMS_EPS);
            const f32x4 g0 = which ? gk0 : gq0, g1 = which ? gk1 : gq1;
            float o1[4], o2[4];
#pragma unroll
            for (int j = 0; j < 4; ++j) { const float y1 = x1[j] * rstd * g0[j], y2 = x2[j] * rstd * g1[j]; o1[j] = y1 * cs[j].x - y2 * cs[j].y; o2[j] = y2 * cs[j].x + y1 * cs[j].y; }
            u32x2 wlo, whi; wlo.x = pk2(o1[0], o1[1]); wlo.y = pk2(o1[2], o1[3]); whi.x = pk2(o2[0], o2[1]); whi.y = pk2(o2[2], o2[3]);
            { bf16* pw = DRY ? p + (WS_OPART - WS_Q) / 2 : p; *(u32x2*)pw = wlo; *(u32x2*)(pw + 64) = whi; }
            if (which) {
#pragma unroll
                for (int j = 0; j < 4; ++j) { ks[j] += o1[j]; ks[4 + j] += o2[j]; } }
        }
    }
    LAS float* red = (LAS float*)F.lds;
    __syncthreads();
#pragma unroll
    for (int j = 0; j < 8; ++j) red[(F.wave * 64 + F.lane) * 8 + j] = ks[j];
    __syncthreads();
    { const int l = F.tid >> 3, j = F.tid & 7; float s = 0.f;
#pragma unroll
        for (int w = 0; w < 8; ++w) s += red[(w * 64 + l) * 8 + j];
        const int hh = hq * 4 + (l >> 4), s2 = l & 15, d = (j < 4) ? 4 * s2 + j : 64 + 4 * s2 + (j - 4);
        ((float*)(F.ws + (DRY ? WS_OPART + 200 * MiB : WS_KMEAN)))[(((size_t)b * H + hh) * NBLK + n) * HD + d] = s * (1.0f / MBLK); }
    const bf16* V = (const bf16*)(F.ws + WS_V); bf16* Vt = (bf16*)(F.ws + (DRY ? WS_OPART + 128 * MiB : WS_VT));
    LAS bf16* vl = (LAS bf16*)(F.lds + 32768);
    for (int hh = 0; hh < 4; ++hh) {
        const int hv = hq * 4 + hh;
        __syncthreads();
#pragma unroll
        for (int i = 0; i < 8; ++i) { const int ch = F.tid + i * 512, r = ch >> 4, cc = ch & 15;
            const u32x4 w = *(const u32x4*)(V + ((size_t)b * T + n * MBLK + r) * D + hv * HD + cc * 8);
            *(LAS u32x4*)(vl + r * 136 + cc * 8) = w; }
        __syncthreads();
#pragma unroll
        for (int i = 0; i < 8; ++i) { const int idx = F.tid + i * 512, d = idx & 127, tg = idx >> 7;
            unsigned short e[8];
#pragma unroll
            for (int j = 0; j < 8; ++j) e[j] = vl[(tg * 8 + j) * 136 + d];
            u32x4 w; w.x = e[0] | ((unsigned)e[1] << 16); w.y = e[2] | ((unsigned)e[3] << 16); w.z = e[4] | ((unsigned)e[5] << 16); w.w = e[6] | ((unsigned)e[7] << 16);
            *(u32x4*)(Vt + (((size_t)b * H + hv) * HD + d) * T + n * MBLK + tg * 8) = w; }
    }
    __syncthreads();
}

__device__ __forceinline__ void attn_v0_item(Frame& F, int item) {
    const int b = item >> 8, h = (item >> 4) & 15, jb = item & 15;
    const bf16* Q = (const bf16*)(F.ws + WS_Q); const bf16* Kb = (const bf16*)(F.ws + WS_K); const bf16* Vt = (const bf16*)(F.ws + WS_VT); bf16* OA = (bf16*)(F.ws + WS_OA);
    const float* kmean = (const float*)(F.ws + WS_KMEAN) + ((size_t)b * H + h) * NBLK * HD;
    const int lane = F.lane, fr = lane & 15, fq = lane >> 4;
    const size_t tokw = (size_t)b * T + jb * MBLK + F.wave * 32;
    LAS unsigned* maskl = (LAS unsigned*)(F.lds + F.wave * 8192);
    LAS bf16* pl = (LAS bf16*)(F.lds + F.wave * 8192 + 256);
    {
        const int row = lane & 31, half = lane >> 5;
        float g[8];
#pragma unroll
        for (int i = 0; i < 8; ++i) g[i] = 0.f;
        const bf16* qrow = Q + (tokw + row) * D + h * HD;
        for (int dc = 0; dc < 16; ++dc) {
            const u32x4 w = *(const u32x4*)(qrow + dc * 8);
            const float qv[8] = {bflo(w.x), bfhi(w.x), bflo(w.y), bfhi(w.y), bflo(w.z), bfhi(w.z), bflo(w.w), bfhi(w.w)};
#pragma unroll
            for (int i = 0; i < 8; ++i) { const float* km = kmean + (2 * i + half) * HD + dc * 8;
#pragma unroll
                for (int e = 0; e < 8; ++e) g[i] += qv[e] * km[e]; }
        }
        float ga[16];
#pragma unroll
        for (int i = 0; i < 8; ++i) { const float o = __shfl_xor(g[i], 32); ga[2 * i] = half ? o : g[i]; ga[2 * i + 1] = half ? g[i] : o; }
        unsigned mask = 0u;
#pragma unroll
        for (int pick = 0; pick < 3; ++pick) { float best = -INFINITY; int bi = -1;
#pragma unroll
            for (int n = 0; n < 16; ++n) { const bool ok = (n < jb) && !((mask >> n) & 1u); if (ok && ga[n] > best) { best = ga[n]; bi = n; } }
            if (bi >= 0) mask |= 1u << bi; }
        if (half == 0) maskl[row] = mask;
    }
    LDS_WAIT(); __builtin_amdgcn_wave_barrier();
    unsigned rmask[2][4]; unsigned anym = 0u;
#pragma unroll
    for (int rt = 0; rt < 2; ++rt)
#pragma unroll
        for (int r = 0; r < 4; ++r) { rmask[rt][r] = maskl[rt * 16 + 4 * fq + r]; }
    { unsigned m = maskl[lane & 31];
#pragma unroll
      for (int o = 1; o < 32; o <<= 1) m |= __shfl_xor(m, o);
      anym = __builtin_amdgcn_readfirstlane(m); }
    bf16x8 qf[2][4];
#pragma unroll
    for (int rt = 0; rt < 2; ++rt)
#pragma unroll
        for (int ks = 0; ks < 4; ++ks) qf[rt][ks] = *(const bf16x8*)(Q + (tokw + rt * 16 + fr) * D + h * HD + ks * 32 + 8 * fq);
    f32x4 oacc[2][8];
#pragma unroll
    for (int rt = 0; rt < 2; ++rt)
#pragma unroll
        for (int dt = 0; dt < 8; ++dt) oacc[rt][dt] = (f32x4){0.f, 0.f, 0.f, 0.f};
    float lsum[2][4];
#pragma unroll
    for (int rt = 0; rt < 2; ++rt)
#pragma unroll
        for (int r = 0; r < 4; ++r) lsum[rt][r] = 0.f;
    const float c2 = 0.08838834764831845f * 1.4426950408889634f;
    const int nkt = 4 * jb + 4;
    for (int kt = 0; kt < nkt; ++kt) {
        const int n = kt >> 2; const bool own = (n == jb);
        if (!own && !((anym >> n) & 1u)) continue;
        if (own && (kt & 3) * 64 > F.wave * 32 + 31) continue;
        const size_t key0 = (size_t)b * T + kt * 64;
        f32x4 sacc[2][4];
#pragma unroll
        for (int ct = 0; ct < 4; ++ct) {
            bf16x8 kf[4];
#pragma unroll
            for (int ks = 0; ks < 4; ++ks) kf[ks] = *(const bf16x8*)(Kb + (key0 + ct * 16 + fr) * D + h * HD + ks * 32 + 8 * fq);
#pragma unroll
            for (int rt = 0; rt < 2; ++rt) { f32x4 s = (f32x4){0.f, 0.f, 0.f, 0.f};
#pragma unroll
                for (int ks = 0; ks < 4; ++ks) s = __builtin_amdgcn_mfma_f32_16x16x32_bf16(qf[rt][ks], kf[ks], s, 0, 0, 0);
                sacc[rt][ct] = s; }
        }
#pragma unroll
        for (int rt = 0; rt < 2; ++rt)
#pragma unroll
            for (int ct = 0; ct < 4; ++ct)
#pragma unroll
                for (int r = 0; r < 4; ++r) {
                    const int qrow = rt * 16 + 4 * fq + r, kcol = ct * 16 + fr;
                    const bool ok = own ? ((kt & 3) * 64 + kcol <= F.wave * 32 + qrow) : ((rmask[rt][r] >> n) & 1u);
                    const float p = ok ? __builtin_amdgcn_exp2f(sacc[rt][ct][r] * c2) : 0.f;
                    lsum[rt][r] += p;
                    pl[qrow * 72 + kcol] = (bf16)f2bf(p);
                }
        LDS_WAIT(); __builtin_amdgcn_wave_barrier();
        bf16x8 pf[2][2];
#pragma unroll
        for (int rt = 0; rt < 2; ++rt)
#pragma unroll
            for (int k2 = 0; k2 < 2; ++k2) pf[rt][k2] = *(const LAS bf16x8*)(pl + (rt * 16 + fr) * 72 + k2 * 32 + 8 * fq);
#pragma unroll
        for (int dt = 0; dt < 8; ++dt) {
            bf16x8 vf[2];
#pragma unroll
            for (int k2 = 0; k2 < 2; ++k2) vf[k2] = *(const bf16x8*)(Vt + (((size_t)b * H + h) * HD + dt * 16 + fr) * T + kt * 64 + k2 * 32 + 8 * fq);
#pragma unroll
            for (int rt = 0; rt < 2; ++rt)
#pragma unroll
                for (int k2 = 0; k2 < 2; ++k2) oacc[rt][dt] = __builtin_amdgcn_mfma_f32_16x16x32_bf16(pf[rt][k2], vf[k2], oacc[rt][dt], 0, 0, 0);
        }
        LDS_WAIT(); __builtin_amdgcn_wave_barrier();
    }
#pragma unroll
    for (int rt = 0; rt < 2; ++rt)
#pragma unroll
        for (int r = 0; r < 4; ++r) { float s = lsum[rt][r]; s += __shfl_xor(s, 1); s += __shfl_xor(s, 2); s += __shfl_xor(s, 4); s += __shfl_xor(s, 8); const float inv = 1.0f / s;
            bf16* orow = OA + (tokw + rt * 16 + 4 * fq + r) * D + h * HD + fr;
#pragma unroll
            for (int dt = 0; dt < 8; ++dt) orow[dt * 16] = (bf16)f2bf(oacc[rt][dt][r] * inv); }
}

typedef float f32x16 __attribute__((ext_vector_type(16)));
template <bool DRY> __device__ __forceinline__ void moba_gate_item(Frame& F, int item) {
    const int bh = item >> 3, p = item & 7, b = bh >> 4, h = bh & 15;
    LAS float* km = (LAS float*)F.lds;
    __syncthreads();
    { const f32x4 v = ((const f32x4*)((const float*)(F.ws + WS_KMEAN) + (size_t)bh * NBLK * HD))[F.tid]; ((LAS f32x4*)km)[F.tid] = v; }
    __syncthreads();
    const int j = 2 * p + (F.wave >> 2), t = j * MBLK + (F.wave & 3) * 64 + F.lane;
    if (j == 0) return;
    const unsigned char* qrow = F.ws + WS_Q + ((size_t)b * T + t) * D + h * HD;
    float g[16];
#pragma unroll
    for (int n = 0; n < 16; ++n) g[n] = 0.f;
    for (int dc = 0; dc < 8; ++dc) {
        const u32x4 w = *(const u32x4*)(qrow + dc * 16);
        float qv[16]; { float t4[4]; fp8x4_to_f32(w.x, t4); qv[0] = t4[0]; qv[1] = t4[1]; qv[2] = t4[2]; qv[3] = t4[3]; fp8x4_to_f32(w.y, t4); qv[4] = t4[0]; qv[5] = t4[1]; qv[6] = t4[2]; qv[7] = t4[3];
            fp8x4_to_f32(w.z, t4); qv[8] = t4[0]; qv[9] = t4[1]; qv[10] = t4[2]; qv[11] = t4[3]; fp8x4_to_f32(w.w, t4); qv[12] = t4[0]; qv[13] = t4[1]; qv[14] = t4[2]; qv[15] = t4[3]; }
#pragma unroll
        for (int n = 0; n < 15; ++n) if (n < j) {
#pragma unroll
            for (int q4 = 0; q4 < 4; ++q4) { const f32x4 k0 = *(const LAS f32x4*)(km + n * HD + dc * 16 + 4 * q4);
                g[n] += (qv[4 * q4] * k0.x + qv[4 * q4 + 1] * k0.y) + (qv[4 * q4 + 2] * k0.z + qv[4 * q4 + 3] * k0.w); } }
    }
    int pk[3];
    unsigned mask = 0u;
#pragma unroll
    for (int pick = 0; pick < 3; ++pick) { float best = -INFINITY; int bi = -1;
#pragma unroll
        for (int n = 0; n < 15; ++n) { const bool ok = (n < j) && !((mask >> n) & 1u); if (ok && g[n] > best) { best = g[n]; bi = n; } }
        if (bi >= 0) mask |= 1u << bi;
        pk[pick] = bi; }
    unsigned* acnt = F.ctl + CW_ACNT + bh * 16; int* alist = (int*)(F.ws + WS_ALIST) + (size_t)bh * 16 * ALIST_CAP;
    unsigned mycnt = 0u;
#pragma unroll
    for (int n = 0; n < 15; ++n) if (n < j) { const unsigned long long bal = __ballot((mask >> n) & 1u); mycnt = (F.lane == n) ? (unsigned)__popcll(bal) : mycnt; }
    unsigned mybase = 0u;
    if (F.lane < 15 && mycnt > 0u && !DRY) mybase = atomicAdd(acnt + F.lane, mycnt);
#pragma unroll
    for (int n = 0; n < 15; ++n) if (n < j) {
        const bool sel = (mask >> n) & 1u; const int slot = (pk[0] == n) ? 0 : ((pk[1] == n) ? 1 : 2);
        const unsigned long long bal = __ballot(sel);
        if (bal) { const unsigned base = (unsigned)__builtin_amdgcn_readlane((int)mybase, n);
            const int rank = __popcll(bal & ((1ull << F.lane) - 1ull));
            if (sel) (DRY ? (int*)(F.ws + WS_OPART) : alist)[n * ALIST_CAP + base + rank] = t | (slot << 16); }
    }
}

constexpr int AL_K = 0, AL_V = 36864; constexpr float SC_P = 4.f;
typedef int i32x8v __attribute__((ext_vector_type(8)));
__device__ __forceinline__ i32x8v ld32(const LAS unsigned char* p) { const u32x4 a = *(const LAS u32x4*)p, b = *(const LAS u32x4*)(p + 16); i32x8v r; r[0] = a.x; r[1] = a.y; r[2] = a.z; r[3] = a.w; r[4] = b.x; r[5] = b.y; r[6] = b.z; r[7] = b.w; return r; }
template <bool OWN> __device__ __forceinline__ void attn_chunk(Frame& F, int b, int h, int n, int c, int cnt, const int* lst) {
    const int lane = F.lane, qi = lane & 31, hh = lane >> 5, w = F.wave;
    const int rem = OWN ? MBLK : cnt - c * 256;
    if (w * 32 >= rem) return;
    int t, slot; bool valid = true;
    if (OWN) { t = n * MBLK + w * 32 + qi; slot = 3; }
    else { const int idx = w * 32 + qi; valid = idx < rem; const int e = lst[c * 256 + (valid ? idx : 0)]; t = e & 0xffff; slot = e >> 16; }
    const size_t tok = (size_t)b * T + t;
    const unsigned char* qrow = F.ws + WS_Q + tok * D + h * HD;
    i32x8v qf[2];
#pragma unroll
    for (int ks = 0; ks < 2; ++ks) { const u32x4 a = *(const u32x4*)(qrow + 64 * ks + 32 * hh), bq = *(const u32x4*)(qrow + 64 * ks + 32 * hh + 16);
        qf[ks][0] = a.x; qf[ks][1] = a.y; qf[ks][2] = a.z; qf[ks][3] = a.w; qf[ks][4] = bq.x; qf[ks][5] = bq.y; qf[ks][6] = bq.z; qf[ks][7] = bq.w; }
    const LAS unsigned char* Kl = F.lds + AL_K; const LAS unsigned char* Vl = F.lds + AL_V;
    f32x16 oacc[4];
#pragma unroll
    for (int dt = 0; dt < 4; ++dt)
#pragma unroll
        for (int r = 0; r < 16; ++r) oacc[dt][r] = 0.f;
    float lsum = 0.f, mrun = -1e30f;
    const float c2 = 0.08838834764831845f * 1.4426950408889634f / (SC_QKV * SC_QKV);
    const int ngrp = OWN ? ((w >> 1) + 1) : 4;
#pragma unroll
    for (int G = 0; G < 4; ++G) {
        if (G >= ngrp) break;
        f32x16 sa, sb;
#pragma unroll
        for (int r = 0; r < 16; ++r) { sa[r] = 0.f; sb[r] = 0.f; }
#pragma unroll
        for (int ks = 0; ks < 2; ++ks) {
            const i32x8v ka = ld32(Kl + (64 * G + qi) * 144 + 64 * ks + 32 * hh), kb = ld32(Kl + (64 * G + 32 + qi) * 144 + 64 * ks + 32 * hh);
            sa = __builtin_amdgcn_mfma_scale_f32_32x32x64_f8f6f4(ka, qf[ks], sa, 0, 0, 0, 0, 0, 0);
            sb = __builtin_amdgcn_mfma_scale_f32_32x32x64_f8f6f4(kb, qf[ks], sb, 0, 0, 0, 0, 0, 0);
        }
        float tv[32];
#pragma unroll
        for (int r = 0; r < 16; ++r) { tv[r] = sa[r]; tv[16 + r] = sb[r]; }
        if (OWN && G == (w >> 1)) {
#pragma unroll
            for (int p = 0; p < 32; ++p) { const int key = 64 * G + 32 * (p >> 4) + (p & 3) + 8 * ((p >> 2) & 3) + 4 * hh; tv[p] = (key <= w * 32 + qi) ? tv[p] : -3e38f; }
        }
        float ml = tv[0];
#pragma unroll
        for (int p = 1; p < 32; ++p) ml = fmaxf(ml, tv[p]);
        ml = fmaxf(ml, __shfl_xor(ml, 32)) * c2;
        const float mnew = (ml > mrun + 6.0f) ? ml : mrun;
        const bool moved = (mnew != mrun);
        const float alpha = __builtin_amdgcn_exp2f(mrun - mnew);
        mrun = mnew;
        float ps = 0.f; i32x8v pf;
#pragma unroll
        for (int q4 = 0; q4 < 8; ++q4) { float e4[4];
#pragma unroll
            for (int j = 0; j < 4; ++j) { e4[j] = __builtin_amdgcn_exp2f(__builtin_fmaf(tv[4 * q4 + j], c2, -mnew)); ps += e4[j]; }
            int pw_ = __builtin_amdgcn_cvt_pk_fp8_f32(e4[0] * SC_P, e4[1] * SC_P, 0, false); pw_ = __builtin_amdgcn_cvt_pk_fp8_f32(e4[2] * SC_P, e4[3] * SC_P, pw_, true); pf[q4] = pw_; }
        lsum = lsum * alpha + ps;
        if (G > 0 && __any(moved)) {
#pragma unroll
            for (int dt = 0; dt < 4; ++dt)
#pragma unroll
                for (int r = 0; r < 16; ++r) oacc[dt][r] *= alpha;
        }
#pragma unroll
        for (int dt = 0; dt < 4; ++dt) {
            const i32x8v vf = ld32(Vl + (32 * dt + qi) * 272 + 64 * G + 32 * hh);
            oacc[dt] = __builtin_amdgcn_mfma_scale_f32_32x32x64_f8f6f4(vf, pf, oacc[dt], 0, 0, 0, 0, 0, 0);
        }
    }
    lsum += __shfl_xor(lsum, 32);
    if (valid) {
        unsigned char* op = F.ws + WS_OPART + ((size_t)slot * M + tok) * D + h * HD;
        const float pinv = __builtin_amdgcn_rcpf(lsum) * (SC_PART / (SC_QKV * SC_P));
        unsigned wq[4][4];
#pragma unroll
        for (int dt = 0; dt < 4; ++dt)
#pragma unroll
            for (int g4 = 0; g4 < 4; ++g4) wq[dt][g4] = pk4_fp8(oacc[dt][4 * g4 + 0] * pinv, oacc[dt][4 * g4 + 1] * pinv, oacc[dt][4 * g4 + 2] * pinv, oacc[dt][4 * g4 + 3] * pinv);
        u32x4 st[4];
#pragma unroll
        for (int d2 = 0; d2 < 2; ++d2)
#pragma unroll
            for (int g4 = 0; g4 < 4; ++g4) { const unsigned give = hh ? wq[d2][g4] : wq[2 + d2][g4], keep = hh ? wq[2 + d2][g4] : wq[d2][g4];
                const unsigned got = (unsigned)__shfl_xor((int)give, 32);
                const unsigned w_even = hh ? got : keep, w_odd = hh ? keep : got;
                st[2 * d2 + (g4 >> 1)][2 * (g4 & 1)] = w_even; st[2 * d2 + (g4 >> 1)][2 * (g4 & 1) + 1] = w_odd; }
#pragma unroll
        for (int q = 0; q < 4; ++q) *(u32x4*)(op + 64 * hh + 16 * q) = st[q];
        if (hh == 0) { f32x2 lm; lm.x = lsum; lm.y = mrun; ((f32x2*)(F.ws + WS_LPART))[((size_t)slot * M + tok) * H + h] = lm; }
    }
}
__device__ __forceinline__ void attn_group(Frame& F, int bh, int n) {
    const int b = bh >> 4, h = bh & 15;
    const gcptr Kg = opaque_s(F.ws + WS_K + ((size_t)b * T + n * MBLK) * D + h * HD);
    const gcptr Vg = opaque_s(F.ws + WS_V + ((size_t)b * T + n * MBLK) * D + h * HD);
    const int tg = make_tid(F.wave);
    __syncthreads();
#pragma unroll
    for (int i = 0; i < 4; ++i) { const int ch = tg + i * 512;
        { const int r = ch >> 3, cc = ch & 7; *(LAS u32x4*)(F.lds + AL_K + r * 144 + cc * 16) = *(const GAS u32x4*)(Kg + (unsigned)(r * D + cc * 16)); }
        { const int rl = ch & 63, cc = (ch >> 6) & 7, G = ch >> 9, r = 64 * G + rl;
          const u32x4 vv = *(const GAS u32x4*)(Vg + (unsigned)(r * D + cc * 16)); const unsigned vw[4] = {vv.x, vv.y, vv.z, vv.w};
          LAS unsigned char* vd = F.lds + AL_V + (16 * cc) * 272 + 64 * G + 32 * ((rl >> 2) & 1) + 4 * (rl >> 3) + (rl & 3);
#pragma unroll
          for (int e = 0; e < 16; ++e) vd[e * 272] = (unsigned char)(vw[e >> 2] >> (8 * (e & 3))); }
    }
    __syncthreads();
    attn_chunk<true>(F, b, h, n, 0, 0, nullptr);
    if (n < 15) {
        const int cnt = (int)__hip_atomic_load(F.ctl + CW_ACNT + bh * 16 + n, __ATOMIC_RELAXED, __HIP_MEMORY_SCOPE_AGENT);
        const int* lst = (const int*)(F.ws + WS_ALIST) + ((size_t)bh * 16 + n) * ALIST_CAP;
        for (int c = 0; c * 256 < cnt; ++c) attn_chunk<false>(F, b, h, n, c, cnt, lst);
    }
}
__device__ __forceinline__ void attn_combine_token(Frame& F, int tok) {
    const int j = (tok & (T - 1)) >> 8, nsl = j < 3 ? j : 3, hd = F.lane >> 2;
    f32x2 lm[4]; float mx = -1e30f;
#pragma unroll
    for (int s4 = 0; s4 < 4; ++s4) { const int s_ = (s4 == 0) ? 3 : s4 - 1; lm[s4] = (f32x2){0.f, -1e30f};
        if (s4 == 0 || s4 - 1 < nsl) { lm[s4] = ((const f32x2*)(F.ws + WS_LPART))[((size_t)s_ * M + tok) * H + hd]; mx = fmaxf(mx, lm[s4].y); } }
    float acc[32]; float l = 0.f;
#pragma unroll
    for (int i = 0; i < 32; ++i) acc[i] = 0.f;
#pragma unroll
    for (int s4 = 0; s4 < 4; ++s4) { const int s_ = (s4 == 0) ? 3 : s4 - 1;
        if (s4 == 0 || s4 - 1 < nsl) {
            const u32x4* p = (const u32x4*)(F.ws + WS_OPART + ((size_t)s_ * M + tok) * D + F.lane * 32);
            const float ls = lm[s4].x * __builtin_amdgcn_exp2f(lm[s4].y - mx);
            const u32x4 w0 = p[0], w1 = p[1]; const unsigned wd[8] = {w0.x, w0.y, w0.z, w0.w, w1.x, w1.y, w1.z, w1.w};
#pragma unroll
            for (int i = 0; i < 8; ++i) { const f32x2 lo = __builtin_amdgcn_cvt_pk_f32_fp8((int)wd[i], false), hi = __builtin_amdgcn_cvt_pk_f32_fp8((int)wd[i], true);
                acc[4 * i] += lo.x * ls; acc[4 * i + 1] += lo.y * ls; acc[4 * i + 2] += hi.x * ls; acc[4 * i + 3] += hi.y * ls; }
            l += ls; } }
    const float inv = __builtin_amdgcn_rcpf(l) * (1.0f / SC_PART);
    if (FP8_OUTB) { const float iv = inv * SC_OA; u32x4* o8 = (u32x4*)(F.ws + WS_OA + (size_t)tok * D + F.lane * 32);
#pragma unroll
        for (int i = 0; i < 2; ++i) { u32x4 w; w.x = pk4_fp8(acc[16 * i] * iv, acc[16 * i + 1] * iv, acc[16 * i + 2] * iv, acc[16 * i + 3] * iv); w.y = pk4_fp8(acc[16 * i + 4] * iv, acc[16 * i + 5] * iv, acc[16 * i + 6] * iv, acc[16 * i + 7] * iv);
            w.z = pk4_fp8(acc[16 * i + 8] * iv, acc[16 * i + 9] * iv, acc[16 * i + 10] * iv, acc[16 * i + 11] * iv); w.w = pk4_fp8(acc[16 * i + 12] * iv, acc[16 * i + 13] * iv, acc[16 * i + 14] * iv, acc[16 * i + 15] * iv); o8[i] = w; }
        return; }
    u32x4* o = (u32x4*)((bf16*)(F.ws + WS_OA) + (size_t)tok * D + F.lane * 32);
#pragma unroll
    for (int i = 0; i < 4; ++i) { u32x4 w; w.x = pk2(acc[8 * i] * inv, acc[8 * i + 1] * inv); w.y = pk2(acc[8 * i + 2] * inv, acc[8 * i + 3] * inv); w.z = pk2(acc[8 * i + 4] * inv, acc[8 * i + 5] * inv); w.w = pk2(acc[8 * i + 6] * inv, acc[8 * i + 7] * inv); o[i] = w; }
}
constexpr size_t WS_SLOC = WS_ORAW;
constexpr size_t WS_DLOG = WS_ORAW + 16 * MiB;
constexpr int HL_A = 0, HL_BM = 17408, HL_BMT = 34816, HL_VT = 53248, HL_SPT = 71680, HL_P = 106496, HL_EGR = 115712, HL_EEND = 116224, HL_QSUM = 116736, HL_SSQ = 118784,
              HL_STQ = HL_SPT, HL_STK = HL_SPT + 17408, HL_STG = 119808, HL_STV = 119808 + 17408;
#define HG_BAR() do { asm volatile("s_waitcnt lgkmcnt(0)" ::: "memory"); __builtin_amdgcn_s_barrier(); asm volatile("" ::: "memory"); } while (0)
template <bool FULL> __device__ __forceinline__ void hgrn_item(Frame& F, CArgs& a, int item) {
    const int bh = item >> 2, seg = item & 3, b = bh >> 4, h = bh & 15;
    if (!FULL && seg == 3) return;
    const int lane = F.lane, qi = lane & 31, hh = lane >> 5, w = F.wave;
    const int kk = F.tid & 127, tq = F.tid >> 7;
    const int vt = w & 3, ktb = 2 * (w >> 2);
    const bf16* Zq = (const bf16*)(F.ws + WS_ZQ); const bf16* Zk = (const bf16*)(F.ws + WS_ZK); const _Float16* Zg = (const _Float16*)(F.ws + WS_ZG); const bf16* Zv = (const bf16*)(F.ws + WS_ZV);
    LAS unsigned char* L = F.lds;
    LAS float* eGr = (LAS float*)(L + HL_EGR); LAS float* eEnd = (LAS float*)(L + HL_EEND); LAS float* qsum = (LAS float*)(L + HL_QSUM); LAS float* ssq = (LAS float*)(L + HL_SSQ);
    f32x16 S[2];
#pragma unroll
    for (int i = 0; i < 2; ++i)
#pragma unroll
        for (int r = 0; r < 16; ++r) S[i][r] = 0.f;
    if (FULL && seg > 0) {
        const float* sl = (const float*)(F.ws + WS_SLOC) + (size_t)bh * 3 * HD * HD; const float* dl = (const float*)(F.ws + WS_DLOG) + (size_t)bh * 3 * HD;
        LAS float* tile = (LAS float*)L; LAS float* fac = (LAS float*)(L + 65536);
        float dsum = 0.f;
        for (int s_ = seg - 1; s_ >= 0; --s_) {
            __syncthreads();
            const f32x4* src = (const f32x4*)(sl + (size_t)s_ * HD * HD);
#pragma unroll
            for (int i = 0; i < 8; ++i) ((LAS f32x4*)tile)[F.tid + i * 512] = src[F.tid + i * 512];
            if (F.tid < 128) { fac[F.tid] = __expf(dsum); dsum += dl[s_ * HD + F.tid]; }
            __syncthreads();
            const LAS float* tl = tile + (4 * hh) * HD + 32 * vt + qi; const LAS float* fl = fac + 4 * hh;
#pragma unroll
            for (int i = 0; i < 2; ++i)
#pragma unroll
                for (int r = 0; r < 16; ++r) { const int dkc = 32 * (ktb + i) + (r & 3) + 8 * (r >> 2); S[i][r] += fl[dkc] * tl[dkc * HD]; }
        }
    }
    float gtot = 0.f;
    u32x4 rq[2], rk[2], rg[2], rv[2];
#define HG_PREFETCH(cc) do { const size_t tk_ = (size_t)b * T + (size_t)(seg * 16 + (cc)) * 64; _Pragma("unroll") for (int i_ = 0; i_ < 2; ++i_) { const int row_ = 16 * (w >> 1) + (lane >> 3) + 8 * i_, ch_ = 8 * (w & 1) + (lane & 7); const size_t go_ = (tk_ + row_) * D + h * HD + ch_ * 8; \
        rk[i_] = *(const u32x4*)(Zk + go_); rg[i_] = *(const u32x4*)((const bf16*)Zg + go_); rv[i_] = *(const u32x4*)(Zv + go_); if (FULL) rq[i_] = *(const u32x4*)(Zq + go_); } } while (0)
    HG_PREFETCH(0);
    __syncthreads();
    for (int c = 0; c < 16; ++c) {
        const size_t tok0 = (size_t)b * T + (size_t)(seg * 16 + c) * 64;
#pragma unroll
        for (int i = 0; i < 2; ++i) { const int so = (16 * (w >> 1) + (lane >> 3) + 8 * i) * 272 + (8 * (w & 1) + (lane & 7)) * 16;
            *(LAS u32x4*)(L + HL_STK + so) = rk[i]; *(LAS u32x4*)(L + HL_STG + so) = rg[i]; *(LAS u32x4*)(L + HL_STV + so) = rv[i]; if (FULL) *(LAS u32x4*)(L + HL_STQ + so) = rq[i]; }
        LDS_WAIT();
        float gl[16];
        { float run = 0.f;
#pragma unroll
            for (int i = 0; i < 16; ++i) { run += (float)*(const LAS _Float16*)(L + HL_STG + (16 * tq + i) * 272 + kk * 2); gl[i] = run; }
            qsum[tq * 128 + kk] = run; }
        HG_BAR();
        {
            const float q0 = qsum[kk], q1 = qsum[128 + kk], q2 = qsum[256 + kk], q3 = qsum[384 + kk];
            const float pre = (tq > 0 ? q0 : 0.f) + (tq > 1 ? q1 : 0.f) + (tq > 2 ? q2 : 0.f), Gr = q0 + q1, Gend = (q0 + q1) + (q2 + q3);
            unsigned bt[8], vtw[8];
#pragma unroll
            for (int i = 0; i < 16; i += 2) {
                const int t0 = 16 * tq + i;
                const float G0 = pre + gl[i], G1 = pre + gl[i + 1];
                const float eb0 = __expf(Gr - G0), eb1 = __expf(Gr - G1);
                const float b0 = bf2f(*(const LAS bf16*)(L + HL_STK + t0 * 272 + kk * 2)) * eb0, b1 = bf2f(*(const LAS bf16*)(L + HL_STK + (t0 + 1) * 272 + kk * 2)) * eb1;
                bt[i >> 1] = pk2(b0, b1);
                vtw[i >> 1] = (unsigned)*(const LAS bf16*)(L + HL_STV + t0 * 272 + kk * 2) | ((unsigned)*(const LAS bf16*)(L + HL_STV + (t0 + 1) * 272 + kk * 2) << 16);
                if (FULL) { const float ea0 = __expf(G0 - Gr), ea1 = __expf(G1 - Gr);
                    const float qa = bf2f(*(const LAS bf16*)(L + HL_STQ + t0 * 272 + kk * 2)), qb = bf2f(*(const LAS bf16*)(L + HL_STQ + (t0 + 1) * 272 + kk * 2));
                    *(LAS bf16*)(L + HL_A + t0 * 272 + kk * 2) = (bf16)f2bf(qa * ea0); *(LAS bf16*)(L + HL_A + (t0 + 1) * 272 + kk * 2) = (bf16)f2bf(qb * ea1);
                    *(LAS bf16*)(L + HL_BM + t0 * 272 + kk * 2) = (bf16)(bt[i >> 1] & 0xffffu); *(LAS bf16*)(L + HL_BM + (t0 + 1) * 272 + kk * 2) = (bf16)(bt[i >> 1] >> 16); }
                __builtin_amdgcn_sched_barrier(0);
            }
            *(LAS u32x4*)(L + HL_BMT + kk * 144 + tq * 32) = (u32x4){bt[0], bt[1], bt[2], bt[3]}; *(LAS u32x4*)(L + HL_BMT + kk * 144 + tq * 32 + 16) = (u32x4){bt[4], bt[5], bt[6], bt[7]};
            *(LAS u32x4*)(L + HL_VT + kk * 144 + tq * 32) = (u32x4){vtw[0], vtw[1], vtw[2], vtw[3]}; *(LAS u32x4*)(L + HL_VT + kk * 144 + tq * 32 + 16) = (u32x4){vtw[4], vtw[5], vtw[6], vtw[7]};
            if (tq == 0) { eGr[kk] = __expf(Gr); eEnd[kk] = __expf(Gend - Gr); }
            gtot += Gend;
        }
        HG_BAR();
        if (c + 1 < 16) HG_PREFETCH(c + 1);
#pragma unroll
        for (int i = 0; i < 2; ++i)
#pragma unroll
            for (int g4 = 0; g4 < 4; ++g4) { const int dk0 = 32 * (ktb + i) + 8 * g4 + 4 * hh; const f32x4 e = *(const LAS f32x4*)(eGr + dk0);
#pragma unroll
                for (int j = 0; j < 4; ++j) S[i][4 * g4 + j] *= e[j];
                if (FULL) { u32x2 wv; wv.x = pg8::cvt_pk_bf16_n(S[i][4 * g4], S[i][4 * g4 + 1]); wv.y = pg8::cvt_pk_bf16_n(S[i][4 * g4 + 2], S[i][4 * g4 + 3]);
                    *(LAS u32x2*)(L + HL_SPT + (32 * vt + qi) * 272 + dk0 * 2) = wv; } }
        if (FULL && w < 3) {
            const int st = (w == 2) ? 1 : 0, tt = (w == 0) ? 0 : 1;
            f32x16 sc;
#pragma unroll
            for (int r = 0; r < 16; ++r) sc[r] = 0.f;
#pragma unroll
            for (int ks = 0; ks < 8; ++ks) { const bf16x8 af = *(const LAS bf16x8*)(L + HL_BM + (32 * st + qi) * 272 + (16 * ks + 8 * hh) * 2); const bf16x8 bfr = *(const LAS bf16x8*)(L + HL_A + (32 * tt + qi) * 272 + (16 * ks + 8 * hh) * 2);
                sc = __builtin_amdgcn_mfma_f32_32x32x16_bf16(af, bfr, sc, 0, 0, 0); }
#pragma unroll
            for (int g4 = 0; g4 < 4; ++g4) { const int s0 = 32 * st + 8 * g4 + 4 * hh, t = 32 * tt + qi; float p[4];
#pragma unroll
                for (int j = 0; j < 4; ++j) p[j] = sc[4 * g4 + j] * __builtin_amdgcn_fmed3f((float)(t - (s0 + j) + 1), 0.f, 1.f);
                u32x2 wv; wv.x = pg8::cvt_pk_bf16_n(p[0], p[1]); wv.y = pg8::cvt_pk_bf16_n(p[2], p[3]);
                *(LAS u32x2*)(L + HL_P + t * 144 + s0 * 2) = wv; }
        }
#pragma unroll
        for (int ks2 = 0; ks2 < 4; ++ks2) { const bf16x8 vf = *(const LAS bf16x8*)(L + HL_VT + (32 * vt + qi) * 144 + (16 * ks2 + 8 * hh) * 2);
#pragma unroll
            for (int i = 0; i < 2; ++i) { const bf16x8 bf_ = *(const LAS bf16x8*)(L + HL_BMT + (32 * (ktb + i) + qi) * 144 + (16 * ks2 + 8 * hh) * 2);
                S[i] = __builtin_amdgcn_mfma_f32_32x32x16_bf16(bf_, vf, S[i], 0, 0, 0); } }
#pragma unroll
        for (int i = 0; i < 2; ++i)
#pragma unroll
            for (int g4 = 0; g4 < 4; ++g4) { const int dk0 = 32 * (ktb + i) + 8 * g4 + 4 * hh; const f32x4 e = *(const LAS f32x4*)(eEnd + dk0);
#pragma unroll
                for (int j = 0; j < 4; ++j) S[i][4 * g4 + j] *= e[j]; }
        if (FULL) {
            HG_BAR();
            const int tt = w & 1, dt = w >> 1, t = 32 * tt + qi;
            f32x16 o;
#pragma unroll
            for (int r = 0; r < 16; ++r) o[r] = 0.f;
#pragma unroll
            for (int ks = 0; ks < 8; ++ks) { const bf16x8 af = *(const LAS bf16x8*)(L + HL_SPT + (32 * dt + qi) * 272 + (16 * ks + 8 * hh) * 2); const bf16x8 bfr = *(const LAS bf16x8*)(L + HL_A + t * 272 + (16 * ks + 8 * hh) * 2);
                o = __builtin_amdgcn_mfma_f32_32x32x16_bf16(af, bfr, o, 0, 0, 0); }
#pragma unroll
            for (int ks2 = 0; ks2 < 4; ++ks2) if (ks2 < 2 * (tt + 1)) { const bf16x8 af = *(const LAS bf16x8*)(L + HL_VT + (32 * dt + qi) * 144 + (16 * ks2 + 8 * hh) * 2); const bf16x8 bfr = *(const LAS bf16x8*)(L + HL_P + t * 144 + (16 * ks2 + 8 * hh) * 2);
                o = __builtin_amdgcn_mfma_f32_32x32x16_bf16(af, bfr, o, 0, 0, 0); }
            float sq = 0.f;
#pragma unroll
            for (int r = 0; r < 16; ++r) sq += o[r] * o[r];
            sq += __shfl_xor(sq, 32);
            if (hh == 0) ssq[dt * 64 + t] = sq;
            HG_BAR();
            const float tot = (ssq[t] + ssq[64 + t]) + (ssq[128 + t] + ssq[192 + t]);
            const float rstd = __builtin_amdgcn_rsqf(tot * (1.f / HD) + RMS_EPS);
            const size_t ro = (tok0 + t) * D + h * HD;
#pragma unroll
            for (int g4 = 0; g4 < 4; ++g4) { const int dv0 = 32 * dt + 8 * g4 + 4 * hh;
                const u32x2 gt = *(const u32x2*)((const bf16*)(F.ws + WS_ZGATE) + ro + dv0); const f32x4 gn = *(const f32x4*)(a.in[I_A_OGAIN] + dv0);
                u32x2 wv; wv.x = pg8::cvt_pk_bf16_n(o[4 * g4] * rstd * gn.x * bflo(gt.x), o[4 * g4 + 1] * rstd * gn.y * bfhi(gt.x)); wv.y = pg8::cvt_pk_bf16_n(o[4 * g4 + 2] * rstd * gn.z * bflo(gt.y), o[4 * g4 + 3] * rstd * gn.w * bfhi(gt.y));
                *(u32x2*)((bf16*)(F.ws + WS_OH) + ro + dv0) = wv; }
        }
    }
#undef HG_PREFETCH
    if (!FULL) {
        float* sl = (float*)(F.ws + WS_SLOC) + ((size_t)bh * 3 + seg) * HD * HD;
#pragma unroll
        for (int i = 0; i < 2; ++i)
#pragma unroll
            for (int r = 0; r < 16; ++r) { const int dk = 32 * (ktb + i) + (r & 3) + 8 * (r >> 2) + 4 * hh; sl[(size_t)dk * HD + 32 * vt + qi] = S[i][r]; }
        if (tq == 0) ((float*)(F.ws + WS_DLOG))[((size_t)bh * 3 + seg) * HD + kk] = gtot;
    }
    __syncthreads();
}

constexpr int N_PHASES = 19;
#ifndef REP_MASK
#define REP_MASK 0
#endif
#define NREP(k) ((((REP_MASK) >> (k)) & 1) ? 2 : 1)
__global__ void __launch_bounds__(NTHR, 2) fwd(Args args_kernarg) {
    extern __shared__ __attribute__((aligned(16))) unsigned char lds_raw[];
    Frame F;
    CArgs* pa = (CArgs*)__builtin_amdgcn_kernarg_segment_ptr();
#define args (*pa)
    F.lds = (LAS unsigned char*)lds_raw; F.ws = args.ws; F.ctl = (unsigned*)(args.ws + WS_CTL);
    F.wave = __builtin_amdgcn_readfirstlane((int)threadIdx.x >> 6); F.tid = make_tid(F.wave); F.lane = F.tid & 63;
    F.G = gridDim.x; { const int bx = blockIdx.x; F.vcu = (F.G % 8 == 0) ? (bx % 8) * (F.G / 8) + bx / 8 : bx; }
    F.gw = F.vcu * NWAVES + F.wave; F.NGW = F.G * NWAVES;
    for (int u = F.tid; u < (LDS_BYTES - LDSCTL_OFF) / 4; u += NTHR) ((LAS unsigned*)(F.lds + LDSCTL_OFF))[u] = 0u;
    __syncthreads();
    const int lo = args.ph_lo, hi = args.ph_hi;
    const bool multi = (hi - lo) > 1;
    XcdBarrier bar; bar.bar = F.ctl + CW_BAR; bar.x = 0; bar.st = nullptr;
    if (multi) bar = xcd_barrier_post(F.ctl + CW_BAR, (volatile LAS unsigned*)(F.lds + LDSCTL_OFF), F.tid);
#define REFRESH() do { pa = (CArgs*)__builtin_amdgcn_kernarg_segment_ptr(); asm volatile("" : "+s"(pa)); ws = args.ws; F.ws = ws; F.ctl = (unsigned*)(ws + WS_CTL); const int t_ = make_tid(F.wave); F.tid = t_; F.lane = t_ & 63; F.gw = F.vcu * NWAVES + F.wave; } while (0)
#define IN(k) (lo <= (k) && (k) < hi)
#define SEAM(k) do { if (IN(k) && IN((k) + 1)) xcd_barrier(bar, make_tid(F.wave)); } while (0)
    unsigned char* ws = args.ws;
    (void)args_kernarg;
    const int GT = F.NGW * 64;

    if (IN(0)) _Pragma("unroll") for (int rep_ = 0; rep_ < NREP(0); ++rep_) { REFRESH();
        const int gtid = F.gw * 64 + F.lane;
        LAS float* scr = (LAS float*)(F.lds + F.wave * TR_SCR_BYTES);
        constexpr int J0 = 16 * 256;
        tr_run([&](int it) { TrItem t; t.src = args.in[I_A_W_IN]; t.ksc = args.in[I_NORM_MIX]; t.dst = ws + WS_WIN; t.N = 4 * D; t.K = D; t.k0 = 128 * (it / 256); t.n0 = 32 * (it % 256); t.drow0 = t.n0; t.flags = 0; t.osc = 1.f; return t; },
               F.gw, J0, F.NGW, scr, F.lane);
        for (int c = gtid; c < D; c += GT) { const float* L = args.in[I_A_LB]; const float l0 = L[c], l1 = L[D + c], l2 = L[2 * D + c]; const float mx = fmaxf(l0, fmaxf(l1, l2));
            const float e0 = expf(l0 - mx), e1 = expf(l1 - mx), e2 = expf(l2 - mx); ((float*)(ws + WS_LB))[c] = e0 / (e0 + e1 + e2); }
        for (int i = gtid; i < 2 * 36 * D; i += GT) { const int l = i / (36 * D), r = (i / D) % 36, k = i % D;
            ((float*)(ws + WS_RT))[i] = r < 4 ? args.in[I_W_GROUP][((size_t)l * D + k) * NG + r] : args.in[I_W_EXPERT][((size_t)l * D + k) * NE + (r - 4)]; }
        { const int fi = gtid & 63; const float inv = exp2f(-(float)fi * (13.287712379549449f / 64.0f));
          for (int i = gtid; i < T * 64; i += GT) { const float ang = (float)(i >> 6) * inv; float sn_, cs_; sincosf(ang, &sn_, &cs_); ((f32x2*)(ws + WS_ROPE))[i] = (f32x2){cs_, sn_}; } }
        for (int m = F.gw; m < M; m += F.NGW) rms_row_to_bf16(args.in[I_X] + (size_t)m * D, (bf16*)(ws + WS_XN) + (size_t)m * D, F.lane);
    }
    SEAM(0);
    if (IN(1)) _Pragma("unroll") for (int rep_ = 0; rep_ < NREP(1); ++rep_) { REFRESH();
        constexpr int NCV = 112, J1 = 16 * 64, J2 = 16 * 128, J3 = 16 * 64, J4 = 16 * 64, J5 = MOE_CV_ITEMS;
        if ((int)blockIdx.x < NCV) {
            LAS float* scr = (LAS float*)(F.lds + F.wave * TR_SCR_BYTES);
            tr_run([&](int r) { TrItem t; t.osc = 1.f; t.ksc = nullptr; t.flags = 0; t.N = D; t.K = D;
                    if (r < J1) { t.src = args.in[I_A_W_OUT]; t.dst = ws + WS_WOA; t.k0 = 128 * (r / 64); t.n0 = 32 * (r % 64); t.drow0 = t.n0; return t; } r -= J1;
                    if (r < J2) { const int nb = r % 128; t.src = args.in[I_KV_W]; t.ksc = args.in[I_KV_NORM]; t.dst = ws + WS_WQKV; t.N = 2 * D; t.k0 = 128 * (r / 128); t.n0 = 32 * nb; t.drow0 = D + t.n0;
                                  t.flags = (FP8_QKV ? 2 : 0) | (nb < 64 ? 1 : 0); t.osc = FP8_QKV ? SC_W : 1.f; return t; } r -= J2;
                    if (r < J3) { t.src = args.in[I_B_W_Q]; t.ksc = args.in[I_NORM_MIX] + D; t.dst = ws + WS_WQKV; t.k0 = 128 * (r / 64); t.n0 = 32 * (r % 64); t.drow0 = t.n0; t.flags = (FP8_QKV ? 2 : 0) | 1; t.osc = FP8_QKV ? SC_W : 1.f; return t; } r -= J3;
                    if (r < J4) { t.src = args.in[I_B_W_OUT]; t.dst = ws + WS_WOB; t.k0 = 128 * (r / 64); t.n0 = 32 * (r % 64); t.drow0 = t.n0; t.flags = FP8_OUTB ? 2 : 0; t.osc = FP8_OUTB ? SC_W : 1.f; return t; } r -= J4;
                    return moe_cv_item(args, ws, 0, r); },
                   (int)blockIdx.x * NWAVES + F.wave, J1 + J2 + J3 + J4 + J5, NCV * NWAVES, scr, F.lane);
            __syncthreads();
        }
        pg8::DynOrder S; S.init(ws + WS_XN, ws + WS_WIN, M, 4 * D, D, F.wave, F.ctl + CW_DYN, (LAS int*)(F.lds + LDSCTL_OFF + 32));
        pg8::EpiHgrnIn E{ws + WS_R, (const float*)(ws + WS_LB)};
        pg8::gemm_phase<pg8::EpiHgrnIn, pg8::DynOrder, true>(F.lds, S, E);
    }
    SEAM(1);
    if (IN(2)) _Pragma("unroll") for (int rep_ = 0; rep_ < NREP(2); ++rep_) { REFRESH(); for (int it = F.vcu; it < 256; it += F.G) hgrn_item<false>(F, args, it); }
    SEAM(2);
    if (IN(3)) _Pragma("unroll") for (int rep_ = 0; rep_ < NREP(3); ++rep_) { REFRESH(); for (int it = F.vcu; it < 256; it += F.G) hgrn_item<true>(F, args, it); }
    SEAM(3);
    if (IN(4)) _Pragma("unroll") for (int rep_ = 0; rep_ < NREP(4); ++rep_) { REFRESH();
        pg8::DenseOrder S; S.init(ws + WS_OH, ws + WS_WOA, M, D, D, F.G, (int)blockIdx.x, F.wave);
        pg8::EpiRes16<true> E{(bf16*)(ws + WS_XR), args.in[I_X], 1.0f};
        pg8::gemm_phase<pg8::EpiRes16<true>, pg8::DenseOrder, true>(F.lds, S, E);
    }
    SEAM(4);
#define MOE_LAYER(P, layer, F8, O8) \
    if (IN(P)) { REFRESH(); REFRESH(); if (NREP(P) == 2) { for (int t = F.gw; t < M; t += F.NGW) route_token<true, F8>(F, args, layer, t); } for (int t = F.gw; t < M; t += F.NGW) route_token<false, F8>(F, args, layer, t); } \
    SEAM(P); \
    if (IN((P) + 1)) _Pragma("unroll") for (int rep_ = 0; rep_ < NREP((P) + 1); ++rep_) { REFRESH(); const int nrb = __builtin_amdgcn_readfirstlane(moe_tables(F, layer)); \
        pg8::MoeOrder<true> S; S.A = (const char*)(ws + WS_XN); S.B = (const char*)(ws + WS_WGU + (size_t)(layer) * WGU_LSTRIDE); S.estride = (size_t)1024 * D * (F8 ? 1 : 2); S.K = D; S.RB = F8 ? D : 2 * D; S.NT = 4; S.total = nrb * 4; S.G = F.G; S.c = F.vcu; S.wv = F.wave; \
        S.blk_e = (const LAS int*)(F.lds + LT_BLKE); S.blkstart = (const LAS int*)(F.lds + LT_BLKSTART); S.cnt = (const LAS int*)(F.lds + LT_CNT); S.list = (const int*)(ws + WS_LISTS); \
        pg8::EpiSwiGLU<F8> E{(bf16*)(ws + WS_ACT), F8 ? 1.0f / (SC_XN * SC_W) : 1.0f}; \
        pg8::gemm_phase<pg8::EpiSwiGLU<F8>, pg8::MoeOrder<true>, true, F8>(F.lds, S, E); } \
    SEAM((P) + 1); \
    if (IN((P) + 2)) _Pragma("unroll") for (int rep_ = 0; rep_ < NREP((P) + 2); ++rep_) { REFRESH(); const int nrb = __builtin_amdgcn_readfirstlane(moe_tables(F, layer)); \
        pg8::MoeOrder<false> S; S.A = (const char*)(ws + WS_ACT); S.B = (const char*)(ws + WS_WD + (size_t)(layer) * WD_LSTRIDE); S.estride = (size_t)D * FF * (F8 ? 1 : 2); S.K = FF; S.RB = F8 ? FF : 2 * FF; S.NT = 8; S.total = nrb * 8; S.G = F.G; S.c = F.vcu; S.wv = F.wave; \
        S.blk_e = (const LAS int*)(F.lds + LT_BLKE); S.blkstart = (const LAS int*)(F.lds + LT_BLKSTART); S.cnt = (const LAS int*)(F.lds + LT_CNT); S.list = (const int*)(ws + WS_LISTS); \
        if constexpr (O8) { pg8::EpiOut8 E{ws + WS_OUTB, D, (F8 ? 1.0f / (SC_ACT * SC_WD) : 1.0f) * SC_OUT}; pg8::gemm_phase<pg8::EpiOut8, pg8::MoeOrder<false>, true, F8>(F.lds, S, E); } \
        else { pg8::EpiBf16 E{(bf16*)(ws + WS_OUTB), D, 0, 0, F8 ? 1.0f / (SC_ACT * SC_WD) : 1.0f}; pg8::gemm_phase<pg8::EpiBf16, pg8::MoeOrder<false>, true, F8>(F.lds, S, E); } } \
    SEAM((P) + 2);
    MOE_LAYER(5, 0, FP8_MOE0, OUT8_L0)
    if (IN(8)) { REFRESH();
        (void)moe_tables(F, 0);
        if (NREP(8) == 2) { for (int t = F.gw; t < M; t += F.NGW) combine_token<true, true, OUT8_L0>(F, args, t); }
        for (int t = F.gw; t < M; t += F.NGW) combine_token<true, false, OUT8_L0>(F, args, t);
    }
    SEAM(8);
    if (IN(9)) _Pragma("unroll") for (int rep_ = 0; rep_ < NREP(9); ++rep_) { REFRESH();
        constexpr int NCV2 = 112;
        if ((int)blockIdx.x < NCV2) {
            LAS float* scr = (LAS float*)(F.lds + F.wave * TR_SCR_BYTES);
            tr_run([&](int it) { return moe_cv_item(args, ws, 1, it); }, (int)blockIdx.x * NWAVES + F.wave, MOE_CV_ITEMS, NCV2 * NWAVES, scr, F.lane);
            __syncthreads();
        }
        pg8::DynOrder S; S.init(ws + WS_XN, ws + WS_WQKV, M, 3 * D, D, F.wave, F.ctl + CW_DYN + 64, (LAS int*)(F.lds + LDSCTL_OFF + 32), FP8_QKV);
        pg8::EpiQKV E{(bf16*)(ws + WS_Q), (bf16*)(ws + WS_K), (bf16*)(ws + WS_V), args.in[I_B_Q_NORM], args.in[I_K_NORM], (const f32x2*)(ws + WS_ROPE), (float*)(ws + WS_KMEAN), F.lds + 131072, FP8_QKV ? 1.0f / (SC_XN * SC_W) : 1.0f, F.wave};
        pg8::gemm_phase<pg8::EpiQKV, pg8::DynOrder, true, FP8_QKV>(F.lds, S, E);
    }
    SEAM(9);
    if (IN(11)) { REFRESH(); if (NREP(11) == 2) { for (int it = F.vcu; it < 64 * 8; it += F.G) moba_gate_item<true>(F, it); } for (int it = F.vcu; it < 64 * 8; it += F.G) moba_gate_item<false>(F, it); }
    SEAM(11);
    if (IN(12)) _Pragma("unroll") for (int rep_ = 0; rep_ < NREP(12); ++rep_) { REFRESH();
        for (int v = F.vcu; v < 256; v += F.G) { const int bh = v >> 2, q = v & 3;
            _Pragma("unroll 1") for (int gi = 0; gi < 4; ++gi) { const int n = (gi == 0) ? q : ((gi == 1) ? 7 - q : ((gi == 2) ? 8 + q : 15 - q)); attn_group(F, bh, n); } }
    }
    SEAM(12);
    if (IN(13)) _Pragma("unroll") for (int rep_ = 0; rep_ < NREP(13); ++rep_) { REFRESH(); for (int t = F.gw; t < M; t += F.NGW) attn_combine_token(F, t); }
    SEAM(13);
    if (IN(14)) { REFRESH();
        pg8::DenseOrder S; S.init(ws + WS_OA, ws + WS_WOB, M, D, D, F.G, (int)blockIdx.x, F.wave, FP8_OUTB);
        pg8::EpiRes16<false> E{(bf16*)(ws + WS_XR), nullptr, FP8_OUTB ? 1.0f / (SC_OA * SC_W) : 1.0f};
        pg8::gemm_phase<pg8::EpiRes16<false>, pg8::DenseOrder, true, FP8_OUTB>(F.lds, S, E);
    }
    SEAM(14);
    MOE_LAYER(15, 1, FP8_MOE1, OUT8_L1)
    if (IN(18)) { REFRESH(); (void)moe_tables(F, 1); for (int t = F.gw; t < M; t += F.NGW) combine_token<false, false, OUT8_L1>(F, args, t); }
#undef IN
#undef SEAM
#undef MOE_LAYER
#undef args
}

#ifndef MK_N_LAUNCHES
#define MK_N_LAUNCHES 1
#endif
#ifndef DBG_STOP
#define DBG_STOP N_PHASES
#endif
extern "C" void kernel_launch(void* const* d_in, const int* in_sizes, int n_in, void* d_out, int out_size, void* d_ws, size_t ws_size, hipStream_t stream) {
    static int grid = 0;
    if (grid == 0) {
        if (n_in != 20 || in_sizes[0] != M * D || out_size != M * D || ws_size < WS_END) { fprintf(stderr, "kernel_launch: unexpected shapes (n_in %d, in0 %d, out %d, ws %zu < %zu); nothing launched\n", n_in, n_in > 0 ? in_sizes[0] : -1, out_size, ws_size, (size_t)WS_END); grid = -1; return; }
        int dev = 0, cus = 0, per_cu = 0;
        if (hipGetDevice(&dev) != hipSuccess || hipDeviceGetAttribute(&cus, hipDeviceAttributeMultiprocessorCount, dev) != hipSuccess) { grid = -1; return; }
        if (hipFuncSetAttribute((const void*)fwd, hipFuncAttributeMaxDynamicSharedMemorySize, LDS_BYTES) != hipSuccess) { fprintf(stderr, "kernel_launch: hipFuncSetAttribute failed\n"); grid = -1; return; }
        if (hipOccupancyMaxActiveBlocksPerMultiprocessor(&per_cu, (const void*)fwd, NTHR, LDS_BYTES) != hipSuccess || per_cu < 1) { fprintf(stderr, "kernel_launch: occupancy query says %d blocks per CU\n", per_cu); }
        (void)hipGetLastError();
        grid = cus;
    }
    if (grid < 0) return;
    (void)hipMemsetAsync((char*)d_ws + WS_CTL, 0, CTL_ZERO_BYTES, stream);
    Args a{};
    for (int i = 0; i < 20; ++i) a.in[i] = (const float*)d_in[i];
    a.out = (float*)d_out; a.ws = (unsigned char*)d_ws;
    if (MK_N_LAUNCHES == 1) { a.ph_lo = 0; a.ph_hi = N_PHASES; hipLaunchKernelGGL(fwd, dim3(grid), dim3(NTHR), LDS_BYTES, stream, a); }
    else for (int p = 0; p < DBG_STOP; ++p) { a.ph_lo = p; a.ph_hi = p + 1; hipLaunchKernelGGL(fwd, dim3(grid), dim3(NTHR), LDS_BYTES, stream, a); }
}
```

```cpp
#include <hip/hip_runtime.h>
#include <cstdio>
#include <cstdint>

#define GAS __attribute__((address_space(1)))
#define LAS __attribute__((address_space(3)))
typedef unsigned short bf16;
typedef short bf16x8 __attribute__((ext_vector_type(8)));
typedef float f32x4 __attribute__((ext_vector_type(4)));
typedef float f32x2 __attribute__((ext_vector_type(2)));
typedef unsigned u32x4 __attribute__((ext_vector_type(4)));
typedef unsigned u32x2 __attribute__((ext_vector_type(2)));

constexpr int BATCH = 4, T = 4096, D = 2048, M = BATCH * T, H = 16, HD = 128;
constexpr int NBLK = 16, MBLK = 256;
constexpr int NG = 4, EPG = 8, NE = 32, FF = 512;
constexpr float RMS_EPS = 1e-6f;
constexpr int NWAVES = 8, NTHR = 512;
constexpr int LIST_CAP = 16384;
constexpr int MAXRB = 160;

constexpr size_t MiB = 1u << 20;
constexpr size_t WS_CTL = 0, CTL_ZERO_BYTES = 1 * MiB;
constexpr size_t WS_LISTS = 1 * MiB;
constexpr size_t WS_TOKREC = 3 * MiB;
constexpr size_t WS_LB = 4 * MiB;
constexpr size_t WS_RT = 4 * MiB + 65536;
constexpr size_t WS_ROPE = 5 * MiB;
constexpr size_t WS_KMEAN = 7 * MiB;
constexpr size_t WS_WIN = 8 * MiB, WS_WOA = 40 * MiB, WS_WQKV = 48 * MiB, WS_WOB = 72 * MiB;
constexpr size_t WS_WGU = 80 * MiB, WS_WD = 208 * MiB;
constexpr size_t WS_XN = 272 * MiB;
constexpr size_t WS_ACT = 336 * MiB;
constexpr size_t WS_R = 376 * MiB;
constexpr size_t WS_ZQ = WS_R, WS_ZK = WS_R + 64 * MiB, WS_ZG = WS_R + 128 * MiB, WS_ZV = WS_R + 192 * MiB, WS_ZGATE = WS_R + 256 * MiB;
constexpr size_t WS_ORAW = WS_R + 320 * MiB;
constexpr size_t WS_OH = WS_R + 448 * MiB;
constexpr size_t WS_OUTB = WS_R;
constexpr size_t WS_Q = WS_R, WS_K = WS_R + 64 * MiB, WS_V = WS_R + 128 * MiB, WS_VT = WS_R + 192 * MiB, WS_OA = WS_R + 256 * MiB;
constexpr size_t WS_XR = WS_R + 192 * MiB;
constexpr size_t WS_OPART = WS_R + 320 * MiB;
constexpr size_t WS_LPART = WS_R + 576 * MiB;
constexpr size_t WS_ALIST = WS_R + 584 * MiB;
constexpr int ALIST_CAP = 3840;
constexpr size_t WS_END = WS_R + 604 * MiB;
constexpr int CW_TMO = 0;
constexpr int CW_BAR = 4096;
constexpr int CW_CNT = 8192;
#define CW_CNT_AT(l, e) (CW_CNT + 2048 * (l) + 64 * (e))
constexpr int CW_ACNT = 16384;
constexpr int CW_DYN = 20480;

constexpr int RING_BYTES = 159744;
constexpr int LDSCTL_OFF = RING_BYTES;
constexpr int LT_BLKE = LDSCTL_OFF + 64;
constexpr int LT_BLKSTART = LT_BLKE + MAXRB * 4;
constexpr int LT_CNT = LT_BLKSTART + 36 * 4;
constexpr int LT_END = LT_CNT + 32 * 4;
constexpr int LDS_BYTES = 163840;
static_assert(LT_END <= LDS_BYTES, "LDS map");

__device__ __forceinline__ unsigned f2bf(float f) { unsigned u = __builtin_bit_cast(unsigned, f); return (u + 0x7fffu + ((u >> 16) & 1u)) >> 16; }
__device__ __forceinline__ unsigned pk2(float lo, float hi) { return f2bf(lo) | (f2bf(hi) << 16); }
__device__ __forceinline__ float bf2f(unsigned b) { return __builtin_bit_cast(float, b << 16); }
__device__ __forceinline__ float bflo(unsigned w) { return __builtin_bit_cast(float, w << 16); }
__device__ __forceinline__ float bfhi(unsigned w) { return __builtin_bit_cast(float, w & 0xffff0000u); }
__device__ __forceinline__ float wave_sum(float v) {
#pragma unroll
    for (int o = 1; o < 64; o <<= 1) v += __shfl_xor(v, o);
    return v;
}
#ifndef FP8_QKV
#define FP8_QKV 1
#endif
#ifndef FP8_OUTB
#define FP8_OUTB 1
#endif
#ifndef FP8_MOE1
#define FP8_MOE1 1
#endif
#ifndef FP8_MOE0
#define FP8_MOE0 1
#endif
#ifndef OUT8_L0
#define OUT8_L0 1
#endif
#ifndef OUT8_L1
#define OUT8_L1 1
#endif
constexpr float SC_XN = 16.f, SC_W = 1024.f, SC_ACT = 8.f, SC_WD = 512.f, SC_OA = 64.f, SC_PART = 64.f, SC_OUT = 32.f, SC_QKV = 32.f;
__device__ __forceinline__ unsigned pk4_fp8(float a, float b, float c, float d) {
    a = __builtin_amdgcn_fmed3f(a, -448.f, 448.f); b = __builtin_amdgcn_fmed3f(b, -448.f, 448.f); c = __builtin_amdgcn_fmed3f(c, -448.f, 448.f); d = __builtin_amdgcn_fmed3f(d, -448.f, 448.f);
    int p = __builtin_amdgcn_cvt_pk_fp8_f32(a, b, 0, false); p = __builtin_amdgcn_cvt_pk_fp8_f32(c, d, p, true); return (unsigned)p; }
__device__ __forceinline__ int lane_id() { int l; asm volatile("v_mbcnt_lo_u32_b32 %0, -1, 0\n\tv_mbcnt_hi_u32_b32 %0, -1, %0" : "=v"(l)); return l; }
__device__ __forceinline__ int make_tid(int wv) { return wv * 64 + lane_id(); }
__device__ __forceinline__ void fp8x4_to_f32(unsigned w, float (&o)[4]) { const f32x2 lo = __builtin_amdgcn_cvt_pk_f32_fp8((int)w, false), hi = __builtin_amdgcn_cvt_pk_f32_fp8((int)w, true); o[0] = lo.x; o[1] = lo.y; o[2] = hi.x; o[3] = hi.y; }
#define LDS_WAIT() asm volatile("s_waitcnt lgkmcnt(0)" ::: "memory")
#define VM_WAIT() asm volatile("s_waitcnt vmcnt(0)" ::: "memory")

namespace pg8 {
constexpr int BM = 256, BK = 64, HALF = 128, HTB = HALF * BK * 2, STAGE_BYTES = 8 * HTB, NXCD = 8, WGM = 8;
__host__ __device__ __forceinline__ int lds_byte(int r, int c) { const int st = (r >> 4) * 2 + (c >> 5), rr = r & 15, cc = c & 31, ob = rr * 64 + cc * 2; return st * 1024 + (ob ^ (((ob >> 9) & 1) << 5)); }
__host__ __device__ __forceinline__ void stage_rc(int b, int& R, int& C) { const int st = b / 1024, sb = b % 1024, swz = sb ^ (((sb >> 9) & 1) << 5); R = (st >> 1) * 16 + swz / 64; C = (st & 1) * 32 + (swz % 64) / 2; }
__host__ __device__ __forceinline__ int perm32(int rho) { const int n = rho >> 4, i = rho & 15; return 8 * (i >> 2) + 4 * n + (i & 3); }

struct Unit { int pm, pn; const char* a; const char* b; int e0, lbase, cnt; };

struct DenseOrder {
    static constexpr bool GATHER = false, DYNAMIC = false;
    const char* A; const char* B; int K, RB; int nM, nN, nwg, G, c, wv;
    __device__ void init(const void* A_, const void* B_, int M_, int N_, int K_, int G_, int c_, int wv_, bool fp8 = false) { wv = wv_; A = (const char*)A_; B = (const char*)B_; K = K_; RB = fp8 ? K_ : 2 * K_; nM = M_ / BM; nN = N_ / BM; nwg = nM * nN; G = G_; c = c_; }
    __device__ __forceinline__ bool next(int i, Unit& u) const {
        const int L = i * G + c; if (L >= nwg) return false;
        int wgid = (int)L; { const int q = nwg / NXCD, r = nwg % NXCD, xcd = wgid % NXCD, off = wgid / NXCD; wgid = (xcd < r ? xcd * (q + 1) : r * (q + 1) + (xcd - r) * q) + off; }
        const int nig = WGM * nN, gid = wgid / nig, fm = gid * WGM, gsz = (nM - fm) < WGM ? (nM - fm) : WGM;
        u.pm = fm + ((wgid % nig) % gsz); u.pn = (wgid % nig) / gsz;
        u.a = A + (size_t)u.pm * BM * RB; u.b = B + (size_t)u.pn * BM * RB; u.e0 = 0; u.lbase = 0; u.cnt = 0; return true;
    }
    __device__ __forceinline__ unsigned row_off(const Unit&, int) const { return 0u; }
};
struct DynOrder {
    static constexpr bool GATHER = false, DYNAMIC = true;
    const char* A; const char* B; int K, RB; int nM, nN, nwg, wv; unsigned* counter; LAS int* slot;
    __device__ void init(const void* A_, const void* B_, int M_, int N_, int K_, int wv_, unsigned* counter_, LAS int* slot_, bool fp8 = false) { wv = wv_; A = (const char*)A_; B = (const char*)B_; K = K_; RB = fp8 ? K_ : 2 * K_; nM = M_ / BM; nN = N_ / BM; nwg = nM * nN; counter = counter_; slot = slot_; }
    __device__ __forceinline__ void map(int L, Unit& u) const {
        int wgid = L; { const int q = nwg / NXCD, r = nwg % NXCD, xcd = wgid % NXCD, off = wgid / NXCD; wgid = (xcd < r ? xcd * (q + 1) : r * (q + 1) + (xcd - r) * q) + off; }
        const int nig = WGM * nN, gid = wgid / nig, fm = gid * WGM, gsz = (nM - fm) < WGM ? (nM - fm) : WGM;
        u.pm = fm + ((wgid % nig) % gsz); u.pn = (wgid % nig) / gsz;
        u.a = A + (size_t)u.pm * BM * RB; u.b = B + (size_t)u.pn * BM * RB; u.e0 = 0; u.lbase = 0; u.cnt = 0;
    }
    __device__ __forceinline__ int fetch() const { return (int)__hip_atomic_fetch_add(counter, 1u, __ATOMIC_RELAXED, __HIP_MEMORY_SCOPE_AGENT); }
    __device__ __forceinline__ bool next(int, Unit&) const { return false; }
    __device__ __forceinline__ unsigned row_off(const Unit&, int) const { return 0u; }
};
template <bool GATHER_> struct MoeOrder {
    static constexpr bool GATHER = GATHER_, DYNAMIC = false;
    const char* A; const char* B; size_t estride; int K, RB, NT, total, G, c, wv;
    const LAS int* blk_e; const LAS int* blkstart; const LAS int* cnt; const int* list;
    __device__ __forceinline__ bool next(int i, Unit& u) const {
        const int L = i * G + c; if (L >= total) return false;
        const int rb = (int)L / NT, pn = (int)L % NT, e = blk_e[rb];
        u.pm = rb; u.pn = pn; u.e0 = e; u.lbase = (rb - blkstart[e]) * BM; u.cnt = cnt[e];
        u.a = GATHER ? A : A + (size_t)rb * BM * RB; u.b = B + (size_t)e * estride + (size_t)pn * BM * RB; return true;
    }
    __device__ __forceinline__ unsigned row_off(const Unit& u, int r) const { const int loc = u.lbase + r; const int t = list[u.e0 * LIST_CAP + (loc < u.cnt ? loc : 0)]; return (unsigned)t * (unsigned)RB; }
};

typedef __bf16 bf16n2 __attribute__((ext_vector_type(2)));
__device__ __forceinline__ unsigned cvt_pk_bf16_n(float lo, float hi) { const f32x2 v = {lo, hi}; return __builtin_bit_cast(unsigned, __builtin_convertvector(v, bf16n2)); }
__device__ __forceinline__ unsigned cvt_pk_bf16(float lo, float hi) { unsigned r; asm volatile("v_cvt_pk_bf16_f32 %0, %1, %2" : "=v"(r) : "v"(lo), "v"(hi)); return r; }

struct EpiBf16 {
    static constexpr bool PERM = true;
    bf16* O; int ldc; int split_cols; size_t split_stride; float osc;
    __device__ __forceinline__ void operator()(const f32x4 (&acc)[2][2][4][2], const Unit& u, int wr, int wc, int fr, int fq) const {
        const int row0 = u.pm * BM + wr * 64 + fr; int colt = u.pn * BM; bf16* base = O;
        if (split_cols) { const int t = colt / split_cols; base += (size_t)t * split_stride; colt -= t * split_cols; }
        const int col0 = colt + wc * 32 + 8 * fq;
#pragma unroll
        for (int ai = 0; ai < 2; ++ai)
#pragma unroll
            for (int m = 0; m < 4; ++m) { bf16* rowp = base + (size_t)(row0 + ai * HALF + m * 16) * ldc + col0;
#pragma unroll
                for (int bj = 0; bj < 2; ++bj) { const f32x4 v0 = acc[ai][bj][m][0] * osc, v1 = acc[ai][bj][m][1] * osc;
                    u32x4 w; w.x = cvt_pk_bf16(v0[0], v0[1]); w.y = cvt_pk_bf16(v0[2], v0[3]); w.z = cvt_pk_bf16(v1[0], v1[1]); w.w = cvt_pk_bf16(v1[2], v1[3]);
                    *(u32x4*)(rowp + bj * HALF) = w; } }
    }
};
struct EpiResF32 {
    static constexpr bool PERM = false;
    float* C; const float* R; int ldc; float osc;
    __device__ __forceinline__ void operator()(const f32x4 (&acc)[2][2][4][2], const Unit& u, int wr, int wc, int fr, int fq) const {
        const int row0 = u.pm * BM + wr * 64 + fr, col0 = u.pn * BM + wc * 32 + 4 * fq;
#pragma unroll
        for (int ai = 0; ai < 2; ++ai)
#pragma unroll
            for (int m = 0; m < 4; ++m) { const size_t ro = (size_t)(row0 + ai * HALF + m * 16) * ldc + col0;
#pragma unroll
                for (int bj = 0; bj < 2; ++bj)
#pragma unroll
                    for (int n = 0; n < 2; ++n) { const f32x4 r = *(const f32x4*)(R + ro + bj * HALF + n * 16); *(f32x4*)(C + ro + bj * HALF + n * 16) = acc[ai][bj][m][n] * osc + r; } }
    }
};
struct EpiOut8 {
    static constexpr bool PERM = true;
    unsigned char* O; int ldc; float osc;
    __device__ __forceinline__ void operator()(const f32x4 (&acc)[2][2][4][2], const Unit& u, int wr, int wc, int fr, int fq) const {
        const int row0 = u.pm * BM + wr * 64 + fr, col0 = u.pn * BM + wc * 32 + 8 * fq;
#pragma unroll
        for (int ai = 0; ai < 2; ++ai)
#pragma unroll
            for (int m = 0; m < 4; ++m) { unsigned char* rowp = O + (size_t)(row0 + ai * HALF + m * 16) * ldc + col0;
#pragma unroll
                for (int bj = 0; bj < 2; ++bj) { const f32x4 v0 = acc[ai][bj][m][0] * osc, v1 = acc[ai][bj][m][1] * osc;
                    u32x2 w; w.x = pk4_fp8(v0[0], v0[1], v0[2], v0[3]); w.y = pk4_fp8(v1[0], v1[1], v1[2], v1[3]);
                    *(u32x2*)(rowp + bj * HALF) = w; } }
    }
};
template <bool SRC32> struct EpiRes16 {
    static constexpr bool PERM = true;
    bf16* XR; const float* R32; float osc;
    __device__ __forceinline__ void operator()(const f32x4 (&acc)[2][2][4][2], const Unit& u, int wr, int wc, int fr, int fq) const {
        const int row0 = u.pm * BM + wr * 64 + fr, col0 = u.pn * BM + wc * 32 + 8 * fq;
#pragma unroll
        for (int ai = 0; ai < 2; ++ai)
#pragma unroll
            for (int m = 0; m < 4; ++m) { const size_t ro = (size_t)(row0 + ai * HALF + m * 16) * D + col0;
#pragma unroll
                for (int bj = 0; bj < 2; ++bj) { float r[8];
                    if (SRC32) { const f32x4 a = *(const f32x4*)(R32 + ro + bj * HALF), b = *(const f32x4*)(R32 + ro + bj * HALF + 4);
#pragma unroll
                        for (int j = 0; j < 4; ++j) { r[j] = a[j]; r[4 + j] = b[j]; } }
                    else { const u32x4 w = *(const u32x4*)(XR + ro + bj * HALF); r[0] = bflo(w.x); r[1] = bfhi(w.x); r[2] = bflo(w.y); r[3] = bfhi(w.y); r[4] = bflo(w.z); r[5] = bfhi(w.z); r[6] = bflo(w.w); r[7] = bfhi(w.w); }
                    const f32x4 v0 = acc[ai][bj][m][0] * osc, v1 = acc[ai][bj][m][1] * osc;
                    u32x4 o; o.x = cvt_pk_bf16(v0[0] + r[0], v0[1] + r[1]); o.y = cvt_pk_bf16(v0[2] + r[2], v0[3] + r[3]); o.z = cvt_pk_bf16(v1[0] + r[4], v1[1] + r[5]); o.w = cvt_pk_bf16(v1[2] + r[6], v1[3] + r[7]);
                    *(u32x4*)(XR + ro + bj * HALF) = o; } }
    }
};
__device__ __forceinline__ float sigmoidf_(float z) { return __builtin_amdgcn_rcpf(1.0f + __expf(-z)); }
template <bool OUT8> struct EpiSwiGLU {
    static constexpr bool PERM = true;
    bf16* O; float osc;
    __device__ __forceinline__ void operator()(const f32x4 (&acc)[2][2][4][2], const Unit& u, int wr, int wc, int fr, int fq) const {
        const int row0 = u.pm * BM + wr * 64 + fr, col0 = u.pn * HALF + wc * 32 + 8 * fq;
#pragma unroll
        for (int ai = 0; ai < 2; ++ai)
#pragma unroll
            for (int m = 0; m < 4; ++m) { const size_t eo = (size_t)(row0 + ai * HALF + m * 16) * FF + col0;
                float o[8];
#pragma unroll
                for (int n = 0; n < 2; ++n)
#pragma unroll
                    for (int j = 0; j < 4; ++j) { const float g = acc[ai][0][m][n][j] * osc, up = acc[ai][1][m][n][j] * osc; o[4 * n + j] = g * sigmoidf_(g) * up; }
                if (OUT8) { u32x2 w; w.x = pk4_fp8(o[0] * SC_ACT, o[1] * SC_ACT, o[2] * SC_ACT, o[3] * SC_ACT); w.y = pk4_fp8(o[4] * SC_ACT, o[5] * SC_ACT, o[6] * SC_ACT, o[7] * SC_ACT); *(u32x2*)((unsigned char*)O + eo) = w; }
                else { u32x4 w; w.x = cvt_pk_bf16(o[0], o[1]); w.y = cvt_pk_bf16(o[2], o[3]); w.z = cvt_pk_bf16(o[4], o[5]); w.w = cvt_pk_bf16(o[6], o[7]); *(u32x4*)(O + eo) = w; } }
    }
};
typedef _Float16 h8 __attribute__((ext_vector_type(8)));
struct EpiHgrnIn {
    static constexpr bool PERM = true;
    unsigned char* zb; const float* lb;
    __device__ __forceinline__ void operator()(const f32x4 (&acc)[2][2][4][2], const Unit& u, int wr, int wc, int fr, int fq) const {
        const int quarter = u.pn >> 3, row0 = u.pm * BM + wr * 64 + fr, col0 = (u.pn & 7) * BM + wc * 32 + 8 * fq;
        if (quarter == 1) {
            float lbv[2][8];
#pragma unroll
            for (int bj = 0; bj < 2; ++bj) { const f32x4 a = *(const f32x4*)(lb + col0 + bj * HALF), b = *(const f32x4*)(lb + col0 + bj * HALF + 4);
#pragma unroll
                for (int j = 0; j < 4; ++j) { lbv[bj][j] = a[j]; lbv[bj][4 + j] = b[j]; } }
#pragma unroll
            for (int ai = 0; ai < 2; ++ai)
#pragma unroll
                for (int m = 0; m < 4; ++m) { const size_t ro = (size_t)(row0 + ai * HALF + m * 16) * D + col0;
#pragma unroll
                    for (int bj = 0; bj < 2; ++bj) { float kk[8]; h8 hv;
#pragma unroll
                        for (int n = 0; n < 2; ++n)
#pragma unroll
                            for (int j = 0; j < 4; ++j) { const float z = acc[ai][bj][m][n][j], l = lbv[bj][4 * n + j];
                                const float k1 = (1.0f - l) * __builtin_amdgcn_rcpf(1.0f + __expf(z));
                                kk[4 * n + j] = k1; hv[4 * n + j] = (_Float16)__logf(1.0f - k1); }
                        u32x4 w; w.x = cvt_pk_bf16(kk[0], kk[1]); w.y = cvt_pk_bf16(kk[2], kk[3]); w.z = cvt_pk_bf16(kk[4], kk[5]); w.w = cvt_pk_bf16(kk[6], kk[7]);
                        *(u32x4*)((bf16*)(zb + (64u << 20)) + ro + bj * HALF) = w;
                        *(h8*)((_Float16*)(zb + (128u << 20)) + ro + bj * HALF) = hv; } }
        } else {
            const size_t zo = quarter == 0 ? 0u : (quarter == 2 ? (size_t)(192u << 20) : (size_t)(256u << 20)); bf16* dst = (bf16*)(zb + zo);
#pragma unroll
            for (int ai = 0; ai < 2; ++ai)
#pragma unroll
                for (int m = 0; m < 4; ++m) { const size_t ro = (size_t)(row0 + ai * HALF + m * 16) * D + col0;
#pragma unroll
                    for (int bj = 0; bj < 2; ++bj) { float o[8];
#pragma unroll
                        for (int n = 0; n < 2; ++n)
#pragma unroll
                            for (int j = 0; j < 4; ++j) { const float z = acc[ai][bj][m][n][j]; o[4 * n + j] = (quarter == 3) ? z * sigmoidf_(z) : z; }
                        u32x4 w; w.x = cvt_pk_bf16(o[0], o[1]); w.y = cvt_pk_bf16(o[2], o[3]); w.z = cvt_pk_bf16(o[4], o[5]); w.w = cvt_pk_bf16(o[6], o[7]);
                        *(u32x4*)(dst + ro + bj * HALF) = w; } }
        }
    }
};

struct EpiQKV {
    static constexpr bool PERM = true;
    bf16* Q; bf16* Kd; bf16* V; const float* qg; const float* kg; const f32x2* rope; float* kmean; LAS unsigned char* xl; float osc; int wv;
    __device__ __forceinline__ void operator()(const f32x4 (&acc)[2][2][4][2], const Unit& u, int wr, int wc, int fr, int fq) const {
        const int sec = u.pn >> 3, row0 = u.pm * BM + wr * 64 + fr;
        if (sec == 2) {
            const int col0 = (u.pn & 7) * BM + wc * 32 + 8 * fq; const float vs = osc * SC_QKV;
#pragma unroll
            for (int ai = 0; ai < 2; ++ai)
#pragma unroll
                for (int m = 0; m < 4; ++m) { unsigned char* rowp = (unsigned char*)V + (size_t)(row0 + ai * HALF + m * 16) * D + col0;
#pragma unroll
                    for (int bj = 0; bj < 2; ++bj) { const f32x4 v0 = acc[ai][bj][m][0] * vs, v1 = acc[ai][bj][m][1] * vs;
                        u32x2 w; w.x = pk4_fp8(v0[0], v0[1], v0[2], v0[3]); w.y = pk4_fp8(v1[0], v1[1], v1[2], v1[3]);
                        *(u32x2*)(rowp + bj * HALF) = w; } }
            return;
        }
        LAS float* X = (LAS float*)xl;
        LAS float* Y = (LAS float*)(xl + 8192);
#pragma unroll
        for (int ai = 0; ai < 2; ++ai)
#pragma unroll
            for (int m = 0; m < 4; ++m)
#pragma unroll
                for (int bj = 0; bj < 2; ++bj) { const f32x4 a = acc[ai][bj][m][0], b = acc[ai][bj][m][1];
                    float s = ((a[0] * a[0] + a[1] * a[1]) + (a[2] * a[2] + a[3] * a[3]) + (b[0] * b[0] + b[1] * b[1]) + (b[2] * b[2] + b[3] * b[3])) * (osc * osc);
                    s += __shfl_xor(s, 16); s += __shfl_xor(s, 32);
                    if (fq == 0) X[((ai * HALF + wr * 64 + m * 16 + fr) * 2 + bj) * 4 + wc] = s; }
        asm volatile("s_waitcnt lgkmcnt(0)" ::: "memory"); __builtin_amdgcn_s_barrier(); asm volatile("" ::: "memory");
        const float* gain = sec ? kg : qg; bf16* dst = sec ? Kd : Q;
#pragma unroll
        for (int ai = 0; ai < 2; ++ai)
#pragma unroll
            for (int m = 0; m < 4; ++m) { const int rl = ai * HALF + wr * 64 + m * 16 + fr, pos = (u.pm & 15) * BM + rl;
                const f32x4 g0 = *(const f32x4*)(gain + 16 * wc + 4 * fq), g1 = *(const f32x4*)(gain + 64 + 16 * wc + 4 * fq);
                const f32x4 r0 = *(const f32x4*)(rope + pos * 64 + 16 * wc + 4 * fq), r1 = *(const f32x4*)(rope + pos * 64 + 16 * wc + 4 * fq + 2);
                const float cc[4] = {r0[0], r0[2], r1[0], r1[2]}, sn[4] = {r0[1], r0[3], r1[1], r1[3]};
#pragma unroll
                for (int bj = 0; bj < 2; ++bj) { const f32x4 p = *(const LAS f32x4*)(X + (rl * 2 + bj) * 4);
                    const float rstd = __builtin_amdgcn_rsqf(((p[0] + p[1]) + (p[2] + p[3])) * (1.f / 128) + RMS_EPS);
                    float o[8];
#pragma unroll
                    for (int j = 0; j < 4; ++j) { const float y1 = acc[ai][bj][m][0][j] * (rstd * osc) * g0[j], y2 = acc[ai][bj][m][1][j] * (rstd * osc) * g1[j]; o[j] = y1 * cc[j] - y2 * sn[j]; o[4 + j] = y2 * cc[j] + y1 * sn[j]; }
                    unsigned char* p0 = (unsigned char*)dst + (size_t)(u.pm * BM + rl) * D + ((u.pn & 7) * 2 + bj) * 128 + 16 * wc + 4 * fq;
                    *(unsigned*)p0 = pk4_fp8(o[0] * SC_QKV, o[1] * SC_QKV, o[2] * SC_QKV, o[3] * SC_QKV); *(unsigned*)(p0 + 64) = pk4_fp8(o[4] * SC_QKV, o[5] * SC_QKV, o[6] * SC_QKV, o[7] * SC_QKV);
                    if (sec == 1) {
#pragma unroll
                        for (int j = 0; j < 8; ++j) { float sv = o[j]; sv += __shfl_xor(sv, 1); sv += __shfl_xor(sv, 2); sv += __shfl_xor(sv, 4); sv += __shfl_xor(sv, 8); o[j] = sv; }
                        if (fr == 0) { LAS float* yp = Y + ((((wr * 2 + ai) * 4 + m) * 2 + bj) * 128) + 16 * wc + 4 * fq; *(LAS f32x4*)yp = (f32x4){o[0], o[1], o[2], o[3]}; *(LAS f32x4*)(yp + 64) = (f32x4){o[4], o[5], o[6], o[7]}; }
                    } }
                asm volatile("" ::: "memory"); }
        if (sec == 1) {
            asm volatile("s_waitcnt lgkmcnt(0)" ::: "memory"); __builtin_amdgcn_s_barrier(); asm volatile("" ::: "memory");
            const int tid = make_tid(wv);
            if (tid < 256) { const int bj = tid >> 7, d = tid & 127; const int b = u.pm >> 4, nb = u.pm & 15, head = (u.pn & 7) * 2 + bj;
                float sm = 0.f;
#pragma unroll
                for (int q = 0; q < 16; ++q) sm += Y[(q * 2 + bj) * 128 + d];
                float* kmb = kmean; asm volatile("" : "+s"(kmb));
                ((GAS float*)kmb)[((b * H + head) * NBLK + nb) * HD + d] = sm * (1.0f / 256); }
        }
    }
};

__device__ __forceinline__ void glds_saddr(const char* sbase, unsigned voff, unsigned lds_dst) {
    unsigned keep;
    asm volatile("s_mov_b32 %0, m0\n\ts_mov_b32 m0, %3\n\ts_nop 4\n\tglobal_load_lds_dwordx4 %1, %2\n\ts_mov_b32 m0, %0" : "=&s"(keep) : "v"(voff), "s"(sbase), "s"(lds_dst) : "memory");
}
typedef int i32x4 __attribute__((ext_vector_type(4)));
typedef int i32x8 __attribute__((ext_vector_type(8)));
__device__ __forceinline__ i32x8 cat8(bf16x8 lo, bf16x8 hi) { const i32x4 a = __builtin_bit_cast(i32x4, lo), b = __builtin_bit_cast(i32x4, hi); return __builtin_shufflevector(a, b, 0, 1, 2, 3, 4, 5, 6, 7); }
template <class Epi, class Sched, bool ALIGN_EPI, bool FP8 = false>
__device__ __forceinline__ void gemm_phase(LAS unsigned char* lds, const Sched& S, const Epi& E) {
    const int tid = make_tid(S.wv), wid = __builtin_amdgcn_readfirstlane(tid >> 6), lane = tid & 63, wr = wid >> 2, wc = wid & 3, fr = lane & 15, fq = lane >> 4;
    const int K = S.K, RB = S.RB, nt = RB / (BK * 2);
    unsigned voffA[2], voffB[2];
#pragma unroll
    for (int i = 0; i < 2; ++i) { int R, C; stage_rc(tid * 16 + i * 8192, R, C); const int Rb = Epi::PERM ? ((R & ~31) + perm32(R & 31)) : R;
        voffA[i] = (unsigned)(R * RB + C * 2); voffB[i] = (unsigned)(Rb * RB + C * 2); }
    const size_t kstep = (size_t)(BK * 2);
    const size_t hstep = (size_t)HALF * RB;
    const unsigned ldsw = (unsigned)wid * 1024u, ldsb = (unsigned)(size_t)lds;
    const int aoff = lds_byte(wr * 64 + fr, fq * 8), boff = lds_byte(wc * 32 + fr, fq * 8);
#define PG8_SA(b, h) (((b) * 2 + (h)) * HTB)
#define PG8_SB(b, h) ((4 + (b) * 2 + (h)) * HTB)
#define PG8_STAGE(bufoff, gbase, voff) do { _Pragma("unroll") for (int _i = 0; _i < 2; ++_i) glds_saddr((const char*)(gbase), (voff)[_i], ldsb + (unsigned)(bufoff) + ldsw + _i * 8192u); } while (0)
#define PG8_GOFS(pp, h, i) (gofs + ((((pp) * 2 + (h)) * 2 + (i)) * 512))
#define PG8_STAGE_A(bufoff, sel, h, ko) do { if constexpr (Sched::GATHER) { const int _pp = (sel) ? (pc ^ 1) : pc; unsigned _v[2]; _v[0] = PG8_GOFS(_pp, h, 0)[tid]; _v[1] = PG8_GOFS(_pp, h, 1)[tid]; PG8_STAGE(bufoff, S.A + (ko), _v); } \
        else { PG8_STAGE(bufoff, ((sel) ? nA : cA) + (h) * hstep + (ko), voffA); } } while (0)
#define PG8_LDA(dst, b, h) do { _Pragma("unroll") for (int m = 0; m < 4; ++m) { if constexpr (FP8) dst##8[m] = cat8(*(const LAS bf16x8*)(lds + PG8_SA(b, h) + aoff + m * 2048), *(const LAS bf16x8*)(lds + PG8_SA(b, h) + aoff + m * 2048 + 1024)); \
        else { _Pragma("unroll") for (int k = 0; k < 2; ++k) dst[m][k] = *(const LAS bf16x8*)(lds + PG8_SA(b, h) + aoff + m * 2048 + k * 1024); } } } while (0)
#define PG8_LDB(dst, b, h) do { _Pragma("unroll") for (int n = 0; n < 2; ++n) { if constexpr (FP8) dst##8[n] = cat8(*(const LAS bf16x8*)(lds + PG8_SB(b, h) + boff + n * 2048), *(const LAS bf16x8*)(lds + PG8_SB(b, h) + boff + n * 2048 + 1024)); \
        else { _Pragma("unroll") for (int k = 0; k < 2; ++k) dst[n][k] = *(const LAS bf16x8*)(lds + PG8_SB(b, h) + boff + n * 2048 + k * 1024); } } } while (0)
#define PG8_MMA(ai, bj, At, Bt) do { __builtin_amdgcn_s_setprio(1); _Pragma("unroll") for (int m = 0; m < 4; ++m) _Pragma("unroll") for (int n = 0; n < 2; ++n) { if constexpr (FP8) { \
        acc[ai][bj][m][n] = __builtin_amdgcn_mfma_scale_f32_16x16x128_f8f6f4(Bt##8[n], At##8[m], acc[ai][bj][m][n], 0, 0, 0, 0, 0, 0); } else { _Pragma("unroll") for (int k = 0; k < 2; ++k) \
        acc[ai][bj][m][n] = __builtin_amdgcn_mfma_f32_16x16x32_bf16(Bt[n][k], At[m][k], acc[ai][bj][m][n], 0, 0, 0); } } __builtin_amdgcn_s_setprio(0); } while (0)
#define PG8_WAIT_V(n) asm volatile("s_waitcnt vmcnt(" #n ")" ::: "memory")
#define PG8_WAIT_L(n) asm volatile("s_waitcnt lgkmcnt(" #n ")" ::: "memory")
#define PG8_BAR __builtin_amdgcn_s_barrier()
#define PG8_SCHED __builtin_amdgcn_sched_barrier(0)
    Unit cur, nxt; int ui = 0; int dyn_pend = 0;
    if constexpr (Sched::DYNAMIC) {
        if (wid == 0) { int v2 = 0; if (lane == 0) { const int v0 = S.fetch(), v1 = S.fetch(); v2 = S.fetch(); S.slot[0] = v0; S.slot[1] = v1; } dyn_pend = __builtin_amdgcn_readfirstlane(v2); }
        PG8_WAIT_L(0); PG8_BAR;
        const int L0 = __builtin_amdgcn_readfirstlane(S.slot[0]); if (L0 >= S.nwg) return;
        S.map(L0, cur);
    } else { if (!S.next(0, cur)) return; }
    LAS unsigned* gofs = (LAS unsigned*)(lds + 131072); int pc = 0;
#define PG8_WRITE_GOFS(pp, U) do { int _t = tid; asm volatile("" : "+v"(_t)); _Pragma("unroll") for (int _i = 0; _i < 2; ++_i) { int _R, _C; stage_rc(_t * 16 + _i * 8192, _R, _C); \
        _Pragma("unroll") for (int _h = 0; _h < 2; ++_h) PG8_GOFS(pp, _h, _i)[_t] = S.row_off(U, _h * HALF + _R) + (unsigned)_C * 2u; } } while (0)
    if constexpr (Sched::GATHER) PG8_WRITE_GOFS(0, cur);
    f32x4 acc[2][2][4][2];
#pragma unroll
    for (int a = 0; a < 2; ++a)
#pragma unroll
        for (int b = 0; b < 2; ++b)
#pragma unroll
            for (int m = 0; m < 4; ++m)
#pragma unroll
                for (int n = 0; n < 2; ++n) acc[a][b][m][n] = (f32x4){0.f, 0.f, 0.f, 0.f};
    bf16x8 At[4][2], B0[2][2], B1[2][2]; i32x8 At8[4], B08[2], B18[2];
    const char* cA = cur.a; const char* cB = cur.b; const char* nA = cA; const char* nB = cB;
    PG8_STAGE(PG8_SB(0, 0), cB, voffB); PG8_STAGE(PG8_SB(0, 1), cB + hstep, voffB); PG8_STAGE_A(PG8_SA(0, 0), false, 0, 0); PG8_STAGE_A(PG8_SA(0, 1), false, 1, 0);
    if (wr == 1) PG8_BAR;
    PG8_WAIT_V(2); PG8_BAR;
    PG8_STAGE(PG8_SB(1, 0), cB + kstep, voffB); PG8_STAGE_A(PG8_SA(1, 0), false, 0, kstep); PG8_STAGE(PG8_SB(1, 1), cB + hstep + kstep, voffB);
    PG8_WAIT_V(6); PG8_BAR;
    for (;;) {
        bool has_next = true;
        if constexpr (Sched::DYNAMIC) {
            if (ui >= 1 && wid == 0) { int v = 0; if (lane == 0) { S.slot[(ui + 1) % 3] = dyn_pend; v = S.fetch(); } dyn_pend = __builtin_amdgcn_readfirstlane(v); }
        } else { has_next = S.next(ui + 1, nxt); nA = has_next ? nxt.a : cA; nB = has_next ? nxt.b : cB; }
        if constexpr (Sched::GATHER) { if (has_next) PG8_WRITE_GOFS(pc ^ 1, nxt); else PG8_WRITE_GOFS(pc ^ 1, cur); }
        for (int t = 0; t < nt; t += 2) {
            const bool last = (t == nt - 2);
            if constexpr (Sched::DYNAMIC) { if (last) { const int Ln = __builtin_amdgcn_readfirstlane(S.slot[(ui + 1) % 3]); has_next = Ln < S.nwg; if (has_next) S.map(Ln, nxt); nA = has_next ? nxt.a : cA; nB = has_next ? nxt.b : cB; } }
            const size_t k1 = (size_t)(t + 1) * kstep;
            const size_t k2 = last ? 0 : (size_t)(t + 2) * kstep, k3 = k2 + kstep;
            const char* b2 = (last ? nB : cB) + k2; const char* b3 = b2 + kstep;
            PG8_LDB(B0, 0, 0); PG8_LDB(B1, 0, 1); PG8_SCHED; PG8_LDA(At, 0, 0); PG8_STAGE_A(PG8_SA(1, 1), false, 1, k1);
            PG8_WAIT_V(8); PG8_WAIT_L(0); PG8_BAR; PG8_MMA(0, 0, At, B0); PG8_MMA(0, 1, At, B1); PG8_BAR; PG8_SCHED;
            PG8_LDA(At, 0, 1); PG8_STAGE(PG8_SB(0, 0), b2, voffB); PG8_STAGE(PG8_SB(0, 1), b2 + hstep, voffB); PG8_STAGE_A(PG8_SA(0, 0), last, 0, k2);
            PG8_WAIT_V(8); PG8_WAIT_L(0); PG8_BAR; PG8_MMA(1, 0, At, B0); PG8_MMA(1, 1, At, B1); PG8_BAR; PG8_SCHED;
            PG8_LDB(B0, 1, 0); PG8_LDB(B1, 1, 1); PG8_SCHED; PG8_LDA(At, 1, 0); PG8_STAGE_A(PG8_SA(0, 1), last, 1, k2);
            PG8_WAIT_V(8); PG8_WAIT_L(0); PG8_BAR; PG8_MMA(0, 0, At, B0); PG8_MMA(0, 1, At, B1); PG8_BAR; PG8_SCHED;
            PG8_LDA(At, 1, 1); PG8_STAGE(PG8_SB(1, 0), b3, voffB); PG8_STAGE(PG8_SB(1, 1), b3 + hstep, voffB); PG8_STAGE_A(PG8_SA(1, 0), last, 0, k3);
            PG8_WAIT_V(8); PG8_WAIT_L(0); PG8_BAR; PG8_MMA(1, 0, At, B0); PG8_MMA(1, 1, At, B1); PG8_BAR; PG8_SCHED;
        }
        if constexpr (ALIGN_EPI) { if (wr == 0) PG8_BAR; }
        { const int l2_ = lane_id(); E(acc, cur, wr, wc, l2_ & 15, l2_ >> 4); }
        if (!has_next) break;
#pragma unroll
        for (int a = 0; a < 2; ++a)
#pragma unroll
            for (int b = 0; b < 2; ++b)
#pragma unroll
                for (int m = 0; m < 4; ++m)
#pragma unroll
                    for (int n = 0; n < 2; ++n) acc[a][b][m][n] = (f32x4){0.f, 0.f, 0.f, 0.f};
        cur = nxt; cA = nA; cB = nB; ++ui;
        pc ^= 1;
        if constexpr (ALIGN_EPI) { if (wr == 1) PG8_BAR; }
    }
    PG8_WAIT_V(0);
    if constexpr (!ALIGN_EPI) { if (wr == 0) PG8_BAR; }
    PG8_BAR;
#undef PG8_SA
#undef PG8_SB
#undef PG8_STAGE
#undef PG8_STAGE_A
#undef PG8_GOFS
#undef PG8_WRITE_GOFS
#undef PG8_LDA
#undef PG8_LDB
#undef PG8_MMA
#undef PG8_WAIT_V
#undef PG8_WAIT_L
#undef PG8_BAR
#undef PG8_SCHED
}
}

#define XB_TMO      128
#define XB_XCNT(j)  (256  + 64 * (j))
#define XB_XSUB(j)  (1280 + 64 * (j))
#define XB_XGEN(j)  (2304 + 64 * (j))
#define XB_TOP      3328
#define XB_TOPGEN   3392
#define XCD_BAR_WORDS 3456
#define XB_SPIN_CAP (1u << 18)
__device__ __forceinline__ unsigned xb_ld(unsigned* p)              { return __hip_atomic_load(p, __ATOMIC_RELAXED, __HIP_MEMORY_SCOPE_AGENT); }
__device__ __forceinline__ unsigned xb_add(unsigned* p, unsigned v) { return __hip_atomic_fetch_add(p, v, __ATOMIC_RELAXED, __HIP_MEMORY_SCOPE_AGENT); }
__device__ __forceinline__ unsigned xb_xcc_id() { return (unsigned)__builtin_amdgcn_s_getreg((3 << 11) | 20) & 0xFu; }
#define XB_SPIN(cond, bar) do { unsigned _sp = 0; while (cond) { __builtin_amdgcn_s_sleep(1); \
    if ((++_sp & 255u) == 0u) { if (xb_ld(&(bar)[XB_TMO])) break; if (_sp > XB_SPIN_CAP) { atomicAdd(&(bar)[XB_TMO], 1u); break; } } } } while (0)
struct XcdBarrier { unsigned* bar; unsigned x; volatile LAS unsigned* st; };
__device__ __forceinline__ XcdBarrier xcd_barrier_post(unsigned* bar, volatile LAS unsigned* st, int tid0) {
    XcdBarrier b; b.bar = bar; b.x = xb_xcc_id(); b.st = st;
    if (tid0 == 0) (void)xb_add(&bar[XB_XCNT(b.x)], 1u);
    return b;
}
__device__ __forceinline__ void xcd_barrier_complete(unsigned* bar, unsigned x, unsigned& nloc, unsigned& nx) {
    const unsigned G = gridDim.x * gridDim.y * gridDim.z;
    unsigned sum, cnt, mine, sp = 0u;
    for (;;) {
        sum = 0u; cnt = 0u; mine = 0u;
#pragma unroll
        for (unsigned j = 0; j < 16; ++j) { const unsigned c = xb_ld(&bar[XB_XCNT(j)]); sum += c; cnt += (c > 0u) ? 1u : 0u; mine = (j == x) ? c : mine; }
        if (sum == G) break;
        __builtin_amdgcn_s_sleep(1);
        if ((++sp & 255u) == 0u) { if (xb_ld(&bar[XB_TMO])) break; if (sp > XB_SPIN_CAP) { atomicAdd(&bar[XB_TMO], 1u); break; } }
    }
    nloc = mine > 0u ? mine : 1u; nx = cnt > 0u ? cnt : 1u;
}
__device__ __forceinline__ void xcd_barrier(const XcdBarrier& b, int tid0) {
    asm volatile("s_waitcnt vmcnt(0)" ::: "memory");
    __syncthreads();
    if (tid0 == 0) {
        unsigned* bar = b.bar;
        __builtin_amdgcn_s_waitcnt(0);
        unsigned nloc = b.st[0], nx = b.st[1];
        if (nloc == 0u) { xcd_barrier_complete(bar, b.x, nloc, nx); b.st[0] = nloc; b.st[1] = nx; }
        const unsigned old = xb_add(&bar[XB_XSUB(b.x)], 1u);
        const unsigned gen = old / nloc;
        if (old + 1u == (gen + 1u) * nloc) {
            __builtin_amdgcn_fence(__ATOMIC_RELEASE, "agent");
            asm volatile("s_waitcnt vmcnt(0)" ::: "memory");
            const unsigned og = xb_add(&bar[XB_TOP], 1u);
            const unsigned tg = og / nx;
            if (og + 1u == (tg + 1u) * nx) xb_add(&bar[XB_TOPGEN], 1u);
            else XB_SPIN(xb_ld(&bar[XB_TOPGEN]) == tg, bar);
            __builtin_amdgcn_fence(__ATOMIC_ACQUIRE, "agent");
            xb_add(&bar[XB_XGEN(b.x)], 1u);
            asm volatile("s_waitcnt vmcnt(0)" ::: "memory");
        } else {
            XB_SPIN(xb_ld(&bar[XB_XGEN(b.x)]) == gen, bar);
            __builtin_amdgcn_fence(__ATOMIC_ACQUIRE, "agent");
            asm volatile("s_waitcnt vmcnt(0)" ::: "memory");
        }
    }
    __syncthreads();
}

struct Args { const float* in[20]; float* out; unsigned char* ws; int ph_lo, ph_hi; };
typedef const __attribute__((address_space(4))) Args CArgs;
enum { I_X = 0, I_NORM_MIX, I_NORM_FFN, I_A_W_IN, I_A_LB, I_A_OGAIN, I_A_W_OUT, I_KV_NORM, I_KV_W, I_K_NORM, I_B_W_Q, I_B_Q_NORM, I_B_W_OUT,
       I_W_GROUP, I_B_GROUP, I_W_EXPERT, I_B_EXPERT, I_W_GATE, I_W_UP, I_W_DOWN };
struct Frame {
    LAS unsigned char* lds; unsigned char* ws; unsigned* ctl;
    int tid, lane, wave, vcu, G, gw, NGW;
};

struct TrItem { const float* src; const float* ksc; unsigned char* dst; int N, K, k0, n0, drow0, flags; float osc; };
struct TrRegs { f32x4 v[16]; f32x4 ks[2]; };
constexpr int TR_SCR_BYTES = 128 * 33 * 4;
__device__ __forceinline__ void tr_load(const TrItem& it, TrRegs& r, int lane) {
    const float* p = it.src + (size_t)(it.k0 + (lane >> 3)) * it.N + it.n0 + 4 * (lane & 7);
    const size_t st = (size_t)8 * it.N;
#pragma unroll
    for (int i = 0; i < 16; ++i) r.v[i] = *(const f32x4*)(p + i * st);
    if (it.ksc) { const f32x4* q = (const f32x4*)(it.ksc + it.k0 + 8 * (lane >> 3)); r.ks[0] = q[0]; r.ks[1] = q[1]; }
    else { r.ks[0] = (f32x4){1.f, 1.f, 1.f, 1.f}; r.ks[1] = r.ks[0]; }
}
__device__ __forceinline__ void tr_to_lds(const TrRegs& r, LAS float* scr, int lane) {
    LAS float* d = scr + (lane >> 3) * 33 + 4 * (lane & 7);
#pragma unroll
    for (int i = 0; i < 16; ++i) { d[(8 * i) * 33 + 0] = r.v[i][0]; d[(8 * i) * 33 + 1] = r.v[i][1]; d[(8 * i) * 33 + 2] = r.v[i][2]; d[(8 * i) * 33 + 3] = r.v[i][3]; }
}
__device__ __forceinline__ void tr_store(const TrItem& it, f32x4 ka, f32x4 kb, const LAS float* scr, int lane) {
#pragma unroll
    for (int jh = 0; jh < 2; ++jh) {
        const int c = (lane >> 3) + 8 * jh;
        if (jh == 1 && it.ksc) { const f32x4* q = (const f32x4*)(it.ksc + it.k0 + 8 * c); ka = q[0]; kb = q[1]; }
        const float o = it.osc;
        const float s0 = ka[0] * o, s1 = ka[1] * o, s2 = ka[2] * o, s3 = ka[3] * o, s4 = kb[0] * o, s5 = kb[1] * o, s6 = kb[2] * o, s7 = kb[3] * o;
#pragma unroll
        for (int jn = 0; jn < 4; ++jn) {
            const int n = (lane & 7) + 8 * jn; const LAS float* s = scr + (8 * c) * 33 + n;
            const float w0 = s[0 * 33] * s0, w1 = s[1 * 33] * s1, w2 = s[2 * 33] * s2, w3 = s[3 * 33] * s3, w4 = s[4 * 33] * s4, w5 = s[5 * 33] * s5, w6 = s[6 * 33] * s6, w7 = s[7 * 33] * s7;
            int drow = it.drow0 + n;
            if (it.flags & 1) { const int cidx = it.n0 + n, d = cidx & 127; drow = (it.drow0 - it.n0) + (cidx & ~127) + 32 * ((d & 63) >> 4) + 8 * ((d & 15) >> 2) + 4 * (d >> 6) + (d & 3); }
            const size_t eo = (size_t)drow * it.K + it.k0 + 8 * c;
            if (it.flags & 2) { u32x2 o8; o8.x = pk4_fp8(w0, w1, w2, w3); o8.y = pk4_fp8(w4, w5, w6, w7); *(u32x2*)(it.dst + eo) = o8; }
            else { u32x4 o16; o16.x = pk2(w0, w1); o16.y = pk2(w2, w3); o16.z = pk2(w4, w5); o16.w = pk2(w6, w7); *(u32x4*)(it.dst + eo * 2) = o16; }
        }
    }
}
template <class Dec> __device__ __forceinline__ void tr_run(Dec dec, int first, int total, int stride, LAS float* scr, int lane) {
    if (first >= total) return;
    TrRegs r; TrItem cur = dec(first); tr_load(cur, r, lane);
    for (int i = first; i < total; i += stride) {
        tr_to_lds(r, scr, lane);
        const f32x4 ka = r.ks[0], kb = r.ks[1];
        TrItem nxt = cur; const bool more = i + stride < total;
        if (more) { nxt = dec(i + stride); tr_load(nxt, r, lane); }
        LDS_WAIT(); asm volatile("" ::: "memory");
        tr_store(cur, ka, kb, scr, lane);
        LDS_WAIT(); asm volatile("" ::: "memory");
        cur = nxt;
    }
}
constexpr size_t WGU_LSTRIDE = 64 * MiB, WD_LSTRIDE = 32 * MiB;
static_assert((FP8_MOE0 != 0) && (FP8_MOE1 != 0), "the two-layer weight residency assumes e4m3 expert weights");
constexpr int MOE_CV_ITEMS = 32 * 768;
__device__ __forceinline__ TrItem moe_cv_item(CArgs& a, unsigned char* ws, int layer, int item) {
    const int e = item / 768, r = item % 768, which = r / 256, q = r % 256;
    const size_t eo = (size_t)(layer * NE + e);
    TrItem t; t.ksc = nullptr; t.flags = 2;
    if (which < 2) {
        const int kb = q / 16, nb = q % 16, n0 = nb * 32;
        t.src = (which == 0 ? a.in[I_W_GATE] : a.in[I_W_UP]) + eo * (size_t)D * FF; t.N = FF; t.K = D; t.k0 = 128 * kb; t.n0 = n0;
        t.dst = ws + WS_WGU + (size_t)layer * WGU_LSTRIDE + (size_t)e * 1024 * D; t.drow0 = (n0 >> 7) * 256 + which * 128 + (n0 & 127); t.osc = SC_W;
    } else {
        const int kb = q / 64, nb = q % 64;
        t.src = a.in[I_W_DOWN] + eo * (size_t)FF * D; t.N = D; t.K = FF; t.k0 = 128 * kb; t.n0 = nb * 32;
        t.dst = ws + WS_WD + (size_t)layer * WD_LSTRIDE + (size_t)e * D * FF; t.drow0 = nb * 32; t.osc = SC_WD;
    }
    return t;
}
__device__ __forceinline__ void rms_row_to_bf16(const float* xrow, bf16* orow, int lane) {
    const f32x4* xr = (const f32x4*)xrow + lane;
    f32x4 v[8]; float s = 0.f;
#pragma unroll
    for (int j = 0; j < 8; ++j) { v[j] = xr[64 * j]; s += (v[j].x * v[j].x + v[j].y * v[j].y) + (v[j].z * v[j].z + v[j].w * v[j].w); }
    const float rstd = __builtin_amdgcn_rsqf(wave_sum(s) * (1.f / D) + RMS_EPS);
    u32x2* o8 = (u32x2*)orow + lane;
#pragma unroll
    for (int j = 0; j < 8; ++j) { u32x2 w; w.x = pk2(v[j].x * rstd, v[j].y * rstd); w.y = pk2(v[j].z * rstd, v[j].w * rstd); o8[64 * j] = w; }
}

__device__ __forceinline__ int moe_tables(Frame& F, int layer) {
    LAS int* blk_e = (LAS int*)(F.lds + LT_BLKE); LAS int* blkstart = (LAS int*)(F.lds + LT_BLKSTART); LAS int* cntl = (LAS int*)(F.lds + LT_CNT);
    __syncthreads();
    if (F.wave == 0) {
        const int e = F.lane & 31;
        const int c = (int)__hip_atomic_load(F.ctl + CW_CNT_AT(layer, e), __ATOMIC_RELAXED, __HIP_MEMORY_SCOPE_AGENT);
        const int nb = (c + 255) >> 8;
        int incl = nb;
#pragma unroll
        for (int o = 1; o < 32; o <<= 1) { const int t = __shfl_up(incl, o, 32); if ((F.lane & 31) >= o) incl += t; }
        const int excl = incl - nb;
        if (F.lane < 32) { blkstart[e] = excl; cntl[e] = c; for (int r = 0; r < nb; ++r) blk_e[excl + r] = e; if (e == 31) blkstart[32] = incl; }
    }
    __syncthreads();
    return blkstart[32];
}

typedef const GAS char* gcptr;
__device__ __forceinline__ gcptr opaque_s(const void* p) { asm volatile("" : "+s"(p)); return (gcptr)p; }
__device__ __forceinline__ float wave_reduce4(const float (&p)[4], int lane) {
    const bool b0 = lane & 1, b1 = lane & 2;
    float a0 = b0 ? p[1] : p[0], x0 = b0 ? p[0] : p[1]; a0 += __shfl_xor(x0, 1);
    float a1 = b0 ? p[3] : p[2], x1 = b0 ? p[2] : p[3]; a1 += __shfl_xor(x1, 1);
    float c = b1 ? a1 : a0, d = b1 ? a0 : a1; c += __shfl_xor(d, 2);
    c += __shfl_xor(c, 4); c += __shfl_xor(c, 8); c += __shfl_xor(c, 16); c += __shfl_xor(c, 32);
    return c;
}
__device__ __forceinline__ float wave_reduce8(const float (&p)[8], int lane) {
    const bool b2 = lane & 4;
    const float lo[4] = {p[0], p[1], p[2], p[3]}, hi[4] = {p[4], p[5], p[6], p[7]};
    float q[4];
#pragma unroll
    for (int i = 0; i < 4; ++i) { const float keep = b2 ? hi[i] : lo[i], give = b2 ? lo[i] : hi[i]; q[i] = keep + __shfl_xor(give, 4); }
    const bool b0 = lane & 1, b1 = lane & 2;
    float a0 = b0 ? q[1] : q[0], x0 = b0 ? q[0] : q[1]; a0 += __shfl_xor(x0, 1);
    float a1 = b0 ? q[3] : q[2], x1 = b0 ? q[2] : q[3]; a1 += __shfl_xor(x1, 1);
    float c = b1 ? a1 : a0, d = b1 ? a0 : a1; c += __shfl_xor(d, 2);
    c += __shfl_xor(c, 8); c += __shfl_xor(c, 16); c += __shfl_xor(c, 32);
    return c;
}
template <bool DRY, bool OUT8> __device__ __forceinline__ void route_token(Frame& F, CArgs& a, int layer, int t) {
    const bf16* xrow = (const bf16*)(F.ws + WS_XR) + (size_t)t * D;
    const unsigned l16 = (unsigned)F.lane * 16u;
    gcptr xb = opaque_s(xrow); gcptr gb = opaque_s(a.in[I_NORM_FFN] + layer * D);
    f32x4 v[8]; float s = 0.f;
#pragma unroll
    for (int j = 0; j < 8; ++j) { const u32x2 xw_ = *(const GAS u32x2*)(xb + j * 512 + (l16 >> 1)); v[j] = (f32x4){bflo(xw_.x), bfhi(xw_.x), bflo(xw_.y), bfhi(xw_.y)}; s += (v[j].x * v[j].x + v[j].y * v[j].y) + (v[j].z * v[j].z + v[j].w * v[j].w); }
    const float rstd = __builtin_amdgcn_rsqf(wave_sum(s) * (1.f / D) + RMS_EPS);
    u32x2* o8 = (u32x2*)((bf16*)(F.ws + (DRY ? WS_OPART : WS_XN)) + (size_t)t * D) + F.lane;
#pragma unroll
    for (int j = 0; j < 8; ++j) { const f32x4 g = *(const GAS f32x4*)(gb + j * 1024 + l16); v[j].x *= rstd * g.x; v[j].y *= rstd * g.y; v[j].z *= rstd * g.z; v[j].w *= rstd * g.w;
        if (OUT8) ((unsigned*)(F.ws + (DRY ? WS_OPART : WS_XN)) + (size_t)t * (D / 4))[64 * j + F.lane] = pk4_fp8(v[j].x * SC_XN, v[j].y * SC_XN, v[j].z * SC_XN, v[j].w * SC_XN);
        else { u32x2 w; w.x = pk2(v[j].x, v[j].y); w.y = pk2(v[j].z, v[j].w); o8[64 * j] = w; } }
    const float* RT = (const float*)(F.ws + WS_RT) + (size_t)layer * 36 * D;
    float gl[4];
    { float pp[4];
#pragma unroll
      for (int r = 0; r < 4; ++r) { gcptr wb = opaque_s(RT + r * D); float p = 0.f;
#pragma unroll
        for (int j = 0; j < 8; ++j) { const f32x4 w = *(const GAS f32x4*)(wb + j * 1024 + l16); p += (v[j].x * w.x + v[j].y * w.y) + (v[j].z * w.z + v[j].w * w.w); }
        pp[r] = p; if (r & 1) __builtin_amdgcn_sched_barrier(0); }
      const float red = wave_reduce4(pp, F.lane);
#pragma unroll
      for (int r = 0; r < 4; ++r) gl[r] = __builtin_bit_cast(float, __builtin_amdgcn_readlane(__builtin_bit_cast(int, red), r)) + a.in[I_B_GROUP][layer * NG + r]; }
    int g = 0; float gm = gl[0];
#pragma unroll
    for (int r = 1; r < 4; ++r) if (gl[r] > gm) { gm = gl[r]; g = r; }
    float gs = 0.f;
#pragma unroll
    for (int r = 0; r < 4; ++r) gs += __expf(gl[r] - gm);
    const float gp = 1.0f / gs;
    g = __builtin_amdgcn_readfirstlane(g);
    float el[8];
    { float pp[8];
#pragma unroll
      for (int r = 0; r < 8; ++r) { gcptr wb = opaque_s(RT + (size_t)(4 + g * 8 + r) * D); float p = 0.f;
#pragma unroll
        for (int j = 0; j < 8; ++j) { const f32x4 w = *(const GAS f32x4*)(wb + j * 1024 + l16); p += (v[j].x * w.x + v[j].y * w.y) + (v[j].z * w.z + v[j].w * w.w); }
        pp[r] = p; if (r & 1) __builtin_amdgcn_sched_barrier(0); }
      const float red = wave_reduce8(pp, F.lane);
#pragma unroll
      for (int r = 0; r < 8; ++r) el[r] = __builtin_bit_cast(float, __builtin_amdgcn_readlane(__builtin_bit_cast(int, red), r)) + a.in[I_B_EXPERT][layer * NE + g * 8 + r]; }
    int i0 = 0; float m0 = el[0];
#pragma unroll
    for (int r = 1; r < 8; ++r) if (el[r] > m0) { m0 = el[r]; i0 = r; }
    int i1 = -1; float m1 = -INFINITY;
#pragma unroll
    for (int r = 0; r < 8; ++r) if (r != i0 && el[r] > m1) { m1 = el[r]; i1 = r; }
    const float q1 = __expf(m1 - m0), w0 = gp / (1.0f + q1), w1 = gp * q1 / (1.0f + q1);
    if (DRY && w0 + w1 < -1.0f) ((float*)(F.ws + WS_OPART))[0] = w0;
    if (F.lane == 0 && !DRY) {
        const int e0 = g * 8 + i0, e1 = g * 8 + i1;
        const int r0 = (int)atomicAdd(F.ctl + CW_CNT_AT(layer, e0), 1u), r1 = (int)atomicAdd(F.ctl + CW_CNT_AT(layer, e1), 1u);
        int* lists = (int*)(F.ws + WS_LISTS); lists[e0 * LIST_CAP + r0] = t; lists[e1 * LIST_CAP + r1] = t;
        int* rec = (int*)(F.ws + WS_TOKREC) + (size_t)t * 8;
        rec[0] = e0; rec[1] = r0; rec[2] = __builtin_bit_cast(int, w0); rec[3] = e1; rec[4] = r1; rec[5] = __builtin_bit_cast(int, w1);
    }
}

template <bool NORM, bool DRY, bool OUT8> __device__ __forceinline__ void combine_token(Frame& F, CArgs& a, int t) {
    const LAS int* blkstart = (const LAS int*)(F.lds + LT_BLKSTART);
    const int* rec = (const int*)(F.ws + WS_TOKREC) + (size_t)t * 8;
    const int e0 = rec[0], r0 = rec[1], e1 = rec[3], r1 = rec[4]; const float w0 = __builtin_bit_cast(float, rec[2]), w1 = __builtin_bit_cast(float, rec[5]);
    const size_t row0 = (size_t)blkstart[e0] * 256 + r0, row1 = (size_t)blkstart[e1] * 256 + r1;
    const u32x2* p0 = (const u32x2*)((const bf16*)(F.ws + WS_OUTB) + row0 * D) + F.lane; const u32x2* p1 = (const u32x2*)((const bf16*)(F.ws + WS_OUTB) + row1 * D) + F.lane;
    const unsigned* q0 = (const unsigned*)(F.ws + WS_OUTB + row0 * D) + F.lane; const unsigned* q1 = (const unsigned*)(F.ws + WS_OUTB + row1 * D) + F.lane;
    u32x2* xr = (u32x2*)((bf16*)(F.ws + WS_XR) + (size_t)t * D) + F.lane; f32x4* xo = (f32x4*)(a.out + (size_t)t * D) + F.lane;
    f32x4 v[8]; float s = 0.f;
#pragma unroll
    for (int j = 0; j < 8; ++j) { const u32x2 xb_ = xr[64 * j]; f32x4 x = (f32x4){bflo(xb_.x), bfhi(xb_.x), bflo(xb_.y), bfhi(xb_.y)};
        if (OUT8) { const unsigned b0 = q0[64 * j], b1 = q1[64 * j]; const float u0 = w0 * (1.0f / SC_OUT), u1 = w1 * (1.0f / SC_OUT);
            const f32x2 l0 = __builtin_amdgcn_cvt_pk_f32_fp8((int)b0, false), h0 = __builtin_amdgcn_cvt_pk_f32_fp8((int)b0, true), l1 = __builtin_amdgcn_cvt_pk_f32_fp8((int)b1, false), h1 = __builtin_amdgcn_cvt_pk_f32_fp8((int)b1, true);
            x.x += u0 * l0.x + u1 * l1.x; x.y += u0 * l0.y + u1 * l1.y; x.z += u0 * h0.x + u1 * h1.x; x.w += u0 * h0.y + u1 * h1.y; }
        else { const u32x2 a0 = p0[64 * j], a1 = p1[64 * j];
            x.x += w0 * bflo(a0.x) + w1 * bflo(a1.x); x.y += w0 * bfhi(a0.x) + w1 * bfhi(a1.x); x.z += w0 * bflo(a0.y) + w1 * bflo(a1.y); x.w += w0 * bfhi(a0.y) + w1 * bfhi(a1.y); }
        v[j] = x; if (NORM) { if (!DRY) { u32x2 w_; w_.x = pk2(x.x, x.y); w_.y = pk2(x.z, x.w); xr[64 * j] = w_; } } else xo[64 * j] = x; s += (x.x * x.x + x.y * x.y) + (x.z * x.z + x.w * x.w); }
    if (NORM) {
        const float rstd = __builtin_amdgcn_rsqf(wave_sum(s) * (1.f / D) + RMS_EPS);
        u32x2* o8 = (u32x2*)((bf16*)(F.ws + (DRY ? WS_OPART + 128 * MiB : WS_XN)) + (size_t)t * D) + F.lane;
#pragma unroll
        for (int j = 0; j < 8; ++j) {
            if (FP8_QKV) ((unsigned*)(F.ws + (DRY ? WS_OPART + 128 * MiB : WS_XN)) + (size_t)t * (D / 4))[64 * j + F.lane] = pk4_fp8(v[j].x * (rstd * SC_XN), v[j].y * (rstd * SC_XN), v[j].z * (rstd * SC_XN), v[j].w * (rstd * SC_XN));
            else { u32x2 w; w.x = pk2(v[j].x * rstd, v[j].y * rstd); w.y = pk2(v[j].z * rstd, v[j].w * rstd); o8[64 * j] = w; } }
    }
}

__device__ __forceinline__ void hgrn_naive_item(Frame& F, int item) {
    const int b = item >> 6, h = (item >> 2) & 15, sl = item & 3;
    const bf16* Zq = (const bf16*)(F.ws + WS_ZQ); const bf16* Zk = (const bf16*)(F.ws + WS_ZK); const _Float16* Zg = (const _Float16*)(F.ws + WS_ZG); const bf16* Zv = (const bf16*)(F.ws + WS_ZV);
    float* Oraw = (float*)(F.ws + WS_ORAW);
    LAS float* fq = (LAS float*)F.lds; LAS float* fk = fq + 16 * 128; LAS float* ff = fk + 16 * 128; LAS float* fv = ff + 16 * 128; LAS float* part = fv + 16 * 32;
    const int dv = F.tid & 31, dkg = F.tid >> 5;
    float S[8];
#pragma unroll
    for (int j = 0; j < 8; ++j) S[j] = 0.f;
    const size_t tok0 = (size_t)b * T;
    for (int c = 0; c < T / 16; ++c) {
        __syncthreads();
#pragma unroll
        for (int i = 0; i < 4; ++i) { const int idx = F.tid + i * 512, st = idx >> 7, dk = idx & 127; const size_t g = (tok0 + c * 16 + st) * D + h * HD + dk;
            fq[idx] = bf2f(Zq[g]); fk[idx] = bf2f(Zk[g]); ff[idx] = __expf((float)Zg[g]); }
        { const int st = F.tid >> 5; fv[F.tid] = bf2f(Zv[(tok0 + c * 16 + st) * D + h * HD + sl * 32 + dv]); }
        __syncthreads();
#pragma unroll 4
        for (int st = 0; st < 16; ++st) {
            const float v = fv[st * 32 + dv];
            const f32x4 q0 = *(const LAS f32x4*)(fq + st * 128 + dkg * 8), q1 = *(const LAS f32x4*)(fq + st * 128 + dkg * 8 + 4);
            const f32x4 k0 = *(const LAS f32x4*)(fk + st * 128 + dkg * 8), k1 = *(const LAS f32x4*)(fk + st * 128 + dkg * 8 + 4);
            const f32x4 f0 = *(const LAS f32x4*)(ff + st * 128 + dkg * 8), f1 = *(const LAS f32x4*)(ff + st * 128 + dkg * 8 + 4);
            float po = 0.f;
#pragma unroll
            for (int j = 0; j < 4; ++j) { S[j] = f0[j] * S[j] + k0[j] * v; po += q0[j] * S[j]; S[4 + j] = f1[j] * S[4 + j] + k1[j] * v; po += q1[j] * S[4 + j]; }
            part[(st * 16 + dkg) * 32 + dv] = po;
        }
        __syncthreads();
        { const int st = F.tid >> 5; float o = 0.f;
#pragma unroll
            for (int g = 0; g < 16; ++g) o += part[(st * 16 + g) * 32 + dv];
            Oraw[(tok0 + c * 16 + st) * D + h * HD + sl * 32 + dv] = o; }
    }
    __syncthreads();
}
__device__ __forceinline__ void hgrn_norm_token(Frame& F, CArgs& a, int t) {
    const float* o = (const float*)(F.ws + WS_ORAW) + (size_t)t * D + F.lane * 32;
    const bf16* zg = (const bf16*)(F.ws + WS_ZGATE) + (size_t)t * D + F.lane * 32;
    const float* gain = a.in[I_A_OGAIN] + (F.lane & 3) * 32;
    f32x4 v[8]; float s = 0.f;
#pragma unroll
    for (int j = 0; j < 8; ++j) { v[j] = ((const f32x4*)o)[j]; s += (v[j].x * v[j].x + v[j].y * v[j].y) + (v[j].z * v[j].z + v[j].w * v[j].w); }
    s += __shfl_xor(s, 1); s += __shfl_xor(s, 2);
    const float rstd = 1.0f / sqrtf(s * (1.f / HD) + RMS_EPS);
    bf16* out = (bf16*)(F.ws + WS_OH) + (size_t)t * D + F.lane * 32;
#pragma unroll
    for (int j = 0; j < 4; ++j) { const u32x4 g = ((const u32x4*)zg)[j]; const f32x4 ga = ((const f32x4*)gain)[2 * j], gb = ((const f32x4*)gain)[2 * j + 1]; const f32x4 va = v[2 * j], vb = v[2 * j + 1];
        u32x4 w; w.x = pk2(va.x * rstd * ga.x * bflo(g.x), va.y * rstd * ga.y * bfhi(g.x)); w.y = pk2(va.z * rstd * ga.z * bflo(g.y), va.w * rstd * ga.w * bfhi(g.y));
        w.z = pk2(vb.x * rstd * gb.x * bflo(g.z), vb.y * rstd * gb.y * bfhi(g.z)); w.w = pk2(vb.z * rstd * gb.z * bflo(g.w), vb.w * rstd * gb.w * bfhi(g.w));
        ((u32x4*)out)[j] = w; }
}

template <bool DRY> __device__ __forceinline__ void qk_post_item(Frame& F, CArgs& a, int item) {
    const int b = item >> 6, n = (item >> 2) & 15, hq = item & 3;
    const int hl = F.lane >> 4, sb = F.lane & 15, h = hq * 4 + hl;
    bf16* Q = (bf16*)(F.ws + WS_Q); bf16* Kb = (bf16*)(F.ws + WS_K);
    const f32x2* rope = (const f32x2*)(F.ws + WS_ROPE);
    const f32x4 gq0 = *(const f32x4*)(a.in[I_B_Q_NORM] + 4 * sb), gq1 = *(const f32x4*)(a.in[I_B_Q_NORM] + 64 + 4 * sb);
    const f32x4 gk0 = *(const f32x4*)(a.in[I_K_NORM] + 4 * sb), gk1 = *(const f32x4*)(a.in[I_K_NORM] + 64 + 4 * sb);
    float ks[8];
#pragma unroll
    for (int j = 0; j < 8; ++j) ks[j] = 0.f;
    for (int i = 0; i < 32; ++i) {
        const int pos = n * MBLK + F.wave * 32 + i; const size_t tok = (size_t)b * T + pos;
        f32x2 cs[4];
#pragma unroll
        for (int j = 0; j < 4; ++j) cs[j] = rope[pos * 64 + 4 * sb + j];
#pragma unroll
        for (int which = 0; which < 2; ++which) {
            bf16* p = (which ? Kb : Q) + tok * D + h * HD + 4 * sb;
            const u32x2 lo = *(const u32x2*)p, hi = *(const u32x2*)(p + 64);
            float x1[4] = {bflo(lo.x), bfhi(lo.x), bflo(lo.y), bfhi(lo.y)}, x2[4] = {bflo(hi.x), bfhi(hi.x), bflo(hi.y), bfhi(hi.y)};
            float s = 0.f;
#pragma unroll
            for (int j = 0; j < 4; ++j) s += x1[j] * x1[j] + x2[j] * x2[j];
            s += __shfl_xor(s, 1); s += __shfl_xor(s, 2); s += __shfl_xor(s, 4); s += __shfl_xor(s, 8);
            const float rstd = 1.0f / sqrtf(s * (1.f / HD) + RMS_EPS);
            const f32x4 g0 = which ? gk0 : gq0, g1 = which ? gk1 : gq1;
            float o1[4], o2[4];
#pragma unroll
            for (int j = 0; j < 4; ++j) { const float y1 = x1[j] * rstd * g0[j], y2 = x2[j] * rstd * g1[j]; o1[j] = y1 * cs[j].x - y2 * cs[j].y; o2[j] = y2 * cs[j].x + y1 * cs[j].y; }
            u32x2 wlo, whi; wlo.x = pk2(o1[0], o1[1]); wlo.y = pk2(o1[2], o1[3]); whi.x = pk2(o2[0], o2[1]); whi.y = pk2(o2[2], o2[3]);
            { bf16* pw = DRY ? p + (WS_OPART - WS_Q) / 2 : p; *(u32x2*)pw = wlo; *(u32x2*)(pw + 64) = whi; }
            if (which) {
#pragma unroll
                for (int j = 0; j < 4; ++j) { ks[j] += o1[j]; ks[4 + j] += o2[j]; } }
        }
    }
    LAS float* red = (LAS float*)F.lds;
    __syncthreads();
#pragma unroll
    for (int j = 0; j < 8; ++j) red[(F.wave * 64 + F.lane) * 8 + j] = ks[j];
    __syncthreads();
    { const int l = F.tid >> 3, j = F.tid & 7; float s = 0.f;
#pragma unroll
        for (int w = 0; w < 8; ++w) s += red[(w * 64 + l) * 8 + j];
        const int hh = hq * 4 + (l >> 4), s2 = l & 15, d = (j < 4) ? 4 * s2 + j : 64 + 4 * s2 + (j - 4);
        ((float*)(F.ws + (DRY ? WS_OPART + 200 * MiB : WS_KMEAN)))[(((size_t)b * H + hh) * NBLK + n) * HD + d] = s * (1.0f / MBLK); }
    const bf16* V = (const bf16*)(F.ws + WS_V); bf16* Vt = (bf16*)(F.ws + (DRY ? WS_OPART + 128 * MiB : WS_VT));
    LAS bf16* vl = (LAS bf16*)(F.lds + 32768);
    for (int hh = 0; hh < 4; ++hh) {
        const int hv = hq * 4 + hh;
        __syncthreads();
#pragma unroll
        for (int i = 0; i < 8; ++i) { const int ch = F.tid + i * 512, r = ch >> 4, cc = ch & 15;
            const u32x4 w = *(const u32x4*)(V + ((size_t)b * T + n * MBLK + r) * D + hv * HD + cc * 8);
            *(LAS u32x4*)(vl + r * 136 + cc * 8) = w; }
        __syncthreads();
#pragma unroll
        for (int i = 0; i < 8; ++i) { const int idx = F.tid + i * 512, d = idx & 127, tg = idx >> 7;
            unsigned short e[8];
#pragma unroll
            for (int j = 0; j < 8; ++j) e[j] = vl[(tg * 8 + j) * 136 + d];
            u32x4 w; w.x = e[0] | ((unsigned)e[1] << 16); w.y = e[2] | ((unsigned)e[3] << 16); w.z = e[4] | ((unsigned)e[5] << 16); w.w = e[6] | ((unsigned)e[7] << 16);
            *(u32x4*)(Vt + (((size_t)b * H + hv) * HD + d) * T + n * MBLK + tg * 8) = w; }
    }
    __syncthreads();
}

__device__ __forceinline__ void attn_v0_item(Frame& F, int item) {
    const int b = item >> 8, h = (item >> 4) & 15, jb = item & 15;
    const bf16* Q = (const bf16*)(F.ws + WS_Q); const bf16* Kb = (const bf16*)(F.ws + WS_K); const bf16* Vt = (const bf16*)(F.ws + WS_VT); bf16* OA = (bf16*)(F.ws + WS_OA);
    const float* kmean = (const float*)(F.ws + WS_KMEAN) + ((size_t)b * H + h) * NBLK * HD;
    const int lane = F.lane, fr = lane & 15, fq = lane >> 4;
    const size_t tokw = (size_t)b * T + jb * MBLK + F.wave * 32;
    LAS unsigned* maskl = (LAS unsigned*)(F.lds + F.wave * 8192);
    LAS bf16* pl = (LAS bf16*)(F.lds + F.wave * 8192 + 256);
    {
        const int row = lane & 31, half = lane >> 5;
        float g[8];
#pragma unroll
        for (int i = 0; i < 8; ++i) g[i] = 0.f;
        const bf16* qrow = Q + (tokw + row) * D + h * HD;
        for (int dc = 0; dc < 16; ++dc) {
            const u32x4 w = *(const u32x4*)(qrow + dc * 8);
            const float qv[8] = {bflo(w.x), bfhi(w.x), bflo(w.y), bfhi(w.y), bflo(w.z), bfhi(w.z), bflo(w.w), bfhi(w.w)};
#pragma unroll
            for (int i = 0; i < 8; ++i) { const float* km = kmean + (2 * i + half) * HD + dc * 8;
#pragma unroll
                for (int e = 0; e < 8; ++e) g[i] += qv[e] * km[e]; }
        }
        float ga[16];
#pragma unroll
        for (int i = 0; i < 8; ++i) { const float o = __shfl_xor(g[i], 32); ga[2 * i] = half ? o : g[i]; ga[2 * i + 1] = half ? g[i] : o; }
        unsigned mask = 0u;
#pragma unroll
        for (int pick = 0; pick < 3; ++pick) { float best = -INFINITY; int bi = -1;
#pragma unroll
            for (int n = 0; n < 16; ++n) { const bool ok = (n < jb) && !((mask >> n) & 1u); if (ok && ga[n] > best) { best = ga[n]; bi = n; } }
            if (bi >= 0) mask |= 1u << bi; }
        if (half == 0) maskl[row] = mask;
    }
    LDS_WAIT(); __builtin_amdgcn_wave_barrier();
    unsigned rmask[2][4]; unsigned anym = 0u;
#pragma unroll
    for (int rt = 0; rt < 2; ++rt)
#pragma unroll
        for (int r = 0; r < 4; ++r) { rmask[rt][r] = maskl[rt * 16 + 4 * fq + r]; }
    { unsigned m = maskl[lane & 31];
#pragma unroll
      for (int o = 1; o < 32; o <<= 1) m |= __shfl_xor(m, o);
      anym = __builtin_amdgcn_readfirstlane(m); }
    bf16x8 qf[2][4];
#pragma unroll
    for (int rt = 0; rt < 2; ++rt)
#pragma unroll
        for (int ks = 0; ks < 4; ++ks) qf[rt][ks] = *(const bf16x8*)(Q + (tokw + rt * 16 + fr) * D + h * HD + ks * 32 + 8 * fq);
    f32x4 oacc[2][8];
#pragma unroll
    for (int rt = 0; rt < 2; ++rt)
#pragma unroll
        for (int dt = 0; dt < 8; ++dt) oacc[rt][dt] = (f32x4){0.f, 0.f, 0.f, 0.f};
    float lsum[2][4];
#pragma unroll
    for (int rt = 0; rt < 2; ++rt)
#pragma unroll
        for (int r = 0; r < 4; ++r) lsum[rt][r] = 0.f;
    const float c2 = 0.08838834764831845f * 1.4426950408889634f;
    const int nkt = 4 * jb + 4;
    for (int kt = 0; kt < nkt; ++kt) {
        const int n = kt >> 2; const bool own = (n == jb);
        if (!own && !((anym >> n) & 1u)) continue;
        if (own && (kt & 3) * 64 > F.wave * 32 + 31) continue;
        const size_t key0 = (size_t)b * T + kt * 64;
        f32x4 sacc[2][4];
#pragma unroll
        for (int ct = 0; ct < 4; ++ct) {
            bf16x8 kf[4];
#pragma unroll
            for (int ks = 0; ks < 4; ++ks) kf[ks] = *(const bf16x8*)(Kb + (key0 + ct * 16 + fr) * D + h * HD + ks * 32 + 8 * fq);
#pragma unroll
            for (int rt = 0; rt < 2; ++rt) { f32x4 s = (f32x4){0.f, 0.f, 0.f, 0.f};
#pragma unroll
                for (int ks = 0; ks < 4; ++ks) s = __builtin_amdgcn_mfma_f32_16x16x32_bf16(qf[rt][ks], kf[ks], s, 0, 0, 0);
                sacc[rt][ct] = s; }
        }
#pragma unroll
        for (int rt = 0; rt < 2; ++rt)
#pragma unroll
            for (int ct = 0; ct < 4; ++ct)
#pragma unroll
                for (int r = 0; r < 4; ++r) {
                    const int qrow = rt * 16 + 4 * fq + r, kcol = ct * 16 + fr;
                    const bool ok = own ? ((kt & 3) * 64 + kcol <= F.wave * 32 + qrow) : ((rmask[rt][r] >> n) & 1u);
                    const float p = ok ? __builtin_amdgcn_exp2f(sacc[rt][ct][r] * c2) : 0.f;
                    lsum[rt][r] += p;
                    pl[qrow * 72 + kcol] = (bf16)f2bf(p);
                }
        LDS_WAIT(); __builtin_amdgcn_wave_barrier();
        bf16x8 pf[2][2];
#pragma unroll
        for (int rt = 0; rt < 2; ++rt)
#pragma unroll
            for (int k2 = 0; k2 < 2; ++k2) pf[rt][k2] = *(const LAS bf16x8*)(pl + (rt * 16 + fr) * 72 + k2 * 32 + 8 * fq);
#pragma unroll
        for (int dt = 0; dt < 8; ++dt) {
            bf16x8 vf[2];
#pragma unroll
            for (int k2 = 0; k2 < 2; ++k2) vf[k2] = *(const bf16x8*)(Vt + (((size_t)b * H + h) * HD + dt * 16 + fr) * T + kt * 64 + k2 * 32 + 8 * fq);
#pragma unroll
            for (int rt = 0; rt < 2; ++rt)
#pragma unroll
                for (int k2 = 0; k2 < 2; ++k2) oacc[rt][dt] = __builtin_amdgcn_mfma_f32_16x16x32_bf16(pf[rt][k2], vf[k2], oacc[rt][dt], 0, 0, 0);
        }
        LDS_WAIT(); __builtin_amdgcn_wave_barrier();
    }
#pragma unroll
    for (int rt = 0; rt < 2; ++rt)
#pragma unroll
        for (int r = 0; r < 4; ++r) { float s = lsum[rt][r]; s += __shfl_xor(s, 1); s += __shfl_xor(s, 2); s += __shfl_xor(s, 4); s += __shfl_xor(s, 8); const float inv = 1.0f / s;
            bf16* orow = OA + (tokw + rt * 16 + 4 * fq + r) * D + h * HD + fr;
#pragma unroll
            for (int dt = 0; dt < 8; ++dt) orow[dt * 16] = (bf16)f2bf(oacc[rt][dt][r] * inv); }
}

typedef float f32x16 __attribute__((ext_vector_type(16)));
template <bool DRY> __device__ __forceinline__ void moba_gate_item(Frame& F, int item) {
    const int bh = item >> 3, p = item & 7, b = bh >> 4, h = bh & 15;
    LAS float* km = (LAS float*)F.lds;
    __syncthreads();
    { const f32x4 v = ((const f32x4*)((const float*)(F.ws + WS_KMEAN) + (size_t)bh * NBLK * HD))[F.tid]; ((LAS f32x4*)km)[F.tid] = v; }
    __syncthreads();
    const int j = 2 * p + (F.wave >> 2), t = j * MBLK + (F.wave & 3) * 64 + F.lane;
    if (j == 0) return;
    const unsigned char* qrow = F.ws + WS_Q + ((size_t)b * T + t) * D + h * HD;
    float g[16];
#pragma unroll
    for (int n = 0; n < 16; ++n) g[n] = 0.f;
    for (int dc = 0; dc < 8; ++dc) {
        const u32x4 w = *(const u32x4*)(qrow + dc * 16);
        float qv[16]; { float t4[4]; fp8x4_to_f32(w.x, t4); qv[0] = t4[0]; qv[1] = t4[1]; qv[2] = t4[2]; qv[3] = t4[3]; fp8x4_to_f32(w.y, t4); qv[4] = t4[0]; qv[5] = t4[1]; qv[6] = t4[2]; qv[7] = t4[3];
            fp8x4_to_f32(w.z, t4); qv[8] = t4[0]; qv[9] = t4[1]; qv[10] = t4[2]; qv[11] = t4[3]; fp8x4_to_f32(w.w, t4); qv[12] = t4[0]; qv[13] = t4[1]; qv[14] = t4[2]; qv[15] = t4[3]; }
#pragma unroll
        for (int n = 0; n < 15; ++n) if (n < j) {
#pragma unroll
            for (int q4 = 0; q4 < 4; ++q4) { const f32x4 k0 = *(const LAS f32x4*)(km + n * HD + dc * 16 + 4 * q4);
                g[n] += (qv[4 * q4] * k0.x + qv[4 * q4 + 1] * k0.y) + (qv[4 * q4 + 2] * k0.z + qv[4 * q4 + 3] * k0.w); } }
    }
    int pk[3];
    unsigned mask = 0u;
#pragma unroll
    for (int pick = 0; pick < 3; ++pick) { float best = -INFINITY; int bi = -1;
#pragma unroll
        for (int n = 0; n < 15; ++n) { const bool ok = (n < j) && !((mask >> n) & 1u); if (ok && g[n] > best) { best = g[n]; bi = n; } }
        if (bi >= 0) mask |= 1u << bi;
        pk[pick] = bi; }
    unsigned* acnt = F.ctl + CW_ACNT + bh * 16; int* alist = (int*)(F.ws + WS_ALIST) + (size_t)bh * 16 * ALIST_CAP;
    unsigned mycnt = 0u;
#pragma unroll
    for (int n = 0; n < 15; ++n) if (n < j) { const unsigned long long bal = __ballot((mask >> n) & 1u); mycnt = (F.lane == n) ? (unsigned)__popcll(bal) : mycnt; }
    unsigned mybase = 0u;
    if (F.lane < 15 && mycnt > 0u && !DRY) mybase = atomicAdd(acnt + F.lane, mycnt);
#pragma unroll
    for (int n = 0; n < 15; ++n) if (n < j) {
        const bool sel = (mask >> n) & 1u; const int slot = (pk[0] == n) ? 0 : ((pk[1] == n) ? 1 : 2);
        const unsigned long long bal = __ballot(sel);
        if (bal) { const unsigned base = (unsigned)__builtin_amdgcn_readlane((int)mybase, n);
            const int rank = __popcll(bal & ((1ull << F.lane) - 1ull));
            if (sel) (DRY ? (int*)(F.ws + WS_OPART) : alist)[n * ALIST_CAP + base + rank] = t | (slot << 16); }
    }
}

constexpr int AL_K = 0, AL_V = 36864; constexpr float SC_P = 4.f;
typedef int i32x8v __attribute__((ext_vector_type(8)));
__device__ __forceinline__ i32x8v ld32(const LAS unsigned char* p) { const u32x4 a = *(const LAS u32x4*)p, b = *(const LAS u32x4*)(p + 16); i32x8v r; r[0] = a.x; r[1] = a.y; r[2] = a.z; r[3] = a.w; r[4] = b.x; r[5] = b.y; r[6] = b.z; r[7] = b.w; return r; }
template <bool OWN> __device__ __forceinline__ void attn_chunk(Frame& F, int b, int h, int n, int c, int cnt, const int* lst) {
    const int lane = F.lane, qi = lane & 31, hh = lane >> 5, w = F.wave;
    const int rem = OWN ? MBLK : cnt - c * 256;
    if (w * 32 >= rem) return;
    int t, slot; bool valid = true;
    if (OWN) { t = n * MBLK + w * 32 + qi; slot = 3; }
    else { const int idx = w * 32 + qi; valid = idx < rem; const int e = lst[c * 256 + (valid ? idx : 0)]; t = e & 0xffff; slot = e >> 16; }
    const size_t tok = (size_t)b * T + t;
    const unsigned char* qrow = F.ws + WS_Q + tok * D + h * HD;
    i32x8v qf[2];
#pragma unroll
    for (int ks = 0; ks < 2; ++ks) { const u32x4 a = *(const u32x4*)(qrow + 64 * ks + 32 * hh), bq = *(const u32x4*)(qrow + 64 * ks + 32 * hh + 16);
        qf[ks][0] = a.x; qf[ks][1] = a.y; qf[ks][2] = a.z; qf[ks][3] = a.w; qf[ks][4] = bq.x; qf[ks][5] = bq.y; qf[ks][6] = bq.z; qf[ks][7] = bq.w; }
    const LAS unsigned char* Kl = F.lds + AL_K; const LAS unsigned char* Vl = F.lds + AL_V;
    f32x16 oacc[4];
#pragma unroll
    for (int dt = 0; dt < 4; ++dt)
#pragma unroll
        for (int r = 0; r < 16; ++r) oacc[dt][r] = 0.f;
    float lsum = 0.f, mrun = -1e30f;
    const float c2 = 0.08838834764831845f * 1.4426950408889634f / (SC_QKV * SC_QKV);
    const int ngrp = OWN ? ((w >> 1) + 1) : 4;
#pragma unroll
    for (int G = 0; G < 4; ++G) {
        if (G >= ngrp) break;
        f32x16 sa, sb;
#pragma unroll
        for (int r = 0; r < 16; ++r) { sa[r] = 0.f; sb[r] = 0.f; }
#pragma unroll
        for (int ks = 0; ks < 2; ++ks) {
            const i32x8v ka = ld32(Kl + (64 * G + qi) * 144 + 64 * ks + 32 * hh), kb = ld32(Kl + (64 * G + 32 + qi) * 144 + 64 * ks + 32 * hh);
            sa = __builtin_amdgcn_mfma_scale_f32_32x32x64_f8f6f4(ka, qf[ks], sa, 0, 0, 0, 0, 0, 0);
            sb = __builtin_amdgcn_mfma_scale_f32_32x32x64_f8f6f4(kb, qf[ks], sb, 0, 0, 0, 0, 0, 0);
        }
        float tv[32];
#pragma unroll
        for (int r = 0; r < 16; ++r) { tv[r] = sa[r]; tv[16 + r] = sb[r]; }
        if (OWN && G == (w >> 1)) {
#pragma unroll
            for (int p = 0; p < 32; ++p) { const int key = 64 * G + 32 * (p >> 4) + (p & 3) + 8 * ((p >> 2) & 3) + 4 * hh; tv[p] = (key <= w * 32 + qi) ? tv[p] : -3e38f; }
        }
        float ml = tv[0];
#pragma unroll
        for (int p = 1; p < 32; ++p) ml = fmaxf(ml, tv[p]);
        ml = fmaxf(ml, __shfl_xor(ml, 32)) * c2;
        const float mnew = (ml > mrun + 6.0f) ? ml : mrun;
        const bool moved = (mnew != mrun);
        const float alpha = __builtin_amdgcn_exp2f(mrun - mnew);
        mrun = mnew;
        float ps = 0.f; i32x8v pf;
#pragma unroll
        for (int q4 = 0; q4 < 8; ++q4) { float e4[4];
#pragma unroll
            for (int j = 0; j < 4; ++j) { e4[j] = __builtin_amdgcn_exp2f(__builtin_fmaf(tv[4 * q4 + j], c2, -mnew)); ps += e4[j]; }
            int pw_ = __builtin_amdgcn_cvt_pk_fp8_f32(e4[0] * SC_P, e4[1] * SC_P, 0, false); pw_ = __builtin_amdgcn_cvt_pk_fp8_f32(e4[2] * SC_P, e4[3] * SC_P, pw_, true); pf[q4] = pw_; }
        lsum = lsum * alpha + ps;
        if (G > 0 && __any(moved)) {
#pragma unroll
            for (int dt = 0; dt < 4; ++dt)
#pragma unroll
                for (int r = 0; r < 16; ++r) oacc[dt][r] *= alpha;
        }
#pragma unroll
        for (int dt = 0; dt < 4; ++dt) {
            const i32x8v vf = ld32(Vl + (32 * dt + qi) * 272 + 64 * G + 32 * hh);
            oacc[dt] = __builtin_amdgcn_mfma_scale_f32_32x32x64_f8f6f4(vf, pf, oacc[dt], 0, 0, 0, 0, 0, 0);
        }
    }
    lsum += __shfl_xor(lsum, 32);
    if (valid) {
        unsigned char* op = F.ws + WS_OPART + ((size_t)slot * M + tok) * D + h * HD;
        const float pinv = __builtin_amdgcn_rcpf(lsum) * (SC_PART / (SC_QKV * SC_P));
        unsigned wq[4][4];
#pragma unroll
        for (int dt = 0; dt < 4; ++dt)
#pragma unroll
            for (int g4 = 0; g4 < 4; ++g4) wq[dt][g4] = pk4_fp8(oacc[dt][4 * g4 + 0] * pinv, oacc[dt][4 * g4 + 1] * pinv, oacc[dt][4 * g4 + 2] * pinv, oacc[dt][4 * g4 + 3] * pinv);
        u32x4 st[4];
#pragma unroll
        for (int d2 = 0; d2 < 2; ++d2)
#pragma unroll
            for (int g4 = 0; g4 < 4; ++g4) { const unsigned give = hh ? wq[d2][g4] : wq[2 + d2][g4], keep = hh ? wq[2 + d2][g4] : wq[d2][g4];
                const unsigned got = (unsigned)__shfl_xor((int)give, 32);
                const unsigned w_even = hh ? got : keep, w_odd = hh ? keep : got;
                st[2 * d2 + (g4 >> 1)][2 * (g4 & 1)] = w_even; st[2 * d2 + (g4 >> 1)][2 * (g4 & 1) + 1] = w_odd; }
#pragma unroll
        for (int q = 0; q < 4; ++q) *(u32x4*)(op + 64 * hh + 16 * q) = st[q];
        if (hh == 0) { f32x2 lm; lm.x = lsum; lm.y = mrun; ((f32x2*)(F.ws + WS_LPART))[((size_t)slot * M + tok) * H + h] = lm; }
    }
}
__device__ __forceinline__ void attn_group(Frame& F, int bh, int n) {
    const int b = bh >> 4, h = bh & 15;
    const gcptr Kg = opaque_s(F.ws + WS_K + ((size_t)b * T + n * MBLK) * D + h * HD);
    const gcptr Vg = opaque_s(F.ws + WS_V + ((size_t)b * T + n * MBLK) * D + h * HD);
    const int tg = make_tid(F.wave);
    __syncthreads();
#pragma unroll
    for (int i = 0; i < 4; ++i) { const int ch = tg + i * 512;
        { const int r = ch >> 3, cc = ch & 7; *(LAS u32x4*)(F.lds + AL_K + r * 144 + cc * 16) = *(const GAS u32x4*)(Kg + (unsigned)(r * D + cc * 16)); }
        { const int rl = ch & 63, cc = (ch >> 6) & 7, G = ch >> 9, r = 64 * G + rl;
          const u32x4 vv = *(const GAS u32x4*)(Vg + (unsigned)(r * D + cc * 16)); const unsigned vw[4] = {vv.x, vv.y, vv.z, vv.w};
          LAS unsigned char* vd = F.lds + AL_V + (16 * cc) * 272 + 64 * G + 32 * ((rl >> 2) & 1) + 4 * (rl >> 3) + (rl & 3);
#pragma unroll
          for (int e = 0; e < 16; ++e) vd[e * 272] = (unsigned char)(vw[e >> 2] >> (8 * (e & 3))); }
    }
    __syncthreads();
    attn_chunk<true>(F, b, h, n, 0, 0, nullptr);
    if (n < 15) {
        const int cnt = (int)__hip_atomic_load(F.ctl + CW_ACNT + bh * 16 + n, __ATOMIC_RELAXED, __HIP_MEMORY_SCOPE_AGENT);
        const int* lst = (const int*)(F.ws + WS_ALIST) + ((size_t)bh * 16 + n) * ALIST_CAP;
        for (int c = 0; c * 256 < cnt; ++c) attn_chunk<false>(F, b, h, n, c, cnt, lst);
    }
}
__device__ __forceinline__ void attn_combine_token(Frame& F, int tok) {
    const int j = (tok & (T - 1)) >> 8, nsl = j < 3 ? j : 3, hd = F.lane >> 2;
    f32x2 lm[4]; float mx = -1e30f;
#pragma unroll
    for (int s4 = 0; s4 < 4; ++s4) { const int s_ = (s4 == 0) ? 3 : s4 - 1; lm[s4] = (f32x2){0.f, -1e30f};
        if (s4 == 0 || s4 - 1 < nsl) { lm[s4] = ((const f32x2*)(F.ws + WS_LPART))[((size_t)s_ * M + tok) * H + hd]; mx = fmaxf(mx, lm[s4].y); } }
    float acc[32]; float l = 0.f;
#pragma unroll
    for (int i = 0; i < 32; ++i) acc[i] = 0.f;
#pragma unroll
    for (int s4 = 0; s4 < 4; ++s4) { const int s_ = (s4 == 0) ? 3 : s4 - 1;
        if (s4 == 0 || s4 - 1 < nsl) {
            const u32x4* p = (const u32x4*)(F.ws + WS_OPART + ((size_t)s_ * M + tok) * D + F.lane * 32);
            const float ls = lm[s4].x * __builtin_amdgcn_exp2f(lm[s4].y - mx);
            const u32x4 w0 = p[0], w1 = p[1]; const unsigned wd[8] = {w0.x, w0.y, w0.z, w0.w, w1.x, w1.y, w1.z, w1.w};
#pragma unroll
            for (int i = 0; i < 8; ++i) { const f32x2 lo = __builtin_amdgcn_cvt_pk_f32_fp8((int)wd[i], false), hi = __builtin_amdgcn_cvt_pk_f32_fp8((int)wd[i], true);
                acc[4 * i] += lo.x * ls; acc[4 * i + 1] += lo.y * ls; acc[4 * i + 2] += hi.x * ls; acc[4 * i + 3] += hi.y * ls; }
            l += ls; } }
    const float inv = __builtin_amdgcn_rcpf(l) * (1.0f / SC_PART);
    if (FP8_OUTB) { const float iv = inv * SC_OA; u32x4* o8 = (u32x4*)(F.ws + WS_OA + (size_t)tok * D + F.lane * 32);
#pragma unroll
        for (int i = 0; i < 2; ++i) { u32x4 w; w.x = pk4_fp8(acc[16 * i] * iv, acc[16 * i + 1] * iv, acc[16 * i + 2] * iv, acc[16 * i + 3] * iv); w.y = pk4_fp8(acc[16 * i + 4] * iv, acc[16 * i + 5] * iv, acc[16 * i + 6] * iv, acc[16 * i + 7] * iv);
            w.z = pk4_fp8(acc[16 * i + 8] * iv, acc[16 * i + 9] * iv, acc[16 * i + 10] * iv, acc[16 * i + 11] * iv); w.w = pk4_fp8(acc[16 * i + 12] * iv, acc[16 * i + 13] * iv, acc[16 * i + 14] * iv, acc[16 * i + 15] * iv); o8[i] = w; }
        return; }
    u32x4* o = (u32x4*)((bf16*)(F.ws + WS_OA) + (size_t)tok * D + F.lane * 32);
#pragma unroll
    for (int i = 0; i < 4; ++i) { u32x4 w; w.x = pk2(acc[8 * i] * inv, acc[8 * i + 1] * inv); w.y = pk2(acc[8 * i + 2] * inv, acc[8 * i + 3] * inv); w.z = pk2(acc[8 * i + 4] * inv, acc[8 * i + 5] * inv); w.w = pk2(acc[8 * i + 6] * inv, acc[8 * i + 7] * inv); o[i] = w; }
}
constexpr size_t WS_SLOC = WS_ORAW;
constexpr size_t WS_DLOG = WS_ORAW + 16 * MiB;
constexpr int HL_A = 0, HL_BM = 17408, HL_BMT = 34816, HL_VT = 53248, HL_SPT = 71680, HL_P = 106496, HL_EGR = 115712, HL_EEND = 116224, HL_QSUM = 116736, HL_SSQ = 118784,
              HL_STQ = HL_SPT, HL_STK = HL_SPT + 17408, HL_STG = 119808, HL_STV = 119808 + 17408;
#define HG_BAR() do { asm volatile("s_waitcnt lgkmcnt(0)" ::: "memory"); __builtin_amdgcn_s_barrier(); asm volatile("" ::: "memory"); } while (0)
template <bool FULL> __device__ __forceinline__ void hgrn_item(Frame& F, CArgs& a, int item) {
    const int bh = item >> 2, seg = item & 3, b = bh >> 4, h = bh & 15;
    if (!FULL && seg == 3) return;
    const int lane = F.lane, qi = lane & 31, hh = lane >> 5, w = F.wave;
    const int kk = F.tid & 127, tq = F.tid >> 7;
    const int vt = w & 3, ktb = 2 * (w >> 2);
    const bf16* Zq = (const bf16*)(F.ws + WS_ZQ); const bf16* Zk = (const bf16*)(F.ws + WS_ZK); const _Float16* Zg = (const _Float16*)(F.ws + WS_ZG); const bf16* Zv = (const bf16*)(F.ws + WS_ZV);
    LAS unsigned char* L = F.lds;
    LAS float* eGr = (LAS float*)(L + HL_EGR); LAS float* eEnd = (LAS float*)(L + HL_EEND); LAS float* qsum = (LAS float*)(L + HL_QSUM); LAS float* ssq = (LAS float*)(L + HL_SSQ);
    f32x16 S[2];
#pragma unroll
    for (int i = 0; i < 2; ++i)
#pragma unroll
        for (int r = 0; r < 16; ++r) S[i][r] = 0.f;
    if (FULL && seg > 0) {
        const float* sl = (const float*)(F.ws + WS_SLOC) + (size_t)bh * 3 * HD * HD; const float* dl = (const float*)(F.ws + WS_DLOG) + (size_t)bh * 3 * HD;
        LAS float* tile = (LAS float*)L; LAS float* fac = (LAS float*)(L + 65536);
        float dsum = 0.f;
        for (int s_ = seg - 1; s_ >= 0; --s_) {
            __syncthreads();
            const f32x4* src = (const f32x4*)(sl + (size_t)s_ * HD * HD);
#pragma unroll
            for (int i = 0; i < 8; ++i) ((LAS f32x4*)tile)[F.tid + i * 512] = src[F.tid + i * 512];
            if (F.tid < 128) { fac[F.tid] = __expf(dsum); dsum += dl[s_ * HD + F.tid]; }
            __syncthreads();
            const LAS float* tl = tile + (4 * hh) * HD + 32 * vt + qi; const LAS float* fl = fac + 4 * hh;
#pragma unroll
            for (int i = 0; i < 2; ++i)
#pragma unroll
                for (int r = 0; r < 16; ++r) { const int dkc = 32 * (ktb + i) + (r & 3) + 8 * (r >> 2); S[i][r] += fl[dkc] * tl[dkc * HD]; }
        }
    }
    float gtot = 0.f;
    u32x4 rq[2], rk[2], rg[2], rv[2];
#define HG_PREFETCH(cc) do { const size_t tk_ = (size_t)b * T + (size_t)(seg * 16 + (cc)) * 64; _Pragma("unroll") for (int i_ = 0; i_ < 2; ++i_) { const int row_ = 16 * (w >> 1) + (lane >> 3) + 8 * i_, ch_ = 8 * (w & 1) + (lane & 7); const size_t go_ = (tk_ + row_) * D + h * HD + ch_ * 8; \
        rk[i_] = *(const u32x4*)(Zk + go_); rg[i_] = *(const u32x4*)((const bf16*)Zg + go_); rv[i_] = *(const u32x4*)(Zv + go_); if (FULL) rq[i_] = *(const u32x4*)(Zq + go_); } } while (0)
    HG_PREFETCH(0);
    __syncthreads();
    for (int c = 0; c < 16; ++c) {
        const size_t tok0 = (size_t)b * T + (size_t)(seg * 16 + c) * 64;
#pragma unroll
        for (int i = 0; i < 2; ++i) { const int so = (16 * (w >> 1) + (lane >> 3) + 8 * i) * 272 + (8 * (w & 1) + (lane & 7)) * 16;
            *(LAS u32x4*)(L + HL_STK + so) = rk[i]; *(LAS u32x4*)(L + HL_STG + so) = rg[i]; *(LAS u32x4*)(L + HL_STV + so) = rv[i]; if (FULL) *(LAS u32x4*)(L + HL_STQ + so) = rq[i]; }
        LDS_WAIT();
        float gl[16];
        { float run = 0.f;
#pragma unroll
            for (int i = 0; i < 16; ++i) { run += (float)*(const LAS _Float16*)(L + HL_STG + (16 * tq + i) * 272 + kk * 2); gl[i] = run; }
            qsum[tq * 128 + kk] = run; }
        HG_BAR();
        {
            const float q0 = qsum[kk], q1 = qsum[128 + kk], q2 = qsum[256 + kk], q3 = qsum[384 + kk];
            const float pre = (tq > 0 ? q0 : 0.f) + (tq > 1 ? q1 : 0.f) + (tq > 2 ? q2 : 0.f), Gr = q0 + q1, Gend = (q0 + q1) + (q2 + q3);
            unsigned bt[8], vtw[8];
#pragma unroll
            for (int i = 0; i < 16; i += 2) {
                const int t0 = 16 * tq + i;
                const float G0 = pre + gl[i], G1 = pre + gl[i + 1];
                const float eb0 = __expf(Gr - G0), eb1 = __expf(Gr - G1);
                const float b0 = bf2f(*(const LAS bf16*)(L + HL_STK + t0 * 272 + kk * 2)) * eb0, b1 = bf2f(*(const LAS bf16*)(L + HL_STK + (t0 + 1) * 272 + kk * 2)) * eb1;
                bt[i >> 1] = pk2(b0, b1);
                vtw[i >> 1] = (unsigned)*(const LAS bf16*)(L + HL_STV + t0 * 272 + kk * 2) | ((unsigned)*(const LAS bf16*)(L + HL_STV + (t0 + 1) * 272 + kk * 2) << 16);
                if (FULL) { const float ea0 = __expf(G0 - Gr), ea1 = __expf(G1 - Gr);
                    const float qa = bf2f(*(const LAS bf16*)(L + HL_STQ + t0 * 272 + kk * 2)), qb = bf2f(*(const LAS bf16*)(L + HL_STQ + (t0 + 1) * 272 + kk * 2));
                    *(LAS bf16*)(L + HL_A + t0 * 272 + kk * 2) = (bf16)f2bf(qa * ea0); *(LAS bf16*)(L + HL_A + (t0 + 1) * 272 + kk * 2) = (bf16)f2bf(qb * ea1);
                    *(LAS bf16*)(L + HL_BM + t0 * 272 + kk * 2) = (bf16)(bt[i >> 1] & 0xffffu); *(LAS bf16*)(L + HL_BM + (t0 + 1) * 272 + kk * 2) = (bf16)(bt[i >> 1] >> 16); }
                __builtin_amdgcn_sched_barrier(0);
            }
            *(LAS u32x4*)(L + HL_BMT + kk * 144 + tq * 32) = (u32x4){bt[0], bt[1], bt[2], bt[3]}; *(LAS u32x4*)(L + HL_BMT + kk * 144 + tq * 32 + 16) = (u32x4){bt[4], bt[5], bt[6], bt[7]};
            *(LAS u32x4*)(L + HL_VT + kk * 144 + tq * 32) = (u32x4){vtw[0], vtw[1], vtw[2], vtw[3]}; *(LAS u32x4*)(L + HL_VT + kk * 144 + tq * 32 + 16) = (u32x4){vtw[4], vtw[5], vtw[6], vtw[7]};
            if (tq == 0) { eGr[kk] = __expf(Gr); eEnd[kk] = __expf(Gend - Gr); }
            gtot += Gend;
        }
        HG_BAR();
        if (c + 1 < 16) HG_PREFETCH(c + 1);
#pragma unroll
        for (int i = 0; i < 2; ++i)
#pragma unroll
            for (int g4 = 0; g4 < 4; ++g4) { const int dk0 = 32 * (ktb + i) + 8 * g4 + 4 * hh; const f32x4 e = *(const LAS f32x4*)(eGr + dk0);
#pragma unroll
                for (int j = 0; j < 4; ++j) S[i][4 * g4 + j] *= e[j];
                if (FULL) { u32x2 wv; wv.x = pg8::cvt_pk_bf16_n(S[i][4 * g4], S[i][4 * g4 + 1]); wv.y = pg8::cvt_pk_bf16_n(S[i][4 * g4 + 2], S[i][4 * g4 + 3]);
                    *(LAS u32x2*)(L + HL_SPT + (32 * vt + qi) * 272 + dk0 * 2) = wv; } }
        if (FULL && w < 3) {
            const int st = (w == 2) ? 1 : 0, tt = (w == 0) ? 0 : 1;
            f32x16 sc;
#pragma unroll
            for (int r = 0; r < 16; ++r) sc[r] = 0.f;
#pragma unroll
            for (int ks = 0; ks < 8; ++ks) { const bf16x8 af = *(const LAS bf16x8*)(L + HL_BM + (32 * st + qi) * 272 + (16 * ks + 8 * hh) * 2); const bf16x8 bfr = *(const LAS bf16x8*)(L + HL_A + (32 * tt + qi) * 272 + (16 * ks + 8 * hh) * 2);
                sc = __builtin_amdgcn_mfma_f32_32x32x16_bf16(af, bfr, sc, 0, 0, 0); }
#pragma unroll
            for (int g4 = 0; g4 < 4; ++g4) { const int s0 = 32 * st + 8 * g4 + 4 * hh, t = 32 * tt + qi; float p[4];
#pragma unroll
                for (int j = 0; j < 4; ++j) p[j] = sc[4 * g4 + j] * __builtin_amdgcn_fmed3f((float)(t - (s0 + j) + 1), 0.f, 1.f);
                u32x2 wv; wv.x = pg8::cvt_pk_bf16_n(p[0], p[1]); wv.y = pg8::cvt_pk_bf16_n(p[2], p[3]);
                *(LAS u32x2*)(L + HL_P + t * 144 + s0 * 2) = wv; }
        }
#pragma unroll
        for (int ks2 = 0; ks2 < 4; ++ks2) { const bf16x8 vf = *(const LAS bf16x8*)(L + HL_VT + (32 * vt + qi) * 144 + (16 * ks2 + 8 * hh) * 2);
#pragma unroll
            for (int i = 0; i < 2; ++i) { const bf16x8 bf_ = *(const LAS bf16x8*)(L + HL_BMT + (32 * (ktb + i) + qi) * 144 + (16 * ks2 + 8 * hh) * 2);
                S[i] = __builtin_amdgcn_mfma_f32_32x32x16_bf16(bf_, vf, S[i], 0, 0, 0); } }
#pragma unroll
        for (int i = 0; i < 2; ++i)
#pragma unroll
            for (int g4 = 0; g4 < 4; ++g4) { const int dk0 = 32 * (ktb + i) + 8 * g4 + 4 * hh; const f32x4 e = *(const LAS f32x4*)(eEnd + dk0);
#pragma unroll
                for (int j = 0; j < 4; ++j) S[i][4 * g4 + j] *= e[j]; }
        if (FULL) {
            HG_BAR();
            const int tt = w & 1, dt = w >> 1, t = 32 * tt + qi;
            f32x16 o;
#pragma unroll
            for (int r = 0; r < 16; ++r) o[r] = 0.f;
#pragma unroll
            for (int ks = 0; ks < 8; ++ks) { const bf16x8 af = *(const LAS bf16x8*)(L + HL_SPT + (32 * dt + qi) * 272 + (16 * ks + 8 * hh) * 2); const bf16x8 bfr = *(const LAS bf16x8*)(L + HL_A + t * 272 + (16 * ks + 8 * hh) * 2);
                o = __builtin_amdgcn_mfma_f32_32x32x16_bf16(af, bfr, o, 0, 0, 0); }
#pragma unroll
            for (int ks2 = 0; ks2 < 4; ++ks2) if (ks2 < 2 * (tt + 1)) { const bf16x8 af = *(const LAS bf16x8*)(L + HL_VT + (32 * dt + qi) * 144 + (16 * ks2 + 8 * hh) * 2); const bf16x8 bfr = *(const LAS bf16x8*)(L + HL_P + t * 144 + (16 * ks2 + 8 * hh) * 2);
                o = __builtin_amdgcn_mfma_f32_32x32x16_bf16(af, bfr, o, 0, 0, 0); }
            float sq = 0.f;
#pragma unroll
            for (int r = 0; r < 16; ++r) sq += o[r] * o[r];
            sq += __shfl_xor(sq, 32);
            if (hh == 0) ssq[dt * 64 + t] = sq;
            HG_BAR();
            const float tot = (ssq[t] + ssq[64 + t]) + (ssq[128 + t] + ssq[192 + t]);
            const float rstd = __builtin_amdgcn_rsqf(tot * (1.f / HD) + RMS_EPS);
            const size_t ro = (tok0 + t) * D + h * HD;
#pragma unroll
            for (int g4 = 0; g4 < 4; ++g4) { const int dv0 = 32 * dt + 8 * g4 + 4 * hh;
                const u32x2 gt = *(const u32x2*)((const bf16*)(F.ws + WS_ZGATE) + ro + dv0); const f32x4 gn = *(const f32x4*)(a.in[I_A_OGAIN] + dv0);
                u32x2 wv; wv.x = pg8::cvt_pk_bf16_n(o[4 * g4] * rstd * gn.x * bflo(gt.x), o[4 * g4 + 1] * rstd * gn.y * bfhi(gt.x)); wv.y = pg8::cvt_pk_bf16_n(o[4 * g4 + 2] * rstd * gn.z * bflo(gt.y), o[4 * g4 + 3] * rstd * gn.w * bfhi(gt.y));
                *(u32x2*)((bf16*)(F.ws + WS_OH) + ro + dv0) = wv; }
        }
    }
#undef HG_PREFETCH
    if (!FULL) {
        float* sl = (float*)(F.ws + WS_SLOC) + ((size_t)bh * 3 + seg) * HD * HD;
#pragma unroll
        for (int i = 0; i < 2; ++i)
#pragma unroll
            for (int r = 0; r < 16; ++r) { const int dk = 32 * (ktb + i) + (r & 3) + 8 * (r >> 2) + 4 * hh; sl[(size_t)dk * HD + 32 * vt + qi] = S[i][r]; }
        if (tq == 0) ((float*)(F.ws + WS_DLOG))[((size_t)bh * 3 + seg) * HD + kk] = gtot;
    }
    __syncthreads();
}

constexpr int N_PHASES = 19;
#ifndef REP_MASK
#define REP_MASK 0
#endif
#define NREP(k) ((((REP_MASK) >> (k)) & 1) ? 2 : 1)
__global__ void __launch_bounds__(NTHR, 2) fwd(Args args_kernarg) {
    extern __shared__ __attribute__((aligned(16))) unsigned char lds_raw[];
    Frame F;
    CArgs* pa = (CArgs*)__builtin_amdgcn_kernarg_segment_ptr();
#define args (*pa)
    F.lds = (LAS unsigned char*)lds_raw; F.ws = args.ws; F.ctl = (unsigned*)(args.ws + WS_CTL);
    F.wave = __builtin_amdgcn_readfirstlane((int)threadIdx.x >> 6); F.tid = make_tid(F.wave); F.lane = F.tid & 63;
    F.G = gridDim.x; { const int bx = blockIdx.x; F.vcu = (F.G % 8 == 0) ? (bx % 8) * (F.G / 8) + bx / 8 : bx; }
    F.gw = F.vcu * NWAVES + F.wave; F.NGW = F.G * NWAVES;
    for (int u = F.tid; u < (LDS_BYTES - LDSCTL_OFF) / 4; u += NTHR) ((LAS unsigned*)(F.lds + LDSCTL_OFF))[u] = 0u;
    __syncthreads();
    const int lo = args.ph_lo, hi = args.ph_hi;
    const bool multi = (hi - lo) > 1;
    XcdBarrier bar; bar.bar = F.ctl + CW_BAR; bar.x = 0; bar.st = nullptr;
    if (multi) bar = xcd_barrier_post(F.ctl + CW_BAR, (volatile LAS unsigned*)(F.lds + LDSCTL_OFF), F.tid);
#define REFRESH() do { pa = (CArgs*)__builtin_amdgcn_kernarg_segment_ptr(); asm volatile("" : "+s"(pa)); ws = args.ws; F.ws = ws; F.ctl = (unsigned*)(ws + WS_CTL); const int t_ = make_tid(F.wave); F.tid = t_; F.lane = t_ & 63; F.gw = F.vcu * NWAVES + F.wave; } while (0)
#define IN(k) (lo <= (k) && (k) < hi)
#define SEAM(k) do { if (IN(k) && IN((k) + 1)) xcd_barrier(bar, make_tid(F.wave)); } while (0)
    unsigned char* ws = args.ws;
    (void)args_kernarg;
    const int GT = F.NGW * 64;

    if (IN(0)) _Pragma("unroll") for (int rep_ = 0; rep_ < NREP(0); ++rep_) { REFRESH();
        const int gtid = F.gw * 64 + F.lane;
        LAS float* scr = (LAS float*)(F.lds + F.wave * TR_SCR_BYTES);
        constexpr int J0 = 16 * 256;
        tr_run([&](int it) { TrItem t; t.src = args.in[I_A_W_IN]; t.ksc = args.in[I_NORM_MIX]; t.dst = ws + WS_WIN; t.N = 4 * D; t.K = D; t.k0 = 128 * (it / 256); t.n0 = 32 * (it % 256); t.drow0 = t.n0; t.flags = 0; t.osc = 1.f; return t; },
               F.gw, J0, F.NGW, scr, F.lane);
        for (int c = gtid; c < D; c += GT) { const float* L = args.in[I_A_LB]; const float l0 = L[c], l1 = L[D + c], l2 = L[2 * D + c]; const float mx = fmaxf(l0, fmaxf(l1, l2));
            const float e0 = expf(l0 - mx), e1 = expf(l1 - mx), e2 = expf(l2 - mx); ((float*)(ws + WS_LB))[c] = e0 / (e0 + e1 + e2); }
        for (int i = gtid; i < 2 * 36 * D; i += GT) { const int l = i / (36 * D), r = (i / D) % 36, k = i % D;
            ((float*)(ws + WS_RT))[i] = r < 4 ? args.in[I_W_GROUP][((size_t)l * D + k) * NG + r] : args.in[I_W_EXPERT][((size_t)l * D + k) * NE + (r - 4)]; }
        { const int fi = gtid & 63; const float inv = exp2f(-(float)fi * (13.287712379549449f / 64.0f));
          for (int i = gtid; i < T * 64; i += GT) { const float ang = (float)(i >> 6) * inv; float sn_, cs_; sincosf(ang, &sn_, &cs_); ((f32x2*)(ws + WS_ROPE))[i] = (f32x2){cs_, sn_}; } }
        for (int m = F.gw; m < M; m += F.NGW) rms_row_to_bf16(args.in[I_X] + (size_t)m * D, (bf16*)(ws + WS_XN) + (size_t)m * D, F.lane);
    }
    SEAM(0);
    if (IN(1)) _Pragma("unroll") for (int rep_ = 0; rep_ < NREP(1); ++rep_) { REFRESH();
        constexpr int NCV = 112, J1 = 16 * 64, J2 = 16 * 128, J3 = 16 * 64, J4 = 16 * 64, J5 = MOE_CV_ITEMS;
        if ((int)blockIdx.x < NCV) {
            LAS float* scr = (LAS float*)(F.lds + F.wave * TR_SCR_BYTES);
            tr_run([&](int r) { TrItem t; t.osc = 1.f; t.ksc = nullptr; t.flags = 0; t.N = D; t.K = D;
                    if (r < J1) { t.src = args.in[I_A_W_OUT]; t.dst = ws + WS_WOA; t.k0 = 128 * (r / 64); t.n0 = 32 * (r % 64); t.drow0 = t.n0; return t; } r -= J1;
                    if (r < J2) { const int nb = r % 128; t.src = args.in[I_KV_W]; t.ksc = args.in[I_KV_NORM]; t.dst = ws + WS_WQKV; t.N = 2 * D; t.k0 = 128 * (r / 128); t.n0 = 32 * nb; t.drow0 = D + t.n0;
                                  t.flags = (FP8_QKV ? 2 : 0) | (nb < 64 ? 1 : 0); t.osc = FP8_QKV ? SC_W : 1.f; return t; } r -= J2;
                    if (r < J3) { t.src = args.in[I_B_W_Q]; t.ksc = args.in[I_NORM_MIX] + D; t.dst = ws + WS_WQKV; t.k0 = 128 * (r / 64); t.n0 = 32 * (r % 64); t.drow0 = t.n0; t.flags = (FP8_QKV ? 2 : 0) | 1; t.osc = FP8_QKV ? SC_W : 1.f; return t; } r -= J3;
                    if (r < J4) { t.src = args.in[I_B_W_OUT]; t.dst = ws + WS_WOB; t.k0 = 128 * (r / 64); t.n0 = 32 * (r % 64); t.drow0 = t.n0; t.flags = FP8_OUTB ? 2 : 0; t.osc = FP8_OUTB ? SC_W : 1.f; return t; } r -= J4;
                    return moe_cv_item(args, ws, 0, r); },
                   (int)blockIdx.x * NWAVES + F.wave, J1 + J2 + J3 + J4 + J5, NCV * NWAVES, scr, F.lane);
            __syncthreads();
        }
        pg8::DynOrder S; S.init(ws + WS_XN, ws + WS_WIN, M, 4 * D, D, F.wave, F.ctl + CW_DYN, (LAS int*)(F.lds + LDSCTL_OFF + 32));
        pg8::EpiHgrnIn E{ws + WS_R, (const float*)(ws + WS_LB)};
        pg8::gemm_phase<pg8::EpiHgrnIn, pg8::DynOrder, true>(F.lds, S, E);
    }
    SEAM(1);
    if (IN(2)) _Pragma("unroll") for (int rep_ = 0; rep_ < NREP(2); ++rep_) { REFRESH(); for (int it = F.vcu; it < 256; it += F.G) hgrn_item<false>(F, args, it); }
    SEAM(2);
    if (IN(3)) _Pragma("unroll") for (int rep_ = 0; rep_ < NREP(3); ++rep_) { REFRESH(); for (int it = F.vcu; it < 256; it += F.G) hgrn_item<true>(F, args, it); }
    SEAM(3);
    if (IN(4)) _Pragma("unroll") for (int rep_ = 0; rep_ < NREP(4); ++rep_) { REFRESH();
        pg8::DenseOrder S; S.init(ws + WS_OH, ws + WS_WOA, M, D, D, F.G, (int)blockIdx.x, F.wave);
        pg8::EpiRes16<true> E{(bf16*)(ws + WS_XR), args.in[I_X], 1.0f};
        pg8::gemm_phase<pg8::EpiRes16<true>, pg8::DenseOrder, true>(F.lds, S, E);
    }
    SEAM(4);
#define MOE_LAYER(P, layer, F8, O8) \
    if (IN(P)) { REFRESH(); REFRESH(); if (NREP(P) == 2) { for (int t = F.gw; t < M; t += F.NGW) route_token<true, F8>(F, args, layer, t); } for (int t = F.gw; t < M; t += F.NGW) route_token<false, F8>(F, args, layer, t); } \
    SEAM(P); \
    if (IN((P) + 1)) _Pragma("unroll") for (int rep_ = 0; rep_ < NREP((P) + 1); ++rep_) { REFRESH(); const int nrb = __builtin_amdgcn_readfirstlane(moe_tables(F, layer)); \
        pg8::MoeOrder<true> S; S.A = (const char*)(ws + WS_XN); S.B = (const char*)(ws + WS_WGU + (size_t)(layer) * WGU_LSTRIDE); S.estride = (size_t)1024 * D * (F8 ? 1 : 2); S.K = D; S.RB = F8 ? D : 2 * D; S.NT = 4; S.total = nrb * 4; S.G = F.G; S.c = F.vcu; S.wv = F.wave; \
        S.blk_e = (const LAS int*)(F.lds + LT_BLKE); S.blkstart = (const LAS int*)(F.lds + LT_BLKSTART); S.cnt = (const LAS int*)(F.lds + LT_CNT); S.list = (const int*)(ws + WS_LISTS); \
        pg8::EpiSwiGLU<F8> E{(bf16*)(ws + WS_ACT), F8 ? 1.0f / (SC_XN * SC_W) : 1.0f}; \
        pg8::gemm_phase<pg8::EpiSwiGLU<F8>, pg8::MoeOrder<true>, true, F8>(F.lds, S, E); } \
    SEAM((P) + 1); \
    if (IN((P) + 2)) _Pragma("unroll") for (int rep_ = 0; rep_ < NREP((P) + 2); ++rep_) { REFRESH(); const int nrb = __builtin_amdgcn_readfirstlane(moe_tables(F, layer)); \
        pg8::MoeOrder<false> S; S.A = (const char*)(ws + WS_ACT); S.B = (const char*)(ws + WS_WD + (size_t)(layer) * WD_LSTRIDE); S.estride = (size_t)D * FF * (F8 ? 1 : 2); S.K = FF; S.RB = F8 ? FF : 2 * FF; S.NT = 8; S.total = nrb * 8; S.G = F.G; S.c = F.vcu; S.wv = F.wave; \
        S.blk_e = (const LAS int*)(F.lds + LT_BLKE); S.blkstart = (const LAS int*)(F.lds + LT_BLKSTART); S.cnt = (const LAS int*)(F.lds + LT_CNT); S.list = (const int*)(ws + WS_LISTS); \
        if constexpr (O8) { pg8::EpiOut8 E{ws + WS_OUTB, D, (F8 ? 1.0f / (SC_ACT * SC_WD) : 1.0f) * SC_OUT}; pg8::gemm_phase<pg8::EpiOut8, pg8::MoeOrder<false>, true, F8>(F.lds, S, E); } \
        else { pg8::EpiBf16 E{(bf16*)(ws + WS_OUTB), D, 0, 0, F8 ? 1.0f / (SC_ACT * SC_WD) : 1.0f}; pg8::gemm_phase<pg8::EpiBf16, pg8::MoeOrder<false>, true, F8>(F.lds, S, E); } } \
    SEAM((P) + 2);
    MOE_LAYER(5, 0, FP8_MOE0, OUT8_L0)
    if (IN(8)) { REFRESH();
        (void)moe_tables(F, 0);
        if (NREP(8) == 2) { for (int t = F.gw; t < M; t += F.NGW) combine_token<true, true, OUT8_L0>(F, args, t); }
        for (int t = F.gw; t < M; t += F.NGW) combine_token<true, false, OUT8_L0>(F, args, t);
    }
    SEAM(8);
    if (IN(9)) _Pragma("unroll") for (int rep_ = 0; rep_ < NREP(9); ++rep_) { REFRESH();
        constexpr int NCV2 = 112;
        if ((int)blockIdx.x < NCV2) {
            LAS float* scr = (LAS float*)(F.lds + F.wave * TR_SCR_BYTES);
            tr_run([&](int it) { return moe_cv_item(args, ws, 1, it); }, (int)blockIdx.x * NWAVES + F.wave, MOE_CV_ITEMS, NCV2 * NWAVES, scr, F.lane);
            __syncthreads();
        }
        pg8::DynOrder S; S.init(ws + WS_XN, ws + WS_WQKV, M, 3 * D, D, F.wave, F.ctl + CW_DYN + 64, (LAS int*)(F.lds + LDSCTL_OFF + 32), FP8_QKV);
        pg8::EpiQKV E{(bf16*)(ws + WS_Q), (bf16*)(ws + WS_K), (bf16*)(ws + WS_V), args.in[I_B_Q_NORM], args.in[I_K_NORM], (const f32x2*)(ws + WS_ROPE), (float*)(ws + WS_KMEAN), F.lds + 131072, FP8_QKV ? 1.0f / (SC_XN * SC_W) : 1.0f, F.wave};
        pg8::gemm_phase<pg8::EpiQKV, pg8::DynOrder, true, FP8_QKV>(F.lds, S, E);
    }
    SEAM(9);
    if (IN(11)) { REFRESH(); if (NREP(11) == 2) { for (int it = F.vcu; it < 64 * 8; it += F.G) moba_gate_item<true>(F, it); } for (int it = F.vcu; it < 64 * 8; it += F.G) moba_gate_item<false>(F, it); }
    SEAM(11);
    if (IN(12)) _Pragma("unroll") for (int rep_ = 0; rep_ < NREP(12); ++rep_) { REFRESH();
        for (int v = F.vcu; v < 256; v += F.G) { const int bh = v >> 2, q = v & 3;
            _Pragma("unroll 1") for (int gi = 0; gi < 4; ++gi) { const int n = (gi == 0) ? q : ((gi == 1) ? 7 - q : ((gi == 2) ? 8 + q : 15 - q)); attn_group(F, bh, n); } }
    }
    SEAM(12);
    if (IN(13)) _Pragma("unroll") for (int rep_ = 0; rep_ < NREP(13); ++rep_) { REFRESH(); for (int t = F.gw; t < M; t += F.NGW) attn_combine_token(F, t); }
    SEAM(13);
    if (IN(14)) { REFRESH();
        pg8::DenseOrder S; S.init(ws + WS_OA, ws + WS_WOB, M, D, D, F.G, (int)blockIdx.x, F.wave, FP8_OUTB);
        pg8::EpiRes16<false> E{(bf16*)(ws + WS_XR), nullptr, FP8_OUTB ? 1.0f / (SC_OA * SC_W) : 1.0f};
        pg8::gemm_phase<pg8::EpiRes16<false>, pg8::DenseOrder, true, FP8_OUTB>(F.lds, S, E);
    }
    SEAM(14);
    MOE_LAYER(15, 1, FP8_MOE1, OUT8_L1)
    if (IN(18)) { REFRESH(); (void)moe_tables(F, 1); for (int t = F.gw; t < M; t += F.NGW) combine_token<false, false, OUT8_L1>(F, args, t); }
#undef IN
#undef SEAM
#undef MOE_LAYER
#undef args
}

#ifndef MK_N_LAUNCHES
#define MK_N_LAUNCHES 1
#endif
#ifndef DBG_STOP
#define DBG_STOP N_PHASES
#endif
extern "C" void kernel_launch(void* const* d_in, const int* in_sizes, int n_in, void* d_out, int out_size, void* d_ws, size_t ws_size, hipStream_t stream) {
    static int grid = 0;
    if (grid == 0) {
        if (n_in != 20 || in_sizes[0] != M * D || out_size != M * D || ws_size < WS_END) { fprintf(stderr, "kernel_launch: unexpected shapes (n_in %d, in0 %d, out %d, ws %zu < %zu); nothing launched\n", n_in, n_in > 0 ? in_sizes[0] : -1, out_size, ws_size, (size_t)WS_END); grid = -1; return; }
        int dev = 0, cus = 0, per_cu = 0;
        if (hipGetDevice(&dev) != hipSuccess || hipDeviceGetAttribute(&cus, hipDeviceAttributeMultiprocessorCount, dev) != hipSuccess) { grid = -1; return; }
        if (hipFuncSetAttribute((const void*)fwd, hipFuncAttributeMaxDynamicSharedMemorySize, LDS_BYTES) != hipSuccess) { fprintf(stderr, "kernel_launch: hipFuncSetAttribute failed\n"); grid = -1; return; }
        if (hipOccupancyMaxActiveBlocksPerMultiprocessor(&per_cu, (const void*)fwd, NTHR, LDS_BYTES) != hipSuccess || per_cu < 1) { fprintf(stderr, "kernel_launch: occupancy query says %d blocks per CU\n", per_cu); }
        (void)hipGetLastError();
        grid = cus;
    }
    if (grid < 0) return;
    (void)hipMemsetAsync((char*)d_ws + WS_CTL, 0, CTL_ZERO_BYTES, stream);
    Args a{};
    for (int i = 0; i < 20; ++i) a.in[i] = (const float*)d_in[i];
    a.out = (float*)d_out; a.ws = (unsigned char*)d_ws;
    if (MK_N_LAUNCHES == 1) { a.ph_lo = 0; a.ph_hi = N_PHASES; hipLaunchKernelGGL(fwd, dim3(grid), dim3(NTHR), LDS_BYTES, stream, a); }
    else for (int p = 0; p < DBG_STOP; ++p) { a.ph_lo = p; a.ph_hi = p + 1; hipLaunchKernelGGL(fwd, dim3(grid), dim3(NTHR), LDS_BYTES, stream, a); }
}
```

```cpp
#include <hip/hip_runtime.h>
#include <cstdio>
#include <cstdint>

#define GAS __attribute__((address_space(1)))
#define LAS __attribute__((address_space(3)))
typedef unsigned short bf16;
typedef short bf16x8 __attribute__((ext_vector_type(8)));
typedef float f32x4 __attribute__((ext_vector_type(4)));
typedef float f32x2 __attribute__((ext_vector_type(2)));
typedef unsigned u32x4 __attribute__((ext_vector_type(4)));
typedef unsigned u32x2 __attribute__((ext_vector_type(2)));

constexpr int BATCH = 4, T = 4096, D = 2048, M = BATCH * T, H = 16, HD = 128;
constexpr int NBLK = 16, MBLK = 256;
constexpr int NG = 4, EPG = 8, NE = 32, FF = 512;
constexpr float RMS_EPS = 1e-6f;
constexpr int NWAVES = 8, NTHR = 512;
constexpr int LIST_CAP = 16384;
constexpr int MAXRB = 160;

constexpr size_t MiB = 1u << 20;
constexpr size_t WS_CTL = 0, CTL_ZERO_BYTES = 1 * MiB;
constexpr size_t WS_LISTS = 1 * MiB;
constexpr size_t WS_TOKREC = 3 * MiB;
constexpr size_t WS_LB = 4 * MiB;
constexpr size_t WS_RT = 4 * MiB + 65536;
constexpr size_t WS_ROPE = 5 * MiB;
constexpr size_t WS_KMEAN = 7 * MiB;
constexpr size_t WS_WIN = 8 * MiB, WS_WOA = 40 * MiB, WS_WQKV = 48 * MiB, WS_WOB = 72 * MiB;
constexpr size_t WS_WGU = 80 * MiB, WS_WD = 208 * MiB;
constexpr size_t WS_XN = 272 * MiB;
constexpr size_t WS_ACT = 336 * MiB;
constexpr size_t WS_R = 376 * MiB;
constexpr size_t WS_ZQ = WS_R, WS_ZK = WS_R + 64 * MiB, WS_ZG = WS_R + 128 * MiB, WS_ZV = WS_R + 192 * MiB, WS_ZGATE = WS_R + 256 * MiB;
constexpr size_t WS_ORAW = WS_R + 320 * MiB;
constexpr size_t WS_OH = WS_R + 448 * MiB;
constexpr size_t WS_OUTB = WS_R;
constexpr size_t WS_Q = WS_R, WS_K = WS_R + 64 * MiB, WS_V = WS_R + 128 * MiB, WS_VT = WS_R + 192 * MiB, WS_OA = WS_R + 256 * MiB;
constexpr size_t WS_XR = WS_R + 192 * MiB;
constexpr size_t WS_OPART = WS_R + 320 * MiB;
constexpr size_t WS_LPART = WS_R + 576 * MiB;
constexpr size_t WS_ALIST = WS_R + 584 * MiB;
constexpr int ALIST_CAP = 3840;
constexpr size_t WS_END = WS_R + 604 * MiB;
constexpr int CW_TMO = 0;
constexpr int CW_BAR = 4096;
constexpr int CW_CNT = 8192;
#define CW_CNT_AT(l, e) (CW_CNT + 2048 * (l) + 64 * (e))
constexpr int CW_ACNT = 16384;
constexpr int CW_DYN = 20480;

constexpr int RING_BYTES = 159744;
constexpr int LDSCTL_OFF = RING_BYTES;
constexpr int LT_BLKE = LDSCTL_OFF + 64;
constexpr int LT_BLKSTART = LT_BLKE + MAXRB * 4;
constexpr int LT_CNT = LT_BLKSTART + 36 * 4;
constexpr int LT_END = LT_CNT + 32 * 4;
constexpr int LDS_BYTES = 163840;
static_assert(LT_END <= LDS_BYTES, "LDS map");

__device__ __forceinline__ unsigned f2bf(float f) { unsigned u = __builtin_bit_cast(unsigned, f); return (u + 0x7fffu + ((u >> 16) & 1u)) >> 16; }
__device__ __forceinline__ unsigned pk2(float lo, float hi) { return f2bf(lo) | (f2bf(hi) << 16); }
__device__ __forceinline__ float bf2f(unsigned b) { return __builtin_bit_cast(float, b << 16); }
__device__ __forceinline__ float bflo(unsigned w) { return __builtin_bit_cast(float, w << 16); }
__device__ __forceinline__ float bfhi(unsigned w) { return __builtin_bit_cast(float, w & 0xffff0000u); }
__device__ __forceinline__ float wave_sum(float v) {
#pragma unroll
    for (int o = 1; o < 64; o <<= 1) v += __shfl_xor(v, o);
    return v;
}
#ifndef FP8_QKV
#define FP8_QKV 1
#endif
#ifndef FP8_OUTB
#define FP8_OUTB 1
#endif
#ifndef FP8_MOE1
#define FP8_MOE1 1
#endif
#ifndef FP8_MOE0
#define FP8_MOE0 1
#endif
#ifndef OUT8_L0
#define OUT8_L0 1
#endif
#ifndef OUT8_L1
#define OUT8_L1 1
#endif
constexpr float SC_XN = 16.f, SC_W = 1024.f, SC_ACT = 8.f, SC_WD = 512.f, SC_OA = 64.f, SC_PART = 64.f, SC_OUT = 32.f, SC_QKV = 32.f;
__device__ __forceinline__ unsigned pk4_fp8(float a, float b, float c, float d) {
    a = __builtin_amdgcn_fmed3f(a, -448.f, 448.f); b = __builtin_amdgcn_fmed3f(b, -448.f, 448.f); c = __builtin_amdgcn_fmed3f(c, -448.f, 448.f); d = __builtin_amdgcn_fmed3f(d, -448.f, 448.f);
    int p = __builtin_amdgcn_cvt_pk_fp8_f32(a, b, 0, false); p = __builtin_amdgcn_cvt_pk_fp8_f32(c, d, p, true); return (unsigned)p; }
__device__ __forceinline__ int lane_id() { int l; asm volatile("v_mbcnt_lo_u32_b32 %0, -1, 0\n\tv_mbcnt_hi_u32_b32 %0, -1, %0" : "=v"(l)); return l; }
__device__ __forceinline__ int make_tid(int wv) { return wv * 64 + lane_id(); }
__device__ __forceinline__ void fp8x4_to_f32(unsigned w, float (&o)[4]) { const f32x2 lo = __builtin_amdgcn_cvt_pk_f32_fp8((int)w, false), hi = __builtin_amdgcn_cvt_pk_f32_fp8((int)w, true); o[0] = lo.x; o[1] = lo.y; o[2] = hi.x; o[3] = hi.y; }
#define LDS_WAIT() asm volatile("s_waitcnt lgkmcnt(0)" ::: "memory")
#define VM_WAIT() asm volatile("s_waitcnt vmcnt(0)" ::: "memory")

namespace pg8 {
constexpr int BM = 256, BK = 64, HALF = 128, HTB = HALF * BK * 2, STAGE_BYTES = 8 * HTB, NXCD = 8, WGM = 8;
__host__ __device__ __forceinline__ int lds_byte(int r, int c) { const int st = (r >> 4) * 2 + (c >> 5), rr = r & 15, cc = c & 31, ob = rr * 64 + cc * 2; return st * 1024 + (ob ^ (((ob >> 9) & 1) << 5)); }
__host__ __device__ __forceinline__ void stage_rc(int b, int& R, int& C) { const int st = b / 1024, sb = b % 1024, swz = sb ^ (((sb >> 9) & 1) << 5); R = (st >> 1) * 16 + swz / 64; C = (st & 1) * 32 + (swz % 64) / 2; }
__host__ __device__ __forceinline__ int perm32(int rho) { const int n = rho >> 4, i = rho & 15; return 8 * (i >> 2) + 4 * n + (i & 3); }

struct Unit { int pm, pn; const char* a; const char* b; int e0, lbase, cnt; };

struct DenseOrder {
    static constexpr bool GATHER = false, DYNAMIC = false;
    const char* A; const char* B; int K, RB; int nM, nN, nwg, G, c, wv;
    __device__ void init(const void* A_, const void* B_, int M_, int N_, int K_, int G_, int c_, int wv_, bool fp8 = false) { wv = wv_; A = (const char*)A_; B = (const char*)B_; K = K_; RB = fp8 ? K_ : 2 * K_; nM = M_ / BM; nN = N_ / BM; nwg = nM * nN; G = G_; c = c_; }
    __device__ __forceinline__ bool next(int i, Unit& u) const {
        const int L = i * G + c; if (L >= nwg) return false;
        int wgid = (int)L; { const int q = nwg / NXCD, r = nwg % NXCD, xcd = wgid % NXCD, off = wgid / NXCD; wgid = (xcd < r ? xcd * (q + 1) : r * (q + 1) + (xcd - r) * q) + off; }
        const int nig = WGM * nN, gid = wgid / nig, fm = gid * WGM, gsz = (nM - fm) < WGM ? (nM - fm) : WGM;
        u.pm = fm + ((wgid % nig) % gsz); u.pn = (wgid % nig) / gsz;
        u.a = A + (size_t)u.pm * BM * RB; u.b = B + (size_t)u.pn * BM * RB; u.e0 = 0; u.lbase = 0; u.cnt = 0; return true;
    }
    __device__ __forceinline__ unsigned row_off(const Unit&, int) const { return 0u; }
};
struct DynOrder {
    static constexpr bool GATHER = false, DYNAMIC = true;
    const char* A; const char* B; int K, RB; int nM, nN, nwg, wv; unsigned* counter; LAS int* slot;
    __device__ void init(const void* A_, const void* B_, int M_, int N_, int K_, int wv_, unsigned* counter_, LAS int* slot_, bool fp8 = false) { wv = wv_; A = (const char*)A_; B = (const char*)B_; K = K_; RB = fp8 ? K_ : 2 * K_; nM = M_ / BM; nN = N_ / BM; nwg = nM * nN; counter = counter_; slot = slot_; }
    __device__ __forceinline__ void map(int L, Unit& u) const {
        int wgid = L; { const int q = nwg / NXCD, r = nwg % NXCD, xcd = wgid % NXCD, off = wgid / NXCD; wgid = (xcd < r ? xcd * (q + 1) : r * (q + 1) + (xcd - r) * q) + off; }
        const int nig = WGM * nN, gid = wgid / nig, fm = gid * WGM, gsz = (nM - fm) < WGM ? (nM - fm) : WGM;
        u.pm = fm + ((wgid % nig) % gsz); u.pn = (wgid % nig) / gsz;
        u.a = A + (size_t)u.pm * BM * RB; u.b = B + (size_t)u.pn * BM * RB; u.e0 = 0; u.lbase = 0; u.cnt = 0;
    }
    __device__ __forceinline__ int fetch() const { return (int)__hip_atomic_fetch_add(counter, 1u, __ATOMIC_RELAXED, __HIP_MEMORY_SCOPE_AGENT); }
    __device__ __forceinline__ bool next(int, Unit&) const { return false; }
    __device__ __forceinline__ unsigned row_off(const Unit&, int) const { return 0u; }
};
template <bool GATHER_> struct MoeOrder {
    static constexpr bool GATHER = GATHER_, DYNAMIC = false;
    const char* A; const char* B; size_t estride; int K, RB, NT, total, G, c, wv;
    const LAS int* blk_e; const LAS int* blkstart; const LAS int* cnt; const int* list;
    __device__ __forceinline__ bool next(int i, Unit& u) const {
        const int L = i * G + c; if (L >= total) return false;
        const int rb = (int)L / NT, pn = (int)L % NT, e = blk_e[rb];
        u.pm = rb; u.pn = pn; u.e0 = e; u.lbase = (rb - blkstart[e]) * BM; u.cnt = cnt[e];
        u.a = GATHER ? A : A + (size_t)rb * BM * RB; u.b = B + (size_t)e * estride + (size_t)pn * BM * RB; return true;
    }
    __device__ __forceinline__ unsigned row_off(const Unit& u, int r) const { const int loc = u.lbase + r; const int t = list[u.e0 * LIST_CAP + (loc < u.cnt ? loc : 0)]; return (unsigned)t * (unsigned)RB; }
};

typedef __bf16 bf16n2 __attribute__((ext_vector_type(2)));
__device__ __forceinline__ unsigned cvt_pk_bf16_n(float lo, float hi) { const f32x2 v = {lo, hi}; return __builtin_bit_cast(unsigned, __builtin_convertvector(v, bf16n2)); }
__device__ __forceinline__ unsigned cvt_pk_bf16(float lo, float hi) { unsigned r; asm volatile("v_cvt_pk_bf16_f32 %0, %1, %2" : "=v"(r) : "v"(lo), "v"(hi)); return r; }

struct EpiBf16 {
    static constexpr bool PERM = true;
    bf16* O; int ldc; int split_cols; size_t split_stride; float osc;
    __device__ __forceinline__ void operator()(const f32x4 (&acc)[2][2][4][2], const Unit& u, int wr, int wc, int fr, int fq) const {
        const int row0 = u.pm * BM + wr * 64 + fr; int colt = u.pn * BM; bf16* base = O;
        if (split_cols) { const int t = colt / split_cols; base += (size_t)t * split_stride; colt -= t * split_cols; }
        const int col0 = colt + wc * 32 + 8 * fq;
#pragma unroll
        for (int ai = 0; ai < 2; ++ai)
#pragma unroll
            for (int m = 0; m < 4; ++m) { bf16* rowp = base + (size_t)(row0 + ai * HALF + m * 16) * ldc + col0;
#pragma unroll
                for (int bj = 0; bj < 2; ++bj) { const f32x4 v0 = acc[ai][bj][m][0] * osc, v1 = acc[ai][bj][m][1] * osc;
                    u32x4 w; w.x = cvt_pk_bf16(v0[0], v0[1]); w.y = cvt_pk_bf16(v0[2], v0[3]); w.z = cvt_pk_bf16(v1[0], v1[1]); w.w = cvt_pk_bf16(v1[2], v1[3]);
                    *(u32x4*)(rowp + bj * HALF) = w; } }
    }
};
struct EpiResF32 {
    static constexpr bool PERM = false;
    float* C; const float* R; int ldc; float osc;
    __device__ __forceinline__ void operator()(const f32x4 (&acc)[2][2][4][2], const Unit& u, int wr, int wc, int fr, int fq) const {
        const int row0 = u.pm * BM + wr * 64 + fr, col0 = u.pn * BM + wc * 32 + 4 * fq;
#pragma unroll
        for (int ai = 0; ai < 2; ++ai)
#pragma unroll
            for (int m = 0; m < 4; ++m) { const size_t ro = (size_t)(row0 + ai * HALF + m * 16) * ldc + col0;
#pragma unroll
                for (int bj = 0; bj < 2; ++bj)
#pragma unroll
                    for (int n = 0; n < 2; ++n) { const f32x4 r = *(const f32x4*)(R + ro + bj * HALF + n * 16); *(f32x4*)(C + ro + bj * HALF + n * 16) = acc[ai][bj][m][n] * osc + r; } }
    }
};
struct EpiOut8 {
    static constexpr bool PERM = true;
    unsigned char* O; int ldc; float osc;
    __device__ __forceinline__ void operator()(const f32x4 (&acc)[2][2][4][2], const Unit& u, int wr, int wc, int fr, int fq) const {
        const int row0 = u.pm * BM + wr * 64 + fr, col0 = u.pn * BM + wc * 32 + 8 * fq;
#pragma unroll
        for (int ai = 0; ai < 2; ++ai)
#pragma unroll
            for (int m = 0; m < 4; ++m) { unsigned char* rowp = O + (size_t)(row0 + ai * HALF + m * 16) * ldc + col0;
#pragma unroll
                for (int bj = 0; bj < 2; ++bj) { const f32x4 v0 = acc[ai][bj][m][0] * osc, v1 = acc[ai][bj][m][1] * osc;
                    u32x2 w; w.x = pk4_fp8(v0[0], v0[1], v0[2], v0[3]); w.y = pk4_fp8(v1[0], v1[1], v1[2], v1[3]);
                    *(u32x2*)(rowp + bj * HALF) = w; } }
    }
};
template <bool SRC32> struct EpiRes16 {
    static constexpr bool PERM = true;
    bf16* XR; const float* R32; float osc;
    __device__ __forceinline__ void operator()(const f32x4 (&acc)[2][2][4][2], const Unit& u, int wr, int wc, int fr, int fq) const {
        const int row0 = u.pm * BM + wr * 64 + fr, col0 = u.pn * BM + wc * 32 + 8 * fq;
#pragma unroll
        for (int ai = 0; ai < 2; ++ai)
#pragma unroll
            for (int m = 0; m < 4; ++m) { const size_t ro = (size_t)(row0 + ai * HALF + m * 16) * D + col0;
#pragma unroll
                for (int bj = 0; bj < 2; ++bj) { float r[8];
                    if (SRC32) { const f32x4 a = *(const f32x4*)(R32 + ro + bj * HALF), b = *(const f32x4*)(R32 + ro + bj * HALF + 4);
#pragma unroll
                        for (int j = 0; j < 4; ++j) { r[j] = a[j]; r[4 + j] = b[j]; } }
                    else { const u32x4 w = *(const u32x4*)(XR + ro + bj * HALF); r[0] = bflo(w.x); r[1] = bfhi(w.x); r[2] = bflo(w.y); r[3] = bfhi(w.y); r[4] = bflo(w.z); r[5] = bfhi(w.z); r[6] = bflo(w.w); r[7] = bfhi(w.w); }
                    const f32x4 v0 = acc[ai][bj][m][0] * osc, v1 = acc[ai][bj][m][1] * osc;
                    u32x4 o; o.x = cvt_pk_bf16(v0[0] + r[0], v0[1] + r[1]); o.y = cvt_pk_bf16(v0[2] + r[2], v0[3] + r[3]); o.z = cvt_pk_bf16(v1[0] + r[4], v1[1] + r[5]); o.w = cvt_pk_bf16(v1[2] + r[6], v1[3] + r[7]);
                    *(u32x4*)(XR + ro + bj * HALF) = o; } }
    }
};
__device__ __forceinline__ float sigmoidf_(float z) { return __builtin_amdgcn_rcpf(1.0f + __expf(-z)); }
template <bool OUT8> struct EpiSwiGLU {
    static constexpr bool PERM = true;
    bf16* O; float osc;
    __device__ __forceinline__ void operator()(const f32x4 (&acc)[2][2][4][2], const Unit& u, int wr, int wc, int fr, int fq) const {
        const int row0 = u.pm * BM + wr * 64 + fr, col0 = u.pn * HALF + wc * 32 + 8 * fq;
#pragma unroll
        for (int ai = 0; ai < 2; ++ai)
#pragma unroll
            for (int m = 0; m < 4; ++m) { const size_t eo = (size_t)(row0 + ai * HALF + m * 16) * FF + col0;
                float o[8];
#pragma unroll
                for (int n = 0; n < 2; ++n)
#pragma unroll
                    for (int j = 0; j < 4; ++j) { const float g = acc[ai][0][m][n][j] * osc, up = acc[ai][1][m][n][j] * osc; o[4 * n + j] = g * sigmoidf_(g) * up; }
                if (OUT8) { u32x2 w; w.x = pk4_fp8(o[0] * SC_ACT, o[1] * SC_ACT, o[2] * SC_ACT, o[3] * SC_ACT); w.y = pk4_fp8(o[4] * SC_ACT, o[5] * SC_ACT, o[6] * SC_ACT, o[7] * SC_ACT); *(u32x2*)((unsigned char*)O + eo) = w; }
                else { u32x4 w; w.x = cvt_pk_bf16(o[0], o[1]); w.y = cvt_pk_bf16(o[2], o[3]); w.z = cvt_pk_bf16(o[4], o[5]); w.w = cvt_pk_bf16(o[6], o[7]); *(u32x4*)(O + eo) = w; } }
    }
};
typedef _Float16 h8 __attribute__((ext_vector_type(8)));
struct EpiHgrnIn {
    static constexpr bool PERM = true;
    unsigned char* zb; const float* lb;
    __device__ __forceinline__ void operator()(const f32x4 (&acc)[2][2][4][2], const Unit& u, int wr, int wc, int fr, int fq) const {
        const int quarter = u.pn >> 3, row0 = u.pm * BM + wr * 64 + fr, col0 = (u.pn & 7) * BM + wc * 32 + 8 * fq;
        if (quarter == 1) {
            float lbv[2][8];
#pragma unroll
            for (int bj = 0; bj < 2; ++bj) { const f32x4 a = *(const f32x4*)(lb + col0 + bj * HALF), b = *(const f32x4*)(lb + col0 + bj * HALF + 4);
#pragma unroll
                for (int j = 0; j < 4; ++j) { lbv[bj][j] = a[j]; lbv[bj][4 + j] = b[j]; } }
#pragma unroll
            for (int ai = 0; ai < 2; ++ai)
#pragma unroll
                for (int m = 0; m < 4; ++m) { const size_t ro = (size_t)(row0 + ai * HALF + m * 16) * D + col0;
#pragma unroll
                    for (int bj = 0; bj < 2; ++bj) { float kk[8]; h8 hv;
#pragma unroll
                        for (int n = 0; n < 2; ++n)
#pragma unroll
                            for (int j = 0; j < 4; ++j) { const float z = acc[ai][bj][m][n][j], l = lbv[bj][4 * n + j];
                                const float k1 = (1.0f - l) * __builtin_amdgcn_rcpf(1.0f + __expf(z));
                                kk[4 * n + j] = k1; hv[4 * n + j] = (_Float16)__logf(1.0f - k1); }
                        u32x4 w; w.x = cvt_pk_bf16(kk[0], kk[1]); w.y = cvt_pk_bf16(kk[2], kk[3]); w.z = cvt_pk_bf16(kk[4], kk[5]); w.w = cvt_pk_bf16(kk[6], kk[7]);
                        *(u32x4*)((bf16*)(zb + (64u << 20)) + ro + bj * HALF) = w;
                        *(h8*)((_Float16*)(zb + (128u << 20)) + ro + bj * HALF) = hv; } }
        } else {
            const size_t zo = quarter == 0 ? 0u : (quarter == 2 ? (size_t)(192u << 20) : (size_t)(256u << 20)); bf16* dst = (bf16*)(zb + zo);
#pragma unroll
            for (int ai = 0; ai < 2; ++ai)
#pragma unroll
                for (int m = 0; m < 4; ++m) { const size_t ro = (size_t)(row0 + ai * HALF + m * 16) * D + col0;
#pragma unroll
                    for (int bj = 0; bj < 2; ++bj) { float o[8];
#pragma unroll
                        for (int n = 0; n < 2; ++n)
#pragma unroll
                            for (int j = 0; j < 4; ++j) { const float z = acc[ai][bj][m][n][j]; o[4 * n + j] = (quarter == 3) ? z * sigmoidf_(z) : z; }
                        u32x4 w; w.x = cvt_pk_bf16(o[0], o[1]); w.y = cvt_pk_bf16(o[2], o[3]); w.z = cvt_pk_bf16(o[4], o[5]); w.w = cvt_pk_bf16(o[6], o[7]);
                        *(u32x4*)(dst + ro + bj * HALF) = w; } }
        }
    }
};

struct EpiQKV {
    static constexpr bool PERM = true;
    bf16* Q; bf16* Kd; bf16* V; const float* qg; const float* kg; const f32x2* rope; float* kmean; LAS unsigned char* xl; float osc; int wv;
    __device__ __forceinline__ void operator()(const f32x4 (&acc)[2][2][4][2], const Unit& u, int wr, int wc, int fr, int fq) const {
        const int sec = u.pn >> 3, row0 = u.pm * BM + wr * 64 + fr;
        if (sec == 2) {
            const int col0 = (u.pn & 7) * BM + wc * 32 + 8 * fq; const float vs = osc * SC_QKV;
#pragma unroll
            for (int ai = 0; ai < 2; ++ai)
#pragma unroll
                for (int m = 0; m < 4; ++m) { unsigned char* rowp = (unsigned char*)V + (size_t)(row0 + ai * HALF + m * 16) * D + col0;
#pragma unroll
                    for (int bj = 0; bj < 2; ++bj) { const f32x4 v0 = acc[ai][bj][m][0] * vs, v1 = acc[ai][bj][m][1] * vs;
                        u32x2 w; w.x = pk4_fp8(v0[0], v0[1], v0[2], v0[3]); w.y = pk4_fp8(v1[0], v1[1], v1[2], v1[3]);
                        *(u32x2*)(rowp + bj * HALF) = w; } }
            return;
        }
        LAS float* X = (LAS float*)xl;
        LAS float* Y = (LAS float*)(xl + 8192);
#pragma unroll
        for (int ai = 0; ai < 2; ++ai)
#pragma unroll
            for (int m = 0; m < 4; ++m)
#pragma unroll
                for (int bj = 0; bj < 2; ++bj) { const f32x4 a = acc[ai][bj][m][0], b = acc[ai][bj][m][1];
                    float s = ((a[0] * a[0] + a[1] * a[1]) + (a[2] * a[2] + a[3] * a[3]) + (b[0] * b[0] + b[1] * b[1]) + (b[2] * b[2] + b[3] * b[3])) * (osc * osc);
                    s += __shfl_xor(s, 16); s += __shfl_xor(s, 32);
                    if (fq == 0) X[((ai * HALF + wr * 64 + m * 16 + fr) * 2 + bj) * 4 + wc] = s; }
        asm volatile("s_waitcnt lgkmcnt(0)" ::: "memory"); __builtin_amdgcn_s_barrier(); asm volatile("" ::: "memory");
        const float* gain = sec ? kg : qg; bf16* dst = sec ? Kd : Q;
#pragma unroll
        for (int ai = 0; ai < 2; ++ai)
#pragma unroll
            for (int m = 0; m < 4; ++m) { const int rl = ai * HALF + wr * 64 + m * 16 + fr, pos = (u.pm & 15) * BM + rl;
                const f32x4 g0 = *(const f32x4*)(gain + 16 * wc + 4 * fq), g1 = *(const f32x4*)(gain + 64 + 16 * wc + 4 * fq);
                const f32x4 r0 = *(const f32x4*)(rope + pos * 64 + 16 * wc + 4 * fq), r1 = *(const f32x4*)(rope + pos * 64 + 16 * wc + 4 * fq + 2);
                const float cc[4] = {r0[0], r0[2], r1[0], r1[2]}, sn[4] = {r0[1], r0[3], r1[1], r1[3]};
#pragma unroll
                for (int bj = 0; bj < 2; ++bj) { const f32x4 p = *(const LAS f32x4*)(X + (rl * 2 + bj) * 4);
                    const float rstd = __builtin_amdgcn_rsqf(((p[0] + p[1]) + (p[2] + p[3])) * (1.f / 128) + RMS_EPS);
                    float o[8];
#pragma unroll
                    for (int j = 0; j < 4; ++j) { const float y1 = acc[ai][bj][m][0][j] * (rstd * osc) * g0[j], y2 = acc[ai][bj][m][1][j] * (rstd * osc) * g1[j]; o[j] = y1 * cc[j] - y2 * sn[j]; o[4 + j] = y2 * cc[j] + y1 * sn[j]; }
                    unsigned char* p0 = (unsigned char*)dst + (size_t)(u.pm * BM + rl) * D + ((u.pn & 7) * 2 + bj) * 128 + 16 * wc + 4 * fq;
                    *(unsigned*)p0 = pk4_fp8(o[0] * SC_QKV, o[1] * SC_QKV, o[2] * SC_QKV, o[3] * SC_QKV); *(unsigned*)(p0 + 64) = pk4_fp8(o[4] * SC_QKV, o[5] * SC_QKV, o[6] * SC_QKV, o[7] * SC_QKV);
                    if (sec == 1) {
#pragma unroll
                        for (int j = 0; j < 8; ++j) { float sv = o[j]; sv += __shfl_xor(sv, 1); sv += __shfl_xor(sv, 2); sv += __shfl_xor(sv, 4); sv += __shfl_xor(sv, 8); o[j] = sv; }
                        if (fr == 0) { LAS float* yp = Y + ((((wr * 2 + ai) * 4 + m) * 2 + bj) * 128) + 16 * wc + 4 * fq; *(LAS f32x4*)yp = (f32x4){o[0], o[1], o[2], o[3]}; *(LAS f32x4*)(yp + 64) = (f32x4){o[4], o[5], o[6], o[7]}; }
                    } }
                asm volatile("" ::: "memory"); }
        if (sec == 1) {
            asm volatile("s_waitcnt lgkmcnt(0)" ::: "memory"); __builtin_amdgcn_s_barrier(); asm volatile("" ::: "memory");
            const int tid = make_tid(wv);
            if (tid < 256) { const int bj = tid >> 7, d = tid & 127; const int b = u.pm >> 4, nb = u.pm & 15, head = (u.pn & 7) * 2 + bj;
                float sm = 0.f;
#pragma unroll
                for (int q = 0; q < 16; ++q) sm += Y[(q * 2 + bj) * 128 + d];
                float* kmb = kmean; asm volatile("" : "+s"(kmb));
                ((GAS float*)kmb)[((b * H + head) * NBLK + nb) * HD + d] = sm * (1.0f / 256); }
        }
    }
};

__device__ __forceinline__ void glds_saddr(const char* sbase, unsigned voff, unsigned lds_dst) {
    unsigned keep;
    asm volatile("s_mov_b32 %0, m0\n\ts_mov_b32 m0, %3\n\ts_nop 4\n\tglobal_load_lds_dwordx4 %1, %2\n\ts_mov_b32 m0, %0" : "=&s"(keep) : "v"(voff), "s"(sbase), "s"(lds_dst) : "memory");
}
typedef int i32x4 __attribute__((ext_vector_type(4)));
typedef int i32x8 __attribute__((ext_vector_type(8)));
__device__ __forceinline__ i32x8 cat8(bf16x8 lo, bf16x8 hi) { const i32x4 a = __builtin_bit_cast(i32x4, lo), b = __builtin_bit_cast(i32x4, hi); return __builtin_shufflevector(a, b, 0, 1, 2, 3, 4, 5, 6, 7); }
template <class Epi, class Sched, bool ALIGN_EPI, bool FP8 = false>
__device__ __forceinline__ void gemm_phase(LAS unsigned char* lds, const Sched& S, const Epi& E) {
    const int tid = make_tid(S.wv), wid = __builtin_amdgcn_readfirstlane(tid >> 6), lane = tid & 63, wr = wid >> 2, wc = wid & 3, fr = lane & 15, fq = lane >> 4;
    const int K = S.K, RB = S.RB, nt = RB / (BK * 2);
    unsigned voffA[2], voffB[2];
#pragma unroll
    for (int i = 0; i < 2; ++i) { int R, C; stage_rc(tid * 16 + i * 8192, R, C); const int Rb = Epi::PERM ? ((R & ~31) + perm32(R & 31)) : R;
        voffA[i] = (unsigned)(R * RB + C * 2); voffB[i] = (unsigned)(Rb * RB + C * 2); }
    const size_t kstep = (size_t)(BK * 2);
    const size_t hstep = (size_t)HALF * RB;
    const unsigned ldsw = (unsigned)wid * 1024u, ldsb = (unsigned)(size_t)lds;
    const int aoff = lds_byte(wr * 64 + fr, fq * 8), boff = lds_byte(wc * 32 + fr, fq * 8);
#define PG8_SA(b, h) (((b) * 2 + (h)) * HTB)
#define PG8_SB(b, h) ((4 + (b) * 2 + (h)) * HTB)
#define PG8_STAGE(bufoff, gbase, voff) do { _Pragma("unroll") for (int _i = 0; _i < 2; ++_i) glds_saddr((const char*)(gbase), (voff)[_i], ldsb + (unsigned)(bufoff) + ldsw + _i * 8192u); } while (0)
#define PG8_GOFS(pp, h, i) (gofs + ((((pp) * 2 + (h)) * 2 + (i)) * 512))
#define PG8_STAGE_A(bufoff, sel, h, ko) do { if constexpr (Sched::GATHER) { const int _pp = (sel) ? (pc ^ 1) : pc; unsigned _v[2]; _v[0] = PG8_GOFS(_pp, h, 0)[tid]; _v[1] = PG8_GOFS(_pp, h, 1)[tid]; PG8_STAGE(bufoff, S.A + (ko), _v); } \
        else { PG8_STAGE(bufoff, ((sel) ? nA : cA) + (h) * hstep + (ko), voffA); } } while (0)
#define PG8_LDA(dst, b, h) do { _Pragma("unroll") for (int m = 0; m < 4; ++m) { if constexpr (FP8) dst##8[m] = cat8(*(const LAS bf16x8*)(lds + PG8_SA(b, h) + aoff + m * 2048), *(const LAS bf16x8*)(lds + PG8_SA(b, h) + aoff + m * 2048 + 1024)); \
        else { _Pragma("unroll") for (int k = 0; k < 2; ++k) dst[m][k] = *(const LAS bf16x8*)(lds + PG8_SA(b, h) + aoff + m * 2048 + k * 1024); } } } while (0)
#define PG8_LDB(dst, b, h) do { _Pragma("unroll") for (int n = 0; n < 2; ++n) { if constexpr (FP8) dst##8[n] = cat8(*(const LAS bf16x8*)(lds + PG8_SB(b, h) + boff + n * 2048), *(const LAS bf16x8*)(lds + PG8_SB(b, h) + boff + n * 2048 + 1024)); \
        else { _Pragma("unroll") for (int k = 0; k < 2; ++k) dst[n][k] = *(const LAS bf16x8*)(lds + PG8_SB(b, h) + boff + n * 2048 + k * 1024); } } } while (0)
#define PG8_MMA(ai, bj, At, Bt) do { __builtin_amdgcn_s_setprio(1); _Pragma("unroll") for (int m = 0; m < 4; ++m) _Pragma("unroll") for (int n = 0; n < 2; ++n) { if constexpr (FP8) { \
        acc[ai][bj][m][n] = __builtin_amdgcn_mfma_scale_f32_16x16x128_f8f6f4(Bt##8[n], At##8[m], acc[ai][bj][m][n], 0, 0, 0, 0, 0, 0); } else { _Pragma("unroll") for (int k = 0; k < 2; ++k) \
        acc[ai][bj][m][n] = __builtin_amdgcn_mfma_f32_16x16x32_bf16(Bt[n][k], At[m][k], acc[ai][bj][m][n], 0, 0, 0); } } __builtin_amdgcn_s_setprio(0); } while (0)
#define PG8_WAIT_V(n) asm volatile("s_waitcnt vmcnt(" #n ")" ::: "memory")
#define PG8_WAIT_L(n) asm volatile("s_waitcnt lgkmcnt(" #n ")" ::: "memory")
#define PG8_BAR __builtin_amdgcn_s_barrier()
#define PG8_SCHED __builtin_amdgcn_sched_barrier(0)
    Unit cur, nxt; int ui = 0; int dyn_pend = 0;
    if constexpr (Sched::DYNAMIC) {
        if (wid == 0) { int v2 = 0; if (lane == 0) { const int v0 = S.fetch(), v1 = S.fetch(); v2 = S.fetch(); S.slot[0] = v0; S.slot[1] = v1; } dyn_pend = __builtin_amdgcn_readfirstlane(v2); }
        PG8_WAIT_L(0); PG8_BAR;
        const int L0 = __builtin_amdgcn_readfirstlane(S.slot[0]); if (L0 >= S.nwg) return;
        S.map(L0, cur);
    } else { if (!S.next(0, cur)) return; }
    LAS unsigned* gofs = (LAS unsigned*)(lds + 131072); int pc = 0;
#define PG8_WRITE_GOFS(pp, U) do { int _t = tid; asm volatile("" : "+v"(_t)); _Pragma("unroll") for (int _i = 0; _i < 2; ++_i) { int _R, _C; stage_rc(_t * 16 + _i * 8192, _R, _C); \
        _Pragma("unroll") for (int _h = 0; _h < 2; ++_h) PG8_GOFS(pp, _h, _i)[_t] = S.row_off(U, _h * HALF + _R) + (unsigned)_C * 2u; } } while (0)
    if constexpr (Sched::GATHER) PG8_WRITE_GOFS(0, cur);
    f32x4 acc[2][2][4][2];
#pragma unroll
    for (int a = 0; a < 2; ++a)
#pragma unroll
        for (int b = 0; b < 2; ++b)
#pragma unroll
            for (int m = 0; m < 4; ++m)
#pragma unroll
                for (int n = 0; n < 2; ++n) acc[a][b][m][n] = (f32x4){0.f, 0.f, 0.f, 0.f};
    bf16x8 At[4][2], B0[2][2], B1[2][2]; i32x8 At8[4], B08[2], B18[2];
    const char* cA = cur.a; const char* cB = cur.b; const char* nA = cA; const char* nB = cB;
    PG8_STAGE(PG8_SB(0, 0), cB, voffB); PG8_STAGE(PG8_SB(0, 1), cB + hstep, voffB); PG8_STAGE_A(PG8_SA(0, 0), false, 0, 0); PG8_STAGE_A(PG8_SA(0, 1), false, 1, 0);
    if (wr == 1) PG8_BAR;
    PG8_WAIT_V(2); PG8_BAR;
    PG8_STAGE(PG8_SB(1, 0), cB + kstep, voffB); PG8_STAGE_A(PG8_SA(1, 0), false, 0, kstep); PG8_STAGE(PG8_SB(1, 1), cB + hstep + kstep, voffB);
    PG8_WAIT_V(6); PG8_BAR;
    for (;;) {
        bool has_next = true;
        if constexpr (Sched::DYNAMIC) {
            if (ui >= 1 && wid == 0) { int v = 0; if (lane == 0) { S.slot[(ui + 1) % 3] = dyn_pend; v = S.fetch(); } dyn_pend = __builtin_amdgcn_readfirstlane(v); }
        } else { has_next = S.next(ui + 1, nxt); nA = has_next ? nxt.a : cA; nB = has_next ? nxt.b : cB; }
        if constexpr (Sched::GATHER) { if (has_next) PG8_WRITE_GOFS(pc ^ 1, nxt); else PG8_WRITE_GOFS(pc ^ 1, cur); }
        for (int t = 0; t < nt; t += 2) {
            const bool last = (t == nt - 2);
            if constexpr (Sched::DYNAMIC) { if (last) { const int Ln = __builtin_amdgcn_readfirstlane(S.slot[(ui + 1) % 3]); has_next = Ln < S.nwg; if (has_next) S.map(Ln, nxt); nA = has_next ? nxt.a : cA; nB = has_next ? nxt.b : cB; } }
            const size_t k1 = (size_t)(t + 1) * kstep;
            const size_t k2 = last ? 0 : (size_t)(t + 2) * kstep, k3 = k2 + kstep;
            const char* b2 = (last ? nB : cB) + k2; const char* b3 = b2 + kstep;
            PG8_LDB(B0, 0, 0); PG8_LDB(B1, 0, 1); PG8_SCHED; PG8_LDA(At, 0, 0); PG8_STAGE_A(PG8_SA(1, 1), false, 1, k1);
            PG8_WAIT_V(8); PG8_WAIT_L(0); PG8_BAR; PG8_MMA(0, 0, At, B0); PG8_MMA(0, 1, At, B1); PG8_BAR; PG8_SCHED;
            PG8_LDA(At, 0, 1); PG8_STAGE(PG8_SB(0, 0), b2, voffB); PG8_STAGE(PG8_SB(0, 1), b2 + hstep, voffB); PG8_STAGE_A(PG8_SA(0, 0), last, 0, k2);
            PG8_WAIT_V(8); PG8_WAIT_L(0); PG8_BAR; PG8_MMA(1, 0, At, B0); PG8_MMA(1, 1, At, B1); PG8_BAR; PG8_SCHED;
            PG8_LDB(B0, 1, 0); PG8_LDB(B1, 1, 1); PG8_SCHED; PG8_LDA(At, 1, 0); PG8_STAGE_A(PG8_SA(0, 1), last, 1, k2);
            PG8_WAIT_V(8); PG8_WAIT_L(0); PG8_BAR; PG8_MMA(0, 0, At, B0); PG8_MMA(0, 1, At, B1); PG8_BAR; PG8_SCHED;
            PG8_LDA(At, 1, 1); PG8_STAGE(PG8_SB(1, 0), b3, voffB); PG8_STAGE(PG8_SB(1, 1), b3 + hstep, voffB); PG8_STAGE_A(PG8_SA(1, 0), last, 0, k3);
            PG8_WAIT_V(8); PG8_WAIT_L(0); PG8_BAR; PG8_MMA(1, 0, At, B0); PG8_MMA(1, 1, At, B1); PG8_BAR; PG8_SCHED;
        }
        if constexpr (ALIGN_EPI) { if (wr == 0) PG8_BAR; }
        { const int l2_ = lane_id(); E(acc, cur, wr, wc, l2_ & 15, l2_ >> 4); }
        if (!has_next) break;
#pragma unroll
        for (int a = 0; a < 2; ++a)
#pragma unroll
            for (int b = 0; b < 2; ++b)
#pragma unroll
                for (int m = 0; m < 4; ++m)
#pragma unroll
                    for (int n = 0; n < 2; ++n) acc[a][b][m][n] = (f32x4){0.f, 0.f, 0.f, 0.f};
        cur = nxt; cA = nA; cB = nB; ++ui;
        pc ^= 1;
        if constexpr (ALIGN_EPI) { if (wr == 1) PG8_BAR; }
    }
    PG8_WAIT_V(0);
    if constexpr (!ALIGN_EPI) { if (wr == 0) PG8_BAR; }
    PG8_BAR;
#undef PG8_SA
#undef PG8_SB
#undef PG8_STAGE
#undef PG8_STAGE_A
#undef PG8_GOFS
#undef PG8_WRITE_GOFS
#undef PG8_LDA
#undef PG8_LDB
#undef PG8_MMA
#undef PG8_WAIT_V
#undef PG8_WAIT_L
#undef PG8_BAR
#undef PG8_SCHED
}
}

#define XB_TMO      128
#define XB_XCNT(j)  (256  + 64 * (j))
#define XB_XSUB(j)  (1280 + 64 * (j))
#define XB_XGEN(j)  (2304 + 64 * (j))
#define XB_TOP      3328
#define XB_TOPGEN   3392
#define XCD_BAR_WORDS 3456
#define XB_SPIN_CAP (1u << 18)
__device__ __forceinline__ unsigned xb_ld(unsigned* p)              { return __hip_atomic_load(p, __ATOMIC_RELAXED, __HIP_MEMORY_SCOPE_AGENT); }
__device__ __forceinline__ unsigned xb_add(unsigned* p, unsigned v) { return __hip_atomic_fetch_add(p, v, __ATOMIC_RELAXED, __HIP_MEMORY_SCOPE_AGENT); }
__device__ __forceinline__ unsigned xb_xcc_id() { return (unsigned)__builtin_amdgcn_s_getreg((3 << 11) | 20) & 0xFu; }
#define XB_SPIN(cond, bar) do { unsigned _sp = 0; while (cond) { __builtin_amdgcn_s_sleep(1); \
    if ((++_sp & 255u) == 0u) { if (xb_ld(&(bar)[XB_TMO])) break; if (_sp > XB_SPIN_CAP) { atomicAdd(&(bar)[XB_TMO], 1u); break; } } } } while (0)
struct XcdBarrier { unsigned* bar; unsigned x; volatile LAS unsigned* st; };
__device__ __forceinline__ XcdBarrier xcd_barrier_post(unsigned* bar, volatile LAS unsigned* st, int tid0) {
    XcdBarrier b; b.bar = bar; b.x = xb_xcc_id(); b.st = st;
    if (tid0 == 0) (void)xb_add(&bar[XB_XCNT(b.x)], 1u);
    return b;
}
__device__ __forceinline__ void xcd_barrier_complete(unsigned* bar, unsigned x, unsigned& nloc, unsigned& nx) {
    const unsigned G = gridDim.x * gridDim.y * gridDim.z;
    unsigned sum, cnt, mine, sp = 0u;
    for (;;) {
        sum = 0u; cnt = 0u; mine = 0u;
#pragma unroll
        for (unsigned j = 0; j < 16; ++j) { const unsigned c = xb_ld(&bar[XB_XCNT(j)]); sum += c; cnt += (c > 0u) ? 1u : 0u; mine = (j == x) ? c : mine; }
        if (sum == G) break;
        __builtin_amdgcn_s_sleep(1);
        if ((++sp & 255u) == 0u) { if (xb_ld(&bar[XB_TMO])) break; if (sp > XB_SPIN_CAP) { atomicAdd(&bar[XB_TMO], 1u); break; } }
    }
    nloc = mine > 0u ? mine : 1u; nx = cnt > 0u ? cnt : 1u;
}
__device__ __forceinline__ void xcd_barrier(const XcdBarrier& b, int tid0) {
    asm volatile("s_waitcnt vmcnt(0)" ::: "memory");
    __syncthreads();
    if (tid0 == 0) {
        unsigned* bar = b.bar;
        __builtin_amdgcn_s_waitcnt(0);
        unsigned nloc = b.st[0], nx = b.st[1];
        if (nloc == 0u) { xcd_barrier_complete(bar, b.x, nloc, nx); b.st[0] = nloc; b.st[1] = nx; }
        const unsigned old = xb_add(&bar[XB_XSUB(b.x)], 1u);
        const unsigned gen = old / nloc;
        if (old + 1u == (gen + 1u) * nloc) {
            __builtin_amdgcn_fence(__ATOMIC_RELEASE, "agent");
            asm volatile("s_waitcnt vmcnt(0)" ::: "memory");
            const unsigned og = xb_add(&bar[XB_TOP], 1u);
            const unsigned tg = og / nx;
            if (og + 1u == (tg + 1u) * nx) xb_add(&bar[XB_TOPGEN], 1u);
            else XB_SPIN(xb_ld(&bar[XB_TOPGEN]) == tg, bar);
            __builtin_amdgcn_fence(__ATOMIC_ACQUIRE, "agent");
            xb_add(&bar[XB_XGEN(b.x)], 1u);
            asm volatile("s_waitcnt vmcnt(0)" ::: "memory");
        } else {
            XB_SPIN(xb_ld(&bar[XB_XGEN(b.x)]) == gen, bar);
            __builtin_amdgcn_fence(__ATOMIC_ACQUIRE, "agent");
            asm volatile("s_waitcnt vmcnt(0)" ::: "memory");
        }
    }
    __syncthreads();
}

struct Args { const float* in[20]; float* out; unsigned char* ws; int ph_lo, ph_hi; };
typedef const __attribute__((address_space(4))) Args CArgs;
enum { I_X = 0, I_NORM_MIX, I_NORM_FFN, I_A_W_IN, I_A_LB, I_A_OGAIN, I_A_W_OUT, I_KV_NORM, I_KV_W, I_K_NORM, I_B_W_Q, I_B_Q_NORM, I_B_W_OUT,
       I_W_GROUP, I_B_GROUP, I_W_EXPERT, I_B_EXPERT, I_W_GATE, I_W_UP, I_W_DOWN };
struct Frame {
    LAS unsigned char* lds; unsigned char* ws; unsigned* ctl;
    int tid, lane, wave, vcu, G, gw, NGW;
};

struct TrItem { const float* src; const float* ksc; unsigned char* dst; int N, K, k0, n0, drow0, flags; float osc; };
struct TrRegs { f32x4 v[16]; f32x4 ks[2]; };
constexpr int TR_SCR_BYTES = 128 * 33 * 4;
__device__ __forceinline__ void tr_load(const TrItem& it, TrRegs& r, int lane) {
    const float* p = it.src + (size_t)(it.k0 + (lane >> 3)) * it.N + it.n0 + 4 * (lane & 7);
    const size_t st = (size_t)8 * it.N;
#pragma unroll
    for (int i = 0; i < 16; ++i) r.v[i] = *(const f32x4*)(p + i * st);
    if (it.ksc) { const f32x4* q = (const f32x4*)(it.ksc + it.k0 + 8 * (lane >> 3)); r.ks[0] = q[0]; r.ks[1] = q[1]; }
    else { r.ks[0] = (f32x4){1.f, 1.f, 1.f, 1.f}; r.ks[1] = r.ks[0]; }
}
__device__ __forceinline__ void tr_to_lds(const TrRegs& r, LAS float* scr, int lane) {
    LAS float* d = scr + (lane >> 3) * 33 + 4 * (lane & 7);
#pragma unroll
    for (int i = 0; i < 16; ++i) { d[(8 * i) * 33 + 0] = r.v[i][0]; d[(8 * i) * 33 + 1] = r.v[i][1]; d[(8 * i) * 33 + 2] = r.v[i][2]; d[(8 * i) * 33 + 3] = r.v[i][3]; }
}
__device__ __forceinline__ void tr_store(const TrItem& it, f32x4 ka, f32x4 kb, const LAS float* scr, int lane) {
#pragma unroll
    for (int jh = 0; jh < 2; ++jh) {
        const int c = (lane >> 3) + 8 * jh;
        if (jh == 1 && it.ksc) { const f32x4* q = (const f32x4*)(it.ksc + it.k0 + 8 * c); ka = q[0]; kb = q[1]; }
        const float o = it.osc;
        const float s0 = ka[0] * o, s1 = ka[1] * o, s2 = ka[2] * o, s3 = ka[3] * o, s4 = kb[0] * o, s5 = kb[1] * o, s6 = kb[2] * o, s7 = kb[3] * o;
#pragma unroll
        for (int jn = 0; jn < 4; ++jn) {
            const int n = (lane & 7) + 8 * jn; const LAS float* s = scr + (8 * c) * 33 + n;
            const float w0 = s[0 * 33] * s0, w1 = s[1 * 33] * s1, w2 = s[2 * 33] * s2, w3 = s[3 * 33] * s3, w4 = s[4 * 33] * s4, w5 = s[5 * 33] * s5, w6 = s[6 * 33] * s6, w7 = s[7 * 33] * s7;
            int drow = it.drow0 + n;
            if (it.flags & 1) { const int cidx = it.n0 + n, d = cidx & 127; drow = (it.drow0 - it.n0) + (cidx & ~127) + 32 * ((d & 63) >> 4) + 8 * ((d & 15) >> 2) + 4 * (d >> 6) + (d & 3); }
            const size_t eo = (size_t)drow * it.K + it.k0 + 8 * c;
            if (it.flags & 2) { u32x2 o8; o8.x = pk4_fp8(w0, w1, w2, w3); o8.y = pk4_fp8(w4, w5, w6, w7); *(u32x2*)(it.dst + eo) = o8; }
            else { u32x4 o16; o16.x = pk2(w0, w1); o16.y = pk2(w2, w3); o16.z = pk2(w4, w5); o16.w = pk2(w6, w7); *(u32x4*)(it.dst + eo * 2) = o16; }
        }
    }
}
template <class Dec> __device__ __forceinline__ void tr_run(Dec dec, int first, int total, int stride, LAS float* scr, int lane) {
    if (first >= total) return;
    TrRegs r; TrItem cur = dec(first); tr_load(cur, r, lane);
    for (int i = first; i < total; i += stride) {
        tr_to_lds(r, scr, lane);
        const f32x4 ka = r.ks[0], kb = r.ks[1];
        TrItem nxt = cur; const bool more = i + stride < total;
        if (more) { nxt = dec(i + stride); tr_load(nxt, r, lane); }
        LDS_WAIT(); asm volatile("" ::: "memory");
        tr_store(cur, ka, kb, scr, lane);
        LDS_WAIT(); asm volatile("" ::: "memory");
        cur = nxt;
    }
}
constexpr size_t WGU_LSTRIDE = 64 * MiB, WD_LSTRIDE = 32 * MiB;
static_assert((FP8_MOE0 != 0) && (FP8_MOE1 != 0), "the two-layer weight residency assumes e4m3 expert weights");
constexpr int MOE_CV_ITEMS = 32 * 768;
__device__ __forceinline__ TrItem moe_cv_item(CArgs& a, unsigned char* ws, int layer, int item) {
    const int e = item / 768, r = item % 768, which = r / 256, q = r % 256;
    const size_t eo = (size_t)(layer * NE + e);
    TrItem t; t.ksc = nullptr; t.flags = 2;
    if (which < 2) {
        const int kb = q / 16, nb = q % 16, n0 = nb * 32;
        t.src = (which == 0 ? a.in[I_W_GATE] : a.in[I_W_UP]) + eo * (size_t)D * FF; t.N = FF; t.K = D; t.k0 = 128 * kb; t.n0 = n0;
        t.dst = ws + WS_WGU + (size_t)layer * WGU_LSTRIDE + (size_t)e * 1024 * D; t.drow0 = (n0 >> 7) * 256 + which * 128 + (n0 & 127); t.osc = SC_W;
    } else {
        const int kb = q / 64, nb = q % 64;
        t.src = a.in[I_W_DOWN] + eo * (size_t)FF * D; t.N = D; t.K = FF; t.k0 = 128 * kb; t.n0 = nb * 32;
        t.dst = ws + WS_WD + (size_t)layer * WD_LSTRIDE + (size_t)e * D * FF; t.drow0 = nb * 32; t.osc = SC_WD;
    }
    return t;
}
__device__ __forceinline__ void rms_row_to_bf16(const float* xrow, bf16* orow, int lane) {
    const f32x4* xr = (const f32x4*)xrow + lane;
    f32x4 v[8]; float s = 0.f;
#pragma unroll
    for (int j = 0; j < 8; ++j) { v[j] = xr[64 * j]; s += (v[j].x * v[j].x + v[j].y * v[j].y) + (v[j].z * v[j].z + v[j].w * v[j].w); }
    const float rstd = __builtin_amdgcn_rsqf(wave_sum(s) * (1.f / D) + RMS_EPS);
    u32x2* o8 = (u32x2*)orow + lane;
#pragma unroll
    for (int j = 0; j < 8; ++j) { u32x2 w; w.x = pk2(v[j].x * rstd, v[j].y * rstd); w.y = pk2(v[j].z * rstd, v[j].w * rstd); o8[64 * j] = w; }
}

__device__ __forceinline__ int moe_tables(Frame& F, int layer) {
    LAS int* blk_e = (LAS int*)(F.lds + LT_BLKE); LAS int* blkstart = (LAS int*)(F.lds + LT_BLKSTART); LAS int* cntl = (LAS int*)(F.lds + LT_CNT);
    __syncthreads();
    if (F.wave == 0) {
        const int e = F.lane & 31;
        const int c = (int)__hip_atomic_load(F.ctl + CW_CNT_AT(layer, e), __ATOMIC_RELAXED, __HIP_MEMORY_SCOPE_AGENT);
        const int nb = (c + 255) >> 8;
        int incl = nb;
#pragma unroll
        for (int o = 1; o < 32; o <<= 1) { const int t = __shfl_up(incl, o, 32); if ((F.lane & 31) >= o) incl += t; }
        const int excl = incl - nb;
        if (F.lane < 32) { blkstart[e] = excl; cntl[e] = c; for (int r = 0; r < nb; ++r) blk_e[excl + r] = e; if (e == 31) blkstart[32] = incl; }
    }
    __syncthreads();
    return blkstart[32];
}

typedef const GAS char* gcptr;
__device__ __forceinline__ gcptr opaque_s(const void* p) { asm volatile("" : "+s"(p)); return (gcptr)p; }
__device__ __forceinline__ float wave_reduce4(const float (&p)[4], int lane) {
    const bool b0 = lane & 1, b1 = lane & 2;
    float a0 = b0 ? p[1] : p[0], x0 = b0 ? p[0] : p[1]; a0 += __shfl_xor(x0, 1);
    float a1 = b0 ? p[3] : p[2], x1 = b0 ? p[2] : p[3]; a1 += __shfl_xor(x1, 1);
    float c = b1 ? a1 : a0, d = b1 ? a0 : a1; c += __shfl_xor(d, 2);
    c += __shfl_xor(c, 4); c += __shfl_xor(c, 8); c += __shfl_xor(c, 16); c += __shfl_xor(c, 32);
    return c;
}
__device__ __forceinline__ float wave_reduce8(const float (&p)[8], int lane) {
    const bool b2 = lane & 4;
    const float lo[4] = {p[0], p[1], p[2], p[3]}, hi[4] = {p[4], p[5], p[6], p[7]};
    float q[4];
#pragma unroll
    for (int i = 0; i < 4; ++i) { const float keep = b2 ? hi[i] : lo[i], give = b2 ? lo[i] : hi[i]; q[i] = keep + __shfl_xor(give, 4); }
    const bool b0 = lane & 1, b1 = lane & 2;
    float a0 = b0 ? q[1] : q[0], x0 = b0 ? q[0] : q[1]; a0 += __shfl_xor(x0, 1);
    float a1 = b0 ? q[3] : q[2], x1 = b0 ? q[2] : q[3]; a1 += __shfl_xor(x1, 1);
    float c = b1 ? a1 : a0, d = b1 ? a0 : a1; c += __shfl_xor(d, 2);
    c += __shfl_xor(c, 8); c += __shfl_xor(c, 16); c += __shfl_xor(c, 32);
    return c;
}
template <bool DRY, bool OUT8> __device__ __forceinline__ void route_token(Frame& F, CArgs& a, int layer, int t) {
    const bf16* xrow = (const bf16*)(F.ws + WS_XR) + (size_t)t * D;
    const unsigned l16 = (unsigned)F.lane * 16u;
    gcptr xb = opaque_s(xrow); gcptr gb = opaque_s(a.in[I_NORM_FFN] + layer * D);
    f32x4 v[8]; float s = 0.f;
#pragma unroll
    for (int j = 0; j < 8; ++j) { const u32x2 xw_ = *(const GAS u32x2*)(xb + j * 512 + (l16 >> 1)); v[j] = (f32x4){bflo(xw_.x), bfhi(xw_.x), bflo(xw_.y), bfhi(xw_.y)}; s += (v[j].x * v[j].x + v[j].y * v[j].y) + (v[j].z * v[j].z + v[j].w * v[j].w); }
    const float rstd = __builtin_amdgcn_rsqf(wave_sum(s) * (1.f / D) + RMS_EPS);
    u32x2* o8 = (u32x2*)((bf16*)(F.ws + (DRY ? WS_OPART : WS_XN)) + (size_t)t * D) + F.lane;
#pragma unroll
    for (int j = 0; j < 8; ++j) { const f32x4 g = *(const GAS f32x4*)(gb + j * 1024 + l16); v[j].x *= rstd * g.x; v[j].y *= rstd * g.y; v[j].z *= rstd * g.z; v[j].w *= rstd * g.w;
        if (OUT8) ((unsigned*)(F.ws + (DRY ? WS_OPART : WS_XN)) + (size_t)t * (D / 4))[64 * j + F.lane] = pk4_fp8(v[j].x * SC_XN, v[j].y * SC_XN, v[j].z * SC_XN, v[j].w * SC_XN);
        else { u32x2 w; w.x = pk2(v[j].x, v[j].y); w.y = pk2(v[j].z, v[j].w); o8[64 * j] = w; } }
    const float* RT = (const float*)(F.ws + WS_RT) + (size_t)layer * 36 * D;
    float gl[4];
    { float pp[4];
#pragma unroll
      for (int r = 0; r < 4; ++r) { gcptr wb = opaque_s(RT + r * D); float p = 0.f;
#pragma unroll
        for (int j = 0; j < 8; ++j) { const f32x4 w = *(const GAS f32x4*)(wb + j * 1024 + l16); p += (v[j].x * w.x + v[j].y * w.y) + (v[j].z * w.z + v[j].w * w.w); }
        pp[r] = p; if (r & 1) __builtin_amdgcn_sched_barrier(0); }
      const float red = wave_reduce4(pp, F.lane);
#pragma unroll
      for (int r = 0; r < 4; ++r) gl[r] = __builtin_bit_cast(float, __builtin_amdgcn_readlane(__builtin_bit_cast(int, red), r)) + a.in[I_B_GROUP][layer * NG + r]; }
    int g = 0; float gm = gl[0];
#pragma unroll
    for (int r = 1; r < 4; ++r) if (gl[r] > gm) { gm = gl[r]; g = r; }
    float gs = 0.f;
#pragma unroll
    for (int r = 0; r < 4; ++r) gs += __expf(gl[r] - gm);
    const float gp = 1.0f / gs;
    g = __builtin_amdgcn_readfirstlane(g);
    float el[8];
    { float pp[8];
#pragma unroll
      for (int r = 0; r < 8; ++r) { gcptr wb = opaque_s(RT + (size_t)(4 + g * 8 + r) * D); float p = 0.f;
#pragma unroll
        for (int j = 0; j < 8; ++j) { const f32x4 w = *(const GAS f32x4*)(wb + j * 1024 + l16); p += (v[j].x * w.x + v[j].y * w.y) + (v[j].z * w.z + v[j].w * w.w); }
        pp[r] = p; if (r & 1) __builtin_amdgcn_sched_barrier(0); }
      const float red = wave_reduce8(pp, F.lane);
#pragma unroll
      for (int r = 0; r < 8; ++r) el[r] = __builtin_bit_cast(float, __builtin_amdgcn_readlane(__builtin_bit_cast(int, red), r)) + a.in[I_B_EXPERT][layer * NE + g * 8 + r]; }
    int i0 = 0; float m0 = el[0];
#pragma unroll
    for (int r = 1; r < 8; ++r) if (el[r] > m0) { m0 = el[r]; i0 = r; }
    int i1 = -1; float m1 = -INFINITY;
#pragma unroll
    for (int r = 0; r < 8; ++r) if (r != i0 && el[r] > m1) { m1 = el[r]; i1 = r; }
    const float q1 = __expf(m1 - m0), w0 = gp / (1.0f + q1), w1 = gp * q1 / (1.0f + q1);
    if (DRY && w0 + w1 < -1.0f) ((float*)(F.ws + WS_OPART))[0] = w0;
    if (F.lane == 0 && !DRY) {
        const int e0 = g * 8 + i0, e1 = g * 8 + i1;
        const int r0 = (int)atomicAdd(F.ctl + CW_CNT_AT(layer, e0), 1u), r1 = (int)atomicAdd(F.ctl + CW_CNT_AT(layer, e1), 1u);
        int* lists = (int*)(F.ws + WS_LISTS); lists[e0 * LIST_CAP + r0] = t; lists[e1 * LIST_CAP + r1] = t;
        int* rec = (int*)(F.ws + WS_TOKREC) + (size_t)t * 8;
        rec[0] = e0; rec[1] = r0; rec[2] = __builtin_bit_cast(int, w0); rec[3] = e1; rec[4] = r1; rec[5] = __builtin_bit_cast(int, w1);
    }
}

template <bool NORM, bool DRY, bool OUT8> __device__ __forceinline__ void combine_token(Frame& F, CArgs& a, int t) {
    const LAS int* blkstart = (const LAS int*)(F.lds + LT_BLKSTART);
    const int* rec = (const int*)(F.ws + WS_TOKREC) + (size_t)t * 8;
    const int e0 = rec[0], r0 = rec[1], e1 = rec[3], r1 = rec[4]; const float w0 = __builtin_bit_cast(float, rec[2]), w1 = __builtin_bit_cast(float, rec[5]);
    const size_t row0 = (size_t)blkstart[e0] * 256 + r0, row1 = (size_t)blkstart[e1] * 256 + r1;
    const u32x2* p0 = (const u32x2*)((const bf16*)(F.ws + WS_OUTB) + row0 * D) + F.lane; const u32x2* p1 = (const u32x2*)((const bf16*)(F.ws + WS_OUTB) + row1 * D) + F.lane;
    const unsigned* q0 = (const unsigned*)(F.ws + WS_OUTB + row0 * D) + F.lane; const unsigned* q1 = (const unsigned*)(F.ws + WS_OUTB + row1 * D) + F.lane;
    u32x2* xr = (u32x2*)((bf16*)(F.ws + WS_XR) + (size_t)t * D) + F.lane; f32x4* xo = (f32x4*)(a.out + (size_t)t * D) + F.lane;
    f32x4 v[8]; float s = 0.f;
#pragma unroll
    for (int j = 0; j < 8; ++j) { const u32x2 xb_ = xr[64 * j]; f32x4 x = (f32x4){bflo(xb_.x), bfhi(xb_.x), bflo(xb_.y), bfhi(xb_.y)};
        if (OUT8) { const unsigned b0 = q0[64 * j], b1 = q1[64 * j]; const float u0 = w0 * (1.0f / SC_OUT), u1 = w1 * (1.0f / SC_OUT);
            const f32x2 l0 = __builtin_amdgcn_cvt_pk_f32_fp8((int)b0, false), h0 = __builtin_amdgcn_cvt_pk_f32_fp8((int)b0, true), l1 = __builtin_amdgcn_cvt_pk_f32_fp8((int)b1, false), h1 = __builtin_amdgcn_cvt_pk_f32_fp8((int)b1, true);
            x.x += u0 * l0.x + u1 * l1.x; x.y += u0 * l0.y + u1 * l1.y; x.z += u0 * h0.x + u1 * h1.x; x.w += u0 * h0.y + u1 * h1.y; }
        else { const u32x2 a0 = p0[64 * j], a1 = p1[64 * j];
            x.x += w0 * bflo(a0.x) + w1 * bflo(a1.x); x.y += w0 * bfhi(a0.x) + w1 * bfhi(a1.x); x.z += w0 * bflo(a0.y) + w1 * bflo(a1.y); x.w += w0 * bfhi(a0.y) + w1 * bfhi(a1.y); }
        v[j] = x; if (NORM) { if (!DRY) { u32x2 w_; w_.x = pk2(x.x, x.y); w_.y = pk2(x.z, x.w); xr[64 * j] = w_; } } else xo[64 * j] = x; s += (x.x * x.x + x.y * x.y) + (x.z * x.z + x.w * x.w); }
    if (NORM) {
        const float rstd = __builtin_amdgcn_rsqf(wave_sum(s) * (1.f / D) + RMS_EPS);
        u32x2* o8 = (u32x2*)((bf16*)(F.ws + (DRY ? WS_OPART + 128 * MiB : WS_XN)) + (size_t)t * D) + F.lane;
#pragma unroll
        for (int j = 0; j < 8; ++j) {
            if (FP8_QKV) ((unsigned*)(F.ws + (DRY ? WS_OPART + 128 * MiB : WS_XN)) + (size_t)t * (D / 4))[64 * j + F.lane] = pk4_fp8(v[j].x * (rstd * SC_XN), v[j].y * (rstd * SC_XN), v[j].z * (rstd * SC_XN), v[j].w * (rstd * SC_XN));
            else { u32x2 w; w.x = pk2(v[j].x * rstd, v[j].y * rstd); w.y = pk2(v[j].z * rstd, v[j].w * rstd); o8[64 * j] = w; } }
    }
}

typedef int ci32x4 __attribute__((ext_vector_type(4)));
struct CombRows { u32x2 x[8]; unsigned b0[8], b1[8]; float w0, w1; };
template <bool NORM> __device__ __forceinline__ void combine_tokens(Frame& F, CArgs& a, int t0, int stride) {
    static_assert(OUT8_L0 && OUT8_L1 && FP8_QKV, "pipelined combine: e4m3 expert rows and e4m3 XN");
    const LAS int* blkstart = (const LAS int*)(F.lds + LT_BLKSTART);
    LAS ci32x4* lrec = (LAS ci32x4*)(F.lds + F.wave * 256);
    const int lane = F.lane;
    auto issue = [&](int k, int t, CombRows& R) {
        const ci32x4 r0 = lrec[2 * k], r1 = lrec[2 * k + 1];
        const int e0 = __builtin_amdgcn_readfirstlane(r0.x), rr0 = __builtin_amdgcn_readfirstlane(r0.y), e1 = __builtin_amdgcn_readfirstlane(r0.w), rr1 = __builtin_amdgcn_readfirstlane(r1.x);
        const LAS float* wf = (const LAS float*)lrec + 8 * k; R.w0 = wf[2] * (1.0f / SC_OUT); R.w1 = wf[5] * (1.0f / SC_OUT);
        const size_t row0 = (size_t)blkstart[e0] * 256 + rr0, row1 = (size_t)blkstart[e1] * 256 + rr1;
        const unsigned* q0 = (const unsigned*)(F.ws + WS_OUTB + row0 * D) + lane; const unsigned* q1 = (const unsigned*)(F.ws + WS_OUTB + row1 * D) + lane;
        const u32x2* xr = (const u32x2*)((const bf16*)(F.ws + WS_XR) + (size_t)t * D) + lane;
#pragma unroll
        for (int j = 0; j < 8; ++j) { R.x[j] = xr[64 * j]; R.b0[j] = q0[64 * j]; R.b1[j] = q1[64 * j]; }
    };
    auto finish = [&](int t, const CombRows& R) {
        u32x2* xr = (u32x2*)((bf16*)(F.ws + WS_XR) + (size_t)t * D) + lane; f32x4* xo = (f32x4*)(a.out + (size_t)t * D) + lane;
        f32x4 v[8]; float s = 0.f;
#pragma unroll
        for (int j = 0; j < 8; ++j) { f32x4 x = (f32x4){bflo(R.x[j].x), bfhi(R.x[j].x), bflo(R.x[j].y), bfhi(R.x[j].y)};
            const f32x2 l0 = __builtin_amdgcn_cvt_pk_f32_fp8((int)R.b0[j], false), h0 = __builtin_amdgcn_cvt_pk_f32_fp8((int)R.b0[j], true), l1 = __builtin_amdgcn_cvt_pk_f32_fp8((int)R.b1[j], false), h1 = __builtin_amdgcn_cvt_pk_f32_fp8((int)R.b1[j], true);
            x.x += R.w0 * l0.x + R.w1 * l1.x; x.y += R.w0 * l0.y + R.w1 * l1.y; x.z += R.w0 * h0.x + R.w1 * h1.x; x.w += R.w0 * h0.y + R.w1 * h1.y;
            v[j] = x; if (NORM) { u32x2 w_; w_.x = pk2(x.x, x.y); w_.y = pk2(x.z, x.w); xr[64 * j] = w_; } else xo[64 * j] = x; s += (x.x * x.x + x.y * x.y) + (x.z * x.z + x.w * x.w); }
        if (NORM) {
            const float rstd = __builtin_amdgcn_rsqf(wave_sum(s) * (1.f / D) + RMS_EPS) * SC_XN;
            unsigned* o = (unsigned*)(F.ws + WS_XN) + (size_t)t * (D / 4) + lane;
#pragma unroll
            for (int j = 0; j < 8; ++j) o[64 * j] = pk4_fp8(v[j].x * rstd, v[j].y * rstd, v[j].z * rstd, v[j].w * rstd);
        }
    };
    for (int base = t0; base < M; base += 8 * stride) {
        const int nt = min(8, (M - base + stride - 1) / stride);
        if (lane < 2 * nt) lrec[lane] = ((const ci32x4*)(F.ws + WS_TOKREC))[2 * (size_t)(base + (lane >> 1) * stride) + (lane & 1)];
        LDS_WAIT(); asm volatile("s_waitcnt vmcnt(0)" ::: "memory"); LDS_WAIT();
        CombRows cur, nxt; issue(0, base, cur);
        for (int k = 0; k < nt; ++k) {
            if (k + 1 < nt) issue(k + 1, base + (k + 1) * stride, nxt);
            finish(base + k * stride, cur);
            cur = nxt;
        }
        LDS_WAIT();
    }
}
__device__ __forceinline__ void hgrn_naive_item(Frame& F, int item) {
    const int b = item >> 6, h = (item >> 2) & 15, sl = item & 3;
    const bf16* Zq = (const bf16*)(F.ws + WS_ZQ); const bf16* Zk = (const bf16*)(F.ws + WS_ZK); const _Float16* Zg = (const _Float16*)(F.ws + WS_ZG); const bf16* Zv = (const bf16*)(F.ws + WS_ZV);
    float* Oraw = (float*)(F.ws + WS_ORAW);
    LAS float* fq = (LAS float*)F.lds; LAS float* fk = fq + 16 * 128; LAS float* ff = fk + 16 * 128; LAS float* fv = ff + 16 * 128; LAS float* part = fv + 16 * 32;
    const int dv = F.tid & 31, dkg = F.tid >> 5;
    float S[8];
#pragma unroll
    for (int j = 0; j < 8; ++j) S[j] = 0.f;
    const size_t tok0 = (size_t)b * T;
    for (int c = 0; c < T / 16; ++c) {
        __syncthreads();
#pragma unroll
        for (int i = 0; i < 4; ++i) { const int idx = F.tid + i * 512, st = idx >> 7, dk = idx & 127; const size_t g = (tok0 + c * 16 + st) * D + h * HD + dk;
            fq[idx] = bf2f(Zq[g]); fk[idx] = bf2f(Zk[g]); ff[idx] = __expf((float)Zg[g]); }
        { const int st = F.tid >> 5; fv[F.tid] = bf2f(Zv[(tok0 + c * 16 + st) * D + h * HD + sl * 32 + dv]); }
        __syncthreads();
#pragma unroll 4
        for (int st = 0; st < 16; ++st) {
            const float v = fv[st * 32 + dv];
            const f32x4 q0 = *(const LAS f32x4*)(fq + st * 128 + dkg * 8), q1 = *(const LAS f32x4*)(fq + st * 128 + dkg * 8 + 4);
            const f32x4 k0 = *(const LAS f32x4*)(fk + st * 128 + dkg * 8), k1 = *(const LAS f32x4*)(fk + st * 128 + dkg * 8 + 4);
            const f32x4 f0 = *(const LAS f32x4*)(ff + st * 128 + dkg * 8), f1 = *(const LAS f32x4*)(ff + st * 128 + dkg * 8 + 4);
            float po = 0.f;
#pragma unroll
            for (int j = 0; j < 4; ++j) { S[j] = f0[j] * S[j] + k0[j] * v; po += q0[j] * S[j]; S[4 + j] = f1[j] * S[4 + j] + k1[j] * v; po += q1[j] * S[4 + j]; }
            part[(st * 16 + dkg) * 32 + dv] = po;
        }
        __syncthreads();
        { const int st = F.tid >> 5; float o = 0.f;
#pragma unroll
            for (int g = 0; g < 16; ++g) o += part[(st * 16 + g) * 32 + dv];
            Oraw[(tok0 + c * 16 + st) * D + h * HD + sl * 32 + dv] = o; }
    }
    __syncthreads();
}
__device__ __forceinline__ void hgrn_norm_token(Frame& F, CArgs& a, int t) {
    const float* o = (const float*)(F.ws + WS_ORAW) + (size_t)t * D + F.lane * 32;
    const bf16* zg = (const bf16*)(F.ws + WS_ZGATE) + (size_t)t * D + F.lane * 32;
    const float* gain = a.in[I_A_OGAIN] + (F.lane & 3) * 32;
    f32x4 v[8]; float s = 0.f;
#pragma unroll
    for (int j = 0; j < 8; ++j) { v[j] = ((const f32x4*)o)[j]; s += (v[j].x * v[j].x + v[j].y * v[j].y) + (v[j].z * v[j].z + v[j].w * v[j].w); }
    s += __shfl_xor(s, 1); s += __shfl_xor(s, 2);
    const float rstd = 1.0f / sqrtf(s * (1.f / HD) + RMS_EPS);
    bf16* out = (bf16*)(F.ws + WS_OH) + (size_t)t * D + F.lane * 32;
#pragma unroll
    for (int j = 0; j < 4; ++j) { const u32x4 g = ((const u32x4*)zg)[j]; const f32x4 ga = ((const f32x4*)gain)[2 * j], gb = ((const f32x4*)gain)[2 * j + 1]; const f32x4 va = v[2 * j], vb = v[2 * j + 1];
        u32x4 w; w.x = pk2(va.x * rstd * ga.x * bflo(g.x), va.y * rstd * ga.y * bfhi(g.x)); w.y = pk2(va.z * rstd * ga.z * bflo(g.y), va.w * rstd * ga.w * bfhi(g.y));
        w.z = pk2(vb.x * rstd * gb.x * bflo(g.z), vb.y * rstd * gb.y * bfhi(g.z)); w.w = pk2(vb.z * rstd * gb.z * bflo(g.w), vb.w * rstd * gb.w * bfhi(g.w));
        ((u32x4*)out)[j] = w; }
}

template <bool DRY> __device__ __forceinline__ void qk_post_item(Frame& F, CArgs& a, int item) {
    const int b = item >> 6, n = (item >> 2) & 15, hq = item & 3;
    const int hl = F.lane >> 4, sb = F.lane & 15, h = hq * 4 + hl;
    bf16* Q = (bf16*)(F.ws + WS_Q); bf16* Kb = (bf16*)(F.ws + WS_K);
    const f32x2* rope = (const f32x2*)(F.ws + WS_ROPE);
    const f32x4 gq0 = *(const f32x4*)(a.in[I_B_Q_NORM] + 4 * sb), gq1 = *(const f32x4*)(a.in[I_B_Q_NORM] + 64 + 4 * sb);
    const f32x4 gk0 = *(const f32x4*)(a.in[I_K_NORM] + 4 * sb), gk1 = *(const f32x4*)(a.in[I_K_NORM] + 64 + 4 * sb);
    float ks[8];
#pragma unroll
    for (int j = 0; j < 8; ++j) ks[j] = 0.f;
    for (int i = 0; i < 32; ++i) {
        const int pos = n * MBLK + F.wave * 32 + i; const size_t tok = (size_t)b * T + pos;
        f32x2 cs[4];
#pragma unroll
        for (int j = 0; j < 4; ++j) cs[j] = rope[pos * 64 + 4 * sb + j];
#pragma unroll
        for (int which = 0; which < 2; ++which) {
            bf16* p = (which ? Kb : Q) + tok * D + h * HD + 4 * sb;
            const u32x2 lo = *(const u32x2*)p, hi = *(const u32x2*)(p + 64);
            float x1[4] = {bflo(lo.x), bfhi(lo.x), bflo(lo.y), bfhi(lo.y)}, x2[4] = {bflo(hi.x), bfhi(hi.x), bflo(hi.y), bfhi(hi.y)};
            float s = 0.f;
#pragma unroll
            for (int j = 0; j < 4; ++j) s += x1[j] * x1[j] + x2[j] * x2[j];
            s += __shfl_xor(s, 1); s += __shfl_xor(s, 2); s += __shfl_xor(s, 4); s += __shfl_xor(s, 8);
            const float rstd = 1.0f / sqrtf(s * (1.f / HD) + RMS_EPS);
            const f32x4 g0 = which ? gk0 : gq0, g1 = which ? gk1 : gq1;
            float o1[4], o2[4];
#pragma unroll
            for (int j = 0; j < 4; ++j) { const float y1 = x1[j] * rstd * g0[j], y2 = x2[j] * rstd * g1[j]; o1[j] = y1 * cs[j].x - y2 * cs[j].y; o2[j] = y2 * cs[j].x + y1 * cs[j].y; }
            u32x2 wlo, whi; wlo.x = pk2(o1[0], o1[1]); wlo.y = pk2(o1[2], o1[3]); whi.x = pk2(o2[0], o2[1]); whi.y = pk2(o2[2], o2[3]);
            { bf16* pw = DRY ? p + (WS_OPART - WS_Q) / 2 : p; *(u32x2*)pw = wlo; *(u32x2*)(pw + 64) = whi; }
            if (which) {
#pragma unroll
                for (int j = 0; j < 4; ++j) { ks[j] += o1[j]; ks[4 + j] += o2[j]; } }
        }
    }
    LAS float* red = (LAS float*)F.lds;
    __syncthreads();
#pragma unroll
    for (int j = 0; j < 8; ++j) red[(F.wave * 64 + F.lane) * 8 + j] = ks[j];
    __syncthreads();
    { const int l = F.tid >> 3, j = F.tid & 7; float s = 0.f;
#pragma unroll
        for (int w = 0; w < 8; ++w) s += red[(w * 64 + l) * 8 + j];
        const int hh = hq * 4 + (l >> 4), s2 = l & 15, d = (j < 4) ? 4 * s2 + j : 64 + 4 * s2 + (j - 4);
        ((float*)(F.ws + (DRY ? WS_OPART + 200 * MiB : WS_KMEAN)))[(((size_t)b * H + hh) * NBLK + n) * HD + d] = s * (1.0f / MBLK); }
    const bf16* V = (const bf16*)(F.ws + WS_V); bf16* Vt = (bf16*)(F.ws + (DRY ? WS_OPART + 128 * MiB : WS_VT));
    LAS bf16* vl = (LAS bf16*)(F.lds + 32768);
    for (int hh = 0; hh < 4; ++hh) {
        const int hv = hq * 4 + hh;
        __syncthreads();
#pragma unroll
        for (int i = 0; i < 8; ++i) { const int ch = F.tid + i * 512, r = ch >> 4, cc = ch & 15;
            const u32x4 w = *(const u32x4*)(V + ((size_t)b * T + n * MBLK + r) * D + hv * HD + cc * 8);
            *(LAS u32x4*)(vl + r * 136 + cc * 8) = w; }
        __syncthreads();
#pragma unroll
        for (int i = 0; i < 8; ++i) { const int idx = F.tid + i * 512, d = idx & 127, tg = idx >> 7;
            unsigned short e[8];
#pragma unroll
            for (int j = 0; j < 8; ++j) e[j] = vl[(tg * 8 + j) * 136 + d];
            u32x4 w; w.x = e[0] | ((unsigned)e[1] << 16); w.y = e[2] | ((unsigned)e[3] << 16); w.z = e[4] | ((unsigned)e[5] << 16); w.w = e[6] | ((unsigned)e[7] << 16);
            *(u32x4*)(Vt + (((size_t)b * H + hv) * HD + d) * T + n * MBLK + tg * 8) = w; }
    }
    __syncthreads();
}

__device__ __forceinline__ void attn_v0_item(Frame& F, int item) {
    const int b = item >> 8, h = (item >> 4) & 15, jb = item & 15;
    const bf16* Q = (const bf16*)(F.ws + WS_Q); const bf16* Kb = (const bf16*)(F.ws + WS_K); const bf16* Vt = (const bf16*)(F.ws + WS_VT); bf16* OA = (bf16*)(F.ws + WS_OA);
    const float* kmean = (const float*)(F.ws + WS_KMEAN) + ((size_t)b * H + h) * NBLK * HD;
    const int lane = F.lane, fr = lane & 15, fq = lane >> 4;
    const size_t tokw = (size_t)b * T + jb * MBLK + F.wave * 32;
    LAS unsigned* maskl = (LAS unsigned*)(F.lds + F.wave * 8192);
    LAS bf16* pl = (LAS bf16*)(F.lds + F.wave * 8192 + 256);
    {
        const int row = lane & 31, half = lane >> 5;
        float g[8];
#pragma unroll
        for (int i = 0; i < 8; ++i) g[i] = 0.f;
        const bf16* qrow = Q + (tokw + row) * D + h * HD;
        for (int dc = 0; dc < 16; ++dc) {
            const u32x4 w = *(const u32x4*)(qrow + dc * 8);
            const float qv[8] = {bflo(w.x), bfhi(w.x), bflo(w.y), bfhi(w.y), bflo(w.z), bfhi(w.z), bflo(w.w), bfhi(w.w)};
#pragma unroll
            for (int i = 0; i < 8; ++i) { const float* km = kmean + (2 * i + half) * HD + dc * 8;
#pragma unroll
                for (int e = 0; e < 8; ++e) g[i] += qv[e] * km[e]; }
        }
        float ga[16];
#pragma unroll
        for (int i = 0; i < 8; ++i) { const float o = __shfl_xor(g[i], 32); ga[2 * i] = half ? o : g[i]; ga[2 * i + 1] = half ? g[i] : o; }
        unsigned mask = 0u;
#pragma unroll
        for (int pick = 0; pick < 3; ++pick) { float best = -INFINITY; int bi = -1;
#pragma unroll
            for (int n = 0; n < 16; ++n) { const bool ok = (n < jb) && !((mask >> n) & 1u); if (ok && ga[n] > best) { best = ga[n]; bi = n; } }
            if (bi >= 0) mask |= 1u << bi; }
        if (half == 0) maskl[row] = mask;
    }
    LDS_WAIT(); __builtin_amdgcn_wave_barrier();
    unsigned rmask[2][4]; unsigned anym = 0u;
#pragma unroll
    for (int rt = 0; rt < 2; ++rt)
#pragma unroll
        for (int r = 0; r < 4; ++r) { rmask[rt][r] = maskl[rt * 16 + 4 * fq + r]; }
    { unsigned m = maskl[lane & 31];
#pragma unroll
      for (int o = 1; o < 32; o <<= 1) m |= __shfl_xor(m, o);
      anym = __builtin_amdgcn_readfirstlane(m); }
    bf16x8 qf[2][4];
#pragma unroll
    for (int rt = 0; rt < 2; ++rt)
#pragma unroll
        for (int ks = 0; ks < 4; ++ks) qf[rt][ks] = *(const bf16x8*)(Q + (tokw + rt * 16 + fr) * D + h * HD + ks * 32 + 8 * fq);
    f32x4 oacc[2][8];
#pragma unroll
    for (int rt = 0; rt < 2; ++rt)
#pragma unroll
        for (int dt = 0; dt < 8; ++dt) oacc[rt][dt] = (f32x4){0.f, 0.f, 0.f, 0.f};
    float lsum[2][4];
#pragma unroll
    for (int rt = 0; rt < 2; ++rt)
#pragma unroll
        for (int r = 0; r < 4; ++r) lsum[rt][r] = 0.f;
    const float c2 = 0.08838834764831845f * 1.4426950408889634f;
    const int nkt = 4 * jb + 4;
    for (int kt = 0; kt < nkt; ++kt) {
        const int n = kt >> 2; const bool own = (n == jb);
        if (!own && !((anym >> n) & 1u)) continue;
        if (own && (kt & 3) * 64 > F.wave * 32 + 31) continue;
        const size_t key0 = (size_t)b * T + kt * 64;
        f32x4 sacc[2][4];
#pragma unroll
        for (int ct = 0; ct < 4; ++ct) {
            bf16x8 kf[4];
#pragma unroll
            for (int ks = 0; ks < 4; ++ks) kf[ks] = *(const bf16x8*)(Kb + (key0 + ct * 16 + fr) * D + h * HD + ks * 32 + 8 * fq);
#pragma unroll
            for (int rt = 0; rt < 2; ++rt) { f32x4 s = (f32x4){0.f, 0.f, 0.f, 0.f};
#pragma unroll
                for (int ks = 0; ks < 4; ++ks) s = __builtin_amdgcn_mfma_f32_16x16x32_bf16(qf[rt][ks], kf[ks], s, 0, 0, 0);
                sacc[rt][ct] = s; }
        }
#pragma unroll
        for (int rt = 0; rt < 2; ++rt)
#pragma unroll
            for (int ct = 0; ct < 4; ++ct)
#pragma unroll
                for (int r = 0; r < 4; ++r) {
                    const int qrow = rt * 16 + 4 * fq + r, kcol = ct * 16 + fr;
                    const bool ok = own ? ((kt & 3) * 64 + kcol <= F.wave * 32 + qrow) : ((rmask[rt][r] >> n) & 1u);
                    const float p = ok ? __builtin_amdgcn_exp2f(sacc[rt][ct][r] * c2) : 0.f;
                    lsum[rt][r] += p;
                    pl[qrow * 72 + kcol] = (bf16)f2bf(p);
                }
        LDS_WAIT(); __builtin_amdgcn_wave_barrier();
        bf16x8 pf[2][2];
#pragma unroll
        for (int rt = 0; rt < 2; ++rt)
#pragma unroll
            for (int k2 = 0; k2 < 2; ++k2) pf[rt][k2] = *(const LAS bf16x8*)(pl + (rt * 16 + fr) * 72 + k2 * 32 + 8 * fq);
#pragma unroll
        for (int dt = 0; dt < 8; ++dt) {
            bf16x8 vf[2];
#pragma unroll
            for (int k2 = 0; k2 < 2; ++k2) vf[k2] = *(const bf16x8*)(Vt + (((size_t)b * H + h) * HD + dt * 16 + fr) * T + kt * 64 + k2 * 32 + 8 * fq);
#pragma unroll
            for (int rt = 0; rt < 2; ++rt)
#pragma unroll
                for (int k2 = 0; k2 < 2; ++k2) oacc[rt][dt] = __builtin_amdgcn_mfma_f32_16x16x32_bf16(pf[rt][k2], vf[k2], oacc[rt][dt], 0, 0, 0);
        }
        LDS_WAIT(); __builtin_amdgcn_wave_barrier();
    }
#pragma unroll
    for (int rt = 0; rt < 2; ++rt)
#pragma unroll
        for (int r = 0; r < 4; ++r) { float s = lsum[rt][r]; s += __shfl_xor(s, 1); s += __shfl_xor(s, 2); s += __shfl_xor(s, 4); s += __shfl_xor(s, 8); const float inv = 1.0f / s;
            bf16* orow = OA + (tokw + rt * 16 + 4 * fq + r) * D + h * HD + fr;
#pragma unroll
            for (int dt = 0; dt < 8; ++dt) orow[dt * 16] = (bf16)f2bf(oacc[rt][dt][r] * inv); }
}

typedef float f32x16 __attribute__((ext_vector_type(16)));
template <bool DRY> __device__ __forceinline__ void moba_gate_item(Frame& F, int item) {
    const int bh = item >> 3, p = item & 7, b = bh >> 4, h = bh & 15;
    LAS float* km = (LAS float*)F.lds;
    __syncthreads();
    { const f32x4 v = ((const f32x4*)((const float*)(F.ws + WS_KMEAN) + (size_t)bh * NBLK * HD))[F.tid]; ((LAS f32x4*)km)[F.tid] = v; }
    __syncthreads();
    const int j = 2 * p + (F.wave >> 2), t = j * MBLK + (F.wave & 3) * 64 + F.lane;
    if (j == 0) return;
    const unsigned char* qrow = F.ws + WS_Q + ((size_t)b * T + t) * D + h * HD;
    float g[16];
#pragma unroll
    for (int n = 0; n < 16; ++n) g[n] = 0.f;
    for (int dc = 0; dc < 8; ++dc) {
        const u32x4 w = *(const u32x4*)(qrow + dc * 16);
        float qv[16]; { float t4[4]; fp8x4_to_f32(w.x, t4); qv[0] = t4[0]; qv[1] = t4[1]; qv[2] = t4[2]; qv[3] = t4[3]; fp8x4_to_f32(w.y, t4); qv[4] = t4[0]; qv[5] = t4[1]; qv[6] = t4[2]; qv[7] = t4[3];
            fp8x4_to_f32(w.z, t4); qv[8] = t4[0]; qv[9] = t4[1]; qv[10] = t4[2]; qv[11] = t4[3]; fp8x4_to_f32(w.w, t4); qv[12] = t4[0]; qv[13] = t4[1]; qv[14] = t4[2]; qv[15] = t4[3]; }
#pragma unroll
        for (int n = 0; n < 15; ++n) if (n < j) {
#pragma unroll
            for (int q4 = 0; q4 < 4; ++q4) { const f32x4 k0 = *(const LAS f32x4*)(km + n * HD + dc * 16 + 4 * q4);
                g[n] += (qv[4 * q4] * k0.x + qv[4 * q4 + 1] * k0.y) + (qv[4 * q4 + 2] * k0.z + qv[4 * q4 + 3] * k0.w); } }
    }
    int pk[3];
    unsigned mask = 0u;
#pragma unroll
    for (int pick = 0; pick < 3; ++pick) { float best = -INFINITY; int bi = -1;
#pragma unroll
        for (int n = 0; n < 15; ++n) { const bool ok = (n < j) && !((mask >> n) & 1u); if (ok && g[n] > best) { best = g[n]; bi = n; } }
        if (bi >= 0) mask |= 1u << bi;
        pk[pick] = bi; }
    unsigned* acnt = F.ctl + CW_ACNT + bh * 16; int* alist = (int*)(F.ws + WS_ALIST) + (size_t)bh * 16 * ALIST_CAP;
    unsigned mycnt = 0u;
#pragma unroll
    for (int n = 0; n < 15; ++n) if (n < j) { const unsigned long long bal = __ballot((mask >> n) & 1u); mycnt = (F.lane == n) ? (unsigned)__popcll(bal) : mycnt; }
    unsigned mybase = 0u;
    if (F.lane < 15 && mycnt > 0u && !DRY) mybase = atomicAdd(acnt + F.lane, mycnt);
#pragma unroll
    for (int n = 0; n < 15; ++n) if (n < j) {
        const bool sel = (mask >> n) & 1u; const int slot = (pk[0] == n) ? 0 : ((pk[1] == n) ? 1 : 2);
        const unsigned long long bal = __ballot(sel);
        if (bal) { const unsigned base = (unsigned)__builtin_amdgcn_readlane((int)mybase, n);
            const int rank = __popcll(bal & ((1ull << F.lane) - 1ull));
            if (sel) (DRY ? (int*)(F.ws + WS_OPART) : alist)[n * ALIST_CAP + base + rank] = t | (slot << 16); }
    }
}

constexpr int AL_K = 0, AL_V = 36864; constexpr float SC_P = 4.f;
typedef int i32x8v __attribute__((ext_vector_type(8)));
__device__ __forceinline__ i32x8v ld32(const LAS unsigned char* p) { const u32x4 a = *(const LAS u32x4*)p, b = *(const LAS u32x4*)(p + 16); i32x8v r; r[0] = a.x; r[1] = a.y; r[2] = a.z; r[3] = a.w; r[4] = b.x; r[5] = b.y; r[6] = b.z; r[7] = b.w; return r; }
template <bool OWN> __device__ __forceinline__ void attn_chunk(Frame& F, int b, int h, int n, int c, int cnt, const int* lst) {
    const int lane = F.lane, qi = lane & 31, hh = lane >> 5, w = F.wave;
    const int rem = OWN ? MBLK : cnt - c * 256;
    if (w * 32 >= rem) return;
    int t, slot; bool valid = true;
    if (OWN) { t = n * MBLK + w * 32 + qi; slot = 3; }
    else { const int idx = w * 32 + qi; valid = idx < rem; const int e = lst[c * 256 + (valid ? idx : 0)]; t = e & 0xffff; slot = e >> 16; }
    const size_t tok = (size_t)b * T + t;
    const unsigned char* qrow = F.ws + WS_Q + tok * D + h * HD;
    i32x8v qf[2];
#pragma unroll
    for (int ks = 0; ks < 2; ++ks) { const u32x4 a = *(const u32x4*)(qrow + 64 * ks + 32 * hh), bq = *(const u32x4*)(qrow + 64 * ks + 32 * hh + 16);
        qf[ks][0] = a.x; qf[ks][1] = a.y; qf[ks][2] = a.z; qf[ks][3] = a.w; qf[ks][4] = bq.x; qf[ks][5] = bq.y; qf[ks][6] = bq.z; qf[ks][7] = bq.w; }
    const LAS unsigned char* Kl = F.lds + AL_K; const LAS unsigned char* Vl = F.lds + AL_V;
    f32x16 oacc[4];
#pragma unroll
    for (int dt = 0; dt < 4; ++dt)
#pragma unroll
        for (int r = 0; r < 16; ++r) oacc[dt][r] = 0.f;
    float lsum = 0.f, mrun = -1e30f;
    const float c2 = 0.08838834764831845f * 1.4426950408889634f / (SC_QKV * SC_QKV);
    const int ngrp = OWN ? ((w >> 1) + 1) : 4;
#pragma unroll
    for (int G = 0; G < 4; ++G) {
        if (G >= ngrp) break;
        f32x16 sa, sb;
#pragma unroll
        for (int r = 0; r < 16; ++r) { sa[r] = 0.f; sb[r] = 0.f; }
#pragma unroll
        for (int ks = 0; ks < 2; ++ks) {
            const i32x8v ka = ld32(Kl + (64 * G + qi) * 144 + 64 * ks + 32 * hh), kb = ld32(Kl + (64 * G + 32 + qi) * 144 + 64 * ks + 32 * hh);
            sa = __builtin_amdgcn_mfma_scale_f32_32x32x64_f8f6f4(ka, qf[ks], sa, 0, 0, 0, 0, 0, 0);
            sb = __builtin_amdgcn_mfma_scale_f32_32x32x64_f8f6f4(kb, qf[ks], sb, 0, 0, 0, 0, 0, 0);
        }
        float tv[32];
#pragma unroll
        for (int r = 0; r < 16; ++r) { tv[r] = sa[r]; tv[16 + r] = sb[r]; }
        if (OWN && G == (w >> 1)) {
#pragma unroll
            for (int p = 0; p < 32; ++p) { const int key = 64 * G + 32 * (p >> 4) + (p & 3) + 8 * ((p >> 2) & 3) + 4 * hh; tv[p] = (key <= w * 32 + qi) ? tv[p] : -3e38f; }
        }
        float ml = tv[0];
#pragma unroll
        for (int p = 1; p < 32; ++p) ml = fmaxf(ml, tv[p]);
        ml = fmaxf(ml, __shfl_xor(ml, 32)) * c2;
        const float mnew = (ml > mrun + 6.0f) ? ml : mrun;
        const bool moved = (mnew != mrun);
        const float alpha = __builtin_amdgcn_exp2f(mrun - mnew);
        mrun = mnew;
        float ps = 0.f; i32x8v pf;
#pragma unroll
        for (int q4 = 0; q4 < 8; ++q4) { float e4[4];
#pragma unroll
            for (int j = 0; j < 4; ++j) { e4[j] = __builtin_amdgcn_exp2f(__builtin_fmaf(tv[4 * q4 + j], c2, -mnew)); ps += e4[j]; }
            int pw_ = __builtin_amdgcn_cvt_pk_fp8_f32(e4[0] * SC_P, e4[1] * SC_P, 0, false); pw_ = __builtin_amdgcn_cvt_pk_fp8_f32(e4[2] * SC_P, e4[3] * SC_P, pw_, true); pf[q4] = pw_; }
        lsum = lsum * alpha + ps;
        if (G > 0 && __any(moved)) {
#pragma unroll
            for (int dt = 0; dt < 4; ++dt)
#pragma unroll
                for (int r = 0; r < 16; ++r) oacc[dt][r] *= alpha;
        }
#pragma unroll
        for (int dt = 0; dt < 4; ++dt) {
            const i32x8v vf = ld32(Vl + (32 * dt + qi) * 272 + 64 * G + 32 * hh);
            oacc[dt] = __builtin_amdgcn_mfma_scale_f32_32x32x64_f8f6f4(vf, pf, oacc[dt], 0, 0, 0, 0, 0, 0);
        }
    }
    lsum += __shfl_xor(lsum, 32);
    if (valid) {
        unsigned char* op = F.ws + WS_OPART + ((size_t)slot * M + tok) * D + h * HD;
        const float pinv = __builtin_amdgcn_rcpf(lsum) * (SC_PART / (SC_QKV * SC_P));
        unsigned wq[4][4];
#pragma unroll
        for (int dt = 0; dt < 4; ++dt)
#pragma unroll
            for (int g4 = 0; g4 < 4; ++g4) wq[dt][g4] = pk4_fp8(oacc[dt][4 * g4 + 0] * pinv, oacc[dt][4 * g4 + 1] * pinv, oacc[dt][4 * g4 + 2] * pinv, oacc[dt][4 * g4 + 3] * pinv);
        u32x4 st[4];
#pragma unroll
        for (int d2 = 0; d2 < 2; ++d2)
#pragma unroll
            for (int g4 = 0; g4 < 4; ++g4) { const unsigned give = hh ? wq[d2][g4] : wq[2 + d2][g4], keep = hh ? wq[2 + d2][g4] : wq[d2][g4];
                const unsigned got = (unsigned)__shfl_xor((int)give, 32);
                const unsigned w_even = hh ? got : keep, w_odd = hh ? keep : got;
                st[2 * d2 + (g4 >> 1)][2 * (g4 & 1)] = w_even; st[2 * d2 + (g4 >> 1)][2 * (g4 & 1) + 1] = w_odd; }
#pragma unroll
        for (int q = 0; q < 4; ++q) *(u32x4*)(op + 64 * hh + 16 * q) = st[q];
        if (hh == 0) { f32x2 lm; lm.x = lsum; lm.y = mrun; ((f32x2*)(F.ws + WS_LPART))[((size_t)slot * M + tok) * H + h] = lm; }
    }
}
__device__ __forceinline__ void attn_group(Frame& F, int bh, int n) {
    const int b = bh >> 4, h = bh & 15;
    const gcptr Kg = opaque_s(F.ws + WS_K + ((size_t)b * T + n * MBLK) * D + h * HD);
    const gcptr Vg = opaque_s(F.ws + WS_V + ((size_t)b * T + n * MBLK) * D + h * HD);
    const int tg = make_tid(F.wave);
    __syncthreads();
#pragma unroll
    for (int i = 0; i < 4; ++i) { const int ch = tg + i * 512;
        { const int r = ch >> 3, cc = ch & 7; *(LAS u32x4*)(F.lds + AL_K + r * 144 + cc * 16) = *(const GAS u32x4*)(Kg + (unsigned)(r * D + cc * 16)); }
        { const int rl = ch & 63, cc = (ch >> 6) & 7, G = ch >> 9, r = 64 * G + rl;
          const u32x4 vv = *(const GAS u32x4*)(Vg + (unsigned)(r * D + cc * 16)); const unsigned vw[4] = {vv.x, vv.y, vv.z, vv.w};
          LAS unsigned char* vd = F.lds + AL_V + (16 * cc) * 272 + 64 * G + 32 * ((rl >> 2) & 1) + 4 * (rl >> 3) + (rl & 3);
#pragma unroll
          for (int e = 0; e < 16; ++e) vd[e * 272] = (unsigned char)(vw[e >> 2] >> (8 * (e & 3))); }
    }
    __syncthreads();
    attn_chunk<true>(F, b, h, n, 0, 0, nullptr);
    if (n < 15) {
        const int cnt = (int)__hip_atomic_load(F.ctl + CW_ACNT + bh * 16 + n, __ATOMIC_RELAXED, __HIP_MEMORY_SCOPE_AGENT);
        const int* lst = (const int*)(F.ws + WS_ALIST) + ((size_t)bh * 16 + n) * ALIST_CAP;
        for (int c = 0; c * 256 < cnt; ++c) attn_chunk<false>(F, b, h, n, c, cnt, lst);
    }
}
__device__ __forceinline__ void attn_combine_token(Frame& F, int tok) {
    const int j = (tok & (T - 1)) >> 8, nsl = j < 3 ? j : 3, hd = F.lane >> 2;
    f32x2 lm[4]; float mx = -1e30f;
#pragma unroll
    for (int s4 = 0; s4 < 4; ++s4) { const int s_ = (s4 == 0) ? 3 : s4 - 1; lm[s4] = (f32x2){0.f, -1e30f};
        if (s4 == 0 || s4 - 1 < nsl) { lm[s4] = ((const f32x2*)(F.ws + WS_LPART))[((size_t)s_ * M + tok) * H + hd]; mx = fmaxf(mx, lm[s4].y); } }
    float acc[32]; float l = 0.f;
#pragma unroll
    for (int i = 0; i < 32; ++i) acc[i] = 0.f;
#pragma unroll
    for (int s4 = 0; s4 < 4; ++s4) { const int s_ = (s4 == 0) ? 3 : s4 - 1;
        if (s4 == 0 || s4 - 1 < nsl) {
            const u32x4* p = (const u32x4*)(F.ws + WS_OPART + ((size_t)s_ * M + tok) * D + F.lane * 32);
            const float ls = lm[s4].x * __builtin_amdgcn_exp2f(lm[s4].y - mx);
            const u32x4 w0 = p[0], w1 = p[1]; const unsigned wd[8] = {w0.x, w0.y, w0.z, w0.w, w1.x, w1.y, w1.z, w1.w};
#pragma unroll
            for (int i = 0; i < 8; ++i) { const f32x2 lo = __builtin_amdgcn_cvt_pk_f32_fp8((int)wd[i], false), hi = __builtin_amdgcn_cvt_pk_f32_fp8((int)wd[i], true);
                acc[4 * i] += lo.x * ls; acc[4 * i + 1] += lo.y * ls; acc[4 * i + 2] += hi.x * ls; acc[4 * i + 3] += hi.y * ls; }
            l += ls; } }
    const float inv = __builtin_amdgcn_rcpf(l) * (1.0f / SC_PART);
    if (FP8_OUTB) { const float iv = inv * SC_OA; u32x4* o8 = (u32x4*)(F.ws + WS_OA + (size_t)tok * D + F.lane * 32);
#pragma unroll
        for (int i = 0; i < 2; ++i) { u32x4 w; w.x = pk4_fp8(acc[16 * i] * iv, acc[16 * i + 1] * iv, acc[16 * i + 2] * iv, acc[16 * i + 3] * iv); w.y = pk4_fp8(acc[16 * i + 4] * iv, acc[16 * i + 5] * iv, acc[16 * i + 6] * iv, acc[16 * i + 7] * iv);
            w.z = pk4_fp8(acc[16 * i + 8] * iv, acc[16 * i + 9] * iv, acc[16 * i + 10] * iv, acc[16 * i + 11] * iv); w.w = pk4_fp8(acc[16 * i + 12] * iv, acc[16 * i + 13] * iv, acc[16 * i + 14] * iv, acc[16 * i + 15] * iv); o8[i] = w; }
        return; }
    u32x4* o = (u32x4*)((bf16*)(F.ws + WS_OA) + (size_t)tok * D + F.lane * 32);
#pragma unroll
    for (int i = 0; i < 4; ++i) { u32x4 w; w.x = pk2(acc[8 * i] * inv, acc[8 * i + 1] * inv); w.y = pk2(acc[8 * i + 2] * inv, acc[8 * i + 3] * inv); w.z = pk2(acc[8 * i + 4] * inv, acc[8 * i + 5] * inv); w.w = pk2(acc[8 * i + 6] * inv, acc[8 * i + 7] * inv); o[i] = w; }
}
constexpr size_t WS_SLOC = WS_ORAW;
constexpr size_t WS_DLOG = WS_ORAW + 16 * MiB;
constexpr int HL_A = 0, HL_BM = 17408, HL_BMT = 34816, HL_VT = 53248, HL_SPT = 71680, HL_P = 106496, HL_EGR = 115712, HL_EEND = 116224, HL_QSUM = 116736, HL_SSQ = 118784,
              HL_STQ = HL_SPT, HL_STK = HL_SPT + 17408, HL_STG = 119808, HL_STV = 119808 + 17408;
#define HG_BAR() do { asm volatile("s_waitcnt lgkmcnt(0)" ::: "memory"); __builtin_amdgcn_s_barrier(); asm volatile("" ::: "memory"); } while (0)
template <bool FULL> __device__ __forceinline__ void hgrn_item(Frame& F, CArgs& a, int item) {
    const int bh = item >> 2, seg = item & 3, b = bh >> 4, h = bh & 15;
    if (!FULL && seg == 3) return;
    const int lane = F.lane, qi = lane & 31, hh = lane >> 5, w = F.wave;
    const int kk = F.tid & 127, tq = F.tid >> 7;
    const int vt = w & 3, ktb = 2 * (w >> 2);
    const bf16* Zq = (const bf16*)(F.ws + WS_ZQ); const bf16* Zk = (const bf16*)(F.ws + WS_ZK); const _Float16* Zg = (const _Float16*)(F.ws + WS_ZG); const bf16* Zv = (const bf16*)(F.ws + WS_ZV);
    LAS unsigned char* L = F.lds;
    LAS float* eGr = (LAS float*)(L + HL_EGR); LAS float* eEnd = (LAS float*)(L + HL_EEND); LAS float* qsum = (LAS float*)(L + HL_QSUM); LAS float* ssq = (LAS float*)(L + HL_SSQ);
    f32x16 S[2];
#pragma unroll
    for (int i = 0; i < 2; ++i)
#pragma unroll
        for (int r = 0; r < 16; ++r) S[i][r] = 0.f;
    if (FULL && seg > 0) {
        const float* sl = (const float*)(F.ws + WS_SLOC) + (size_t)bh * 3 * HD * HD; const float* dl = (const float*)(F.ws + WS_DLOG) + (size_t)bh * 3 * HD;
        LAS float* tile = (LAS float*)L; LAS float* fac = (LAS float*)(L + 65536);
        float dsum = 0.f;
        for (int s_ = seg - 1; s_ >= 0; --s_) {
            __syncthreads();
            const f32x4* src = (const f32x4*)(sl + (size_t)s_ * HD * HD);
#pragma unroll
            for (int i = 0; i < 8; ++i) ((LAS f32x4*)tile)[F.tid + i * 512] = src[F.tid + i * 512];
            if (F.tid < 128) { fac[F.tid] = __expf(dsum); dsum += dl[s_ * HD + F.tid]; }
            __syncthreads();
            const LAS float* tl = tile + (4 * hh) * HD + 32 * vt + qi; const LAS float* fl = fac + 4 * hh;
#pragma unroll
            for (int i = 0; i < 2; ++i)
#pragma unroll
                for (int r = 0; r < 16; ++r) { const int dkc = 32 * (ktb + i) + (r & 3) + 8 * (r >> 2); S[i][r] += fl[dkc] * tl[dkc * HD]; }
        }
    }
    float gtot = 0.f;
    u32x4 rq[2], rk[2], rg[2], rv[2];
#define HG_PREFETCH(cc) do { const size_t tk_ = (size_t)b * T + (size_t)(seg * 16 + (cc)) * 64; _Pragma("unroll") for (int i_ = 0; i_ < 2; ++i_) { const int row_ = 16 * (w >> 1) + (lane >> 3) + 8 * i_, ch_ = 8 * (w & 1) + (lane & 7); const size_t go_ = (tk_ + row_) * D + h * HD + ch_ * 8; \
        rk[i_] = *(const u32x4*)(Zk + go_); rg[i_] = *(const u32x4*)((const bf16*)Zg + go_); rv[i_] = *(const u32x4*)(Zv + go_); if (FULL) rq[i_] = *(const u32x4*)(Zq + go_); } } while (0)
    HG_PREFETCH(0);
    __syncthreads();
    for (int c = 0; c < 16; ++c) {
        const size_t tok0 = (size_t)b * T + (size_t)(seg * 16 + c) * 64;
#pragma unroll
        for (int i = 0; i < 2; ++i) { const int so = (16 * (w >> 1) + (lane >> 3) + 8 * i) * 272 + (8 * (w & 1) + (lane & 7)) * 16;
            *(LAS u32x4*)(L + HL_STK + so) = rk[i]; *(LAS u32x4*)(L + HL_STG + so) = rg[i]; *(LAS u32x4*)(L + HL_STV + so) = rv[i]; if (FULL) *(LAS u32x4*)(L + HL_STQ + so) = rq[i]; }
        LDS_WAIT();
        float gl[16];
        { float run = 0.f;
#pragma unroll
            for (int i = 0; i < 16; ++i) { run += (float)*(const LAS _Float16*)(L + HL_STG + (16 * tq + i) * 272 + kk * 2); gl[i] = run; }
            qsum[tq * 128 + kk] = run; }
        HG_BAR();
        {
            const float q0 = qsum[kk], q1 = qsum[128 + kk], q2 = qsum[256 + kk], q3 = qsum[384 + kk];
            const float pre = (tq > 0 ? q0 : 0.f) + (tq > 1 ? q1 : 0.f) + (tq > 2 ? q2 : 0.f), Gr = q0 + q1, Gend = (q0 + q1) + (q2 + q3);
            unsigned bt[8], vtw[8];
#pragma unroll
            for (int i = 0; i < 16; i += 2) {
                const int t0 = 16 * tq + i;
                const float G0 = pre + gl[i], G1 = pre + gl[i + 1];
                const float eb0 = __expf(Gr - G0), eb1 = __expf(Gr - G1);
                const float b0 = bf2f(*(const LAS bf16*)(L + HL_STK + t0 * 272 + kk * 2)) * eb0, b1 = bf2f(*(const LAS bf16*)(L + HL_STK + (t0 + 1) * 272 + kk * 2)) * eb1;
                bt[i >> 1] = pk2(b0, b1);
                vtw[i >> 1] = (unsigned)*(const LAS bf16*)(L + HL_STV + t0 * 272 + kk * 2) | ((unsigned)*(const LAS bf16*)(L + HL_STV + (t0 + 1) * 272 + kk * 2) << 16);
                if (FULL) { const float ea0 = __expf(G0 - Gr), ea1 = __expf(G1 - Gr);
                    const float qa = bf2f(*(const LAS bf16*)(L + HL_STQ + t0 * 272 + kk * 2)), qb = bf2f(*(const LAS bf16*)(L + HL_STQ + (t0 + 1) * 272 + kk * 2));
                    *(LAS bf16*)(L + HL_A + t0 * 272 + kk * 2) = (bf16)f2bf(qa * ea0); *(LAS bf16*)(L + HL_A + (t0 + 1) * 272 + kk * 2) = (bf16)f2bf(qb * ea1);
                    *(LAS bf16*)(L + HL_BM + t0 * 272 + kk * 2) = (bf16)(bt[i >> 1] & 0xffffu); *(LAS bf16*)(L + HL_BM + (t0 + 1) * 272 + kk * 2) = (bf16)(bt[i >> 1] >> 16); }
                __builtin_amdgcn_sched_barrier(0);
            }
            *(LAS u32x4*)(L + HL_BMT + kk * 144 + tq * 32) = (u32x4){bt[0], bt[1], bt[2], bt[3]}; *(LAS u32x4*)(L + HL_BMT + kk * 144 + tq * 32 + 16) = (u32x4){bt[4], bt[5], bt[6], bt[7]};
            *(LAS u32x4*)(L + HL_VT + kk * 144 + tq * 32) = (u32x4){vtw[0], vtw[1], vtw[2], vtw[3]}; *(LAS u32x4*)(L + HL_VT + kk * 144 + tq * 32 + 16) = (u32x4){vtw[4], vtw[5], vtw[6], vtw[7]};
            if (tq == 0) { eGr[kk] = __expf(Gr); eEnd[kk] = __expf(Gend - Gr); }
            gtot += Gend;
        }
        HG_BAR();
        if (c + 1 < 16) HG_PREFETCH(c + 1);
#pragma unroll
        for (int i = 0; i < 2; ++i)
#pragma unroll
            for (int g4 = 0; g4 < 4; ++g4) { const int dk0 = 32 * (ktb + i) + 8 * g4 + 4 * hh; const f32x4 e = *(const LAS f32x4*)(eGr + dk0);
#pragma unroll
                for (int j = 0; j < 4; ++j) S[i][4 * g4 + j] *= e[j];
                if (FULL) { u32x2 wv; wv.x = pg8::cvt_pk_bf16_n(S[i][4 * g4], S[i][4 * g4 + 1]); wv.y = pg8::cvt_pk_bf16_n(S[i][4 * g4 + 2], S[i][4 * g4 + 3]);
                    *(LAS u32x2*)(L + HL_SPT + (32 * vt + qi) * 272 + dk0 * 2) = wv; } }
        if (FULL && w < 3) {
            const int st = (w == 2) ? 1 : 0, tt = (w == 0) ? 0 : 1;
            f32x16 sc;
#pragma unroll
            for (int r = 0; r < 16; ++r) sc[r] = 0.f;
#pragma unroll
            for (int ks = 0; ks < 8; ++ks) { const bf16x8 af = *(const LAS bf16x8*)(L + HL_BM + (32 * st + qi) * 272 + (16 * ks + 8 * hh) * 2); const bf16x8 bfr = *(const LAS bf16x8*)(L + HL_A + (32 * tt + qi) * 272 + (16 * ks + 8 * hh) * 2);
                sc = __builtin_amdgcn_mfma_f32_32x32x16_bf16(af, bfr, sc, 0, 0, 0); }
#pragma unroll
            for (int g4 = 0; g4 < 4; ++g4) { const int s0 = 32 * st + 8 * g4 + 4 * hh, t = 32 * tt + qi; float p[4];
#pragma unroll
                for (int j = 0; j < 4; ++j) p[j] = sc[4 * g4 + j] * __builtin_amdgcn_fmed3f((float)(t - (s0 + j) + 1), 0.f, 1.f);
                u32x2 wv; wv.x = pg8::cvt_pk_bf16_n(p[0], p[1]); wv.y = pg8::cvt_pk_bf16_n(p[2], p[3]);
                *(LAS u32x2*)(L + HL_P + t * 144 + s0 * 2) = wv; }
        }
#pragma unroll
        for (int ks2 = 0; ks2 < 4; ++ks2) { const bf16x8 vf = *(const LAS bf16x8*)(L + HL_VT + (32 * vt + qi) * 144 + (16 * ks2 + 8 * hh) * 2);
#pragma unroll
            for (int i = 0; i < 2; ++i) { const bf16x8 bf_ = *(const LAS bf16x8*)(L + HL_BMT + (32 * (ktb + i) + qi) * 144 + (16 * ks2 + 8 * hh) * 2);
                S[i] = __builtin_amdgcn_mfma_f32_32x32x16_bf16(bf_, vf, S[i], 0, 0, 0); } }
#pragma unroll
        for (int i = 0; i < 2; ++i)
#pragma unroll
            for (int g4 = 0; g4 < 4; ++g4) { const int dk0 = 32 * (ktb + i) + 8 * g4 + 4 * hh; const f32x4 e = *(const LAS f32x4*)(eEnd + dk0);
#pragma unroll
                for (int j = 0; j < 4; ++j) S[i][4 * g4 + j] *= e[j]; }
        if (FULL) {
            HG_BAR();
            const int tt = w & 1, dt = w >> 1, t = 32 * tt + qi;
            f32x16 o;
#pragma unroll
            for (int r = 0; r < 16; ++r) o[r] = 0.f;
#pragma unroll
            for (int ks = 0; ks < 8; ++ks) { const bf16x8 af = *(const LAS bf16x8*)(L + HL_SPT + (32 * dt + qi) * 272 + (16 * ks + 8 * hh) * 2); const bf16x8 bfr = *(const LAS bf16x8*)(L + HL_A + t * 272 + (16 * ks + 8 * hh) * 2);
                o = __builtin_amdgcn_mfma_f32_32x32x16_bf16(af, bfr, o, 0, 0, 0); }
#pragma unroll
            for (int ks2 = 0; ks2 < 4; ++ks2) if (ks2 < 2 * (tt + 1)) { const bf16x8 af = *(const LAS bf16x8*)(L + HL_VT + (32 * dt + qi) * 144 + (16 * ks2 + 8 * hh) * 2); const bf16x8 bfr = *(const LAS bf16x8*)(L + HL_P + t * 144 + (16 * ks2 + 8 * hh) * 2);
                o = __builtin_amdgcn_mfma_f32_32x32x16_bf16(af, bfr, o, 0, 0, 0); }
            float sq = 0.f;
#pragma unroll
            for (int r = 0; r < 16; ++r) sq += o[r] * o[r];
            sq += __shfl_xor(sq, 32);
            if (hh == 0) ssq[dt * 64 + t] = sq;
            HG_BAR();
            const float tot = (ssq[t] + ssq[64 + t]) + (ssq[128 + t] + ssq[192 + t]);
            const float rstd = __builtin_amdgcn_rsqf(tot * (1.f / HD) + RMS_EPS);
            const size_t ro = (tok0 + t) * D + h * HD;
#pragma unroll
            for (int g4 = 0; g4 < 4; ++g4) { const int dv0 = 32 * dt + 8 * g4 + 4 * hh;
                const u32x2 gt = *(const u32x2*)((const bf16*)(F.ws + WS_ZGATE) + ro + dv0); const f32x4 gn = *(const f32x4*)(a.in[I_A_OGAIN] + dv0);
                u32x2 wv; wv.x = pg8::cvt_pk_bf16_n(o[4 * g4] * rstd * gn.x * bflo(gt.x), o[4 * g4 + 1] * rstd * gn.y * bfhi(gt.x)); wv.y = pg8::cvt_pk_bf16_n(o[4 * g4 + 2] * rstd * gn.z * bflo(gt.y), o[4 * g4 + 3] * rstd * gn.w * bfhi(gt.y));
                *(u32x2*)((bf16*)(F.ws + WS_OH) + ro + dv0) = wv; }
        }
    }
#undef HG_PREFETCH
    if (!FULL) {
        float* sl = (float*)(F.ws + WS_SLOC) + ((size_t)bh * 3 + seg) * HD * HD;
#pragma unroll
        for (int i = 0; i < 2; ++i)
#pragma unroll
            for (int r = 0; r < 16; ++r) { const int dk = 32 * (ktb + i) + (r & 3) + 8 * (r >> 2) + 4 * hh; sl[(size_t)dk * HD + 32 * vt + qi] = S[i][r]; }
        if (tq == 0) ((float*)(F.ws + WS_DLOG))[((size_t)bh * 3 + seg) * HD + kk] = gtot;
    }
    __syncthreads();
}

constexpr int N_PHASES = 19;
#ifndef REP_MASK
#define REP_MASK 0
#endif
#define NREP(k) ((((REP_MASK) >> (k)) & 1) ? 2 : 1)
__global__ void __launch_bounds__(NTHR, 2) fwd(Args args_kernarg) {
    extern __shared__ __attribute__((aligned(16))) unsigned char lds_raw[];
    Frame F;
    CArgs* pa = (CArgs*)__builtin_amdgcn_kernarg_segment_ptr();
#define args (*pa)
    F.lds = (LAS unsigned char*)lds_raw; F.ws = args.ws; F.ctl = (unsigned*)(args.ws + WS_CTL);
    F.wave = __builtin_amdgcn_readfirstlane((int)threadIdx.x >> 6); F.tid = make_tid(F.wave); F.lane = F.tid & 63;
    F.G = gridDim.x; { const int bx = blockIdx.x; F.vcu = (F.G % 8 == 0) ? (bx % 8) * (F.G / 8) + bx / 8 : bx; }
    F.gw = F.vcu * NWAVES + F.wave; F.NGW = F.G * NWAVES;
    for (int u = F.tid; u < (LDS_BYTES - LDSCTL_OFF) / 4; u += NTHR) ((LAS unsigned*)(F.lds + LDSCTL_OFF))[u] = 0u;
    __syncthreads();
    const int lo = args.ph_lo, hi = args.ph_hi;
    const bool multi = (hi - lo) > 1;
    XcdBarrier bar; bar.bar = F.ctl + CW_BAR; bar.x = 0; bar.st = nullptr;
    if (multi) bar = xcd_barrier_post(F.ctl + CW_BAR, (volatile LAS unsigned*)(F.lds + LDSCTL_OFF), F.tid);
#define REFRESH() do { pa = (CArgs*)__builtin_amdgcn_kernarg_segment_ptr(); asm volatile("" : "+s"(pa)); ws = args.ws; F.ws = ws; F.ctl = (unsigned*)(ws + WS_CTL); const int t_ = make_tid(F.wave); F.tid = t_; F.lane = t_ & 63; F.gw = F.vcu * NWAVES + F.wave; } while (0)
#define IN(k) (lo <= (k) && (k) < hi)
#define SEAM(k) do { if (IN(k) && IN((k) + 1)) xcd_barrier(bar, make_tid(F.wave)); } while (0)
    unsigned char* ws = args.ws;
    (void)args_kernarg;
    const int GT = F.NGW * 64;

    if (IN(0)) _Pragma("unroll") for (int rep_ = 0; rep_ < NREP(0); ++rep_) { REFRESH();
        const int gtid = F.gw * 64 + F.lane;
        LAS float* scr = (LAS float*)(F.lds + F.wave * TR_SCR_BYTES);
        constexpr int J0 = 16 * 256;
        tr_run([&](int it) { TrItem t; t.src = args.in[I_A_W_IN]; t.ksc = args.in[I_NORM_MIX]; t.dst = ws + WS_WIN; t.N = 4 * D; t.K = D; t.k0 = 128 * (it / 256); t.n0 = 32 * (it % 256); t.drow0 = t.n0; t.flags = 0; t.osc = 1.f; return t; },
               F.gw, J0, F.NGW, scr, F.lane);
        for (int c = gtid; c < D; c += GT) { const float* L = args.in[I_A_LB]; const float l0 = L[c], l1 = L[D + c], l2 = L[2 * D + c]; const float mx = fmaxf(l0, fmaxf(l1, l2));
            const float e0 = expf(l0 - mx), e1 = expf(l1 - mx), e2 = expf(l2 - mx); ((float*)(ws + WS_LB))[c] = e0 / (e0 + e1 + e2); }
        for (int i = gtid; i < 2 * 36 * D; i += GT) { const int l = i / (36 * D), r = (i / D) % 36, k = i % D;
            ((float*)(ws + WS_RT))[i] = r < 4 ? args.in[I_W_GROUP][((size_t)l * D + k) * NG + r] : args.in[I_W_EXPERT][((size_t)l * D + k) * NE + (r - 4)]; }
        { const int fi = gtid & 63; const float inv = exp2f(-(float)fi * (13.287712379549449f / 64.0f));
          for (int i = gtid; i < T * 64; i += GT) { const float ang = (float)(i >> 6) * inv; float sn_, cs_; sincosf(ang, &sn_, &cs_); ((f32x2*)(ws + WS_ROPE))[i] = (f32x2){cs_, sn_}; } }
        for (int m = F.gw; m < M; m += F.NGW) rms_row_to_bf16(args.in[I_X] + (size_t)m * D, (bf16*)(ws + WS_XN) + (size_t)m * D, F.lane);
    }
    SEAM(0);
    if (IN(1)) _Pragma("unroll") for (int rep_ = 0; rep_ < NREP(1); ++rep_) { REFRESH();
        constexpr int NCV = 112, J1 = 16 * 64, J2 = 16 * 128, J3 = 16 * 64, J4 = 16 * 64, J5 = MOE_CV_ITEMS;
        if ((int)blockIdx.x < NCV) {
            LAS float* scr = (LAS float*)(F.lds + F.wave * TR_SCR_BYTES);
            tr_run([&](int r) { TrItem t; t.osc = 1.f; t.ksc = nullptr; t.flags = 0; t.N = D; t.K = D;
                    if (r < J1) { t.src = args.in[I_A_W_OUT]; t.dst = ws + WS_WOA; t.k0 = 128 * (r / 64); t.n0 = 32 * (r % 64); t.drow0 = t.n0; return t; } r -= J1;
                    if (r < J2) { const int nb = r % 128; t.src = args.in[I_KV_W]; t.ksc = args.in[I_KV_NORM]; t.dst = ws + WS_WQKV; t.N = 2 * D; t.k0 = 128 * (r / 128); t.n0 = 32 * nb; t.drow0 = D + t.n0;
                                  t.flags = (FP8_QKV ? 2 : 0) | (nb < 64 ? 1 : 0); t.osc = FP8_QKV ? SC_W : 1.f; return t; } r -= J2;
                    if (r < J3) { t.src = args.in[I_B_W_Q]; t.ksc = args.in[I_NORM_MIX] + D; t.dst = ws + WS_WQKV; t.k0 = 128 * (r / 64); t.n0 = 32 * (r % 64); t.drow0 = t.n0; t.flags = (FP8_QKV ? 2 : 0) | 1; t.osc = FP8_QKV ? SC_W : 1.f; return t; } r -= J3;
                    if (r < J4) { t.src = args.in[I_B_W_OUT]; t.dst = ws + WS_WOB; t.k0 = 128 * (r / 64); t.n0 = 32 * (r % 64); t.drow0 = t.n0; t.flags = FP8_OUTB ? 2 : 0; t.osc = FP8_OUTB ? SC_W : 1.f; return t; } r -= J4;
                    return moe_cv_item(args, ws, 0, r); },
                   (int)blockIdx.x * NWAVES + F.wave, J1 + J2 + J3 + J4 + J5, NCV * NWAVES, scr, F.lane);
            __syncthreads();
        }
        pg8::DynOrder S; S.init(ws + WS_XN, ws + WS_WIN, M, 4 * D, D, F.wave, F.ctl + CW_DYN, (LAS int*)(F.lds + LDSCTL_OFF + 32));
        pg8::EpiHgrnIn E{ws + WS_R, (const float*)(ws + WS_LB)};
        pg8::gemm_phase<pg8::EpiHgrnIn, pg8::DynOrder, true>(F.lds, S, E);
    }
    SEAM(1);
    if (IN(2)) _Pragma("unroll") for (int rep_ = 0; rep_ < NREP(2); ++rep_) { REFRESH(); for (int it = F.vcu; it < 256; it += F.G) hgrn_item<false>(F, args, it); }
    SEAM(2);
    if (IN(3)) _Pragma("unroll") for (int rep_ = 0; rep_ < NREP(3); ++rep_) { REFRESH(); for (int it = F.vcu; it < 256; it += F.G) hgrn_item<true>(F, args, it); }
    SEAM(3);
    if (IN(4)) _Pragma("unroll") for (int rep_ = 0; rep_ < NREP(4); ++rep_) { REFRESH();
        pg8::DenseOrder S; S.init(ws + WS_OH, ws + WS_WOA, M, D, D, F.G, (int)blockIdx.x, F.wave);
        pg8::EpiRes16<true> E{(bf16*)(ws + WS_XR), args.in[I_X], 1.0f};
        pg8::gemm_phase<pg8::EpiRes16<true>, pg8::DenseOrder, true>(F.lds, S, E);
    }
    SEAM(4);
#define MOE_LAYER(P, layer, F8, O8) \
    if (IN(P)) { REFRESH(); REFRESH(); if (NREP(P) == 2) { for (int t = F.gw; t < M; t += F.NGW) route_token<true, F8>(F, args, layer, t); } for (int t = F.gw; t < M; t += F.NGW) route_token<false, F8>(F, args, layer, t); } \
    SEAM(P); \
    if (IN((P) + 1)) _Pragma("unroll") for (int rep_ = 0; rep_ < NREP((P) + 1); ++rep_) { REFRESH(); const int nrb = __builtin_amdgcn_readfirstlane(moe_tables(F, layer)); \
        pg8::MoeOrder<true> S; S.A = (const char*)(ws + WS_XN); S.B = (const char*)(ws + WS_WGU + (size_t)(layer) * WGU_LSTRIDE); S.estride = (size_t)1024 * D * (F8 ? 1 : 2); S.K = D; S.RB = F8 ? D : 2 * D; S.NT = 4; S.total = nrb * 4; S.G = F.G; S.c = F.vcu; S.wv = F.wave; \
        S.blk_e = (const LAS int*)(F.lds + LT_BLKE); S.blkstart = (const LAS int*)(F.lds + LT_BLKSTART); S.cnt = (const LAS int*)(F.lds + LT_CNT); S.list = (const int*)(ws + WS_LISTS); \
        pg8::EpiSwiGLU<F8> E{(bf16*)(ws + WS_ACT), F8 ? 1.0f / (SC_XN * SC_W) : 1.0f}; \
        pg8::gemm_phase<pg8::EpiSwiGLU<F8>, pg8::MoeOrder<true>, true, F8>(F.lds, S, E); } \
    SEAM((P) + 1); \
    if (IN((P) + 2)) _Pragma("unroll") for (int rep_ = 0; rep_ < NREP((P) + 2); ++rep_) { REFRESH(); const int nrb = __builtin_amdgcn_readfirstlane(moe_tables(F, layer)); \
        pg8::MoeOrder<false> S; S.A = (const char*)(ws + WS_ACT); S.B = (const char*)(ws + WS_WD + (size_t)(layer) * WD_LSTRIDE); S.estride = (size_t)D * FF * (F8 ? 1 : 2); S.K = FF; S.RB = F8 ? FF : 2 * FF; S.NT = 8; S.total = nrb * 8; S.G = F.G; S.c = F.vcu; S.wv = F.wave; \
        S.blk_e = (const LAS int*)(F.lds + LT_BLKE); S.blkstart = (const LAS int*)(F.lds + LT_BLKSTART); S.cnt = (const LAS int*)(F.lds + LT_CNT); S.list = (const int*)(ws + WS_LISTS); \
        if constexpr (O8) { pg8::EpiOut8 E{ws + WS_OUTB, D, (F8 ? 1.0f / (SC_ACT * SC_WD) : 1.0f) * SC_OUT}; pg8::gemm_phase<pg8::EpiOut8, pg8::MoeOrder<false>, true, F8>(F.lds, S, E); } \
        else { pg8::EpiBf16 E{(bf16*)(ws + WS_OUTB), D, 0, 0, F8 ? 1.0f / (SC_ACT * SC_WD) : 1.0f}; pg8::gemm_phase<pg8::EpiBf16, pg8::MoeOrder<false>, true, F8>(F.lds, S, E); } } \
    SEAM((P) + 2);
    MOE_LAYER(5, 0, FP8_MOE0, OUT8_L0)
    if (IN(8)) { REFRESH();
        (void)moe_tables(F, 0);
        combine_tokens<true>(F, args, F.gw, F.NGW);
    }
    SEAM(8);
    if (IN(9)) _Pragma("unroll") for (int rep_ = 0; rep_ < NREP(9); ++rep_) { REFRESH();
        constexpr int NCV2 = 112;
        if ((int)blockIdx.x < NCV2) {
            LAS float* scr = (LAS float*)(F.lds + F.wave * TR_SCR_BYTES);
            tr_run([&](int it) { return moe_cv_item(args, ws, 1, it); }, (int)blockIdx.x * NWAVES + F.wave, MOE_CV_ITEMS, NCV2 * NWAVES, scr, F.lane);
            __syncthreads();
        }
        pg8::DynOrder S; S.init(ws + WS_XN, ws + WS_WQKV, M, 3 * D, D, F.wave, F.ctl + CW_DYN + 64, (LAS int*)(F.lds + LDSCTL_OFF + 32), FP8_QKV);
        pg8::EpiQKV E{(bf16*)(ws + WS_Q), (bf16*)(ws + WS_K), (bf16*)(ws + WS_V), args.in[I_B_Q_NORM], args.in[I_K_NORM], (const f32x2*)(ws + WS_ROPE), (float*)(ws + WS_KMEAN), F.lds + 131072, FP8_QKV ? 1.0f / (SC_XN * SC_W) : 1.0f, F.wave};
        pg8::gemm_phase<pg8::EpiQKV, pg8::DynOrder, true, FP8_QKV>(F.lds, S, E);
    }
    SEAM(9);
    if (IN(11)) { REFRESH(); if (NREP(11) == 2) { for (int it = F.vcu; it < 64 * 8; it += F.G) moba_gate_item<true>(F, it); } for (int it = F.vcu; it < 64 * 8; it += F.G) moba_gate_item<false>(F, it); }
    SEAM(11);
    if (IN(12)) _Pragma("unroll") for (int rep_ = 0; rep_ < NREP(12); ++rep_) { REFRESH();
        for (int v = F.vcu; v < 256; v += F.G) { const int bh = v >> 2, q = v & 3;
            _Pragma("unroll 1") for (int gi = 0; gi < 4; ++gi) { const int n = (gi == 0) ? q : ((gi == 1) ? 7 - q : ((gi == 2) ? 8 + q : 15 - q)); attn_group(F, bh, n); } }
    }
    SEAM(12);
    if (IN(13)) _Pragma("unroll") for (int rep_ = 0; rep_ < NREP(13); ++rep_) { REFRESH(); for (int t = F.gw; t < M; t += F.NGW) attn_combine_token(F, t); }
    SEAM(13);
    if (IN(14)) { REFRESH();
        pg8::DenseOrder S; S.init(ws + WS_OA, ws + WS_WOB, M, D, D, F.G, (int)blockIdx.x, F.wave, FP8_OUTB);
        pg8::EpiRes16<false> E{(bf16*)(ws + WS_XR), nullptr, FP8_OUTB ? 1.0f / (SC_OA * SC_W) : 1.0f};
        pg8::gemm_phase<pg8::EpiRes16<false>, pg8::DenseOrder, true, FP8_OUTB>(F.lds, S, E);
    }
    SEAM(14);
    MOE_LAYER(15, 1, FP8_MOE1, OUT8_L1)
    if (IN(18)) { REFRESH(); (void)moe_tables(F, 1); combine_tokens<false>(F, args, F.gw, F.NGW); }
#undef IN
#undef SEAM
#undef MOE_LAYER
#undef args
}

#ifndef MK_N_LAUNCHES
#define MK_N_LAUNCHES 1
#endif
#ifndef DBG_STOP
#define DBG_STOP N_PHASES
#endif
extern "C" void kernel_launch(void* const* d_in, const int* in_sizes, int n_in, void* d_out, int out_size, void* d_ws, size_t ws_size, hipStream_t stream) {
    static int grid = 0;
    if (grid == 0) {
        if (n_in != 20 || in_sizes[0] != M * D || out_size != M * D || ws_size < WS_END) { fprintf(stderr, "kernel_launch: unexpected shapes (n_in %d, in0 %d, out %d, ws %zu < %zu); nothing launched\n", n_in, n_in > 0 ? in_sizes[0] : -1, out_size, ws_size, (size_t)WS_END); grid = -1; return; }
        int dev = 0, cus = 0, per_cu = 0;
        if (hipGetDevice(&dev) != hipSuccess || hipDeviceGetAttribute(&cus, hipDeviceAttributeMultiprocessorCount, dev) != hipSuccess) { grid = -1; return; }
        if (hipFuncSetAttribute((const void*)fwd, hipFuncAttributeMaxDynamicSharedMemorySize, LDS_BYTES) != hipSuccess) { fprintf(stderr, "kernel_launch: hipFuncSetAttribute failed\n"); grid = -1; return; }
        if (hipOccupancyMaxActiveBlocksPerMultiprocessor(&per_cu, (const void*)fwd, NTHR, LDS_BYTES) != hipSuccess || per_cu < 1) { fprintf(stderr, "kernel_launch: occupancy query says %d blocks per CU\n", per_cu); }
        (void)hipGetLastError();
        grid = cus;
    }
    if (grid < 0) return;
    (void)hipMemsetAsync((char*)d_ws + WS_CTL, 0, CTL_ZERO_BYTES, stream);
    Args a{};
    for (int i = 0; i < 20; ++i) a.in[i] = (const float*)d_in[i];
    a.out = (float*)d_out; a.ws = (unsigned char*)d_ws;
    if (MK_N_LAUNCHES == 1) { a.ph_lo = 0; a.ph_hi = N_PHASES; hipLaunchKernelGGL(fwd, dim3(grid), dim3(NTHR), LDS_BYTES, stream, a); }
    else for (int p = 0; p < DBG_STOP; ++p) { a.ph_lo = p; a.ph_hi = p + 1; hipLaunchKernelGGL(fwd, dim3(grid), dim3(NTHR), LDS_BYTES, stream, a); }
}
```

```cpp
#include <hip/hip_runtime.h>
#include <cstdio>
#include <cstdint>

#define GAS __attribute__((address_space(1)))
#define LAS __attribute__((address_space(3)))
typedef unsigned short bf16;
typedef short bf16x8 __attribute__((ext_vector_type(8)));
typedef float f32x4 __attribute__((ext_vector_type(4)));
typedef float f32x2 __attribute__((ext_vector_type(2)));
typedef unsigned u32x4 __attribute__((ext_vector_type(4)));
typedef unsigned u32x2 __attribute__((ext_vector_type(2)));

constexpr int BATCH = 4, T = 4096, D = 2048, M = BATCH * T, H = 16, HD = 128;
constexpr int NBLK = 16, MBLK = 256;
constexpr int NG = 4, EPG = 8, NE = 32, FF = 512;
constexpr float RMS_EPS = 1e-6f;
constexpr int NWAVES = 8, NTHR = 512;
constexpr int LIST_CAP = 16384;
constexpr int MAXRB = 160;

constexpr size_t MiB = 1u << 20;
constexpr size_t WS_CTL = 0, CTL_ZERO_BYTES = 1 * MiB;
constexpr size_t WS_LISTS = 1 * MiB;
constexpr size_t WS_TOKREC = 3 * MiB;
constexpr size_t WS_LB = 4 * MiB;
constexpr size_t WS_RT = 4 * MiB + 65536;
constexpr size_t WS_ROPE = 5 * MiB;
constexpr size_t WS_KMEAN = 7 * MiB;
constexpr size_t WS_WIN = 8 * MiB, WS_WOA = 40 * MiB, WS_WQKV = 48 * MiB, WS_WOB = 72 * MiB;
constexpr size_t WS_WGU = 80 * MiB, WS_WD = 208 * MiB;
constexpr size_t WS_XN = 272 * MiB;
constexpr size_t WS_ACT = 336 * MiB;
constexpr size_t WS_R = 376 * MiB;
constexpr size_t WS_ZQ = WS_R, WS_ZK = WS_R + 64 * MiB, WS_ZG = WS_R + 128 * MiB, WS_ZV = WS_R + 192 * MiB, WS_ZGATE = WS_R + 256 * MiB;
constexpr size_t WS_ORAW = WS_R + 320 * MiB;
constexpr size_t WS_OH = WS_R + 448 * MiB;
constexpr size_t WS_OUTB = WS_R;
constexpr size_t WS_Q = WS_R, WS_K = WS_R + 64 * MiB, WS_V = WS_R + 128 * MiB, WS_VT = WS_R + 192 * MiB, WS_OA = WS_R + 256 * MiB;
constexpr size_t WS_XR = WS_R + 192 * MiB;
constexpr size_t WS_OPART = WS_R + 320 * MiB;
constexpr size_t WS_LPART = WS_R + 576 * MiB;
constexpr size_t WS_ALIST = WS_R + 584 * MiB;
constexpr int ALIST_CAP = 3840;
constexpr size_t WS_END = WS_R + 604 * MiB;
constexpr int CW_TMO = 0;
constexpr int CW_BAR = 4096;
constexpr int CW_CNT = 8192;
#define CW_CNT_AT(l, e) (CW_CNT + 2048 * (l) + 64 * (e))
constexpr int CW_ACNT = 16384;
constexpr int CW_DYN = 20480;

constexpr int RING_BYTES = 159744;
constexpr int LDSCTL_OFF = RING_BYTES;
constexpr int LT_BLKE = LDSCTL_OFF + 64;
constexpr int LT_BLKSTART = LT_BLKE + MAXRB * 4;
constexpr int LT_CNT = LT_BLKSTART + 36 * 4;
constexpr int LT_END = LT_CNT + 32 * 4;
constexpr int LDS_BYTES = 163840;
static_assert(LT_END <= LDS_BYTES, "LDS map");

__device__ __forceinline__ unsigned f2bf(float f) { unsigned u = __builtin_bit_cast(unsigned, f); return (u + 0x7fffu + ((u >> 16) & 1u)) >> 16; }
__device__ __forceinline__ unsigned pk2(float lo, float hi) { return f2bf(lo) | (f2bf(hi) << 16); }
__device__ __forceinline__ float bf2f(unsigned b) { return __builtin_bit_cast(float, b << 16); }
__device__ __forceinline__ float bflo(unsigned w) { return __builtin_bit_cast(float, w << 16); }
__device__ __forceinline__ float bfhi(unsigned w) { return __builtin_bit_cast(float, w & 0xffff0000u); }
__device__ __forceinline__ float wave_sum(float v) {
#pragma unroll
    for (int o = 1; o < 64; o <<= 1) v += __shfl_xor(v, o);
    return v;
}
#ifndef FP8_QKV
#define FP8_QKV 1
#endif
#ifndef FP8_OUTB
#define FP8_OUTB 1
#endif
#ifndef FP8_MOE1
#define FP8_MOE1 1
#endif
#ifndef FP8_MOE0
#define FP8_MOE0 1
#endif
#ifndef OUT8_L0
#define OUT8_L0 1
#endif
#ifndef OUT8_L1
#define OUT8_L1 1
#endif
constexpr float SC_XN = 16.f, SC_W = 1024.f, SC_ACT = 8.f, SC_WD = 512.f, SC_OA = 64.f, SC_PART = 64.f, SC_OUT = 32.f, SC_QKV = 32.f;
__device__ __forceinline__ unsigned pk4_fp8(float a, float b, float c, float d) {
    a = __builtin_amdgcn_fmed3f(a, -448.f, 448.f); b = __builtin_amdgcn_fmed3f(b, -448.f, 448.f); c = __builtin_amdgcn_fmed3f(c, -448.f, 448.f); d = __builtin_amdgcn_fmed3f(d, -448.f, 448.f);
    int p = __builtin_amdgcn_cvt_pk_fp8_f32(a, b, 0, false); p = __builtin_amdgcn_cvt_pk_fp8_f32(c, d, p, true); return (unsigned)p; }
__device__ __forceinline__ int lane_id() { int l; asm volatile("v_mbcnt_lo_u32_b32 %0, -1, 0\n\tv_mbcnt_hi_u32_b32 %0, -1, %0" : "=v"(l)); return l; }
__device__ __forceinline__ int make_tid(int wv) { return wv * 64 + lane_id(); }
__device__ __forceinline__ void fp8x4_to_f32(unsigned w, float (&o)[4]) { const f32x2 lo = __builtin_amdgcn_cvt_pk_f32_fp8((int)w, false), hi = __builtin_amdgcn_cvt_pk_f32_fp8((int)w, true); o[0] = lo.x; o[1] = lo.y; o[2] = hi.x; o[3] = hi.y; }
#define LDS_WAIT() asm volatile("s_waitcnt lgkmcnt(0)" ::: "memory")
#define VM_WAIT() asm volatile("s_waitcnt vmcnt(0)" ::: "memory")

namespace pg8 {
constexpr int BM = 256, BK = 64, HALF = 128, HTB = HALF * BK * 2, STAGE_BYTES = 8 * HTB, NXCD = 8, WGM = 8;
__host__ __device__ __forceinline__ int lds_byte(int r, int c) { const int st = (r >> 4) * 2 + (c >> 5), rr = r & 15, cc = c & 31, ob = rr * 64 + cc * 2; return st * 1024 + (ob ^ (((ob >> 9) & 1) << 5)); }
__host__ __device__ __forceinline__ void stage_rc(int b, int& R, int& C) { const int st = b / 1024, sb = b % 1024, swz = sb ^ (((sb >> 9) & 1) << 5); R = (st >> 1) * 16 + swz / 64; C = (st & 1) * 32 + (swz % 64) / 2; }
__host__ __device__ __forceinline__ int perm32(int rho) { const int n = rho >> 4, i = rho & 15; return 8 * (i >> 2) + 4 * n + (i & 3); }

struct Unit { int pm, pn; const char* a; const char* b; int e0, lbase, cnt; };

struct DenseOrder {
    static constexpr bool GATHER = false, DYNAMIC = false;
    const char* A; const char* B; int K, RB; int nM, nN, nwg, G, c, wv;
    __device__ void init(const void* A_, const void* B_, int M_, int N_, int K_, int G_, int c_, int wv_, bool fp8 = false) { wv = wv_; A = (const char*)A_; B = (const char*)B_; K = K_; RB = fp8 ? K_ : 2 * K_; nM = M_ / BM; nN = N_ / BM; nwg = nM * nN; G = G_; c = c_; }
    __device__ __forceinline__ bool next(int i, Unit& u) const {
        const int L = i * G + c; if (L >= nwg) return false;
        int wgid = (int)L; { const int q = nwg / NXCD, r = nwg % NXCD, xcd = wgid % NXCD, off = wgid / NXCD; wgid = (xcd < r ? xcd * (q + 1) : r * (q + 1) + (xcd - r) * q) + off; }
        const int nig = WGM * nN, gid = wgid / nig, fm = gid * WGM, gsz = (nM - fm) < WGM ? (nM - fm) : WGM;
        u.pm = fm + ((wgid % nig) % gsz); u.pn = (wgid % nig) / gsz;
        u.a = A + (size_t)u.pm * BM * RB; u.b = B + (size_t)u.pn * BM * RB; u.e0 = 0; u.lbase = 0; u.cnt = 0; return true;
    }
    __device__ __forceinline__ unsigned row_off(const Unit&, int) const { return 0u; }
};
struct DynOrder {
    static constexpr bool GATHER = false, DYNAMIC = true;
    const char* A; const char* B; int K, RB; int nM, nN, nwg, wv; unsigned* counter; LAS int* slot;
    __device__ void init(const void* A_, const void* B_, int M_, int N_, int K_, int wv_, unsigned* counter_, LAS int* slot_, bool fp8 = false) { wv = wv_; A = (const char*)A_; B = (const char*)B_; K = K_; RB = fp8 ? K_ : 2 * K_; nM = M_ / BM; nN = N_ / BM; nwg = nM * nN; counter = counter_; slot = slot_; }
    __device__ __forceinline__ void map(int L, Unit& u) const {
        int wgid = L; { const int q = nwg / NXCD, r = nwg % NXCD, xcd = wgid % NXCD, off = wgid / NXCD; wgid = (xcd < r ? xcd * (q + 1) : r * (q + 1) + (xcd - r) * q) + off; }
        const int nig = WGM * nN, gid = wgid / nig, fm = gid * WGM, gsz = (nM - fm) < WGM ? (nM - fm) : WGM;
        u.pm = fm + ((wgid % nig) % gsz); u.pn = (wgid % nig) / gsz;
        u.a = A + (size_t)u.pm * BM * RB; u.b = B + (size_t)u.pn * BM * RB; u.e0 = 0; u.lbase = 0; u.cnt = 0;
    }
    __device__ __forceinline__ int fetch() const { return (int)__hip_atomic_fetch_add(counter, 1u, __ATOMIC_RELAXED, __HIP_MEMORY_SCOPE_AGENT); }
    __device__ __forceinline__ bool next(int, Unit&) const { return false; }
    __device__ __forceinline__ unsigned row_off(const Unit&, int) const { return 0u; }
};
template <bool GATHER_> struct MoeOrder {
    static constexpr bool GATHER = GATHER_, DYNAMIC = false;
    const char* A; const char* B; size_t estride; int K, RB, NT, total, G, c, wv;
    const LAS int* blk_e; const LAS int* blkstart; const LAS int* cnt; const int* list;
    __device__ __forceinline__ bool next(int i, Unit& u) const {
        const int L = i * G + c; if (L >= total) return false;
        const int rb = (int)L / NT, pn = (int)L % NT, e = blk_e[rb];
        u.pm = rb; u.pn = pn; u.e0 = e; u.lbase = (rb - blkstart[e]) * BM; u.cnt = cnt[e];
        u.a = GATHER ? A : A + (size_t)rb * BM * RB; u.b = B + (size_t)e * estride + (size_t)pn * BM * RB; return true;
    }
    __device__ __forceinline__ unsigned row_off(const Unit& u, int r) const { const int loc = u.lbase + r; const int t = list[u.e0 * LIST_CAP + (loc < u.cnt ? loc : 0)]; return (unsigned)t * (unsigned)RB; }
};

typedef __bf16 bf16n2 __attribute__((ext_vector_type(2)));
__device__ __forceinline__ unsigned cvt_pk_bf16_n(float lo, float hi) { const f32x2 v = {lo, hi}; return __builtin_bit_cast(unsigned, __builtin_convertvector(v, bf16n2)); }
__device__ __forceinline__ unsigned cvt_pk_bf16(float lo, float hi) { unsigned r; asm volatile("v_cvt_pk_bf16_f32 %0, %1, %2" : "=v"(r) : "v"(lo), "v"(hi)); return r; }

struct EpiBf16 {
    static constexpr bool PERM = true;
    bf16* O; int ldc; int split_cols; size_t split_stride; float osc;
    __device__ __forceinline__ void operator()(const f32x4 (&acc)[2][2][4][2], const Unit& u, int wr, int wc, int fr, int fq) const {
        const int row0 = u.pm * BM + wr * 64 + fr; int colt = u.pn * BM; bf16* base = O;
        if (split_cols) { const int t = colt / split_cols; base += (size_t)t * split_stride; colt -= t * split_cols; }
        const int col0 = colt + wc * 32 + 8 * fq;
#pragma unroll
        for (int ai = 0; ai < 2; ++ai)
#pragma unroll
            for (int m = 0; m < 4; ++m) { bf16* rowp = base + (size_t)(row0 + ai * HALF + m * 16) * ldc + col0;
#pragma unroll
                for (int bj = 0; bj < 2; ++bj) { const f32x4 v0 = acc[ai][bj][m][0] * osc, v1 = acc[ai][bj][m][1] * osc;
                    u32x4 w; w.x = cvt_pk_bf16(v0[0], v0[1]); w.y = cvt_pk_bf16(v0[2], v0[3]); w.z = cvt_pk_bf16(v1[0], v1[1]); w.w = cvt_pk_bf16(v1[2], v1[3]);
                    *(u32x4*)(rowp + bj * HALF) = w; } }
    }
};
struct EpiResF32 {
    static constexpr bool PERM = false;
    float* C; const float* R; int ldc; float osc;
    __device__ __forceinline__ void operator()(const f32x4 (&acc)[2][2][4][2], const Unit& u, int wr, int wc, int fr, int fq) const {
        const int row0 = u.pm * BM + wr * 64 + fr, col0 = u.pn * BM + wc * 32 + 4 * fq;
#pragma unroll
        for (int ai = 0; ai < 2; ++ai)
#pragma unroll
            for (int m = 0; m < 4; ++m) { const size_t ro = (size_t)(row0 + ai * HALF + m * 16) * ldc + col0;
#pragma unroll
                for (int bj = 0; bj < 2; ++bj)
#pragma unroll
                    for (int n = 0; n < 2; ++n) { const f32x4 r = *(const f32x4*)(R + ro + bj * HALF + n * 16); *(f32x4*)(C + ro + bj * HALF + n * 16) = acc[ai][bj][m][n] * osc + r; } }
    }
};
struct EpiOut8 {
    static constexpr bool PERM = true;
    unsigned char* O; int ldc; float osc;
    __device__ __forceinline__ void operator()(const f32x4 (&acc)[2][2][4][2], const Unit& u, int wr, int wc, int fr, int fq) const {
        const int row0 = u.pm * BM + wr * 64 + fr, col0 = u.pn * BM + wc * 32 + 8 * fq;
#pragma unroll
        for (int ai = 0; ai < 2; ++ai)
#pragma unroll
            for (int m = 0; m < 4; ++m) { unsigned char* rowp = O + (size_t)(row0 + ai * HALF + m * 16) * ldc + col0;
#pragma unroll
                for (int bj = 0; bj < 2; ++bj) { const f32x4 v0 = acc[ai][bj][m][0] * osc, v1 = acc[ai][bj][m][1] * osc;
                    u32x2 w; w.x = pk4_fp8(v0[0], v0[1], v0[2], v0[3]); w.y = pk4_fp8(v1[0], v1[1], v1[2], v1[3]);
                    *(u32x2*)(rowp + bj * HALF) = w; } }
    }
};
template <bool SRC32> struct EpiRes16 {
    static constexpr bool PERM = true;
    bf16* XR; const float* R32; float osc;
    __device__ __forceinline__ void operator()(const f32x4 (&acc)[2][2][4][2], const Unit& u, int wr, int wc, int fr, int fq) const {
        const int row0 = u.pm * BM + wr * 64 + fr, col0 = u.pn * BM + wc * 32 + 8 * fq;
#pragma unroll
        for (int ai = 0; ai < 2; ++ai)
#pragma unroll
            for (int m = 0; m < 4; ++m) { const size_t ro = (size_t)(row0 + ai * HALF + m * 16) * D + col0;
#pragma unroll
                for (int bj = 0; bj < 2; ++bj) { float r[8];
                    if (SRC32) { const f32x4 a = *(const f32x4*)(R32 + ro + bj * HALF), b = *(const f32x4*)(R32 + ro + bj * HALF + 4);
#pragma unroll
                        for (int j = 0; j < 4; ++j) { r[j] = a[j]; r[4 + j] = b[j]; } }
                    else { const u32x4 w = *(const u32x4*)(XR + ro + bj * HALF); r[0] = bflo(w.x); r[1] = bfhi(w.x); r[2] = bflo(w.y); r[3] = bfhi(w.y); r[4] = bflo(w.z); r[5] = bfhi(w.z); r[6] = bflo(w.w); r[7] = bfhi(w.w); }
                    const f32x4 v0 = acc[ai][bj][m][0] * osc, v1 = acc[ai][bj][m][1] * osc;
                    u32x4 o; o.x = cvt_pk_bf16(v0[0] + r[0], v0[1] + r[1]); o.y = cvt_pk_bf16(v0[2] + r[2], v0[3] + r[3]); o.z = cvt_pk_bf16(v1[0] + r[4], v1[1] + r[5]); o.w = cvt_pk_bf16(v1[2] + r[6], v1[3] + r[7]);
                    *(u32x4*)(XR + ro + bj * HALF) = o; } }
    }
};
__device__ __forceinline__ float sigmoidf_(float z) { return __builtin_amdgcn_rcpf(1.0f + __expf(-z)); }
template <bool OUT8> struct EpiSwiGLU {
    static constexpr bool PERM = true;
    bf16* O; float osc;
    __device__ __forceinline__ void operator()(const f32x4 (&acc)[2][2][4][2], const Unit& u, int wr, int wc, int fr, int fq) const {
        const int row0 = u.pm * BM + wr * 64 + fr, col0 = u.pn * HALF + wc * 32 + 8 * fq;
#pragma unroll
        for (int ai = 0; ai < 2; ++ai)
#pragma unroll
            for (int m = 0; m < 4; ++m) { const size_t eo = (size_t)(row0 + ai * HALF + m * 16) * FF + col0;
                float o[8];
#pragma unroll
                for (int n = 0; n < 2; ++n)
#pragma unroll
                    for (int j = 0; j < 4; ++j) { const float g = acc[ai][0][m][n][j] * osc, up = acc[ai][1][m][n][j] * osc; o[4 * n + j] = g * sigmoidf_(g) * up; }
                if (OUT8) { u32x2 w; w.x = pk4_fp8(o[0] * SC_ACT, o[1] * SC_ACT, o[2] * SC_ACT, o[3] * SC_ACT); w.y = pk4_fp8(o[4] * SC_ACT, o[5] * SC_ACT, o[6] * SC_ACT, o[7] * SC_ACT); *(u32x2*)((unsigned char*)O + eo) = w; }
                else { u32x4 w; w.x = cvt_pk_bf16(o[0], o[1]); w.y = cvt_pk_bf16(o[2], o[3]); w.z = cvt_pk_bf16(o[4], o[5]); w.w = cvt_pk_bf16(o[6], o[7]); *(u32x4*)(O + eo) = w; } }
    }
};
typedef _Float16 h8 __attribute__((ext_vector_type(8)));
struct EpiHgrnIn {
    static constexpr bool PERM = true;
    unsigned char* zb; const float* lb;
    __device__ __forceinline__ void operator()(const f32x4 (&acc)[2][2][4][2], const Unit& u, int wr, int wc, int fr, int fq) const {
        const int quarter = u.pn >> 3, row0 = u.pm * BM + wr * 64 + fr, col0 = (u.pn & 7) * BM + wc * 32 + 8 * fq;
        if (quarter == 1) {
            float lbv[2][8];
#pragma unroll
            for (int bj = 0; bj < 2; ++bj) { const f32x4 a = *(const f32x4*)(lb + col0 + bj * HALF), b = *(const f32x4*)(lb + col0 + bj * HALF + 4);
#pragma unroll
                for (int j = 0; j < 4; ++j) { lbv[bj][j] = a[j]; lbv[bj][4 + j] = b[j]; } }
#pragma unroll
            for (int ai = 0; ai < 2; ++ai)
#pragma unroll
                for (int m = 0; m < 4; ++m) { const size_t ro = (size_t)(row0 + ai * HALF + m * 16) * D + col0;
#pragma unroll
                    for (int bj = 0; bj < 2; ++bj) { float kk[8]; h8 hv;
#pragma unroll
                        for (int n = 0; n < 2; ++n)
#pragma unroll
                            for (int j = 0; j < 4; ++j) { const float z = acc[ai][bj][m][n][j], l = lbv[bj][4 * n + j];
                                const float k1 = (1.0f - l) * __builtin_amdgcn_rcpf(1.0f + __expf(z));
                                kk[4 * n + j] = k1; hv[4 * n + j] = (_Float16)__logf(1.0f - k1); }
                        u32x4 w; w.x = cvt_pk_bf16(kk[0], kk[1]); w.y = cvt_pk_bf16(kk[2], kk[3]); w.z = cvt_pk_bf16(kk[4], kk[5]); w.w = cvt_pk_bf16(kk[6], kk[7]);
                        *(u32x4*)((bf16*)(zb + (64u << 20)) + ro + bj * HALF) = w;
                        *(h8*)((_Float16*)(zb + (128u << 20)) + ro + bj * HALF) = hv; } }
        } else {
            const size_t zo = quarter == 0 ? 0u : (quarter == 2 ? (size_t)(192u << 20) : (size_t)(256u << 20)); bf16* dst = (bf16*)(zb + zo);
#pragma unroll
            for (int ai = 0; ai < 2; ++ai)
#pragma unroll
                for (int m = 0; m < 4; ++m) { const size_t ro = (size_t)(row0 + ai * HALF + m * 16) * D + col0;
#pragma unroll
                    for (int bj = 0; bj < 2; ++bj) { float o[8];
#pragma unroll
                        for (int n = 0; n < 2; ++n)
#pragma unroll
                            for (int j = 0; j < 4; ++j) { const float z = acc[ai][bj][m][n][j]; o[4 * n + j] = (quarter == 3) ? z * sigmoidf_(z) : z; }
                        u32x4 w; w.x = cvt_pk_bf16(o[0], o[1]); w.y = cvt_pk_bf16(o[2], o[3]); w.z = cvt_pk_bf16(o[4], o[5]); w.w = cvt_pk_bf16(o[6], o[7]);
                        *(u32x4*)(dst + ro + bj * HALF) = w; } }
        }
    }
};

struct EpiQKV {
    static constexpr bool PERM = true;
    bf16* Q; bf16* Kd; bf16* V; const float* qg; const float* kg; const f32x2* rope; float* kmean; LAS unsigned char* xl; float osc; int wv;
    __device__ __forceinline__ void operator()(const f32x4 (&acc)[2][2][4][2], const Unit& u, int wr, int wc, int fr, int fq) const {
        const int sec = u.pn >> 3, row0 = u.pm * BM + wr * 64 + fr;
        if (sec == 2) {
            const int col0 = (u.pn & 7) * BM + wc * 32 + 8 * fq; const float vs = osc * SC_QKV;
#pragma unroll
            for (int ai = 0; ai < 2; ++ai)
#pragma unroll
                for (int m = 0; m < 4; ++m) { unsigned char* rowp = (unsigned char*)V + (size_t)(row0 + ai * HALF + m * 16) * D + col0;
#pragma unroll
                    for (int bj = 0; bj < 2; ++bj) { const f32x4 v0 = acc[ai][bj][m][0] * vs, v1 = acc[ai][bj][m][1] * vs;
                        u32x2 w; w.x = pk4_fp8(v0[0], v0[1], v0[2], v0[3]); w.y = pk4_fp8(v1[0], v1[1], v1[2], v1[3]);
                        *(u32x2*)(rowp + bj * HALF) = w; } }
            return;
        }
        LAS float* X = (LAS float*)xl;
        LAS float* Y = (LAS float*)(xl + 8192);
#pragma unroll
        for (int ai = 0; ai < 2; ++ai)
#pragma unroll
            for (int m = 0; m < 4; ++m)
#pragma unroll
                for (int bj = 0; bj < 2; ++bj) { const f32x4 a = acc[ai][bj][m][0], b = acc[ai][bj][m][1];
                    float s = ((a[0] * a[0] + a[1] * a[1]) + (a[2] * a[2] + a[3] * a[3]) + (b[0] * b[0] + b[1] * b[1]) + (b[2] * b[2] + b[3] * b[3])) * (osc * osc);
                    s += __shfl_xor(s, 16); s += __shfl_xor(s, 32);
                    if (fq == 0) X[((ai * HALF + wr * 64 + m * 16 + fr) * 2 + bj) * 4 + wc] = s; }
        asm volatile("s_waitcnt lgkmcnt(0)" ::: "memory"); __builtin_amdgcn_s_barrier(); asm volatile("" ::: "memory");
        const float* gain = sec ? kg : qg; bf16* dst = sec ? Kd : Q;
#pragma unroll
        for (int ai = 0; ai < 2; ++ai)
#pragma unroll
            for (int m = 0; m < 4; ++m) { const int rl = ai * HALF + wr * 64 + m * 16 + fr, pos = (u.pm & 15) * BM + rl;
                const f32x4 g0 = *(const f32x4*)(gain + 16 * wc + 4 * fq), g1 = *(const f32x4*)(gain + 64 + 16 * wc + 4 * fq);
                const f32x4 r0 = *(const f32x4*)(rope + pos * 64 + 16 * wc + 4 * fq), r1 = *(const f32x4*)(rope + pos * 64 + 16 * wc + 4 * fq + 2);
                const float cc[4] = {r0[0], r0[2], r1[0], r1[2]}, sn[4] = {r0[1], r0[3], r1[1], r1[3]};
#pragma unroll
                for (int bj = 0; bj < 2; ++bj) { const f32x4 p = *(const LAS f32x4*)(X + (rl * 2 + bj) * 4);
                    const float rstd = __builtin_amdgcn_rsqf(((p[0] + p[1]) + (p[2] + p[3])) * (1.f / 128) + RMS_EPS);
                    float o[8];
#pragma unroll
                    for (int j = 0; j < 4; ++j) { const float y1 = acc[ai][bj][m][0][j] * (rstd * osc) * g0[j], y2 = acc[ai][bj][m][1][j] * (rstd * osc) * g1[j]; o[j] = y1 * cc[j] - y2 * sn[j]; o[4 + j] = y2 * cc[j] + y1 * sn[j]; }
                    unsigned char* p0 = (unsigned char*)dst + (size_t)(u.pm * BM + rl) * D + ((u.pn & 7) * 2 + bj) * 128 + 16 * wc + 4 * fq;
                    *(unsigned*)p0 = pk4_fp8(o[0] * SC_QKV, o[1] * SC_QKV, o[2] * SC_QKV, o[3] * SC_QKV); *(unsigned*)(p0 + 64) = pk4_fp8(o[4] * SC_QKV, o[5] * SC_QKV, o[6] * SC_QKV, o[7] * SC_QKV);
                    if (sec == 1) {
#pragma unroll
                        for (int j = 0; j < 8; ++j) { float sv = o[j]; sv += __shfl_xor(sv, 1); sv += __shfl_xor(sv, 2); sv += __shfl_xor(sv, 4); sv += __shfl_xor(sv, 8); o[j] = sv; }
                        if (fr == 0) { LAS float* yp = Y + ((((wr * 2 + ai) * 4 + m) * 2 + bj) * 128) + 16 * wc + 4 * fq; *(LAS f32x4*)yp = (f32x4){o[0], o[1], o[2], o[3]}; *(LAS f32x4*)(yp + 64) = (f32x4){o[4], o[5], o[6], o[7]}; }
                    } }
                asm volatile("" ::: "memory"); }
        if (sec == 1) {
            asm volatile("s_waitcnt lgkmcnt(0)" ::: "memory"); __builtin_amdgcn_s_barrier(); asm volatile("" ::: "memory");
            const int tid = make_tid(wv);
            if (tid < 256) { const int bj = tid >> 7, d = tid & 127; const int b = u.pm >> 4, nb = u.pm & 15, head = (u.pn & 7) * 2 + bj;
                float sm = 0.f;
#pragma unroll
                for (int q = 0; q < 16; ++q) sm += Y[(q * 2 + bj) * 128 + d];
                float* kmb = kmean; asm volatile("" : "+s"(kmb));
                ((GAS float*)kmb)[((b * H + head) * NBLK + nb) * HD + d] = sm * (1.0f / 256); }
        }
    }
};

__device__ __forceinline__ void glds_saddr(const char* sbase, unsigned voff, unsigned lds_dst) {
    unsigned keep;
    asm volatile("s_mov_b32 %0, m0\n\ts_mov_b32 m0, %3\n\ts_nop 4\n\tglobal_load_lds_dwordx4 %1, %2\n\ts_mov_b32 m0, %0" : "=&s"(keep) : "v"(voff), "s"(sbase), "s"(lds_dst) : "memory");
}
typedef int i32x4 __attribute__((ext_vector_type(4)));
typedef int i32x8 __attribute__((ext_vector_type(8)));
__device__ __forceinline__ i32x8 cat8(bf16x8 lo, bf16x8 hi) { const i32x4 a = __builtin_bit_cast(i32x4, lo), b = __builtin_bit_cast(i32x4, hi); return __builtin_shufflevector(a, b, 0, 1, 2, 3, 4, 5, 6, 7); }
template <class Epi, class Sched, bool ALIGN_EPI, bool FP8 = false>
__device__ __forceinline__ void gemm_phase(LAS unsigned char* lds, const Sched& S, const Epi& E) {
    const int tid = make_tid(S.wv), wid = __builtin_amdgcn_readfirstlane(tid >> 6), lane = tid & 63, wr = wid >> 2, wc = wid & 3, fr = lane & 15, fq = lane >> 4;
    const int K = S.K, RB = S.RB, nt = RB / (BK * 2);
    unsigned voffA[2], voffB[2];
#pragma unroll
    for (int i = 0; i < 2; ++i) { int R, C; stage_rc(tid * 16 + i * 8192, R, C); const int Rb = Epi::PERM ? ((R & ~31) + perm32(R & 31)) : R;
        voffA[i] = (unsigned)(R * RB + C * 2); voffB[i] = (unsigned)(Rb * RB + C * 2); }
    const size_t kstep = (size_t)(BK * 2);
    const size_t hstep = (size_t)HALF * RB;
    const unsigned ldsw = (unsigned)wid * 1024u, ldsb = (unsigned)(size_t)lds;
    const int aoff = lds_byte(wr * 64 + fr, fq * 8), boff = lds_byte(wc * 32 + fr, fq * 8);
#define PG8_SA(b, h) (((b) * 2 + (h)) * HTB)
#define PG8_SB(b, h) ((4 + (b) * 2 + (h)) * HTB)
#define PG8_STAGE(bufoff, gbase, voff) do { _Pragma("unroll") for (int _i = 0; _i < 2; ++_i) glds_saddr((const char*)(gbase), (voff)[_i], ldsb + (unsigned)(bufoff) + ldsw + _i * 8192u); } while (0)
#define PG8_GOFS(pp, h, i) (gofs + ((((pp) * 2 + (h)) * 2 + (i)) * 512))
#define PG8_STAGE_A(bufoff, sel, h, ko) do { if constexpr (Sched::GATHER) { const int _pp = (sel) ? (pc ^ 1) : pc; unsigned _v[2]; _v[0] = PG8_GOFS(_pp, h, 0)[tid]; _v[1] = PG8_GOFS(_pp, h, 1)[tid]; PG8_STAGE(bufoff, S.A + (ko), _v); } \
        else { PG8_STAGE(bufoff, ((sel) ? nA : cA) + (h) * hstep + (ko), voffA); } } while (0)
#define PG8_LDA(dst, b, h) do { _Pragma("unroll") for (int m = 0; m < 4; ++m) { if constexpr (FP8) dst##8[m] = cat8(*(const LAS bf16x8*)(lds + PG8_SA(b, h) + aoff + m * 2048), *(const LAS bf16x8*)(lds + PG8_SA(b, h) + aoff + m * 2048 + 1024)); \
        else { _Pragma("unroll") for (int k = 0; k < 2; ++k) dst[m][k] = *(const LAS bf16x8*)(lds + PG8_SA(b, h) + aoff + m * 2048 + k * 1024); } } } while (0)
#define PG8_LDB(dst, b, h) do { _Pragma("unroll") for (int n = 0; n < 2; ++n) { if constexpr (FP8) dst##8[n] = cat8(*(const LAS bf16x8*)(lds + PG8_SB(b, h) + boff + n * 2048), *(const LAS bf16x8*)(lds + PG8_SB(b, h) + boff + n * 2048 + 1024)); \
        else { _Pragma("unroll") for (int k = 0; k < 2; ++k) dst[n][k] = *(const LAS bf16x8*)(lds + PG8_SB(b, h) + boff + n * 2048 + k * 1024); } } } while (0)
#define PG8_MMA(ai, bj, At, Bt) do { __builtin_amdgcn_s_setprio(1); _Pragma("unroll") for (int m = 0; m < 4; ++m) _Pragma("unroll") for (int n = 0; n < 2; ++n) { if constexpr (FP8) { \
        acc[ai][bj][m][n] = __builtin_amdgcn_mfma_scale_f32_16x16x128_f8f6f4(Bt##8[n], At##8[m], acc[ai][bj][m][n], 0, 0, 0, 0, 0, 0); } else { _Pragma("unroll") for (int k = 0; k < 2; ++k) \
        acc[ai][bj][m][n] = __builtin_amdgcn_mfma_f32_16x16x32_bf16(Bt[n][k], At[m][k], acc[ai][bj][m][n], 0, 0, 0); } } __builtin_amdgcn_s_setprio(0); } while (0)
#define PG8_WAIT_V(n) asm volatile("s_waitcnt vmcnt(" #n ")" ::: "memory")
#define PG8_WAIT_L(n) asm volatile("s_waitcnt lgkmcnt(" #n ")" ::: "memory")
#define PG8_BAR __builtin_amdgcn_s_barrier()
#define PG8_SCHED __builtin_amdgcn_sched_barrier(0)
    Unit cur, nxt; int ui = 0; int dyn_pend = 0;
    if constexpr (Sched::DYNAMIC) {
        if (wid == 0) { int v2 = 0; if (lane == 0) { const int v0 = S.fetch(), v1 = S.fetch(); v2 = S.fetch(); S.slot[0] = v0; S.slot[1] = v1; } dyn_pend = __builtin_amdgcn_readfirstlane(v2); }
        PG8_WAIT_L(0); PG8_BAR;
        const int L0 = __builtin_amdgcn_readfirstlane(S.slot[0]); if (L0 >= S.nwg) return;
        S.map(L0, cur);
    } else { if (!S.next(0, cur)) return; }
    LAS unsigned* gofs = (LAS unsigned*)(lds + 131072); int pc = 0;
#define PG8_WRITE_GOFS(pp, U) do { int _t = tid; asm volatile("" : "+v"(_t)); _Pragma("unroll") for (int _i = 0; _i < 2; ++_i) { int _R, _C; stage_rc(_t * 16 + _i * 8192, _R, _C); \
        _Pragma("unroll") for (int _h = 0; _h < 2; ++_h) PG8_GOFS(pp, _h, _i)[_t] = S.row_off(U, _h * HALF + _R) + (unsigned)_C * 2u; } } while (0)
    if constexpr (Sched::GATHER) PG8_WRITE_GOFS(0, cur);
    f32x4 acc[2][2][4][2];
#pragma unroll
    for (int a = 0; a < 2; ++a)
#pragma unroll
        for (int b = 0; b < 2; ++b)
#pragma unroll
            for (int m = 0; m < 4; ++m)
#pragma unroll
                for (int n = 0; n < 2; ++n) acc[a][b][m][n] = (f32x4){0.f, 0.f, 0.f, 0.f};
    bf16x8 At[4][2], B0[2][2], B1[2][2]; i32x8 At8[4], B08[2], B18[2];
    const char* cA = cur.a; const char* cB = cur.b; const char* nA = cA; const char* nB = cB;
    PG8_STAGE(PG8_SB(0, 0), cB, voffB); PG8_STAGE(PG8_SB(0, 1), cB + hstep, voffB); PG8_STAGE_A(PG8_SA(0, 0), false, 0, 0); PG8_STAGE_A(PG8_SA(0, 1), false, 1, 0);
    if (wr == 1) PG8_BAR;
    PG8_WAIT_V(2); PG8_BAR;
    PG8_STAGE(PG8_SB(1, 0), cB + kstep, voffB); PG8_STAGE_A(PG8_SA(1, 0), false, 0, kstep); PG8_STAGE(PG8_SB(1, 1), cB + hstep + kstep, voffB);
    PG8_WAIT_V(6); PG8_BAR;
    for (;;) {
        bool has_next = true;
        if constexpr (Sched::DYNAMIC) {
            if (ui >= 1 && wid == 0) { int v = 0; if (lane == 0) { S.slot[(ui + 1) % 3] = dyn_pend; v = S.fetch(); } dyn_pend = __builtin_amdgcn_readfirstlane(v); }
        } else { has_next = S.next(ui + 1, nxt); nA = has_next ? nxt.a : cA; nB = has_next ? nxt.b : cB; }
        if constexpr (Sched::GATHER) { if (has_next) PG8_WRITE_GOFS(pc ^ 1, nxt); else PG8_WRITE_GOFS(pc ^ 1, cur); }
        for (int t = 0; t < nt; t += 2) {
            const bool last = (t == nt - 2);
            if constexpr (Sched::DYNAMIC) { if (last) { const int Ln = __builtin_amdgcn_readfirstlane(S.slot[(ui + 1) % 3]); has_next = Ln < S.nwg; if (has_next) S.map(Ln, nxt); nA = has_next ? nxt.a : cA; nB = has_next ? nxt.b : cB; } }
            const size_t k1 = (size_t)(t + 1) * kstep;
            const size_t k2 = last ? 0 : (size_t)(t + 2) * kstep, k3 = k2 + kstep;
            const char* b2 = (last ? nB : cB) + k2; const char* b3 = b2 + kstep;
            PG8_LDB(B0, 0, 0); PG8_LDB(B1, 0, 1); PG8_SCHED; PG8_LDA(At, 0, 0); PG8_STAGE_A(PG8_SA(1, 1), false, 1, k1);
            PG8_WAIT_V(8); PG8_WAIT_L(0); PG8_BAR; PG8_MMA(0, 0, At, B0); PG8_MMA(0, 1, At, B1); PG8_BAR; PG8_SCHED;
            PG8_LDA(At, 0, 1); PG8_STAGE(PG8_SB(0, 0), b2, voffB); PG8_STAGE(PG8_SB(0, 1), b2 + hstep, voffB); PG8_STAGE_A(PG8_SA(0, 0), last, 0, k2);
            PG8_WAIT_V(8); PG8_WAIT_L(0); PG8_BAR; PG8_MMA(1, 0, At, B0); PG8_MMA(1, 1, At, B1); PG8_BAR; PG8_SCHED;
            PG8_LDB(B0, 1, 0); PG8_LDB(B1, 1, 1); PG8_SCHED; PG8_LDA(At, 1, 0); PG8_STAGE_A(PG8_SA(0, 1), last, 1, k2);
            PG8_WAIT_V(8); PG8_WAIT_L(0); PG8_BAR; PG8_MMA(0, 0, At, B0); PG8_MMA(0, 1, At, B1); PG8_BAR; PG8_SCHED;
            PG8_LDA(At, 1, 1); PG8_STAGE(PG8_SB(1, 0), b3, voffB); PG8_STAGE(PG8_SB(1, 1), b3 + hstep, voffB); PG8_STAGE_A(PG8_SA(1, 0), last, 0, k3);
            PG8_WAIT_V(8); PG8_WAIT_L(0); PG8_BAR; PG8_MMA(1, 0, At, B0); PG8_MMA(1, 1, At, B1); PG8_BAR; PG8_SCHED;
        }
        if constexpr (ALIGN_EPI) { if (wr == 0) PG8_BAR; }
        { const int l2_ = lane_id(); E(acc, cur, wr, wc, l2_ & 15, l2_ >> 4); }
        if (!has_next) break;
#pragma unroll
        for (int a = 0; a < 2; ++a)
#pragma unroll
            for (int b = 0; b < 2; ++b)
#pragma unroll
                for (int m = 0; m < 4; ++m)
#pragma unroll
                    for (int n = 0; n < 2; ++n) acc[a][b][m][n] = (f32x4){0.f, 0.f, 0.f, 0.f};
        cur = nxt; cA = nA; cB = nB; ++ui;
        pc ^= 1;
        if constexpr (ALIGN_EPI) { if (wr == 1) PG8_BAR; }
    }
    PG8_WAIT_V(0);
    if constexpr (!ALIGN_EPI) { if (wr == 0) PG8_BAR; }
    PG8_BAR;
#undef PG8_SA
#undef PG8_SB
#undef PG8_STAGE
#undef PG8_STAGE_A
#undef PG8_GOFS
#undef PG8_WRITE_GOFS
#undef PG8_LDA
#undef PG8_LDB
#undef PG8_MMA
#undef PG8_WAIT_V
#undef PG8_WAIT_L
#undef PG8_BAR
#undef PG8_SCHED
}
}

#define XB_TMO      128
#define XB_XCNT(j)  (256  + 64 * (j))
#define XB_XSUB(j)  (1280 + 64 * (j))
#define XB_XGEN(j)  (2304 + 64 * (j))
#define XB_TOP      3328
#define XB_TOPGEN   3392
#define XCD_BAR_WORDS 3456
#define XB_SPIN_CAP (1u << 18)
__device__ __forceinline__ unsigned xb_ld(unsigned* p)              { return __hip_atomic_load(p, __ATOMIC_RELAXED, __HIP_MEMORY_SCOPE_AGENT); }
__device__ __forceinline__ unsigned xb_add(unsigned* p, unsigned v) { return __hip_atomic_fetch_add(p, v, __ATOMIC_RELAXED, __HIP_MEMORY_SCOPE_AGENT); }
__device__ __forceinline__ unsigned xb_xcc_id() { return (unsigned)__builtin_amdgcn_s_getreg((3 << 11) | 20) & 0xFu; }
#define XB_SPIN(cond, bar) do { unsigned _sp = 0; while (cond) { __builtin_amdgcn_s_sleep(1); \
    if ((++_sp & 255u) == 0u) { if (xb_ld(&(bar)[XB_TMO])) break; if (_sp > XB_SPIN_CAP) { atomicAdd(&(bar)[XB_TMO], 1u); break; } } } } while (0)
struct XcdBarrier { unsigned* bar; unsigned x; volatile LAS unsigned* st; };
__device__ __forceinline__ XcdBarrier xcd_barrier_post(unsigned* bar, volatile LAS unsigned* st, int tid0) {
    XcdBarrier b; b.bar = bar; b.x = xb_xcc_id(); b.st = st;
    if (tid0 == 0) (void)xb_add(&bar[XB_XCNT(b.x)], 1u);
    return b;
}
__device__ __forceinline__ void xcd_barrier_complete(unsigned* bar, unsigned x, unsigned& nloc, unsigned& nx) {
    const unsigned G = gridDim.x * gridDim.y * gridDim.z;
    unsigned sum, cnt, mine, sp = 0u;
    for (;;) {
        sum = 0u; cnt = 0u; mine = 0u;
#pragma unroll
        for (unsigned j = 0; j < 16; ++j) { const unsigned c = xb_ld(&bar[XB_XCNT(j)]); sum += c; cnt += (c > 0u) ? 1u : 0u; mine = (j == x) ? c : mine; }
        if (sum == G) break;
        __builtin_amdgcn_s_sleep(1);
        if ((++sp & 255u) == 0u) { if (xb_ld(&bar[XB_TMO])) break; if (sp > XB_SPIN_CAP) { atomicAdd(&bar[XB_TMO], 1u); break; } }
    }
    nloc = mine > 0u ? mine : 1u; nx = cnt > 0u ? cnt : 1u;
}
__device__ __forceinline__ void xcd_barrier(const XcdBarrier& b, int tid0) {
    asm volatile("s_waitcnt vmcnt(0)" ::: "memory");
    __syncthreads();
    if (tid0 == 0) {
        unsigned* bar = b.bar;
        __builtin_amdgcn_s_waitcnt(0);
        unsigned nloc = b.st[0], nx = b.st[1];
        if (nloc == 0u) { xcd_barrier_complete(bar, b.x, nloc, nx); b.st[0] = nloc; b.st[1] = nx; }
        const unsigned old = xb_add(&bar[XB_XSUB(b.x)], 1u);
        const unsigned gen = old / nloc;
        if (old + 1u == (gen + 1u) * nloc) {
            __builtin_amdgcn_fence(__ATOMIC_RELEASE, "agent");
            asm volatile("s_waitcnt vmcnt(0)" ::: "memory");
            const unsigned og = xb_add(&bar[XB_TOP], 1u);
            const unsigned tg = og / nx;
            if (og + 1u == (tg + 1u) * nx) xb_add(&bar[XB_TOPGEN], 1u);
            else XB_SPIN(xb_ld(&bar[XB_TOPGEN]) == tg, bar);
            __builtin_amdgcn_fence(__ATOMIC_ACQUIRE, "agent");
            xb_add(&bar[XB_XGEN(b.x)], 1u);
            asm volatile("s_waitcnt vmcnt(0)" ::: "memory");
        } else {
            XB_SPIN(xb_ld(&bar[XB_XGEN(b.x)]) == gen, bar);
            __builtin_amdgcn_fence(__ATOMIC_ACQUIRE, "agent");
            asm volatile("s_waitcnt vmcnt(0)" ::: "memory");
        }
    }
    __syncthreads();
}

struct Args { const float* in[20]; float* out; unsigned char* ws; int ph_lo, ph_hi; };
typedef const __attribute__((address_space(4))) Args CArgs;
enum { I_X = 0, I_NORM_MIX, I_NORM_FFN, I_A_W_IN, I_A_LB, I_A_OGAIN, I_A_W_OUT, I_KV_NORM, I_KV_W, I_K_NORM, I_B_W_Q, I_B_Q_NORM, I_B_W_OUT,
       I_W_GROUP, I_B_GROUP, I_W_EXPERT, I_B_EXPERT, I_W_GATE, I_W_UP, I_W_DOWN };
struct Frame {
    LAS unsigned char* lds; unsigned char* ws; unsigned* ctl;
    int tid, lane, wave, vcu, G, gw, NGW;
};

struct TrItem { const float* src; const float* ksc; unsigned char* dst; int N, K, k0, n0, drow0, flags; float osc; };
struct TrRegs { f32x4 v[16]; f32x4 ks[2]; };
constexpr int TR_SCR_BYTES = 128 * 33 * 4;
__device__ __forceinline__ void tr_load(const TrItem& it, TrRegs& r, int lane) {
    const float* p = it.src + (size_t)(it.k0 + (lane >> 3)) * it.N + it.n0 + 4 * (lane & 7);
    const size_t st = (size_t)8 * it.N;
#pragma unroll
    for (int i = 0; i < 16; ++i) r.v[i] = *(const f32x4*)(p + i * st);
    if (it.ksc) { const f32x4* q = (const f32x4*)(it.ksc + it.k0 + 8 * (lane >> 3)); r.ks[0] = q[0]; r.ks[1] = q[1]; }
    else { r.ks[0] = (f32x4){1.f, 1.f, 1.f, 1.f}; r.ks[1] = r.ks[0]; }
}
__device__ __forceinline__ void tr_to_lds(const TrRegs& r, LAS float* scr, int lane) {
    LAS float* d = scr + (lane >> 3) * 33 + 4 * (lane & 7);
#pragma unroll
    for (int i = 0; i < 16; ++i) { d[(8 * i) * 33 + 0] = r.v[i][0]; d[(8 * i) * 33 + 1] = r.v[i][1]; d[(8 * i) * 33 + 2] = r.v[i][2]; d[(8 * i) * 33 + 3] = r.v[i][3]; }
}
__device__ __forceinline__ void tr_store(const TrItem& it, f32x4 ka, f32x4 kb, const LAS float* scr, int lane) {
#pragma unroll
    for (int jh = 0; jh < 2; ++jh) {
        const int c = (lane >> 3) + 8 * jh;
        if (jh == 1 && it.ksc) { const f32x4* q = (const f32x4*)(it.ksc + it.k0 + 8 * c); ka = q[0]; kb = q[1]; }
        const float o = it.osc;
        const float s0 = ka[0] * o, s1 = ka[1] * o, s2 = ka[2] * o, s3 = ka[3] * o, s4 = kb[0] * o, s5 = kb[1] * o, s6 = kb[2] * o, s7 = kb[3] * o;
#pragma unroll
        for (int jn = 0; jn < 4; ++jn) {
            const int n = (lane & 7) + 8 * jn; const LAS float* s = scr + (8 * c) * 33 + n;
            const float w0 = s[0 * 33] * s0, w1 = s[1 * 33] * s1, w2 = s[2 * 33] * s2, w3 = s[3 * 33] * s3, w4 = s[4 * 33] * s4, w5 = s[5 * 33] * s5, w6 = s[6 * 33] * s6, w7 = s[7 * 33] * s7;
            int drow = it.drow0 + n;
            if (it.flags & 1) { const int cidx = it.n0 + n, d = cidx & 127; drow = (it.drow0 - it.n0) + (cidx & ~127) + 32 * ((d & 63) >> 4) + 8 * ((d & 15) >> 2) + 4 * (d >> 6) + (d & 3); }
            const size_t eo = (size_t)drow * it.K + it.k0 + 8 * c;
            if (it.flags & 2) { u32x2 o8; o8.x = pk4_fp8(w0, w1, w2, w3); o8.y = pk4_fp8(w4, w5, w6, w7); *(u32x2*)(it.dst + eo) = o8; }
            else { u32x4 o16; o16.x = pk2(w0, w1); o16.y = pk2(w2, w3); o16.z = pk2(w4, w5); o16.w = pk2(w6, w7); *(u32x4*)(it.dst + eo * 2) = o16; }
        }
    }
}
template <class Dec> __device__ __forceinline__ void tr_run(Dec dec, int first, int total, int stride, LAS float* scr, int lane) {
    if (first >= total) return;
    TrRegs r; TrItem cur = dec(first); tr_load(cur, r, lane);
    for (int i = first; i < total; i += stride) {
        tr_to_lds(r, scr, lane);
        const f32x4 ka = r.ks[0], kb = r.ks[1];
        TrItem nxt = cur; const bool more = i + stride < total;
        if (more) { nxt = dec(i + stride); tr_load(nxt, r, lane); }
        LDS_WAIT(); asm volatile("" ::: "memory");
        tr_store(cur, ka, kb, scr, lane);
        LDS_WAIT(); asm volatile("" ::: "memory");
        cur = nxt;
    }
}
constexpr size_t WGU_LSTRIDE = 64 * MiB, WD_LSTRIDE = 32 * MiB;
static_assert((FP8_MOE0 != 0) && (FP8_MOE1 != 0), "the two-layer weight residency assumes e4m3 expert weights");
constexpr int MOE_CV_ITEMS = 32 * 768;
__device__ __forceinline__ TrItem moe_cv_item(CArgs& a, unsigned char* ws, int layer, int item) {
    const int e = item / 768, r = item % 768, which = r / 256, q = r % 256;
    const size_t eo = (size_t)(layer * NE + e);
    TrItem t; t.ksc = nullptr; t.flags = 2;
    if (which < 2) {
        const int kb = q / 16, nb = q % 16, n0 = nb * 32;
        t.src = (which == 0 ? a.in[I_W_GATE] : a.in[I_W_UP]) + eo * (size_t)D * FF; t.N = FF; t.K = D; t.k0 = 128 * kb; t.n0 = n0;
        t.dst = ws + WS_WGU + (size_t)layer * WGU_LSTRIDE + (size_t)e * 1024 * D; t.drow0 = (n0 >> 7) * 256 + which * 128 + (n0 & 127); t.osc = SC_W;
    } else {
        const int kb = q / 64, nb = q % 64;
        t.src = a.in[I_W_DOWN] + eo * (size_t)FF * D; t.N = D; t.K = FF; t.k0 = 128 * kb; t.n0 = nb * 32;
        t.dst = ws + WS_WD + (size_t)layer * WD_LSTRIDE + (size_t)e * D * FF; t.drow0 = nb * 32; t.osc = SC_WD;
    }
    return t;
}
__device__ __forceinline__ void rms_row_to_bf16(const float* xrow, bf16* orow, int lane) {
    const f32x4* xr = (const f32x4*)xrow + lane;
    f32x4 v[8]; float s = 0.f;
#pragma unroll
    for (int j = 0; j < 8; ++j) { v[j] = xr[64 * j]; s += (v[j].x * v[j].x + v[j].y * v[j].y) + (v[j].z * v[j].z + v[j].w * v[j].w); }
    const float rstd = __builtin_amdgcn_rsqf(wave_sum(s) * (1.f / D) + RMS_EPS);
    u32x2* o8 = (u32x2*)orow + lane;
#pragma unroll
    for (int j = 0; j < 8; ++j) { u32x2 w; w.x = pk2(v[j].x * rstd, v[j].y * rstd); w.y = pk2(v[j].z * rstd, v[j].w * rstd); o8[64 * j] = w; }
}

__device__ __forceinline__ int moe_tables(Frame& F, int layer) {
    LAS int* blk_e = (LAS int*)(F.lds + LT_BLKE); LAS int* blkstart = (LAS int*)(F.lds + LT_BLKSTART); LAS int* cntl = (LAS int*)(F.lds + LT_CNT);
    __syncthreads();
    if (F.wave == 0) {
        const int e = F.lane & 31;
        const int c = (int)__hip_atomic_load(F.ctl + CW_CNT_AT(layer, e), __ATOMIC_RELAXED, __HIP_MEMORY_SCOPE_AGENT);
        const int nb = (c + 255) >> 8;
        int incl = nb;
#pragma unroll
        for (int o = 1; o < 32; o <<= 1) { const int t = __shfl_up(incl, o, 32); if ((F.lane & 31) >= o) incl += t; }
        const int excl = incl - nb;
        if (F.lane < 32) { blkstart[e] = excl; cntl[e] = c; for (int r = 0; r < nb; ++r) blk_e[excl + r] = e; if (e == 31) blkstart[32] = incl; }
    }
    __syncthreads();
    return blkstart[32];
}

typedef const GAS char* gcptr;
__device__ __forceinline__ gcptr opaque_s(const void* p) { asm volatile("" : "+s"(p)); return (gcptr)p; }
__device__ __forceinline__ float wave_reduce4(const float (&p)[4], int lane) {
    const bool b0 = lane & 1, b1 = lane & 2;
    float a0 = b0 ? p[1] : p[0], x0 = b0 ? p[0] : p[1]; a0 += __shfl_xor(x0, 1);
    float a1 = b0 ? p[3] : p[2], x1 = b0 ? p[2] : p[3]; a1 += __shfl_xor(x1, 1);
    float c = b1 ? a1 : a0, d = b1 ? a0 : a1; c += __shfl_xor(d, 2);
    c += __shfl_xor(c, 4); c += __shfl_xor(c, 8); c += __shfl_xor(c, 16); c += __shfl_xor(c, 32);
    return c;
}
__device__ __forceinline__ float wave_reduce8(const float (&p)[8], int lane) {
    const bool b2 = lane & 4;
    const float lo[4] = {p[0], p[1], p[2], p[3]}, hi[4] = {p[4], p[5], p[6], p[7]};
    float q[4];
#pragma unroll
    for (int i = 0; i < 4; ++i) { const float keep = b2 ? hi[i] : lo[i], give = b2 ? lo[i] : hi[i]; q[i] = keep + __shfl_xor(give, 4); }
    const bool b0 = lane & 1, b1 = lane & 2;
    float a0 = b0 ? q[1] : q[0], x0 = b0 ? q[0] : q[1]; a0 += __shfl_xor(x0, 1);
    float a1 = b0 ? q[3] : q[2], x1 = b0 ? q[2] : q[3]; a1 += __shfl_xor(x1, 1);
    float c = b1 ? a1 : a0, d = b1 ? a0 : a1; c += __shfl_xor(d, 2);
    c += __shfl_xor(c, 8); c += __shfl_xor(c, 16); c += __shfl_xor(c, 32);
    return c;
}
template <bool DRY, bool OUT8> __device__ __forceinline__ void route_token(Frame& F, CArgs& a, int layer, int t) {
    const bf16* xrow = (const bf16*)(F.ws + WS_XR) + (size_t)t * D;
    const unsigned l16 = (unsigned)F.lane * 16u;
    gcptr xb = opaque_s(xrow); gcptr gb = opaque_s(a.in[I_NORM_FFN] + layer * D);
    f32x4 v[8]; float s = 0.f;
#pragma unroll
    for (int j = 0; j < 8; ++j) { const u32x2 xw_ = *(const GAS u32x2*)(xb + j * 512 + (l16 >> 1)); v[j] = (f32x4){bflo(xw_.x), bfhi(xw_.x), bflo(xw_.y), bfhi(xw_.y)}; s += (v[j].x * v[j].x + v[j].y * v[j].y) + (v[j].z * v[j].z + v[j].w * v[j].w); }
    const float rstd = __builtin_amdgcn_rsqf(wave_sum(s) * (1.f / D) + RMS_EPS);
    u32x2* o8 = (u32x2*)((bf16*)(F.ws + (DRY ? WS_OPART : WS_XN)) + (size_t)t * D) + F.lane;
#pragma unroll
    for (int j = 0; j < 8; ++j) { const f32x4 g = *(const GAS f32x4*)(gb + j * 1024 + l16); v[j].x *= rstd * g.x; v[j].y *= rstd * g.y; v[j].z *= rstd * g.z; v[j].w *= rstd * g.w;
        if (OUT8) ((unsigned*)(F.ws + (DRY ? WS_OPART : WS_XN)) + (size_t)t * (D / 4))[64 * j + F.lane] = pk4_fp8(v[j].x * SC_XN, v[j].y * SC_XN, v[j].z * SC_XN, v[j].w * SC_XN);
        else { u32x2 w; w.x = pk2(v[j].x, v[j].y); w.y = pk2(v[j].z, v[j].w); o8[64 * j] = w; } }
    const float* RT = (const float*)(F.ws + WS_RT) + (size_t)layer * 36 * D;
    float gl[4];
    { float pp[4];
#pragma unroll
      for (int r = 0; r < 4; ++r) { gcptr wb = opaque_s(RT + r * D); float p = 0.f;
#pragma unroll
        for (int j = 0; j < 8; ++j) { const f32x4 w = *(const GAS f32x4*)(wb + j * 1024 + l16); p += (v[j].x * w.x + v[j].y * w.y) + (v[j].z * w.z + v[j].w * w.w); }
        pp[r] = p; if (r & 1) __builtin_amdgcn_sched_barrier(0); }
      const float red = wave_reduce4(pp, F.lane);
#pragma unroll
      for (int r = 0; r < 4; ++r) gl[r] = __builtin_bit_cast(float, __builtin_amdgcn_readlane(__builtin_bit_cast(int, red), r)) + a.in[I_B_GROUP][layer * NG + r]; }
    int g = 0; float gm = gl[0];
#pragma unroll
    for (int r = 1; r < 4; ++r) if (gl[r] > gm) { gm = gl[r]; g = r; }
    float gs = 0.f;
#pragma unroll
    for (int r = 0; r < 4; ++r) gs += __expf(gl[r] - gm);
    const float gp = 1.0f / gs;
    g = __builtin_amdgcn_readfirstlane(g);
    float el[8];
    { float pp[8];
#pragma unroll
      for (int r = 0; r < 8; ++r) { gcptr wb = opaque_s(RT + (size_t)(4 + g * 8 + r) * D); float p = 0.f;
#pragma unroll
        for (int j = 0; j < 8; ++j) { const f32x4 w = *(const GAS f32x4*)(wb + j * 1024 + l16); p += (v[j].x * w.x + v[j].y * w.y) + (v[j].z * w.z + v[j].w * w.w); }
        pp[r] = p; if (r & 1) __builtin_amdgcn_sched_barrier(0); }
      const float red = wave_reduce8(pp, F.lane);
#pragma unroll
      for (int r = 0; r < 8; ++r) el[r] = __builtin_bit_cast(float, __builtin_amdgcn_readlane(__builtin_bit_cast(int, red), r)) + a.in[I_B_EXPERT][layer * NE + g * 8 + r]; }
    int i0 = 0; float m0 = el[0];
#pragma unroll
    for (int r = 1; r < 8; ++r) if (el[r] > m0) { m0 = el[r]; i0 = r; }
    int i1 = -1; float m1 = -INFINITY;
#pragma unroll
    for (int r = 0; r < 8; ++r) if (r != i0 && el[r] > m1) { m1 = el[r]; i1 = r; }
    const float q1 = __expf(m1 - m0), w0 = gp / (1.0f + q1), w1 = gp * q1 / (1.0f + q1);
    if (DRY && w0 + w1 < -1.0f) ((float*)(F.ws + WS_OPART))[0] = w0;
    if (F.lane == 0 && !DRY) {
        const int e0 = g * 8 + i0, e1 = g * 8 + i1;
        const int r0 = (int)atomicAdd(F.ctl + CW_CNT_AT(layer, e0), 1u), r1 = (int)atomicAdd(F.ctl + CW_CNT_AT(layer, e1), 1u);
        int* lists = (int*)(F.ws + WS_LISTS); lists[e0 * LIST_CAP + r0] = t; lists[e1 * LIST_CAP + r1] = t;
        int* rec = (int*)(F.ws + WS_TOKREC) + (size_t)t * 8;
        rec[0] = e0; rec[1] = r0; rec[2] = __builtin_bit_cast(int, w0); rec[3] = e1; rec[4] = r1; rec[5] = __builtin_bit_cast(int, w1);
    }
}

template <bool OUT8> __device__ __forceinline__ void route_pair(Frame& F, CArgs& a, int layer, int ta, int tb) {
    const unsigned l16 = (unsigned)F.lane * 16u;
    gcptr xb0 = opaque_s((const bf16*)(F.ws + WS_XR) + (size_t)ta * D), xb1 = opaque_s((const bf16*)(F.ws + WS_XR) + (size_t)tb * D); gcptr gb = opaque_s(a.in[I_NORM_FFN] + layer * D);
    f32x4 v0[8], v1[8]; float s0 = 0.f, s1 = 0.f;
#pragma unroll
    for (int j = 0; j < 8; ++j) { const u32x2 x0 = *(const GAS u32x2*)(xb0 + j * 512 + (l16 >> 1)), x1 = *(const GAS u32x2*)(xb1 + j * 512 + (l16 >> 1));
        v0[j] = (f32x4){bflo(x0.x), bfhi(x0.x), bflo(x0.y), bfhi(x0.y)}; v1[j] = (f32x4){bflo(x1.x), bfhi(x1.x), bflo(x1.y), bfhi(x1.y)};
        s0 += (v0[j].x * v0[j].x + v0[j].y * v0[j].y) + (v0[j].z * v0[j].z + v0[j].w * v0[j].w); s1 += (v1[j].x * v1[j].x + v1[j].y * v1[j].y) + (v1[j].z * v1[j].z + v1[j].w * v1[j].w); }
    const float rstd0 = __builtin_amdgcn_rsqf(wave_sum(s0) * (1.f / D) + RMS_EPS), rstd1 = __builtin_amdgcn_rsqf(wave_sum(s1) * (1.f / D) + RMS_EPS);
#pragma unroll
    for (int j = 0; j < 8; ++j) { const f32x4 g = *(const GAS f32x4*)(gb + j * 1024 + l16);
        v0[j].x *= rstd0 * g.x; v0[j].y *= rstd0 * g.y; v0[j].z *= rstd0 * g.z; v0[j].w *= rstd0 * g.w; v1[j].x *= rstd1 * g.x; v1[j].y *= rstd1 * g.y; v1[j].z *= rstd1 * g.z; v1[j].w *= rstd1 * g.w;
        if (OUT8) { ((unsigned*)(F.ws + WS_XN) + (size_t)ta * (D / 4))[64 * j + F.lane] = pk4_fp8(v0[j].x * SC_XN, v0[j].y * SC_XN, v0[j].z * SC_XN, v0[j].w * SC_XN);
                    ((unsigned*)(F.ws + WS_XN) + (size_t)tb * (D / 4))[64 * j + F.lane] = pk4_fp8(v1[j].x * SC_XN, v1[j].y * SC_XN, v1[j].z * SC_XN, v1[j].w * SC_XN); }
        else { u32x2 w; w.x = pk2(v0[j].x, v0[j].y); w.y = pk2(v0[j].z, v0[j].w); ((u32x2*)((bf16*)(F.ws + WS_XN) + (size_t)ta * D) + F.lane)[64 * j] = w;
               w.x = pk2(v1[j].x, v1[j].y); w.y = pk2(v1[j].z, v1[j].w); ((u32x2*)((bf16*)(F.ws + WS_XN) + (size_t)tb * D) + F.lane)[64 * j] = w; } }
    const float* RT = (const float*)(F.ws + WS_RT) + (size_t)layer * 36 * D;
    float gla[4], glb[4];
    { float pa_[4], pb_[4];
#pragma unroll
      for (int r = 0; r < 4; ++r) { gcptr wb = opaque_s(RT + r * D); float p0 = 0.f, p1 = 0.f;
#pragma unroll
        for (int j = 0; j < 8; ++j) { const f32x4 w = *(const GAS f32x4*)(wb + j * 1024 + l16);
            p0 += (v0[j].x * w.x + v0[j].y * w.y) + (v0[j].z * w.z + v0[j].w * w.w); p1 += (v1[j].x * w.x + v1[j].y * w.y) + (v1[j].z * w.z + v1[j].w * w.w); }
        pa_[r] = p0; pb_[r] = p1; if (r & 1) __builtin_amdgcn_sched_barrier(0); }
      const float reda = wave_reduce4(pa_, F.lane), redb = wave_reduce4(pb_, F.lane);
#pragma unroll
      for (int r = 0; r < 4; ++r) { const float bg = a.in[I_B_GROUP][layer * NG + r];
          gla[r] = __builtin_bit_cast(float, __builtin_amdgcn_readlane(__builtin_bit_cast(int, reda), r)) + bg; glb[r] = __builtin_bit_cast(float, __builtin_amdgcn_readlane(__builtin_bit_cast(int, redb), r)) + bg; } }
    int ga = 0, gb_ = 0; float gma = gla[0], gmb = glb[0];
#pragma unroll
    for (int r = 1; r < 4; ++r) { if (gla[r] > gma) { gma = gla[r]; ga = r; } if (glb[r] > gmb) { gmb = glb[r]; gb_ = r; } }
    float gsa = 0.f, gsb = 0.f;
#pragma unroll
    for (int r = 0; r < 4; ++r) { gsa += __expf(gla[r] - gma); gsb += __expf(glb[r] - gmb); }
    const float gpa = 1.0f / gsa, gpb = 1.0f / gsb;
    ga = __builtin_amdgcn_readfirstlane(ga); gb_ = __builtin_amdgcn_readfirstlane(gb_);
    float ela[8], elb[8];
    { float pa_[8], pb_[8];
#pragma unroll
      for (int r = 0; r < 8; ++r) { gcptr wa = opaque_s(RT + (size_t)(4 + ga * 8 + r) * D), wb = opaque_s(RT + (size_t)(4 + gb_ * 8 + r) * D); float p0 = 0.f, p1 = 0.f;
#pragma unroll
        for (int j = 0; j < 8; ++j) { const f32x4 w0 = *(const GAS f32x4*)(wa + j * 1024 + l16), w1 = *(const GAS f32x4*)(wb + j * 1024 + l16);
            p0 += (v0[j].x * w0.x + v0[j].y * w0.y) + (v0[j].z * w0.z + v0[j].w * w0.w); p1 += (v1[j].x * w1.x + v1[j].y * w1.y) + (v1[j].z * w1.z + v1[j].w * w1.w); }
        pa_[r] = p0; pb_[r] = p1; if (r & 1) __builtin_amdgcn_sched_barrier(0); }
      const float reda = wave_reduce8(pa_, F.lane), redb = wave_reduce8(pb_, F.lane);
#pragma unroll
      for (int r = 0; r < 8; ++r) { ela[r] = __builtin_bit_cast(float, __builtin_amdgcn_readlane(__builtin_bit_cast(int, reda), r)) + a.in[I_B_EXPERT][layer * NE + ga * 8 + r];
                                    elb[r] = __builtin_bit_cast(float, __builtin_amdgcn_readlane(__builtin_bit_cast(int, redb), r)) + a.in[I_B_EXPERT][layer * NE + gb_ * 8 + r]; } }
    int ia0 = 0, ib0 = 0; float ma0 = ela[0], mb0 = elb[0];
#pragma unroll
    for (int r = 1; r < 8; ++r) { if (ela[r] > ma0) { ma0 = ela[r]; ia0 = r; } if (elb[r] > mb0) { mb0 = elb[r]; ib0 = r; } }
    int ia1 = -1, ib1 = -1; float ma1 = -INFINITY, mb1 = -INFINITY;
#pragma unroll
    for (int r = 0; r < 8; ++r) { if (r != ia0 && ela[r] > ma1) { ma1 = ela[r]; ia1 = r; } if (r != ib0 && elb[r] > mb1) { mb1 = elb[r]; ib1 = r; } }
    const float qa = __expf(ma1 - ma0), wa0 = gpa / (1.0f + qa), wa1 = gpa * qa / (1.0f + qa);
    const float qb = __expf(mb1 - mb0), wb0 = gpb / (1.0f + qb), wb1 = gpb * qb / (1.0f + qb);
    if (F.lane == 0) {
        const int ea0 = ga * 8 + ia0, ea1 = ga * 8 + ia1, eb0 = gb_ * 8 + ib0, eb1 = gb_ * 8 + ib1;
        const int ra0 = (int)atomicAdd(F.ctl + CW_CNT_AT(layer, ea0), 1u), ra1 = (int)atomicAdd(F.ctl + CW_CNT_AT(layer, ea1), 1u);
        const int rb0 = (int)atomicAdd(F.ctl + CW_CNT_AT(layer, eb0), 1u), rb1 = (int)atomicAdd(F.ctl + CW_CNT_AT(layer, eb1), 1u);
        int* lists = (int*)(F.ws + WS_LISTS); lists[ea0 * LIST_CAP + ra0] = ta; lists[ea1 * LIST_CAP + ra1] = ta; lists[eb0 * LIST_CAP + rb0] = tb; lists[eb1 * LIST_CAP + rb1] = tb;
        int* rec = (int*)(F.ws + WS_TOKREC) + (size_t)ta * 8;
        rec[0] = ea0; rec[1] = ra0; rec[2] = __builtin_bit_cast(int, wa0); rec[3] = ea1; rec[4] = ra1; rec[5] = __builtin_bit_cast(int, wa1);
        rec = (int*)(F.ws + WS_TOKREC) + (size_t)tb * 8;
        rec[0] = eb0; rec[1] = rb0; rec[2] = __builtin_bit_cast(int, wb0); rec[3] = eb1; rec[4] = rb1; rec[5] = __builtin_bit_cast(int, wb1);
    }
}

template <bool NORM, bool DRY, bool OUT8> __device__ __forceinline__ void combine_token(Frame& F, CArgs& a, int t) {
    const LAS int* blkstart = (const LAS int*)(F.lds + LT_BLKSTART);
    const int* rec = (const int*)(F.ws + WS_TOKREC) + (size_t)t * 8;
    const int e0 = rec[0], r0 = rec[1], e1 = rec[3], r1 = rec[4]; const float w0 = __builtin_bit_cast(float, rec[2]), w1 = __builtin_bit_cast(float, rec[5]);
    const size_t row0 = (size_t)blkstart[e0] * 256 + r0, row1 = (size_t)blkstart[e1] * 256 + r1;
    const u32x2* p0 = (const u32x2*)((const bf16*)(F.ws + WS_OUTB) + row0 * D) + F.lane; const u32x2* p1 = (const u32x2*)((const bf16*)(F.ws + WS_OUTB) + row1 * D) + F.lane;
    const unsigned* q0 = (const unsigned*)(F.ws + WS_OUTB + row0 * D) + F.lane; const unsigned* q1 = (const unsigned*)(F.ws + WS_OUTB + row1 * D) + F.lane;
    u32x2* xr = (u32x2*)((bf16*)(F.ws + WS_XR) + (size_t)t * D) + F.lane; f32x4* xo = (f32x4*)(a.out + (size_t)t * D) + F.lane;
    f32x4 v[8]; float s = 0.f;
#pragma unroll
    for (int j = 0; j < 8; ++j) { const u32x2 xb_ = xr[64 * j]; f32x4 x = (f32x4){bflo(xb_.x), bfhi(xb_.x), bflo(xb_.y), bfhi(xb_.y)};
        if (OUT8) { const unsigned b0 = q0[64 * j], b1 = q1[64 * j]; const float u0 = w0 * (1.0f / SC_OUT), u1 = w1 * (1.0f / SC_OUT);
            const f32x2 l0 = __builtin_amdgcn_cvt_pk_f32_fp8((int)b0, false), h0 = __builtin_amdgcn_cvt_pk_f32_fp8((int)b0, true), l1 = __builtin_amdgcn_cvt_pk_f32_fp8((int)b1, false), h1 = __builtin_amdgcn_cvt_pk_f32_fp8((int)b1, true);
            x.x += u0 * l0.x + u1 * l1.x; x.y += u0 * l0.y + u1 * l1.y; x.z += u0 * h0.x + u1 * h1.x; x.w += u0 * h0.y + u1 * h1.y; }
        else { const u32x2 a0 = p0[64 * j], a1 = p1[64 * j];
            x.x += w0 * bflo(a0.x) + w1 * bflo(a1.x); x.y += w0 * bfhi(a0.x) + w1 * bfhi(a1.x); x.z += w0 * bflo(a0.y) + w1 * bflo(a1.y); x.w += w0 * bfhi(a0.y) + w1 * bfhi(a1.y); }
        v[j] = x; if (NORM) { if (!DRY) { u32x2 w_; w_.x = pk2(x.x, x.y); w_.y = pk2(x.z, x.w); xr[64 * j] = w_; } } else xo[64 * j] = x; s += (x.x * x.x + x.y * x.y) + (x.z * x.z + x.w * x.w); }
    if (NORM) {
        const float rstd = __builtin_amdgcn_rsqf(wave_sum(s) * (1.f / D) + RMS_EPS);
        u32x2* o8 = (u32x2*)((bf16*)(F.ws + (DRY ? WS_OPART + 128 * MiB : WS_XN)) + (size_t)t * D) + F.lane;
#pragma unroll
        for (int j = 0; j < 8; ++j) {
            if (FP8_QKV) ((unsigned*)(F.ws + (DRY ? WS_OPART + 128 * MiB : WS_XN)) + (size_t)t * (D / 4))[64 * j + F.lane] = pk4_fp8(v[j].x * (rstd * SC_XN), v[j].y * (rstd * SC_XN), v[j].z * (rstd * SC_XN), v[j].w * (rstd * SC_XN));
            else { u32x2 w; w.x = pk2(v[j].x * rstd, v[j].y * rstd); w.y = pk2(v[j].z * rstd, v[j].w * rstd); o8[64 * j] = w; } }
    }
}

typedef int ci32x4 __attribute__((ext_vector_type(4)));
struct CombRows { u32x2 x[8]; unsigned b0[8], b1[8]; float w0, w1; };
template <bool NORM> __device__ __forceinline__ void combine_tokens(Frame& F, CArgs& a, int t0, int stride) {
    static_assert(OUT8_L0 && OUT8_L1 && FP8_QKV, "pipelined combine: e4m3 expert rows and e4m3 XN");
    const LAS int* blkstart = (const LAS int*)(F.lds + LT_BLKSTART);
    LAS ci32x4* lrec = (LAS ci32x4*)(F.lds + F.wave * 256);
    const int lane = F.lane;
    auto issue = [&](int k, int t, CombRows& R) {
        const ci32x4 r0 = lrec[2 * k], r1 = lrec[2 * k + 1];
        const int e0 = __builtin_amdgcn_readfirstlane(r0.x), rr0 = __builtin_amdgcn_readfirstlane(r0.y), e1 = __builtin_amdgcn_readfirstlane(r0.w), rr1 = __builtin_amdgcn_readfirstlane(r1.x);
        const LAS float* wf = (const LAS float*)lrec + 8 * k; R.w0 = wf[2] * (1.0f / SC_OUT); R.w1 = wf[5] * (1.0f / SC_OUT);
        const size_t row0 = (size_t)blkstart[e0] * 256 + rr0, row1 = (size_t)blkstart[e1] * 256 + rr1;
        const unsigned* q0 = (const unsigned*)(F.ws + WS_OUTB + row0 * D) + lane; const unsigned* q1 = (const unsigned*)(F.ws + WS_OUTB + row1 * D) + lane;
        const u32x2* xr = (const u32x2*)((const bf16*)(F.ws + WS_XR) + (size_t)t * D) + lane;
#pragma unroll
        for (int j = 0; j < 8; ++j) { R.x[j] = xr[64 * j]; R.b0[j] = q0[64 * j]; R.b1[j] = q1[64 * j]; }
    };
    auto finish = [&](int t, const CombRows& R) {
        u32x2* xr = (u32x2*)((bf16*)(F.ws + WS_XR) + (size_t)t * D) + lane; f32x4* xo = (f32x4*)(a.out + (size_t)t * D) + lane;
        f32x4 v[8]; float s = 0.f;
#pragma unroll
        for (int j = 0; j < 8; ++j) { f32x4 x = (f32x4){bflo(R.x[j].x), bfhi(R.x[j].x), bflo(R.x[j].y), bfhi(R.x[j].y)};
            const f32x2 l0 = __builtin_amdgcn_cvt_pk_f32_fp8((int)R.b0[j], false), h0 = __builtin_amdgcn_cvt_pk_f32_fp8((int)R.b0[j], true), l1 = __builtin_amdgcn_cvt_pk_f32_fp8((int)R.b1[j], false), h1 = __builtin_amdgcn_cvt_pk_f32_fp8((int)R.b1[j], true);
            x.x += R.w0 * l0.x + R.w1 * l1.x; x.y += R.w0 * l0.y + R.w1 * l1.y; x.z += R.w0 * h0.x + R.w1 * h1.x; x.w += R.w0 * h0.y + R.w1 * h1.y;
            v[j] = x; if (NORM) { u32x2 w_; w_.x = pk2(x.x, x.y); w_.y = pk2(x.z, x.w); xr[64 * j] = w_; } else xo[64 * j] = x; s += (x.x * x.x + x.y * x.y) + (x.z * x.z + x.w * x.w); }
        if (NORM) {
            const float rstd = __builtin_amdgcn_rsqf(wave_sum(s) * (1.f / D) + RMS_EPS) * SC_XN;
            unsigned* o = (unsigned*)(F.ws + WS_XN) + (size_t)t * (D / 4) + lane;
#pragma unroll
            for (int j = 0; j < 8; ++j) o[64 * j] = pk4_fp8(v[j].x * rstd, v[j].y * rstd, v[j].z * rstd, v[j].w * rstd);
        }
    };
    for (int base = t0; base < M; base += 8 * stride) {
        const int nt = min(8, (M - base + stride - 1) / stride);
        if (lane < 2 * nt) lrec[lane] = ((const ci32x4*)(F.ws + WS_TOKREC))[2 * (size_t)(base + (lane >> 1) * stride) + (lane & 1)];
        LDS_WAIT(); asm volatile("s_waitcnt vmcnt(0)" ::: "memory"); LDS_WAIT();
        CombRows cur, nxt; issue(0, base, cur);
        for (int k = 0; k < nt; ++k) {
            if (k + 1 < nt) issue(k + 1, base + (k + 1) * stride, nxt);
            finish(base + k * stride, cur);
            cur = nxt;
        }
        LDS_WAIT();
    }
}
__device__ __forceinline__ void hgrn_naive_item(Frame& F, int item) {
    const int b = item >> 6, h = (item >> 2) & 15, sl = item & 3;
    const bf16* Zq = (const bf16*)(F.ws + WS_ZQ); const bf16* Zk = (const bf16*)(F.ws + WS_ZK); const _Float16* Zg = (const _Float16*)(F.ws + WS_ZG); const bf16* Zv = (const bf16*)(F.ws + WS_ZV);
    float* Oraw = (float*)(F.ws + WS_ORAW);
    LAS float* fq = (LAS float*)F.lds; LAS float* fk = fq + 16 * 128; LAS float* ff = fk + 16 * 128; LAS float* fv = ff + 16 * 128; LAS float* part = fv + 16 * 32;
    const int dv = F.tid & 31, dkg = F.tid >> 5;
    float S[8];
#pragma unroll
    for (int j = 0; j < 8; ++j) S[j] = 0.f;
    const size_t tok0 = (size_t)b * T;
    for (int c = 0; c < T / 16; ++c) {
        __syncthreads();
#pragma unroll
        for (int i = 0; i < 4; ++i) { const int idx = F.tid + i * 512, st = idx >> 7, dk = idx & 127; const size_t g = (tok0 + c * 16 + st) * D + h * HD + dk;
            fq[idx] = bf2f(Zq[g]); fk[idx] = bf2f(Zk[g]); ff[idx] = __expf((float)Zg[g]); }
        { const int st = F.tid >> 5; fv[F.tid] = bf2f(Zv[(tok0 + c * 16 + st) * D + h * HD + sl * 32 + dv]); }
        __syncthreads();
#pragma unroll 4
        for (int st = 0; st < 16; ++st) {
            const float v = fv[st * 32 + dv];
            const f32x4 q0 = *(const LAS f32x4*)(fq + st * 128 + dkg * 8), q1 = *(const LAS f32x4*)(fq + st * 128 + dkg * 8 + 4);
            const f32x4 k0 = *(const LAS f32x4*)(fk + st * 128 + dkg * 8), k1 = *(const LAS f32x4*)(fk + st * 128 + dkg * 8 + 4);
            const f32x4 f0 = *(const LAS f32x4*)(ff + st * 128 + dkg * 8), f1 = *(const LAS f32x4*)(ff + st * 128 + dkg * 8 + 4);
            float po = 0.f;
#pragma unroll
            for (int j = 0; j < 4; ++j) { S[j] = f0[j] * S[j] + k0[j] * v; po += q0[j] * S[j]; S[4 + j] = f1[j] * S[4 + j] + k1[j] * v; po += q1[j] * S[4 + j]; }
            part[(st * 16 + dkg) * 32 + dv] = po;
        }
        __syncthreads();
        { const int st = F.tid >> 5; float o = 0.f;
#pragma unroll
            for (int g = 0; g < 16; ++g) o += part[(st * 16 + g) * 32 + dv];
            Oraw[(tok0 + c * 16 + st) * D + h * HD + sl * 32 + dv] = o; }
    }
    __syncthreads();
}
__device__ __forceinline__ void hgrn_norm_token(Frame& F, CArgs& a, int t) {
    const float* o = (const float*)(F.ws + WS_ORAW) + (size_t)t * D + F.lane * 32;
    const bf16* zg = (const bf16*)(F.ws + WS_ZGATE) + (size_t)t * D + F.lane * 32;
    const float* gain = a.in[I_A_OGAIN] + (F.lane & 3) * 32;
    f32x4 v[8]; float s = 0.f;
#pragma unroll
    for (int j = 0; j < 8; ++j) { v[j] = ((const f32x4*)o)[j]; s += (v[j].x * v[j].x + v[j].y * v[j].y) + (v[j].z * v[j].z + v[j].w * v[j].w); }
    s += __shfl_xor(s, 1); s += __shfl_xor(s, 2);
    const float rstd = 1.0f / sqrtf(s * (1.f / HD) + RMS_EPS);
    bf16* out = (bf16*)(F.ws + WS_OH) + (size_t)t * D + F.lane * 32;
#pragma unroll
    for (int j = 0; j < 4; ++j) { const u32x4 g = ((const u32x4*)zg)[j]; const f32x4 ga = ((const f32x4*)gain)[2 * j], gb = ((const f32x4*)gain)[2 * j + 1]; const f32x4 va = v[2 * j], vb = v[2 * j + 1];
        u32x4 w; w.x = pk2(va.x * rstd * ga.x * bflo(g.x), va.y * rstd * ga.y * bfhi(g.x)); w.y = pk2(va.z * rstd * ga.z * bflo(g.y), va.w * rstd * ga.w * bfhi(g.y));
        w.z = pk2(vb.x * rstd * gb.x * bflo(g.z), vb.y * rstd * gb.y * bfhi(g.z)); w.w = pk2(vb.z * rstd * gb.z * bflo(g.w), vb.w * rstd * gb.w * bfhi(g.w));
        ((u32x4*)out)[j] = w; }
}

template <bool DRY> __device__ __forceinline__ void qk_post_item(Frame& F, CArgs& a, int item) {
    const int b = item >> 6, n = (item >> 2) & 15, hq = item & 3;
    const int hl = F.lane >> 4, sb = F.lane & 15, h = hq * 4 + hl;
    bf16* Q = (bf16*)(F.ws + WS_Q); bf16* Kb = (bf16*)(F.ws + WS_K);
    const f32x2* rope = (const f32x2*)(F.ws + WS_ROPE);
    const f32x4 gq0 = *(const f32x4*)(a.in[I_B_Q_NORM] + 4 * sb), gq1 = *(const f32x4*)(a.in[I_B_Q_NORM] + 64 + 4 * sb);
    const f32x4 gk0 = *(const f32x4*)(a.in[I_K_NORM] + 4 * sb), gk1 = *(const f32x4*)(a.in[I_K_NORM] + 64 + 4 * sb);
    float ks[8];
#pragma unroll
    for (int j = 0; j < 8; ++j) ks[j] = 0.f;
    for (int i = 0; i < 32; ++i) {
        const int pos = n * MBLK + F.wave * 32 + i; const size_t tok = (size_t)b * T + pos;
        f32x2 cs[4];
#pragma unroll
        for (int j = 0; j < 4; ++j) cs[j] = rope[pos * 64 + 4 * sb + j];
#pragma unroll
        for (int which = 0; which < 2; ++which) {
            bf16* p = (which ? Kb : Q) + tok * D + h * HD + 4 * sb;
            const u32x2 lo = *(const u32x2*)p, hi = *(const u32x2*)(p + 64);
            float x1[4] = {bflo(lo.x), bfhi(lo.x), bflo(lo.y), bfhi(lo.y)}, x2[4] = {bflo(hi.x), bfhi(hi.x), bflo(hi.y), bfhi(hi.y)};
            float s = 0.f;
#pragma unroll
            for (int j = 0; j < 4; ++j) s += x1[j] * x1[j] + x2[j] * x2[j];
            s += __shfl_xor(s, 1); s += __shfl_xor(s, 2); s += __shfl_xor(s, 4); s += __shfl_xor(s, 8);
            const float rstd = 1.0f / sqrtf(s * (1.f / HD) + RMS_EPS);
            const f32x4 g0 = which ? gk0 : gq0, g1 = which ? gk1 : gq1;
            float o1[4], o2[4];
#pragma unroll
            for (int j = 0; j < 4; ++j) { const float y1 = x1[j] * rstd * g0[j], y2 = x2[j] * rstd * g1[j]; o1[j] = y1 * cs[j].x - y2 * cs[j].y; o2[j] = y2 * cs[j].x + y1 * cs[j].y; }
            u32x2 wlo, whi; wlo.x = pk2(o1[0], o1[1]); wlo.y = pk2(o1[2], o1[3]); whi.x = pk2(o2[0], o2[1]); whi.y = pk2(o2[2], o2[3]);
            { bf16* pw = DRY ? p + (WS_OPART - WS_Q) / 2 : p; *(u32x2*)pw = wlo; *(u32x2*)(pw + 64) = whi; }
            if (which) {
#pragma unroll
                for (int j = 0; j < 4; ++j) { ks[j] += o1[j]; ks[4 + j] += o2[j]; } }
        }
    }
    LAS float* red = (LAS float*)F.lds;
    __syncthreads();
#pragma unroll
    for (int j = 0; j < 8; ++j) red[(F.wave * 64 + F.lane) * 8 + j] = ks[j];
    __syncthreads();
    { const int l = F.tid >> 3, j = F.tid & 7; float s = 0.f;
#pragma unroll
        for (int w = 0; w < 8; ++w) s += red[(w * 64 + l) * 8 + j];
        const int hh = hq * 4 + (l >> 4), s2 = l & 15, d = (j < 4) ? 4 * s2 + j : 64 + 4 * s2 + (j - 4);
        ((float*)(F.ws + (DRY ? WS_OPART + 200 * MiB : WS_KMEAN)))[(((size_t)b * H + hh) * NBLK + n) * HD + d] = s * (1.0f / MBLK); }
    const bf16* V = (const bf16*)(F.ws + WS_V); bf16* Vt = (bf16*)(F.ws + (DRY ? WS_OPART + 128 * MiB : WS_VT));
    LAS bf16* vl = (LAS bf16*)(F.lds + 32768);
    for (int hh = 0; hh < 4; ++hh) {
        const int hv = hq * 4 + hh;
        __syncthreads();
#pragma unroll
        for (int i = 0; i < 8; ++i) { const int ch = F.tid + i * 512, r = ch >> 4, cc = ch & 15;
            const u32x4 w = *(const u32x4*)(V + ((size_t)b * T + n * MBLK + r) * D + hv * HD + cc * 8);
            *(LAS u32x4*)(vl + r * 136 + cc * 8) = w; }
        __syncthreads();
#pragma unroll
        for (int i = 0; i < 8; ++i) { const int idx = F.tid + i * 512, d = idx & 127, tg = idx >> 7;
            unsigned short e[8];
#pragma unroll
            for (int j = 0; j < 8; ++j) e[j] = vl[(tg * 8 + j) * 136 + d];
            u32x4 w; w.x = e[0] | ((unsigned)e[1] << 16); w.y = e[2] | ((unsigned)e[3] << 16); w.z = e[4] | ((unsigned)e[5] << 16); w.w = e[6] | ((unsigned)e[7] << 16);
            *(u32x4*)(Vt + (((size_t)b * H + hv) * HD + d) * T + n * MBLK + tg * 8) = w; }
    }
    __syncthreads();
}

__device__ __forceinline__ void attn_v0_item(Frame& F, int item) {
    const int b = item >> 8, h = (item >> 4) & 15, jb = item & 15;
    const bf16* Q = (const bf16*)(F.ws + WS_Q); const bf16* Kb = (const bf16*)(F.ws + WS_K); const bf16* Vt = (const bf16*)(F.ws + WS_VT); bf16* OA = (bf16*)(F.ws + WS_OA);
    const float* kmean = (const float*)(F.ws + WS_KMEAN) + ((size_t)b * H + h) * NBLK * HD;
    const int lane = F.lane, fr = lane & 15, fq = lane >> 4;
    const size_t tokw = (size_t)b * T + jb * MBLK + F.wave * 32;
    LAS unsigned* maskl = (LAS unsigned*)(F.lds + F.wave * 8192);
    LAS bf16* pl = (LAS bf16*)(F.lds + F.wave * 8192 + 256);
    {
        const int row = lane & 31, half = lane >> 5;
        float g[8];
#pragma unroll
        for (int i = 0; i < 8; ++i) g[i] = 0.f;
        const bf16* qrow = Q + (tokw + row) * D + h * HD;
        for (int dc = 0; dc < 16; ++dc) {
            const u32x4 w = *(const u32x4*)(qrow + dc * 8);
            const float qv[8] = {bflo(w.x), bfhi(w.x), bflo(w.y), bfhi(w.y), bflo(w.z), bfhi(w.z), bflo(w.w), bfhi(w.w)};
#pragma unroll
            for (int i = 0; i < 8; ++i) { const float* km = kmean + (2 * i + half) * HD + dc * 8;
#pragma unroll
                for (int e = 0; e < 8; ++e) g[i] += qv[e] * km[e]; }
        }
        float ga[16];
#pragma unroll
        for (int i = 0; i < 8; ++i) { const float o = __shfl_xor(g[i], 32); ga[2 * i] = half ? o : g[i]; ga[2 * i + 1] = half ? g[i] : o; }
        unsigned mask = 0u;
#pragma unroll
        for (int pick = 0; pick < 3; ++pick) { float best = -INFINITY; int bi = -1;
#pragma unroll
            for (int n = 0; n < 16; ++n) { const bool ok = (n < jb) && !((mask >> n) & 1u); if (ok && ga[n] > best) { best = ga[n]; bi = n; } }
            if (bi >= 0) mask |= 1u << bi; }
        if (half == 0) maskl[row] = mask;
    }
    LDS_WAIT(); __builtin_amdgcn_wave_barrier();
    unsigned rmask[2][4]; unsigned anym = 0u;
#pragma unroll
    for (int rt = 0; rt < 2; ++rt)
#pragma unroll
        for (int r = 0; r < 4; ++r) { rmask[rt][r] = maskl[rt * 16 + 4 * fq + r]; }
    { unsigned m = maskl[lane & 31];
#pragma unroll
      for (int o = 1; o < 32; o <<= 1) m |= __shfl_xor(m, o);
      anym = __builtin_amdgcn_readfirstlane(m); }
    bf16x8 qf[2][4];
#pragma unroll
    for (int rt = 0; rt < 2; ++rt)
#pragma unroll
        for (int ks = 0; ks < 4; ++ks) qf[rt][ks] = *(const bf16x8*)(Q + (tokw + rt * 16 + fr) * D + h * HD + ks * 32 + 8 * fq);
    f32x4 oacc[2][8];
#pragma unroll
    for (int rt = 0; rt < 2; ++rt)
#pragma unroll
        for (int dt = 0; dt < 8; ++dt) oacc[rt][dt] = (f32x4){0.f, 0.f, 0.f, 0.f};
    float lsum[2][4];
#pragma unroll
    for (int rt = 0; rt < 2; ++rt)
#pragma unroll
        for (int r = 0; r < 4; ++r) lsum[rt][r] = 0.f;
    const float c2 = 0.08838834764831845f * 1.4426950408889634f;
    const int nkt = 4 * jb + 4;
    for (int kt = 0; kt < nkt; ++kt) {
        const int n = kt >> 2; const bool own = (n == jb);
        if (!own && !((anym >> n) & 1u)) continue;
        if (own && (kt & 3) * 64 > F.wave * 32 + 31) continue;
        const size_t key0 = (size_t)b * T + kt * 64;
        f32x4 sacc[2][4];
#pragma unroll
        for (int ct = 0; ct < 4; ++ct) {
            bf16x8 kf[4];
#pragma unroll
            for (int ks = 0; ks < 4; ++ks) kf[ks] = *(const bf16x8*)(Kb + (key0 + ct * 16 + fr) * D + h * HD + ks * 32 + 8 * fq);
#pragma unroll
            for (int rt = 0; rt < 2; ++rt) { f32x4 s = (f32x4){0.f, 0.f, 0.f, 0.f};
#pragma unroll
                for (int ks = 0; ks < 4; ++ks) s = __builtin_amdgcn_mfma_f32_16x16x32_bf16(qf[rt][ks], kf[ks], s, 0, 0, 0);
                sacc[rt][ct] = s; }
        }
#pragma unroll
        for (int rt = 0; rt < 2; ++rt)
#pragma unroll
            for (int ct = 0; ct < 4; ++ct)
#pragma unroll
                for (int r = 0; r < 4; ++r) {
                    const int qrow = rt * 16 + 4 * fq + r, kcol = ct * 16 + fr;
                    const bool ok = own ? ((kt & 3) * 64 + kcol <= F.wave * 32 + qrow) : ((rmask[rt][r] >> n) & 1u);
                    const float p = ok ? __builtin_amdgcn_exp2f(sacc[rt][ct][r] * c2) : 0.f;
                    lsum[rt][r] += p;
                    pl[qrow * 72 + kcol] = (bf16)f2bf(p);
                }
        LDS_WAIT(); __builtin_amdgcn_wave_barrier();
        bf16x8 pf[2][2];
#pragma unroll
        for (int rt = 0; rt < 2; ++rt)
#pragma unroll
            for (int k2 = 0; k2 < 2; ++k2) pf[rt][k2] = *(const LAS bf16x8*)(pl + (rt * 16 + fr) * 72 + k2 * 32 + 8 * fq);
#pragma unroll
        for (int dt = 0; dt < 8; ++dt) {
            bf16x8 vf[2];
#pragma unroll
            for (int k2 = 0; k2 < 2; ++k2) vf[k2] = *(const bf16x8*)(Vt + (((size_t)b * H + h) * HD + dt * 16 + fr) * T + kt * 64 + k2 * 32 + 8 * fq);
#pragma unroll
            for (int rt = 0; rt < 2; ++rt)
#pragma unroll
                for (int k2 = 0; k2 < 2; ++k2) oacc[rt][dt] = __builtin_amdgcn_mfma_f32_16x16x32_bf16(pf[rt][k2], vf[k2], oacc[rt][dt], 0, 0, 0);
        }
        LDS_WAIT(); __builtin_amdgcn_wave_barrier();
    }
#pragma unroll
    for (int rt = 0; rt < 2; ++rt)
#pragma unroll
        for (int r = 0; r < 4; ++r) { float s = lsum[rt][r]; s += __shfl_xor(s, 1); s += __shfl_xor(s, 2); s += __shfl_xor(s, 4); s += __shfl_xor(s, 8); const float inv = 1.0f / s;
            bf16* orow = OA + (tokw + rt * 16 + 4 * fq + r) * D + h * HD + fr;
#pragma unroll
            for (int dt = 0; dt < 8; ++dt) orow[dt * 16] = (bf16)f2bf(oacc[rt][dt][r] * inv); }
}

typedef float f32x16 __attribute__((ext_vector_type(16)));
template <bool DRY> __device__ __forceinline__ void moba_gate_item(Frame& F, int item) {
    const int bh = item >> 3, p = item & 7, b = bh >> 4, h = bh & 15;
    LAS float* km = (LAS float*)F.lds;
    __syncthreads();
    { const f32x4 v = ((const f32x4*)((const float*)(F.ws + WS_KMEAN) + (size_t)bh * NBLK * HD))[F.tid]; ((LAS f32x4*)km)[F.tid] = v; }
    __syncthreads();
    const int j = 2 * p + (F.wave >> 2), t = j * MBLK + (F.wave & 3) * 64 + F.lane;
    if (j == 0) return;
    const unsigned char* qrow = F.ws + WS_Q + ((size_t)b * T + t) * D + h * HD;
    float g[16];
#pragma unroll
    for (int n = 0; n < 16; ++n) g[n] = 0.f;
    for (int dc = 0; dc < 8; ++dc) {
        const u32x4 w = *(const u32x4*)(qrow + dc * 16);
        float qv[16]; { float t4[4]; fp8x4_to_f32(w.x, t4); qv[0] = t4[0]; qv[1] = t4[1]; qv[2] = t4[2]; qv[3] = t4[3]; fp8x4_to_f32(w.y, t4); qv[4] = t4[0]; qv[5] = t4[1]; qv[6] = t4[2]; qv[7] = t4[3];
            fp8x4_to_f32(w.z, t4); qv[8] = t4[0]; qv[9] = t4[1]; qv[10] = t4[2]; qv[11] = t4[3]; fp8x4_to_f32(w.w, t4); qv[12] = t4[0]; qv[13] = t4[1]; qv[14] = t4[2]; qv[15] = t4[3]; }
#pragma unroll
        for (int n = 0; n < 15; ++n) if (n < j) {
#pragma unroll
            for (int q4 = 0; q4 < 4; ++q4) { const f32x4 k0 = *(const LAS f32x4*)(km + n * HD + dc * 16 + 4 * q4);
                g[n] += (qv[4 * q4] * k0.x + qv[4 * q4 + 1] * k0.y) + (qv[4 * q4 + 2] * k0.z + qv[4 * q4 + 3] * k0.w); } }
    }
    int pk[3];
    unsigned mask = 0u;
#pragma unroll
    for (int pick = 0; pick < 3; ++pick) { float best = -INFINITY; int bi = -1;
#pragma unroll
        for (int n = 0; n < 15; ++n) { const bool ok = (n < j) && !((mask >> n) & 1u); if (ok && g[n] > best) { best = g[n]; bi = n; } }
        if (bi >= 0) mask |= 1u << bi;
        pk[pick] = bi; }
    unsigned* acnt = F.ctl + CW_ACNT + bh * 16; int* alist = (int*)(F.ws + WS_ALIST) + (size_t)bh * 16 * ALIST_CAP;
    unsigned mycnt = 0u;
#pragma unroll
    for (int n = 0; n < 15; ++n) if (n < j) { const unsigned long long bal = __ballot((mask >> n) & 1u); mycnt = (F.lane == n) ? (unsigned)__popcll(bal) : mycnt; }
    unsigned mybase = 0u;
    if (F.lane < 15 && mycnt > 0u && !DRY) mybase = atomicAdd(acnt + F.lane, mycnt);
#pragma unroll
    for (int n = 0; n < 15; ++n) if (n < j) {
        const bool sel = (mask >> n) & 1u; const int slot = (pk[0] == n) ? 0 : ((pk[1] == n) ? 1 : 2);
        const unsigned long long bal = __ballot(sel);
        if (bal) { const unsigned base = (unsigned)__builtin_amdgcn_readlane((int)mybase, n);
            const int rank = __popcll(bal & ((1ull << F.lane) - 1ull));
            if (sel) (DRY ? (int*)(F.ws + WS_OPART) : alist)[n * ALIST_CAP + base + rank] = t | (slot << 16); }
    }
}

constexpr int AL_K = 0, AL_V = 36864; constexpr float SC_P = 4.f;
typedef int i32x8v __attribute__((ext_vector_type(8)));
__device__ __forceinline__ i32x8v ld32(const LAS unsigned char* p) { const u32x4 a = *(const LAS u32x4*)p, b = *(const LAS u32x4*)(p + 16); i32x8v r; r[0] = a.x; r[1] = a.y; r[2] = a.z; r[3] = a.w; r[4] = b.x; r[5] = b.y; r[6] = b.z; r[7] = b.w; return r; }
template <bool OWN> __device__ __forceinline__ void attn_chunk(Frame& F, int b, int h, int n, int c, int cnt, const int* lst) {
    const int lane = F.lane, qi = lane & 31, hh = lane >> 5, w = F.wave;
    const int rem = OWN ? MBLK : cnt - c * 256;
    if (w * 32 >= rem) return;
    int t, slot; bool valid = true;
    if (OWN) { t = n * MBLK + w * 32 + qi; slot = 3; }
    else { const int idx = w * 32 + qi; valid = idx < rem; const int e = lst[c * 256 + (valid ? idx : 0)]; t = e & 0xffff; slot = e >> 16; }
    const size_t tok = (size_t)b * T + t;
    const unsigned char* qrow = F.ws + WS_Q + tok * D + h * HD;
    i32x8v qf[2];
#pragma unroll
    for (int ks = 0; ks < 2; ++ks) { const u32x4 a = *(const u32x4*)(qrow + 64 * ks + 32 * hh), bq = *(const u32x4*)(qrow + 64 * ks + 32 * hh + 16);
        qf[ks][0] = a.x; qf[ks][1] = a.y; qf[ks][2] = a.z; qf[ks][3] = a.w; qf[ks][4] = bq.x; qf[ks][5] = bq.y; qf[ks][6] = bq.z; qf[ks][7] = bq.w; }
    const LAS unsigned char* Kl = F.lds + AL_K; const LAS unsigned char* Vl = F.lds + AL_V;
    f32x16 oacc[4];
#pragma unroll
    for (int dt = 0; dt < 4; ++dt)
#pragma unroll
        for (int r = 0; r < 16; ++r) oacc[dt][r] = 0.f;
    float lsum = 0.f, mrun = -1e30f;
    const float c2 = 0.08838834764831845f * 1.4426950408889634f / (SC_QKV * SC_QKV);
    const int ngrp = OWN ? ((w >> 1) + 1) : 4;
#pragma unroll
    for (int G = 0; G < 4; ++G) {
        if (G >= ngrp) break;
        f32x16 sa, sb;
#pragma unroll
        for (int r = 0; r < 16; ++r) { sa[r] = 0.f; sb[r] = 0.f; }
#pragma unroll
        for (int ks = 0; ks < 2; ++ks) {
            const i32x8v ka = ld32(Kl + (64 * G + qi) * 144 + 64 * ks + 32 * hh), kb = ld32(Kl + (64 * G + 32 + qi) * 144 + 64 * ks + 32 * hh);
            sa = __builtin_amdgcn_mfma_scale_f32_32x32x64_f8f6f4(ka, qf[ks], sa, 0, 0, 0, 0, 0, 0);
            sb = __builtin_amdgcn_mfma_scale_f32_32x32x64_f8f6f4(kb, qf[ks], sb, 0, 0, 0, 0, 0, 0);
        }
        float tv[32];
#pragma unroll
        for (int r = 0; r < 16; ++r) { tv[r] = sa[r]; tv[16 + r] = sb[r]; }
        if (OWN && G == (w >> 1)) {
#pragma unroll
            for (int p = 0; p < 32; ++p) { const int key = 64 * G + 32 * (p >> 4) + (p & 3) + 8 * ((p >> 2) & 3) + 4 * hh; tv[p] = (key <= w * 32 + qi) ? tv[p] : -3e38f; }
        }
        float ml = tv[0];
#pragma unroll
        for (int p = 1; p < 32; ++p) ml = fmaxf(ml, tv[p]);
        ml = fmaxf(ml, __shfl_xor(ml, 32)) * c2;
        const float mnew = (ml > mrun + 6.0f) ? ml : mrun;
        const bool moved = (mnew != mrun);
        const float alpha = __builtin_amdgcn_exp2f(mrun - mnew);
        mrun = mnew;
        float ps = 0.f; i32x8v pf;
#pragma unroll
        for (int q4 = 0; q4 < 8; ++q4) { float e4[4];
#pragma unroll
            for (int j = 0; j < 4; ++j) { e4[j] = __builtin_amdgcn_exp2f(__builtin_fmaf(tv[4 * q4 + j], c2, -mnew)); ps += e4[j]; }
            int pw_ = __builtin_amdgcn_cvt_pk_fp8_f32(e4[0] * SC_P, e4[1] * SC_P, 0, false); pw_ = __builtin_amdgcn_cvt_pk_fp8_f32(e4[2] * SC_P, e4[3] * SC_P, pw_, true); pf[q4] = pw_; }
        lsum = lsum * alpha + ps;
        if (G > 0 && __any(moved)) {
#pragma unroll
            for (int dt = 0; dt < 4; ++dt)
#pragma unroll
                for (int r = 0; r < 16; ++r) oacc[dt][r] *= alpha;
        }
#pragma unroll
        for (int dt = 0; dt < 4; ++dt) {
            const i32x8v vf = ld32(Vl + (32 * dt + qi) * 272 + 64 * G + 32 * hh);
            oacc[dt] = __builtin_amdgcn_mfma_scale_f32_32x32x64_f8f6f4(vf, pf, oacc[dt], 0, 0, 0, 0, 0, 0);
        }
    }
    lsum += __shfl_xor(lsum, 32);
    if (valid) {
        unsigned char* op = F.ws + WS_OPART + ((size_t)slot * M + tok) * D + h * HD;
        const float pinv = __builtin_amdgcn_rcpf(lsum) * (SC_PART / (SC_QKV * SC_P));
        unsigned wq[4][4];
#pragma unroll
        for (int dt = 0; dt < 4; ++dt)
#pragma unroll
            for (int g4 = 0; g4 < 4; ++g4) wq[dt][g4] = pk4_fp8(oacc[dt][4 * g4 + 0] * pinv, oacc[dt][4 * g4 + 1] * pinv, oacc[dt][4 * g4 + 2] * pinv, oacc[dt][4 * g4 + 3] * pinv);
        u32x4 st[4];
#pragma unroll
        for (int d2 = 0; d2 < 2; ++d2)
#pragma unroll
            for (int g4 = 0; g4 < 4; ++g4) { const unsigned give = hh ? wq[d2][g4] : wq[2 + d2][g4], keep = hh ? wq[2 + d2][g4] : wq[d2][g4];
                const unsigned got = (unsigned)__shfl_xor((int)give, 32);
                const unsigned w_even = hh ? got : keep, w_odd = hh ? keep : got;
                st[2 * d2 + (g4 >> 1)][2 * (g4 & 1)] = w_even; st[2 * d2 + (g4 >> 1)][2 * (g4 & 1) + 1] = w_odd; }
#pragma unroll
        for (int q = 0; q < 4; ++q) *(u32x4*)(op + 64 * hh + 16 * q) = st[q];
        if (hh == 0) { f32x2 lm; lm.x = lsum; lm.y = mrun; ((f32x2*)(F.ws + WS_LPART))[((size_t)slot * M + tok) * H + h] = lm; }
    }
}
__device__ __forceinline__ void attn_group(Frame& F, int bh, int n) {
    const int b = bh >> 4, h = bh & 15;
    const gcptr Kg = opaque_s(F.ws + WS_K + ((size_t)b * T + n * MBLK) * D + h * HD);
    const gcptr Vg = opaque_s(F.ws + WS_V + ((size_t)b * T + n * MBLK) * D + h * HD);
    const int tg = make_tid(F.wave);
    __syncthreads();
#pragma unroll
    for (int i = 0; i < 4; ++i) { const int ch = tg + i * 512;
        { const int r = ch >> 3, cc = ch & 7; *(LAS u32x4*)(F.lds + AL_K + r * 144 + cc * 16) = *(const GAS u32x4*)(Kg + (unsigned)(r * D + cc * 16)); }
        { const int rl = ch & 63, cc = (ch >> 6) & 7, G = ch >> 9, r = 64 * G + rl;
          const u32x4 vv = *(const GAS u32x4*)(Vg + (unsigned)(r * D + cc * 16)); const unsigned vw[4] = {vv.x, vv.y, vv.z, vv.w};
          LAS unsigned char* vd = F.lds + AL_V + (16 * cc) * 272 + 64 * G + 32 * ((rl >> 2) & 1) + 4 * (rl >> 3) + (rl & 3);
#pragma unroll
          for (int e = 0; e < 16; ++e) vd[e * 272] = (unsigned char)(vw[e >> 2] >> (8 * (e & 3))); }
    }
    __syncthreads();
    attn_chunk<true>(F, b, h, n, 0, 0, nullptr);
    if (n < 15) {
        const int cnt = (int)__hip_atomic_load(F.ctl + CW_ACNT + bh * 16 + n, __ATOMIC_RELAXED, __HIP_MEMORY_SCOPE_AGENT);
        const int* lst = (const int*)(F.ws + WS_ALIST) + ((size_t)bh * 16 + n) * ALIST_CAP;
        for (int c = 0; c * 256 < cnt; ++c) attn_chunk<false>(F, b, h, n, c, cnt, lst);
    }
}
__device__ __forceinline__ void attn_combine_token(Frame& F, int tok) {
    const int j = (tok & (T - 1)) >> 8, nsl = j < 3 ? j : 3, hd = F.lane >> 2;
    f32x2 lm[4]; float mx = -1e30f;
#pragma unroll
    for (int s4 = 0; s4 < 4; ++s4) { const int s_ = (s4 == 0) ? 3 : s4 - 1; lm[s4] = (f32x2){0.f, -1e30f};
        if (s4 == 0 || s4 - 1 < nsl) { lm[s4] = ((const f32x2*)(F.ws + WS_LPART))[((size_t)s_ * M + tok) * H + hd]; mx = fmaxf(mx, lm[s4].y); } }
    float acc[32]; float l = 0.f;
#pragma unroll
    for (int i = 0; i < 32; ++i) acc[i] = 0.f;
#pragma unroll
    for (int s4 = 0; s4 < 4; ++s4) { const int s_ = (s4 == 0) ? 3 : s4 - 1;
        if (s4 == 0 || s4 - 1 < nsl) {
            const u32x4* p = (const u32x4*)(F.ws + WS_OPART + ((size_t)s_ * M + tok) * D + F.lane * 32);
            const float ls = lm[s4].x * __builtin_amdgcn_exp2f(lm[s4].y - mx);
            const u32x4 w0 = p[0], w1 = p[1]; const unsigned wd[8] = {w0.x, w0.y, w0.z, w0.w, w1.x, w1.y, w1.z, w1.w};
#pragma unroll
            for (int i = 0; i < 8; ++i) { const f32x2 lo = __builtin_amdgcn_cvt_pk_f32_fp8((int)wd[i], false), hi = __builtin_amdgcn_cvt_pk_f32_fp8((int)wd[i], true);
                acc[4 * i] += lo.x * ls; acc[4 * i + 1] += lo.y * ls; acc[4 * i + 2] += hi.x * ls; acc[4 * i + 3] += hi.y * ls; }
            l += ls; } }
    const float inv = __builtin_amdgcn_rcpf(l) * (1.0f / SC_PART);
    if (FP8_OUTB) { const float iv = inv * SC_OA; u32x4* o8 = (u32x4*)(F.ws + WS_OA + (size_t)tok * D + F.lane * 32);
#pragma unroll
        for (int i = 0; i < 2; ++i) { u32x4 w; w.x = pk4_fp8(acc[16 * i] * iv, acc[16 * i + 1] * iv, acc[16 * i + 2] * iv, acc[16 * i + 3] * iv); w.y = pk4_fp8(acc[16 * i + 4] * iv, acc[16 * i + 5] * iv, acc[16 * i + 6] * iv, acc[16 * i + 7] * iv);
            w.z = pk4_fp8(acc[16 * i + 8] * iv, acc[16 * i + 9] * iv, acc[16 * i + 10] * iv, acc[16 * i + 11] * iv); w.w = pk4_fp8(acc[16 * i + 12] * iv, acc[16 * i + 13] * iv, acc[16 * i + 14] * iv, acc[16 * i + 15] * iv); o8[i] = w; }
        return; }
    u32x4* o = (u32x4*)((bf16*)(F.ws + WS_OA) + (size_t)tok * D + F.lane * 32);
#pragma unroll
    for (int i = 0; i < 4; ++i) { u32x4 w; w.x = pk2(acc[8 * i] * inv, acc[8 * i + 1] * inv); w.y = pk2(acc[8 * i + 2] * inv, acc[8 * i + 3] * inv); w.z = pk2(acc[8 * i + 4] * inv, acc[8 * i + 5] * inv); w.w = pk2(acc[8 * i + 6] * inv, acc[8 * i + 7] * inv); o[i] = w; }
}
constexpr size_t WS_SLOC = WS_ORAW;
constexpr size_t WS_DLOG = WS_ORAW + 16 * MiB;
constexpr int HL_A = 0, HL_BM = 17408, HL_BMT = 34816, HL_VT = 53248, HL_SPT = 71680, HL_P = 106496, HL_EGR = 115712, HL_EEND = 116224, HL_QSUM = 116736, HL_SSQ = 118784,
              HL_STQ = HL_SPT, HL_STK = HL_SPT + 17408, HL_STG = 119808, HL_STV = 119808 + 17408;
#define HG_BAR() do { asm volatile("s_waitcnt lgkmcnt(0)" ::: "memory"); __builtin_amdgcn_s_barrier(); asm volatile("" ::: "memory"); } while (0)
template <bool FULL> __device__ __forceinline__ void hgrn_item(Frame& F, CArgs& a, int item) {
    const int bh = item >> 2, seg = item & 3, b = bh >> 4, h = bh & 15;
    if (!FULL && seg == 3) return;
    const int lane = F.lane, qi = lane & 31, hh = lane >> 5, w = F.wave;
    const int kk = F.tid & 127, tq = F.tid >> 7;
    const int vt = w & 3, ktb = 2 * (w >> 2);
    const bf16* Zq = (const bf16*)(F.ws + WS_ZQ); const bf16* Zk = (const bf16*)(F.ws + WS_ZK); const _Float16* Zg = (const _Float16*)(F.ws + WS_ZG); const bf16* Zv = (const bf16*)(F.ws + WS_ZV);
    LAS unsigned char* L = F.lds;
    LAS float* eGr = (LAS float*)(L + HL_EGR); LAS float* eEnd = (LAS float*)(L + HL_EEND); LAS float* qsum = (LAS float*)(L + HL_QSUM); LAS float* ssq = (LAS float*)(L + HL_SSQ);
    f32x16 S[2];
#pragma unroll
    for (int i = 0; i < 2; ++i)
#pragma unroll
        for (int r = 0; r < 16; ++r) S[i][r] = 0.f;
    if (FULL && seg > 0) {
        const float* sl = (const float*)(F.ws + WS_SLOC) + (size_t)bh * 3 * HD * HD; const float* dl = (const float*)(F.ws + WS_DLOG) + (size_t)bh * 3 * HD;
        LAS float* tile = (LAS float*)L; LAS float* fac = (LAS float*)(L + 65536);
        float dsum = 0.f;
        for (int s_ = seg - 1; s_ >= 0; --s_) {
            __syncthreads();
            const f32x4* src = (const f32x4*)(sl + (size_t)s_ * HD * HD);
#pragma unroll
            for (int i = 0; i < 8; ++i) ((LAS f32x4*)tile)[F.tid + i * 512] = src[F.tid + i * 512];
            if (F.tid < 128) { fac[F.tid] = __expf(dsum); dsum += dl[s_ * HD + F.tid]; }
            __syncthreads();
            const LAS float* tl = tile + (4 * hh) * HD + 32 * vt + qi; const LAS float* fl = fac + 4 * hh;
#pragma unroll
            for (int i = 0; i < 2; ++i)
#pragma unroll
                for (int r = 0; r < 16; ++r) { const int dkc = 32 * (ktb + i) + (r & 3) + 8 * (r >> 2); S[i][r] += fl[dkc] * tl[dkc * HD]; }
        }
    }
    float gtot = 0.f;
    u32x4 rq[2], rk[2], rg[2], rv[2];
#define HG_PREFETCH(cc) do { const size_t tk_ = (size_t)b * T + (size_t)(seg * 16 + (cc)) * 64; _Pragma("unroll") for (int i_ = 0; i_ < 2; ++i_) { const int row_ = 16 * (w >> 1) + (lane >> 3) + 8 * i_, ch_ = 8 * (w & 1) + (lane & 7); const size_t go_ = (tk_ + row_) * D + h * HD + ch_ * 8; \
        rk[i_] = *(const u32x4*)(Zk + go_); rg[i_] = *(const u32x4*)((const bf16*)Zg + go_); rv[i_] = *(const u32x4*)(Zv + go_); if (FULL) rq[i_] = *(const u32x4*)(Zq + go_); } } while (0)
    HG_PREFETCH(0);
    __syncthreads();
    for (int c = 0; c < 16; ++c) {
        const size_t tok0 = (size_t)b * T + (size_t)(seg * 16 + c) * 64;
#pragma unroll
        for (int i = 0; i < 2; ++i) { const int so = (16 * (w >> 1) + (lane >> 3) + 8 * i) * 272 + (8 * (w & 1) + (lane & 7)) * 16;
            *(LAS u32x4*)(L + HL_STK + so) = rk[i]; *(LAS u32x4*)(L + HL_STG + so) = rg[i]; *(LAS u32x4*)(L + HL_STV + so) = rv[i]; if (FULL) *(LAS u32x4*)(L + HL_STQ + so) = rq[i]; }
        LDS_WAIT();
        float gl[16];
        { float run = 0.f;
#pragma unroll
            for (int i = 0; i < 16; ++i) { run += (float)*(const LAS _Float16*)(L + HL_STG + (16 * tq + i) * 272 + kk * 2); gl[i] = run; }
            qsum[tq * 128 + kk] = run; }
        HG_BAR();
        {
            const float q0 = qsum[kk], q1 = qsum[128 + kk], q2 = qsum[256 + kk], q3 = qsum[384 + kk];
            const float pre = (tq > 0 ? q0 : 0.f) + (tq > 1 ? q1 : 0.f) + (tq > 2 ? q2 : 0.f), Gr = q0 + q1, Gend = (q0 + q1) + (q2 + q3);
            unsigned bt[8], vtw[8];
#pragma unroll
            for (int i = 0; i < 16; i += 2) {
                const int t0 = 16 * tq + i;
                const float G0 = pre + gl[i], G1 = pre + gl[i + 1];
                const float eb0 = __expf(Gr - G0), eb1 = __expf(Gr - G1);
                const float b0 = bf2f(*(const LAS bf16*)(L + HL_STK + t0 * 272 + kk * 2)) * eb0, b1 = bf2f(*(const LAS bf16*)(L + HL_STK + (t0 + 1) * 272 + kk * 2)) * eb1;
                bt[i >> 1] = pk2(b0, b1);
                vtw[i >> 1] = (unsigned)*(const LAS bf16*)(L + HL_STV + t0 * 272 + kk * 2) | ((unsigned)*(const LAS bf16*)(L + HL_STV + (t0 + 1) * 272 + kk * 2) << 16);
                if (FULL) { const float ea0 = __expf(G0 - Gr), ea1 = __expf(G1 - Gr);
                    const float qa = bf2f(*(const LAS bf16*)(L + HL_STQ + t0 * 272 + kk * 2)), qb = bf2f(*(const LAS bf16*)(L + HL_STQ + (t0 + 1) * 272 + kk * 2));
                    *(LAS bf16*)(L + HL_A + t0 * 272 + kk * 2) = (bf16)f2bf(qa * ea0); *(LAS bf16*)(L + HL_A + (t0 + 1) * 272 + kk * 2) = (bf16)f2bf(qb * ea1);
                    *(LAS bf16*)(L + HL_BM + t0 * 272 + kk * 2) = (bf16)(bt[i >> 1] & 0xffffu); *(LAS bf16*)(L + HL_BM + (t0 + 1) * 272 + kk * 2) = (bf16)(bt[i >> 1] >> 16); }
                __builtin_amdgcn_sched_barrier(0);
            }
            *(LAS u32x4*)(L + HL_BMT + kk * 144 + tq * 32) = (u32x4){bt[0], bt[1], bt[2], bt[3]}; *(LAS u32x4*)(L + HL_BMT + kk * 144 + tq * 32 + 16) = (u32x4){bt[4], bt[5], bt[6], bt[7]};
            *(LAS u32x4*)(L + HL_VT + kk * 144 + tq * 32) = (u32x4){vtw[0], vtw[1], vtw[2], vtw[3]}; *(LAS u32x4*)(L + HL_VT + kk * 144 + tq * 32 + 16) = (u32x4){vtw[4], vtw[5], vtw[6], vtw[7]};
            if (tq == 0) { eGr[kk] = __expf(Gr); eEnd[kk] = __expf(Gend - Gr); }
            gtot += Gend;
        }
        HG_BAR();
        if (c + 1 < 16) HG_PREFETCH(c + 1);
#pragma unroll
        for (int i = 0; i < 2; ++i)
#pragma unroll
            for (int g4 = 0; g4 < 4; ++g4) { const int dk0 = 32 * (ktb + i) + 8 * g4 + 4 * hh; const f32x4 e = *(const LAS f32x4*)(eGr + dk0);
#pragma unroll
                for (int j = 0; j < 4; ++j) S[i][4 * g4 + j] *= e[j];
                if (FULL) { u32x2 wv; wv.x = pg8::cvt_pk_bf16_n(S[i][4 * g4], S[i][4 * g4 + 1]); wv.y = pg8::cvt_pk_bf16_n(S[i][4 * g4 + 2], S[i][4 * g4 + 3]);
                    *(LAS u32x2*)(L + HL_SPT + (32 * vt + qi) * 272 + dk0 * 2) = wv; } }
        if (FULL && w < 3) {
            const int st = (w == 2) ? 1 : 0, tt = (w == 0) ? 0 : 1;
            f32x16 sc;
#pragma unroll
            for (int r = 0; r < 16; ++r) sc[r] = 0.f;
#pragma unroll
            for (int ks = 0; ks < 8; ++ks) { const bf16x8 af = *(const LAS bf16x8*)(L + HL_BM + (32 * st + qi) * 272 + (16 * ks + 8 * hh) * 2); const bf16x8 bfr = *(const LAS bf16x8*)(L + HL_A + (32 * tt + qi) * 272 + (16 * ks + 8 * hh) * 2);
                sc = __builtin_amdgcn_mfma_f32_32x32x16_bf16(af, bfr, sc, 0, 0, 0); }
#pragma unroll
            for (int g4 = 0; g4 < 4; ++g4) { const int s0 = 32 * st + 8 * g4 + 4 * hh, t = 32 * tt + qi; float p[4];
#pragma unroll
                for (int j = 0; j < 4; ++j) p[j] = sc[4 * g4 + j] * __builtin_amdgcn_fmed3f((float)(t - (s0 + j) + 1), 0.f, 1.f);
                u32x2 wv; wv.x = pg8::cvt_pk_bf16_n(p[0], p[1]); wv.y = pg8::cvt_pk_bf16_n(p[2], p[3]);
                *(LAS u32x2*)(L + HL_P + t * 144 + s0 * 2) = wv; }
        }
#pragma unroll
        for (int ks2 = 0; ks2 < 4; ++ks2) { const bf16x8 vf = *(const LAS bf16x8*)(L + HL_VT + (32 * vt + qi) * 144 + (16 * ks2 + 8 * hh) * 2);
#pragma unroll
            for (int i = 0; i < 2; ++i) { const bf16x8 bf_ = *(const LAS bf16x8*)(L + HL_BMT + (32 * (ktb + i) + qi) * 144 + (16 * ks2 + 8 * hh) * 2);
                S[i] = __builtin_amdgcn_mfma_f32_32x32x16_bf16(bf_, vf, S[i], 0, 0, 0); } }
#pragma unroll
        for (int i = 0; i < 2; ++i)
#pragma unroll
            for (int g4 = 0; g4 < 4; ++g4) { const int dk0 = 32 * (ktb + i) + 8 * g4 + 4 * hh; const f32x4 e = *(const LAS f32x4*)(eEnd + dk0);
#pragma unroll
                for (int j = 0; j < 4; ++j) S[i][4 * g4 + j] *= e[j]; }
        if (FULL) {
            HG_BAR();
            const int tt = w & 1, dt = w >> 1, t = 32 * tt + qi;
            f32x16 o;
#pragma unroll
            for (int r = 0; r < 16; ++r) o[r] = 0.f;
#pragma unroll
            for (int ks = 0; ks < 8; ++ks) { const bf16x8 af = *(const LAS bf16x8*)(L + HL_SPT + (32 * dt + qi) * 272 + (16 * ks + 8 * hh) * 2); const bf16x8 bfr = *(const LAS bf16x8*)(L + HL_A + t * 272 + (16 * ks + 8 * hh) * 2);
                o = __builtin_amdgcn_mfma_f32_32x32x16_bf16(af, bfr, o, 0, 0, 0); }
#pragma unroll
            for (int ks2 = 0; ks2 < 4; ++ks2) if (ks2 < 2 * (tt + 1)) { const bf16x8 af = *(const LAS bf16x8*)(L + HL_VT + (32 * dt + qi) * 144 + (16 * ks2 + 8 * hh) * 2); const bf16x8 bfr = *(const LAS bf16x8*)(L + HL_P + t * 144 + (16 * ks2 + 8 * hh) * 2);
                o = __builtin_amdgcn_mfma_f32_32x32x16_bf16(af, bfr, o, 0, 0, 0); }
            float sq = 0.f;
#pragma unroll
            for (int r = 0; r < 16; ++r) sq += o[r] * o[r];
            sq += __shfl_xor(sq, 32);
            if (hh == 0) ssq[dt * 64 + t] = sq;
            HG_BAR();
            const float tot = (ssq[t] + ssq[64 + t]) + (ssq[128 + t] + ssq[192 + t]);
            const float rstd = __builtin_amdgcn_rsqf(tot * (1.f / HD) + RMS_EPS);
            const size_t ro = (tok0 + t) * D + h * HD;
#pragma unroll
            for (int g4 = 0; g4 < 4; ++g4) { const int dv0 = 32 * dt + 8 * g4 + 4 * hh;
                const u32x2 gt = *(const u32x2*)((const bf16*)(F.ws + WS_ZGATE) + ro + dv0); const f32x4 gn = *(const f32x4*)(a.in[I_A_OGAIN] + dv0);
                u32x2 wv; wv.x = pg8::cvt_pk_bf16_n(o[4 * g4] * rstd * gn.x * bflo(gt.x), o[4 * g4 + 1] * rstd * gn.y * bfhi(gt.x)); wv.y = pg8::cvt_pk_bf16_n(o[4 * g4 + 2] * rstd * gn.z * bflo(gt.y), o[4 * g4 + 3] * rstd * gn.w * bfhi(gt.y));
                *(u32x2*)((bf16*)(F.ws + WS_OH) + ro + dv0) = wv; }
        }
    }
#undef HG_PREFETCH
    if (!FULL) {
        float* sl = (float*)(F.ws + WS_SLOC) + ((size_t)bh * 3 + seg) * HD * HD;
#pragma unroll
        for (int i = 0; i < 2; ++i)
#pragma unroll
            for (int r = 0; r < 16; ++r) { const int dk = 32 * (ktb + i) + (r & 3) + 8 * (r >> 2) + 4 * hh; sl[(size_t)dk * HD + 32 * vt + qi] = S[i][r]; }
        if (tq == 0) ((float*)(F.ws + WS_DLOG))[((size_t)bh * 3 + seg) * HD + kk] = gtot;
    }
    __syncthreads();
}

constexpr int N_PHASES = 19;
#ifndef REP_MASK
#define REP_MASK 0
#endif
#define NREP(k) ((((REP_MASK) >> (k)) & 1) ? 2 : 1)
__global__ void __launch_bounds__(NTHR, 2) fwd(Args args_kernarg) {
    extern __shared__ __attribute__((aligned(16))) unsigned char lds_raw[];
    Frame F;
    CArgs* pa = (CArgs*)__builtin_amdgcn_kernarg_segment_ptr();
#define args (*pa)
    F.lds = (LAS unsigned char*)lds_raw; F.ws = args.ws; F.ctl = (unsigned*)(args.ws + WS_CTL);
    F.wave = __builtin_amdgcn_readfirstlane((int)threadIdx.x >> 6); F.tid = make_tid(F.wave); F.lane = F.tid & 63;
    F.G = gridDim.x; { const int bx = blockIdx.x; F.vcu = (F.G % 8 == 0) ? (bx % 8) * (F.G / 8) + bx / 8 : bx; }
    F.gw = F.vcu * NWAVES + F.wave; F.NGW = F.G * NWAVES;
    for (int u = F.tid; u < (LDS_BYTES - LDSCTL_OFF) / 4; u += NTHR) ((LAS unsigned*)(F.lds + LDSCTL_OFF))[u] = 0u;
    __syncthreads();
    const int lo = args.ph_lo, hi = args.ph_hi;
    const bool multi = (hi - lo) > 1;
    XcdBarrier bar; bar.bar = F.ctl + CW_BAR; bar.x = 0; bar.st = nullptr;
    if (multi) bar = xcd_barrier_post(F.ctl + CW_BAR, (volatile LAS unsigned*)(F.lds + LDSCTL_OFF), F.tid);
#define REFRESH() do { pa = (CArgs*)__builtin_amdgcn_kernarg_segment_ptr(); asm volatile("" : "+s"(pa)); ws = args.ws; F.ws = ws; F.ctl = (unsigned*)(ws + WS_CTL); const int t_ = make_tid(F.wave); F.tid = t_; F.lane = t_ & 63; F.gw = F.vcu * NWAVES + F.wave; } while (0)
#define IN(k) (lo <= (k) && (k) < hi)
#define SEAM(k) do { if (IN(k) && IN((k) + 1)) xcd_barrier(bar, make_tid(F.wave)); } while (0)
    unsigned char* ws = args.ws;
    (void)args_kernarg;
    const int GT = F.NGW * 64;

    if (IN(0)) _Pragma("unroll") for (int rep_ = 0; rep_ < NREP(0); ++rep_) { REFRESH();
        const int gtid = F.gw * 64 + F.lane;
        LAS float* scr = (LAS float*)(F.lds + F.wave * TR_SCR_BYTES);
        constexpr int J0 = 16 * 256;
        tr_run([&](int it) { TrItem t; t.src = args.in[I_A_W_IN]; t.ksc = args.in[I_NORM_MIX]; t.dst = ws + WS_WIN; t.N = 4 * D; t.K = D; t.k0 = 128 * (it / 256); t.n0 = 32 * (it % 256); t.drow0 = t.n0; t.flags = 0; t.osc = 1.f; return t; },
               F.gw, J0, F.NGW, scr, F.lane);
        for (int c = gtid; c < D; c += GT) { const float* L = args.in[I_A_LB]; const float l0 = L[c], l1 = L[D + c], l2 = L[2 * D + c]; const float mx = fmaxf(l0, fmaxf(l1, l2));
            const float e0 = expf(l0 - mx), e1 = expf(l1 - mx), e2 = expf(l2 - mx); ((float*)(ws + WS_LB))[c] = e0 / (e0 + e1 + e2); }
        for (int i = gtid; i < 2 * 36 * D; i += GT) { const int l = i / (36 * D), r = (i / D) % 36, k = i % D;
            ((float*)(ws + WS_RT))[i] = r < 4 ? args.in[I_W_GROUP][((size_t)l * D + k) * NG + r] : args.in[I_W_EXPERT][((size_t)l * D + k) * NE + (r - 4)]; }
        { const int fi = gtid & 63; const float inv = exp2f(-(float)fi * (13.287712379549449f / 64.0f));
          for (int i = gtid; i < T * 64; i += GT) { const float ang = (float)(i >> 6) * inv; float sn_, cs_; sincosf(ang, &sn_, &cs_); ((f32x2*)(ws + WS_ROPE))[i] = (f32x2){cs_, sn_}; } }
        for (int m = F.gw; m < M; m += F.NGW) rms_row_to_bf16(args.in[I_X] + (size_t)m * D, (bf16*)(ws + WS_XN) + (size_t)m * D, F.lane);
    }
    SEAM(0);
    if (IN(1)) _Pragma("unroll") for (int rep_ = 0; rep_ < NREP(1); ++rep_) { REFRESH();
        constexpr int NCV = 112, J1 = 16 * 64, J2 = 16 * 128, J3 = 16 * 64, J4 = 16 * 64, J5 = MOE_CV_ITEMS;
        if ((int)blockIdx.x < NCV) {
            LAS float* scr = (LAS float*)(F.lds + F.wave * TR_SCR_BYTES);
            tr_run([&](int r) { TrItem t; t.osc = 1.f; t.ksc = nullptr; t.flags = 0; t.N = D; t.K = D;
                    if (r < J1) { t.src = args.in[I_A_W_OUT]; t.dst = ws + WS_WOA; t.k0 = 128 * (r / 64); t.n0 = 32 * (r % 64); t.drow0 = t.n0; return t; } r -= J1;
                    if (r < J2) { const int nb = r % 128; t.src = args.in[I_KV_W]; t.ksc = args.in[I_KV_NORM]; t.dst = ws + WS_WQKV; t.N = 2 * D; t.k0 = 128 * (r / 128); t.n0 = 32 * nb; t.drow0 = D + t.n0;
                                  t.flags = (FP8_QKV ? 2 : 0) | (nb < 64 ? 1 : 0); t.osc = FP8_QKV ? SC_W : 1.f; return t; } r -= J2;
                    if (r < J3) { t.src = args.in[I_B_W_Q]; t.ksc = args.in[I_NORM_MIX] + D; t.dst = ws + WS_WQKV; t.k0 = 128 * (r / 64); t.n0 = 32 * (r % 64); t.drow0 = t.n0; t.flags = (FP8_QKV ? 2 : 0) | 1; t.osc = FP8_QKV ? SC_W : 1.f; return t; } r -= J3;
                    if (r < J4) { t.src = args.in[I_B_W_OUT]; t.dst = ws + WS_WOB; t.k0 = 128 * (r / 64); t.n0 = 32 * (r % 64); t.drow0 = t.n0; t.flags = FP8_OUTB ? 2 : 0; t.osc = FP8_OUTB ? SC_W : 1.f; return t; } r -= J4;
                    return moe_cv_item(args, ws, 0, r); },
                   (int)blockIdx.x * NWAVES + F.wave, J1 + J2 + J3 + J4 + J5, NCV * NWAVES, scr, F.lane);
            __syncthreads();
        }
        pg8::DynOrder S; S.init(ws + WS_XN, ws + WS_WIN, M, 4 * D, D, F.wave, F.ctl + CW_DYN, (LAS int*)(F.lds + LDSCTL_OFF + 32));
        pg8::EpiHgrnIn E{ws + WS_R, (const float*)(ws + WS_LB)};
        pg8::gemm_phase<pg8::EpiHgrnIn, pg8::DynOrder, true>(F.lds, S, E);
    }
    SEAM(1);
    if (IN(2)) _Pragma("unroll") for (int rep_ = 0; rep_ < NREP(2); ++rep_) { REFRESH(); for (int it = F.vcu; it < 256; it += F.G) hgrn_item<false>(F, args, it); }
    SEAM(2);
    if (IN(3)) _Pragma("unroll") for (int rep_ = 0; rep_ < NREP(3); ++rep_) { REFRESH(); for (int it = F.vcu; it < 256; it += F.G) hgrn_item<true>(F, args, it); }
    SEAM(3);
    if (IN(4)) _Pragma("unroll") for (int rep_ = 0; rep_ < NREP(4); ++rep_) { REFRESH();
        pg8::DenseOrder S; S.init(ws + WS_OH, ws + WS_WOA, M, D, D, F.G, (int)blockIdx.x, F.wave);
        pg8::EpiRes16<true> E{(bf16*)(ws + WS_XR), args.in[I_X], 1.0f};
        pg8::gemm_phase<pg8::EpiRes16<true>, pg8::DenseOrder, true>(F.lds, S, E);
    }
    SEAM(4);
#define MOE_LAYER(P, layer, F8, O8) \
    if (IN(P)) { REFRESH(); for (int t = F.gw; t < M; t += 2 * F.NGW) { if (t + F.NGW < M) route_pair<F8>(F, args, layer, t, t + F.NGW); else route_token<false, F8>(F, args, layer, t); } } \
    SEAM(P); \
    if (IN((P) + 1)) _Pragma("unroll") for (int rep_ = 0; rep_ < NREP((P) + 1); ++rep_) { REFRESH(); const int nrb = __builtin_amdgcn_readfirstlane(moe_tables(F, layer)); \
        pg8::MoeOrder<true> S; S.A = (const char*)(ws + WS_XN); S.B = (const char*)(ws + WS_WGU + (size_t)(layer) * WGU_LSTRIDE); S.estride = (size_t)1024 * D * (F8 ? 1 : 2); S.K = D; S.RB = F8 ? D : 2 * D; S.NT = 4; S.total = nrb * 4; S.G = F.G; S.c = F.vcu; S.wv = F.wave; \
        S.blk_e = (const LAS int*)(F.lds + LT_BLKE); S.blkstart = (const LAS int*)(F.lds + LT_BLKSTART); S.cnt = (const LAS int*)(F.lds + LT_CNT); S.list = (const int*)(ws + WS_LISTS); \
        pg8::EpiSwiGLU<F8> E{(bf16*)(ws + WS_ACT), F8 ? 1.0f / (SC_XN * SC_W) : 1.0f}; \
        pg8::gemm_phase<pg8::EpiSwiGLU<F8>, pg8::MoeOrder<true>, true, F8>(F.lds, S, E); } \
    SEAM((P) + 1); \
    if (IN((P) + 2)) _Pragma("unroll") for (int rep_ = 0; rep_ < NREP((P) + 2); ++rep_) { REFRESH(); const int nrb = __builtin_amdgcn_readfirstlane(moe_tables(F, layer)); \
        pg8::MoeOrder<false> S; S.A = (const char*)(ws + WS_ACT); S.B = (const char*)(ws + WS_WD + (size_t)(layer) * WD_LSTRIDE); S.estride = (size_t)D * FF * (F8 ? 1 : 2); S.K = FF; S.RB = F8 ? FF : 2 * FF; S.NT = 8; S.total = nrb * 8; S.G = F.G; S.c = F.vcu; S.wv = F.wave; \
        S.blk_e = (const LAS int*)(F.lds + LT_BLKE); S.blkstart = (const LAS int*)(F.lds + LT_BLKSTART); S.cnt = (const LAS int*)(F.lds + LT_CNT); S.list = (const int*)(ws + WS_LISTS); \
        if constexpr (O8) { pg8::EpiOut8 E{ws + WS_OUTB, D, (F8 ? 1.0f / (SC_ACT * SC_WD) : 1.0f) * SC_OUT}; pg8::gemm_phase<pg8::EpiOut8, pg8::MoeOrder<false>, true, F8>(F.lds, S, E); } \
        else { pg8::EpiBf16 E{(bf16*)(ws + WS_OUTB), D, 0, 0, F8 ? 1.0f / (SC_ACT * SC_WD) : 1.0f}; pg8::gemm_phase<pg8::EpiBf16, pg8::MoeOrder<false>, true, F8>(F.lds, S, E); } } \
    SEAM((P) + 2);
    MOE_LAYER(5, 0, FP8_MOE0, OUT8_L0)
    if (IN(8)) { REFRESH();
        (void)moe_tables(F, 0);
        combine_tokens<true>(F, args, F.gw, F.NGW);
    }
    SEAM(8);
    if (IN(9)) _Pragma("unroll") for (int rep_ = 0; rep_ < NREP(9); ++rep_) { REFRESH();
        constexpr int NCV2 = 112;
        if ((int)blockIdx.x < NCV2) {
            LAS float* scr = (LAS float*)(F.lds + F.wave * TR_SCR_BYTES);
            tr_run([&](int it) { return moe_cv_item(args, ws, 1, it); }, (int)blockIdx.x * NWAVES + F.wave, MOE_CV_ITEMS, NCV2 * NWAVES, scr, F.lane);
            __syncthreads();
        }
        pg8::DynOrder S; S.init(ws + WS_XN, ws + WS_WQKV, M, 3 * D, D, F.wave, F.ctl + CW_DYN + 64, (LAS int*)(F.lds + LDSCTL_OFF + 32), FP8_QKV);
        pg8::EpiQKV E{(bf16*)(ws + WS_Q), (bf16*)(ws + WS_K), (bf16*)(ws + WS_V), args.in[I_B_Q_NORM], args.in[I_K_NORM], (const f32x2*)(ws + WS_ROPE), (float*)(ws + WS_KMEAN), F.lds + 131072, FP8_QKV ? 1.0f / (SC_XN * SC_W) : 1.0f, F.wave};
        pg8::gemm_phase<pg8::EpiQKV, pg8::DynOrder, true, FP8_QKV>(F.lds, S, E);
    }
    SEAM(9);
    if (IN(11)) { REFRESH(); if (NREP(11) == 2) { for (int it = F.vcu; it < 64 * 8; it += F.G) moba_gate_item<true>(F, it); } for (int it = F.vcu; it < 64 * 8; it += F.G) moba_gate_item<false>(F, it); }
    SEAM(11);
    if (IN(12)) _Pragma("unroll") for (int rep_ = 0; rep_ < NREP(12); ++rep_) { REFRESH();
        for (int v = F.vcu; v < 256; v += F.G) { const int bh = v >> 2, q = v & 3;
            _Pragma("unroll 1") for (int gi = 0; gi < 4; ++gi) { const int n = (gi == 0) ? q : ((gi == 1) ? 7 - q : ((gi == 2) ? 8 + q : 15 - q)); attn_group(F, bh, n); } }
    }
    SEAM(12);
    if (IN(13)) _Pragma("unroll") for (int rep_ = 0; rep_ < NREP(13); ++rep_) { REFRESH(); for (int t = F.gw; t < M; t += F.NGW) attn_combine_token(F, t); }
    SEAM(13);
    if (IN(14)) { REFRESH();
        pg8::DenseOrder S; S.init(ws + WS_OA, ws + WS_WOB, M, D, D, F.G, (int)blockIdx.x, F.wave, FP8_OUTB);
        pg8::EpiRes16<false> E{(bf16*)(ws + WS_XR), nullptr, FP8_OUTB ? 1.0f / (SC_OA * SC_W) : 1.0f};
        pg8::gemm_phase<pg8::EpiRes16<false>, pg8::DenseOrder, true, FP8_OUTB>(F.lds, S, E);
    }
    SEAM(14);
    MOE_LAYER(15, 1, FP8_MOE1, OUT8_L1)
    if (IN(18)) { REFRESH(); (void)moe_tables(F, 1); combine_tokens<false>(F, args, F.gw, F.NGW); }
#undef IN
#undef SEAM
#undef MOE_LAYER
#undef args
}

#ifndef MK_N_LAUNCHES
#define MK_N_LAUNCHES 1
#endif
#ifndef DBG_STOP
#define DBG_STOP N_PHASES
#endif
extern "C" void kernel_launch(void* const* d_in, const int* in_sizes, int n_in, void* d_out, int out_size, void* d_ws, size_t ws_size, hipStream_t stream) {
    static int grid = 0;
    if (grid == 0) {
        if (n_in != 20 || in_sizes[0] != M * D || out_size != M * D || ws_size < WS_END) { fprintf(stderr, "kernel_launch: unexpected shapes (n_in %d, in0 %d, out %d, ws %zu < %zu); nothing launched\n", n_in, n_in > 0 ? in_sizes[0] : -1, out_size, ws_size, (size_t)WS_END); grid = -1; return; }
        int dev = 0, cus = 0, per_cu = 0;
        if (hipGetDevice(&dev) != hipSuccess || hipDeviceGetAttribute(&cus, hipDeviceAttributeMultiprocessorCount, dev) != hipSuccess) { grid = -1; return; }
        if (hipFuncSetAttribute((const void*)fwd, hipFuncAttributeMaxDynamicSharedMemorySize, LDS_BYTES) != hipSuccess) { fprintf(stderr, "kernel_launch: hipFuncSetAttribute failed\n"); grid = -1; return; }
        if (hipOccupancyMaxActiveBlocksPerMultiprocessor(&per_cu, (const void*)fwd, NTHR, LDS_BYTES) != hipSuccess || per_cu < 1) { fprintf(stderr, "kernel_launch: occupancy query says %d blocks per CU\n", per_cu); }
        (void)hipGetLastError();
        grid = cus;
    }
    if (grid < 0) return;
    (void)hipMemsetAsync((char*)d_ws + WS_CTL, 0, CTL_ZERO_BYTES, stream);
    Args a{};
    for (int i = 0; i < 20; ++i) a.in[i] = (const float*)d_in[i];
    a.out = (float*)d_out; a.ws = (unsigned char*)d_ws;
    if (MK_N_LAUNCHES == 1) { a.ph_lo = 0; a.ph_hi = N_PHASES; hipLaunchKernelGGL(fwd, dim3(grid), dim3(NTHR), LDS_BYTES, stream, a); }
    else for (int p = 0; p < DBG_STOP; ++p) { a.ph_lo = p; a.ph_hi = p + 1; hipLaunchKernelGGL(fwd, dim3(grid), dim3(NTHR), LDS_BYTES, stream, a); }
}
```

```cpp
#include <hip/hip_runtime.h>
#include <cstdio>
#include <cstdint>

#define GAS __attribute__((address_space(1)))
#define LAS __attribute__((address_space(3)))
typedef unsigned short bf16;
typedef short bf16x8 __attribute__((ext_vector_type(8)));
typedef float f32x4 __attribute__((ext_vector_type(4)));
typedef float f32x2 __attribute__((ext_vector_type(2)));
typedef unsigned u32x4 __attribute__((ext_vector_type(4)));
typedef unsigned u32x2 __attribute__((ext_vector_type(2)));

constexpr int BATCH = 4, T = 4096, D = 2048, M = BATCH * T, H = 16, HD = 128;
constexpr int NBLK = 16, MBLK = 256;
constexpr int NG = 4, EPG = 8, NE = 32, FF = 512;
constexpr float RMS_EPS = 1e-6f;
constexpr int NWAVES = 8, NTHR = 512;
constexpr int LIST_CAP = 16384;
constexpr int MAXRB = 160;

constexpr size_t MiB = 1u << 20;
constexpr size_t WS_CTL = 0, CTL_ZERO_BYTES = 1 * MiB;
constexpr size_t WS_LISTS = 1 * MiB;
constexpr size_t WS_TOKREC = 3 * MiB;
constexpr size_t WS_LB = 4 * MiB;
constexpr size_t WS_RT = 4 * MiB + 65536;
constexpr size_t WS_ROPE = 5 * MiB;
constexpr size_t WS_KMEAN = 7 * MiB;
constexpr size_t WS_WIN = 8 * MiB, WS_WOA = 40 * MiB, WS_WQKV = 48 * MiB, WS_WOB = 72 * MiB;
constexpr size_t WS_WGU = 80 * MiB, WS_WD = 208 * MiB;
constexpr size_t WS_XN = 272 * MiB;
constexpr size_t WS_ACT = 336 * MiB;
constexpr size_t WS_R = 376 * MiB;
constexpr size_t WS_ZQ = WS_R, WS_ZK = WS_R + 64 * MiB, WS_ZG = WS_R + 128 * MiB, WS_ZV = WS_R + 192 * MiB, WS_ZGATE = WS_R + 256 * MiB;
constexpr size_t WS_ORAW = WS_R + 320 * MiB;
constexpr size_t WS_OH = WS_R + 448 * MiB;
constexpr size_t WS_OUTB = WS_R;
constexpr size_t WS_Q = WS_R, WS_K = WS_R + 64 * MiB, WS_V = WS_R + 128 * MiB, WS_VT = WS_R + 192 * MiB, WS_OA = WS_R + 256 * MiB;
constexpr size_t WS_XR = WS_R + 192 * MiB;
constexpr size_t WS_OPART = WS_R + 320 * MiB;
constexpr size_t WS_LPART = WS_R + 576 * MiB;
constexpr size_t WS_ALIST = WS_R + 584 * MiB;
constexpr int ALIST_CAP = 3840;
constexpr size_t WS_END = WS_R + 604 * MiB;
constexpr int CW_TMO = 0;
constexpr int CW_BAR = 4096;
constexpr int CW_CNT = 8192;
#define CW_CNT_AT(l, e) (CW_CNT + 2048 * (l) + 64 * (e))
constexpr int CW_ACNT = 16384;
constexpr int CW_DYN = 20480;

constexpr int RING_BYTES = 159744;
constexpr int LDSCTL_OFF = RING_BYTES;
constexpr int LT_BLKE = LDSCTL_OFF + 64;
constexpr int LT_BLKSTART = LT_BLKE + MAXRB * 4;
constexpr int LT_CNT = LT_BLKSTART + 36 * 4;
constexpr int LT_END = LT_CNT + 32 * 4;
constexpr int LDS_BYTES = 163840;
static_assert(LT_END <= LDS_BYTES, "LDS map");

__device__ __forceinline__ unsigned f2bf(float f) { unsigned u = __builtin_bit_cast(unsigned, f); return (u + 0x7fffu + ((u >> 16) & 1u)) >> 16; }
__device__ __forceinline__ unsigned pk2(float lo, float hi) { return f2bf(lo) | (f2bf(hi) << 16); }
__device__ __forceinline__ float bf2f(unsigned b) { return __builtin_bit_cast(float, b << 16); }
__device__ __forceinline__ float bflo(unsigned w) { return __builtin_bit_cast(float, w << 16); }
__device__ __forceinline__ float bfhi(unsigned w) { return __builtin_bit_cast(float, w & 0xffff0000u); }
__device__ __forceinline__ float wave_sum(float v) {
#pragma unroll
    for (int o = 1; o < 64; o <<= 1) v += __shfl_xor(v, o);
    return v;
}
#ifndef FP8_QKV
#define FP8_QKV 1
#endif
#ifndef FP8_OUTB
#define FP8_OUTB 1
#endif
#ifndef FP8_MOE1
#define FP8_MOE1 1
#endif
#ifndef FP8_MOE0
#define FP8_MOE0 1
#endif
#ifndef OUT8_L0
#define OUT8_L0 1
#endif
#ifndef OUT8_L1
#define OUT8_L1 1
#endif
constexpr float SC_XN = 16.f, SC_W = 1024.f, SC_ACT = 8.f, SC_WD = 512.f, SC_OA = 64.f, SC_PART = 64.f, SC_OUT = 32.f, SC_QKV = 32.f;
__device__ __forceinline__ unsigned pk4_fp8(float a, float b, float c, float d) {
    a = __builtin_amdgcn_fmed3f(a, -448.f, 448.f); b = __builtin_amdgcn_fmed3f(b, -448.f, 448.f); c = __builtin_amdgcn_fmed3f(c, -448.f, 448.f); d = __builtin_amdgcn_fmed3f(d, -448.f, 448.f);
    int p = __builtin_amdgcn_cvt_pk_fp8_f32(a, b, 0, false); p = __builtin_amdgcn_cvt_pk_fp8_f32(c, d, p, true); return (unsigned)p; }
__device__ __forceinline__ int lane_id() { int l; asm volatile("v_mbcnt_lo_u32_b32 %0, -1, 0\n\tv_mbcnt_hi_u32_b32 %0, -1, %0" : "=v"(l)); return l; }
__device__ __forceinline__ int make_tid(int wv) { return wv * 64 + lane_id(); }
__device__ __forceinline__ void fp8x4_to_f32(unsigned w, float (&o)[4]) { const f32x2 lo = __builtin_amdgcn_cvt_pk_f32_fp8((int)w, false), hi = __builtin_amdgcn_cvt_pk_f32_fp8((int)w, true); o[0] = lo.x; o[1] = lo.y; o[2] = hi.x; o[3] = hi.y; }
#define LDS_WAIT() asm volatile("s_waitcnt lgkmcnt(0)" ::: "memory")
#define VM_WAIT() asm volatile("s_waitcnt vmcnt(0)" ::: "memory")

namespace pg8 {
constexpr int BM = 256, BK = 64, HALF = 128, HTB = HALF * BK * 2, STAGE_BYTES = 8 * HTB, NXCD = 8, WGM = 8;
__host__ __device__ __forceinline__ int lds_byte(int r, int c) { const int st = (r >> 4) * 2 + (c >> 5), rr = r & 15, cc = c & 31, ob = rr * 64 + cc * 2; return st * 1024 + (ob ^ (((ob >> 9) & 1) << 5)); }
__host__ __device__ __forceinline__ void stage_rc(int b, int& R, int& C) { const int st = b / 1024, sb = b % 1024, swz = sb ^ (((sb >> 9) & 1) << 5); R = (st >> 1) * 16 + swz / 64; C = (st & 1) * 32 + (swz % 64) / 2; }
__host__ __device__ __forceinline__ int perm32(int rho) { const int n = rho >> 4, i = rho & 15; return 8 * (i >> 2) + 4 * n + (i & 3); }

struct Unit { int pm, pn; const char* a; const char* b; int e0, lbase, cnt; };

struct DenseOrder {
    static constexpr bool GATHER = false, DYNAMIC = false;
    const char* A; const char* B; int K, RB; int nM, nN, nwg, G, c, wv;
    __device__ void init(const void* A_, const void* B_, int M_, int N_, int K_, int G_, int c_, int wv_, bool fp8 = false) { wv = wv_; A = (const char*)A_; B = (const char*)B_; K = K_; RB = fp8 ? K_ : 2 * K_; nM = M_ / BM; nN = N_ / BM; nwg = nM * nN; G = G_; c = c_; }
    __device__ __forceinline__ bool next(int i, Unit& u) const {
        const int L = i * G + c; if (L >= nwg) return false;
        int wgid = (int)L; { const int q = nwg / NXCD, r = nwg % NXCD, xcd = wgid % NXCD, off = wgid / NXCD; wgid = (xcd < r ? xcd * (q + 1) : r * (q + 1) + (xcd - r) * q) + off; }
        const int nig = WGM * nN, gid = wgid / nig, fm = gid * WGM, gsz = (nM - fm) < WGM ? (nM - fm) : WGM;
        u.pm = fm + ((wgid % nig) % gsz); u.pn = (wgid % nig) / gsz;
        u.a = A + (size_t)u.pm * BM * RB; u.b = B + (size_t)u.pn * BM * RB; u.e0 = 0; u.lbase = 0; u.cnt = 0; return true;
    }
    __device__ __forceinline__ unsigned row_off(const Unit&, int) const { return 0u; }
};
struct DynOrder {
    static constexpr bool GATHER = false, DYNAMIC = true;
    const char* A; const char* B; int K, RB; int nM, nN, nwg, wv; unsigned* counter; LAS int* slot;
    __device__ void init(const void* A_, const void* B_, int M_, int N_, int K_, int wv_, unsigned* counter_, LAS int* slot_, bool fp8 = false) { wv = wv_; A = (const char*)A_; B = (const char*)B_; K = K_; RB = fp8 ? K_ : 2 * K_; nM = M_ / BM; nN = N_ / BM; nwg = nM * nN; counter = counter_; slot = slot_; }
    __device__ __forceinline__ void map(int L, Unit& u) const {
        int wgid = L; { const int q = nwg / NXCD, r = nwg % NXCD, xcd = wgid % NXCD, off = wgid / NXCD; wgid = (xcd < r ? xcd * (q + 1) : r * (q + 1) + (xcd - r) * q) + off; }
        const int nig = WGM * nN, gid = wgid / nig, fm = gid * WGM, gsz = (nM - fm) < WGM ? (nM - fm) : WGM;
        u.pm = fm + ((wgid % nig) % gsz); u.pn = (wgid % nig) / gsz;
        u.a = A + (size_t)u.pm * BM * RB; u.b = B + (size_t)u.pn * BM * RB; u.e0 = 0; u.lbase = 0; u.cnt = 0;
    }
    __device__ __forceinline__ int fetch() const { return (int)__hip_atomic_fetch_add(counter, 1u, __ATOMIC_RELAXED, __HIP_MEMORY_SCOPE_AGENT); }
    __device__ __forceinline__ bool next(int, Unit&) const { return false; }
    __device__ __forceinline__ unsigned row_off(const Unit&, int) const { return 0u; }
};
template <bool GATHER_> struct MoeOrder {
    static constexpr bool GATHER = GATHER_, DYNAMIC = false;
    const char* A; const char* B; size_t estride; int K, RB, NT, total, G, c, wv;
    const LAS int* blk_e; const LAS int* blkstart; const LAS int* cnt; const int* list;
    __device__ __forceinline__ bool next(int i, Unit& u) const {
        const int L = i * G + c; if (L >= total) return false;
        const int rb = (int)L / NT, pn = (int)L % NT, e = blk_e[rb];
        u.pm = rb; u.pn = pn; u.e0 = e; u.lbase = (rb - blkstart[e]) * BM; u.cnt = cnt[e];
        u.a = GATHER ? A : A + (size_t)rb * BM * RB; u.b = B + (size_t)e * estride + (size_t)pn * BM * RB; return true;
    }
    __device__ __forceinline__ unsigned row_off(const Unit& u, int r) const { const int loc = u.lbase + r; const int t = list[u.e0 * LIST_CAP + (loc < u.cnt ? loc : 0)]; return (unsigned)t * (unsigned)RB; }
};

typedef __bf16 bf16n2 __attribute__((ext_vector_type(2)));
__device__ __forceinline__ unsigned cvt_pk_bf16_n(float lo, float hi) { const f32x2 v = {lo, hi}; return __builtin_bit_cast(unsigned, __builtin_convertvector(v, bf16n2)); }
__device__ __forceinline__ unsigned cvt_pk_bf16(float lo, float hi) { unsigned r; asm volatile("v_cvt_pk_bf16_f32 %0, %1, %2" : "=v"(r) : "v"(lo), "v"(hi)); return r; }

struct EpiBf16 {
    static constexpr bool PERM = true;
    bf16* O; int ldc; int split_cols; size_t split_stride; float osc;
    __device__ __forceinline__ void operator()(const f32x4 (&acc)[2][2][4][2], const Unit& u, int wr, int wc, int fr, int fq) const {
        const int row0 = u.pm * BM + wr * 64 + fr; int colt = u.pn * BM; bf16* base = O;
        if (split_cols) { const int t = colt / split_cols; base += (size_t)t * split_stride; colt -= t * split_cols; }
        const int col0 = colt + wc * 32 + 8 * fq;
#pragma unroll
        for (int ai = 0; ai < 2; ++ai)
#pragma unroll
            for (int m = 0; m < 4; ++m) { bf16* rowp = base + (size_t)(row0 + ai * HALF + m * 16) * ldc + col0;
#pragma unroll
                for (int bj = 0; bj < 2; ++bj) { const f32x4 v0 = acc[ai][bj][m][0] * osc, v1 = acc[ai][bj][m][1] * osc;
                    u32x4 w; w.x = cvt_pk_bf16(v0[0], v0[1]); w.y = cvt_pk_bf16(v0[2], v0[3]); w.z = cvt_pk_bf16(v1[0], v1[1]); w.w = cvt_pk_bf16(v1[2], v1[3]);
                    *(u32x4*)(rowp + bj * HALF) = w; } }
    }
};
struct EpiResF32 {
    static constexpr bool PERM = false;
    float* C; const float* R; int ldc; float osc;
    __device__ __forceinline__ void operator()(const f32x4 (&acc)[2][2][4][2], const Unit& u, int wr, int wc, int fr, int fq) const {
        const int row0 = u.pm * BM + wr * 64 + fr, col0 = u.pn * BM + wc * 32 + 4 * fq;
#pragma unroll
        for (int ai = 0; ai < 2; ++ai)
#pragma unroll
            for (int m = 0; m < 4; ++m) { const size_t ro = (size_t)(row0 + ai * HALF + m * 16) * ldc + col0;
#pragma unroll
                for (int bj = 0; bj < 2; ++bj)
#pragma unroll
                    for (int n = 0; n < 2; ++n) { const f32x4 r = *(const f32x4*)(R + ro + bj * HALF + n * 16); *(f32x4*)(C + ro + bj * HALF + n * 16) = acc[ai][bj][m][n] * osc + r; } }
    }
};
struct EpiOut8 {
    static constexpr bool PERM = true;
    unsigned char* O; int ldc; float osc;
    __device__ __forceinline__ void operator()(const f32x4 (&acc)[2][2][4][2], const Unit& u, int wr, int wc, int fr, int fq) const {
        const int row0 = u.pm * BM + wr * 64 + fr, col0 = u.pn * BM + wc * 32 + 8 * fq;
#pragma unroll
        for (int ai = 0; ai < 2; ++ai)
#pragma unroll
            for (int m = 0; m < 4; ++m) { unsigned char* rowp = O + (size_t)(row0 + ai * HALF + m * 16) * ldc + col0;
#pragma unroll
                for (int bj = 0; bj < 2; ++bj) { const f32x4 v0 = acc[ai][bj][m][0] * osc, v1 = acc[ai][bj][m][1] * osc;
                    u32x2 w; w.x = pk4_fp8(v0[0], v0[1], v0[2], v0[3]); w.y = pk4_fp8(v1[0], v1[1], v1[2], v1[3]);
                    *(u32x2*)(rowp + bj * HALF) = w; } }
    }
};
template <bool SRC32> struct EpiRes16 {
    static constexpr bool PERM = true;
    bf16* XR; const float* R32; float osc;
    __device__ __forceinline__ void operator()(const f32x4 (&acc)[2][2][4][2], const Unit& u, int wr, int wc, int fr, int fq) const {
        const int row0 = u.pm * BM + wr * 64 + fr, col0 = u.pn * BM + wc * 32 + 8 * fq;
#pragma unroll
        for (int ai = 0; ai < 2; ++ai)
#pragma unroll
            for (int m = 0; m < 4; ++m) { const size_t ro = (size_t)(row0 + ai * HALF + m * 16) * D + col0;
#pragma unroll
                for (int bj = 0; bj < 2; ++bj) { float r[8];
                    if (SRC32) { const f32x4 a = *(const f32x4*)(R32 + ro + bj * HALF), b = *(const f32x4*)(R32 + ro + bj * HALF + 4);
#pragma unroll
                        for (int j = 0; j < 4; ++j) { r[j] = a[j]; r[4 + j] = b[j]; } }
                    else { const u32x4 w = *(const u32x4*)(XR + ro + bj * HALF); r[0] = bflo(w.x); r[1] = bfhi(w.x); r[2] = bflo(w.y); r[3] = bfhi(w.y); r[4] = bflo(w.z); r[5] = bfhi(w.z); r[6] = bflo(w.w); r[7] = bfhi(w.w); }
                    const f32x4 v0 = acc[ai][bj][m][0] * osc, v1 = acc[ai][bj][m][1] * osc;
                    u32x4 o; o.x = cvt_pk_bf16(v0[0] + r[0], v0[1] + r[1]); o.y = cvt_pk_bf16(v0[2] + r[2], v0[3] + r[3]); o.z = cvt_pk_bf16(v1[0] + r[4], v1[1] + r[5]); o.w = cvt_pk_bf16(v1[2] + r[6], v1[3] + r[7]);
                    *(u32x4*)(XR + ro + bj * HALF) = o; } }
    }
};
__device__ __forceinline__ float sigmoidf_(float z) { return __builtin_amdgcn_rcpf(1.0f + __expf(-z)); }
template <bool OUT8> struct EpiSwiGLU {
    static constexpr bool PERM = true;
    bf16* O; float osc;
    __device__ __forceinline__ void operator()(const f32x4 (&acc)[2][2][4][2], const Unit& u, int wr, int wc, int fr, int fq) const {
        const int row0 = u.pm * BM + wr * 64 + fr, col0 = u.pn * HALF + wc * 32 + 8 * fq;
#pragma unroll
        for (int ai = 0; ai < 2; ++ai)
#pragma unroll
            for (int m = 0; m < 4; ++m) { const size_t eo = (size_t)(row0 + ai * HALF + m * 16) * FF + col0;
                float o[8];
#pragma unroll
                for (int n = 0; n < 2; ++n)
#pragma unroll
                    for (int j = 0; j < 4; ++j) { const float g = acc[ai][0][m][n][j] * osc, up = acc[ai][1][m][n][j] * osc; o[4 * n + j] = g * sigmoidf_(g) * up; }
                if (OUT8) { u32x2 w; w.x = pk4_fp8(o[0] * SC_ACT, o[1] * SC_ACT, o[2] * SC_ACT, o[3] * SC_ACT); w.y = pk4_fp8(o[4] * SC_ACT, o[5] * SC_ACT, o[6] * SC_ACT, o[7] * SC_ACT); *(u32x2*)((unsigned char*)O + eo) = w; }
                else { u32x4 w; w.x = cvt_pk_bf16(o[0], o[1]); w.y = cvt_pk_bf16(o[2], o[3]); w.z = cvt_pk_bf16(o[4], o[5]); w.w = cvt_pk_bf16(o[6], o[7]); *(u32x4*)(O + eo) = w; } }
    }
};
typedef _Float16 h8 __attribute__((ext_vector_type(8)));
struct EpiHgrnIn {
    static constexpr bool PERM = true;
    unsigned char* zb; const float* lb;
    __device__ __forceinline__ void operator()(const f32x4 (&acc)[2][2][4][2], const Unit& u, int wr, int wc, int fr, int fq) const {
        const int quarter = u.pn >> 3, row0 = u.pm * BM + wr * 64 + fr, col0 = (u.pn & 7) * BM + wc * 32 + 8 * fq;
        if (quarter == 1) {
            float lbv[2][8];
#pragma unroll
            for (int bj = 0; bj < 2; ++bj) { const f32x4 a = *(const f32x4*)(lb + col0 + bj * HALF), b = *(const f32x4*)(lb + col0 + bj * HALF + 4);
#pragma unroll
                for (int j = 0; j < 4; ++j) { lbv[bj][j] = a[j]; lbv[bj][4 + j] = b[j]; } }
#pragma unroll
            for (int ai = 0; ai < 2; ++ai)
#pragma unroll
                for (int m = 0; m < 4; ++m) { const size_t ro = (size_t)(row0 + ai * HALF + m * 16) * D + col0;
#pragma unroll
                    for (int bj = 0; bj < 2; ++bj) { float kk[8]; h8 hv;
#pragma unroll
                        for (int n = 0; n < 2; ++n)
#pragma unroll
                            for (int j = 0; j < 4; ++j) { const float z = acc[ai][bj][m][n][j], l = lbv[bj][4 * n + j];
                                const float k1 = (1.0f - l) * __builtin_amdgcn_rcpf(1.0f + __expf(z));
                                kk[4 * n + j] = k1; hv[4 * n + j] = (_Float16)__logf(1.0f - k1); }
                        u32x4 w; w.x = cvt_pk_bf16(kk[0], kk[1]); w.y = cvt_pk_bf16(kk[2], kk[3]); w.z = cvt_pk_bf16(kk[4], kk[5]); w.w = cvt_pk_bf16(kk[6], kk[7]);
                        *(u32x4*)((bf16*)(zb + (64u << 20)) + ro + bj * HALF) = w;
                        *(h8*)((_Float16*)(zb + (128u << 20)) + ro + bj * HALF) = hv; } }
        } else {
            const size_t zo = quarter == 0 ? 0u : (quarter == 2 ? (size_t)(192u << 20) : (size_t)(256u << 20)); bf16* dst = (bf16*)(zb + zo);
#pragma unroll
            for (int ai = 0; ai < 2; ++ai)
#pragma unroll
                for (int m = 0; m < 4; ++m) { const size_t ro = (size_t)(row0 + ai * HALF + m * 16) * D + col0;
#pragma unroll
                    for (int bj = 0; bj < 2; ++bj) { float o[8];
#pragma unroll
                        for (int n = 0; n < 2; ++n)
#pragma unroll
                            for (int j = 0; j < 4; ++j) { const float z = acc[ai][bj][m][n][j]; o[4 * n + j] = (quarter == 3) ? z * sigmoidf_(z) : z; }
                        u32x4 w; w.x = cvt_pk_bf16(o[0], o[1]); w.y = cvt_pk_bf16(o[2], o[3]); w.z = cvt_pk_bf16(o[4], o[5]); w.w = cvt_pk_bf16(o[6], o[7]);
                        *(u32x4*)(dst + ro + bj * HALF) = w; } }
        }
    }
};

struct EpiQKV {
    static constexpr bool PERM = true;
    bf16* Q; bf16* Kd; bf16* V; const float* qg; const float* kg; const f32x2* rope; float* kmean; LAS unsigned char* xl; float osc; int wv;
    __device__ __forceinline__ void operator()(const f32x4 (&acc)[2][2][4][2], const Unit& u, int wr, int wc, int fr, int fq) const {
        const int sec = u.pn >> 3, row0 = u.pm * BM + wr * 64 + fr;
        if (sec == 2) {
            const int col0 = (u.pn & 7) * BM + wc * 32 + 8 * fq; const float vs = osc * SC_QKV;
#pragma unroll
            for (int ai = 0; ai < 2; ++ai)
#pragma unroll
                for (int m = 0; m < 4; ++m) { unsigned char* rowp = (unsigned char*)V + (size_t)(row0 + ai * HALF + m * 16) * D + col0;
#pragma unroll
                    for (int bj = 0; bj < 2; ++bj) { const f32x4 v0 = acc[ai][bj][m][0] * vs, v1 = acc[ai][bj][m][1] * vs;
                        u32x2 w; w.x = pk4_fp8(v0[0], v0[1], v0[2], v0[3]); w.y = pk4_fp8(v1[0], v1[1], v1[2], v1[3]);
                        *(u32x2*)(rowp + bj * HALF) = w; } }
            return;
        }
        LAS float* X = (LAS float*)xl;
        LAS float* Y = (LAS float*)(xl + 8192);
#pragma unroll
        for (int ai = 0; ai < 2; ++ai)
#pragma unroll
            for (int m = 0; m < 4; ++m)
#pragma unroll
                for (int bj = 0; bj < 2; ++bj) { const f32x4 a = acc[ai][bj][m][0], b = acc[ai][bj][m][1];
                    float s = ((a[0] * a[0] + a[1] * a[1]) + (a[2] * a[2] + a[3] * a[3]) + (b[0] * b[0] + b[1] * b[1]) + (b[2] * b[2] + b[3] * b[3])) * (osc * osc);
                    s += __shfl_xor(s, 16); s += __shfl_xor(s, 32);
                    if (fq == 0) X[((ai * HALF + wr * 64 + m * 16 + fr) * 2 + bj) * 4 + wc] = s; }
        asm volatile("s_waitcnt lgkmcnt(0)" ::: "memory"); __builtin_amdgcn_s_barrier(); asm volatile("" ::: "memory");
        const float* gain = sec ? kg : qg; bf16* dst = sec ? Kd : Q;
#pragma unroll
        for (int ai = 0; ai < 2; ++ai)
#pragma unroll
            for (int m = 0; m < 4; ++m) { const int rl = ai * HALF + wr * 64 + m * 16 + fr, pos = (u.pm & 15) * BM + rl;
                const f32x4 g0 = *(const f32x4*)(gain + 16 * wc + 4 * fq), g1 = *(const f32x4*)(gain + 64 + 16 * wc + 4 * fq);
                const f32x4 r0 = *(const f32x4*)(rope + pos * 64 + 16 * wc + 4 * fq), r1 = *(const f32x4*)(rope + pos * 64 + 16 * wc + 4 * fq + 2);
                const float cc[4] = {r0[0], r0[2], r1[0], r1[2]}, sn[4] = {r0[1], r0[3], r1[1], r1[3]};
#pragma unroll
                for (int bj = 0; bj < 2; ++bj) { const f32x4 p = *(const LAS f32x4*)(X + (rl * 2 + bj) * 4);
                    const float rstd = __builtin_amdgcn_rsqf(((p[0] + p[1]) + (p[2] + p[3])) * (1.f / 128) + RMS_EPS);
                    float o[8];
#pragma unroll
                    for (int j = 0; j < 4; ++j) { const float y1 = acc[ai][bj][m][0][j] * (rstd * osc) * g0[j], y2 = acc[ai][bj][m][1][j] * (rstd * osc) * g1[j]; o[j] = y1 * cc[j] - y2 * sn[j]; o[4 + j] = y2 * cc[j] + y1 * sn[j]; }
                    unsigned char* p0 = (unsigned char*)dst + (size_t)(u.pm * BM + rl) * D + ((u.pn & 7) * 2 + bj) * 128 + 16 * wc + 4 * fq;
                    *(unsigned*)p0 = pk4_fp8(o[0] * SC_QKV, o[1] * SC_QKV, o[2] * SC_QKV, o[3] * SC_QKV); *(unsigned*)(p0 + 64) = pk4_fp8(o[4] * SC_QKV, o[5] * SC_QKV, o[6] * SC_QKV, o[7] * SC_QKV);
                    if (sec == 1) {
#pragma unroll
                        for (int j = 0; j < 8; ++j) { float sv = o[j]; sv += __shfl_xor(sv, 1); sv += __shfl_xor(sv, 2); sv += __shfl_xor(sv, 4); sv += __shfl_xor(sv, 8); o[j] = sv; }
                        if (fr == 0) { LAS float* yp = Y + ((((wr * 2 + ai) * 4 + m) * 2 + bj) * 128) + 16 * wc + 4 * fq; *(LAS f32x4*)yp = (f32x4){o[0], o[1], o[2], o[3]}; *(LAS f32x4*)(yp + 64) = (f32x4){o[4], o[5], o[6], o[7]}; }
                    } }
                asm volatile("" ::: "memory"); }
        if (sec == 1) {
            asm volatile("s_waitcnt lgkmcnt(0)" ::: "memory"); __builtin_amdgcn_s_barrier(); asm volatile("" ::: "memory");
            const int tid = make_tid(wv);
            if (tid < 256) { const int bj = tid >> 7, d = tid & 127; const int b = u.pm >> 4, nb = u.pm & 15, head = (u.pn & 7) * 2 + bj;
                float sm = 0.f;
#pragma unroll
                for (int q = 0; q < 16; ++q) sm += Y[(q * 2 + bj) * 128 + d];
                float* kmb = kmean; asm volatile("" : "+s"(kmb));
                ((GAS float*)kmb)[((b * H + head) * NBLK + nb) * HD + d] = sm * (1.0f / 256); }
        }
    }
};

__device__ __forceinline__ void glds_saddr(const char* sbase, unsigned voff, unsigned lds_dst) {
    unsigned keep;
    asm volatile("s_mov_b32 %0, m0\n\ts_mov_b32 m0, %3\n\ts_nop 4\n\tglobal_load_lds_dwordx4 %1, %2\n\ts_mov_b32 m0, %0" : "=&s"(keep) : "v"(voff), "s"(sbase), "s"(lds_dst) : "memory");
}
typedef int i32x4 __attribute__((ext_vector_type(4)));
typedef int i32x8 __attribute__((ext_vector_type(8)));
__device__ __forceinline__ i32x8 cat8(bf16x8 lo, bf16x8 hi) { const i32x4 a = __builtin_bit_cast(i32x4, lo), b = __builtin_bit_cast(i32x4, hi); return __builtin_shufflevector(a, b, 0, 1, 2, 3, 4, 5, 6, 7); }
template <class Epi, class Sched, bool ALIGN_EPI, bool FP8 = false>
__device__ __forceinline__ void gemm_phase(LAS unsigned char* lds, const Sched& S, const Epi& E) {
    const int tid = make_tid(S.wv), wid = __builtin_amdgcn_readfirstlane(tid >> 6), lane = tid & 63, wr = wid >> 2, wc = wid & 3, fr = lane & 15, fq = lane >> 4;
    const int K = S.K, RB = S.RB, nt = RB / (BK * 2);
    unsigned voffA[2], voffB[2];
#pragma unroll
    for (int i = 0; i < 2; ++i) { int R, C; stage_rc(tid * 16 + i * 8192, R, C); const int Rb = Epi::PERM ? ((R & ~31) + perm32(R & 31)) : R;
        voffA[i] = (unsigned)(R * RB + C * 2); voffB[i] = (unsigned)(Rb * RB + C * 2); }
    const size_t kstep = (size_t)(BK * 2);
    const size_t hstep = (size_t)HALF * RB;
    const unsigned ldsw = (unsigned)wid * 1024u, ldsb = (unsigned)(size_t)lds;
    const int aoff = lds_byte(wr * 64 + fr, fq * 8), boff = lds_byte(wc * 32 + fr, fq * 8);
#define PG8_SA(b, h) (((b) * 2 + (h)) * HTB)
#define PG8_SB(b, h) ((4 + (b) * 2 + (h)) * HTB)
#define PG8_STAGE(bufoff, gbase, voff) do { _Pragma("unroll") for (int _i = 0; _i < 2; ++_i) glds_saddr((const char*)(gbase), (voff)[_i], ldsb + (unsigned)(bufoff) + ldsw + _i * 8192u); } while (0)
#define PG8_GOFS(pp, h, i) (gofs + ((((pp) * 2 + (h)) * 2 + (i)) * 512))
#define PG8_STAGE_A(bufoff, sel, h, ko) do { if constexpr (Sched::GATHER) { const int _pp = (sel) ? (pc ^ 1) : pc; unsigned _v[2]; _v[0] = PG8_GOFS(_pp, h, 0)[tid]; _v[1] = PG8_GOFS(_pp, h, 1)[tid]; PG8_STAGE(bufoff, S.A + (ko), _v); } \
        else { PG8_STAGE(bufoff, ((sel) ? nA : cA) + (h) * hstep + (ko), voffA); } } while (0)
#define PG8_LDA(dst, b, h) do { _Pragma("unroll") for (int m = 0; m < 4; ++m) { if constexpr (FP8) dst##8[m] = cat8(*(const LAS bf16x8*)(lds + PG8_SA(b, h) + aoff + m * 2048), *(const LAS bf16x8*)(lds + PG8_SA(b, h) + aoff + m * 2048 + 1024)); \
        else { _Pragma("unroll") for (int k = 0; k < 2; ++k) dst[m][k] = *(const LAS bf16x8*)(lds + PG8_SA(b, h) + aoff + m * 2048 + k * 1024); } } } while (0)
#define PG8_LDB(dst, b, h) do { _Pragma("unroll") for (int n = 0; n < 2; ++n) { if constexpr (FP8) dst##8[n] = cat8(*(const LAS bf16x8*)(lds + PG8_SB(b, h) + boff + n * 2048), *(const LAS bf16x8*)(lds + PG8_SB(b, h) + boff + n * 2048 + 1024)); \
        else { _Pragma("unroll") for (int k = 0; k < 2; ++k) dst[n][k] = *(const LAS bf16x8*)(lds + PG8_SB(b, h) + boff + n * 2048 + k * 1024); } } } while (0)
#define PG8_MMA(ai, bj, At, Bt) do { __builtin_amdgcn_s_setprio(1); _Pragma("unroll") for (int m = 0; m < 4; ++m) _Pragma("unroll") for (int n = 0; n < 2; ++n) { if constexpr (FP8) { \
        acc[ai][bj][m][n] = __builtin_amdgcn_mfma_scale_f32_16x16x128_f8f6f4(Bt##8[n], At##8[m], acc[ai][bj][m][n], 0, 0, 0, 0, 0, 0); } else { _Pragma("unroll") for (int k = 0; k < 2; ++k) \
        acc[ai][bj][m][n] = __builtin_amdgcn_mfma_f32_16x16x32_bf16(Bt[n][k], At[m][k], acc[ai][bj][m][n], 0, 0, 0); } } __builtin_amdgcn_s_setprio(0); } while (0)
#define PG8_WAIT_V(n) asm volatile("s_waitcnt vmcnt(" #n ")" ::: "memory")
#define PG8_WAIT_L(n) asm volatile("s_waitcnt lgkmcnt(" #n ")" ::: "memory")
#define PG8_BAR __builtin_amdgcn_s_barrier()
#define PG8_SCHED __builtin_amdgcn_sched_barrier(0)
    Unit cur, nxt; int ui = 0; int dyn_pend = 0;
    if constexpr (Sched::DYNAMIC) {
        if (wid == 0) { int v2 = 0; if (lane == 0) { const int v0 = S.fetch(), v1 = S.fetch(); v2 = S.fetch(); S.slot[0] = v0; S.slot[1] = v1; } dyn_pend = __builtin_amdgcn_readfirstlane(v2); }
        PG8_WAIT_L(0); PG8_BAR;
        const int L0 = __builtin_amdgcn_readfirstlane(S.slot[0]); if (L0 >= S.nwg) return;
        S.map(L0, cur);
    } else { if (!S.next(0, cur)) return; }
    LAS unsigned* gofs = (LAS unsigned*)(lds + 131072); int pc = 0;
#define PG8_WRITE_GOFS(pp, U) do { int _t = tid; asm volatile("" : "+v"(_t)); _Pragma("unroll") for (int _i = 0; _i < 2; ++_i) { int _R, _C; stage_rc(_t * 16 + _i * 8192, _R, _C); \
        _Pragma("unroll") for (int _h = 0; _h < 2; ++_h) PG8_GOFS(pp, _h, _i)[_t] = S.row_off(U, _h * HALF + _R) + (unsigned)_C * 2u; } } while (0)
    if constexpr (Sched::GATHER) PG8_WRITE_GOFS(0, cur);
    f32x4 acc[2][2][4][2];
#pragma unroll
    for (int a = 0; a < 2; ++a)
#pragma unroll
        for (int b = 0; b < 2; ++b)
#pragma unroll
            for (int m = 0; m < 4; ++m)
#pragma unroll
                for (int n = 0; n < 2; ++n) acc[a][b][m][n] = (f32x4){0.f, 0.f, 0.f, 0.f};
    bf16x8 At[4][2], B0[2][2], B1[2][2]; i32x8 At8[4], B08[2], B18[2];
    const char* cA = cur.a; const char* cB = cur.b; const char* nA = cA; const char* nB = cB;
    PG8_STAGE(PG8_SB(0, 0), cB, voffB); PG8_STAGE(PG8_SB(0, 1), cB + hstep, voffB); PG8_STAGE_A(PG8_SA(0, 0), false, 0, 0); PG8_STAGE_A(PG8_SA(0, 1), false, 1, 0);
    if (wr == 1) PG8_BAR;
    PG8_WAIT_V(2); PG8_BAR;
    PG8_STAGE(PG8_SB(1, 0), cB + kstep, voffB); PG8_STAGE_A(PG8_SA(1, 0), false, 0, kstep); PG8_STAGE(PG8_SB(1, 1), cB + hstep + kstep, voffB);
    PG8_WAIT_V(6); PG8_BAR;
    for (;;) {
        bool has_next = true;
        if constexpr (Sched::DYNAMIC) {
            if (ui >= 1 && wid == 0) { int v = 0; if (lane == 0) { S.slot[(ui + 1) % 3] = dyn_pend; v = S.fetch(); } dyn_pend = __builtin_amdgcn_readfirstlane(v); }
        } else { has_next = S.next(ui + 1, nxt); nA = has_next ? nxt.a : cA; nB = has_next ? nxt.b : cB; }
        if constexpr (Sched::GATHER) { if (has_next) PG8_WRITE_GOFS(pc ^ 1, nxt); else PG8_WRITE_GOFS(pc ^ 1, cur); }
        for (int t = 0; t < nt; t += 2) {
            const bool last = (t == nt - 2);
            if constexpr (Sched::DYNAMIC) { if (last) { const int Ln = __builtin_amdgcn_readfirstlane(S.slot[(ui + 1) % 3]); has_next = Ln < S.nwg; if (has_next) S.map(Ln, nxt); nA = has_next ? nxt.a : cA; nB = has_next ? nxt.b : cB; } }
            const size_t k1 = (size_t)(t + 1) * kstep;
            const size_t k2 = last ? 0 : (size_t)(t + 2) * kstep, k3 = k2 + kstep;
            const char* b2 = (last ? nB : cB) + k2; const char* b3 = b2 + kstep;
            PG8_LDB(B0, 0, 0); PG8_LDB(B1, 0, 1); PG8_SCHED; PG8_LDA(At, 0, 0); PG8_STAGE_A(PG8_SA(1, 1), false, 1, k1);
            PG8_WAIT_V(8); PG8_WAIT_L(0); PG8_BAR; PG8_MMA(0, 0, At, B0); PG8_MMA(0, 1, At, B1); PG8_BAR; PG8_SCHED;
            PG8_LDA(At, 0, 1); PG8_STAGE(PG8_SB(0, 0), b2, voffB); PG8_STAGE(PG8_SB(0, 1), b2 + hstep, voffB); PG8_STAGE_A(PG8_SA(0, 0), last, 0, k2);
            PG8_WAIT_V(8); PG8_WAIT_L(0); PG8_BAR; PG8_MMA(1, 0, At, B0); PG8_MMA(1, 1, At, B1); PG8_BAR; PG8_SCHED;
            PG8_LDB(B0, 1, 0); PG8_LDB(B1, 1, 1); PG8_SCHED; PG8_LDA(At, 1, 0); PG8_STAGE_A(PG8_SA(0, 1), last, 1, k2);
            PG8_WAIT_V(8); PG8_WAIT_L(0); PG8_BAR; PG8_MMA(0, 0, At, B0); PG8_MMA(0, 1, At, B1); PG8_BAR; PG8_SCHED;
            PG8_LDA(At, 1, 1); PG8_STAGE(PG8_SB(1, 0), b3, voffB); PG8_STAGE(PG8_SB(1, 1), b3 + hstep, voffB); PG8_STAGE_A(PG8_SA(1, 0), last, 0, k3);
            PG8_WAIT_V(8); PG8_WAIT_L(0); PG8_BAR; PG8_MMA(1, 0, At, B0); PG8_MMA(1, 1, At, B1); PG8_BAR; PG8_SCHED;
        }
        if constexpr (ALIGN_EPI) { if (wr == 0) PG8_BAR; }
        { const int l2_ = lane_id(); E(acc, cur, wr, wc, l2_ & 15, l2_ >> 4); }
        if (!has_next) break;
#pragma unroll
        for (int a = 0; a < 2; ++a)
#pragma unroll
            for (int b = 0; b < 2; ++b)
#pragma unroll
                for (int m = 0; m < 4; ++m)
#pragma unroll
                    for (int n = 0; n < 2; ++n) acc[a][b][m][n] = (f32x4){0.f, 0.f, 0.f, 0.f};
        cur = nxt; cA = nA; cB = nB; ++ui;
        pc ^= 1;
        if constexpr (ALIGN_EPI) { if (wr == 1) PG8_BAR; }
    }
    PG8_WAIT_V(0);
    if constexpr (!ALIGN_EPI) { if (wr == 0) PG8_BAR; }
    PG8_BAR;
#undef PG8_SA
#undef PG8_SB
#undef PG8_STAGE
#undef PG8_STAGE_A
#undef PG8_GOFS
#undef PG8_WRITE_GOFS
#undef PG8_LDA
#undef PG8_LDB
#undef PG8_MMA
#undef PG8_WAIT_V
#undef PG8_WAIT_L
#undef PG8_BAR
#undef PG8_SCHED
}
}

#define XB_TMO      128
#define XB_XCNT(j)  (256  + 64 * (j))
#define XB_XSUB(j)  (1280 + 64 * (j))
#define XB_XGEN(j)  (2304 + 64 * (j))
#define XB_TOP      3328
#define XB_TOPGEN   3392
#define XCD_BAR_WORDS 3456
#define XB_SPIN_CAP (1u << 18)
__device__ __forceinline__ unsigned xb_ld(unsigned* p)              { return __hip_atomic_load(p, __ATOMIC_RELAXED, __HIP_MEMORY_SCOPE_AGENT); }
__device__ __forceinline__ unsigned xb_add(unsigned* p, unsigned v) { return __hip_atomic_fetch_add(p, v, __ATOMIC_RELAXED, __HIP_MEMORY_SCOPE_AGENT); }
__device__ __forceinline__ unsigned xb_xcc_id() { return (unsigned)__builtin_amdgcn_s_getreg((3 << 11) | 20) & 0xFu; }
#define XB_SPIN(cond, bar) do { unsigned _sp = 0; while (cond) { __builtin_amdgcn_s_sleep(1); \
    if ((++_sp & 255u) == 0u) { if (xb_ld(&(bar)[XB_TMO])) break; if (_sp > XB_SPIN_CAP) { atomicAdd(&(bar)[XB_TMO], 1u); break; } } } } while (0)
struct XcdBarrier { unsigned* bar; unsigned x; volatile LAS unsigned* st; };
__device__ __forceinline__ XcdBarrier xcd_barrier_post(unsigned* bar, volatile LAS unsigned* st, int tid0) {
    XcdBarrier b; b.bar = bar; b.x = xb_xcc_id(); b.st = st;
    if (tid0 == 0) (void)xb_add(&bar[XB_XCNT(b.x)], 1u);
    return b;
}
__device__ __forceinline__ void xcd_barrier_complete(unsigned* bar, unsigned x, unsigned& nloc, unsigned& nx) {
    const unsigned G = gridDim.x * gridDim.y * gridDim.z;
    unsigned sum, cnt, mine, sp = 0u;
    for (;;) {
        sum = 0u; cnt = 0u; mine = 0u;
#pragma unroll
        for (unsigned j = 0; j < 16; ++j) { const unsigned c = xb_ld(&bar[XB_XCNT(j)]); sum += c; cnt += (c > 0u) ? 1u : 0u; mine = (j == x) ? c : mine; }
        if (sum == G) break;
        __builtin_amdgcn_s_sleep(1);
        if ((++sp & 255u) == 0u) { if (xb_ld(&bar[XB_TMO])) break; if (sp > XB_SPIN_CAP) { atomicAdd(&bar[XB_TMO], 1u); break; } }
    }
    nloc = mine > 0u ? mine : 1u; nx = cnt > 0u ? cnt : 1u;
}
__device__ __forceinline__ void xcd_barrier(const XcdBarrier& b, int tid0) {
    asm volatile("s_waitcnt vmcnt(0)" ::: "memory");
    __syncthreads();
    if (tid0 == 0) {
        unsigned* bar = b.bar;
        __builtin_amdgcn_s_waitcnt(0);
        unsigned nloc = b.st[0], nx = b.st[1];
        if (nloc == 0u) { xcd_barrier_complete(bar, b.x, nloc, nx); b.st[0] = nloc; b.st[1] = nx; }
        const unsigned old = xb_add(&bar[XB_XSUB(b.x)], 1u);
        const unsigned gen = old / nloc;
        if (old + 1u == (gen + 1u) * nloc) {
            __builtin_amdgcn_fence(__ATOMIC_RELEASE, "agent");
            asm volatile("s_waitcnt vmcnt(0)" ::: "memory");
            const unsigned og = xb_add(&bar[XB_TOP], 1u);
            const unsigned tg = og / nx;
            if (og + 1u == (tg + 1u) * nx) xb_add(&bar[XB_TOPGEN], 1u);
            else XB_SPIN(xb_ld(&bar[XB_TOPGEN]) == tg, bar);
            __builtin_amdgcn_fence(__ATOMIC_ACQUIRE, "agent");
            xb_add(&bar[XB_XGEN(b.x)], 1u);
            asm volatile("s_waitcnt vmcnt(0)" ::: "memory");
        } else {
            XB_SPIN(xb_ld(&bar[XB_XGEN(b.x)]) == gen, bar);
            __builtin_amdgcn_fence(__ATOMIC_ACQUIRE, "agent");
            asm volatile("s_waitcnt vmcnt(0)" ::: "memory");
        }
    }
    __syncthreads();
}

struct Args { const float* in[20]; float* out; unsigned char* ws; int ph_lo, ph_hi; };
typedef const __attribute__((address_space(4))) Args CArgs;
enum { I_X = 0, I_NORM_MIX, I_NORM_FFN, I_A_W_IN, I_A_LB, I_A_OGAIN, I_A_W_OUT, I_KV_NORM, I_KV_W, I_K_NORM, I_B_W_Q, I_B_Q_NORM, I_B_W_OUT,
       I_W_GROUP, I_B_GROUP, I_W_EXPERT, I_B_EXPERT, I_W_GATE, I_W_UP, I_W_DOWN };
struct Frame {
    LAS unsigned char* lds; unsigned char* ws; unsigned* ctl;
    int tid, lane, wave, vcu, G, gw, NGW;
};

struct TrItem { const float* src; const float* ksc; unsigned char* dst; int N, K, k0, n0, drow0, flags; float osc; };
struct TrRegs { f32x4 v[16]; f32x4 ks[2]; };
constexpr int TR_SCR_BYTES = 128 * 33 * 4;
__device__ __forceinline__ void tr_load(const TrItem& it, TrRegs& r, int lane) {
    const float* p = it.src + (size_t)(it.k0 + (lane >> 3)) * it.N + it.n0 + 4 * (lane & 7);
    const size_t st = (size_t)8 * it.N;
#pragma unroll
    for (int i = 0; i < 16; ++i) r.v[i] = *(const f32x4*)(p + i * st);
    if (it.ksc) { const f32x4* q = (const f32x4*)(it.ksc + it.k0 + 8 * (lane >> 3)); r.ks[0] = q[0]; r.ks[1] = q[1]; }
    else { r.ks[0] = (f32x4){1.f, 1.f, 1.f, 1.f}; r.ks[1] = r.ks[0]; }
}
__device__ __forceinline__ void tr_to_lds(const TrRegs& r, LAS float* scr, int lane) {
    LAS float* d = scr + (lane >> 3) * 33 + 4 * (lane & 7);
#pragma unroll
    for (int i = 0; i < 16; ++i) { d[(8 * i) * 33 + 0] = r.v[i][0]; d[(8 * i) * 33 + 1] = r.v[i][1]; d[(8 * i) * 33 + 2] = r.v[i][2]; d[(8 * i) * 33 + 3] = r.v[i][3]; }
}
__device__ __forceinline__ void tr_store(const TrItem& it, f32x4 ka, f32x4 kb, const LAS float* scr, int lane) {
#pragma unroll
    for (int jh = 0; jh < 2; ++jh) {
        const int c = (lane >> 3) + 8 * jh;
        if (jh == 1 && it.ksc) { const f32x4* q = (const f32x4*)(it.ksc + it.k0 + 8 * c); ka = q[0]; kb = q[1]; }
        const float o = it.osc;
        const float s0 = ka[0] * o, s1 = ka[1] * o, s2 = ka[2] * o, s3 = ka[3] * o, s4 = kb[0] * o, s5 = kb[1] * o, s6 = kb[2] * o, s7 = kb[3] * o;
#pragma unroll
        for (int jn = 0; jn < 4; ++jn) {
            const int n = (lane & 7) + 8 * jn; const LAS float* s = scr + (8 * c) * 33 + n;
            const float w0 = s[0 * 33] * s0, w1 = s[1 * 33] * s1, w2 = s[2 * 33] * s2, w3 = s[3 * 33] * s3, w4 = s[4 * 33] * s4, w5 = s[5 * 33] * s5, w6 = s[6 * 33] * s6, w7 = s[7 * 33] * s7;
            int drow = it.drow0 + n;
            if (it.flags & 1) { const int cidx = it.n0 + n, d = cidx & 127; drow = (it.drow0 - it.n0) + (cidx & ~127) + 32 * ((d & 63) >> 4) + 8 * ((d & 15) >> 2) + 4 * (d >> 6) + (d & 3); }
            const size_t eo = (size_t)drow * it.K + it.k0 + 8 * c;
            if (it.flags & 2) { u32x2 o8; o8.x = pk4_fp8(w0, w1, w2, w3); o8.y = pk4_fp8(w4, w5, w6, w7); *(u32x2*)(it.dst + eo) = o8; }
            else { u32x4 o16; o16.x = pk2(w0, w1); o16.y = pk2(w2, w3); o16.z = pk2(w4, w5); o16.w = pk2(w6, w7); *(u32x4*)(it.dst + eo * 2) = o16; }
        }
    }
}
template <class Dec> __device__ __forceinline__ void tr_run(Dec dec, int first, int total, int stride, LAS float* scr, int lane) {
    if (first >= total) return;
    TrRegs r; TrItem cur = dec(first); tr_load(cur, r, lane);
    for (int i = first; i < total; i += stride) {
        tr_to_lds(r, scr, lane);
        const f32x4 ka = r.ks[0], kb = r.ks[1];
        TrItem nxt = cur; const bool more = i + stride < total;
        if (more) { nxt = dec(i + stride); tr_load(nxt, r, lane); }
        LDS_WAIT(); asm volatile("" ::: "memory");
        tr_store(cur, ka, kb, scr, lane);
        LDS_WAIT(); asm volatile("" ::: "memory");
        cur = nxt;
    }
}
constexpr size_t WGU_LSTRIDE = 64 * MiB, WD_LSTRIDE = 32 * MiB;
static_assert((FP8_MOE0 != 0) && (FP8_MOE1 != 0), "the two-layer weight residency assumes e4m3 expert weights");
constexpr int MOE_CV_ITEMS = 32 * 768;
__device__ __forceinline__ TrItem moe_cv_item(CArgs& a, unsigned char* ws, int layer, int item) {
    const int e = item / 768, r = item % 768, which = r / 256, q = r % 256;
    const size_t eo = (size_t)(layer * NE + e);
    TrItem t; t.ksc = nullptr; t.flags = 2;
    if (which < 2) {
        const int kb = q / 16, nb = q % 16, n0 = nb * 32;
        t.src = (which == 0 ? a.in[I_W_GATE] : a.in[I_W_UP]) + eo * (size_t)D * FF; t.N = FF; t.K = D; t.k0 = 128 * kb; t.n0 = n0;
        t.dst = ws + WS_WGU + (size_t)layer * WGU_LSTRIDE + (size_t)e * 1024 * D; t.drow0 = (n0 >> 7) * 256 + which * 128 + (n0 & 127); t.osc = SC_W;
    } else {
        const int kb = q / 64, nb = q % 64;
        t.src = a.in[I_W_DOWN] + eo * (size_t)FF * D; t.N = D; t.K = FF; t.k0 = 128 * kb; t.n0 = nb * 32;
        t.dst = ws + WS_WD + (size_t)layer * WD_LSTRIDE + (size_t)e * D * FF; t.drow0 = nb * 32; t.osc = SC_WD;
    }
    return t;
}
__device__ __forceinline__ void rms_row_to_bf16(const float* xrow, bf16* orow, int lane) {
    const f32x4* xr = (const f32x4*)xrow + lane;
    f32x4 v[8]; float s = 0.f;
#pragma unroll
    for (int j = 0; j < 8; ++j) { v[j] = xr[64 * j]; s += (v[j].x * v[j].x + v[j].y * v[j].y) + (v[j].z * v[j].z + v[j].w * v[j].w); }
    const float rstd = __builtin_amdgcn_rsqf(wave_sum(s) * (1.f / D) + RMS_EPS);
    u32x2* o8 = (u32x2*)orow + lane;
#pragma unroll
    for (int j = 0; j < 8; ++j) { u32x2 w; w.x = pk2(v[j].x * rstd, v[j].y * rstd); w.y = pk2(v[j].z * rstd, v[j].w * rstd); o8[64 * j] = w; }
}

__device__ __forceinline__ int moe_tables(Frame& F, int layer) {
    LAS int* blk_e = (LAS int*)(F.lds + LT_BLKE); LAS int* blkstart = (LAS int*)(F.lds + LT_BLKSTART); LAS int* cntl = (LAS int*)(F.lds + LT_CNT);
    __syncthreads();
    if (F.wave == 0) {
        const int e = F.lane & 31;
        const int c = (int)__hip_atomic_load(F.ctl + CW_CNT_AT(layer, e), __ATOMIC_RELAXED, __HIP_MEMORY_SCOPE_AGENT);
        const int nb = (c + 255) >> 8;
        int incl = nb;
#pragma unroll
        for (int o = 1; o < 32; o <<= 1) { const int t = __shfl_up(incl, o, 32); if ((F.lane & 31) >= o) incl += t; }
        const int excl = incl - nb;
        if (F.lane < 32) { blkstart[e] = excl; cntl[e] = c; for (int r = 0; r < nb; ++r) blk_e[excl + r] = e; if (e == 31) blkstart[32] = incl; }
    }
    __syncthreads();
    return blkstart[32];
}

typedef const GAS char* gcptr;
__device__ __forceinline__ gcptr opaque_s(const void* p) { asm volatile("" : "+s"(p)); return (gcptr)p; }
__device__ __forceinline__ float wave_reduce4(const float (&p)[4], int lane) {
    const bool b0 = lane & 1, b1 = lane & 2;
    float a0 = b0 ? p[1] : p[0], x0 = b0 ? p[0] : p[1]; a0 += __shfl_xor(x0, 1);
    float a1 = b0 ? p[3] : p[2], x1 = b0 ? p[2] : p[3]; a1 += __shfl_xor(x1, 1);
    float c = b1 ? a1 : a0, d = b1 ? a0 : a1; c += __shfl_xor(d, 2);
    c += __shfl_xor(c, 4); c += __shfl_xor(c, 8); c += __shfl_xor(c, 16); c += __shfl_xor(c, 32);
    return c;
}
__device__ __forceinline__ float wave_reduce8(const float (&p)[8], int lane) {
    const bool b2 = lane & 4;
    const float lo[4] = {p[0], p[1], p[2], p[3]}, hi[4] = {p[4], p[5], p[6], p[7]};
    float q[4];
#pragma unroll
    for (int i = 0; i < 4; ++i) { const float keep = b2 ? hi[i] : lo[i], give = b2 ? lo[i] : hi[i]; q[i] = keep + __shfl_xor(give, 4); }
    const bool b0 = lane & 1, b1 = lane & 2;
    float a0 = b0 ? q[1] : q[0], x0 = b0 ? q[0] : q[1]; a0 += __shfl_xor(x0, 1);
    float a1 = b0 ? q[3] : q[2], x1 = b0 ? q[2] : q[3]; a1 += __shfl_xor(x1, 1);
    float c = b1 ? a1 : a0, d = b1 ? a0 : a1; c += __shfl_xor(d, 2);
    c += __shfl_xor(c, 8); c += __shfl_xor(c, 16); c += __shfl_xor(c, 32);
    return c;
}
template <bool DRY, bool OUT8> __device__ __forceinline__ void route_token(Frame& F, CArgs& a, int layer, int t) {
    const bf16* xrow = (const bf16*)(F.ws + WS_XR) + (size_t)t * D;
    const unsigned l16 = (unsigned)F.lane * 16u;
    gcptr xb = opaque_s(xrow); gcptr gb = opaque_s(a.in[I_NORM_FFN] + layer * D);
    f32x4 v[8]; float s = 0.f;
#pragma unroll
    for (int j = 0; j < 8; ++j) { const u32x2 xw_ = *(const GAS u32x2*)(xb + j * 512 + (l16 >> 1)); v[j] = (f32x4){bflo(xw_.x), bfhi(xw_.x), bflo(xw_.y), bfhi(xw_.y)}; s += (v[j].x * v[j].x + v[j].y * v[j].y) + (v[j].z * v[j].z + v[j].w * v[j].w); }
    const float rstd = __builtin_amdgcn_rsqf(wave_sum(s) * (1.f / D) + RMS_EPS);
    u32x2* o8 = (u32x2*)((bf16*)(F.ws + (DRY ? WS_OPART : WS_XN)) + (size_t)t * D) + F.lane;
#pragma unroll
    for (int j = 0; j < 8; ++j) { const f32x4 g = *(const GAS f32x4*)(gb + j * 1024 + l16); v[j].x *= rstd * g.x; v[j].y *= rstd * g.y; v[j].z *= rstd * g.z; v[j].w *= rstd * g.w;
        if (OUT8) ((unsigned*)(F.ws + (DRY ? WS_OPART : WS_XN)) + (size_t)t * (D / 4))[64 * j + F.lane] = pk4_fp8(v[j].x * SC_XN, v[j].y * SC_XN, v[j].z * SC_XN, v[j].w * SC_XN);
        else { u32x2 w; w.x = pk2(v[j].x, v[j].y); w.y = pk2(v[j].z, v[j].w); o8[64 * j] = w; } }
    const float* RT = (const float*)(F.ws + WS_RT) + (size_t)layer * 36 * D;
    float gl[4];
    { float pp[4];
#pragma unroll
      for (int r = 0; r < 4; ++r) { gcptr wb = opaque_s(RT + r * D); float p = 0.f;
#pragma unroll
        for (int j = 0; j < 8; ++j) { const f32x4 w = *(const GAS f32x4*)(wb + j * 1024 + l16); p += (v[j].x * w.x + v[j].y * w.y) + (v[j].z * w.z + v[j].w * w.w); }
        pp[r] = p; if (r & 1) __builtin_amdgcn_sched_barrier(0); }
      const float red = wave_reduce4(pp, F.lane);
#pragma unroll
      for (int r = 0; r < 4; ++r) gl[r] = __builtin_bit_cast(float, __builtin_amdgcn_readlane(__builtin_bit_cast(int, red), r)) + a.in[I_B_GROUP][layer * NG + r]; }
    int g = 0; float gm = gl[0];
#pragma unroll
    for (int r = 1; r < 4; ++r) if (gl[r] > gm) { gm = gl[r]; g = r; }
    float gs = 0.f;
#pragma unroll
    for (int r = 0; r < 4; ++r) gs += __expf(gl[r] - gm);
    const float gp = 1.0f / gs;
    g = __builtin_amdgcn_readfirstlane(g);
    float el[8];
    { float pp[8];
#pragma unroll
      for (int r = 0; r < 8; ++r) { gcptr wb = opaque_s(RT + (size_t)(4 + g * 8 + r) * D); float p = 0.f;
#pragma unroll
        for (int j = 0; j < 8; ++j) { const f32x4 w = *(const GAS f32x4*)(wb + j * 1024 + l16); p += (v[j].x * w.x + v[j].y * w.y) + (v[j].z * w.z + v[j].w * w.w); }
        pp[r] = p; if (r & 1) __builtin_amdgcn_sched_barrier(0); }
      const float red = wave_reduce8(pp, F.lane);
#pragma unroll
      for (int r = 0; r < 8; ++r) el[r] = __builtin_bit_cast(float, __builtin_amdgcn_readlane(__builtin_bit_cast(int, red), r)) + a.in[I_B_EXPERT][layer * NE + g * 8 + r]; }
    int i0 = 0; float m0 = el[0];
#pragma unroll
    for (int r = 1; r < 8; ++r) if (el[r] > m0) { m0 = el[r]; i0 = r; }
    int i1 = -1; float m1 = -INFINITY;
#pragma unroll
    for (int r = 0; r < 8; ++r) if (r != i0 && el[r] > m1) { m1 = el[r]; i1 = r; }
    const float q1 = __expf(m1 - m0), w0 = gp / (1.0f + q1), w1 = gp * q1 / (1.0f + q1);
    if (DRY && w0 + w1 < -1.0f) ((float*)(F.ws + WS_OPART))[0] = w0;
    if (F.lane == 0 && !DRY) {
        const int e0 = g * 8 + i0, e1 = g * 8 + i1;
        const int r0 = (int)atomicAdd(F.ctl + CW_CNT_AT(layer, e0), 1u), r1 = (int)atomicAdd(F.ctl + CW_CNT_AT(layer, e1), 1u);
        int* lists = (int*)(F.ws + WS_LISTS); lists[e0 * LIST_CAP + r0] = t; lists[e1 * LIST_CAP + r1] = t;
        int* rec = (int*)(F.ws + WS_TOKREC) + (size_t)t * 8;
        rec[0] = e0; rec[1] = r0; rec[2] = __builtin_bit_cast(int, w0); rec[3] = e1; rec[4] = r1; rec[5] = __builtin_bit_cast(int, w1);
    }
}

template <bool OUT8> __device__ __forceinline__ void route_pair(Frame& F, CArgs& a, int layer, int ta, int tb) {
    const unsigned l16 = (unsigned)F.lane * 16u;
    gcptr xb0 = opaque_s((const bf16*)(F.ws + WS_XR) + (size_t)ta * D), xb1 = opaque_s((const bf16*)(F.ws + WS_XR) + (size_t)tb * D); gcptr gb = opaque_s(a.in[I_NORM_FFN] + layer * D);
    f32x4 v0[8], v1[8]; float s0 = 0.f, s1 = 0.f;
#pragma unroll
    for (int j = 0; j < 8; ++j) { const u32x2 x0 = *(const GAS u32x2*)(xb0 + j * 512 + (l16 >> 1)), x1 = *(const GAS u32x2*)(xb1 + j * 512 + (l16 >> 1));
        v0[j] = (f32x4){bflo(x0.x), bfhi(x0.x), bflo(x0.y), bfhi(x0.y)}; v1[j] = (f32x4){bflo(x1.x), bfhi(x1.x), bflo(x1.y), bfhi(x1.y)};
        s0 += (v0[j].x * v0[j].x + v0[j].y * v0[j].y) + (v0[j].z * v0[j].z + v0[j].w * v0[j].w); s1 += (v1[j].x * v1[j].x + v1[j].y * v1[j].y) + (v1[j].z * v1[j].z + v1[j].w * v1[j].w); }
    const float rstd0 = __builtin_amdgcn_rsqf(wave_sum(s0) * (1.f / D) + RMS_EPS), rstd1 = __builtin_amdgcn_rsqf(wave_sum(s1) * (1.f / D) + RMS_EPS);
#pragma unroll
    for (int j = 0; j < 8; ++j) { const f32x4 g = *(const GAS f32x4*)(gb + j * 1024 + l16);
        v0[j].x *= rstd0 * g.x; v0[j].y *= rstd0 * g.y; v0[j].z *= rstd0 * g.z; v0[j].w *= rstd0 * g.w; v1[j].x *= rstd1 * g.x; v1[j].y *= rstd1 * g.y; v1[j].z *= rstd1 * g.z; v1[j].w *= rstd1 * g.w;
        if (OUT8) { ((unsigned*)(F.ws + WS_XN) + (size_t)ta * (D / 4))[64 * j + F.lane] = pk4_fp8(v0[j].x * SC_XN, v0[j].y * SC_XN, v0[j].z * SC_XN, v0[j].w * SC_XN);
                    ((unsigned*)(F.ws + WS_XN) + (size_t)tb * (D / 4))[64 * j + F.lane] = pk4_fp8(v1[j].x * SC_XN, v1[j].y * SC_XN, v1[j].z * SC_XN, v1[j].w * SC_XN); }
        else { u32x2 w; w.x = pk2(v0[j].x, v0[j].y); w.y = pk2(v0[j].z, v0[j].w); ((u32x2*)((bf16*)(F.ws + WS_XN) + (size_t)ta * D) + F.lane)[64 * j] = w;
               w.x = pk2(v1[j].x, v1[j].y); w.y = pk2(v1[j].z, v1[j].w); ((u32x2*)((bf16*)(F.ws + WS_XN) + (size_t)tb * D) + F.lane)[64 * j] = w; } }
    const float* RT = (const float*)(F.ws + WS_RT) + (size_t)layer * 36 * D;
    float gla[4], glb[4];
    { float pa_[4], pb_[4];
#pragma unroll
      for (int r = 0; r < 4; ++r) { gcptr wb = opaque_s(RT + r * D); float p0 = 0.f, p1 = 0.f;
#pragma unroll
        for (int j = 0; j < 8; ++j) { const f32x4 w = *(const GAS f32x4*)(wb + j * 1024 + l16);
            p0 += (v0[j].x * w.x + v0[j].y * w.y) + (v0[j].z * w.z + v0[j].w * w.w); p1 += (v1[j].x * w.x + v1[j].y * w.y) + (v1[j].z * w.z + v1[j].w * w.w); }
        pa_[r] = p0; pb_[r] = p1; if (r & 1) __builtin_amdgcn_sched_barrier(0); }
      const float reda = wave_reduce4(pa_, F.lane), redb = wave_reduce4(pb_, F.lane);
#pragma unroll
      for (int r = 0; r < 4; ++r) { const float bg = a.in[I_B_GROUP][layer * NG + r];
          gla[r] = __builtin_bit_cast(float, __builtin_amdgcn_readlane(__builtin_bit_cast(int, reda), r)) + bg; glb[r] = __builtin_bit_cast(float, __builtin_amdgcn_readlane(__builtin_bit_cast(int, redb), r)) + bg; } }
    int ga = 0, gb_ = 0; float gma = gla[0], gmb = glb[0];
#pragma unroll
    for (int r = 1; r < 4; ++r) { if (gla[r] > gma) { gma = gla[r]; ga = r; } if (glb[r] > gmb) { gmb = glb[r]; gb_ = r; } }
    float gsa = 0.f, gsb = 0.f;
#pragma unroll
    for (int r = 0; r < 4; ++r) { gsa += __expf(gla[r] - gma); gsb += __expf(glb[r] - gmb); }
    const float gpa = 1.0f / gsa, gpb = 1.0f / gsb;
    ga = __builtin_amdgcn_readfirstlane(ga); gb_ = __builtin_amdgcn_readfirstlane(gb_);
    float ela[8], elb[8];
    { float pa_[8], pb_[8];
#pragma unroll
      for (int r = 0; r < 8; ++r) { gcptr wa = opaque_s(RT + (size_t)(4 + ga * 8 + r) * D), wb = opaque_s(RT + (size_t)(4 + gb_ * 8 + r) * D); float p0 = 0.f, p1 = 0.f;
#pragma unroll
        for (int j = 0; j < 8; ++j) { const f32x4 w0 = *(const GAS f32x4*)(wa + j * 1024 + l16), w1 = *(const GAS f32x4*)(wb + j * 1024 + l16);
            p0 += (v0[j].x * w0.x + v0[j].y * w0.y) + (v0[j].z * w0.z + v0[j].w * w0.w); p1 += (v1[j].x * w1.x + v1[j].y * w1.y) + (v1[j].z * w1.z + v1[j].w * w1.w); }
        pa_[r] = p0; pb_[r] = p1; if (r & 1) __builtin_amdgcn_sched_barrier(0); }
      const float reda = wave_reduce8(pa_, F.lane), redb = wave_reduce8(pb_, F.lane);
#pragma unroll
      for (int r = 0; r < 8; ++r) { ela[r] = __builtin_bit_cast(float, __builtin_amdgcn_readlane(__builtin_bit_cast(int, reda), r)) + a.in[I_B_EXPERT][layer * NE + ga * 8 + r];
                                    elb[r] = __builtin_bit_cast(float, __builtin_amdgcn_readlane(__builtin_bit_cast(int, redb), r)) + a.in[I_B_EXPERT][layer * NE + gb_ * 8 + r]; } }
    int ia0 = 0, ib0 = 0; float ma0 = ela[0], mb0 = elb[0];
#pragma unroll
    for (int r = 1; r < 8; ++r) { if (ela[r] > ma0) { ma0 = ela[r]; ia0 = r; } if (elb[r] > mb0) { mb0 = elb[r]; ib0 = r; } }
    int ia1 = -1, ib1 = -1; float ma1 = -INFINITY, mb1 = -INFINITY;
#pragma unroll
    for (int r = 0; r < 8; ++r) { if (r != ia0 && ela[r] > ma1) { ma1 = ela[r]; ia1 = r; } if (r != ib0 && elb[r] > mb1) { mb1 = elb[r]; ib1 = r; } }
    const float qa = __expf(ma1 - ma0), wa0 = gpa / (1.0f + qa), wa1 = gpa * qa / (1.0f + qa);
    const float qb = __expf(mb1 - mb0), wb0 = gpb / (1.0f + qb), wb1 = gpb * qb / (1.0f + qb);
    if (F.lane == 0) {
        const int ea0 = ga * 8 + ia0, ea1 = ga * 8 + ia1, eb0 = gb_ * 8 + ib0, eb1 = gb_ * 8 + ib1;
        const int ra0 = (int)atomicAdd(F.ctl + CW_CNT_AT(layer, ea0), 1u), ra1 = (int)atomicAdd(F.ctl + CW_CNT_AT(layer, ea1), 1u);
        const int rb0 = (int)atomicAdd(F.ctl + CW_CNT_AT(layer, eb0), 1u), rb1 = (int)atomicAdd(F.ctl + CW_CNT_AT(layer, eb1), 1u);
        int* lists = (int*)(F.ws + WS_LISTS); lists[ea0 * LIST_CAP + ra0] = ta; lists[ea1 * LIST_CAP + ra1] = ta; lists[eb0 * LIST_CAP + rb0] = tb; lists[eb1 * LIST_CAP + rb1] = tb;
        int* rec = (int*)(F.ws + WS_TOKREC) + (size_t)ta * 8;
        rec[0] = ea0; rec[1] = ra0; rec[2] = __builtin_bit_cast(int, wa0); rec[3] = ea1; rec[4] = ra1; rec[5] = __builtin_bit_cast(int, wa1);
        rec = (int*)(F.ws + WS_TOKREC) + (size_t)tb * 8;
        rec[0] = eb0; rec[1] = rb0; rec[2] = __builtin_bit_cast(int, wb0); rec[3] = eb1; rec[4] = rb1; rec[5] = __builtin_bit_cast(int, wb1);
    }
}

template <bool NORM, bool DRY, bool OUT8> __device__ __forceinline__ void combine_token(Frame& F, CArgs& a, int t) {
    const LAS int* blkstart = (const LAS int*)(F.lds + LT_BLKSTART);
    const int* rec = (const int*)(F.ws + WS_TOKREC) + (size_t)t * 8;
    const int e0 = rec[0], r0 = rec[1], e1 = rec[3], r1 = rec[4]; const float w0 = __builtin_bit_cast(float, rec[2]), w1 = __builtin_bit_cast(float, rec[5]);
    const size_t row0 = (size_t)blkstart[e0] * 256 + r0, row1 = (size_t)blkstart[e1] * 256 + r1;
    const u32x2* p0 = (const u32x2*)((const bf16*)(F.ws + WS_OUTB) + row0 * D) + F.lane; const u32x2* p1 = (const u32x2*)((const bf16*)(F.ws + WS_OUTB) + row1 * D) + F.lane;
    const unsigned* q0 = (const unsigned*)(F.ws + WS_OUTB + row0 * D) + F.lane; const unsigned* q1 = (const unsigned*)(F.ws + WS_OUTB + row1 * D) + F.lane;
    u32x2* xr = (u32x2*)((bf16*)(F.ws + WS_XR) + (size_t)t * D) + F.lane; f32x4* xo = (f32x4*)(a.out + (size_t)t * D) + F.lane;
    f32x4 v[8]; float s = 0.f;
#pragma unroll
    for (int j = 0; j < 8; ++j) { const u32x2 xb_ = xr[64 * j]; f32x4 x = (f32x4){bflo(xb_.x), bfhi(xb_.x), bflo(xb_.y), bfhi(xb_.y)};
        if (OUT8) { const unsigned b0 = q0[64 * j], b1 = q1[64 * j]; const float u0 = w0 * (1.0f / SC_OUT), u1 = w1 * (1.0f / SC_OUT);
            const f32x2 l0 = __builtin_amdgcn_cvt_pk_f32_fp8((int)b0, false), h0 = __builtin_amdgcn_cvt_pk_f32_fp8((int)b0, true), l1 = __builtin_amdgcn_cvt_pk_f32_fp8((int)b1, false), h1 = __builtin_amdgcn_cvt_pk_f32_fp8((int)b1, true);
            x.x += u0 * l0.x + u1 * l1.x; x.y += u0 * l0.y + u1 * l1.y; x.z += u0 * h0.x + u1 * h1.x; x.w += u0 * h0.y + u1 * h1.y; }
        else { const u32x2 a0 = p0[64 * j], a1 = p1[64 * j];
            x.x += w0 * bflo(a0.x) + w1 * bflo(a1.x); x.y += w0 * bfhi(a0.x) + w1 * bfhi(a1.x); x.z += w0 * bflo(a0.y) + w1 * bflo(a1.y); x.w += w0 * bfhi(a0.y) + w1 * bfhi(a1.y); }
        v[j] = x; if (NORM) { if (!DRY) { u32x2 w_; w_.x = pk2(x.x, x.y); w_.y = pk2(x.z, x.w); xr[64 * j] = w_; } } else xo[64 * j] = x; s += (x.x * x.x + x.y * x.y) + (x.z * x.z + x.w * x.w); }
    if (NORM) {
        const float rstd = __builtin_amdgcn_rsqf(wave_sum(s) * (1.f / D) + RMS_EPS);
        u32x2* o8 = (u32x2*)((bf16*)(F.ws + (DRY ? WS_OPART + 128 * MiB : WS_XN)) + (size_t)t * D) + F.lane;
#pragma unroll
        for (int j = 0; j < 8; ++j) {
            if (FP8_QKV) ((unsigned*)(F.ws + (DRY ? WS_OPART + 128 * MiB : WS_XN)) + (size_t)t * (D / 4))[64 * j + F.lane] = pk4_fp8(v[j].x * (rstd * SC_XN), v[j].y * (rstd * SC_XN), v[j].z * (rstd * SC_XN), v[j].w * (rstd * SC_XN));
            else { u32x2 w; w.x = pk2(v[j].x * rstd, v[j].y * rstd); w.y = pk2(v[j].z * rstd, v[j].w * rstd); o8[64 * j] = w; } }
    }
}

typedef int ci32x4 __attribute__((ext_vector_type(4)));
struct CombRows { u32x2 x[8]; unsigned b0[8], b1[8]; float w0, w1; };
template <bool NORM> __device__ __forceinline__ void combine_tokens(Frame& F, CArgs& a, int t0, int stride) {
    static_assert(OUT8_L0 && OUT8_L1 && FP8_QKV, "pipelined combine: e4m3 expert rows and e4m3 XN");
    const LAS int* blkstart = (const LAS int*)(F.lds + LT_BLKSTART);
    LAS ci32x4* lrec = (LAS ci32x4*)(F.lds + F.wave * 256);
    const int lane = F.lane;
    auto issue = [&](int k, int t, CombRows& R) {
        const ci32x4 r0 = lrec[2 * k], r1 = lrec[2 * k + 1];
        const int e0 = __builtin_amdgcn_readfirstlane(r0.x), rr0 = __builtin_amdgcn_readfirstlane(r0.y), e1 = __builtin_amdgcn_readfirstlane(r0.w), rr1 = __builtin_amdgcn_readfirstlane(r1.x);
        const LAS float* wf = (const LAS float*)lrec + 8 * k; R.w0 = wf[2] * (1.0f / SC_OUT); R.w1 = wf[5] * (1.0f / SC_OUT);
        const size_t row0 = (size_t)blkstart[e0] * 256 + rr0, row1 = (size_t)blkstart[e1] * 256 + rr1;
        const unsigned* q0 = (const unsigned*)(F.ws + WS_OUTB + row0 * D) + lane; const unsigned* q1 = (const unsigned*)(F.ws + WS_OUTB + row1 * D) + lane;
        const u32x2* xr = (const u32x2*)((const bf16*)(F.ws + WS_XR) + (size_t)t * D) + lane;
#pragma unroll
        for (int j = 0; j < 8; ++j) { R.x[j] = xr[64 * j]; R.b0[j] = q0[64 * j]; R.b1[j] = q1[64 * j]; }
    };
    auto finish = [&](int t, const CombRows& R) {
        u32x2* xr = (u32x2*)((bf16*)(F.ws + WS_XR) + (size_t)t * D) + lane; f32x4* xo = (f32x4*)(a.out + (size_t)t * D) + lane;
        f32x4 v[8]; float s = 0.f;
#pragma unroll
        for (int j = 0; j < 8; ++j) { f32x4 x = (f32x4){bflo(R.x[j].x), bfhi(R.x[j].x), bflo(R.x[j].y), bfhi(R.x[j].y)};
            const f32x2 l0 = __builtin_amdgcn_cvt_pk_f32_fp8((int)R.b0[j], false), h0 = __builtin_amdgcn_cvt_pk_f32_fp8((int)R.b0[j], true), l1 = __builtin_amdgcn_cvt_pk_f32_fp8((int)R.b1[j], false), h1 = __builtin_amdgcn_cvt_pk_f32_fp8((int)R.b1[j], true);
            x.x += R.w0 * l0.x + R.w1 * l1.x; x.y += R.w0 * l0.y + R.w1 * l1.y; x.z += R.w0 * h0.x + R.w1 * h1.x; x.w += R.w0 * h0.y + R.w1 * h1.y;
            v[j] = x; if (NORM) { u32x2 w_; w_.x = pk2(x.x, x.y); w_.y = pk2(x.z, x.w); xr[64 * j] = w_; } else xo[64 * j] = x; s += (x.x * x.x + x.y * x.y) + (x.z * x.z + x.w * x.w); }
        if (NORM) {
            const float rstd = __builtin_amdgcn_rsqf(wave_sum(s) * (1.f / D) + RMS_EPS) * SC_XN;
            unsigned* o = (unsigned*)(F.ws + WS_XN) + (size_t)t * (D / 4) + lane;
#pragma unroll
            for (int j = 0; j < 8; ++j) o[64 * j] = pk4_fp8(v[j].x * rstd, v[j].y * rstd, v[j].z * rstd, v[j].w * rstd);
        }
    };
    for (int base = t0; base < M; base += 8 * stride) {
        const int nt = min(8, (M - base + stride - 1) / stride);
        if (lane < 2 * nt) lrec[lane] = ((const ci32x4*)(F.ws + WS_TOKREC))[2 * (size_t)(base + (lane >> 1) * stride) + (lane & 1)];
        LDS_WAIT(); asm volatile("s_waitcnt vmcnt(0)" ::: "memory"); LDS_WAIT();
        CombRows cur, nxt; issue(0, base, cur);
        for (int k = 0; k < nt; ++k) {
            if (k + 1 < nt) issue(k + 1, base + (k + 1) * stride, nxt);
            finish(base + k * stride, cur);
            cur = nxt;
        }
        LDS_WAIT();
    }
}
__device__ __forceinline__ void hgrn_naive_item(Frame& F, int item) {
    const int b = item >> 6, h = (item >> 2) & 15, sl = item & 3;
    const bf16* Zq = (const bf16*)(F.ws + WS_ZQ); const bf16* Zk = (const bf16*)(F.ws + WS_ZK); const _Float16* Zg = (const _Float16*)(F.ws + WS_ZG); const bf16* Zv = (const bf16*)(F.ws + WS_ZV);
    float* Oraw = (float*)(F.ws + WS_ORAW);
    LAS float* fq = (LAS float*)F.lds; LAS float* fk = fq + 16 * 128; LAS float* ff = fk + 16 * 128; LAS float* fv = ff + 16 * 128; LAS float* part = fv + 16 * 32;
    const int dv = F.tid & 31, dkg = F.tid >> 5;
    float S[8];
#pragma unroll
    for (int j = 0; j < 8; ++j) S[j] = 0.f;
    const size_t tok0 = (size_t)b * T;
    for (int c = 0; c < T / 16; ++c) {
        __syncthreads();
#pragma unroll
        for (int i = 0; i < 4; ++i) { const int idx = F.tid + i * 512, st = idx >> 7, dk = idx & 127; const size_t g = (tok0 + c * 16 + st) * D + h * HD + dk;
            fq[idx] = bf2f(Zq[g]); fk[idx] = bf2f(Zk[g]); ff[idx] = __expf((float)Zg[g]); }
        { const int st = F.tid >> 5; fv[F.tid] = bf2f(Zv[(tok0 + c * 16 + st) * D + h * HD + sl * 32 + dv]); }
        __syncthreads();
#pragma unroll 4
        for (int st = 0; st < 16; ++st) {
            const float v = fv[st * 32 + dv];
            const f32x4 q0 = *(const LAS f32x4*)(fq + st * 128 + dkg * 8), q1 = *(const LAS f32x4*)(fq + st * 128 + dkg * 8 + 4);
            const f32x4 k0 = *(const LAS f32x4*)(fk + st * 128 + dkg * 8), k1 = *(const LAS f32x4*)(fk + st * 128 + dkg * 8 + 4);
            const f32x4 f0 = *(const LAS f32x4*)(ff + st * 128 + dkg * 8), f1 = *(const LAS f32x4*)(ff + st * 128 + dkg * 8 + 4);
            float po = 0.f;
#pragma unroll
            for (int j = 0; j < 4; ++j) { S[j] = f0[j] * S[j] + k0[j] * v; po += q0[j] * S[j]; S[4 + j] = f1[j] * S[4 + j] + k1[j] * v; po += q1[j] * S[4 + j]; }
            part[(st * 16 + dkg) * 32 + dv] = po;
        }
        __syncthreads();
        { const int st = F.tid >> 5; float o = 0.f;
#pragma unroll
            for (int g = 0; g < 16; ++g) o += part[(st * 16 + g) * 32 + dv];
            Oraw[(tok0 + c * 16 + st) * D + h * HD + sl * 32 + dv] = o; }
    }
    __syncthreads();
}
__device__ __forceinline__ void hgrn_norm_token(Frame& F, CArgs& a, int t) {
    const float* o = (const float*)(F.ws + WS_ORAW) + (size_t)t * D + F.lane * 32;
    const bf16* zg = (const bf16*)(F.ws + WS_ZGATE) + (size_t)t * D + F.lane * 32;
    const float* gain = a.in[I_A_OGAIN] + (F.lane & 3) * 32;
    f32x4 v[8]; float s = 0.f;
#pragma unroll
    for (int j = 0; j < 8; ++j) { v[j] = ((const f32x4*)o)[j]; s += (v[j].x * v[j].x + v[j].y * v[j].y) + (v[j].z * v[j].z + v[j].w * v[j].w); }
    s += __shfl_xor(s, 1); s += __shfl_xor(s, 2);
    const float rstd = 1.0f / sqrtf(s * (1.f / HD) + RMS_EPS);
    bf16* out = (bf16*)(F.ws + WS_OH) + (size_t)t * D + F.lane * 32;
#pragma unroll
    for (int j = 0; j < 4; ++j) { const u32x4 g = ((const u32x4*)zg)[j]; const f32x4 ga = ((const f32x4*)gain)[2 * j], gb = ((const f32x4*)gain)[2 * j + 1]; const f32x4 va = v[2 * j], vb = v[2 * j + 1];
        u32x4 w; w.x = pk2(va.x * rstd * ga.x * bflo(g.x), va.y * rstd * ga.y * bfhi(g.x)); w.y = pk2(va.z * rstd * ga.z * bflo(g.y), va.w * rstd * ga.w * bfhi(g.y));
        w.z = pk2(vb.x * rstd * gb.x * bflo(g.z), vb.y * rstd * gb.y * bfhi(g.z)); w.w = pk2(vb.z * rstd * gb.z * bflo(g.w), vb.w * rstd * gb.w * bfhi(g.w));
        ((u32x4*)out)[j] = w; }
}

template <bool DRY> __device__ __forceinline__ void qk_post_item(Frame& F, CArgs& a, int item) {
    const int b = item >> 6, n = (item >> 2) & 15, hq = item & 3;
    const int hl = F.lane >> 4, sb = F.lane & 15, h = hq * 4 + hl;
    bf16* Q = (bf16*)(F.ws + WS_Q); bf16* Kb = (bf16*)(F.ws + WS_K);
    const f32x2* rope = (const f32x2*)(F.ws + WS_ROPE);
    const f32x4 gq0 = *(const f32x4*)(a.in[I_B_Q_NORM] + 4 * sb), gq1 = *(const f32x4*)(a.in[I_B_Q_NORM] + 64 + 4 * sb);
    const f32x4 gk0 = *(const f32x4*)(a.in[I_K_NORM] + 4 * sb), gk1 = *(const f32x4*)(a.in[I_K_NORM] + 64 + 4 * sb);
    float ks[8];
#pragma unroll
    for (int j = 0; j < 8; ++j) ks[j] = 0.f;
    for (int i = 0; i < 32; ++i) {
        const int pos = n * MBLK + F.wave * 32 + i; const size_t tok = (size_t)b * T + pos;
        f32x2 cs[4];
#pragma unroll
        for (int j = 0; j < 4; ++j) cs[j] = rope[pos * 64 + 4 * sb + j];
#pragma unroll
        for (int which = 0; which < 2; ++which) {
            bf16* p = (which ? Kb : Q) + tok * D + h * HD + 4 * sb;
            const u32x2 lo = *(const u32x2*)p, hi = *(const u32x2*)(p + 64);
            float x1[4] = {bflo(lo.x), bfhi(lo.x), bflo(lo.y), bfhi(lo.y)}, x2[4] = {bflo(hi.x), bfhi(hi.x), bflo(hi.y), bfhi(hi.y)};
            float s = 0.f;
#pragma unroll
            for (int j = 0; j < 4; ++j) s += x1[j] * x1[j] + x2[j] * x2[j];
            s += __shfl_xor(s, 1); s += __shfl_xor(s, 2); s += __shfl_xor(s, 4); s += __shfl_xor(s, 8);
            const float rstd = 1.0f / sqrtf(s * (1.f / HD) + RMS_EPS);
            const f32x4 g0 = which ? gk0 : gq0, g1 = which ? gk1 : gq1;
            float o1[4], o2[4];
#pragma unroll
            for (int j = 0; j < 4; ++j) { const float y1 = x1[j] * rstd * g0[j], y2 = x2[j] * rstd * g1[j]; o1[j] = y1 * cs[j].x - y2 * cs[j].y; o2[j] = y2 * cs[j].x + y1 * cs[j].y; }
            u32x2 wlo, whi; wlo.x = pk2(o1[0], o1[1]); wlo.y = pk2(o1[2], o1[3]); whi.x = pk2(o2[0], o2[1]); whi.y = pk2(o2[2], o2[3]);
            { bf16* pw = DRY ? p + (WS_OPART - WS_Q) / 2 : p; *(u32x2*)pw = wlo; *(u32x2*)(pw + 64) = whi; }
            if (which) {
#pragma unroll
                for (int j = 0; j < 4; ++j) { ks[j] += o1[j]; ks[4 + j] += o2[j]; } }
        }
    }
    LAS float* red = (LAS float*)F.lds;
    __syncthreads();
#pragma unroll
    for (int j = 0; j < 8; ++j) red[(F.wave * 64 + F.lane) * 8 + j] = ks[j];
    __syncthreads();
    { const int l = F.tid >> 3, j = F.tid & 7; float s = 0.f;
#pragma unroll
        for (int w = 0; w < 8; ++w) s += red[(w * 64 + l) * 8 + j];
        const int hh = hq * 4 + (l >> 4), s2 = l & 15, d = (j < 4) ? 4 * s2 + j : 64 + 4 * s2 + (j - 4);
        ((float*)(F.ws + (DRY ? WS_OPART + 200 * MiB : WS_KMEAN)))[(((size_t)b * H + hh) * NBLK + n) * HD + d] = s * (1.0f / MBLK); }
    const bf16* V = (const bf16*)(F.ws + WS_V); bf16* Vt = (bf16*)(F.ws + (DRY ? WS_OPART + 128 * MiB : WS_VT));
    LAS bf16* vl = (LAS bf16*)(F.lds + 32768);
    for (int hh = 0; hh < 4; ++hh) {
        const int hv = hq * 4 + hh;
        __syncthreads();
#pragma unroll
        for (int i = 0; i < 8; ++i) { const int ch = F.tid + i * 512, r = ch >> 4, cc = ch & 15;
            const u32x4 w = *(const u32x4*)(V + ((size_t)b * T + n * MBLK + r) * D + hv * HD + cc * 8);
            *(LAS u32x4*)(vl + r * 136 + cc * 8) = w; }
        __syncthreads();
#pragma unroll
        for (int i = 0; i < 8; ++i) { const int idx = F.tid + i * 512, d = idx & 127, tg = idx >> 7;
            unsigned short e[8];
#pragma unroll
            for (int j = 0; j < 8; ++j) e[j] = vl[(tg * 8 + j) * 136 + d];
            u32x4 w; w.x = e[0] | ((unsigned)e[1] << 16); w.y = e[2] | ((unsigned)e[3] << 16); w.z = e[4] | ((unsigned)e[5] << 16); w.w = e[6] | ((unsigned)e[7] << 16);
            *(u32x4*)(Vt + (((size_t)b * H + hv) * HD + d) * T + n * MBLK + tg * 8) = w; }
    }
    __syncthreads();
}

__device__ __forceinline__ void attn_v0_item(Frame& F, int item) {
    const int b = item >> 8, h = (item >> 4) & 15, jb = item & 15;
    const bf16* Q = (const bf16*)(F.ws + WS_Q); const bf16* Kb = (const bf16*)(F.ws + WS_K); const bf16* Vt = (const bf16*)(F.ws + WS_VT); bf16* OA = (bf16*)(F.ws + WS_OA);
    const float* kmean = (const float*)(F.ws + WS_KMEAN) + ((size_t)b * H + h) * NBLK * HD;
    const int lane = F.lane, fr = lane & 15, fq = lane >> 4;
    const size_t tokw = (size_t)b * T + jb * MBLK + F.wave * 32;
    LAS unsigned* maskl = (LAS unsigned*)(F.lds + F.wave * 8192);
    LAS bf16* pl = (LAS bf16*)(F.lds + F.wave * 8192 + 256);
    {
        const int row = lane & 31, half = lane >> 5;
        float g[8];
#pragma unroll
        for (int i = 0; i < 8; ++i) g[i] = 0.f;
        const bf16* qrow = Q + (tokw + row) * D + h * HD;
        for (int dc = 0; dc < 16; ++dc) {
            const u32x4 w = *(const u32x4*)(qrow + dc * 8);
            const float qv[8] = {bflo(w.x), bfhi(w.x), bflo(w.y), bfhi(w.y), bflo(w.z), bfhi(w.z), bflo(w.w), bfhi(w.w)};
#pragma unroll
            for (int i = 0; i < 8; ++i) { const float* km = kmean + (2 * i + half) * HD + dc * 8;
#pragma unroll
                for (int e = 0; e < 8; ++e) g[i] += qv[e] * km[e]; }
        }
        float ga[16];
#pragma unroll
        for (int i = 0; i < 8; ++i) { const float o = __shfl_xor(g[i], 32); ga[2 * i] = half ? o : g[i]; ga[2 * i + 1] = half ? g[i] : o; }
        unsigned mask = 0u;
#pragma unroll
        for (int pick = 0; pick < 3; ++pick) { float best = -INFINITY; int bi = -1;
#pragma unroll
            for (int n = 0; n < 16; ++n) { const bool ok = (n < jb) && !((mask >> n) & 1u); if (ok && ga[n] > best) { best = ga[n]; bi = n; } }
            if (bi >= 0) mask |= 1u << bi; }
        if (half == 0) maskl[row] = mask;
    }
    LDS_WAIT(); __builtin_amdgcn_wave_barrier();
    unsigned rmask[2][4]; unsigned anym = 0u;
#pragma unroll
    for (int rt = 0; rt < 2; ++rt)
#pragma unroll
        for (int r = 0; r < 4; ++r) { rmask[rt][r] = maskl[rt * 16 + 4 * fq + r]; }
    { unsigned m = maskl[lane & 31];
#pragma unroll
      for (int o = 1; o < 32; o <<= 1) m |= __shfl_xor(m, o);
      anym = __builtin_amdgcn_readfirstlane(m); }
    bf16x8 qf[2][4];
#pragma unroll
    for (int rt = 0; rt < 2; ++rt)
#pragma unroll
        for (int ks = 0; ks < 4; ++ks) qf[rt][ks] = *(const bf16x8*)(Q + (tokw + rt * 16 + fr) * D + h * HD + ks * 32 + 8 * fq);
    f32x4 oacc[2][8];
#pragma unroll
    for (int rt = 0; rt < 2; ++rt)
#pragma unroll
        for (int dt = 0; dt < 8; ++dt) oacc[rt][dt] = (f32x4){0.f, 0.f, 0.f, 0.f};
    float lsum[2][4];
#pragma unroll
    for (int rt = 0; rt < 2; ++rt)
#pragma unroll
        for (int r = 0; r < 4; ++r) lsum[rt][r] = 0.f;
    const float c2 = 0.08838834764831845f * 1.4426950408889634f;
    const int nkt = 4 * jb + 4;
    for (int kt = 0; kt < nkt; ++kt) {
        const int n = kt >> 2; const bool own = (n == jb);
        if (!own && !((anym >> n) & 1u)) continue;
        if (own && (kt & 3) * 64 > F.wave * 32 + 31) continue;
        const size_t key0 = (size_t)b * T + kt * 64;
        f32x4 sacc[2][4];
#pragma unroll
        for (int ct = 0; ct < 4; ++ct) {
            bf16x8 kf[4];
#pragma unroll
            for (int ks = 0; ks < 4; ++ks) kf[ks] = *(const bf16x8*)(Kb + (key0 + ct * 16 + fr) * D + h * HD + ks * 32 + 8 * fq);
#pragma unroll
            for (int rt = 0; rt < 2; ++rt) { f32x4 s = (f32x4){0.f, 0.f, 0.f, 0.f};
#pragma unroll
                for (int ks = 0; ks < 4; ++ks) s = __builtin_amdgcn_mfma_f32_16x16x32_bf16(qf[rt][ks], kf[ks], s, 0, 0, 0);
                sacc[rt][ct] = s; }
        }
#pragma unroll
        for (int rt = 0; rt < 2; ++rt)
#pragma unroll
            for (int ct = 0; ct < 4; ++ct)
#pragma unroll
                for (int r = 0; r < 4; ++r) {
                    const int qrow = rt * 16 + 4 * fq + r, kcol = ct * 16 + fr;
                    const bool ok = own ? ((kt & 3) * 64 + kcol <= F.wave * 32 + qrow) : ((rmask[rt][r] >> n) & 1u);
                    const float p = ok ? __builtin_amdgcn_exp2f(sacc[rt][ct][r] * c2) : 0.f;
                    lsum[rt][r] += p;
                    pl[qrow * 72 + kcol] = (bf16)f2bf(p);
                }
        LDS_WAIT(); __builtin_amdgcn_wave_barrier();
        bf16x8 pf[2][2];
#pragma unroll
        for (int rt = 0; rt < 2; ++rt)
#pragma unroll
            for (int k2 = 0; k2 < 2; ++k2) pf[rt][k2] = *(const LAS bf16x8*)(pl + (rt * 16 + fr) * 72 + k2 * 32 + 8 * fq);
#pragma unroll
        for (int dt = 0; dt < 8; ++dt) {
            bf16x8 vf[2];
#pragma unroll
            for (int k2 = 0; k2 < 2; ++k2) vf[k2] = *(const bf16x8*)(Vt + (((size_t)b * H + h) * HD + dt * 16 + fr) * T + kt * 64 + k2 * 32 + 8 * fq);
#pragma unroll
            for (int rt = 0; rt < 2; ++rt)
#pragma unroll
                for (int k2 = 0; k2 < 2; ++k2) oacc[rt][dt] = __builtin_amdgcn_mfma_f32_16x16x32_bf16(pf[rt][k2], vf[k2], oacc[rt][dt], 0, 0, 0);
        }
        LDS_WAIT(); __builtin_amdgcn_wave_barrier();
    }
#pragma unroll
    for (int rt = 0; rt < 2; ++rt)
#pragma unroll
        for (int r = 0; r < 4; ++r) { float s = lsum[rt][r]; s += __shfl_xor(s, 1); s += __shfl_xor(s, 2); s += __shfl_xor(s, 4); s += __shfl_xor(s, 8); const float inv = 1.0f / s;
            bf16* orow = OA + (tokw + rt * 16 + 4 * fq + r) * D + h * HD + fr;
#pragma unroll
            for (int dt = 0; dt < 8; ++dt) orow[dt * 16] = (bf16)f2bf(oacc[rt][dt][r] * inv); }
}

typedef float f32x16 __attribute__((ext_vector_type(16)));
template <bool DRY> __device__ __forceinline__ void moba_gate_item(Frame& F, int item) {
    const int bh = item >> 3, p = item & 7, b = bh >> 4, h = bh & 15;
    LAS float* km = (LAS float*)F.lds;
    __syncthreads();
    { const f32x4 v = ((const f32x4*)((const float*)(F.ws + WS_KMEAN) + (size_t)bh * NBLK * HD))[F.tid]; ((LAS f32x4*)km)[F.tid] = v; }
    __syncthreads();
    const int j = 2 * p + (F.wave >> 2), t = j * MBLK + (F.wave & 3) * 64 + F.lane;
    if (j == 0) return;
    const unsigned char* qrow = F.ws + WS_Q + ((size_t)b * T + t) * D + h * HD;
    float g[16];
#pragma unroll
    for (int n = 0; n < 16; ++n) g[n] = 0.f;
    for (int dc = 0; dc < 8; ++dc) {
        const u32x4 w = *(const u32x4*)(qrow + dc * 16);
        float qv[16]; { float t4[4]; fp8x4_to_f32(w.x, t4); qv[0] = t4[0]; qv[1] = t4[1]; qv[2] = t4[2]; qv[3] = t4[3]; fp8x4_to_f32(w.y, t4); qv[4] = t4[0]; qv[5] = t4[1]; qv[6] = t4[2]; qv[7] = t4[3];
            fp8x4_to_f32(w.z, t4); qv[8] = t4[0]; qv[9] = t4[1]; qv[10] = t4[2]; qv[11] = t4[3]; fp8x4_to_f32(w.w, t4); qv[12] = t4[0]; qv[13] = t4[1]; qv[14] = t4[2]; qv[15] = t4[3]; }
#pragma unroll
        for (int n = 0; n < 15; ++n) if (n < j) {
#pragma unroll
            for (int q4 = 0; q4 < 4; ++q4) { const f32x4 k0 = *(const LAS f32x4*)(km + n * HD + dc * 16 + 4 * q4);
                g[n] += (qv[4 * q4] * k0.x + qv[4 * q4 + 1] * k0.y) + (qv[4 * q4 + 2] * k0.z + qv[4 * q4 + 3] * k0.w); } }
    }
    int pk[3];
    unsigned mask = 0u;
#pragma unroll
    for (int pick = 0; pick < 3; ++pick) { float best = -INFINITY; int bi = -1;
#pragma unroll
        for (int n = 0; n < 15; ++n) { const bool ok = (n < j) && !((mask >> n) & 1u); if (ok && g[n] > best) { best = g[n]; bi = n; } }
        if (bi >= 0) mask |= 1u << bi;
        pk[pick] = bi; }
    unsigned* acnt = F.ctl + CW_ACNT + bh * 16; int* alist = (int*)(F.ws + WS_ALIST) + (size_t)bh * 16 * ALIST_CAP;
    unsigned mycnt = 0u;
#pragma unroll
    for (int n = 0; n < 15; ++n) if (n < j) { const unsigned long long bal = __ballot((mask >> n) & 1u); mycnt = (F.lane == n) ? (unsigned)__popcll(bal) : mycnt; }
    unsigned mybase = 0u;
    if (F.lane < 15 && mycnt > 0u && !DRY) mybase = atomicAdd(acnt + F.lane, mycnt);
#pragma unroll
    for (int n = 0; n < 15; ++n) if (n < j) {
        const bool sel = (mask >> n) & 1u; const int slot = (pk[0] == n) ? 0 : ((pk[1] == n) ? 1 : 2);
        const unsigned long long bal = __ballot(sel);
        if (bal) { const unsigned base = (unsigned)__builtin_amdgcn_readlane((int)mybase, n);
            const int rank = __popcll(bal & ((1ull << F.lane) - 1ull));
            if (sel) (DRY ? (int*)(F.ws + WS_OPART) : alist)[n * ALIST_CAP + base + rank] = t | (slot << 16); }
    }
}

constexpr int AL_K = 0, AL_V = 36864; constexpr float SC_P = 4.f;
typedef int i32x8v __attribute__((ext_vector_type(8)));
__device__ __forceinline__ i32x8v ld32(const LAS unsigned char* p) { const u32x4 a = *(const LAS u32x4*)p, b = *(const LAS u32x4*)(p + 16); i32x8v r; r[0] = a.x; r[1] = a.y; r[2] = a.z; r[3] = a.w; r[4] = b.x; r[5] = b.y; r[6] = b.z; r[7] = b.w; return r; }
template <bool OWN> __device__ __forceinline__ void attn_chunk(Frame& F, int b, int h, int n, int c, int cnt, const int* lst) {
    const int lane = F.lane, qi = lane & 31, hh = lane >> 5, w = F.wave;
    const int rem = OWN ? MBLK : cnt - c * 256;
    if (w * 32 >= rem) return;
    int t, slot; bool valid = true;
    if (OWN) { t = n * MBLK + w * 32 + qi; slot = 3; }
    else { const int idx = w * 32 + qi; valid = idx < rem; const int e = lst[c * 256 + (valid ? idx : 0)]; t = e & 0xffff; slot = e >> 16; }
    const size_t tok = (size_t)b * T + t;
    const unsigned char* qrow = F.ws + WS_Q + tok * D + h * HD;
    i32x8v qf[2];
#pragma unroll
    for (int ks = 0; ks < 2; ++ks) { const u32x4 a = *(const u32x4*)(qrow + 64 * ks + 32 * hh), bq = *(const u32x4*)(qrow + 64 * ks + 32 * hh + 16);
        qf[ks][0] = a.x; qf[ks][1] = a.y; qf[ks][2] = a.z; qf[ks][3] = a.w; qf[ks][4] = bq.x; qf[ks][5] = bq.y; qf[ks][6] = bq.z; qf[ks][7] = bq.w; }
    const LAS unsigned char* Kl = F.lds + AL_K; const LAS unsigned char* Vl = F.lds + AL_V;
    f32x16 oacc[4];
#pragma unroll
    for (int dt = 0; dt < 4; ++dt)
#pragma unroll
        for (int r = 0; r < 16; ++r) oacc[dt][r] = 0.f;
    float lsum = 0.f, mrun = -1e30f;
    const float c2 = 0.08838834764831845f * 1.4426950408889634f / (SC_QKV * SC_QKV);
    const int ngrp = OWN ? ((w >> 1) + 1) : 4;
#pragma unroll
    for (int G = 0; G < 4; ++G) {
        if (G >= ngrp) break;
        f32x16 sa, sb;
#pragma unroll
        for (int r = 0; r < 16; ++r) { sa[r] = 0.f; sb[r] = 0.f; }
#pragma unroll
        for (int ks = 0; ks < 2; ++ks) {
            const i32x8v ka = ld32(Kl + (64 * G + qi) * 144 + 64 * ks + 32 * hh), kb = ld32(Kl + (64 * G + 32 + qi) * 144 + 64 * ks + 32 * hh);
            sa = __builtin_amdgcn_mfma_scale_f32_32x32x64_f8f6f4(ka, qf[ks], sa, 0, 0, 0, 0, 0, 0);
            sb = __builtin_amdgcn_mfma_scale_f32_32x32x64_f8f6f4(kb, qf[ks], sb, 0, 0, 0, 0, 0, 0);
        }
        float tv[32];
#pragma unroll
        for (int r = 0; r < 16; ++r) { tv[r] = sa[r]; tv[16 + r] = sb[r]; }
        if (OWN && G == (w >> 1)) {
#pragma unroll
            for (int p = 0; p < 32; ++p) { const int key = 64 * G + 32 * (p >> 4) + (p & 3) + 8 * ((p >> 2) & 3) + 4 * hh; tv[p] = (key <= w * 32 + qi) ? tv[p] : -3e38f; }
        }
        float ml = tv[0];
#pragma unroll
        for (int p = 1; p < 32; ++p) ml = fmaxf(ml, tv[p]);
        ml = fmaxf(ml, __shfl_xor(ml, 32)) * c2;
        const float mnew = (ml > mrun + 6.0f) ? ml : mrun;
        const bool moved = (mnew != mrun);
        const float alpha = __builtin_amdgcn_exp2f(mrun - mnew);
        mrun = mnew;
        float ps = 0.f; i32x8v pf;
#pragma unroll
        for (int q4 = 0; q4 < 8; ++q4) { float e4[4];
#pragma unroll
            for (int j = 0; j < 4; ++j) { e4[j] = __builtin_amdgcn_exp2f(__builtin_fmaf(tv[4 * q4 + j], c2, -mnew)); ps += e4[j]; }
            int pw_ = __builtin_amdgcn_cvt_pk_fp8_f32(e4[0] * SC_P, e4[1] * SC_P, 0, false); pw_ = __builtin_amdgcn_cvt_pk_fp8_f32(e4[2] * SC_P, e4[3] * SC_P, pw_, true); pf[q4] = pw_; }
        lsum = lsum * alpha + ps;
        if (G > 0 && __any(moved)) {
#pragma unroll
            for (int dt = 0; dt < 4; ++dt)
#pragma unroll
                for (int r = 0; r < 16; ++r) oacc[dt][r] *= alpha;
        }
#pragma unroll
        for (int dt = 0; dt < 4; ++dt) {
            const i32x8v vf = ld32(Vl + (32 * dt + qi) * 272 + 64 * G + 32 * hh);
            oacc[dt] = __builtin_amdgcn_mfma_scale_f32_32x32x64_f8f6f4(vf, pf, oacc[dt], 0, 0, 0, 0, 0, 0);
        }
    }
    lsum += __shfl_xor(lsum, 32);
    if (valid) {
        unsigned char* op = F.ws + WS_OPART + ((size_t)slot * M + tok) * D + h * HD;
        const float pinv = __builtin_amdgcn_rcpf(lsum) * (SC_PART / (SC_QKV * SC_P));
        unsigned wq[4][4];
#pragma unroll
        for (int dt = 0; dt < 4; ++dt)
#pragma unroll
            for (int g4 = 0; g4 < 4; ++g4) wq[dt][g4] = pk4_fp8(oacc[dt][4 * g4 + 0] * pinv, oacc[dt][4 * g4 + 1] * pinv, oacc[dt][4 * g4 + 2] * pinv, oacc[dt][4 * g4 + 3] * pinv);
        u32x4 st[4];
#pragma unroll
        for (int d2 = 0; d2 < 2; ++d2)
#pragma unroll
            for (int g4 = 0; g4 < 4; ++g4) { const unsigned give = hh ? wq[d2][g4] : wq[2 + d2][g4], keep = hh ? wq[2 + d2][g4] : wq[d2][g4];
                const unsigned got = (unsigned)__shfl_xor((int)give, 32);
                const unsigned w_even = hh ? got : keep, w_odd = hh ? keep : got;
                st[2 * d2 + (g4 >> 1)][2 * (g4 & 1)] = w_even; st[2 * d2 + (g4 >> 1)][2 * (g4 & 1) + 1] = w_odd; }
#pragma unroll
        for (int q = 0; q < 4; ++q) *(u32x4*)(op + 64 * hh + 16 * q) = st[q];
        if (hh == 0) { f32x2 lm; lm.x = lsum; lm.y = mrun; ((f32x2*)(F.ws + WS_LPART))[((size_t)slot * M + tok) * H + h] = lm; }
    }
}
__device__ __forceinline__ void attn_group(Frame& F, int bh, int n) {
    const int b = bh >> 4, h = bh & 15;
    const gcptr Kg = opaque_s(F.ws + WS_K + ((size_t)b * T + n * MBLK) * D + h * HD);
    const gcptr Vg = opaque_s(F.ws + WS_V + ((size_t)b * T + n * MBLK) * D + h * HD);
    const int tg = make_tid(F.wave);
    __syncthreads();
#pragma unroll
    for (int i = 0; i < 4; ++i) { const int ch = tg + i * 512;
        { const int r = ch >> 3, cc = ch & 7; *(LAS u32x4*)(F.lds + AL_K + r * 144 + cc * 16) = *(const GAS u32x4*)(Kg + (unsigned)(r * D + cc * 16)); }
        { const int rl = ch & 63, cc = (ch >> 6) & 7, G = ch >> 9, r = 64 * G + rl;
          const u32x4 vv = *(const GAS u32x4*)(Vg + (unsigned)(r * D + cc * 16)); const unsigned vw[4] = {vv.x, vv.y, vv.z, vv.w};
          LAS unsigned char* vd = F.lds + AL_V + (16 * cc) * 272 + 64 * G + 32 * ((rl >> 2) & 1) + 4 * (rl >> 3) + (rl & 3);
#pragma unroll
          for (int e = 0; e < 16; ++e) vd[e * 272] = (unsigned char)(vw[e >> 2] >> (8 * (e & 3))); }
    }
    __syncthreads();
    attn_chunk<true>(F, b, h, n, 0, 0, nullptr);
    if (n < 15) {
        const int cnt = (int)__hip_atomic_load(F.ctl + CW_ACNT + bh * 16 + n, __ATOMIC_RELAXED, __HIP_MEMORY_SCOPE_AGENT);
        const int* lst = (const int*)(F.ws + WS_ALIST) + ((size_t)bh * 16 + n) * ALIST_CAP;
        for (int c = 0; c * 256 < cnt; ++c) attn_chunk<false>(F, b, h, n, c, cnt, lst);
    }
}
struct AttnCombRegs { f32x2 lm[4]; u32x4 w[4][2]; };
__device__ __forceinline__ void attn_combine_load(Frame& F, int tok, AttnCombRegs& R) {
    const int j = (tok & (T - 1)) >> 8, nsl = j < 3 ? j : 3, hd = F.lane >> 2;
#pragma unroll
    for (int s4 = 0; s4 < 4; ++s4) { const bool valid = (s4 == 0) || (s4 - 1 < nsl); const int s_ = valid ? ((s4 == 0) ? 3 : s4 - 1) : 3;
        R.lm[s4] = ((const f32x2*)(F.ws + WS_LPART))[((size_t)s_ * M + tok) * H + hd];
        const u32x4* p = (const u32x4*)(F.ws + WS_OPART + ((size_t)s_ * M + tok) * D + F.lane * 32); R.w[s4][0] = p[0]; R.w[s4][1] = p[1]; }
}
__device__ __forceinline__ void attn_combine_finish(Frame& F, int tok, const AttnCombRegs& R) {
    const int j = (tok & (T - 1)) >> 8, nsl = j < 3 ? j : 3;
    f32x2 lm[4]; float mx = -1e30f;
#pragma unroll
    for (int s4 = 0; s4 < 4; ++s4) { const bool valid = (s4 == 0) || (s4 - 1 < nsl); lm[s4] = valid ? R.lm[s4] : (f32x2){0.f, -1e30f}; mx = fmaxf(mx, lm[s4].y); }
    float acc[32]; float l = 0.f;
#pragma unroll
    for (int i = 0; i < 32; ++i) acc[i] = 0.f;
#pragma unroll
    for (int s4 = 0; s4 < 4; ++s4) {
        const float ls = lm[s4].x * __builtin_amdgcn_exp2f(lm[s4].y - mx);
        const u32x4 w0 = R.w[s4][0], w1 = R.w[s4][1]; const unsigned wd[8] = {w0.x, w0.y, w0.z, w0.w, w1.x, w1.y, w1.z, w1.w};
#pragma unroll
        for (int i = 0; i < 8; ++i) { const f32x2 lo = __builtin_amdgcn_cvt_pk_f32_fp8((int)wd[i], false), hi = __builtin_amdgcn_cvt_pk_f32_fp8((int)wd[i], true);
            acc[4 * i] += lo.x * ls; acc[4 * i + 1] += lo.y * ls; acc[4 * i + 2] += hi.x * ls; acc[4 * i + 3] += hi.y * ls; }
        l += ls; }
    const float inv = __builtin_amdgcn_rcpf(l) * (1.0f / SC_PART);
    if (FP8_OUTB) { const float iv = inv * SC_OA; u32x4* o8 = (u32x4*)(F.ws + WS_OA + (size_t)tok * D + F.lane * 32);
#pragma unroll
        for (int i = 0; i < 2; ++i) { u32x4 w; w.x = pk4_fp8(acc[16 * i] * iv, acc[16 * i + 1] * iv, acc[16 * i + 2] * iv, acc[16 * i + 3] * iv); w.y = pk4_fp8(acc[16 * i + 4] * iv, acc[16 * i + 5] * iv, acc[16 * i + 6] * iv, acc[16 * i + 7] * iv);
            w.z = pk4_fp8(acc[16 * i + 8] * iv, acc[16 * i + 9] * iv, acc[16 * i + 10] * iv, acc[16 * i + 11] * iv); w.w = pk4_fp8(acc[16 * i + 12] * iv, acc[16 * i + 13] * iv, acc[16 * i + 14] * iv, acc[16 * i + 15] * iv); o8[i] = w; }
        return; }
    u32x4* o = (u32x4*)((bf16*)(F.ws + WS_OA) + (size_t)tok * D + F.lane * 32);
#pragma unroll
    for (int i = 0; i < 4; ++i) { u32x4 w; w.x = pk2(acc[8 * i] * inv, acc[8 * i + 1] * inv); w.y = pk2(acc[8 * i + 2] * inv, acc[8 * i + 3] * inv); w.z = pk2(acc[8 * i + 4] * inv, acc[8 * i + 5] * inv); w.w = pk2(acc[8 * i + 6] * inv, acc[8 * i + 7] * inv); o[i] = w; }
}
__device__ __forceinline__ void attn_combine_tokens(Frame& F, int t0, int stride) {
    static_assert(SC_PART > 0, "");
    AttnCombRegs A, B;
    int t = t0; if (t >= M) return;
    attn_combine_load(F, t, A);
    for (;;) {
        const int tn = t + stride; const bool more = tn < M;
        if (more) attn_combine_load(F, tn, B);
        attn_combine_finish(F, t, A);
        if (!more) break;
        A = B; t = tn;
    }
}
constexpr size_t WS_SLOC = WS_ORAW;
constexpr size_t WS_DLOG = WS_ORAW + 16 * MiB;
constexpr int HL_A = 0, HL_BM = 17408, HL_BMT = 34816, HL_VT = 53248, HL_SPT = 71680, HL_P = 106496, HL_EGR = 115712, HL_EEND = 116224, HL_QSUM = 116736, HL_SSQ = 118784,
              HL_STQ = HL_SPT, HL_STK = HL_SPT + 17408, HL_STG = 119808, HL_STV = 119808 + 17408;
#define HG_BAR() do { asm volatile("s_waitcnt lgkmcnt(0)" ::: "memory"); __builtin_amdgcn_s_barrier(); asm volatile("" ::: "memory"); } while (0)
template <bool FULL> __device__ __forceinline__ void hgrn_item(Frame& F, CArgs& a, int item) {
    const int bh = item >> 2, seg = item & 3, b = bh >> 4, h = bh & 15;
    if (!FULL && seg == 3) return;
    const int lane = F.lane, qi = lane & 31, hh = lane >> 5, w = F.wave;
    const int kk = F.tid & 127, tq = F.tid >> 7;
    const int vt = w & 3, ktb = 2 * (w >> 2);
    const bf16* Zq = (const bf16*)(F.ws + WS_ZQ); const bf16* Zk = (const bf16*)(F.ws + WS_ZK); const _Float16* Zg = (const _Float16*)(F.ws + WS_ZG); const bf16* Zv = (const bf16*)(F.ws + WS_ZV);
    LAS unsigned char* L = F.lds;
    LAS float* eGr = (LAS float*)(L + HL_EGR); LAS float* eEnd = (LAS float*)(L + HL_EEND); LAS float* qsum = (LAS float*)(L + HL_QSUM); LAS float* ssq = (LAS float*)(L + HL_SSQ);
    f32x16 S[2];
#pragma unroll
    for (int i = 0; i < 2; ++i)
#pragma unroll
        for (int r = 0; r < 16; ++r) S[i][r] = 0.f;
    if (FULL && seg > 0) {
        const float* sl = (const float*)(F.ws + WS_SLOC) + (size_t)bh * 3 * HD * HD; const float* dl = (const float*)(F.ws + WS_DLOG) + (size_t)bh * 3 * HD;
        LAS float* tile = (LAS float*)L; LAS float* fac = (LAS float*)(L + 65536);
        float dsum = 0.f;
        for (int s_ = seg - 1; s_ >= 0; --s_) {
            __syncthreads();
            const f32x4* src = (const f32x4*)(sl + (size_t)s_ * HD * HD);
#pragma unroll
            for (int i = 0; i < 8; ++i) ((LAS f32x4*)tile)[F.tid + i * 512] = src[F.tid + i * 512];
            if (F.tid < 128) { fac[F.tid] = __expf(dsum); dsum += dl[s_ * HD + F.tid]; }
            __syncthreads();
            const LAS float* tl = tile + (4 * hh) * HD + 32 * vt + qi; const LAS float* fl = fac + 4 * hh;
#pragma unroll
            for (int i = 0; i < 2; ++i)
#pragma unroll
                for (int r = 0; r < 16; ++r) { const int dkc = 32 * (ktb + i) + (r & 3) + 8 * (r >> 2); S[i][r] += fl[dkc] * tl[dkc * HD]; }
        }
    }
    float gtot = 0.f;
    u32x4 rq[2], rk[2], rg[2], rv[2];
#define HG_PREFETCH(cc) do { const size_t tk_ = (size_t)b * T + (size_t)(seg * 16 + (cc)) * 64; _Pragma("unroll") for (int i_ = 0; i_ < 2; ++i_) { const int row_ = 16 * (w >> 1) + (lane >> 3) + 8 * i_, ch_ = 8 * (w & 1) + (lane & 7); const size_t go_ = (tk_ + row_) * D + h * HD + ch_ * 8; \
        rk[i_] = *(const u32x4*)(Zk + go_); rg[i_] = *(const u32x4*)((const bf16*)Zg + go_); rv[i_] = *(const u32x4*)(Zv + go_); if (FULL) rq[i_] = *(const u32x4*)(Zq + go_); } } while (0)
    HG_PREFETCH(0);
    __syncthreads();
    for (int c = 0; c < 16; ++c) {
        const size_t tok0 = (size_t)b * T + (size_t)(seg * 16 + c) * 64;
#pragma unroll
        for (int i = 0; i < 2; ++i) { const int so = (16 * (w >> 1) + (lane >> 3) + 8 * i) * 272 + (8 * (w & 1) + (lane & 7)) * 16;
            *(LAS u32x4*)(L + HL_STK + so) = rk[i]; *(LAS u32x4*)(L + HL_STG + so) = rg[i]; *(LAS u32x4*)(L + HL_STV + so) = rv[i]; if (FULL) *(LAS u32x4*)(L + HL_STQ + so) = rq[i]; }
        LDS_WAIT();
        float gl[16];
        { float run = 0.f;
#pragma unroll
            for (int i = 0; i < 16; ++i) { run += (float)*(const LAS _Float16*)(L + HL_STG + (16 * tq + i) * 272 + kk * 2); gl[i] = run; }
            qsum[tq * 128 + kk] = run; }
        HG_BAR();
        {
            const float q0 = qsum[kk], q1 = qsum[128 + kk], q2 = qsum[256 + kk], q3 = qsum[384 + kk];
            const float pre = (tq > 0 ? q0 : 0.f) + (tq > 1 ? q1 : 0.f) + (tq > 2 ? q2 : 0.f), Gr = q0 + q1, Gend = (q0 + q1) + (q2 + q3);
            unsigned bt[8], vtw[8];
#pragma unroll
            for (int i = 0; i < 16; i += 2) {
                const int t0 = 16 * tq + i;
                const float G0 = pre + gl[i], G1 = pre + gl[i + 1];
                const float eb0 = __expf(Gr - G0), eb1 = __expf(Gr - G1);
                const float b0 = bf2f(*(const LAS bf16*)(L + HL_STK + t0 * 272 + kk * 2)) * eb0, b1 = bf2f(*(const LAS bf16*)(L + HL_STK + (t0 + 1) * 272 + kk * 2)) * eb1;
                bt[i >> 1] = pk2(b0, b1);
                vtw[i >> 1] = (unsigned)*(const LAS bf16*)(L + HL_STV + t0 * 272 + kk * 2) | ((unsigned)*(const LAS bf16*)(L + HL_STV + (t0 + 1) * 272 + kk * 2) << 16);
                if (FULL) { const float ea0 = __expf(G0 - Gr), ea1 = __expf(G1 - Gr);
                    const float qa = bf2f(*(const LAS bf16*)(L + HL_STQ + t0 * 272 + kk * 2)), qb = bf2f(*(const LAS bf16*)(L + HL_STQ + (t0 + 1) * 272 + kk * 2));
                    *(LAS bf16*)(L + HL_A + t0 * 272 + kk * 2) = (bf16)f2bf(qa * ea0); *(LAS bf16*)(L + HL_A + (t0 + 1) * 272 + kk * 2) = (bf16)f2bf(qb * ea1);
                    *(LAS bf16*)(L + HL_BM + t0 * 272 + kk * 2) = (bf16)(bt[i >> 1] & 0xffffu); *(LAS bf16*)(L + HL_BM + (t0 + 1) * 272 + kk * 2) = (bf16)(bt[i >> 1] >> 16); }
                __builtin_amdgcn_sched_barrier(0);
            }
            *(LAS u32x4*)(L + HL_BMT + kk * 144 + tq * 32) = (u32x4){bt[0], bt[1], bt[2], bt[3]}; *(LAS u32x4*)(L + HL_BMT + kk * 144 + tq * 32 + 16) = (u32x4){bt[4], bt[5], bt[6], bt[7]};
            *(LAS u32x4*)(L + HL_VT + kk * 144 + tq * 32) = (u32x4){vtw[0], vtw[1], vtw[2], vtw[3]}; *(LAS u32x4*)(L + HL_VT + kk * 144 + tq * 32 + 16) = (u32x4){vtw[4], vtw[5], vtw[6], vtw[7]};
            if (tq == 0) { eGr[kk] = __expf(Gr); eEnd[kk] = __expf(Gend - Gr); }
            gtot += Gend;
        }
        HG_BAR();
        if (c + 1 < 16) HG_PREFETCH(c + 1);
#pragma unroll
        for (int i = 0; i < 2; ++i)
#pragma unroll
            for (int g4 = 0; g4 < 4; ++g4) { const int dk0 = 32 * (ktb + i) + 8 * g4 + 4 * hh; const f32x4 e = *(const LAS f32x4*)(eGr + dk0);
#pragma unroll
                for (int j = 0; j < 4; ++j) S[i][4 * g4 + j] *= e[j];
                if (FULL) { u32x2 wv; wv.x = pg8::cvt_pk_bf16_n(S[i][4 * g4], S[i][4 * g4 + 1]); wv.y = pg8::cvt_pk_bf16_n(S[i][4 * g4 + 2], S[i][4 * g4 + 3]);
                    *(LAS u32x2*)(L + HL_SPT + (32 * vt + qi) * 272 + dk0 * 2) = wv; } }
        if (FULL && w < 3) {
            const int st = (w == 2) ? 1 : 0, tt = (w == 0) ? 0 : 1;
            f32x16 sc;
#pragma unroll
            for (int r = 0; r < 16; ++r) sc[r] = 0.f;
#pragma unroll
            for (int ks = 0; ks < 8; ++ks) { const bf16x8 af = *(const LAS bf16x8*)(L + HL_BM + (32 * st + qi) * 272 + (16 * ks + 8 * hh) * 2); const bf16x8 bfr = *(const LAS bf16x8*)(L + HL_A + (32 * tt + qi) * 272 + (16 * ks + 8 * hh) * 2);
                sc = __builtin_amdgcn_mfma_f32_32x32x16_bf16(af, bfr, sc, 0, 0, 0); }
#pragma unroll
            for (int g4 = 0; g4 < 4; ++g4) { const int s0 = 32 * st + 8 * g4 + 4 * hh, t = 32 * tt + qi; float p[4];
#pragma unroll
                for (int j = 0; j < 4; ++j) p[j] = sc[4 * g4 + j] * __builtin_amdgcn_fmed3f((float)(t - (s0 + j) + 1), 0.f, 1.f);
                u32x2 wv; wv.x = pg8::cvt_pk_bf16_n(p[0], p[1]); wv.y = pg8::cvt_pk_bf16_n(p[2], p[3]);
                *(LAS u32x2*)(L + HL_P + t * 144 + s0 * 2) = wv; }
        }
#pragma unroll
        for (int ks2 = 0; ks2 < 4; ++ks2) { const bf16x8 vf = *(const LAS bf16x8*)(L + HL_VT + (32 * vt + qi) * 144 + (16 * ks2 + 8 * hh) * 2);
#pragma unroll
            for (int i = 0; i < 2; ++i) { const bf16x8 bf_ = *(const LAS bf16x8*)(L + HL_BMT + (32 * (ktb + i) + qi) * 144 + (16 * ks2 + 8 * hh) * 2);
                S[i] = __builtin_amdgcn_mfma_f32_32x32x16_bf16(bf_, vf, S[i], 0, 0, 0); } }
#pragma unroll
        for (int i = 0; i < 2; ++i)
#pragma unroll
            for (int g4 = 0; g4 < 4; ++g4) { const int dk0 = 32 * (ktb + i) + 8 * g4 + 4 * hh; const f32x4 e = *(const LAS f32x4*)(eEnd + dk0);
#pragma unroll
                for (int j = 0; j < 4; ++j) S[i][4 * g4 + j] *= e[j]; }
        if (FULL) {
            HG_BAR();
            const int tt = w & 1, dt = w >> 1, t = 32 * tt + qi;
            f32x16 o;
#pragma unroll
            for (int r = 0; r < 16; ++r) o[r] = 0.f;
#pragma unroll
            for (int ks = 0; ks < 8; ++ks) { const bf16x8 af = *(const LAS bf16x8*)(L + HL_SPT + (32 * dt + qi) * 272 + (16 * ks + 8 * hh) * 2); const bf16x8 bfr = *(const LAS bf16x8*)(L + HL_A + t * 272 + (16 * ks + 8 * hh) * 2);
                o = __builtin_amdgcn_mfma_f32_32x32x16_bf16(af, bfr, o, 0, 0, 0); }
#pragma unroll
            for (int ks2 = 0; ks2 < 4; ++ks2) if (ks2 < 2 * (tt + 1)) { const bf16x8 af = *(const LAS bf16x8*)(L + HL_VT + (32 * dt + qi) * 144 + (16 * ks2 + 8 * hh) * 2); const bf16x8 bfr = *(const LAS bf16x8*)(L + HL_P + t * 144 + (16 * ks2 + 8 * hh) * 2);
                o = __builtin_amdgcn_mfma_f32_32x32x16_bf16(af, bfr, o, 0, 0, 0); }
            float sq = 0.f;
#pragma unroll
            for (int r = 0; r < 16; ++r) sq += o[r] * o[r];
            sq += __shfl_xor(sq, 32);
            if (hh == 0) ssq[dt * 64 + t] = sq;
            HG_BAR();
            const float tot = (ssq[t] + ssq[64 + t]) + (ssq[128 + t] + ssq[192 + t]);
            const float rstd = __builtin_amdgcn_rsqf(tot * (1.f / HD) + RMS_EPS);
            const size_t ro = (tok0 + t) * D + h * HD;
#pragma unroll
            for (int g4 = 0; g4 < 4; ++g4) { const int dv0 = 32 * dt + 8 * g4 + 4 * hh;
                const u32x2 gt = *(const u32x2*)((const bf16*)(F.ws + WS_ZGATE) + ro + dv0); const f32x4 gn = *(const f32x4*)(a.in[I_A_OGAIN] + dv0);
                u32x2 wv; wv.x = pg8::cvt_pk_bf16_n(o[4 * g4] * rstd * gn.x * bflo(gt.x), o[4 * g4 + 1] * rstd * gn.y * bfhi(gt.x)); wv.y = pg8::cvt_pk_bf16_n(o[4 * g4 + 2] * rstd * gn.z * bflo(gt.y), o[4 * g4 + 3] * rstd * gn.w * bfhi(gt.y));
                *(u32x2*)((bf16*)(F.ws + WS_OH) + ro + dv0) = wv; }
        }
    }
#undef HG_PREFETCH
    if (!FULL) {
        float* sl = (float*)(F.ws + WS_SLOC) + ((size_t)bh * 3 + seg) * HD * HD;
#pragma unroll
        for (int i = 0; i < 2; ++i)
#pragma unroll
            for (int r = 0; r < 16; ++r) { const int dk = 32 * (ktb + i) + (r & 3) + 8 * (r >> 2) + 4 * hh; sl[(size_t)dk * HD + 32 * vt + qi] = S[i][r]; }
        if (tq == 0) ((float*)(F.ws + WS_DLOG))[((size_t)bh * 3 + seg) * HD + kk] = gtot;
    }
    __syncthreads();
}

constexpr int N_PHASES = 19;
#ifndef REP_MASK
#define REP_MASK 0
#endif
#define NREP(k) ((((REP_MASK) >> (k)) & 1) ? 2 : 1)
__global__ void __launch_bounds__(NTHR, 2) fwd(Args args_kernarg) {
    extern __shared__ __attribute__((aligned(16))) unsigned char lds_raw[];
    Frame F;
    CArgs* pa = (CArgs*)__builtin_amdgcn_kernarg_segment_ptr();
#define args (*pa)
    F.lds = (LAS unsigned char*)lds_raw; F.ws = args.ws; F.ctl = (unsigned*)(args.ws + WS_CTL);
    F.wave = __builtin_amdgcn_readfirstlane((int)threadIdx.x >> 6); F.tid = make_tid(F.wave); F.lane = F.tid & 63;
    F.G = gridDim.x; { const int bx = blockIdx.x; F.vcu = (F.G % 8 == 0) ? (bx % 8) * (F.G / 8) + bx / 8 : bx; }
    F.gw = F.vcu * NWAVES + F.wave; F.NGW = F.G * NWAVES;
    for (int u = F.tid; u < (LDS_BYTES - LDSCTL_OFF) / 4; u += NTHR) ((LAS unsigned*)(F.lds + LDSCTL_OFF))[u] = 0u;
    __syncthreads();
    const int lo = args.ph_lo, hi = args.ph_hi;
    const bool multi = (hi - lo) > 1;
    XcdBarrier bar; bar.bar = F.ctl + CW_BAR; bar.x = 0; bar.st = nullptr;
    if (multi) bar = xcd_barrier_post(F.ctl + CW_BAR, (volatile LAS unsigned*)(F.lds + LDSCTL_OFF), F.tid);
#define REFRESH() do { pa = (CArgs*)__builtin_amdgcn_kernarg_segment_ptr(); asm volatile("" : "+s"(pa)); ws = args.ws; F.ws = ws; F.ctl = (unsigned*)(ws + WS_CTL); const int t_ = make_tid(F.wave); F.tid = t_; F.lane = t_ & 63; F.gw = F.vcu * NWAVES + F.wave; } while (0)
#define IN(k) (lo <= (k) && (k) < hi)
#define SEAM(k) do { if (IN(k) && IN((k) + 1)) xcd_barrier(bar, make_tid(F.wave)); } while (0)
    unsigned char* ws = args.ws;
    (void)args_kernarg;
    const int GT = F.NGW * 64;

    if (IN(0)) _Pragma("unroll") for (int rep_ = 0; rep_ < NREP(0); ++rep_) { REFRESH();
        const int gtid = F.gw * 64 + F.lane;
        LAS float* scr = (LAS float*)(F.lds + F.wave * TR_SCR_BYTES);
        constexpr int J0 = 16 * 256;
        tr_run([&](int it) { TrItem t; t.src = args.in[I_A_W_IN]; t.ksc = args.in[I_NORM_MIX]; t.dst = ws + WS_WIN; t.N = 4 * D; t.K = D; t.k0 = 128 * (it / 256); t.n0 = 32 * (it % 256); t.drow0 = t.n0; t.flags = 0; t.osc = 1.f; return t; },
               F.gw, J0, F.NGW, scr, F.lane);
        for (int c = gtid; c < D; c += GT) { const float* L = args.in[I_A_LB]; const float l0 = L[c], l1 = L[D + c], l2 = L[2 * D + c]; const float mx = fmaxf(l0, fmaxf(l1, l2));
            const float e0 = expf(l0 - mx), e1 = expf(l1 - mx), e2 = expf(l2 - mx); ((float*)(ws + WS_LB))[c] = e0 / (e0 + e1 + e2); }
        for (int i = gtid; i < 2 * 36 * D; i += GT) { const int l = i / (36 * D), r = (i / D) % 36, k = i % D;
            ((float*)(ws + WS_RT))[i] = r < 4 ? args.in[I_W_GROUP][((size_t)l * D + k) * NG + r] : args.in[I_W_EXPERT][((size_t)l * D + k) * NE + (r - 4)]; }
        { const int fi = gtid & 63; const float inv = exp2f(-(float)fi * (13.287712379549449f / 64.0f));
          for (int i = gtid; i < T * 64; i += GT) { const float ang = (float)(i >> 6) * inv; float sn_, cs_; sincosf(ang, &sn_, &cs_); ((f32x2*)(ws + WS_ROPE))[i] = (f32x2){cs_, sn_}; } }
        for (int m = F.gw; m < M; m += F.NGW) rms_row_to_bf16(args.in[I_X] + (size_t)m * D, (bf16*)(ws + WS_XN) + (size_t)m * D, F.lane);
    }
    SEAM(0);
    if (IN(1)) _Pragma("unroll") for (int rep_ = 0; rep_ < NREP(1); ++rep_) { REFRESH();
        constexpr int NCV = 112, J1 = 16 * 64, J2 = 16 * 128, J3 = 16 * 64, J4 = 16 * 64, J5 = MOE_CV_ITEMS;
        if ((int)blockIdx.x < NCV) {
            LAS float* scr = (LAS float*)(F.lds + F.wave * TR_SCR_BYTES);
            tr_run([&](int r) { TrItem t; t.osc = 1.f; t.ksc = nullptr; t.flags = 0; t.N = D; t.K = D;
                    if (r < J1) { t.src = args.in[I_A_W_OUT]; t.dst = ws + WS_WOA; t.k0 = 128 * (r / 64); t.n0 = 32 * (r % 64); t.drow0 = t.n0; return t; } r -= J1;
                    if (r < J2) { const int nb = r % 128; t.src = args.in[I_KV_W]; t.ksc = args.in[I_KV_NORM]; t.dst = ws + WS_WQKV; t.N = 2 * D; t.k0 = 128 * (r / 128); t.n0 = 32 * nb; t.drow0 = D + t.n0;
                                  t.flags = (FP8_QKV ? 2 : 0) | (nb < 64 ? 1 : 0); t.osc = FP8_QKV ? SC_W : 1.f; return t; } r -= J2;
                    if (r < J3) { t.src = args.in[I_B_W_Q]; t.ksc = args.in[I_NORM_MIX] + D; t.dst = ws + WS_WQKV; t.k0 = 128 * (r / 64); t.n0 = 32 * (r % 64); t.drow0 = t.n0; t.flags = (FP8_QKV ? 2 : 0) | 1; t.osc = FP8_QKV ? SC_W : 1.f; return t; } r -= J3;
                    if (r < J4) { t.src = args.in[I_B_W_OUT]; t.dst = ws + WS_WOB; t.k0 = 128 * (r / 64); t.n0 = 32 * (r % 64); t.drow0 = t.n0; t.flags = FP8_OUTB ? 2 : 0; t.osc = FP8_OUTB ? SC_W : 1.f; return t; } r -= J4;
                    return moe_cv_item(args, ws, 0, r); },
                   (int)blockIdx.x * NWAVES + F.wave, J1 + J2 + J3 + J4 + J5, NCV * NWAVES, scr, F.lane);
            __syncthreads();
        }
        pg8::DynOrder S; S.init(ws + WS_XN, ws + WS_WIN, M, 4 * D, D, F.wave, F.ctl + CW_DYN, (LAS int*)(F.lds + LDSCTL_OFF + 32));
        pg8::EpiHgrnIn E{ws + WS_R, (const float*)(ws + WS_LB)};
        pg8::gemm_phase<pg8::EpiHgrnIn, pg8::DynOrder, true>(F.lds, S, E);
    }
    SEAM(1);
    if (IN(2)) _Pragma("unroll") for (int rep_ = 0; rep_ < NREP(2); ++rep_) { REFRESH(); for (int it = F.vcu; it < 256; it += F.G) hgrn_item<false>(F, args, it); }
    SEAM(2);
    if (IN(3)) _Pragma("unroll") for (int rep_ = 0; rep_ < NREP(3); ++rep_) { REFRESH(); for (int it = F.vcu; it < 256; it += F.G) hgrn_item<true>(F, args, it); }
    SEAM(3);
    if (IN(4)) _Pragma("unroll") for (int rep_ = 0; rep_ < NREP(4); ++rep_) { REFRESH();
        pg8::DenseOrder S; S.init(ws + WS_OH, ws + WS_WOA, M, D, D, F.G, (int)blockIdx.x, F.wave);
        pg8::EpiRes16<true> E{(bf16*)(ws + WS_XR), args.in[I_X], 1.0f};
        pg8::gemm_phase<pg8::EpiRes16<true>, pg8::DenseOrder, true>(F.lds, S, E);
    }
    SEAM(4);
#define MOE_LAYER(P, layer, F8, O8) \
    if (IN(P)) { REFRESH(); for (int t = F.gw; t < M; t += 2 * F.NGW) { if (t + F.NGW < M) route_pair<F8>(F, args, layer, t, t + F.NGW); else route_token<false, F8>(F, args, layer, t); } } \
    SEAM(P); \
    if (IN((P) + 1)) _Pragma("unroll") for (int rep_ = 0; rep_ < NREP((P) + 1); ++rep_) { REFRESH(); const int nrb = __builtin_amdgcn_readfirstlane(moe_tables(F, layer)); \
        pg8::MoeOrder<true> S; S.A = (const char*)(ws + WS_XN); S.B = (const char*)(ws + WS_WGU + (size_t)(layer) * WGU_LSTRIDE); S.estride = (size_t)1024 * D * (F8 ? 1 : 2); S.K = D; S.RB = F8 ? D : 2 * D; S.NT = 4; S.total = nrb * 4; S.G = F.G; S.c = F.vcu; S.wv = F.wave; \
        S.blk_e = (const LAS int*)(F.lds + LT_BLKE); S.blkstart = (const LAS int*)(F.lds + LT_BLKSTART); S.cnt = (const LAS int*)(F.lds + LT_CNT); S.list = (const int*)(ws + WS_LISTS); \
        pg8::EpiSwiGLU<F8> E{(bf16*)(ws + WS_ACT), F8 ? 1.0f / (SC_XN * SC_W) : 1.0f}; \
        pg8::gemm_phase<pg8::EpiSwiGLU<F8>, pg8::MoeOrder<true>, true, F8>(F.lds, S, E); } \
    SEAM((P) + 1); \
    if (IN((P) + 2)) _Pragma("unroll") for (int rep_ = 0; rep_ < NREP((P) + 2); ++rep_) { REFRESH(); const int nrb = __builtin_amdgcn_readfirstlane(moe_tables(F, layer)); \
        pg8::MoeOrder<false> S; S.A = (const char*)(ws + WS_ACT); S.B = (const char*)(ws + WS_WD + (size_t)(layer) * WD_LSTRIDE); S.estride = (size_t)D * FF * (F8 ? 1 : 2); S.K = FF; S.RB = F8 ? FF : 2 * FF; S.NT = 8; S.total = nrb * 8; S.G = F.G; S.c = F.vcu; S.wv = F.wave; \
        S.blk_e = (const LAS int*)(F.lds + LT_BLKE); S.blkstart = (const LAS int*)(F.lds + LT_BLKSTART); S.cnt = (const LAS int*)(F.lds + LT_CNT); S.list = (const int*)(ws + WS_LISTS); \
        if constexpr (O8) { pg8::EpiOut8 E{ws + WS_OUTB, D, (F8 ? 1.0f / (SC_ACT * SC_WD) : 1.0f) * SC_OUT}; pg8::gemm_phase<pg8::EpiOut8, pg8::MoeOrder<false>, true, F8>(F.lds, S, E); } \
        else { pg8::EpiBf16 E{(bf16*)(ws + WS_OUTB), D, 0, 0, F8 ? 1.0f / (SC_ACT * SC_WD) : 1.0f}; pg8::gemm_phase<pg8::EpiBf16, pg8::MoeOrder<false>, true, F8>(F.lds, S, E); } } \
    SEAM((P) + 2);
    MOE_LAYER(5, 0, FP8_MOE0, OUT8_L0)
    if (IN(8)) { REFRESH();
        (void)moe_tables(F, 0);
        combine_tokens<true>(F, args, F.gw, F.NGW);
    }
    SEAM(8);
    if (IN(9)) _Pragma("unroll") for (int rep_ = 0; rep_ < NREP(9); ++rep_) { REFRESH();
        constexpr int NCV2 = 112;
        if ((int)blockIdx.x < NCV2) {
            LAS float* scr = (LAS float*)(F.lds + F.wave * TR_SCR_BYTES);
            tr_run([&](int it) { return moe_cv_item(args, ws, 1, it); }, (int)blockIdx.x * NWAVES + F.wave, MOE_CV_ITEMS, NCV2 * NWAVES, scr, F.lane);
            __syncthreads();
        }
        pg8::DynOrder S; S.init(ws + WS_XN, ws + WS_WQKV, M, 3 * D, D, F.wave, F.ctl + CW_DYN + 64, (LAS int*)(F.lds + LDSCTL_OFF + 32), FP8_QKV);
        pg8::EpiQKV E{(bf16*)(ws + WS_Q), (bf16*)(ws + WS_K), (bf16*)(ws + WS_V), args.in[I_B_Q_NORM], args.in[I_K_NORM], (const f32x2*)(ws + WS_ROPE), (float*)(ws + WS_KMEAN), F.lds + 131072, FP8_QKV ? 1.0f / (SC_XN * SC_W) : 1.0f, F.wave};
        pg8::gemm_phase<pg8::EpiQKV, pg8::DynOrder, true, FP8_QKV>(F.lds, S, E);
    }
    SEAM(9);
    if (IN(11)) { REFRESH(); if (NREP(11) == 2) { for (int it = F.vcu; it < 64 * 8; it += F.G) moba_gate_item<true>(F, it); } for (int it = F.vcu; it < 64 * 8; it += F.G) moba_gate_item<false>(F, it); }
    SEAM(11);
    if (IN(12)) _Pragma("unroll") for (int rep_ = 0; rep_ < NREP(12); ++rep_) { REFRESH();
        for (int v = F.vcu; v < 256; v += F.G) { const int bh = v >> 2, q = v & 3;
            _Pragma("unroll 1") for (int gi = 0; gi < 4; ++gi) { const int n = (gi == 0) ? q : ((gi == 1) ? 7 - q : ((gi == 2) ? 8 + q : 15 - q)); attn_group(F, bh, n); } }
    }
    SEAM(12);
    if (IN(13)) _Pragma("unroll") for (int rep_ = 0; rep_ < NREP(13); ++rep_) { REFRESH(); attn_combine_tokens(F, F.gw, F.NGW); }
    SEAM(13);
    if (IN(14)) { REFRESH();
        pg8::DenseOrder S; S.init(ws + WS_OA, ws + WS_WOB, M, D, D, F.G, (int)blockIdx.x, F.wave, FP8_OUTB);
        pg8::EpiRes16<false> E{(bf16*)(ws + WS_XR), nullptr, FP8_OUTB ? 1.0f / (SC_OA * SC_W) : 1.0f};
        pg8::gemm_phase<pg8::EpiRes16<false>, pg8::DenseOrder, true, FP8_OUTB>(F.lds, S, E);
    }
    SEAM(14);
    MOE_LAYER(15, 1, FP8_MOE1, OUT8_L1)
    if (IN(18)) { REFRESH(); (void)moe_tables(F, 1); combine_tokens<false>(F, args, F.gw, F.NGW); }
#undef IN
#undef SEAM
#undef MOE_LAYER
#undef args
}

#ifndef MK_N_LAUNCHES
#define MK_N_LAUNCHES 1
#endif
#ifndef DBG_STOP
#define DBG_STOP N_PHASES
#endif
extern "C" void kernel_launch(void* const* d_in, const int* in_sizes, int n_in, void* d_out, int out_size, void* d_ws, size_t ws_size, hipStream_t stream) {
    static int grid = 0;
    if (grid == 0) {
        if (n_in != 20 || in_sizes[0] != M * D || out_size != M * D || ws_size < WS_END) { fprintf(stderr, "kernel_launch: unexpected shapes (n_in %d, in0 %d, out %d, ws %zu < %zu); nothing launched\n", n_in, n_in > 0 ? in_sizes[0] : -1, out_size, ws_size, (size_t)WS_END); grid = -1; return; }
        int dev = 0, cus = 0, per_cu = 0;
        if (hipGetDevice(&dev) != hipSuccess || hipDeviceGetAttribute(&cus, hipDeviceAttributeMultiprocessorCount, dev) != hipSuccess) { grid = -1; return; }
        if (hipFuncSetAttribute((const void*)fwd, hipFuncAttributeMaxDynamicSharedMemorySize, LDS_BYTES) != hipSuccess) { fprintf(stderr, "kernel_launch: hipFuncSetAttribute failed\n"); grid = -1; return; }
        if (hipOccupancyMaxActiveBlocksPerMultiprocessor(&per_cu, (const void*)fwd, NTHR, LDS_BYTES) != hipSuccess || per_cu < 1) { fprintf(stderr, "kernel_launch: occupancy query says %d blocks per CU\n", per_cu); }
        (void)hipGetLastError();
        grid = cus;
    }
    if (grid < 0) return;
    (void)hipMemsetAsync((char*)d_ws + WS_CTL, 0, CTL_ZERO_BYTES, stream);
    Args a{};
    for (int i = 0; i < 20; ++i) a.in[i] = (const float*)d_in[i];
    a.out = (float*)d_out; a.ws = (unsigned char*)d_ws;
    if (MK_N_LAUNCHES == 1) { a.ph_lo = 0; a.ph_hi = N_PHASES; hipLaunchKernelGGL(fwd, dim3(grid), dim3(NTHR), LDS_BYTES, stream, a); }
    else for (int p = 0; p < DBG_STOP; ++p) { a.ph_lo = p; a.ph_hi = p + 1; hipLaunchKernelGGL(fwd, dim3(grid), dim3(NTHR), LDS_BYTES, stream, a); }
}
```

```cpp
#include <hip/hip_runtime.h>
#include <cstdio>
#include <cstdint>

#define GAS __attribute__((address_space(1)))
#define LAS __attribute__((address_space(3)))
typedef unsigned short bf16;
typedef short bf16x8 __attribute__((ext_vector_type(8)));
typedef float f32x4 __attribute__((ext_vector_type(4)));
typedef float f32x2 __attribute__((ext_vector_type(2)));
typedef unsigned u32x4 __attribute__((ext_vector_type(4)));
typedef unsigned u32x2 __attribute__((ext_vector_type(2)));

constexpr int BATCH = 4, T = 4096, D = 2048, M = BATCH * T, H = 16, HD = 128;
constexpr int NBLK = 16, MBLK = 256;
constexpr int NG = 4, EPG = 8, NE = 32, FF = 512;
constexpr float RMS_EPS = 1e-6f;
constexpr int NWAVES = 8, NTHR = 512;
constexpr int LIST_CAP = 16384;
constexpr int MAXRB = 160;

constexpr size_t MiB = 1u << 20;
constexpr size_t WS_CTL = 0, CTL_ZERO_BYTES = 1 * MiB;
constexpr size_t WS_LISTS = 1 * MiB;
constexpr size_t WS_TOKREC = 3 * MiB;
constexpr size_t WS_LB = 4 * MiB;
constexpr size_t WS_RT = 4 * MiB + 65536;
constexpr size_t WS_ROPE = 5 * MiB;
constexpr size_t WS_KMEAN = 7 * MiB;
constexpr size_t WS_WIN = 8 * MiB, WS_WOA = 40 * MiB, WS_WQKV = 48 * MiB, WS_WOB = 72 * MiB;
constexpr size_t WS_WGU = 80 * MiB, WS_WD = 208 * MiB;
constexpr size_t WS_XN = 272 * MiB;
constexpr size_t WS_ACT = 336 * MiB;
constexpr size_t WS_R = 376 * MiB;
constexpr size_t WS_ZQ = WS_R, WS_ZK = WS_R + 64 * MiB, WS_ZG = WS_R + 128 * MiB, WS_ZV = WS_R + 192 * MiB, WS_ZGATE = WS_R + 256 * MiB;
constexpr size_t WS_ORAW = WS_R + 320 * MiB;
constexpr size_t WS_OH = WS_R + 448 * MiB;
constexpr size_t WS_OUTB = WS_R;
constexpr size_t WS_Q = WS_R, WS_K = WS_R + 64 * MiB, WS_V = WS_R + 128 * MiB, WS_VT = WS_R + 192 * MiB, WS_OA = WS_R + 256 * MiB;
constexpr size_t WS_XR = WS_R + 192 * MiB;
constexpr size_t WS_OPART = WS_R + 320 * MiB;
constexpr size_t WS_LPART = WS_R + 576 * MiB;
constexpr size_t WS_ALIST = WS_R + 584 * MiB;
constexpr int ALIST_CAP = 3840;
constexpr size_t WS_END = WS_R + 604 * MiB;
constexpr int CW_TMO = 0;
constexpr int CW_BAR = 4096;
constexpr int CW_CNT = 8192;
#define CW_CNT_AT(l, e) (CW_CNT + 2048 * (l) + 64 * (e))
constexpr int CW_ACNT = 16384;
constexpr int CW_DYN = 20480;

constexpr int RING_BYTES = 159744;
constexpr int LDSCTL_OFF = RING_BYTES;
constexpr int LT_BLKE = LDSCTL_OFF + 64;
constexpr int LT_BLKSTART = LT_BLKE + MAXRB * 4;
constexpr int LT_CNT = LT_BLKSTART + 36 * 4;
constexpr int LT_END = LT_CNT + 32 * 4;
constexpr int LDS_BYTES = 163840;
static_assert(LT_END <= LDS_BYTES, "LDS map");

__device__ __forceinline__ unsigned f2bf(float f) { unsigned u = __builtin_bit_cast(unsigned, f); return (u + 0x7fffu + ((u >> 16) & 1u)) >> 16; }
__device__ __forceinline__ unsigned pk2(float lo, float hi) { return f2bf(lo) | (f2bf(hi) << 16); }
__device__ __forceinline__ float bf2f(unsigned b) { return __builtin_bit_cast(float, b << 16); }
__device__ __forceinline__ float bflo(unsigned w) { return __builtin_bit_cast(float, w << 16); }
__device__ __forceinline__ float bfhi(unsigned w) { return __builtin_bit_cast(float, w & 0xffff0000u); }
__device__ __forceinline__ float wave_sum(float v) {
#pragma unroll
    for (int o = 1; o < 64; o <<= 1) v += __shfl_xor(v, o);
    return v;
}
#ifndef FP8_QKV
#define FP8_QKV 1
#endif
#ifndef FP8_OUTB
#define FP8_OUTB 1
#endif
#ifndef FP8_MOE1
#define FP8_MOE1 1
#endif
#ifndef FP8_MOE0
#define FP8_MOE0 1
#endif
#ifndef OUT8_L0
#define OUT8_L0 1
#endif
#ifndef OUT8_L1
#define OUT8_L1 1
#endif
constexpr float SC_XN = 16.f, SC_W = 1024.f, SC_ACT = 8.f, SC_WD = 512.f, SC_OA = 64.f, SC_PART = 64.f, SC_OUT = 32.f, SC_QKV = 32.f;
__device__ __forceinline__ unsigned pk4_fp8(float a, float b, float c, float d) {
    a = __builtin_amdgcn_fmed3f(a, -448.f, 448.f); b = __builtin_amdgcn_fmed3f(b, -448.f, 448.f); c = __builtin_amdgcn_fmed3f(c, -448.f, 448.f); d = __builtin_amdgcn_fmed3f(d, -448.f, 448.f);
    int p = __builtin_amdgcn_cvt_pk_fp8_f32(a, b, 0, false); p = __builtin_amdgcn_cvt_pk_fp8_f32(c, d, p, true); return (unsigned)p; }
__device__ __forceinline__ int lane_id() { int l; asm volatile("v_mbcnt_lo_u32_b32 %0, -1, 0\n\tv_mbcnt_hi_u32_b32 %0, -1, %0" : "=v"(l)); return l; }
__device__ __forceinline__ int make_tid(int wv) { return wv * 64 + lane_id(); }
__device__ __forceinline__ void fp8x4_to_f32(unsigned w, float (&o)[4]) { const f32x2 lo = __builtin_amdgcn_cvt_pk_f32_fp8((int)w, false), hi = __builtin_amdgcn_cvt_pk_f32_fp8((int)w, true); o[0] = lo.x; o[1] = lo.y; o[2] = hi.x; o[3] = hi.y; }
#define LDS_WAIT() asm volatile("s_waitcnt lgkmcnt(0)" ::: "memory")
#define VM_WAIT() asm volatile("s_waitcnt vmcnt(0)" ::: "memory")

namespace pg8 {
constexpr int BM = 256, BK = 64, HALF = 128, HTB = HALF * BK * 2, STAGE_BYTES = 8 * HTB, NXCD = 8, WGM = 8;
__host__ __device__ __forceinline__ int lds_byte(int r, int c) { const int st = (r >> 4) * 2 + (c >> 5), rr = r & 15, cc = c & 31, ob = rr * 64 + cc * 2; return st * 1024 + (ob ^ (((ob >> 9) & 1) << 5)); }
__host__ __device__ __forceinline__ void stage_rc(int b, int& R, int& C) { const int st = b / 1024, sb = b % 1024, swz = sb ^ (((sb >> 9) & 1) << 5); R = (st >> 1) * 16 + swz / 64; C = (st & 1) * 32 + (swz % 64) / 2; }
__host__ __device__ __forceinline__ int perm32(int rho) { const int n = rho >> 4, i = rho & 15; return 8 * (i >> 2) + 4 * n + (i & 3); }

struct Unit { int pm, pn; const char* a; const char* b; int e0, lbase, cnt; };

struct DenseOrder {
    static constexpr bool GATHER = false, DYNAMIC = false;
    const char* A; const char* B; int K, RB; int nM, nN, nwg, G, c, wv;
    __device__ void init(const void* A_, const void* B_, int M_, int N_, int K_, int G_, int c_, int wv_, bool fp8 = false) { wv = wv_; A = (const char*)A_; B = (const char*)B_; K = K_; RB = fp8 ? K_ : 2 * K_; nM = M_ / BM; nN = N_ / BM; nwg = nM * nN; G = G_; c = c_; }
    __device__ __forceinline__ bool next(int i, Unit& u) const {
        const int L = i * G + c; if (L >= nwg) return false;
        int wgid = (int)L; { const int q = nwg / NXCD, r = nwg % NXCD, xcd = wgid % NXCD, off = wgid / NXCD; wgid = (xcd < r ? xcd * (q + 1) : r * (q + 1) + (xcd - r) * q) + off; }
        const int nig = WGM * nN, gid = wgid / nig, fm = gid * WGM, gsz = (nM - fm) < WGM ? (nM - fm) : WGM;
        u.pm = fm + ((wgid % nig) % gsz); u.pn = (wgid % nig) / gsz;
        u.a = A + (size_t)u.pm * BM * RB; u.b = B + (size_t)u.pn * BM * RB; u.e0 = 0; u.lbase = 0; u.cnt = 0; return true;
    }
    __device__ __forceinline__ unsigned row_off(const Unit&, int) const { return 0u; }
};
struct DynOrder {
    static constexpr bool GATHER = false, DYNAMIC = true;
    const char* A; const char* B; int K, RB; int nM, nN, nwg, wv; unsigned* counter; LAS int* slot;
    __device__ void init(const void* A_, const void* B_, int M_, int N_, int K_, int wv_, unsigned* counter_, LAS int* slot_, bool fp8 = false) { wv = wv_; A = (const char*)A_; B = (const char*)B_; K = K_; RB = fp8 ? K_ : 2 * K_; nM = M_ / BM; nN = N_ / BM; nwg = nM * nN; counter = counter_; slot = slot_; }
    __device__ __forceinline__ void map(int L, Unit& u) const {
        int wgid = L; { const int q = nwg / NXCD, r = nwg % NXCD, xcd = wgid % NXCD, off = wgid / NXCD; wgid = (xcd < r ? xcd * (q + 1) : r * (q + 1) + (xcd - r) * q) + off; }
        const int nig = WGM * nN, gid = wgid / nig, fm = gid * WGM, gsz = (nM - fm) < WGM ? (nM - fm) : WGM;
        u.pm = fm + ((wgid % nig) % gsz); u.pn = (wgid % nig) / gsz;
        u.a = A + (size_t)u.pm * BM * RB; u.b = B + (size_t)u.pn * BM * RB; u.e0 = 0; u.lbase = 0; u.cnt = 0;
    }
    __device__ __forceinline__ int fetch() const { return (int)__hip_atomic_fetch_add(counter, 1u, __ATOMIC_RELAXED, __HIP_MEMORY_SCOPE_AGENT); }
    __device__ __forceinline__ bool next(int, Unit&) const { return false; }
    __device__ __forceinline__ unsigned row_off(const Unit&, int) const { return 0u; }
};
template <bool GATHER_> struct MoeOrder {
    static constexpr bool GATHER = GATHER_, DYNAMIC = false;
    const char* A; const char* B; size_t estride; int K, RB, NT, total, G, c, wv;
    const LAS int* blk_e; const LAS int* blkstart; const LAS int* cnt; const int* list;
    __device__ __forceinline__ bool next(int i, Unit& u) const {
        const int L = i * G + c; if (L >= total) return false;
        const int rb = (int)L / NT, pn = (int)L % NT, e = blk_e[rb];
        u.pm = rb; u.pn = pn; u.e0 = e; u.lbase = (rb - blkstart[e]) * BM; u.cnt = cnt[e];
        u.a = GATHER ? A : A + (size_t)rb * BM * RB; u.b = B + (size_t)e * estride + (size_t)pn * BM * RB; return true;
    }
    __device__ __forceinline__ unsigned row_off(const Unit& u, int r) const { const int loc = u.lbase + r; const int t = list[u.e0 * LIST_CAP + (loc < u.cnt ? loc : 0)]; return (unsigned)t * (unsigned)RB; }
};

typedef __bf16 bf16n2 __attribute__((ext_vector_type(2)));
__device__ __forceinline__ unsigned cvt_pk_bf16_n(float lo, float hi) { const f32x2 v = {lo, hi}; return __builtin_bit_cast(unsigned, __builtin_convertvector(v, bf16n2)); }
__device__ __forceinline__ unsigned cvt_pk_bf16(float lo, float hi) { unsigned r; asm volatile("v_cvt_pk_bf16_f32 %0, %1, %2" : "=v"(r) : "v"(lo), "v"(hi)); return r; }

struct EpiBf16 {
    static constexpr bool PERM = true;
    bf16* O; int ldc; int split_cols; size_t split_stride; float osc;
    __device__ __forceinline__ void operator()(const f32x4 (&acc)[2][2][4][2], const Unit& u, int wr, int wc, int fr, int fq) const {
        const int row0 = u.pm * BM + wr * 64 + fr; int colt = u.pn * BM; bf16* base = O;
        if (split_cols) { const int t = colt / split_cols; base += (size_t)t * split_stride; colt -= t * split_cols; }
        const int col0 = colt + wc * 32 + 8 * fq;
#pragma unroll
        for (int ai = 0; ai < 2; ++ai)
#pragma unroll
            for (int m = 0; m < 4; ++m) { bf16* rowp = base + (size_t)(row0 + ai * HALF + m * 16) * ldc + col0;
#pragma unroll
                for (int bj = 0; bj < 2; ++bj) { const f32x4 v0 = acc[ai][bj][m][0] * osc, v1 = acc[ai][bj][m][1] * osc;
                    u32x4 w; w.x = cvt_pk_bf16(v0[0], v0[1]); w.y = cvt_pk_bf16(v0[2], v0[3]); w.z = cvt_pk_bf16(v1[0], v1[1]); w.w = cvt_pk_bf16(v1[2], v1[3]);
                    *(u32x4*)(rowp + bj * HALF) = w; } }
    }
};
struct EpiResF32 {
    static constexpr bool PERM = false;
    float* C; const float* R; int ldc; float osc;
    __device__ __forceinline__ void operator()(const f32x4 (&acc)[2][2][4][2], const Unit& u, int wr, int wc, int fr, int fq) const {
        const int row0 = u.pm * BM + wr * 64 + fr, col0 = u.pn * BM + wc * 32 + 4 * fq;
#pragma unroll
        for (int ai = 0; ai < 2; ++ai)
#pragma unroll
            for (int m = 0; m < 4; ++m) { const size_t ro = (size_t)(row0 + ai * HALF + m * 16) * ldc + col0;
#pragma unroll
                for (int bj = 0; bj < 2; ++bj)
#pragma unroll
                    for (int n = 0; n < 2; ++n) { const f32x4 r = *(const f32x4*)(R + ro + bj * HALF + n * 16); *(f32x4*)(C + ro + bj * HALF + n * 16) = acc[ai][bj][m][n] * osc + r; } }
    }
};
struct EpiOut8 {
    static constexpr bool PERM = true;
    unsigned char* O; int ldc; float osc;
    __device__ __forceinline__ void operator()(const f32x4 (&acc)[2][2][4][2], const Unit& u, int wr, int wc, int fr, int fq) const {
        const int row0 = u.pm * BM + wr * 64 + fr, col0 = u.pn * BM + wc * 32 + 8 * fq;
#pragma unroll
        for (int ai = 0; ai < 2; ++ai)
#pragma unroll
            for (int m = 0; m < 4; ++m) { unsigned char* rowp = O + (size_t)(row0 + ai * HALF + m * 16) * ldc + col0;
#pragma unroll
                for (int bj = 0; bj < 2; ++bj) { const f32x4 v0 = acc[ai][bj][m][0] * osc, v1 = acc[ai][bj][m][1] * osc;
                    u32x2 w; w.x = pk4_fp8(v0[0], v0[1], v0[2], v0[3]); w.y = pk4_fp8(v1[0], v1[1], v1[2], v1[3]);
                    *(u32x2*)(rowp + bj * HALF) = w; } }
    }
};
template <bool SRC32> struct EpiRes16 {
    static constexpr bool PERM = true;
    bf16* XR; const float* R32; float osc;
    __device__ __forceinline__ void operator()(const f32x4 (&acc)[2][2][4][2], const Unit& u, int wr, int wc, int fr, int fq) const {
        const int row0 = u.pm * BM + wr * 64 + fr, col0 = u.pn * BM + wc * 32 + 8 * fq;
#pragma unroll
        for (int ai = 0; ai < 2; ++ai)
#pragma unroll
            for (int m = 0; m < 4; ++m) { const size_t ro = (size_t)(row0 + ai * HALF + m * 16) * D + col0;
#pragma unroll
                for (int bj = 0; bj < 2; ++bj) { float r[8];
                    if (SRC32) { const f32x4 a = *(const f32x4*)(R32 + ro + bj * HALF), b = *(const f32x4*)(R32 + ro + bj * HALF + 4);
#pragma unroll
                        for (int j = 0; j < 4; ++j) { r[j] = a[j]; r[4 + j] = b[j]; } }
                    else { const u32x4 w = *(const u32x4*)(XR + ro + bj * HALF); r[0] = bflo(w.x); r[1] = bfhi(w.x); r[2] = bflo(w.y); r[3] = bfhi(w.y); r[4] = bflo(w.z); r[5] = bfhi(w.z); r[6] = bflo(w.w); r[7] = bfhi(w.w); }
                    const f32x4 v0 = acc[ai][bj][m][0] * osc, v1 = acc[ai][bj][m][1] * osc;
                    u32x4 o; o.x = cvt_pk_bf16(v0[0] + r[0], v0[1] + r[1]); o.y = cvt_pk_bf16(v0[2] + r[2], v0[3] + r[3]); o.z = cvt_pk_bf16(v1[0] + r[4], v1[1] + r[5]); o.w = cvt_pk_bf16(v1[2] + r[6], v1[3] + r[7]);
                    *(u32x4*)(XR + ro + bj * HALF) = o; } }
    }
};
__device__ __forceinline__ float sigmoidf_(float z) { return __builtin_amdgcn_rcpf(1.0f + __expf(-z)); }
template <bool OUT8> struct EpiSwiGLU {
    static constexpr bool PERM = true;
    bf16* O; float osc;
    __device__ __forceinline__ void operator()(const f32x4 (&acc)[2][2][4][2], const Unit& u, int wr, int wc, int fr, int fq) const {
        const int row0 = u.pm * BM + wr * 64 + fr, col0 = u.pn * HALF + wc * 32 + 8 * fq;
#pragma unroll
        for (int ai = 0; ai < 2; ++ai)
#pragma unroll
            for (int m = 0; m < 4; ++m) { const size_t eo = (size_t)(row0 + ai * HALF + m * 16) * FF + col0;
                float o[8];
#pragma unroll
                for (int n = 0; n < 2; ++n)
#pragma unroll
                    for (int j = 0; j < 4; ++j) { const float g = acc[ai][0][m][n][j] * osc, up = acc[ai][1][m][n][j] * osc; o[4 * n + j] = g * sigmoidf_(g) * up; }
                if (OUT8) { u32x2 w; w.x = pk4_fp8(o[0] * SC_ACT, o[1] * SC_ACT, o[2] * SC_ACT, o[3] * SC_ACT); w.y = pk4_fp8(o[4] * SC_ACT, o[5] * SC_ACT, o[6] * SC_ACT, o[7] * SC_ACT); *(u32x2*)((unsigned char*)O + eo) = w; }
                else { u32x4 w; w.x = cvt_pk_bf16(o[0], o[1]); w.y = cvt_pk_bf16(o[2], o[3]); w.z = cvt_pk_bf16(o[4], o[5]); w.w = cvt_pk_bf16(o[6], o[7]); *(u32x4*)(O + eo) = w; } }
    }
};
typedef _Float16 h8 __attribute__((ext_vector_type(8)));
struct EpiHgrnIn {
    static constexpr bool PERM = true;
    unsigned char* zb; const float* lb;
    __device__ __forceinline__ void operator()(const f32x4 (&acc)[2][2][4][2], const Unit& u, int wr, int wc, int fr, int fq) const {
        const int quarter = u.pn >> 3, row0 = u.pm * BM + wr * 64 + fr, col0 = (u.pn & 7) * BM + wc * 32 + 8 * fq;
        if (quarter == 1) {
            float lbv[2][8];
#pragma unroll
            for (int bj = 0; bj < 2; ++bj) { const f32x4 a = *(const f32x4*)(lb + col0 + bj * HALF), b = *(const f32x4*)(lb + col0 + bj * HALF + 4);
#pragma unroll
                for (int j = 0; j < 4; ++j) { lbv[bj][j] = a[j]; lbv[bj][4 + j] = b[j]; } }
#pragma unroll
            for (int ai = 0; ai < 2; ++ai)
#pragma unroll
                for (int m = 0; m < 4; ++m) { const size_t ro = (size_t)(row0 + ai * HALF + m * 16) * D + col0;
#pragma unroll
                    for (int bj = 0; bj < 2; ++bj) { float kk[8]; h8 hv;
#pragma unroll
                        for (int n = 0; n < 2; ++n)
#pragma unroll
                            for (int j = 0; j < 4; ++j) { const float z = acc[ai][bj][m][n][j], l = lbv[bj][4 * n + j];
                                const float k1 = (1.0f - l) * __builtin_amdgcn_rcpf(1.0f + __expf(z));
                                kk[4 * n + j] = k1; hv[4 * n + j] = (_Float16)__logf(1.0f - k1); }
                        u32x4 w; w.x = cvt_pk_bf16(kk[0], kk[1]); w.y = cvt_pk_bf16(kk[2], kk[3]); w.z = cvt_pk_bf16(kk[4], kk[5]); w.w = cvt_pk_bf16(kk[6], kk[7]);
                        *(u32x4*)((bf16*)(zb + (64u << 20)) + ro + bj * HALF) = w;
                        *(h8*)((_Float16*)(zb + (128u << 20)) + ro + bj * HALF) = hv; } }
        } else {
            const size_t zo = quarter == 0 ? 0u : (quarter == 2 ? (size_t)(192u << 20) : (size_t)(256u << 20)); bf16* dst = (bf16*)(zb + zo);
#pragma unroll
            for (int ai = 0; ai < 2; ++ai)
#pragma unroll
                for (int m = 0; m < 4; ++m) { const size_t ro = (size_t)(row0 + ai * HALF + m * 16) * D + col0;
#pragma unroll
                    for (int bj = 0; bj < 2; ++bj) { float o[8];
#pragma unroll
                        for (int n = 0; n < 2; ++n)
#pragma unroll
                            for (int j = 0; j < 4; ++j) { const float z = acc[ai][bj][m][n][j]; o[4 * n + j] = (quarter == 3) ? z * sigmoidf_(z) : z; }
                        u32x4 w; w.x = cvt_pk_bf16(o[0], o[1]); w.y = cvt_pk_bf16(o[2], o[3]); w.z = cvt_pk_bf16(o[4], o[5]); w.w = cvt_pk_bf16(o[6], o[7]);
                        *(u32x4*)(dst + ro + bj * HALF) = w; } }
        }
    }
};

struct EpiQKV {
    static constexpr bool PERM = true;
    bf16* Q; bf16* Kd; bf16* V; const float* qg; const float* kg; const f32x2* rope; float* kmean; LAS unsigned char* xl; float osc; int wv;
    __device__ __forceinline__ void operator()(const f32x4 (&acc)[2][2][4][2], const Unit& u, int wr, int wc, int fr, int fq) const {
        const int sec = u.pn >> 3, row0 = u.pm * BM + wr * 64 + fr;
        if (sec == 2) {
            const int col0 = (u.pn & 7) * BM + wc * 32 + 8 * fq; const float vs = osc * SC_QKV;
#pragma unroll
            for (int ai = 0; ai < 2; ++ai)
#pragma unroll
                for (int m = 0; m < 4; ++m) { unsigned char* rowp = (unsigned char*)V + (size_t)(row0 + ai * HALF + m * 16) * D + col0;
#pragma unroll
                    for (int bj = 0; bj < 2; ++bj) { const f32x4 v0 = acc[ai][bj][m][0] * vs, v1 = acc[ai][bj][m][1] * vs;
                        u32x2 w; w.x = pk4_fp8(v0[0], v0[1], v0[2], v0[3]); w.y = pk4_fp8(v1[0], v1[1], v1[2], v1[3]);
                        *(u32x2*)(rowp + bj * HALF) = w; } }
            return;
        }
        LAS float* X = (LAS float*)xl;
        LAS float* Y = (LAS float*)(xl + 8192);
#pragma unroll
        for (int ai = 0; ai < 2; ++ai)
#pragma unroll
            for (int m = 0; m < 4; ++m)
#pragma unroll
                for (int bj = 0; bj < 2; ++bj) { const f32x4 a = acc[ai][bj][m][0], b = acc[ai][bj][m][1];
                    float s = ((a[0] * a[0] + a[1] * a[1]) + (a[2] * a[2] + a[3] * a[3]) + (b[0] * b[0] + b[1] * b[1]) + (b[2] * b[2] + b[3] * b[3])) * (osc * osc);
                    s += __shfl_xor(s, 16); s += __shfl_xor(s, 32);
                    if (fq == 0) X[((ai * HALF + wr * 64 + m * 16 + fr) * 2 + bj) * 4 + wc] = s; }
        asm volatile("s_waitcnt lgkmcnt(0)" ::: "memory"); __builtin_amdgcn_s_barrier(); asm volatile("" ::: "memory");
        const float* gain = sec ? kg : qg; bf16* dst = sec ? Kd : Q;
#pragma unroll
        for (int ai = 0; ai < 2; ++ai)
#pragma unroll
            for (int m = 0; m < 4; ++m) { const int rl = ai * HALF + wr * 64 + m * 16 + fr, pos = (u.pm & 15) * BM + rl;
                const f32x4 g0 = *(const f32x4*)(gain + 16 * wc + 4 * fq), g1 = *(const f32x4*)(gain + 64 + 16 * wc + 4 * fq);
                const f32x4 r0 = *(const f32x4*)(rope + pos * 64 + 16 * wc + 4 * fq), r1 = *(const f32x4*)(rope + pos * 64 + 16 * wc + 4 * fq + 2);
                const float cc[4] = {r0[0], r0[2], r1[0], r1[2]}, sn[4] = {r0[1], r0[3], r1[1], r1[3]};
#pragma unroll
                for (int bj = 0; bj < 2; ++bj) { const f32x4 p = *(const LAS f32x4*)(X + (rl * 2 + bj) * 4);
                    const float rstd = __builtin_amdgcn_rsqf(((p[0] + p[1]) + (p[2] + p[3])) * (1.f / 128) + RMS_EPS);
                    float o[8];
#pragma unroll
                    for (int j = 0; j < 4; ++j) { const float y1 = acc[ai][bj][m][0][j] * (rstd * osc) * g0[j], y2 = acc[ai][bj][m][1][j] * (rstd * osc) * g1[j]; o[j] = y1 * cc[j] - y2 * sn[j]; o[4 + j] = y2 * cc[j] + y1 * sn[j]; }
                    unsigned char* p0 = (unsigned char*)dst + (size_t)(u.pm * BM + rl) * D + ((u.pn & 7) * 2 + bj) * 128 + 16 * wc + 4 * fq;
                    *(unsigned*)p0 = pk4_fp8(o[0] * SC_QKV, o[1] * SC_QKV, o[2] * SC_QKV, o[3] * SC_QKV); *(unsigned*)(p0 + 64) = pk4_fp8(o[4] * SC_QKV, o[5] * SC_QKV, o[6] * SC_QKV, o[7] * SC_QKV);
                    if (sec == 1) {
#pragma unroll
                        for (int j = 0; j < 8; ++j) { float sv = o[j]; sv += __shfl_xor(sv, 1); sv += __shfl_xor(sv, 2); sv += __shfl_xor(sv, 4); sv += __shfl_xor(sv, 8); o[j] = sv; }
                        if (fr == 0) { LAS float* yp = Y + ((((wr * 2 + ai) * 4 + m) * 2 + bj) * 128) + 16 * wc + 4 * fq; *(LAS f32x4*)yp = (f32x4){o[0], o[1], o[2], o[3]}; *(LAS f32x4*)(yp + 64) = (f32x4){o[4], o[5], o[6], o[7]}; }
                    } }
                asm volatile("" ::: "memory"); }
        if (sec == 1) {
            asm volatile("s_waitcnt lgkmcnt(0)" ::: "memory"); __builtin_amdgcn_s_barrier(); asm volatile("" ::: "memory");
            const int tid = make_tid(wv);
            if (tid < 256) { const int bj = tid >> 7, d = tid & 127; const int b = u.pm >> 4, nb = u.pm & 15, head = (u.pn & 7) * 2 + bj;
                float sm = 0.f;
#pragma unroll
                for (int q = 0; q < 16; ++q) sm += Y[(q * 2 + bj) * 128 + d];
                float* kmb = kmean; asm volatile("" : "+s"(kmb));
                ((GAS float*)kmb)[((b * H + head) * NBLK + nb) * HD + d] = sm * (1.0f / 256); }
        }
    }
};

__device__ __forceinline__ void glds_saddr(const char* sbase, unsigned voff, unsigned lds_dst) {
    unsigned keep;
    asm volatile("s_mov_b32 %0, m0\n\ts_mov_b32 m0, %3\n\ts_nop 4\n\tglobal_load_lds_dwordx4 %1, %2\n\ts_mov_b32 m0, %0" : "=&s"(keep) : "v"(voff), "s"(sbase), "s"(lds_dst) : "memory");
}
typedef int i32x4 __attribute__((ext_vector_type(4)));
typedef int i32x8 __attribute__((ext_vector_type(8)));
__device__ __forceinline__ i32x8 cat8(bf16x8 lo, bf16x8 hi) { const i32x4 a = __builtin_bit_cast(i32x4, lo), b = __builtin_bit_cast(i32x4, hi); return __builtin_shufflevector(a, b, 0, 1, 2, 3, 4, 5, 6, 7); }
template <class Epi, class Sched, bool ALIGN_EPI, bool FP8 = false>
__device__ __forceinline__ void gemm_phase(LAS unsigned char* lds, const Sched& S, const Epi& E) {
    const int tid = make_tid(S.wv), wid = __builtin_amdgcn_readfirstlane(tid >> 6), lane = tid & 63, wr = wid >> 2, wc = wid & 3, fr = lane & 15, fq = lane >> 4;
    const int K = S.K, RB = S.RB, nt = RB / (BK * 2);
    unsigned voffA[2], voffB[2];
#pragma unroll
    for (int i = 0; i < 2; ++i) { int R, C; stage_rc(tid * 16 + i * 8192, R, C); const int Rb = Epi::PERM ? ((R & ~31) + perm32(R & 31)) : R;
        voffA[i] = (unsigned)(R * RB + C * 2); voffB[i] = (unsigned)(Rb * RB + C * 2); }
    const size_t kstep = (size_t)(BK * 2);
    const size_t hstep = (size_t)HALF * RB;
    const unsigned ldsw = (unsigned)wid * 1024u, ldsb = (unsigned)(size_t)lds;
    const int aoff = lds_byte(wr * 64 + fr, fq * 8), boff = lds_byte(wc * 32 + fr, fq * 8);
#define PG8_SA(b, h) (((b) * 2 + (h)) * HTB)
#define PG8_SB(b, h) ((4 + (b) * 2 + (h)) * HTB)
#define PG8_STAGE(bufoff, gbase, voff) do { _Pragma("unroll") for (int _i = 0; _i < 2; ++_i) glds_saddr((const char*)(gbase), (voff)[_i], ldsb + (unsigned)(bufoff) + ldsw + _i * 8192u); } while (0)
#define PG8_GOFS(pp, h, i) (gofs + ((((pp) * 2 + (h)) * 2 + (i)) * 512))
#define PG8_STAGE_A(bufoff, sel, h, ko) do { if constexpr (Sched::GATHER) { const int _pp = (sel) ? (pc ^ 1) : pc; unsigned _v[2]; _v[0] = PG8_GOFS(_pp, h, 0)[tid]; _v[1] = PG8_GOFS(_pp, h, 1)[tid]; PG8_STAGE(bufoff, S.A + (ko), _v); } \
        else { PG8_STAGE(bufoff, ((sel) ? nA : cA) + (h) * hstep + (ko), voffA); } } while (0)
#define PG8_LDA(dst, b, h) do { _Pragma("unroll") for (int m = 0; m < 4; ++m) { if constexpr (FP8) dst##8[m] = cat8(*(const LAS bf16x8*)(lds + PG8_SA(b, h) + aoff + m * 2048), *(const LAS bf16x8*)(lds + PG8_SA(b, h) + aoff + m * 2048 + 1024)); \
        else { _Pragma("unroll") for (int k = 0; k < 2; ++k) dst[m][k] = *(const LAS bf16x8*)(lds + PG8_SA(b, h) + aoff + m * 2048 + k * 1024); } } } while (0)
#define PG8_LDB(dst, b, h) do { _Pragma("unroll") for (int n = 0; n < 2; ++n) { if constexpr (FP8) dst##8[n] = cat8(*(const LAS bf16x8*)(lds + PG8_SB(b, h) + boff + n * 2048), *(const LAS bf16x8*)(lds + PG8_SB(b, h) + boff + n * 2048 + 1024)); \
        else { _Pragma("unroll") for (int k = 0; k < 2; ++k) dst[n][k] = *(const LAS bf16x8*)(lds + PG8_SB(b, h) + boff + n * 2048 + k * 1024); } } } while (0)
#define PG8_MMA(ai, bj, At, Bt) do { __builtin_amdgcn_s_setprio(1); _Pragma("unroll") for (int m = 0; m < 4; ++m) _Pragma("unroll") for (int n = 0; n < 2; ++n) { if constexpr (FP8) { \
        acc[ai][bj][m][n] = __builtin_amdgcn_mfma_scale_f32_16x16x128_f8f6f4(Bt##8[n], At##8[m], acc[ai][bj][m][n], 0, 0, 0, 0, 0, 0); } else { _Pragma("unroll") for (int k = 0; k < 2; ++k) \
        acc[ai][bj][m][n] = __builtin_amdgcn_mfma_f32_16x16x32_bf16(Bt[n][k], At[m][k], acc[ai][bj][m][n], 0, 0, 0); } } __builtin_amdgcn_s_setprio(0); } while (0)
#define PG8_WAIT_V(n) asm volatile("s_waitcnt vmcnt(" #n ")" ::: "memory")
#define PG8_WAIT_L(n) asm volatile("s_waitcnt lgkmcnt(" #n ")" ::: "memory")
#define PG8_BAR __builtin_amdgcn_s_barrier()
#define PG8_SCHED __builtin_amdgcn_sched_barrier(0)
    Unit cur, nxt; int ui = 0; int dyn_pend = 0;
    if constexpr (Sched::DYNAMIC) {
        if (wid == 0) { int v2 = 0; if (lane == 0) { const int v0 = S.fetch(), v1 = S.fetch(); v2 = S.fetch(); S.slot[0] = v0; S.slot[1] = v1; } dyn_pend = __builtin_amdgcn_readfirstlane(v2); }
        PG8_WAIT_L(0); PG8_BAR;
        const int L0 = __builtin_amdgcn_readfirstlane(S.slot[0]); if (L0 >= S.nwg) return;
        S.map(L0, cur);
    } else { if (!S.next(0, cur)) return; }
    LAS unsigned* gofs = (LAS unsigned*)(lds + 131072); int pc = 0;
#define PG8_WRITE_GOFS(pp, U) do { int _t = tid; asm volatile("" : "+v"(_t)); _Pragma("unroll") for (int _i = 0; _i < 2; ++_i) { int _R, _C; stage_rc(_t * 16 + _i * 8192, _R, _C); \
        _Pragma("unroll") for (int _h = 0; _h < 2; ++_h) PG8_GOFS(pp, _h, _i)[_t] = S.row_off(U, _h * HALF + _R) + (unsigned)_C * 2u; } } while (0)
    if constexpr (Sched::GATHER) PG8_WRITE_GOFS(0, cur);
    f32x4 acc[2][2][4][2];
#pragma unroll
    for (int a = 0; a < 2; ++a)
#pragma unroll
        for (int b = 0; b < 2; ++b)
#pragma unroll
            for (int m = 0; m < 4; ++m)
#pragma unroll
                for (int n = 0; n < 2; ++n) acc[a][b][m][n] = (f32x4){0.f, 0.f, 0.f, 0.f};
    bf16x8 At[4][2], B0[2][2], B1[2][2]; i32x8 At8[4], B08[2], B18[2];
    const char* cA = cur.a; const char* cB = cur.b; const char* nA = cA; const char* nB = cB;
    PG8_STAGE(PG8_SB(0, 0), cB, voffB); PG8_STAGE(PG8_SB(0, 1), cB + hstep, voffB); PG8_STAGE_A(PG8_SA(0, 0), false, 0, 0); PG8_STAGE_A(PG8_SA(0, 1), false, 1, 0);
    if (wr == 1) PG8_BAR;
    PG8_WAIT_V(2); PG8_BAR;
    PG8_STAGE(PG8_SB(1, 0), cB + kstep, voffB); PG8_STAGE_A(PG8_SA(1, 0), false, 0, kstep); PG8_STAGE(PG8_SB(1, 1), cB + hstep + kstep, voffB);
    PG8_WAIT_V(6); PG8_BAR;
    for (;;) {
        bool has_next = true;
        if constexpr (Sched::DYNAMIC) {
            if (ui >= 1 && wid == 0) { int v = 0; if (lane == 0) { S.slot[(ui + 1) % 3] = dyn_pend; v = S.fetch(); } dyn_pend = __builtin_amdgcn_readfirstlane(v); }
        } else { has_next = S.next(ui + 1, nxt); nA = has_next ? nxt.a : cA; nB = has_next ? nxt.b : cB; }
        if constexpr (Sched::GATHER) { if (has_next) PG8_WRITE_GOFS(pc ^ 1, nxt); else PG8_WRITE_GOFS(pc ^ 1, cur); }
        for (int t = 0; t < nt; t += 2) {
            const bool last = (t == nt - 2);
            if constexpr (Sched::DYNAMIC) { if (last) { const int Ln = __builtin_amdgcn_readfirstlane(S.slot[(ui + 1) % 3]); has_next = Ln < S.nwg; if (has_next) S.map(Ln, nxt); nA = has_next ? nxt.a : cA; nB = has_next ? nxt.b : cB; } }
            const size_t k1 = (size_t)(t + 1) * kstep;
            const size_t k2 = last ? 0 : (size_t)(t + 2) * kstep, k3 = k2 + kstep;
            const char* b2 = (last ? nB : cB) + k2; const char* b3 = b2 + kstep;
            PG8_LDB(B0, 0, 0); PG8_LDB(B1, 0, 1); PG8_SCHED; PG8_LDA(At, 0, 0); PG8_STAGE_A(PG8_SA(1, 1), false, 1, k1);
            PG8_WAIT_V(8); PG8_WAIT_L(0); PG8_BAR; PG8_MMA(0, 0, At, B0); PG8_MMA(0, 1, At, B1); PG8_BAR; PG8_SCHED;
            PG8_LDA(At, 0, 1); PG8_STAGE(PG8_SB(0, 0), b2, voffB); PG8_STAGE(PG8_SB(0, 1), b2 + hstep, voffB); PG8_STAGE_A(PG8_SA(0, 0), last, 0, k2);
            PG8_WAIT_V(8); PG8_WAIT_L(0); PG8_BAR; PG8_MMA(1, 0, At, B0); PG8_MMA(1, 1, At, B1); PG8_BAR; PG8_SCHED;
            PG8_LDB(B0, 1, 0); PG8_LDB(B1, 1, 1); PG8_SCHED; PG8_LDA(At, 1, 0); PG8_STAGE_A(PG8_SA(0, 1), last, 1, k2);
            PG8_WAIT_V(8); PG8_WAIT_L(0); PG8_BAR; PG8_MMA(0, 0, At, B0); PG8_MMA(0, 1, At, B1); PG8_BAR; PG8_SCHED;
            PG8_LDA(At, 1, 1); PG8_STAGE(PG8_SB(1, 0), b3, voffB); PG8_STAGE(PG8_SB(1, 1), b3 + hstep, voffB); PG8_STAGE_A(PG8_SA(1, 0), last, 0, k3);
            PG8_WAIT_V(8); PG8_WAIT_L(0); PG8_BAR; PG8_MMA(1, 0, At, B0); PG8_MMA(1, 1, At, B1); PG8_BAR; PG8_SCHED;
        }
        if constexpr (ALIGN_EPI) { if (wr == 0) PG8_BAR; }
        { const int l2_ = lane_id(); E(acc, cur, wr, wc, l2_ & 15, l2_ >> 4); }
        if (!has_next) break;
#pragma unroll
        for (int a = 0; a < 2; ++a)
#pragma unroll
            for (int b = 0; b < 2; ++b)
#pragma unroll
                for (int m = 0; m < 4; ++m)
#pragma unroll
                    for (int n = 0; n < 2; ++n) acc[a][b][m][n] = (f32x4){0.f, 0.f, 0.f, 0.f};
        cur = nxt; cA = nA; cB = nB; ++ui;
        pc ^= 1;
        if constexpr (ALIGN_EPI) { if (wr == 1) PG8_BAR; }
    }
    PG8_WAIT_V(0);
    if constexpr (!ALIGN_EPI) { if (wr == 0) PG8_BAR; }
    PG8_BAR;
#undef PG8_SA
#undef PG8_SB
#undef PG8_STAGE
#undef PG8_STAGE_A
#undef PG8_GOFS
#undef PG8_WRITE_GOFS
#undef PG8_LDA
#undef PG8_LDB
#undef PG8_MMA
#undef PG8_WAIT_V
#undef PG8_WAIT_L
#undef PG8_BAR
#undef PG8_SCHED
}
}

#define XB_TMO      128
#define XB_XCNT(j)  (256  + 64 * (j))
#define XB_XSUB(j)  (1280 + 64 * (j))
#define XB_XGEN(j)  (2304 + 64 * (j))
#define XB_TOP      3328
#define XB_TOPGEN   3392
#define XCD_BAR_WORDS 3456
#define XB_SPIN_CAP (1u << 18)
__device__ __forceinline__ unsigned xb_ld(unsigned* p)              { return __hip_atomic_load(p, __ATOMIC_RELAXED, __HIP_MEMORY_SCOPE_AGENT); }
__device__ __forceinline__ unsigned xb_add(unsigned* p, unsigned v) { return __hip_atomic_fetch_add(p, v, __ATOMIC_RELAXED, __HIP_MEMORY_SCOPE_AGENT); }
__device__ __forceinline__ unsigned xb_xcc_id() { return (unsigned)__builtin_amdgcn_s_getreg((3 << 11) | 20) & 0xFu; }
#define XB_SPIN(cond, bar) do { unsigned _sp = 0; while (cond) { __builtin_amdgcn_s_sleep(1); \
    if ((++_sp & 255u) == 0u) { if (xb_ld(&(bar)[XB_TMO])) break; if (_sp > XB_SPIN_CAP) { atomicAdd(&(bar)[XB_TMO], 1u); break; } } } } while (0)
struct XcdBarrier { unsigned* bar; unsigned x; volatile LAS unsigned* st; };
__device__ __forceinline__ XcdBarrier xcd_barrier_post(unsigned* bar, volatile LAS unsigned* st, int tid0) {
    XcdBarrier b; b.bar = bar; b.x = xb_xcc_id(); b.st = st;
    if (tid0 == 0) (void)xb_add(&bar[XB_XCNT(b.x)], 1u);
    return b;
}
__device__ __forceinline__ void xcd_barrier_complete(unsigned* bar, unsigned x, unsigned& nloc, unsigned& nx) {
    const unsigned G = gridDim.x * gridDim.y * gridDim.z;
    unsigned sum, cnt, mine, sp = 0u;
    for (;;) {
        sum = 0u; cnt = 0u; mine = 0u;
#pragma unroll
        for (unsigned j = 0; j < 16; ++j) { const unsigned c = xb_ld(&bar[XB_XCNT(j)]); sum += c; cnt += (c > 0u) ? 1u : 0u; mine = (j == x) ? c : mine; }
        if (sum == G) break;
        __builtin_amdgcn_s_sleep(1);
        if ((++sp & 255u) == 0u) { if (xb_ld(&bar[XB_TMO])) break; if (sp > XB_SPIN_CAP) { atomicAdd(&bar[XB_TMO], 1u); break; } }
    }
    nloc = mine > 0u ? mine : 1u; nx = cnt > 0u ? cnt : 1u;
}
__device__ __forceinline__ void xcd_barrier(const XcdBarrier& b, int tid0) {
    asm volatile("s_waitcnt vmcnt(0)" ::: "memory");
    __syncthreads();
    if (tid0 == 0) {
        unsigned* bar = b.bar;
        __builtin_amdgcn_s_waitcnt(0);
        unsigned nloc = b.st[0], nx = b.st[1];
        if (nloc == 0u) { xcd_barrier_complete(bar, b.x, nloc, nx); b.st[0] = nloc; b.st[1] = nx; }
        const unsigned old = xb_add(&bar[XB_XSUB(b.x)], 1u);
        const unsigned gen = old / nloc;
        if (old + 1u == (gen + 1u) * nloc) {
            __builtin_amdgcn_fence(__ATOMIC_RELEASE, "agent");
            asm volatile("s_waitcnt vmcnt(0)" ::: "memory");
            const unsigned og = xb_add(&bar[XB_TOP], 1u);
            const unsigned tg = og / nx;
            if (og + 1u == (tg + 1u) * nx) xb_add(&bar[XB_TOPGEN], 1u);
            else XB_SPIN(xb_ld(&bar[XB_TOPGEN]) == tg, bar);
            __builtin_amdgcn_fence(__ATOMIC_ACQUIRE, "agent");
            xb_add(&bar[XB_XGEN(b.x)], 1u);
            asm volatile("s_waitcnt vmcnt(0)" ::: "memory");
        } else {
            XB_SPIN(xb_ld(&bar[XB_XGEN(b.x)]) == gen, bar);
            __builtin_amdgcn_fence(__ATOMIC_ACQUIRE, "agent");
            asm volatile("s_waitcnt vmcnt(0)" ::: "memory");
        }
    }
    __syncthreads();
}

struct Args { const float* in[20]; float* out; unsigned char* ws; int ph_lo, ph_hi; };
typedef const __attribute__((address_space(4))) Args CArgs;
enum { I_X = 0, I_NORM_MIX, I_NORM_FFN, I_A_W_IN, I_A_LB, I_A_OGAIN, I_A_W_OUT, I_KV_NORM, I_KV_W, I_K_NORM, I_B_W_Q, I_B_Q_NORM, I_B_W_OUT,
       I_W_GROUP, I_B_GROUP, I_W_EXPERT, I_B_EXPERT, I_W_GATE, I_W_UP, I_W_DOWN };
struct Frame {
    LAS unsigned char* lds; unsigned char* ws; unsigned* ctl;
    int tid, lane, wave, vcu, G, gw, NGW;
};

struct TrItem { const float* src; const float* ksc; unsigned char* dst; int N, K, k0, n0, drow0, flags; float osc; };
struct TrRegs { f32x4 v[16]; f32x4 ks[2]; };
constexpr int TR_SCR_BYTES = 128 * 33 * 4;
__device__ __forceinline__ void tr_load(const TrItem& it, TrRegs& r, int lane) {
    const float* p = it.src + (size_t)(it.k0 + (lane >> 3)) * it.N + it.n0 + 4 * (lane & 7);
    const size_t st = (size_t)8 * it.N;
#pragma unroll
    for (int i = 0; i < 16; ++i) r.v[i] = *(const f32x4*)(p + i * st);
    if (it.ksc) { const f32x4* q = (const f32x4*)(it.ksc + it.k0 + 8 * (lane >> 3)); r.ks[0] = q[0]; r.ks[1] = q[1]; }
    else { r.ks[0] = (f32x4){1.f, 1.f, 1.f, 1.f}; r.ks[1] = r.ks[0]; }
}
__device__ __forceinline__ void tr_to_lds(const TrRegs& r, LAS float* scr, int lane) {
    LAS float* d = scr + (lane >> 3) * 33 + 4 * (lane & 7);
#pragma unroll
    for (int i = 0; i < 16; ++i) { d[(8 * i) * 33 + 0] = r.v[i][0]; d[(8 * i) * 33 + 1] = r.v[i][1]; d[(8 * i) * 33 + 2] = r.v[i][2]; d[(8 * i) * 33 + 3] = r.v[i][3]; }
}
__device__ __forceinline__ void tr_store(const TrItem& it, f32x4 ka, f32x4 kb, const LAS float* scr, int lane) {
#pragma unroll
    for (int jh = 0; jh < 2; ++jh) {
        const int c = (lane >> 3) + 8 * jh;
        if (jh == 1 && it.ksc) { const f32x4* q = (const f32x4*)(it.ksc + it.k0 + 8 * c); ka = q[0]; kb = q[1]; }
        const float o = it.osc;
        const float s0 = ka[0] * o, s1 = ka[1] * o, s2 = ka[2] * o, s3 = ka[3] * o, s4 = kb[0] * o, s5 = kb[1] * o, s6 = kb[2] * o, s7 = kb[3] * o;
#pragma unroll
        for (int jn = 0; jn < 4; ++jn) {
            const int n = (lane & 7) + 8 * jn; const LAS float* s = scr + (8 * c) * 33 + n;
            const float w0 = s[0 * 33] * s0, w1 = s[1 * 33] * s1, w2 = s[2 * 33] * s2, w3 = s[3 * 33] * s3, w4 = s[4 * 33] * s4, w5 = s[5 * 33] * s5, w6 = s[6 * 33] * s6, w7 = s[7 * 33] * s7;
            int drow = it.drow0 + n;
            if (it.flags & 1) { const int cidx = it.n0 + n, d = cidx & 127; drow = (it.drow0 - it.n0) + (cidx & ~127) + 32 * ((d & 63) >> 4) + 8 * ((d & 15) >> 2) + 4 * (d >> 6) + (d & 3); }
            const size_t eo = (size_t)drow * it.K + it.k0 + 8 * c;
            if (it.flags & 2) { u32x2 o8; o8.x = pk4_fp8(w0, w1, w2, w3); o8.y = pk4_fp8(w4, w5, w6, w7); *(u32x2*)(it.dst + eo) = o8; }
            else { u32x4 o16; o16.x = pk2(w0, w1); o16.y = pk2(w2, w3); o16.z = pk2(w4, w5); o16.w = pk2(w6, w7); *(u32x4*)(it.dst + eo * 2) = o16; }
        }
    }
}
template <class Dec> __device__ __forceinline__ void tr_run(Dec dec, int first, int total, int stride, LAS float* scr, int lane) {
    if (first >= total) return;
    TrRegs r; TrItem cur = dec(first); tr_load(cur, r, lane);
    for (int i = first; i < total; i += stride) {
        tr_to_lds(r, scr, lane);
        const f32x4 ka = r.ks[0], kb = r.ks[1];
        TrItem nxt = cur; const bool more = i + stride < total;
        if (more) { nxt = dec(i + stride); tr_load(nxt, r, lane); }
        LDS_WAIT(); asm volatile("" ::: "memory");
        tr_store(cur, ka, kb, scr, lane);
        LDS_WAIT(); asm volatile("" ::: "memory");
        cur = nxt;
    }
}
constexpr size_t WGU_LSTRIDE = 64 * MiB, WD_LSTRIDE = 32 * MiB;
static_assert((FP8_MOE0 != 0) && (FP8_MOE1 != 0), "the two-layer weight residency assumes e4m3 expert weights");
constexpr int MOE_CV_ITEMS = 32 * 768;
__device__ __forceinline__ TrItem moe_cv_item(CArgs& a, unsigned char* ws, int layer, int item) {
    const int e = item / 768, r = item % 768, which = r / 256, q = r % 256;
    const size_t eo = (size_t)(layer * NE + e);
    TrItem t; t.ksc = nullptr; t.flags = 2;
    if (which < 2) {
        const int kb = q / 16, nb = q % 16, n0 = nb * 32;
        t.src = (which == 0 ? a.in[I_W_GATE] : a.in[I_W_UP]) + eo * (size_t)D * FF; t.N = FF; t.K = D; t.k0 = 128 * kb; t.n0 = n0;
        t.dst = ws + WS_WGU + (size_t)layer * WGU_LSTRIDE + (size_t)e * 1024 * D; t.drow0 = (n0 >> 7) * 256 + which * 128 + (n0 & 127); t.osc = SC_W;
    } else {
        const int kb = q / 64, nb = q % 64;
        t.src = a.in[I_W_DOWN] + eo * (size_t)FF * D; t.N = D; t.K = FF; t.k0 = 128 * kb; t.n0 = nb * 32;
        t.dst = ws + WS_WD + (size_t)layer * WD_LSTRIDE + (size_t)e * D * FF; t.drow0 = nb * 32; t.osc = SC_WD;
    }
    return t;
}
__device__ __forceinline__ void rms_row_to_bf16(const float* xrow, bf16* orow, int lane) {
    const f32x4* xr = (const f32x4*)xrow + lane;
    f32x4 v[8]; float s = 0.f;
#pragma unroll
    for (int j = 0; j < 8; ++j) { v[j] = xr[64 * j]; s += (v[j].x * v[j].x + v[j].y * v[j].y) + (v[j].z * v[j].z + v[j].w * v[j].w); }
    const float rstd = __builtin_amdgcn_rsqf(wave_sum(s) * (1.f / D) + RMS_EPS);
    u32x2* o8 = (u32x2*)orow + lane;
#pragma unroll
    for (int j = 0; j < 8; ++j) { u32x2 w; w.x = pk2(v[j].x * rstd, v[j].y * rstd); w.y = pk2(v[j].z * rstd, v[j].w * rstd); o8[64 * j] = w; }
}

__device__ __forceinline__ int moe_tables(Frame& F, int layer) {
    LAS int* blk_e = (LAS int*)(F.lds + LT_BLKE); LAS int* blkstart = (LAS int*)(F.lds + LT_BLKSTART); LAS int* cntl = (LAS int*)(F.lds + LT_CNT);
    __syncthreads();
    if (F.wave == 0) {
        const int e = F.lane & 31;
        const int c = (int)__hip_atomic_load(F.ctl + CW_CNT_AT(layer, e), __ATOMIC_RELAXED, __HIP_MEMORY_SCOPE_AGENT);
        const int nb = (c + 255) >> 8;
        int incl = nb;
#pragma unroll
        for (int o = 1; o < 32; o <<= 1) { const int t = __shfl_up(incl, o, 32); if ((F.lane & 31) >= o) incl += t; }
        const int excl = incl - nb;
        if (F.lane < 32) { blkstart[e] = excl; cntl[e] = c; for (int r = 0; r < nb; ++r) blk_e[excl + r] = e; if (e == 31) blkstart[32] = incl; }
    }
    __syncthreads();
    return blkstart[32];
}

typedef const GAS char* gcptr;
__device__ __forceinline__ gcptr opaque_s(const void* p) { asm volatile("" : "+s"(p)); return (gcptr)p; }
__device__ __forceinline__ float wave_reduce4(const float (&p)[4], int lane) {
    const bool b0 = lane & 1, b1 = lane & 2;
    float a0 = b0 ? p[1] : p[0], x0 = b0 ? p[0] : p[1]; a0 += __shfl_xor(x0, 1);
    float a1 = b0 ? p[3] : p[2], x1 = b0 ? p[2] : p[3]; a1 += __shfl_xor(x1, 1);
    float c = b1 ? a1 : a0, d = b1 ? a0 : a1; c += __shfl_xor(d, 2);
    c += __shfl_xor(c, 4); c += __shfl_xor(c, 8); c += __shfl_xor(c, 16); c += __shfl_xor(c, 32);
    return c;
}
__device__ __forceinline__ float wave_reduce8(const float (&p)[8], int lane) {
    const bool b2 = lane & 4;
    const float lo[4] = {p[0], p[1], p[2], p[3]}, hi[4] = {p[4], p[5], p[6], p[7]};
    float q[4];
#pragma unroll
    for (int i = 0; i < 4; ++i) { const float keep = b2 ? hi[i] : lo[i], give = b2 ? lo[i] : hi[i]; q[i] = keep + __shfl_xor(give, 4); }
    const bool b0 = lane & 1, b1 = lane & 2;
    float a0 = b0 ? q[1] : q[0], x0 = b0 ? q[0] : q[1]; a0 += __shfl_xor(x0, 1);
    float a1 = b0 ? q[3] : q[2], x1 = b0 ? q[2] : q[3]; a1 += __shfl_xor(x1, 1);
    float c = b1 ? a1 : a0, d = b1 ? a0 : a1; c += __shfl_xor(d, 2);
    c += __shfl_xor(c, 8); c += __shfl_xor(c, 16); c += __shfl_xor(c, 32);
    return c;
}
template <bool DRY, bool OUT8> __device__ __forceinline__ void route_token(Frame& F, CArgs& a, int layer, int t) {
    const bf16* xrow = (const bf16*)(F.ws + WS_XR) + (size_t)t * D;
    const unsigned l16 = (unsigned)F.lane * 16u;
    gcptr xb = opaque_s(xrow); gcptr gb = opaque_s(a.in[I_NORM_FFN] + layer * D);
    f32x4 v[8]; float s = 0.f;
#pragma unroll
    for (int j = 0; j < 8; ++j) { const u32x2 xw_ = *(const GAS u32x2*)(xb + j * 512 + (l16 >> 1)); v[j] = (f32x4){bflo(xw_.x), bfhi(xw_.x), bflo(xw_.y), bfhi(xw_.y)}; s += (v[j].x * v[j].x + v[j].y * v[j].y) + (v[j].z * v[j].z + v[j].w * v[j].w); }
    const float rstd = __builtin_amdgcn_rsqf(wave_sum(s) * (1.f / D) + RMS_EPS);
    u32x2* o8 = (u32x2*)((bf16*)(F.ws + (DRY ? WS_OPART : WS_XN)) + (size_t)t * D) + F.lane;
#pragma unroll
    for (int j = 0; j < 8; ++j) { const f32x4 g = *(const GAS f32x4*)(gb + j * 1024 + l16); v[j].x *= rstd * g.x; v[j].y *= rstd * g.y; v[j].z *= rstd * g.z; v[j].w *= rstd * g.w;
        if (OUT8) ((unsigned*)(F.ws + (DRY ? WS_OPART : WS_XN)) + (size_t)t * (D / 4))[64 * j + F.lane] = pk4_fp8(v[j].x * SC_XN, v[j].y * SC_XN, v[j].z * SC_XN, v[j].w * SC_XN);
        else { u32x2 w; w.x = pk2(v[j].x, v[j].y); w.y = pk2(v[j].z, v[j].w); o8[64 * j] = w; } }
    const float* RT = (const float*)(F.ws + WS_RT) + (size_t)layer * 36 * D;
    float gl[4];
    { float pp[4];
#pragma unroll
      for (int r = 0; r < 4; ++r) { gcptr wb = opaque_s(RT + r * D); float p = 0.f;
#pragma unroll
        for (int j = 0; j < 8; ++j) { const f32x4 w = *(const GAS f32x4*)(wb + j * 1024 + l16); p += (v[j].x * w.x + v[j].y * w.y) + (v[j].z * w.z + v[j].w * w.w); }
        pp[r] = p; if (r & 1) __builtin_amdgcn_sched_barrier(0); }
      const float red = wave_reduce4(pp, F.lane);
#pragma unroll
      for (int r = 0; r < 4; ++r) gl[r] = __builtin_bit_cast(float, __builtin_amdgcn_readlane(__builtin_bit_cast(int, red), r)) + a.in[I_B_GROUP][layer * NG + r]; }
    int g = 0; float gm = gl[0];
#pragma unroll
    for (int r = 1; r < 4; ++r) if (gl[r] > gm) { gm = gl[r]; g = r; }
    float gs = 0.f;
#pragma unroll
    for (int r = 0; r < 4; ++r) gs += __expf(gl[r] - gm);
    const float gp = 1.0f / gs;
    g = __builtin_amdgcn_readfirstlane(g);
    float el[8];
    { float pp[8];
#pragma unroll
      for (int r = 0; r < 8; ++r) { gcptr wb = opaque_s(RT + (size_t)(4 + g * 8 + r) * D); float p = 0.f;
#pragma unroll
        for (int j = 0; j < 8; ++j) { const f32x4 w = *(const GAS f32x4*)(wb + j * 1024 + l16); p += (v[j].x * w.x + v[j].y * w.y) + (v[j].z * w.z + v[j].w * w.w); }
        pp[r] = p; if (r & 1) __builtin_amdgcn_sched_barrier(0); }
      const float red = wave_reduce8(pp, F.lane);
#pragma unroll
      for (int r = 0; r < 8; ++r) el[r] = __builtin_bit_cast(float, __builtin_amdgcn_readlane(__builtin_bit_cast(int, red), r)) + a.in[I_B_EXPERT][layer * NE + g * 8 + r]; }
    int i0 = 0; float m0 = el[0];
#pragma unroll
    for (int r = 1; r < 8; ++r) if (el[r] > m0) { m0 = el[r]; i0 = r; }
    int i1 = -1; float m1 = -INFINITY;
#pragma unroll
    for (int r = 0; r < 8; ++r) if (r != i0 && el[r] > m1) { m1 = el[r]; i1 = r; }
    const float q1 = __expf(m1 - m0), w0 = gp / (1.0f + q1), w1 = gp * q1 / (1.0f + q1);
    if (DRY && w0 + w1 < -1.0f) ((float*)(F.ws + WS_OPART))[0] = w0;
    if (F.lane == 0 && !DRY) {
        const int e0 = g * 8 + i0, e1 = g * 8 + i1;
        const int r0 = (int)atomicAdd(F.ctl + CW_CNT_AT(layer, e0), 1u), r1 = (int)atomicAdd(F.ctl + CW_CNT_AT(layer, e1), 1u);
        int* lists = (int*)(F.ws + WS_LISTS); lists[e0 * LIST_CAP + r0] = t; lists[e1 * LIST_CAP + r1] = t;
        int* rec = (int*)(F.ws + WS_TOKREC) + (size_t)t * 8;
        rec[0] = e0; rec[1] = r0; rec[2] = __builtin_bit_cast(int, w0); rec[3] = e1; rec[4] = r1; rec[5] = __builtin_bit_cast(int, w1);
    }
}

template <bool OUT8> __device__ __forceinline__ void route_pair(Frame& F, CArgs& a, int layer, int ta, int tb) {
    const unsigned l16 = (unsigned)F.lane * 16u;
    gcptr xb0 = opaque_s((const bf16*)(F.ws + WS_XR) + (size_t)ta * D), xb1 = opaque_s((const bf16*)(F.ws + WS_XR) + (size_t)tb * D); gcptr gb = opaque_s(a.in[I_NORM_FFN] + layer * D);
    f32x4 v0[8], v1[8]; float s0 = 0.f, s1 = 0.f;
#pragma unroll
    for (int j = 0; j < 8; ++j) { const u32x2 x0 = *(const GAS u32x2*)(xb0 + j * 512 + (l16 >> 1)), x1 = *(const GAS u32x2*)(xb1 + j * 512 + (l16 >> 1));
        v0[j] = (f32x4){bflo(x0.x), bfhi(x0.x), bflo(x0.y), bfhi(x0.y)}; v1[j] = (f32x4){bflo(x1.x), bfhi(x1.x), bflo(x1.y), bfhi(x1.y)};
        s0 += (v0[j].x * v0[j].x + v0[j].y * v0[j].y) + (v0[j].z * v0[j].z + v0[j].w * v0[j].w); s1 += (v1[j].x * v1[j].x + v1[j].y * v1[j].y) + (v1[j].z * v1[j].z + v1[j].w * v1[j].w); }
    const float rstd0 = __builtin_amdgcn_rsqf(wave_sum(s0) * (1.f / D) + RMS_EPS), rstd1 = __builtin_amdgcn_rsqf(wave_sum(s1) * (1.f / D) + RMS_EPS);
#pragma unroll
    for (int j = 0; j < 8; ++j) { const f32x4 g = *(const GAS f32x4*)(gb + j * 1024 + l16);
        v0[j].x *= rstd0 * g.x; v0[j].y *= rstd0 * g.y; v0[j].z *= rstd0 * g.z; v0[j].w *= rstd0 * g.w; v1[j].x *= rstd1 * g.x; v1[j].y *= rstd1 * g.y; v1[j].z *= rstd1 * g.z; v1[j].w *= rstd1 * g.w;
        if (OUT8) { ((unsigned*)(F.ws + WS_XN) + (size_t)ta * (D / 4))[64 * j + F.lane] = pk4_fp8(v0[j].x * SC_XN, v0[j].y * SC_XN, v0[j].z * SC_XN, v0[j].w * SC_XN);
                    ((unsigned*)(F.ws + WS_XN) + (size_t)tb * (D / 4))[64 * j + F.lane] = pk4_fp8(v1[j].x * SC_XN, v1[j].y * SC_XN, v1[j].z * SC_XN, v1[j].w * SC_XN); }
        else { u32x2 w; w.x = pk2(v0[j].x, v0[j].y); w.y = pk2(v0[j].z, v0[j].w); ((u32x2*)((bf16*)(F.ws + WS_XN) + (size_t)ta * D) + F.lane)[64 * j] = w;
               w.x = pk2(v1[j].x, v1[j].y); w.y = pk2(v1[j].z, v1[j].w); ((u32x2*)((bf16*)(F.ws + WS_XN) + (size_t)tb * D) + F.lane)[64 * j] = w; } }
    const float* RT = (const float*)(F.ws + WS_RT) + (size_t)layer * 36 * D;
    float gla[4], glb[4];
    { float pa_[4], pb_[4];
#pragma unroll
      for (int r = 0; r < 4; ++r) { gcptr wb = opaque_s(RT + r * D); float p0 = 0.f, p1 = 0.f;
#pragma unroll
        for (int j = 0; j < 8; ++j) { const f32x4 w = *(const GAS f32x4*)(wb + j * 1024 + l16);
            p0 += (v0[j].x * w.x + v0[j].y * w.y) + (v0[j].z * w.z + v0[j].w * w.w); p1 += (v1[j].x * w.x + v1[j].y * w.y) + (v1[j].z * w.z + v1[j].w * w.w); }
        pa_[r] = p0; pb_[r] = p1; if (r & 1) __builtin_amdgcn_sched_barrier(0); }
      const float reda = wave_reduce4(pa_, F.lane), redb = wave_reduce4(pb_, F.lane);
#pragma unroll
      for (int r = 0; r < 4; ++r) { const float bg = a.in[I_B_GROUP][layer * NG + r];
          gla[r] = __builtin_bit_cast(float, __builtin_amdgcn_readlane(__builtin_bit_cast(int, reda), r)) + bg; glb[r] = __builtin_bit_cast(float, __builtin_amdgcn_readlane(__builtin_bit_cast(int, redb), r)) + bg; } }
    int ga = 0, gb_ = 0; float gma = gla[0], gmb = glb[0];
#pragma unroll
    for (int r = 1; r < 4; ++r) { if (gla[r] > gma) { gma = gla[r]; ga = r; } if (glb[r] > gmb) { gmb = glb[r]; gb_ = r; } }
    float gsa = 0.f, gsb = 0.f;
#pragma unroll
    for (int r = 0; r < 4; ++r) { gsa += __expf(gla[r] - gma); gsb += __expf(glb[r] - gmb); }
    const float gpa = 1.0f / gsa, gpb = 1.0f / gsb;
    ga = __builtin_amdgcn_readfirstlane(ga); gb_ = __builtin_amdgcn_readfirstlane(gb_);
    float ela[8], elb[8];
    { float pa_[8], pb_[8];
#pragma unroll
      for (int r = 0; r < 8; ++r) { gcptr wa = opaque_s(RT + (size_t)(4 + ga * 8 + r) * D), wb = opaque_s(RT + (size_t)(4 + gb_ * 8 + r) * D); float p0 = 0.f, p1 = 0.f;
#pragma unroll
        for (int j = 0; j < 8; ++j) { const f32x4 w0 = *(const GAS f32x4*)(wa + j * 1024 + l16), w1 = *(const GAS f32x4*)(wb + j * 1024 + l16);
            p0 += (v0[j].x * w0.x + v0[j].y * w0.y) + (v0[j].z * w0.z + v0[j].w * w0.w); p1 += (v1[j].x * w1.x + v1[j].y * w1.y) + (v1[j].z * w1.z + v1[j].w * w1.w); }
        pa_[r] = p0; pb_[r] = p1; if (r & 1) __builtin_amdgcn_sched_barrier(0); }
      const float reda = wave_reduce8(pa_, F.lane), redb = wave_reduce8(pb_, F.lane);
#pragma unroll
      for (int r = 0; r < 8; ++r) { ela[r] = __builtin_bit_cast(float, __builtin_amdgcn_readlane(__builtin_bit_cast(int, reda), r)) + a.in[I_B_EXPERT][layer * NE + ga * 8 + r];
                                    elb[r] = __builtin_bit_cast(float, __builtin_amdgcn_readlane(__builtin_bit_cast(int, redb), r)) + a.in[I_B_EXPERT][layer * NE + gb_ * 8 + r]; } }
    int ia0 = 0, ib0 = 0; float ma0 = ela[0], mb0 = elb[0];
#pragma unroll
    for (int r = 1; r < 8; ++r) { if (ela[r] > ma0) { ma0 = ela[r]; ia0 = r; } if (elb[r] > mb0) { mb0 = elb[r]; ib0 = r; } }
    int ia1 = -1, ib1 = -1; float ma1 = -INFINITY, mb1 = -INFINITY;
#pragma unroll
    for (int r = 0; r < 8; ++r) { if (r != ia0 && ela[r] > ma1) { ma1 = ela[r]; ia1 = r; } if (r != ib0 && elb[r] > mb1) { mb1 = elb[r]; ib1 = r; } }
    const float qa = __expf(ma1 - ma0), wa0 = gpa / (1.0f + qa), wa1 = gpa * qa / (1.0f + qa);
    const float qb = __expf(mb1 - mb0), wb0 = gpb / (1.0f + qb), wb1 = gpb * qb / (1.0f + qb);
    if (F.lane == 0) {
        const int ea0 = ga * 8 + ia0, ea1 = ga * 8 + ia1, eb0 = gb_ * 8 + ib0, eb1 = gb_ * 8 + ib1;
        const int ra0 = (int)atomicAdd(F.ctl + CW_CNT_AT(layer, ea0), 1u), ra1 = (int)atomicAdd(F.ctl + CW_CNT_AT(layer, ea1), 1u);
        const int rb0 = (int)atomicAdd(F.ctl + CW_CNT_AT(layer, eb0), 1u), rb1 = (int)atomicAdd(F.ctl + CW_CNT_AT(layer, eb1), 1u);
        int* lists = (int*)(F.ws + WS_LISTS); lists[ea0 * LIST_CAP + ra0] = ta; lists[ea1 * LIST_CAP + ra1] = ta; lists[eb0 * LIST_CAP + rb0] = tb; lists[eb1 * LIST_CAP + rb1] = tb;
        int* rec = (int*)(F.ws + WS_TOKREC) + (size_t)ta * 8;
        rec[0] = ea0; rec[1] = ra0; rec[2] = __builtin_bit_cast(int, wa0); rec[3] = ea1; rec[4] = ra1; rec[5] = __builtin_bit_cast(int, wa1);
        rec = (int*)(F.ws + WS_TOKREC) + (size_t)tb * 8;
        rec[0] = eb0; rec[1] = rb0; rec[2] = __builtin_bit_cast(int, wb0); rec[3] = eb1; rec[4] = rb1; rec[5] = __builtin_bit_cast(int, wb1);
    }
}

template <bool NORM, bool DRY, bool OUT8> __device__ __forceinline__ void combine_token(Frame& F, CArgs& a, int t) {
    const LAS int* blkstart = (const LAS int*)(F.lds + LT_BLKSTART);
    const int* rec = (const int*)(F.ws + WS_TOKREC) + (size_t)t * 8;
    const int e0 = rec[0], r0 = rec[1], e1 = rec[3], r1 = rec[4]; const float w0 = __builtin_bit_cast(float, rec[2]), w1 = __builtin_bit_cast(float, rec[5]);
    const size_t row0 = (size_t)blkstart[e0] * 256 + r0, row1 = (size_t)blkstart[e1] * 256 + r1;
    const u32x2* p0 = (const u32x2*)((const bf16*)(F.ws + WS_OUTB) + row0 * D) + F.lane; const u32x2* p1 = (const u32x2*)((const bf16*)(F.ws + WS_OUTB) + row1 * D) + F.lane;
    const unsigned* q0 = (const unsigned*)(F.ws + WS_OUTB + row0 * D) + F.lane; const unsigned* q1 = (const unsigned*)(F.ws + WS_OUTB + row1 * D) + F.lane;
    u32x2* xr = (u32x2*)((bf16*)(F.ws + WS_XR) + (size_t)t * D) + F.lane; f32x4* xo = (f32x4*)(a.out + (size_t)t * D) + F.lane;
    f32x4 v[8]; float s = 0.f;
#pragma unroll
    for (int j = 0; j < 8; ++j) { const u32x2 xb_ = xr[64 * j]; f32x4 x = (f32x4){bflo(xb_.x), bfhi(xb_.x), bflo(xb_.y), bfhi(xb_.y)};
        if (OUT8) { const unsigned b0 = q0[64 * j], b1 = q1[64 * j]; const float u0 = w0 * (1.0f / SC_OUT), u1 = w1 * (1.0f / SC_OUT);
            const f32x2 l0 = __builtin_amdgcn_cvt_pk_f32_fp8((int)b0, false), h0 = __builtin_amdgcn_cvt_pk_f32_fp8((int)b0, true), l1 = __builtin_amdgcn_cvt_pk_f32_fp8((int)b1, false), h1 = __builtin_amdgcn_cvt_pk_f32_fp8((int)b1, true);
            x.x += u0 * l0.x + u1 * l1.x; x.y += u0 * l0.y + u1 * l1.y; x.z += u0 * h0.x + u1 * h1.x; x.w += u0 * h0.y + u1 * h1.y; }
        else { const u32x2 a0 = p0[64 * j], a1 = p1[64 * j];
            x.x += w0 * bflo(a0.x) + w1 * bflo(a1.x); x.y += w0 * bfhi(a0.x) + w1 * bfhi(a1.x); x.z += w0 * bflo(a0.y) + w1 * bflo(a1.y); x.w += w0 * bfhi(a0.y) + w1 * bfhi(a1.y); }
        v[j] = x; if (NORM) { if (!DRY) { u32x2 w_; w_.x = pk2(x.x, x.y); w_.y = pk2(x.z, x.w); xr[64 * j] = w_; } } else xo[64 * j] = x; s += (x.x * x.x + x.y * x.y) + (x.z * x.z + x.w * x.w); }
    if (NORM) {
        const float rstd = __builtin_amdgcn_rsqf(wave_sum(s) * (1.f / D) + RMS_EPS);
        u32x2* o8 = (u32x2*)((bf16*)(F.ws + (DRY ? WS_OPART + 128 * MiB : WS_XN)) + (size_t)t * D) + F.lane;
#pragma unroll
        for (int j = 0; j < 8; ++j) {
            if (FP8_QKV) ((unsigned*)(F.ws + (DRY ? WS_OPART + 128 * MiB : WS_XN)) + (size_t)t * (D / 4))[64 * j + F.lane] = pk4_fp8(v[j].x * (rstd * SC_XN), v[j].y * (rstd * SC_XN), v[j].z * (rstd * SC_XN), v[j].w * (rstd * SC_XN));
            else { u32x2 w; w.x = pk2(v[j].x * rstd, v[j].y * rstd); w.y = pk2(v[j].z * rstd, v[j].w * rstd); o8[64 * j] = w; } }
    }
}

typedef int ci32x4 __attribute__((ext_vector_type(4)));
struct CombRows { u32x2 x[8]; unsigned b0[8], b1[8]; float w0, w1; };
template <bool NORM> __device__ __forceinline__ void combine_tokens(Frame& F, CArgs& a, int t0, int stride) {
    static_assert(OUT8_L0 && OUT8_L1 && FP8_QKV, "pipelined combine: e4m3 expert rows and e4m3 XN");
    const LAS int* blkstart = (const LAS int*)(F.lds + LT_BLKSTART);
    LAS ci32x4* lrec = (LAS ci32x4*)(F.lds + F.wave * 256);
    const int lane = F.lane;
    auto issue = [&](int k, int t, CombRows& R) {
        const ci32x4 r0 = lrec[2 * k], r1 = lrec[2 * k + 1];
        const int e0 = __builtin_amdgcn_readfirstlane(r0.x), rr0 = __builtin_amdgcn_readfirstlane(r0.y), e1 = __builtin_amdgcn_readfirstlane(r0.w), rr1 = __builtin_amdgcn_readfirstlane(r1.x);
        const LAS float* wf = (const LAS float*)lrec + 8 * k; R.w0 = wf[2] * (1.0f / SC_OUT); R.w1 = wf[5] * (1.0f / SC_OUT);
        const size_t row0 = (size_t)blkstart[e0] * 256 + rr0, row1 = (size_t)blkstart[e1] * 256 + rr1;
        const unsigned* q0 = (const unsigned*)(F.ws + WS_OUTB + row0 * D) + lane; const unsigned* q1 = (const unsigned*)(F.ws + WS_OUTB + row1 * D) + lane;
        const u32x2* xr = (const u32x2*)((const bf16*)(F.ws + WS_XR) + (size_t)t * D) + lane;
#pragma unroll
        for (int j = 0; j < 8; ++j) { R.x[j] = xr[64 * j]; R.b0[j] = q0[64 * j]; R.b1[j] = q1[64 * j]; }
    };
    auto finish = [&](int t, const CombRows& R) {
        u32x2* xr = (u32x2*)((bf16*)(F.ws + WS_XR) + (size_t)t * D) + lane; f32x4* xo = (f32x4*)(a.out + (size_t)t * D) + lane;
        f32x4 v[8]; float s = 0.f;
#pragma unroll
        for (int j = 0; j < 8; ++j) { f32x4 x = (f32x4){bflo(R.x[j].x), bfhi(R.x[j].x), bflo(R.x[j].y), bfhi(R.x[j].y)};
            const f32x2 l0 = __builtin_amdgcn_cvt_pk_f32_fp8((int)R.b0[j], false), h0 = __builtin_amdgcn_cvt_pk_f32_fp8((int)R.b0[j], true), l1 = __builtin_amdgcn_cvt_pk_f32_fp8((int)R.b1[j], false), h1 = __builtin_amdgcn_cvt_pk_f32_fp8((int)R.b1[j], true);
            x.x += R.w0 * l0.x + R.w1 * l1.x; x.y += R.w0 * l0.y + R.w1 * l1.y; x.z += R.w0 * h0.x + R.w1 * h1.x; x.w += R.w0 * h0.y + R.w1 * h1.y;
            v[j] = x; if (NORM) { u32x2 w_; w_.x = pk2(x.x, x.y); w_.y = pk2(x.z, x.w); xr[64 * j] = w_; } else xo[64 * j] = x; s += (x.x * x.x + x.y * x.y) + (x.z * x.z + x.w * x.w); }
        if (NORM) {
            const float rstd = __builtin_amdgcn_rsqf(wave_sum(s) * (1.f / D) + RMS_EPS) * SC_XN;
            unsigned* o = (unsigned*)(F.ws + WS_XN) + (size_t)t * (D / 4) + lane;
#pragma unroll
            for (int j = 0; j < 8; ++j) o[64 * j] = pk4_fp8(v[j].x * rstd, v[j].y * rstd, v[j].z * rstd, v[j].w * rstd);
        }
    };
    for (int base = t0; base < M; base += 8 * stride) {
        const int nt = min(8, (M - base + stride - 1) / stride);
        if (lane < 2 * nt) lrec[lane] = ((const ci32x4*)(F.ws + WS_TOKREC))[2 * (size_t)(base + (lane >> 1) * stride) + (lane & 1)];
        LDS_WAIT(); asm volatile("s_waitcnt vmcnt(0)" ::: "memory"); LDS_WAIT();
        CombRows cur, nxt; issue(0, base, cur);
        for (int k = 0; k < nt; ++k) {
            if (k + 1 < nt) issue(k + 1, base + (k + 1) * stride, nxt);
            finish(base + k * stride, cur);
            cur = nxt;
        }
        LDS_WAIT();
    }
}
__device__ __forceinline__ void hgrn_naive_item(Frame& F, int item) {
    const int b = item >> 6, h = (item >> 2) & 15, sl = item & 3;
    const bf16* Zq = (const bf16*)(F.ws + WS_ZQ); const bf16* Zk = (const bf16*)(F.ws + WS_ZK); const _Float16* Zg = (const _Float16*)(F.ws + WS_ZG); const bf16* Zv = (const bf16*)(F.ws + WS_ZV);
    float* Oraw = (float*)(F.ws + WS_ORAW);
    LAS float* fq = (LAS float*)F.lds; LAS float* fk = fq + 16 * 128; LAS float* ff = fk + 16 * 128; LAS float* fv = ff + 16 * 128; LAS float* part = fv + 16 * 32;
    const int dv = F.tid & 31, dkg = F.tid >> 5;
    float S[8];
#pragma unroll
    for (int j = 0; j < 8; ++j) S[j] = 0.f;
    const size_t tok0 = (size_t)b * T;
    for (int c = 0; c < T / 16; ++c) {
        __syncthreads();
#pragma unroll
        for (int i = 0; i < 4; ++i) { const int idx = F.tid + i * 512, st = idx >> 7, dk = idx & 127; const size_t g = (tok0 + c * 16 + st) * D + h * HD + dk;
            fq[idx] = bf2f(Zq[g]); fk[idx] = bf2f(Zk[g]); ff[idx] = __expf((float)Zg[g]); }
        { const int st = F.tid >> 5; fv[F.tid] = bf2f(Zv[(tok0 + c * 16 + st) * D + h * HD + sl * 32 + dv]); }
        __syncthreads();
#pragma unroll 4
        for (int st = 0; st < 16; ++st) {
            const float v = fv[st * 32 + dv];
            const f32x4 q0 = *(const LAS f32x4*)(fq + st * 128 + dkg * 8), q1 = *(const LAS f32x4*)(fq + st * 128 + dkg * 8 + 4);
            const f32x4 k0 = *(const LAS f32x4*)(fk + st * 128 + dkg * 8), k1 = *(const LAS f32x4*)(fk + st * 128 + dkg * 8 + 4);
            const f32x4 f0 = *(const LAS f32x4*)(ff + st * 128 + dkg * 8), f1 = *(const LAS f32x4*)(ff + st * 128 + dkg * 8 + 4);
            float po = 0.f;
#pragma unroll
            for (int j = 0; j < 4; ++j) { S[j] = f0[j] * S[j] + k0[j] * v; po += q0[j] * S[j]; S[4 + j] = f1[j] * S[4 + j] + k1[j] * v; po += q1[j] * S[4 + j]; }
            part[(st * 16 + dkg) * 32 + dv] = po;
        }
        __syncthreads();
        { const int st = F.tid >> 5; float o = 0.f;
#pragma unroll
            for (int g = 0; g < 16; ++g) o += part[(st * 16 + g) * 32 + dv];
            Oraw[(tok0 + c * 16 + st) * D + h * HD + sl * 32 + dv] = o; }
    }
    __syncthreads();
}
__device__ __forceinline__ void hgrn_norm_token(Frame& F, CArgs& a, int t) {
    const float* o = (const float*)(F.ws + WS_ORAW) + (size_t)t * D + F.lane * 32;
    const bf16* zg = (const bf16*)(F.ws + WS_ZGATE) + (size_t)t * D + F.lane * 32;
    const float* gain = a.in[I_A_OGAIN] + (F.lane & 3) * 32;
    f32x4 v[8]; float s = 0.f;
#pragma unroll
    for (int j = 0; j < 8; ++j) { v[j] = ((const f32x4*)o)[j]; s += (v[j].x * v[j].x + v[j].y * v[j].y) + (v[j].z * v[j].z + v[j].w * v[j].w); }
    s += __shfl_xor(s, 1); s += __shfl_xor(s, 2);
    const float rstd = 1.0f / sqrtf(s * (1.f / HD) + RMS_EPS);
    bf16* out = (bf16*)(F.ws + WS_OH) + (size_t)t * D + F.lane * 32;
#pragma unroll
    for (int j = 0; j < 4; ++j) { const u32x4 g = ((const u32x4*)zg)[j]; const f32x4 ga = ((const f32x4*)gain)[2 * j], gb = ((const f32x4*)gain)[2 * j + 1]; const f32x4 va = v[2 * j], vb = v[2 * j + 1];
        u32x4 w; w.x = pk2(va.x * rstd * ga.x * bflo(g.x), va.y * rstd * ga.y * bfhi(g.x)); w.y = pk2(va.z * rstd * ga.z * bflo(g.y), va.w * rstd * ga.w * bfhi(g.y));
        w.z = pk2(vb.x * rstd * gb.x * bflo(g.z), vb.y * rstd * gb.y * bfhi(g.z)); w.w = pk2(vb.z * rstd * gb.z * bflo(g.w), vb.w * rstd * gb.w * bfhi(g.w));
        ((u32x4*)out)[j] = w; }
}

template <bool DRY> __device__ __forceinline__ void qk_post_item(Frame& F, CArgs& a, int item) {
    const int b = item >> 6, n = (item >> 2) & 15, hq = item & 3;
    const int hl = F.lane >> 4, sb = F.lane & 15, h = hq * 4 + hl;
    bf16* Q = (bf16*)(F.ws + WS_Q); bf16* Kb = (bf16*)(F.ws + WS_K);
    const f32x2* rope = (const f32x2*)(F.ws + WS_ROPE);
    const f32x4 gq0 = *(const f32x4*)(a.in[I_B_Q_NORM] + 4 * sb), gq1 = *(const f32x4*)(a.in[I_B_Q_NORM] + 64 + 4 * sb);
    const f32x4 gk0 = *(const f32x4*)(a.in[I_K_NORM] + 4 * sb), gk1 = *(const f32x4*)(a.in[I_K_NORM] + 64 + 4 * sb);
    float ks[8];
#pragma unroll
    for (int j = 0; j < 8; ++j) ks[j] = 0.f;
    for (int i = 0; i < 32; ++i) {
        const int pos = n * MBLK + F.wave * 32 + i; const size_t tok = (size_t)b * T + pos;
        f32x2 cs[4];
#pragma unroll
        for (int j = 0; j < 4; ++j) cs[j] = rope[pos * 64 + 4 * sb + j];
#pragma unroll
        for (int which = 0; which < 2; ++which) {
            bf16* p = (which ? Kb : Q) + tok * D + h * HD + 4 * sb;
            const u32x2 lo = *(const u32x2*)p, hi = *(const u32x2*)(p + 64);
            float x1[4] = {bflo(lo.x), bfhi(lo.x), bflo(lo.y), bfhi(lo.y)}, x2[4] = {bflo(hi.x), bfhi(hi.x), bflo(hi.y), bfhi(hi.y)};
            float s = 0.f;
#pragma unroll
            for (int j = 0; j < 4; ++j) s += x1[j] * x1[j] + x2[j] * x2[j];
            s += __shfl_xor(s, 1); s += __shfl_xor(s, 2); s += __shfl_xor(s, 4); s += __shfl_xor(s, 8);
            const float rstd = 1.0f / sqrtf(s * (1.f / HD) + RMS_EPS);
            const f32x4 g0 = which ? gk0 : gq0, g1 = which ? gk1 : gq1;
            float o1[4], o2[4];
#pragma unroll
            for (int j = 0; j < 4; ++j) { const float y1 = x1[j] * rstd * g0[j], y2 = x2[j] * rstd * g1[j]; o1[j] = y1 * cs[j].x - y2 * cs[j].y; o2[j] = y2 * cs[j].x + y1 * cs[j].y; }
            u32x2 wlo, whi; wlo.x = pk2(o1[0], o1[1]); wlo.y = pk2(o1[2], o1[3]); whi.x = pk2(o2[0], o2[1]); whi.y = pk2(o2[2], o2[3]);
            { bf16* pw = DRY ? p + (WS_OPART - WS_Q) / 2 : p; *(u32x2*)pw = wlo; *(u32x2*)(pw + 64) = whi; }
            if (which) {
#pragma unroll
                for (int j = 0; j < 4; ++j) { ks[j] += o1[j]; ks[4 + j] += o2[j]; } }
        }
    }
    LAS float* red = (LAS float*)F.lds;
    __syncthreads();
#pragma unroll
    for (int j = 0; j < 8; ++j) red[(F.wave * 64 + F.lane) * 8 + j] = ks[j];
    __syncthreads();
    { const int l = F.tid >> 3, j = F.tid & 7; float s = 0.f;
#pragma unroll
        for (int w = 0; w < 8; ++w) s += red[(w * 64 + l) * 8 + j];
        const int hh = hq * 4 + (l >> 4), s2 = l & 15, d = (j < 4) ? 4 * s2 + j : 64 + 4 * s2 + (j - 4);
        ((float*)(F.ws + (DRY ? WS_OPART + 200 * MiB : WS_KMEAN)))[(((size_t)b * H + hh) * NBLK + n) * HD + d] = s * (1.0f / MBLK); }
    const bf16* V = (const bf16*)(F.ws + WS_V); bf16* Vt = (bf16*)(F.ws + (DRY ? WS_OPART + 128 * MiB : WS_VT));
    LAS bf16* vl = (LAS bf16*)(F.lds + 32768);
    for (int hh = 0; hh < 4; ++hh) {
        const int hv = hq * 4 + hh;
        __syncthreads();
#pragma unroll
        for (int i = 0; i < 8; ++i) { const int ch = F.tid + i * 512, r = ch >> 4, cc = ch & 15;
            const u32x4 w = *(const u32x4*)(V + ((size_t)b * T + n * MBLK + r) * D + hv * HD + cc * 8);
            *(LAS u32x4*)(vl + r * 136 + cc * 8) = w; }
        __syncthreads();
#pragma unroll
        for (int i = 0; i < 8; ++i) { const int idx = F.tid + i * 512, d = idx & 127, tg = idx >> 7;
            unsigned short e[8];
#pragma unroll
            for (int j = 0; j < 8; ++j) e[j] = vl[(tg * 8 + j) * 136 + d];
            u32x4 w; w.x = e[0] | ((unsigned)e[1] << 16); w.y = e[2] | ((unsigned)e[3] << 16); w.z = e[4] | ((unsigned)e[5] << 16); w.w = e[6] | ((unsigned)e[7] << 16);
            *(u32x4*)(Vt + (((size_t)b * H + hv) * HD + d) * T + n * MBLK + tg * 8) = w; }
    }
    __syncthreads();
}

__device__ __forceinline__ void attn_v0_item(Frame& F, int item) {
    const int b = item >> 8, h = (item >> 4) & 15, jb = item & 15;
    const bf16* Q = (const bf16*)(F.ws + WS_Q); const bf16* Kb = (const bf16*)(F.ws + WS_K); const bf16* Vt = (const bf16*)(F.ws + WS_VT); bf16* OA = (bf16*)(F.ws + WS_OA);
    const float* kmean = (const float*)(F.ws + WS_KMEAN) + ((size_t)b * H + h) * NBLK * HD;
    const int lane = F.lane, fr = lane & 15, fq = lane >> 4;
    const size_t tokw = (size_t)b * T + jb * MBLK + F.wave * 32;
    LAS unsigned* maskl = (LAS unsigned*)(F.lds + F.wave * 8192);
    LAS bf16* pl = (LAS bf16*)(F.lds + F.wave * 8192 + 256);
    {
        const int row = lane & 31, half = lane >> 5;
        float g[8];
#pragma unroll
        for (int i = 0; i < 8; ++i) g[i] = 0.f;
        const bf16* qrow = Q + (tokw + row) * D + h * HD;
        for (int dc = 0; dc < 16; ++dc) {
            const u32x4 w = *(const u32x4*)(qrow + dc * 8);
            const float qv[8] = {bflo(w.x), bfhi(w.x), bflo(w.y), bfhi(w.y), bflo(w.z), bfhi(w.z), bflo(w.w), bfhi(w.w)};
#pragma unroll
            for (int i = 0; i < 8; ++i) { const float* km = kmean + (2 * i + half) * HD + dc * 8;
#pragma unroll
                for (int e = 0; e < 8; ++e) g[i] += qv[e] * km[e]; }
        }
        float ga[16];
#pragma unroll
        for (int i = 0; i < 8; ++i) { const float o = __shfl_xor(g[i], 32); ga[2 * i] = half ? o : g[i]; ga[2 * i + 1] = half ? g[i] : o; }
        unsigned mask = 0u;
#pragma unroll
        for (int pick = 0; pick < 3; ++pick) { float best = -INFINITY; int bi = -1;
#pragma unroll
            for (int n = 0; n < 16; ++n) { const bool ok = (n < jb) && !((mask >> n) & 1u); if (ok && ga[n] > best) { best = ga[n]; bi = n; } }
            if (bi >= 0) mask |= 1u << bi; }
        if (half == 0) maskl[row] = mask;
    }
    LDS_WAIT(); __builtin_amdgcn_wave_barrier();
    unsigned rmask[2][4]; unsigned anym = 0u;
#pragma unroll
    for (int rt = 0; rt < 2; ++rt)
#pragma unroll
        for (int r = 0; r < 4; ++r) { rmask[rt][r] = maskl[rt * 16 + 4 * fq + r]; }
    { unsigned m = maskl[lane & 31];
#pragma unroll
      for (int o = 1; o < 32; o <<= 1) m |= __shfl_xor(m, o);
      anym = __builtin_amdgcn_readfirstlane(m); }
    bf16x8 qf[2][4];
#pragma unroll
    for (int rt = 0; rt < 2; ++rt)
#pragma unroll
        for (int ks = 0; ks < 4; ++ks) qf[rt][ks] = *(const bf16x8*)(Q + (tokw + rt * 16 + fr) * D + h * HD + ks * 32 + 8 * fq);
    f32x4 oacc[2][8];
#pragma unroll
    for (int rt = 0; rt < 2; ++rt)
#pragma unroll
        for (int dt = 0; dt < 8; ++dt) oacc[rt][dt] = (f32x4){0.f, 0.f, 0.f, 0.f};
    float lsum[2][4];
#pragma unroll
    for (int rt = 0; rt < 2; ++rt)
#pragma unroll
        for (int r = 0; r < 4; ++r) lsum[rt][r] = 0.f;
    const float c2 = 0.08838834764831845f * 1.4426950408889634f;
    const int nkt = 4 * jb + 4;
    for (int kt = 0; kt < nkt; ++kt) {
        const int n = kt >> 2; const bool own = (n == jb);
        if (!own && !((anym >> n) & 1u)) continue;
        if (own && (kt & 3) * 64 > F.wave * 32 + 31) continue;
        const size_t key0 = (size_t)b * T + kt * 64;
        f32x4 sacc[2][4];
#pragma unroll
        for (int ct = 0; ct < 4; ++ct) {
            bf16x8 kf[4];
#pragma unroll
            for (int ks = 0; ks < 4; ++ks) kf[ks] = *(const bf16x8*)(Kb + (key0 + ct * 16 + fr) * D + h * HD + ks * 32 + 8 * fq);
#pragma unroll
            for (int rt = 0; rt < 2; ++rt) { f32x4 s = (f32x4){0.f, 0.f, 0.f, 0.f};
#pragma unroll
                for (int ks = 0; ks < 4; ++ks) s = __builtin_amdgcn_mfma_f32_16x16x32_bf16(qf[rt][ks], kf[ks], s, 0, 0, 0);
                sacc[rt][ct] = s; }
        }
#pragma unroll
        for (int rt = 0; rt < 2; ++rt)
#pragma unroll
            for (int ct = 0; ct < 4; ++ct)
#pragma unroll
                for (int r = 0; r < 4; ++r) {
                    const int qrow = rt * 16 + 4 * fq + r, kcol = ct * 16 + fr;
                    const bool ok = own ? ((kt & 3) * 64 + kcol <= F.wave * 32 + qrow) : ((rmask[rt][r] >> n) & 1u);
                    const float p = ok ? __builtin_amdgcn_exp2f(sacc[rt][ct][r] * c2) : 0.f;
                    lsum[rt][r] += p;
                    pl[qrow * 72 + kcol] = (bf16)f2bf(p);
                }
        LDS_WAIT(); __builtin_amdgcn_wave_barrier();
        bf16x8 pf[2][2];
#pragma unroll
        for (int rt = 0; rt < 2; ++rt)
#pragma unroll
            for (int k2 = 0; k2 < 2; ++k2) pf[rt][k2] = *(const LAS bf16x8*)(pl + (rt * 16 + fr) * 72 + k2 * 32 + 8 * fq);
#pragma unroll
        for (int dt = 0; dt < 8; ++dt) {
            bf16x8 vf[2];
#pragma unroll
            for (int k2 = 0; k2 < 2; ++k2) vf[k2] = *(const bf16x8*)(Vt + (((size_t)b * H + h) * HD + dt * 16 + fr) * T + kt * 64 + k2 * 32 + 8 * fq);
#pragma unroll
            for (int rt = 0; rt < 2; ++rt)
#pragma unroll
                for (int k2 = 0; k2 < 2; ++k2) oacc[rt][dt] = __builtin_amdgcn_mfma_f32_16x16x32_bf16(pf[rt][k2], vf[k2], oacc[rt][dt], 0, 0, 0);
        }
        LDS_WAIT(); __builtin_amdgcn_wave_barrier();
    }
#pragma unroll
    for (int rt = 0; rt < 2; ++rt)
#pragma unroll
        for (int r = 0; r < 4; ++r) { float s = lsum[rt][r]; s += __shfl_xor(s, 1); s += __shfl_xor(s, 2); s += __shfl_xor(s, 4); s += __shfl_xor(s, 8); const float inv = 1.0f / s;
            bf16* orow = OA + (tokw + rt * 16 + 4 * fq + r) * D + h * HD + fr;
#pragma unroll
            for (int dt = 0; dt < 8; ++dt) orow[dt * 16] = (bf16)f2bf(oacc[rt][dt][r] * inv); }
}

typedef float f32x16 __attribute__((ext_vector_type(16)));
template <bool DRY> __device__ __forceinline__ void moba_gate_item(Frame& F, int item) {
    const int bh = item >> 3, p = item & 7, b = bh >> 4, h = bh & 15;
    LAS float* km = (LAS float*)F.lds;
    __syncthreads();
    { const f32x4 v = ((const f32x4*)((const float*)(F.ws + WS_KMEAN) + (size_t)bh * NBLK * HD))[F.tid]; ((LAS f32x4*)km)[F.tid] = v; }
    __syncthreads();
    const int j = 2 * p + (F.wave >> 2), t = j * MBLK + (F.wave & 3) * 64 + F.lane;
    if (j == 0) return;
    const unsigned char* qrow = F.ws + WS_Q + ((size_t)b * T + t) * D + h * HD;
    float g[16];
#pragma unroll
    for (int n = 0; n < 16; ++n) g[n] = 0.f;
    for (int dc = 0; dc < 8; ++dc) {
        const u32x4 w = *(const u32x4*)(qrow + dc * 16);
        float qv[16]; { float t4[4]; fp8x4_to_f32(w.x, t4); qv[0] = t4[0]; qv[1] = t4[1]; qv[2] = t4[2]; qv[3] = t4[3]; fp8x4_to_f32(w.y, t4); qv[4] = t4[0]; qv[5] = t4[1]; qv[6] = t4[2]; qv[7] = t4[3];
            fp8x4_to_f32(w.z, t4); qv[8] = t4[0]; qv[9] = t4[1]; qv[10] = t4[2]; qv[11] = t4[3]; fp8x4_to_f32(w.w, t4); qv[12] = t4[0]; qv[13] = t4[1]; qv[14] = t4[2]; qv[15] = t4[3]; }
#pragma unroll
        for (int n = 0; n < 15; ++n) if (n < j) {
#pragma unroll
            for (int q4 = 0; q4 < 4; ++q4) { const f32x4 k0 = *(const LAS f32x4*)(km + n * HD + dc * 16 + 4 * q4);
                g[n] += (qv[4 * q4] * k0.x + qv[4 * q4 + 1] * k0.y) + (qv[4 * q4 + 2] * k0.z + qv[4 * q4 + 3] * k0.w); } }
    }
    int pk[3];
    unsigned mask = 0u;
#pragma unroll
    for (int pick = 0; pick < 3; ++pick) { float best = -INFINITY; int bi = -1;
#pragma unroll
        for (int n = 0; n < 15; ++n) { const bool ok = (n < j) && !((mask >> n) & 1u); if (ok && g[n] > best) { best = g[n]; bi = n; } }
        if (bi >= 0) mask |= 1u << bi;
        pk[pick] = bi; }
    unsigned* acnt = F.ctl + CW_ACNT + bh * 16; int* alist = (int*)(F.ws + WS_ALIST) + (size_t)bh * 16 * ALIST_CAP;
    unsigned mycnt = 0u;
#pragma unroll
    for (int n = 0; n < 15; ++n) if (n < j) { const unsigned long long bal = __ballot((mask >> n) & 1u); mycnt = (F.lane == n) ? (unsigned)__popcll(bal) : mycnt; }
    unsigned mybase = 0u;
    if (F.lane < 15 && mycnt > 0u && !DRY) mybase = atomicAdd(acnt + F.lane, mycnt);
#pragma unroll
    for (int n = 0; n < 15; ++n) if (n < j) {
        const bool sel = (mask >> n) & 1u; const int slot = (pk[0] == n) ? 0 : ((pk[1] == n) ? 1 : 2);
        const unsigned long long bal = __ballot(sel);
        if (bal) { const unsigned base = (unsigned)__builtin_amdgcn_readlane((int)mybase, n);
            const int rank = __popcll(bal & ((1ull << F.lane) - 1ull));
            if (sel) (DRY ? (int*)(F.ws + WS_OPART) : alist)[n * ALIST_CAP + base + rank] = t | (slot << 16); }
    }
}

constexpr int AL_K = 0, AL_V = 36864; constexpr float SC_P = 4.f;
typedef int i32x8v __attribute__((ext_vector_type(8)));
__device__ __forceinline__ i32x8v ld32(const LAS unsigned char* p) { const u32x4 a = *(const LAS u32x4*)p, b = *(const LAS u32x4*)(p + 16); i32x8v r; r[0] = a.x; r[1] = a.y; r[2] = a.z; r[3] = a.w; r[4] = b.x; r[5] = b.y; r[6] = b.z; r[7] = b.w; return r; }
template <bool OWN> __device__ __forceinline__ void attn_chunk(Frame& F, int b, int h, int n, int c, int cnt, const int* lst) {
    const int lane = F.lane, qi = lane & 31, hh = lane >> 5, w = F.wave;
    const int rem = OWN ? MBLK : cnt - c * 256;
    if (w * 32 >= rem) return;
    int t, slot; bool valid = true;
    if (OWN) { t = n * MBLK + w * 32 + qi; slot = 3; }
    else { const int idx = w * 32 + qi; valid = idx < rem; const int e = lst[c * 256 + (valid ? idx : 0)]; t = e & 0xffff; slot = e >> 16; }
    const size_t tok = (size_t)b * T + t;
    const unsigned char* qrow = F.ws + WS_Q + tok * D + h * HD;
    i32x8v qf[2];
#pragma unroll
    for (int ks = 0; ks < 2; ++ks) { const u32x4 a = *(const u32x4*)(qrow + 64 * ks + 32 * hh), bq = *(const u32x4*)(qrow + 64 * ks + 32 * hh + 16);
        qf[ks][0] = a.x; qf[ks][1] = a.y; qf[ks][2] = a.z; qf[ks][3] = a.w; qf[ks][4] = bq.x; qf[ks][5] = bq.y; qf[ks][6] = bq.z; qf[ks][7] = bq.w; }
    const LAS unsigned char* Kl = F.lds + AL_K; const LAS unsigned char* Vl = F.lds + AL_V;
    f32x16 oacc[4];
#pragma unroll
    for (int dt = 0; dt < 4; ++dt)
#pragma unroll
        for (int r = 0; r < 16; ++r) oacc[dt][r] = 0.f;
    float lsum = 0.f, mrun = -1e30f;
    const float c2 = 0.08838834764831845f * 1.4426950408889634f / (SC_QKV * SC_QKV);
    const int ngrp = OWN ? ((w >> 1) + 1) : 4;
#pragma unroll
    for (int G = 0; G < 4; ++G) {
        if (G >= ngrp) break;
        f32x16 sa, sb;
#pragma unroll
        for (int r = 0; r < 16; ++r) { sa[r] = 0.f; sb[r] = 0.f; }
#pragma unroll
        for (int ks = 0; ks < 2; ++ks) {
            const i32x8v ka = ld32(Kl + (64 * G + qi) * 144 + 64 * ks + 32 * hh), kb = ld32(Kl + (64 * G + 32 + qi) * 144 + 64 * ks + 32 * hh);
            sa = __builtin_amdgcn_mfma_scale_f32_32x32x64_f8f6f4(ka, qf[ks], sa, 0, 0, 0, 0, 0, 0);
            sb = __builtin_amdgcn_mfma_scale_f32_32x32x64_f8f6f4(kb, qf[ks], sb, 0, 0, 0, 0, 0, 0);
        }
        float tv[32];
#pragma unroll
        for (int r = 0; r < 16; ++r) { tv[r] = sa[r]; tv[16 + r] = sb[r]; }
        if (OWN && G == (w >> 1)) {
#pragma unroll
            for (int p = 0; p < 32; ++p) { const int key = 64 * G + 32 * (p >> 4) + (p & 3) + 8 * ((p >> 2) & 3) + 4 * hh; tv[p] = (key <= w * 32 + qi) ? tv[p] : -3e38f; }
        }
        float ml = tv[0];
#pragma unroll
        for (int p = 1; p < 32; ++p) ml = fmaxf(ml, tv[p]);
        ml = fmaxf(ml, __shfl_xor(ml, 32)) * c2;
        const float mnew = (ml > mrun + 6.0f) ? ml : mrun;
        const bool moved = (mnew != mrun);
        const float alpha = __builtin_amdgcn_exp2f(mrun - mnew);
        mrun = mnew;
        float ps = 0.f; i32x8v pf;
#pragma unroll
        for (int q4 = 0; q4 < 8; ++q4) { float e4[4];
#pragma unroll
            for (int j = 0; j < 4; ++j) { e4[j] = __builtin_amdgcn_exp2f(__builtin_fmaf(tv[4 * q4 + j], c2, -mnew)); ps += e4[j]; }
            int pw_ = __builtin_amdgcn_cvt_pk_fp8_f32(e4[0] * SC_P, e4[1] * SC_P, 0, false); pw_ = __builtin_amdgcn_cvt_pk_fp8_f32(e4[2] * SC_P, e4[3] * SC_P, pw_, true); pf[q4] = pw_; }
        lsum = lsum * alpha + ps;
        if (G > 0 && __any(moved)) {
#pragma unroll
            for (int dt = 0; dt < 4; ++dt)
#pragma unroll
                for (int r = 0; r < 16; ++r) oacc[dt][r] *= alpha;
        }
#pragma unroll
        for (int dt = 0; dt < 4; ++dt) {
            const i32x8v vf = ld32(Vl + (32 * dt + qi) * 272 + 64 * G + 32 * hh);
            oacc[dt] = __builtin_amdgcn_mfma_scale_f32_32x32x64_f8f6f4(vf, pf, oacc[dt], 0, 0, 0, 0, 0, 0);
        }
    }
    lsum += __shfl_xor(lsum, 32);
    if (valid) {
        unsigned char* op = F.ws + WS_OPART + ((size_t)slot * M + tok) * D + h * HD;
        const float pinv = __builtin_amdgcn_rcpf(lsum) * (SC_PART / (SC_QKV * SC_P));
        unsigned wq[4][4];
#pragma unroll
        for (int dt = 0; dt < 4; ++dt)
#pragma unroll
            for (int g4 = 0; g4 < 4; ++g4) wq[dt][g4] = pk4_fp8(oacc[dt][4 * g4 + 0] * pinv, oacc[dt][4 * g4 + 1] * pinv, oacc[dt][4 * g4 + 2] * pinv, oacc[dt][4 * g4 + 3] * pinv);
        u32x4 st[4];
#pragma unroll
        for (int d2 = 0; d2 < 2; ++d2)
#pragma unroll
            for (int g4 = 0; g4 < 4; ++g4) { const unsigned give = hh ? wq[d2][g4] : wq[2 + d2][g4], keep = hh ? wq[2 + d2][g4] : wq[d2][g4];
                const unsigned got = (unsigned)__shfl_xor((int)give, 32);
                const unsigned w_even = hh ? got : keep, w_odd = hh ? keep : got;
                st[2 * d2 + (g4 >> 1)][2 * (g4 & 1)] = w_even; st[2 * d2 + (g4 >> 1)][2 * (g4 & 1) + 1] = w_odd; }
#pragma unroll
        for (int q = 0; q < 4; ++q) *(u32x4*)(op + 64 * hh + 16 * q) = st[q];
        if (hh == 0) { f32x2 lm; lm.x = lsum; lm.y = mrun; ((f32x2*)(F.ws + WS_LPART))[((size_t)slot * M + tok) * H + h] = lm; }
    }
}
__device__ __forceinline__ void attn_group(Frame& F, int bh, int n) {
    const int b = bh >> 4, h = bh & 15;
    const gcptr Kg = opaque_s(F.ws + WS_K + ((size_t)b * T + n * MBLK) * D + h * HD);
    const gcptr Vg = opaque_s(F.ws + WS_V + ((size_t)b * T + n * MBLK) * D + h * HD);
    const int tg = make_tid(F.wave);
    __syncthreads();
#pragma unroll
    for (int i = 0; i < 4; ++i) { const int ch = tg + i * 512;
        { const int r = ch >> 3, cc = ch & 7; *(LAS u32x4*)(F.lds + AL_K + r * 144 + cc * 16) = *(const GAS u32x4*)(Kg + (unsigned)(r * D + cc * 16)); }
        { const int rl = ch & 63, cc = (ch >> 6) & 7, G = ch >> 9, r = 64 * G + rl;
          const u32x4 vv = *(const GAS u32x4*)(Vg + (unsigned)(r * D + cc * 16)); const unsigned vw[4] = {vv.x, vv.y, vv.z, vv.w};
          LAS unsigned char* vd = F.lds + AL_V + (16 * cc) * 272 + 64 * G + 32 * ((rl >> 2) & 1) + 4 * (rl >> 3) + (rl & 3);
#pragma unroll
          for (int e = 0; e < 16; ++e) vd[e * 272] = (unsigned char)(vw[e >> 2] >> (8 * (e & 3))); }
    }
    __syncthreads();
    attn_chunk<true>(F, b, h, n, 0, 0, nullptr);
    if (n < 15) {
        const int cnt = (int)__hip_atomic_load(F.ctl + CW_ACNT + bh * 16 + n, __ATOMIC_RELAXED, __HIP_MEMORY_SCOPE_AGENT);
        const int* lst = (const int*)(F.ws + WS_ALIST) + ((size_t)bh * 16 + n) * ALIST_CAP;
        for (int c = 0; c * 256 < cnt; ++c) attn_chunk<false>(F, b, h, n, c, cnt, lst);
    }
}
struct AttnCombRegs { f32x2 lm[4]; u32x4 w[4][2]; };
__device__ __forceinline__ void attn_combine_load(Frame& F, int tok, AttnCombRegs& R) {
    const int j = (tok & (T - 1)) >> 8, nsl = j < 3 ? j : 3, hd = F.lane >> 2;
#pragma unroll
    for (int s4 = 0; s4 < 4; ++s4) { const bool valid = (s4 == 0) || (s4 - 1 < nsl); const int s_ = valid ? ((s4 == 0) ? 3 : s4 - 1) : 3;
        R.lm[s4] = ((const f32x2*)(F.ws + WS_LPART))[((size_t)s_ * M + tok) * H + hd];
        const u32x4* p = (const u32x4*)(F.ws + WS_OPART + ((size_t)s_ * M + tok) * D + F.lane * 32); R.w[s4][0] = p[0]; R.w[s4][1] = p[1]; }
}
__device__ __forceinline__ void attn_combine_finish(Frame& F, int tok, const AttnCombRegs& R) {
    const int j = (tok & (T - 1)) >> 8, nsl = j < 3 ? j : 3;
    f32x2 lm[4]; float mx = -1e30f;
#pragma unroll
    for (int s4 = 0; s4 < 4; ++s4) { const bool valid = (s4 == 0) || (s4 - 1 < nsl); lm[s4] = valid ? R.lm[s4] : (f32x2){0.f, -1e30f}; mx = fmaxf(mx, lm[s4].y); }
    float acc[32]; float l = 0.f;
#pragma unroll
    for (int i = 0; i < 32; ++i) acc[i] = 0.f;
#pragma unroll
    for (int s4 = 0; s4 < 4; ++s4) {
        const float ls = lm[s4].x * __builtin_amdgcn_exp2f(lm[s4].y - mx);
        const u32x4 w0 = R.w[s4][0], w1 = R.w[s4][1]; const unsigned wd[8] = {w0.x, w0.y, w0.z, w0.w, w1.x, w1.y, w1.z, w1.w};
#pragma unroll
        for (int i = 0; i < 8; ++i) { const f32x2 lo = __builtin_amdgcn_cvt_pk_f32_fp8((int)wd[i], false), hi = __builtin_amdgcn_cvt_pk_f32_fp8((int)wd[i], true);
            acc[4 * i] += lo.x * ls; acc[4 * i + 1] += lo.y * ls; acc[4 * i + 2] += hi.x * ls; acc[4 * i + 3] += hi.y * ls; }
        l += ls; }
    const float inv = __builtin_amdgcn_rcpf(l) * (1.0f / SC_PART);
    if (FP8_OUTB) { const float iv = inv * SC_OA; u32x4* o8 = (u32x4*)(F.ws + WS_OA + (size_t)tok * D + F.lane * 32);
#pragma unroll
        for (int i = 0; i < 2; ++i) { u32x4 w; w.x = pk4_fp8(acc[16 * i] * iv, acc[16 * i + 1] * iv, acc[16 * i + 2] * iv, acc[16 * i + 3] * iv); w.y = pk4_fp8(acc[16 * i + 4] * iv, acc[16 * i + 5] * iv, acc[16 * i + 6] * iv, acc[16 * i + 7] * iv);
            w.z = pk4_fp8(acc[16 * i + 8] * iv, acc[16 * i + 9] * iv, acc[16 * i + 10] * iv, acc[16 * i + 11] * iv); w.w = pk4_fp8(acc[16 * i + 12] * iv, acc[16 * i + 13] * iv, acc[16 * i + 14] * iv, acc[16 * i + 15] * iv); o8[i] = w; }
        return; }
    u32x4* o = (u32x4*)((bf16*)(F.ws + WS_OA) + (size_t)tok * D + F.lane * 32);
#pragma unroll
    for (int i = 0; i < 4; ++i) { u32x4 w; w.x = pk2(acc[8 * i] * inv, acc[8 * i + 1] * inv); w.y = pk2(acc[8 * i + 2] * inv, acc[8 * i + 3] * inv); w.z = pk2(acc[8 * i + 4] * inv, acc[8 * i + 5] * inv); w.w = pk2(acc[8 * i + 6] * inv, acc[8 * i + 7] * inv); o[i] = w; }
}
__device__ __forceinline__ void attn_combine_tokens(Frame& F, int t0, int stride) {
    static_assert(SC_PART > 0, "");
    AttnCombRegs A, B;
    int t = t0; if (t >= M) return;
    attn_combine_load(F, t, A);
    for (;;) {
        const int tn = t + stride; const bool more = tn < M;
        if (more) attn_combine_load(F, tn, B);
        attn_combine_finish(F, t, A);
        if (!more) break;
        A = B; t = tn;
    }
}
constexpr size_t WS_SLOC = WS_ORAW;
constexpr size_t WS_DLOG = WS_ORAW + 16 * MiB;
constexpr int HL_A = 0, HL_BM = 17408, HL_BMT = 34816, HL_VT = 53248, HL_SPT = 71680, HL_P = 106496, HL_EGR = 115712, HL_EEND = 116224, HL_QSUM = 116736, HL_SSQ = 118784,
              HL_STQ = HL_SPT, HL_STK = HL_SPT + 17408, HL_STG = 119808, HL_STV = 119808 + 17408;
#define HG_BAR() do { asm volatile("s_waitcnt lgkmcnt(0)" ::: "memory"); __builtin_amdgcn_s_barrier(); asm volatile("" ::: "memory"); } while (0)
template <bool FULL> __device__ __forceinline__ void hgrn_item(Frame& F, CArgs& a, int item) {
    const int bh = item >> 2, seg = item & 3, b = bh >> 4, h = bh & 15;
    if (!FULL && seg == 3) return;
    const int lane = F.lane, qi = lane & 31, hh = lane >> 5, w = F.wave;
    const int kk = F.tid & 127, tq = F.tid >> 7;
    const int vt = w & 3, ktb = 2 * (w >> 2);
    const bf16* Zq = (const bf16*)(F.ws + WS_ZQ); const bf16* Zk = (const bf16*)(F.ws + WS_ZK); const _Float16* Zg = (const _Float16*)(F.ws + WS_ZG); const bf16* Zv = (const bf16*)(F.ws + WS_ZV);
    LAS unsigned char* L = F.lds;
    LAS float* eGr = (LAS float*)(L + HL_EGR); LAS float* eEnd = (LAS float*)(L + HL_EEND); LAS float* qsum = (LAS float*)(L + HL_QSUM); LAS float* ssq = (LAS float*)(L + HL_SSQ);
    f32x16 S[2];
#pragma unroll
    for (int i = 0; i < 2; ++i)
#pragma unroll
        for (int r = 0; r < 16; ++r) S[i][r] = 0.f;
    if (FULL && seg > 0) {
        const float* sl = (const float*)(F.ws + WS_SLOC) + (size_t)bh * 3 * HD * HD; const float* dl = (const float*)(F.ws + WS_DLOG) + (size_t)bh * 3 * HD;
        LAS float* tile = (LAS float*)L; LAS float* fac = (LAS float*)(L + 65536);
        float dsum = 0.f;
        for (int s_ = seg - 1; s_ >= 0; --s_) {
            __syncthreads();
            const f32x4* src = (const f32x4*)(sl + (size_t)s_ * HD * HD);
#pragma unroll
            for (int i = 0; i < 8; ++i) ((LAS f32x4*)tile)[F.tid + i * 512] = src[F.tid + i * 512];
            if (F.tid < 128) { fac[F.tid] = __expf(dsum); dsum += dl[s_ * HD + F.tid]; }
            __syncthreads();
            const LAS float* tl = tile + (4 * hh) * HD + 32 * vt + qi; const LAS float* fl = fac + 4 * hh;
#pragma unroll
            for (int i = 0; i < 2; ++i)
#pragma unroll
                for (int r = 0; r < 16; ++r) { const int dkc = 32 * (ktb + i) + (r & 3) + 8 * (r >> 2); S[i][r] += fl[dkc] * tl[dkc * HD]; }
        }
    }
    float gtot = 0.f;
    u32x4 rq[2], rk[2], rg[2], rv[2];
#define HG_PREFETCH(cc) do { const size_t tk_ = (size_t)b * T + (size_t)(seg * 16 + (cc)) * 64; _Pragma("unroll") for (int i_ = 0; i_ < 2; ++i_) { const int row_ = 16 * (w >> 1) + (lane >> 3) + 8 * i_, ch_ = 8 * (w & 1) + (lane & 7); const size_t go_ = (tk_ + row_) * D + h * HD + ch_ * 8; \
        rk[i_] = *(const u32x4*)(Zk + go_); rg[i_] = *(const u32x4*)((const bf16*)Zg + go_); rv[i_] = *(const u32x4*)(Zv + go_); if (FULL) rq[i_] = *(const u32x4*)(Zq + go_); } } while (0)
    HG_PREFETCH(0);
    __syncthreads();
    for (int c = 0; c < 16; ++c) {
        const size_t tok0 = (size_t)b * T + (size_t)(seg * 16 + c) * 64;
#pragma unroll
        for (int i = 0; i < 2; ++i) { const int so = (16 * (w >> 1) + (lane >> 3) + 8 * i) * 272 + (8 * (w & 1) + (lane & 7)) * 16;
            *(LAS u32x4*)(L + HL_STK + so) = rk[i]; *(LAS u32x4*)(L + HL_STG + so) = rg[i]; *(LAS u32x4*)(L + HL_STV + so) = rv[i]; if (FULL) *(LAS u32x4*)(L + HL_STQ + so) = rq[i]; }
        LDS_WAIT();
        float gl[16];
        { float run = 0.f;
#pragma unroll
            for (int i = 0; i < 16; ++i) { run += (float)*(const LAS _Float16*)(L + HL_STG + (16 * tq + i) * 272 + kk * 2); gl[i] = run; }
            qsum[tq * 128 + kk] = run; }
        HG_BAR();
        {
            const float q0 = qsum[kk], q1 = qsum[128 + kk], q2 = qsum[256 + kk], q3 = qsum[384 + kk];
            const float pre = (tq > 0 ? q0 : 0.f) + (tq > 1 ? q1 : 0.f) + (tq > 2 ? q2 : 0.f), Gr = q0 + q1, Gend = (q0 + q1) + (q2 + q3);
            unsigned bt[8], vtw[8];
#pragma unroll
            for (int i = 0; i < 16; i += 2) {
                const int t0 = 16 * tq + i;
                const float G0 = pre + gl[i], G1 = pre + gl[i + 1];
                const float eb0 = __expf(Gr - G0), eb1 = __expf(Gr - G1);
                const float b0 = bf2f(*(const LAS bf16*)(L + HL_STK + t0 * 272 + kk * 2)) * eb0, b1 = bf2f(*(const LAS bf16*)(L + HL_STK + (t0 + 1) * 272 + kk * 2)) * eb1;
                bt[i >> 1] = pk2(b0, b1);
                vtw[i >> 1] = (unsigned)*(const LAS bf16*)(L + HL_STV + t0 * 272 + kk * 2) | ((unsigned)*(const LAS bf16*)(L + HL_STV + (t0 + 1) * 272 + kk * 2) << 16);
                if (FULL) { const float ea0 = __expf(G0 - Gr), ea1 = __expf(G1 - Gr);
                    const float qa = bf2f(*(const LAS bf16*)(L + HL_STQ + t0 * 272 + kk * 2)), qb = bf2f(*(const LAS bf16*)(L + HL_STQ + (t0 + 1) * 272 + kk * 2));
                    *(LAS bf16*)(L + HL_A + t0 * 272 + kk * 2) = (bf16)f2bf(qa * ea0); *(LAS bf16*)(L + HL_A + (t0 + 1) * 272 + kk * 2) = (bf16)f2bf(qb * ea1);
                    *(LAS bf16*)(L + HL_BM + t0 * 272 + kk * 2) = (bf16)(bt[i >> 1] & 0xffffu); *(LAS bf16*)(L + HL_BM + (t0 + 1) * 272 + kk * 2) = (bf16)(bt[i >> 1] >> 16); }
                __builtin_amdgcn_sched_barrier(0);
            }
            *(LAS u32x4*)(L + HL_BMT + kk * 144 + tq * 32) = (u32x4){bt[0], bt[1], bt[2], bt[3]}; *(LAS u32x4*)(L + HL_BMT + kk * 144 + tq * 32 + 16) = (u32x4){bt[4], bt[5], bt[6], bt[7]};
            *(LAS u32x4*)(L + HL_VT + kk * 144 + tq * 32) = (u32x4){vtw[0], vtw[1], vtw[2], vtw[3]}; *(LAS u32x4*)(L + HL_VT + kk * 144 + tq * 32 + 16) = (u32x4){vtw[4], vtw[5], vtw[6], vtw[7]};
            if (tq == 0) { eGr[kk] = __expf(Gr); eEnd[kk] = __expf(Gend - Gr); }
            gtot += Gend;
        }
        HG_BAR();
        if (c + 1 < 16) HG_PREFETCH(c + 1);
#pragma unroll
        for (int i = 0; i < 2; ++i)
#pragma unroll
            for (int g4 = 0; g4 < 4; ++g4) { const int dk0 = 32 * (ktb + i) + 8 * g4 + 4 * hh; const f32x4 e = *(const LAS f32x4*)(eGr + dk0);
#pragma unroll
                for (int j = 0; j < 4; ++j) S[i][4 * g4 + j] *= e[j];
                if (FULL) { u32x2 wv; wv.x = pg8::cvt_pk_bf16_n(S[i][4 * g4], S[i][4 * g4 + 1]); wv.y = pg8::cvt_pk_bf16_n(S[i][4 * g4 + 2], S[i][4 * g4 + 3]);
                    *(LAS u32x2*)(L + HL_SPT + (32 * vt + qi) * 272 + dk0 * 2) = wv; } }
        if (FULL && w < 3) {
            const int st = (w == 2) ? 1 : 0, tt = (w == 0) ? 0 : 1;
            f32x16 sc;
#pragma unroll
            for (int r = 0; r < 16; ++r) sc[r] = 0.f;
#pragma unroll
            for (int ks = 0; ks < 8; ++ks) { const bf16x8 af = *(const LAS bf16x8*)(L + HL_BM + (32 * st + qi) * 272 + (16 * ks + 8 * hh) * 2); const bf16x8 bfr = *(const LAS bf16x8*)(L + HL_A + (32 * tt + qi) * 272 + (16 * ks + 8 * hh) * 2);
                sc = __builtin_amdgcn_mfma_f32_32x32x16_bf16(af, bfr, sc, 0, 0, 0); }
#pragma unroll
            for (int g4 = 0; g4 < 4; ++g4) { const int s0 = 32 * st + 8 * g4 + 4 * hh, t = 32 * tt + qi; float p[4];
#pragma unroll
                for (int j = 0; j < 4; ++j) p[j] = sc[4 * g4 + j] * __builtin_amdgcn_fmed3f((float)(t - (s0 + j) + 1), 0.f, 1.f);
                u32x2 wv; wv.x = pg8::cvt_pk_bf16_n(p[0], p[1]); wv.y = pg8::cvt_pk_bf16_n(p[2], p[3]);
                *(LAS u32x2*)(L + HL_P + t * 144 + s0 * 2) = wv; }
        }
#pragma unroll
        for (int ks2 = 0; ks2 < 4; ++ks2) { const bf16x8 vf = *(const LAS bf16x8*)(L + HL_VT + (32 * vt + qi) * 144 + (16 * ks2 + 8 * hh) * 2);
#pragma unroll
            for (int i = 0; i < 2; ++i) { const bf16x8 bf_ = *(const LAS bf16x8*)(L + HL_BMT + (32 * (ktb + i) + qi) * 144 + (16 * ks2 + 8 * hh) * 2);
                S[i] = __builtin_amdgcn_mfma_f32_32x32x16_bf16(bf_, vf, S[i], 0, 0, 0); } }
#pragma unroll
        for (int i = 0; i < 2; ++i)
#pragma unroll
            for (int g4 = 0; g4 < 4; ++g4) { const int dk0 = 32 * (ktb + i) + 8 * g4 + 4 * hh; const f32x4 e = *(const LAS f32x4*)(eEnd + dk0);
#pragma unroll
                for (int j = 0; j < 4; ++j) S[i][4 * g4 + j] *= e[j]; }
        if (FULL) {
            HG_BAR();
            const int tt = w & 1, dt = w >> 1, t = 32 * tt + qi;
            u32x2 gtv[4];
            { const size_t ro_ = (tok0 + t) * D + h * HD;
#pragma unroll
              for (int g4 = 0; g4 < 4; ++g4) gtv[g4] = *(const u32x2*)((const bf16*)(F.ws + WS_ZGATE) + ro_ + 32 * dt + 8 * g4 + 4 * hh); }
            f32x16 o;
#pragma unroll
            for (int r = 0; r < 16; ++r) o[r] = 0.f;
#pragma unroll
            for (int ks = 0; ks < 8; ++ks) { const bf16x8 af = *(const LAS bf16x8*)(L + HL_SPT + (32 * dt + qi) * 272 + (16 * ks + 8 * hh) * 2); const bf16x8 bfr = *(const LAS bf16x8*)(L + HL_A + t * 272 + (16 * ks + 8 * hh) * 2);
                o = __builtin_amdgcn_mfma_f32_32x32x16_bf16(af, bfr, o, 0, 0, 0); }
#pragma unroll
            for (int ks2 = 0; ks2 < 4; ++ks2) if (ks2 < 2 * (tt + 1)) { const bf16x8 af = *(const LAS bf16x8*)(L + HL_VT + (32 * dt + qi) * 144 + (16 * ks2 + 8 * hh) * 2); const bf16x8 bfr = *(const LAS bf16x8*)(L + HL_P + t * 144 + (16 * ks2 + 8 * hh) * 2);
                o = __builtin_amdgcn_mfma_f32_32x32x16_bf16(af, bfr, o, 0, 0, 0); }
            float sq = 0.f;
#pragma unroll
            for (int r = 0; r < 16; ++r) sq += o[r] * o[r];
            sq += __shfl_xor(sq, 32);
            if (hh == 0) ssq[dt * 64 + t] = sq;
            HG_BAR();
            const float tot = (ssq[t] + ssq[64 + t]) + (ssq[128 + t] + ssq[192 + t]);
            const float rstd = __builtin_amdgcn_rsqf(tot * (1.f / HD) + RMS_EPS);
            const size_t ro = (tok0 + t) * D + h * HD;
#pragma unroll
            for (int g4 = 0; g4 < 4; ++g4) { const int dv0 = 32 * dt + 8 * g4 + 4 * hh;
                const u32x2 gt = gtv[g4]; const f32x4 gn = *(const f32x4*)(a.in[I_A_OGAIN] + dv0);
                u32x2 wv; wv.x = pg8::cvt_pk_bf16_n(o[4 * g4] * rstd * gn.x * bflo(gt.x), o[4 * g4 + 1] * rstd * gn.y * bfhi(gt.x)); wv.y = pg8::cvt_pk_bf16_n(o[4 * g4 + 2] * rstd * gn.z * bflo(gt.y), o[4 * g4 + 3] * rstd * gn.w * bfhi(gt.y));
                *(u32x2*)((bf16*)(F.ws + WS_OH) + ro + dv0) = wv; }
        }
    }
#undef HG_PREFETCH
    if (!FULL) {
        float* sl = (float*)(F.ws + WS_SLOC) + ((size_t)bh * 3 + seg) * HD * HD;
#pragma unroll
        for (int i = 0; i < 2; ++i)
#pragma unroll
            for (int r = 0; r < 16; ++r) { const int dk = 32 * (ktb + i) + (r & 3) + 8 * (r >> 2) + 4 * hh; sl[(size_t)dk * HD + 32 * vt + qi] = S[i][r]; }
        if (tq == 0) ((float*)(F.ws + WS_DLOG))[((size_t)bh * 3 + seg) * HD + kk] = gtot;
    }
    __syncthreads();
}

constexpr int N_PHASES = 19;
#ifndef CV_TAIL1
#define CV_TAIL1 6144
#endif
#ifndef REP_MASK
#define REP_MASK 0
#endif
#define NREP(k) ((((REP_MASK) >> (k)) & 1) ? 2 : 1)
__global__ void __launch_bounds__(NTHR, 2) fwd(Args args_kernarg) {
    extern __shared__ __attribute__((aligned(16))) unsigned char lds_raw[];
    Frame F;
    CArgs* pa = (CArgs*)__builtin_amdgcn_kernarg_segment_ptr();
#define args (*pa)
    F.lds = (LAS unsigned char*)lds_raw; F.ws = args.ws; F.ctl = (unsigned*)(args.ws + WS_CTL);
    F.wave = __builtin_amdgcn_readfirstlane((int)threadIdx.x >> 6); F.tid = make_tid(F.wave); F.lane = F.tid & 63;
    F.G = gridDim.x; { const int bx = blockIdx.x; F.vcu = (F.G % 8 == 0) ? (bx % 8) * (F.G / 8) + bx / 8 : bx; }
    F.gw = F.vcu * NWAVES + F.wave; F.NGW = F.G * NWAVES;
    for (int u = F.tid; u < (LDS_BYTES - LDSCTL_OFF) / 4; u += NTHR) ((LAS unsigned*)(F.lds + LDSCTL_OFF))[u] = 0u;
    __syncthreads();
    const int lo = args.ph_lo, hi = args.ph_hi;
    const bool multi = (hi - lo) > 1;
    XcdBarrier bar; bar.bar = F.ctl + CW_BAR; bar.x = 0; bar.st = nullptr;
    if (multi) bar = xcd_barrier_post(F.ctl + CW_BAR, (volatile LAS unsigned*)(F.lds + LDSCTL_OFF), F.tid);
#define REFRESH() do { pa = (CArgs*)__builtin_amdgcn_kernarg_segment_ptr(); asm volatile("" : "+s"(pa)); ws = args.ws; F.ws = ws; F.ctl = (unsigned*)(ws + WS_CTL); const int t_ = make_tid(F.wave); F.tid = t_; F.lane = t_ & 63; F.gw = F.vcu * NWAVES + F.wave; } while (0)
#define IN(k) (lo <= (k) && (k) < hi)
#define SEAM(k) do { if (IN(k) && IN((k) + 1)) xcd_barrier(bar, make_tid(F.wave)); } while (0)
    unsigned char* ws = args.ws;
    (void)args_kernarg;
    const int GT = F.NGW * 64;

    if (IN(0)) _Pragma("unroll") for (int rep_ = 0; rep_ < NREP(0); ++rep_) { REFRESH();
        const int gtid = F.gw * 64 + F.lane;
        LAS float* scr = (LAS float*)(F.lds + F.wave * TR_SCR_BYTES);
        constexpr int J0 = 16 * 256;
        tr_run([&](int it) { TrItem t; t.src = args.in[I_A_W_IN]; t.ksc = args.in[I_NORM_MIX]; t.dst = ws + WS_WIN; t.N = 4 * D; t.K = D; t.k0 = 128 * (it / 256); t.n0 = 32 * (it % 256); t.drow0 = t.n0; t.flags = 0; t.osc = 1.f; return t; },
               F.gw, J0, F.NGW, scr, F.lane);
        for (int c = gtid; c < D; c += GT) { const float* L = args.in[I_A_LB]; const float l0 = L[c], l1 = L[D + c], l2 = L[2 * D + c]; const float mx = fmaxf(l0, fmaxf(l1, l2));
            const float e0 = expf(l0 - mx), e1 = expf(l1 - mx), e2 = expf(l2 - mx); ((float*)(ws + WS_LB))[c] = e0 / (e0 + e1 + e2); }
        for (int i = gtid; i < 2 * 36 * D; i += GT) { const int l = i / (36 * D), r = (i / D) % 36, k = i % D;
            ((float*)(ws + WS_RT))[i] = r < 4 ? args.in[I_W_GROUP][((size_t)l * D + k) * NG + r] : args.in[I_W_EXPERT][((size_t)l * D + k) * NE + (r - 4)]; }
        { const int fi = gtid & 63; const float inv = exp2f(-(float)fi * (13.287712379549449f / 64.0f));
          for (int i = gtid; i < T * 64; i += GT) { const float ang = (float)(i >> 6) * inv; float sn_, cs_; sincosf(ang, &sn_, &cs_); ((f32x2*)(ws + WS_ROPE))[i] = (f32x2){cs_, sn_}; } }
        for (int m = F.gw; m < M; m += F.NGW) rms_row_to_bf16(args.in[I_X] + (size_t)m * D, (bf16*)(ws + WS_XN) + (size_t)m * D, F.lane);
    }
    SEAM(0);
    if (IN(1)) _Pragma("unroll") for (int rep_ = 0; rep_ < NREP(1); ++rep_) { REFRESH();
        constexpr int NCV = 112, J1 = 16 * 64, J2 = 16 * 128, J3 = 16 * 64, J4 = 16 * 64, J5 = MOE_CV_ITEMS;
        if ((int)blockIdx.x < NCV) {
            LAS float* scr = (LAS float*)(F.lds + F.wave * TR_SCR_BYTES);
            tr_run([&](int r) { TrItem t; t.osc = 1.f; t.ksc = nullptr; t.flags = 0; t.N = D; t.K = D;
                    if (r < J1) { t.src = args.in[I_A_W_OUT]; t.dst = ws + WS_WOA; t.k0 = 128 * (r / 64); t.n0 = 32 * (r % 64); t.drow0 = t.n0; return t; } r -= J1;
                    if (r < J2) { const int nb = r % 128; t.src = args.in[I_KV_W]; t.ksc = args.in[I_KV_NORM]; t.dst = ws + WS_WQKV; t.N = 2 * D; t.k0 = 128 * (r / 128); t.n0 = 32 * nb; t.drow0 = D + t.n0;
                                  t.flags = (FP8_QKV ? 2 : 0) | (nb < 64 ? 1 : 0); t.osc = FP8_QKV ? SC_W : 1.f; return t; } r -= J2;
                    if (r < J3) { t.src = args.in[I_B_W_Q]; t.ksc = args.in[I_NORM_MIX] + D; t.dst = ws + WS_WQKV; t.k0 = 128 * (r / 64); t.n0 = 32 * (r % 64); t.drow0 = t.n0; t.flags = (FP8_QKV ? 2 : 0) | 1; t.osc = FP8_QKV ? SC_W : 1.f; return t; } r -= J3;
                    if (r < J4) { t.src = args.in[I_B_W_OUT]; t.dst = ws + WS_WOB; t.k0 = 128 * (r / 64); t.n0 = 32 * (r % 64); t.drow0 = t.n0; t.flags = FP8_OUTB ? 2 : 0; t.osc = FP8_OUTB ? SC_W : 1.f; return t; } r -= J4;
                    return moe_cv_item(args, ws, 0, r); },
                   (int)blockIdx.x * NWAVES + F.wave, J1 + J2 + J3 + J4 + J5 - CV_TAIL1, NCV * NWAVES, scr, F.lane);
            __syncthreads();
        }
        pg8::DynOrder S; S.init(ws + WS_XN, ws + WS_WIN, M, 4 * D, D, F.wave, F.ctl + CW_DYN, (LAS int*)(F.lds + LDSCTL_OFF + 32));
        pg8::EpiHgrnIn E{ws + WS_R, (const float*)(ws + WS_LB)};
        pg8::gemm_phase<pg8::EpiHgrnIn, pg8::DynOrder, true>(F.lds, S, E);
        { REFRESH(); __syncthreads(); volatile LAS int* slot = (volatile LAS int*)(F.lds + LDSCTL_OFF + 8); LAS float* scr = (LAS float*)(F.lds + F.wave * TR_SCR_BYTES);
          for (int rnd = 0;; ++rnd) {
              if (F.wave == 0 && F.lane == 0) slot[rnd & 1] = (int)xb_add(F.ctl + CW_DYN + 128, (unsigned)NWAVES);
              __syncthreads();
              const int base = __builtin_amdgcn_readfirstlane(slot[rnd & 1]);
              if (base >= CV_TAIL1) break;
              const int r = MOE_CV_ITEMS - CV_TAIL1 + base + F.wave;
              if (base + F.wave < CV_TAIL1) tr_run([&](int i) { return moe_cv_item(args, ws, 0, i); }, r, r + 1, 1, scr, F.lane);
          } }
    }
    SEAM(1);
    if (IN(2)) { REFRESH(); for (int it = F.vcu; it < 256; it += F.G) hgrn_item<false>(F, args, it); }
    SEAM(2);
    if (IN(3)) _Pragma("unroll") for (int rep_ = 0; rep_ < NREP(3); ++rep_) { REFRESH(); for (int it = F.vcu; it < 256; it += F.G) hgrn_item<true>(F, args, it); }
    SEAM(3);
    if (IN(4)) _Pragma("unroll") for (int rep_ = 0; rep_ < NREP(4); ++rep_) { REFRESH();
        pg8::DenseOrder S; S.init(ws + WS_OH, ws + WS_WOA, M, D, D, F.G, (int)blockIdx.x, F.wave);
        pg8::EpiRes16<true> E{(bf16*)(ws + WS_XR), args.in[I_X], 1.0f};
        pg8::gemm_phase<pg8::EpiRes16<true>, pg8::DenseOrder, true>(F.lds, S, E);
    }
    SEAM(4);
#define MOE_LAYER(P, layer, F8, O8) \
    if (IN(P)) { REFRESH(); for (int t = F.gw; t < M; t += 2 * F.NGW) { if (t + F.NGW < M) route_pair<F8>(F, args, layer, t, t + F.NGW); else route_token<false, F8>(F, args, layer, t); } } \
    SEAM(P); \
    if (IN((P) + 1)) _Pragma("unroll") for (int rep_ = 0; rep_ < NREP((P) + 1); ++rep_) { REFRESH(); const int nrb = __builtin_amdgcn_readfirstlane(moe_tables(F, layer)); \
        pg8::MoeOrder<true> S; S.A = (const char*)(ws + WS_XN); S.B = (const char*)(ws + WS_WGU + (size_t)(layer) * WGU_LSTRIDE); S.estride = (size_t)1024 * D * (F8 ? 1 : 2); S.K = D; S.RB = F8 ? D : 2 * D; S.NT = 4; S.total = nrb * 4; S.G = F.G; S.c = F.vcu; S.wv = F.wave; \
        S.blk_e = (const LAS int*)(F.lds + LT_BLKE); S.blkstart = (const LAS int*)(F.lds + LT_BLKSTART); S.cnt = (const LAS int*)(F.lds + LT_CNT); S.list = (const int*)(ws + WS_LISTS); \
        pg8::EpiSwiGLU<F8> E{(bf16*)(ws + WS_ACT), F8 ? 1.0f / (SC_XN * SC_W) : 1.0f}; \
        pg8::gemm_phase<pg8::EpiSwiGLU<F8>, pg8::MoeOrder<true>, true, F8>(F.lds, S, E); } \
    SEAM((P) + 1); \
    if (IN((P) + 2)) _Pragma("unroll") for (int rep_ = 0; rep_ < NREP((P) + 2); ++rep_) { REFRESH(); const int nrb = __builtin_amdgcn_readfirstlane(moe_tables(F, layer)); \
        pg8::MoeOrder<false> S; S.A = (const char*)(ws + WS_ACT); S.B = (const char*)(ws + WS_WD + (size_t)(layer) * WD_LSTRIDE); S.estride = (size_t)D * FF * (F8 ? 1 : 2); S.K = FF; S.RB = F8 ? FF : 2 * FF; S.NT = 8; S.total = nrb * 8; S.G = F.G; S.c = F.vcu; S.wv = F.wave; \
        S.blk_e = (const LAS int*)(F.lds + LT_BLKE); S.blkstart = (const LAS int*)(F.lds + LT_BLKSTART); S.cnt = (const LAS int*)(F.lds + LT_CNT); S.list = (const int*)(ws + WS_LISTS); \
        if constexpr (O8) { pg8::EpiOut8 E{ws + WS_OUTB, D, (F8 ? 1.0f / (SC_ACT * SC_WD) : 1.0f) * SC_OUT}; pg8::gemm_phase<pg8::EpiOut8, pg8::MoeOrder<false>, true, F8>(F.lds, S, E); } \
        else { pg8::EpiBf16 E{(bf16*)(ws + WS_OUTB), D, 0, 0, F8 ? 1.0f / (SC_ACT * SC_WD) : 1.0f}; pg8::gemm_phase<pg8::EpiBf16, pg8::MoeOrder<false>, true, F8>(F.lds, S, E); } } \
    SEAM((P) + 2);
    MOE_LAYER(5, 0, FP8_MOE0, OUT8_L0)
    if (IN(8)) { REFRESH();
        (void)moe_tables(F, 0);
        combine_tokens<true>(F, args, F.gw, F.NGW);
    }
    SEAM(8);
    if (IN(9)) _Pragma("unroll") for (int rep_ = 0; rep_ < NREP(9); ++rep_) { REFRESH();
        constexpr int NCV2 = 112;
        if ((int)blockIdx.x < NCV2) {
            LAS float* scr = (LAS float*)(F.lds + F.wave * TR_SCR_BYTES);
            tr_run([&](int it) { return moe_cv_item(args, ws, 1, it); }, (int)blockIdx.x * NWAVES + F.wave, MOE_CV_ITEMS, NCV2 * NWAVES, scr, F.lane);
            __syncthreads();
        }
        pg8::DynOrder S; S.init(ws + WS_XN, ws + WS_WQKV, M, 3 * D, D, F.wave, F.ctl + CW_DYN + 64, (LAS int*)(F.lds + LDSCTL_OFF + 32), FP8_QKV);
        pg8::EpiQKV E{(bf16*)(ws + WS_Q), (bf16*)(ws + WS_K), (bf16*)(ws + WS_V), args.in[I_B_Q_NORM], args.in[I_K_NORM], (const f32x2*)(ws + WS_ROPE), (float*)(ws + WS_KMEAN), F.lds + 131072, FP8_QKV ? 1.0f / (SC_XN * SC_W) : 1.0f, F.wave};
        pg8::gemm_phase<pg8::EpiQKV, pg8::DynOrder, true, FP8_QKV>(F.lds, S, E);
    }
    SEAM(9);
    if (IN(11)) { REFRESH(); if (NREP(11) == 2) { for (int it = F.vcu; it < 64 * 8; it += F.G) moba_gate_item<true>(F, it); } for (int it = F.vcu; it < 64 * 8; it += F.G) moba_gate_item<false>(F, it); }
    SEAM(11);
    if (IN(12)) _Pragma("unroll") for (int rep_ = 0; rep_ < NREP(12); ++rep_) { REFRESH();
        for (int v = F.vcu; v < 256; v += F.G) { const int bh = v >> 2, q = v & 3;
            _Pragma("unroll 1") for (int gi = 0; gi < 4; ++gi) { const int n = (gi == 0) ? q : ((gi == 1) ? 7 - q : ((gi == 2) ? 8 + q : 15 - q)); attn_group(F, bh, n); } }
    }
    SEAM(12);
    if (IN(13)) _Pragma("unroll") for (int rep_ = 0; rep_ < NREP(13); ++rep_) { REFRESH(); attn_combine_tokens(F, F.gw, F.NGW); }
    SEAM(13);
    if (IN(14)) { REFRESH();
        pg8::DenseOrder S; S.init(ws + WS_OA, ws + WS_WOB, M, D, D, F.G, (int)blockIdx.x, F.wave, FP8_OUTB);
        pg8::EpiRes16<false> E{(bf16*)(ws + WS_XR), nullptr, FP8_OUTB ? 1.0f / (SC_OA * SC_W) : 1.0f};
        pg8::gemm_phase<pg8::EpiRes16<false>, pg8::DenseOrder, true, FP8_OUTB>(F.lds, S, E);
    }
    SEAM(14);
    MOE_LAYER(15, 1, FP8_MOE1, OUT8_L1)
    if (IN(18)) { REFRESH(); (void)moe_tables(F, 1); combine_tokens<false>(F, args, F.gw, F.NGW); }
#undef IN
#undef SEAM
#undef MOE_LAYER
#undef args
}

#ifndef MK_N_LAUNCHES
#define MK_N_LAUNCHES 1
#endif
#ifndef DBG_STOP
#define DBG_STOP N_PHASES
#endif
extern "C" void kernel_launch(void* const* d_in, const int* in_sizes, int n_in, void* d_out, int out_size, void* d_ws, size_t ws_size, hipStream_t stream) {
    static int grid = 0;
    if (grid == 0) {
        if (n_in != 20 || in_sizes[0] != M * D || out_size != M * D || ws_size < WS_END) { fprintf(stderr, "kernel_launch: unexpected shapes (n_in %d, in0 %d, out %d, ws %zu < %zu); nothing launched\n", n_in, n_in > 0 ? in_sizes[0] : -1, out_size, ws_size, (size_t)WS_END); grid = -1; return; }
        int dev = 0, cus = 0, per_cu = 0;
        if (hipGetDevice(&dev) != hipSuccess || hipDeviceGetAttribute(&cus, hipDeviceAttributeMultiprocessorCount, dev) != hipSuccess) { grid = -1; return; }
        if (hipFuncSetAttribute((const void*)fwd, hipFuncAttributeMaxDynamicSharedMemorySize, LDS_BYTES) != hipSuccess) { fprintf(stderr, "kernel_launch: hipFuncSetAttribute failed\n"); grid = -1; return; }
        if (hipOccupancyMaxActiveBlocksPerMultiprocessor(&per_cu, (const void*)fwd, NTHR, LDS_BYTES) != hipSuccess || per_cu < 1) { fprintf(stderr, "kernel_launch: occupancy query says %d blocks per CU\n", per_cu); }
        (void)hipGetLastError();
        grid = cus;
    }
    if (grid < 0) return;
    (void)hipMemsetAsync((char*)d_ws + WS_CTL, 0, CTL_ZERO_BYTES, stream);
    Args a{};
    for (int i = 0; i < 20; ++i) a.in[i] = (const float*)d_in[i];
    a.out = (float*)d_out; a.ws = (unsigned char*)d_ws;
    if (MK_N_LAUNCHES == 1) { a.ph_lo = 0; a.ph_hi = N_PHASES; hipLaunchKernelGGL(fwd, dim3(grid), dim3(NTHR), LDS_BYTES, stream, a); }
    else for (int p = 0; p < DBG_STOP; ++p) { a.ph_lo = p; a.ph_hi = p + 1; hipLaunchKernelGGL(fwd, dim3(grid), dim3(NTHR), LDS_BYTES, stream, a); }
}
```

```cpp
#include <hip/hip_runtime.h>
#include <cstdio>
#include <cstdint>

#define GAS __attribute__((address_space(1)))
#define LAS __attribute__((address_space(3)))
typedef unsigned short bf16;
typedef short bf16x8 __attribute__((ext_vector_type(8)));
typedef float f32x4 __attribute__((ext_vector_type(4)));
typedef float f32x2 __attribute__((ext_vector_type(2)));
typedef unsigned u32x4 __attribute__((ext_vector_type(4)));
typedef unsigned u32x2 __attribute__((ext_vector_type(2)));

constexpr int BATCH = 4, T = 4096, D = 2048, M = BATCH * T, H = 16, HD = 128;
constexpr int NBLK = 16, MBLK = 256;
constexpr int NG = 4, EPG = 8, NE = 32, FF = 512;
constexpr float RMS_EPS = 1e-6f;
constexpr int NWAVES = 8, NTHR = 512;
constexpr int LIST_CAP = 16384;
constexpr int MAXRB = 160;

constexpr size_t MiB = 1u << 20;
constexpr size_t WS_CTL = 0, CTL_ZERO_BYTES = 1 * MiB;
constexpr size_t WS_LISTS = 1 * MiB;
constexpr size_t WS_TOKREC = 3 * MiB;
constexpr size_t WS_LB = 4 * MiB;
constexpr size_t WS_RT = 4 * MiB + 65536;
constexpr size_t WS_ROPE = 5 * MiB;
constexpr size_t WS_KMEAN = 7 * MiB;
constexpr size_t WS_WIN = 8 * MiB, WS_WOA = 40 * MiB, WS_WQKV = 48 * MiB, WS_WOB = 72 * MiB;
constexpr size_t WS_WGU = 80 * MiB, WS_WD = 208 * MiB;
constexpr size_t WS_XN = 272 * MiB;
constexpr size_t WS_ACT = 336 * MiB;
constexpr size_t WS_R = 376 * MiB;
constexpr size_t WS_ZQ = WS_R, WS_ZK = WS_R + 64 * MiB, WS_ZG = WS_R + 128 * MiB, WS_ZV = WS_R + 192 * MiB, WS_ZGATE = WS_R + 256 * MiB;
constexpr size_t WS_ORAW = WS_R + 320 * MiB;
constexpr size_t WS_OH = WS_R + 448 * MiB;
constexpr size_t WS_OUTB = WS_R;
constexpr size_t WS_Q = WS_R, WS_K = WS_R + 64 * MiB, WS_V = WS_R + 128 * MiB, WS_VT = WS_R + 192 * MiB, WS_OA = WS_R + 256 * MiB;
constexpr size_t WS_XR = WS_R + 192 * MiB;
constexpr size_t WS_OPART = WS_R + 320 * MiB;
constexpr size_t WS_LPART = WS_R + 576 * MiB;
constexpr size_t WS_ALIST = WS_R + 584 * MiB;
constexpr int ALIST_CAP = 3840;
constexpr size_t WS_END = WS_R + 604 * MiB;
constexpr int CW_TMO = 0;
constexpr int CW_BAR = 4096;
constexpr int CW_CNT = 8192;
#define CW_CNT_AT(l, e) (CW_CNT + 2048 * (l) + 64 * (e))
constexpr int CW_ACNT = 16384;
constexpr int CW_RDY = 65536;
constexpr int CW_DYN = 20480;

constexpr int RING_BYTES = 159744;
constexpr int LDSCTL_OFF = RING_BYTES;
constexpr int LT_BLKE = LDSCTL_OFF + 64;
constexpr int LT_BLKSTART = LT_BLKE + MAXRB * 4;
constexpr int LT_CNT = LT_BLKSTART + 36 * 4;
constexpr int LT_END = LT_CNT + 32 * 4;
constexpr int LDS_BYTES = 163840;
static_assert(LT_END <= LDS_BYTES, "LDS map");

__device__ __forceinline__ unsigned f2bf(float f) { unsigned u = __builtin_bit_cast(unsigned, f); return (u + 0x7fffu + ((u >> 16) & 1u)) >> 16; }
__device__ __forceinline__ unsigned pk2(float lo, float hi) { return f2bf(lo) | (f2bf(hi) << 16); }
__device__ __forceinline__ float bf2f(unsigned b) { return __builtin_bit_cast(float, b << 16); }
__device__ __forceinline__ float bflo(unsigned w) { return __builtin_bit_cast(float, w << 16); }
__device__ __forceinline__ float bfhi(unsigned w) { return __builtin_bit_cast(float, w & 0xffff0000u); }
__device__ __forceinline__ float wave_sum(float v) {
#pragma unroll
    for (int o = 1; o < 64; o <<= 1) v += __shfl_xor(v, o);
    return v;
}
#ifndef FP8_QKV
#define FP8_QKV 1
#endif
#ifndef FP8_OUTB
#define FP8_OUTB 1
#endif
#ifndef FP8_MOE1
#define FP8_MOE1 1
#endif
#ifndef FP8_MOE0
#define FP8_MOE0 1
#endif
#ifndef OUT8_L0
#define OUT8_L0 1
#endif
#ifndef OUT8_L1
#define OUT8_L1 1
#endif
constexpr float SC_OH = 8.f;
constexpr float SC_XN = 16.f, SC_W = 1024.f, SC_ACT = 8.f, SC_WD = 512.f, SC_OA = 64.f, SC_PART = 64.f, SC_OUT = 32.f, SC_QKV = 32.f;
__device__ __forceinline__ unsigned pk4_fp8(float a, float b, float c, float d) {
    a = __builtin_amdgcn_fmed3f(a, -448.f, 448.f); b = __builtin_amdgcn_fmed3f(b, -448.f, 448.f); c = __builtin_amdgcn_fmed3f(c, -448.f, 448.f); d = __builtin_amdgcn_fmed3f(d, -448.f, 448.f);
    int p = __builtin_amdgcn_cvt_pk_fp8_f32(a, b, 0, false); p = __builtin_amdgcn_cvt_pk_fp8_f32(c, d, p, true); return (unsigned)p; }
__device__ __forceinline__ int lane_id() { int l; asm volatile("v_mbcnt_lo_u32_b32 %0, -1, 0\n\tv_mbcnt_hi_u32_b32 %0, -1, %0" : "=v"(l)); return l; }
__device__ __forceinline__ int make_tid(int wv) { return wv * 64 + lane_id(); }
__device__ __forceinline__ void fp8x4_to_f32(unsigned w, float (&o)[4]) { const f32x2 lo = __builtin_amdgcn_cvt_pk_f32_fp8((int)w, false), hi = __builtin_amdgcn_cvt_pk_f32_fp8((int)w, true); o[0] = lo.x; o[1] = lo.y; o[2] = hi.x; o[3] = hi.y; }
#define LDS_WAIT() asm volatile("s_waitcnt lgkmcnt(0)" ::: "memory")
#define VM_WAIT() asm volatile("s_waitcnt vmcnt(0)" ::: "memory")

namespace pg8 {
constexpr int BM = 256, BK = 64, HALF = 128, HTB = HALF * BK * 2, STAGE_BYTES = 8 * HTB, NXCD = 8, WGM = 8;
__host__ __device__ __forceinline__ int lds_byte(int r, int c) { const int st = (r >> 4) * 2 + (c >> 5), rr = r & 15, cc = c & 31, ob = rr * 64 + cc * 2; return st * 1024 + (ob ^ (((ob >> 9) & 1) << 5)); }
__host__ __device__ __forceinline__ void stage_rc(int b, int& R, int& C) { const int st = b / 1024, sb = b % 1024, swz = sb ^ (((sb >> 9) & 1) << 5); R = (st >> 1) * 16 + swz / 64; C = (st & 1) * 32 + (swz % 64) / 2; }
__host__ __device__ __forceinline__ int perm32(int rho) { const int n = rho >> 4, i = rho & 15; return 8 * (i >> 2) + 4 * n + (i & 3); }

struct Unit { int pm, pn; const char* a; const char* b; int e0, lbase, cnt; };

struct DenseOrder {
    static constexpr bool GATHER = false, DYNAMIC = false;
    const char* A; const char* B; int K, RB; int nM, nN, nwg, G, c, wv;
    __device__ void init(const void* A_, const void* B_, int M_, int N_, int K_, int G_, int c_, int wv_, bool fp8 = false) { wv = wv_; A = (const char*)A_; B = (const char*)B_; K = K_; RB = fp8 ? K_ : 2 * K_; nM = M_ / BM; nN = N_ / BM; nwg = nM * nN; G = G_; c = c_; }
    __device__ __forceinline__ bool next(int i, Unit& u) const {
        const int L = i * G + c; if (L >= nwg) return false;
        int wgid = (int)L; { const int q = nwg / NXCD, r = nwg % NXCD, xcd = wgid % NXCD, off = wgid / NXCD; wgid = (xcd < r ? xcd * (q + 1) : r * (q + 1) + (xcd - r) * q) + off; }
        const int nig = WGM * nN, gid = wgid / nig, fm = gid * WGM, gsz = (nM - fm) < WGM ? (nM - fm) : WGM;
        u.pm = fm + ((wgid % nig) % gsz); u.pn = (wgid % nig) / gsz;
        u.a = A + (size_t)u.pm * BM * RB; u.b = B + (size_t)u.pn * BM * RB; u.e0 = 0; u.lbase = 0; u.cnt = 0; return true;
    }
    __device__ __forceinline__ unsigned row_off(const Unit&, int) const { return 0u; }
};
struct DynOrder {
    static constexpr bool GATHER = false, DYNAMIC = true;
    const char* A; const char* B; int K, RB; int nM, nN, nwg, wv, x0; unsigned* counter; LAS int* slot;
    __device__ void init(const void* A_, const void* B_, int M_, int N_, int K_, int wv_, unsigned* counter_, LAS int* slot_, bool fp8 = false, int x0_ = 0) { wv = wv_; A = (const char*)A_; B = (const char*)B_; K = K_; RB = fp8 ? K_ : 2 * K_; nM = M_ / BM; nN = N_ / BM; nwg = nM * nN; counter = counter_; slot = slot_; x0 = x0_ & (NXCD - 1); }
    __device__ __forceinline__ void map(int L, Unit& u) const {
        int wgid = L; { const int q = nwg / NXCD, r = nwg % NXCD, xcd = wgid % NXCD, off = wgid / NXCD; wgid = (xcd < r ? xcd * (q + 1) : r * (q + 1) + (xcd - r) * q) + off; }
        const int nig = WGM * nN, gid = wgid / nig, fm = gid * WGM, gsz = (nM - fm) < WGM ? (nM - fm) : WGM;
        u.pm = fm + ((wgid % nig) % gsz); u.pn = (wgid % nig) / gsz;
        u.a = A + (size_t)u.pm * BM * RB; u.b = B + (size_t)u.pn * BM * RB; u.e0 = 0; u.lbase = 0; u.cnt = 0;
    }
    __device__ __forceinline__ int fetch(int k) const {
        int L = 0xffffff;
        for (; k < NXCD; ++k) { const int xx = (x0 + k) & (NXCD - 1); const int n = (int)__hip_atomic_fetch_add(counter + 64 * xx, 1u, __ATOMIC_RELAXED, __HIP_MEMORY_SCOPE_AGENT); const int Lc = n * NXCD + xx; if (Lc < nwg) { L = Lc; break; } }
        return L | (k << 24);
    }
    __device__ __forceinline__ void wait_ready(int) const {}
    __device__ __forceinline__ bool valid(int L) const { return L < nwg; }
    __device__ __forceinline__ bool next(int, Unit&) const { return false; }
    __device__ __forceinline__ unsigned row_off(const Unit&, int) const { return 0u; }
};
template <bool GATHER_> struct MoeOrder {
    static constexpr bool GATHER = GATHER_, DYNAMIC = false;
    const char* A; const char* B; size_t estride; int K, RB, NT, total, G, c, wv;
    const LAS int* blk_e; const LAS int* blkstart; const LAS int* cnt; const int* list;
    __device__ __forceinline__ bool next(int i, Unit& u) const {
        const int L = i * G + c; if (L >= total) return false;
        const int rb = (int)L / NT, pn = (int)L % NT, e = blk_e[rb];
        u.pm = rb; u.pn = pn; u.e0 = e; u.lbase = (rb - blkstart[e]) * BM; u.cnt = cnt[e];
        u.a = GATHER ? A : A + (size_t)rb * BM * RB; u.b = B + (size_t)e * estride + (size_t)pn * BM * RB; return true;
    }
    __device__ __forceinline__ unsigned row_off(const Unit& u, int r) const { const int loc = u.lbase + r; const int t = list[u.e0 * LIST_CAP + (loc < u.cnt ? loc : 0)]; return (unsigned)t * (unsigned)RB; }
};

struct DynMoeOrder {
    static constexpr bool GATHER = false, DYNAMIC = true;
    static constexpr int NT = 8;
    const char* A; const char* B; size_t estride; int K, RB, nwg, wv; unsigned* counter; LAS int* slot; unsigned* ready;
    const LAS int* blk_e;
    __device__ __forceinline__ bool valid(int Lp) const { return (Lp & 0xffff) < nwg; }
    __device__ __forceinline__ void map(int Lp, Unit& u) const {
        const int L = Lp & 0xffff, rb = L / NT, pn = L % NT, e = Lp >> 16;
        u.pm = rb; u.pn = pn; u.e0 = e; u.lbase = 0; u.cnt = 0;
        u.a = A + (size_t)rb * BM * RB; u.b = B + (size_t)e * estride + (size_t)pn * BM * RB;
    }
    __device__ __forceinline__ int fetch(int) const { const int L = (int)__hip_atomic_fetch_add(counter, 1u, __ATOMIC_RELAXED, __HIP_MEMORY_SCOPE_AGENT); const int Lc = L < nwg ? L : 0xffff; return Lc | ((L < nwg ? blk_e[L / NT] : 0) << 16); }
    __device__ __forceinline__ void wait_ready(int Lp) const {
        if (valid(Lp)) { const unsigned* r = ready + ((Lp & 0xffff) / NT) * 64; asm volatile("" : "+s"(r)); int sp = 0;
            while (__builtin_amdgcn_readfirstlane((int)__hip_atomic_load(r, __ATOMIC_RELAXED, __HIP_MEMORY_SCOPE_AGENT)) < 32) { __builtin_amdgcn_s_sleep(2); if (++sp > (1 << 22)) break; } }
    }
    __device__ __forceinline__ bool next(int, Unit&) const { return false; }
    __device__ __forceinline__ unsigned row_off(const Unit&, int) const { return 0u; }
};
template <class E> __device__ __forceinline__ auto epi_ready(const E& e, int) -> decltype(e.ready) { return e.ready; }
template <class E> __device__ __forceinline__ unsigned* epi_ready(const E&, long) { return nullptr; }

typedef __bf16 bf16n2 __attribute__((ext_vector_type(2)));
__device__ __forceinline__ unsigned cvt_pk_bf16_n(float lo, float hi) { const f32x2 v = {lo, hi}; return __builtin_bit_cast(unsigned, __builtin_convertvector(v, bf16n2)); }
__device__ __forceinline__ unsigned cvt_pk_bf16(float lo, float hi) { unsigned r; asm volatile("v_cvt_pk_bf16_f32 %0, %1, %2" : "=v"(r) : "v"(lo), "v"(hi)); return r; }

struct EpiBf16 {
    static constexpr bool PERM = true;
    bf16* O; int ldc; int split_cols; size_t split_stride; float osc;
    __device__ __forceinline__ void operator()(const f32x4 (&acc)[2][2][4][2], const Unit& u, int wr, int wc, int fr, int fq) const {
        const int row0 = u.pm * BM + wr * 64 + fr; int colt = u.pn * BM; bf16* base = O;
        if (split_cols) { const int t = colt / split_cols; base += (size_t)t * split_stride; colt -= t * split_cols; }
        const int col0 = colt + wc * 32 + 8 * fq;
#pragma unroll
        for (int ai = 0; ai < 2; ++ai)
#pragma unroll
            for (int m = 0; m < 4; ++m) { bf16* rowp = base + (size_t)(row0 + ai * HALF + m * 16) * ldc + col0;
#pragma unroll
                for (int bj = 0; bj < 2; ++bj) { const f32x4 v0 = acc[ai][bj][m][0] * osc, v1 = acc[ai][bj][m][1] * osc;
                    u32x4 w; w.x = cvt_pk_bf16(v0[0], v0[1]); w.y = cvt_pk_bf16(v0[2], v0[3]); w.z = cvt_pk_bf16(v1[0], v1[1]); w.w = cvt_pk_bf16(v1[2], v1[3]);
                    *(u32x4*)(rowp + bj * HALF) = w; } }
    }
};
struct EpiResF32 {
    static constexpr bool PERM = false;
    float* C; const float* R; int ldc; float osc;
    __device__ __forceinline__ void operator()(const f32x4 (&acc)[2][2][4][2], const Unit& u, int wr, int wc, int fr, int fq) const {
        const int row0 = u.pm * BM + wr * 64 + fr, col0 = u.pn * BM + wc * 32 + 4 * fq;
#pragma unroll
        for (int ai = 0; ai < 2; ++ai)
#pragma unroll
            for (int m = 0; m < 4; ++m) { const size_t ro = (size_t)(row0 + ai * HALF + m * 16) * ldc + col0;
#pragma unroll
                for (int bj = 0; bj < 2; ++bj)
#pragma unroll
                    for (int n = 0; n < 2; ++n) { const f32x4 r = *(const f32x4*)(R + ro + bj * HALF + n * 16); *(f32x4*)(C + ro + bj * HALF + n * 16) = acc[ai][bj][m][n] * osc + r; } }
    }
};
struct EpiOut8 {
    static constexpr bool PERM = true;
    unsigned char* O; int ldc; float osc;
    __device__ __forceinline__ void operator()(const f32x4 (&acc)[2][2][4][2], const Unit& u, int wr, int wc, int fr, int fq) const {
        const int row0 = u.pm * BM + wr * 64 + fr, col0 = u.pn * BM + wc * 32 + 8 * fq;
#pragma unroll
        for (int ai = 0; ai < 2; ++ai)
#pragma unroll
            for (int m = 0; m < 4; ++m) { unsigned char* rowp = O + (size_t)(row0 + ai * HALF + m * 16) * ldc + col0;
#pragma unroll
                for (int bj = 0; bj < 2; ++bj) { const f32x4 v0 = acc[ai][bj][m][0] * osc, v1 = acc[ai][bj][m][1] * osc;
                    u32x2 w; w.x = pk4_fp8(v0[0], v0[1], v0[2], v0[3]); w.y = pk4_fp8(v1[0], v1[1], v1[2], v1[3]);
                    *(u32x2*)(rowp + bj * HALF) = w; } }
    }
};
template <bool SRC32> struct EpiRes16 {
    static constexpr bool PERM = true;
    bf16* XR; const float* R32; float osc;
    __device__ __forceinline__ void operator()(const f32x4 (&acc)[2][2][4][2], const Unit& u, int wr, int wc, int fr, int fq) const {
        const int row0 = u.pm * BM + wr * 64 + fr, col0 = u.pn * BM + wc * 32 + 8 * fq;
#pragma unroll
        for (int ai = 0; ai < 2; ++ai)
#pragma unroll
            for (int m = 0; m < 4; ++m) { const size_t ro = (size_t)(row0 + ai * HALF + m * 16) * D + col0;
#pragma unroll
                for (int bj = 0; bj < 2; ++bj) { float r[8];
                    if (SRC32) { const f32x4 a = __builtin_nontemporal_load((const f32x4*)(R32 + ro + bj * HALF)), b = __builtin_nontemporal_load((const f32x4*)(R32 + ro + bj * HALF + 4));
#pragma unroll
                        for (int j = 0; j < 4; ++j) { r[j] = a[j]; r[4 + j] = b[j]; } }
                    else { const u32x4 w = *(const u32x4*)(XR + ro + bj * HALF); r[0] = bflo(w.x); r[1] = bfhi(w.x); r[2] = bflo(w.y); r[3] = bfhi(w.y); r[4] = bflo(w.z); r[5] = bfhi(w.z); r[6] = bflo(w.w); r[7] = bfhi(w.w); }
                    const f32x4 v0 = acc[ai][bj][m][0] * osc, v1 = acc[ai][bj][m][1] * osc;
                    u32x4 o; o.x = cvt_pk_bf16(v0[0] + r[0], v0[1] + r[1]); o.y = cvt_pk_bf16(v0[2] + r[2], v0[3] + r[3]); o.z = cvt_pk_bf16(v1[0] + r[4], v1[1] + r[5]); o.w = cvt_pk_bf16(v1[2] + r[6], v1[3] + r[7]);
                    *(u32x4*)(XR + ro + bj * HALF) = o; } }
    }
};
__device__ __forceinline__ float sigmoidf_(float z) { return __builtin_amdgcn_rcpf(1.0f + __expf(-z)); }
template <bool OUT8> struct EpiSwiGLU {
    static constexpr bool PERM = true;
    bf16* O; float osc; unsigned* ready;
    __device__ __forceinline__ void operator()(const f32x4 (&acc)[2][2][4][2], const Unit& u, int wr, int wc, int fr, int fq) const {
        const int row0 = u.pm * BM + wr * 64 + fr, col0 = u.pn * HALF + wc * 32 + 8 * fq;
#pragma unroll
        for (int ai = 0; ai < 2; ++ai)
#pragma unroll
            for (int m = 0; m < 4; ++m) { const size_t eo = (size_t)(row0 + ai * HALF + m * 16) * FF + col0;
                float o[8];
#pragma unroll
                for (int n = 0; n < 2; ++n)
#pragma unroll
                    for (int j = 0; j < 4; ++j) { const float g = acc[ai][0][m][n][j] * osc, up = acc[ai][1][m][n][j] * osc; o[4 * n + j] = g * sigmoidf_(g) * up; }
                if (OUT8) { u32x2 w; w.x = pk4_fp8(o[0] * SC_ACT, o[1] * SC_ACT, o[2] * SC_ACT, o[3] * SC_ACT); w.y = pk4_fp8(o[4] * SC_ACT, o[5] * SC_ACT, o[6] * SC_ACT, o[7] * SC_ACT);
                    __hip_atomic_store((unsigned long long*)((unsigned char*)O + eo), __builtin_bit_cast(unsigned long long, w), __ATOMIC_RELAXED, __HIP_MEMORY_SCOPE_AGENT); }
                else { u32x4 w; w.x = cvt_pk_bf16(o[0], o[1]); w.y = cvt_pk_bf16(o[2], o[3]); w.z = cvt_pk_bf16(o[4], o[5]); w.w = cvt_pk_bf16(o[6], o[7]); *(u32x4*)(O + eo) = w; } }
    }
};
typedef _Float16 h8 __attribute__((ext_vector_type(8)));
struct EpiHgrnIn {
    static constexpr bool PERM = true;
    unsigned char* zb; const float* lb;
    __device__ __forceinline__ void operator()(const f32x4 (&acc)[2][2][4][2], const Unit& u, int wr, int wc, int fr, int fq) const {
        const int quarter = u.pn >> 3, row0 = u.pm * BM + wr * 64 + fr, col0 = (u.pn & 7) * BM + wc * 32 + 8 * fq;
        if (quarter == 1) {
            float lbv[2][8];
#pragma unroll
            for (int bj = 0; bj < 2; ++bj) { const f32x4 a = *(const f32x4*)(lb + col0 + bj * HALF), b = *(const f32x4*)(lb + col0 + bj * HALF + 4);
#pragma unroll
                for (int j = 0; j < 4; ++j) { lbv[bj][j] = a[j]; lbv[bj][4 + j] = b[j]; } }
#pragma unroll
            for (int ai = 0; ai < 2; ++ai)
#pragma unroll
                for (int m = 0; m < 4; ++m) { const size_t ro = (size_t)(row0 + ai * HALF + m * 16) * D + col0;
#pragma unroll
                    for (int bj = 0; bj < 2; ++bj) { float kk[8]; h8 hv;
#pragma unroll
                        for (int n = 0; n < 2; ++n)
#pragma unroll
                            for (int j = 0; j < 4; ++j) { const float z = acc[ai][bj][m][n][j], l = lbv[bj][4 * n + j];
                                const float k1 = (1.0f - l) * __builtin_amdgcn_rcpf(1.0f + __expf(z));
                                kk[4 * n + j] = k1; hv[4 * n + j] = (_Float16)__logf(1.0f - k1); }
                        u32x4 w; w.x = cvt_pk_bf16(kk[0], kk[1]); w.y = cvt_pk_bf16(kk[2], kk[3]); w.z = cvt_pk_bf16(kk[4], kk[5]); w.w = cvt_pk_bf16(kk[6], kk[7]);
                        *(u32x4*)((bf16*)(zb + (64u << 20)) + ro + bj * HALF) = w;
                        *(h8*)((_Float16*)(zb + (128u << 20)) + ro + bj * HALF) = hv; } }
        } else {
            const size_t zo = quarter == 0 ? 0u : (quarter == 2 ? (size_t)(192u << 20) : (size_t)(256u << 20)); bf16* dst = (bf16*)(zb + zo);
#pragma unroll
            for (int ai = 0; ai < 2; ++ai)
#pragma unroll
                for (int m = 0; m < 4; ++m) { const size_t ro = (size_t)(row0 + ai * HALF + m * 16) * D + col0;
#pragma unroll
                    for (int bj = 0; bj < 2; ++bj) { float o[8];
#pragma unroll
                        for (int n = 0; n < 2; ++n)
#pragma unroll
                            for (int j = 0; j < 4; ++j) { const float z = acc[ai][bj][m][n][j]; o[4 * n + j] = (quarter == 3) ? z * sigmoidf_(z) : z; }
                        u32x4 w; w.x = cvt_pk_bf16(o[0], o[1]); w.y = cvt_pk_bf16(o[2], o[3]); w.z = cvt_pk_bf16(o[4], o[5]); w.w = cvt_pk_bf16(o[6], o[7]);
                        *(u32x4*)(dst + ro + bj * HALF) = w; } }
        }
    }
};

struct EpiQKV {
    static constexpr bool PERM = true;
    bf16* Q; bf16* Kd; bf16* V; const float* qg; const float* kg; const f32x2* rope; float* kmean; LAS unsigned char* xl; float osc; int wv;
    __device__ __forceinline__ void operator()(const f32x4 (&acc)[2][2][4][2], const Unit& u, int wr, int wc, int fr, int fq) const {
        const int sec = u.pn >> 3, row0 = u.pm * BM + wr * 64 + fr;
        if (sec == 2) {
            const int col0 = (u.pn & 7) * BM + wc * 32 + 8 * fq; const float vs = osc * SC_QKV;
#pragma unroll
            for (int ai = 0; ai < 2; ++ai)
#pragma unroll
                for (int m = 0; m < 4; ++m) { unsigned char* rowp = (unsigned char*)V + (size_t)(row0 + ai * HALF + m * 16) * D + col0;
#pragma unroll
                    for (int bj = 0; bj < 2; ++bj) { const f32x4 v0 = acc[ai][bj][m][0] * vs, v1 = acc[ai][bj][m][1] * vs;
                        u32x2 w; w.x = pk4_fp8(v0[0], v0[1], v0[2], v0[3]); w.y = pk4_fp8(v1[0], v1[1], v1[2], v1[3]);
                        *(u32x2*)(rowp + bj * HALF) = w; } }
            return;
        }
        LAS float* X = (LAS float*)xl;
        LAS float* Y = (LAS float*)(xl + 8192);
#pragma unroll
        for (int ai = 0; ai < 2; ++ai)
#pragma unroll
            for (int m = 0; m < 4; ++m)
#pragma unroll
                for (int bj = 0; bj < 2; ++bj) { const f32x4 a = acc[ai][bj][m][0], b = acc[ai][bj][m][1];
                    float s = ((a[0] * a[0] + a[1] * a[1]) + (a[2] * a[2] + a[3] * a[3]) + (b[0] * b[0] + b[1] * b[1]) + (b[2] * b[2] + b[3] * b[3])) * (osc * osc);
                    s += __shfl_xor(s, 16); s += __shfl_xor(s, 32);
                    if (fq == 0) X[((ai * HALF + wr * 64 + m * 16 + fr) * 2 + bj) * 4 + wc] = s; }
        asm volatile("s_waitcnt lgkmcnt(0)" ::: "memory"); __builtin_amdgcn_s_barrier(); asm volatile("" ::: "memory");
        const float* gain = sec ? kg : qg; bf16* dst = sec ? Kd : Q;
#pragma unroll
        for (int ai = 0; ai < 2; ++ai)
#pragma unroll
            for (int m = 0; m < 4; ++m) { const int rl = ai * HALF + wr * 64 + m * 16 + fr, pos = (u.pm & 15) * BM + rl;
                const f32x4 g0 = *(const f32x4*)(gain + 16 * wc + 4 * fq), g1 = *(const f32x4*)(gain + 64 + 16 * wc + 4 * fq);
                const f32x4 r0 = *(const f32x4*)(rope + pos * 64 + 16 * wc + 4 * fq), r1 = *(const f32x4*)(rope + pos * 64 + 16 * wc + 4 * fq + 2);
                const float cc[4] = {r0[0], r0[2], r1[0], r1[2]}, sn[4] = {r0[1], r0[3], r1[1], r1[3]};
#pragma unroll
                for (int bj = 0; bj < 2; ++bj) { const f32x4 p = *(const LAS f32x4*)(X + (rl * 2 + bj) * 4);
                    const float rstd = __builtin_amdgcn_rsqf(((p[0] + p[1]) + (p[2] + p[3])) * (1.f / 128) + RMS_EPS);
                    float o[8];
#pragma unroll
                    for (int j = 0; j < 4; ++j) { const float y1 = acc[ai][bj][m][0][j] * (rstd * osc) * g0[j], y2 = acc[ai][bj][m][1][j] * (rstd * osc) * g1[j]; o[j] = y1 * cc[j] - y2 * sn[j]; o[4 + j] = y2 * cc[j] + y1 * sn[j]; }
                    unsigned char* p0 = (unsigned char*)dst + (size_t)(u.pm * BM + rl) * D + ((u.pn & 7) * 2 + bj) * 128 + 16 * wc + 4 * fq;
                    *(unsigned*)p0 = pk4_fp8(o[0] * SC_QKV, o[1] * SC_QKV, o[2] * SC_QKV, o[3] * SC_QKV); *(unsigned*)(p0 + 64) = pk4_fp8(o[4] * SC_QKV, o[5] * SC_QKV, o[6] * SC_QKV, o[7] * SC_QKV);
                    if (sec == 1) {
#pragma unroll
                        for (int j = 0; j < 8; ++j) { float sv = o[j]; sv += __shfl_xor(sv, 1); sv += __shfl_xor(sv, 2); sv += __shfl_xor(sv, 4); sv += __shfl_xor(sv, 8); o[j] = sv; }
                        if (fr == 0) { LAS float* yp = Y + ((((wr * 2 + ai) * 4 + m) * 2 + bj) * 128) + 16 * wc + 4 * fq; *(LAS f32x4*)yp = (f32x4){o[0], o[1], o[2], o[3]}; *(LAS f32x4*)(yp + 64) = (f32x4){o[4], o[5], o[6], o[7]}; }
                    } }
                asm volatile("" ::: "memory"); }
        if (sec == 1) {
            asm volatile("s_waitcnt lgkmcnt(0)" ::: "memory"); __builtin_amdgcn_s_barrier(); asm volatile("" ::: "memory");
            const int tid = make_tid(wv);
            if (tid < 256) { const int bj = tid >> 7, d = tid & 127; const int b = u.pm >> 4, nb = u.pm & 15, head = (u.pn & 7) * 2 + bj;
                float sm = 0.f;
#pragma unroll
                for (int q = 0; q < 16; ++q) sm += Y[(q * 2 + bj) * 128 + d];
                float* kmb = kmean; asm volatile("" : "+s"(kmb));
                ((GAS float*)kmb)[((b * H + head) * NBLK + nb) * HD + d] = sm * (1.0f / 256); }
        }
    }
};

__device__ __forceinline__ void glds_saddr(const char* sbase, unsigned voff, unsigned lds_dst) {
    unsigned keep;
    asm volatile("s_mov_b32 %0, m0\n\ts_mov_b32 m0, %3\n\ts_nop 4\n\tglobal_load_lds_dwordx4 %1, %2\n\ts_mov_b32 m0, %0" : "=&s"(keep) : "v"(voff), "s"(sbase), "s"(lds_dst) : "memory");
}
typedef int i32x4 __attribute__((ext_vector_type(4)));
typedef int i32x8 __attribute__((ext_vector_type(8)));
__device__ __forceinline__ i32x8 cat8(bf16x8 lo, bf16x8 hi) { const i32x4 a = __builtin_bit_cast(i32x4, lo), b = __builtin_bit_cast(i32x4, hi); return __builtin_shufflevector(a, b, 0, 1, 2, 3, 4, 5, 6, 7); }
template <class Epi, class Sched, bool ALIGN_EPI, bool FP8 = false>
__device__ __forceinline__ void gemm_phase(LAS unsigned char* lds, const Sched& S, const Epi& E) {
    const int tid = make_tid(S.wv), wid = __builtin_amdgcn_readfirstlane(tid >> 6), lane = tid & 63, wr = wid >> 2, wc = wid & 3, fr = lane & 15, fq = lane >> 4;
    const int K = S.K, RB = S.RB, nt = RB / (BK * 2);
    unsigned voffA[2], voffB[2];
#pragma unroll
    for (int i = 0; i < 2; ++i) { int R, C; stage_rc(tid * 16 + i * 8192, R, C); const int Rb = Epi::PERM ? ((R & ~31) + perm32(R & 31)) : R;
        voffA[i] = (unsigned)(R * RB + C * 2); voffB[i] = (unsigned)(Rb * RB + C * 2); }
    const size_t kstep = (size_t)(BK * 2);
    const size_t hstep = (size_t)HALF * RB;
    const unsigned ldsw = (unsigned)wid * 1024u, ldsb = (unsigned)(size_t)lds;
    const int aoff = lds_byte(wr * 64 + fr, fq * 8), boff = lds_byte(wc * 32 + fr, fq * 8);
#define PG8_SA(b, h) (((b) * 2 + (h)) * HTB)
#define PG8_SB(b, h) ((4 + (b) * 2 + (h)) * HTB)
#define PG8_STAGE(bufoff, gbase, voff) do { _Pragma("unroll") for (int _i = 0; _i < 2; ++_i) glds_saddr((const char*)(gbase), (voff)[_i], ldsb + (unsigned)(bufoff) + ldsw + _i * 8192u); } while (0)
#define PG8_GOFS(pp, h, i) (gofs + ((((pp) * 2 + (h)) * 2 + (i)) * 512))
#define PG8_STAGE_A(bufoff, sel, h, ko) do { if constexpr (Sched::GATHER) { const int _pp = (sel) ? (pc ^ 1) : pc; unsigned _v[2]; _v[0] = PG8_GOFS(_pp, h, 0)[tid]; _v[1] = PG8_GOFS(_pp, h, 1)[tid]; PG8_STAGE(bufoff, S.A + (ko), _v); } \
        else { PG8_STAGE(bufoff, ((sel) ? nA : cA) + (h) * hstep + (ko), voffA); } } while (0)
#define PG8_LDA(dst, b, h) do { _Pragma("unroll") for (int m = 0; m < 4; ++m) { if constexpr (FP8) dst##8[m] = cat8(*(const LAS bf16x8*)(lds + PG8_SA(b, h) + aoff + m * 2048), *(const LAS bf16x8*)(lds + PG8_SA(b, h) + aoff + m * 2048 + 1024)); \
        else { _Pragma("unroll") for (int k = 0; k < 2; ++k) dst[m][k] = *(const LAS bf16x8*)(lds + PG8_SA(b, h) + aoff + m * 2048 + k * 1024); } } } while (0)
#define PG8_LDB(dst, b, h) do { _Pragma("unroll") for (int n = 0; n < 2; ++n) { if constexpr (FP8) dst##8[n] = cat8(*(const LAS bf16x8*)(lds + PG8_SB(b, h) + boff + n * 2048), *(const LAS bf16x8*)(lds + PG8_SB(b, h) + boff + n * 2048 + 1024)); \
        else { _Pragma("unroll") for (int k = 0; k < 2; ++k) dst[n][k] = *(const LAS bf16x8*)(lds + PG8_SB(b, h) + boff + n * 2048 + k * 1024); } } } while (0)
#define PG8_MMA(ai, bj, At, Bt) do { __builtin_amdgcn_s_setprio(1); _Pragma("unroll") for (int m = 0; m < 4; ++m) _Pragma("unroll") for (int n = 0; n < 2; ++n) { if constexpr (FP8) { \
        acc[ai][bj][m][n] = __builtin_amdgcn_mfma_scale_f32_16x16x128_f8f6f4(Bt##8[n], At##8[m], acc[ai][bj][m][n], 0, 0, 0, 0, 0, 0); } else { _Pragma("unroll") for (int k = 0; k < 2; ++k) \
        acc[ai][bj][m][n] = __builtin_amdgcn_mfma_f32_16x16x32_bf16(Bt[n][k], At[m][k], acc[ai][bj][m][n], 0, 0, 0); } } __builtin_amdgcn_s_setprio(0); } while (0)
#define PG8_WAIT_V(n) asm volatile("s_waitcnt vmcnt(" #n ")" ::: "memory")
#define PG8_WAIT_L(n) asm volatile("s_waitcnt lgkmcnt(" #n ")" ::: "memory")
#define PG8_BAR __builtin_amdgcn_s_barrier()
#define PG8_SCHED __builtin_amdgcn_sched_barrier(0)
    Unit cur, nxt; int ui = 0; int dyn_pend = 0, dyn_k = 0;
    if constexpr (Sched::DYNAMIC) {
        if (wid == 0) { int v2 = 0, v0 = 0, v1 = 0; if (lane == 0) { v0 = S.fetch(0); v1 = S.fetch((int)((unsigned)v0 >> 24)); v2 = S.fetch((int)((unsigned)v1 >> 24)); S.slot[0] = v0 & 0xffffff; S.slot[1] = v1 & 0xffffff; }
            const int v2u = __builtin_amdgcn_readfirstlane(v2); dyn_pend = v2u & 0xffffff; dyn_k = (int)((unsigned)v2u >> 24);
            S.wait_ready(__builtin_amdgcn_readfirstlane(v0) & 0xffffff); S.wait_ready(__builtin_amdgcn_readfirstlane(v1) & 0xffffff); S.wait_ready(dyn_pend); }
        PG8_WAIT_L(0); PG8_BAR;
        const int L0 = __builtin_amdgcn_readfirstlane(S.slot[0]); if (!S.valid(L0)) return;
        S.map(L0, cur);
    } else { if (!S.next(0, cur)) return; }
    LAS unsigned* gofs = (LAS unsigned*)(lds + 131072); int pc = 0;
#define PG8_WRITE_GOFS(pp, U) do { int _t = tid; asm volatile("" : "+v"(_t)); _Pragma("unroll") for (int _i = 0; _i < 2; ++_i) { int _R, _C; stage_rc(_t * 16 + _i * 8192, _R, _C); \
        _Pragma("unroll") for (int _h = 0; _h < 2; ++_h) PG8_GOFS(pp, _h, _i)[_t] = S.row_off(U, _h * HALF + _R) + (unsigned)_C * 2u; } } while (0)
    if constexpr (Sched::GATHER) PG8_WRITE_GOFS(0, cur);
    f32x4 acc[2][2][4][2];
#pragma unroll
    for (int a = 0; a < 2; ++a)
#pragma unroll
        for (int b = 0; b < 2; ++b)
#pragma unroll
            for (int m = 0; m < 4; ++m)
#pragma unroll
                for (int n = 0; n < 2; ++n) acc[a][b][m][n] = (f32x4){0.f, 0.f, 0.f, 0.f};
    bf16x8 At[4][2], B0[2][2], B1[2][2]; i32x8 At8[4], B08[2], B18[2];
    const char* cA = cur.a; const char* cB = cur.b; const char* nA = cA; const char* nB = cB;
    PG8_STAGE(PG8_SB(0, 0), cB, voffB); PG8_STAGE(PG8_SB(0, 1), cB + hstep, voffB); PG8_STAGE_A(PG8_SA(0, 0), false, 0, 0); PG8_STAGE_A(PG8_SA(0, 1), false, 1, 0);
    if (wr == 1) PG8_BAR;
    PG8_WAIT_V(2); PG8_BAR;
    PG8_STAGE(PG8_SB(1, 0), cB + kstep, voffB); PG8_STAGE_A(PG8_SA(1, 0), false, 0, kstep); PG8_STAGE(PG8_SB(1, 1), cB + hstep + kstep, voffB);
    PG8_WAIT_V(6); PG8_BAR;
    for (;;) {
        bool has_next = true;
        if constexpr (Sched::DYNAMIC) {
            if (ui >= 1 && wid == 0) { int v = 0; if (lane == 0) { S.slot[(ui + 1) % 3] = dyn_pend; v = S.fetch(dyn_k); } const int vu = __builtin_amdgcn_readfirstlane(v); dyn_pend = vu & 0xffffff; dyn_k = (int)((unsigned)vu >> 24); S.wait_ready(dyn_pend); }
        } else { has_next = S.next(ui + 1, nxt); nA = has_next ? nxt.a : cA; nB = has_next ? nxt.b : cB; }
        if constexpr (Sched::GATHER) { if (has_next) PG8_WRITE_GOFS(pc ^ 1, nxt); else PG8_WRITE_GOFS(pc ^ 1, cur); }
        for (int t = 0; t < nt; t += 2) {
            const bool last = (t == nt - 2);
            if constexpr (Sched::DYNAMIC) { if (last) { const int Ln = __builtin_amdgcn_readfirstlane(S.slot[(ui + 1) % 3]); has_next = S.valid(Ln); if (has_next) S.map(Ln, nxt); nA = has_next ? nxt.a : cA; nB = has_next ? nxt.b : cB; } }
            const size_t k1 = (size_t)(t + 1) * kstep;
            const size_t k2 = last ? 0 : (size_t)(t + 2) * kstep, k3 = k2 + kstep;
            const char* b2 = (last ? nB : cB) + k2; const char* b3 = b2 + kstep;
            PG8_LDB(B0, 0, 0); PG8_LDB(B1, 0, 1); PG8_SCHED; PG8_LDA(At, 0, 0); PG8_STAGE_A(PG8_SA(1, 1), false, 1, k1);
            PG8_WAIT_V(8); PG8_WAIT_L(0); PG8_BAR; PG8_MMA(0, 0, At, B0); PG8_MMA(0, 1, At, B1); PG8_BAR; PG8_SCHED;
            PG8_LDA(At, 0, 1); PG8_STAGE(PG8_SB(0, 0), b2, voffB); PG8_STAGE(PG8_SB(0, 1), b2 + hstep, voffB); PG8_STAGE_A(PG8_SA(0, 0), last, 0, k2);
            PG8_WAIT_V(8); PG8_WAIT_L(0); PG8_BAR; PG8_MMA(1, 0, At, B0); PG8_MMA(1, 1, At, B1); PG8_BAR; PG8_SCHED;
            PG8_LDB(B0, 1, 0); PG8_LDB(B1, 1, 1); PG8_SCHED; PG8_LDA(At, 1, 0); PG8_STAGE_A(PG8_SA(0, 1), last, 1, k2);
            PG8_WAIT_V(8); PG8_WAIT_L(0); PG8_BAR; PG8_MMA(0, 0, At, B0); PG8_MMA(0, 1, At, B1); PG8_BAR; PG8_SCHED;
            PG8_LDA(At, 1, 1); PG8_STAGE(PG8_SB(1, 0), b3, voffB); PG8_STAGE(PG8_SB(1, 1), b3 + hstep, voffB); PG8_STAGE_A(PG8_SA(1, 0), last, 0, k3);
            PG8_WAIT_V(8); PG8_WAIT_L(0); PG8_BAR; PG8_MMA(1, 0, At, B0); PG8_MMA(1, 1, At, B1); PG8_BAR; PG8_SCHED;
        }
        if constexpr (ALIGN_EPI) { if (wr == 0) PG8_BAR; }
        { const int l2_ = lane_id(); E(acc, cur, wr, wc, l2_ & 15, l2_ >> 4); }
        if (unsigned* rdy_ = epi_ready(E, 0)) { PG8_WAIT_V(0); if (lane_id() == 0) __hip_atomic_fetch_add(rdy_ + cur.pm * 64, 1u, __ATOMIC_RELAXED, __HIP_MEMORY_SCOPE_AGENT); }
        if (!has_next) break;
#pragma unroll
        for (int a = 0; a < 2; ++a)
#pragma unroll
            for (int b = 0; b < 2; ++b)
#pragma unroll
                for (int m = 0; m < 4; ++m)
#pragma unroll
                    for (int n = 0; n < 2; ++n) acc[a][b][m][n] = (f32x4){0.f, 0.f, 0.f, 0.f};
        cur = nxt; cA = nA; cB = nB; ++ui;
        pc ^= 1;
        if constexpr (ALIGN_EPI) { if (wr == 1) PG8_BAR; }
    }
    PG8_WAIT_V(0);
    if constexpr (!ALIGN_EPI) { if (wr == 0) PG8_BAR; }
    PG8_BAR;
#undef PG8_SA
#undef PG8_SB
#undef PG8_STAGE
#undef PG8_STAGE_A
#undef PG8_GOFS
#undef PG8_WRITE_GOFS
#undef PG8_LDA
#undef PG8_LDB
#undef PG8_MMA
#undef PG8_WAIT_V
#undef PG8_WAIT_L
#undef PG8_BAR
#undef PG8_SCHED
}
}

#define XB_TMO      128
#define XB_XCNT(j)  (256  + 64 * (j))
#define XB_XSUB(j)  (1280 + 64 * (j))
#define XB_XGEN(j)  (2304 + 64 * (j))
#define XB_TOP      3328
#define XB_TOPGEN   3392
#define XCD_BAR_WORDS 3456
#define XB_SPIN_CAP (1u << 18)
__device__ __forceinline__ unsigned xb_ld(unsigned* p)              { return __hip_atomic_load(p, __ATOMIC_RELAXED, __HIP_MEMORY_SCOPE_AGENT); }
__device__ __forceinline__ unsigned xb_add(unsigned* p, unsigned v) { return __hip_atomic_fetch_add(p, v, __ATOMIC_RELAXED, __HIP_MEMORY_SCOPE_AGENT); }
__device__ __forceinline__ unsigned xb_xcc_id() { return (unsigned)__builtin_amdgcn_s_getreg((3 << 11) | 20) & 0xFu; }
#define XB_SPIN(cond, bar) do { unsigned _sp = 0; while (cond) { __builtin_amdgcn_s_sleep(1); \
    if ((++_sp & 255u) == 0u) { if (xb_ld(&(bar)[XB_TMO])) break; if (_sp > XB_SPIN_CAP) { atomicAdd(&(bar)[XB_TMO], 1u); break; } } } } while (0)
struct XcdBarrier { unsigned* bar; unsigned x; volatile LAS unsigned* st; };
__device__ __forceinline__ XcdBarrier xcd_barrier_post(unsigned* bar, volatile LAS unsigned* st, int tid0) {
    XcdBarrier b; b.bar = bar; b.x = xb_xcc_id(); b.st = st;
    if (tid0 == 0) (void)xb_add(&bar[XB_XCNT(b.x)], 1u);
    return b;
}
__device__ __forceinline__ void xcd_barrier_complete(unsigned* bar, unsigned x, unsigned& nloc, unsigned& nx) {
    const unsigned G = gridDim.x * gridDim.y * gridDim.z;
    unsigned sum, cnt, mine, sp = 0u;
    for (;;) {
        sum = 0u; cnt = 0u; mine = 0u;
#pragma unroll
        for (unsigned j = 0; j < 16; ++j) { const unsigned c = xb_ld(&bar[XB_XCNT(j)]); sum += c; cnt += (c > 0u) ? 1u : 0u; mine = (j == x) ? c : mine; }
        if (sum == G) break;
        __builtin_amdgcn_s_sleep(1);
        if ((++sp & 255u) == 0u) { if (xb_ld(&bar[XB_TMO])) break; if (sp > XB_SPIN_CAP) { atomicAdd(&bar[XB_TMO], 1u); break; } }
    }
    nloc = mine > 0u ? mine : 1u; nx = cnt > 0u ? cnt : 1u;
}
__device__ __forceinline__ void xcd_barrier(const XcdBarrier& b, int tid0) {
    asm volatile("s_waitcnt vmcnt(0)" ::: "memory");
    __syncthreads();
    if (tid0 == 0) {
        unsigned* bar = b.bar;
        __builtin_amdgcn_s_waitcnt(0);
        unsigned nloc = b.st[0], nx = b.st[1];
        if (nloc == 0u) { xcd_barrier_complete(bar, b.x, nloc, nx); b.st[0] = nloc; b.st[1] = nx; }
        const unsigned old = xb_add(&bar[XB_XSUB(b.x)], 1u);
        const unsigned gen = old / nloc;
        if (old + 1u == (gen + 1u) * nloc) {
            __builtin_amdgcn_fence(__ATOMIC_RELEASE, "agent");
            asm volatile("s_waitcnt vmcnt(0)" ::: "memory");
            const unsigned og = xb_add(&bar[XB_TOP], 1u);
            const unsigned tg = og / nx;
            if (og + 1u == (tg + 1u) * nx) xb_add(&bar[XB_TOPGEN], 1u);
            else XB_SPIN(xb_ld(&bar[XB_TOPGEN]) == tg, bar);
            __builtin_amdgcn_fence(__ATOMIC_ACQUIRE, "agent");
            xb_add(&bar[XB_XGEN(b.x)], 1u);
            asm volatile("s_waitcnt vmcnt(0)" ::: "memory");
        } else {
            XB_SPIN(xb_ld(&bar[XB_XGEN(b.x)]) == gen, bar);
            __builtin_amdgcn_fence(__ATOMIC_ACQUIRE, "agent");
            asm volatile("s_waitcnt vmcnt(0)" ::: "memory");
        }
    }
    __syncthreads();
}

struct Args { const float* in[20]; float* out; unsigned char* ws; int ph_lo, ph_hi; };
typedef const __attribute__((address_space(4))) Args CArgs;
enum { I_X = 0, I_NORM_MIX, I_NORM_FFN, I_A_W_IN, I_A_LB, I_A_OGAIN, I_A_W_OUT, I_KV_NORM, I_KV_W, I_K_NORM, I_B_W_Q, I_B_Q_NORM, I_B_W_OUT,
       I_W_GROUP, I_B_GROUP, I_W_EXPERT, I_B_EXPERT, I_W_GATE, I_W_UP, I_W_DOWN };
struct Frame {
    LAS unsigned char* lds; unsigned char* ws; unsigned* ctl;
    int tid, lane, wave, vcu, G, gw, NGW;
};

struct TrItem { const float* src; const float* ksc; unsigned char* dst; int N, K, k0, n0, drow0, flags; float osc; };
struct TrRegs { f32x4 v[16]; f32x4 ks[2]; };
constexpr int TR_SCR_BYTES = 128 * 33 * 4;
__device__ __forceinline__ void tr_load(const TrItem& it, TrRegs& r, int lane) {
    const float* p = it.src + (size_t)(it.k0 + (lane >> 3)) * it.N + it.n0 + 4 * (lane & 7);
    const size_t st = (size_t)8 * it.N;
#pragma unroll
    for (int i = 0; i < 16; ++i) r.v[i] = __builtin_nontemporal_load((const f32x4*)(p + i * st));
    if (it.ksc) { const f32x4* q = (const f32x4*)(it.ksc + it.k0 + 8 * (lane >> 3)); r.ks[0] = q[0]; r.ks[1] = q[1]; }
    else { r.ks[0] = (f32x4){1.f, 1.f, 1.f, 1.f}; r.ks[1] = r.ks[0]; }
}
__device__ __forceinline__ void tr_to_lds(const TrRegs& r, LAS float* scr, int lane) {
    LAS float* d = scr + (lane >> 3) * 33 + 4 * (lane & 7);
#pragma unroll
    for (int i = 0; i < 16; ++i) { d[(8 * i) * 33 + 0] = r.v[i][0]; d[(8 * i) * 33 + 1] = r.v[i][1]; d[(8 * i) * 33 + 2] = r.v[i][2]; d[(8 * i) * 33 + 3] = r.v[i][3]; }
}
__device__ __forceinline__ void tr_store(const TrItem& it, f32x4 ka, f32x4 kb, const LAS float* scr, int lane) {
#pragma unroll
    for (int jh = 0; jh < 2; ++jh) {
        const int c = (lane >> 3) + 8 * jh;
        if (jh == 1 && it.ksc) { const f32x4* q = (const f32x4*)(it.ksc + it.k0 + 8 * c); ka = q[0]; kb = q[1]; }
        const float o = it.osc;
        const float s0 = ka[0] * o, s1 = ka[1] * o, s2 = ka[2] * o, s3 = ka[3] * o, s4 = kb[0] * o, s5 = kb[1] * o, s6 = kb[2] * o, s7 = kb[3] * o;
#pragma unroll
        for (int jn = 0; jn < 4; ++jn) {
            const int n = (lane & 7) + 8 * jn; const LAS float* s = scr + (8 * c) * 33 + n;
            const float w0 = s[0 * 33] * s0, w1 = s[1 * 33] * s1, w2 = s[2 * 33] * s2, w3 = s[3 * 33] * s3, w4 = s[4 * 33] * s4, w5 = s[5 * 33] * s5, w6 = s[6 * 33] * s6, w7 = s[7 * 33] * s7;
            int drow = it.drow0 + n;
            if (it.flags & 1) { const int cidx = it.n0 + n, d = cidx & 127; drow = (it.drow0 - it.n0) + (cidx & ~127) + 32 * ((d & 63) >> 4) + 8 * ((d & 15) >> 2) + 4 * (d >> 6) + (d & 3); }
            const size_t eo = (size_t)drow * it.K + it.k0 + 8 * c;
            if (it.flags & 2) { u32x2 o8; o8.x = pk4_fp8(w0, w1, w2, w3); o8.y = pk4_fp8(w4, w5, w6, w7); *(u32x2*)(it.dst + eo) = o8; }
            else { u32x4 o16; o16.x = pk2(w0, w1); o16.y = pk2(w2, w3); o16.z = pk2(w4, w5); o16.w = pk2(w6, w7); *(u32x4*)(it.dst + eo * 2) = o16; }
        }
    }
}
template <class Dec> __device__ __forceinline__ void tr_run(Dec dec, int first, int total, int stride, LAS float* scr, int lane) {
    if (first >= total) return;
    TrRegs r; TrItem cur = dec(first); tr_load(cur, r, lane);
    for (int i = first; i < total; i += stride) {
        tr_to_lds(r, scr, lane);
        const f32x4 ka = r.ks[0], kb = r.ks[1];
        TrItem nxt = cur; const bool more = i + stride < total;
        if (more) { nxt = dec(i + stride); tr_load(nxt, r, lane); }
        LDS_WAIT(); asm volatile("" ::: "memory");
        tr_store(cur, ka, kb, scr, lane);
        LDS_WAIT(); asm volatile("" ::: "memory");
        cur = nxt;
    }
}
constexpr size_t WGU_LSTRIDE = 64 * MiB, WD_LSTRIDE = 32 * MiB;
static_assert((FP8_MOE0 != 0) && (FP8_MOE1 != 0), "the two-layer weight residency assumes e4m3 expert weights");
constexpr int MOE_CV_ITEMS = 32 * 768;
__device__ __forceinline__ TrItem moe_cv_item(CArgs& a, unsigned char* ws, int layer, int item) {
    const int e = item / 768, r = item % 768, which = r / 256, q = r % 256;
    const size_t eo = (size_t)(layer * NE + e);
    TrItem t; t.ksc = nullptr; t.flags = 2;
    if (which < 2) {
        const int kb = q / 16, nb = q % 16, n0 = nb * 32;
        t.src = (which == 0 ? a.in[I_W_GATE] : a.in[I_W_UP]) + eo * (size_t)D * FF; t.N = FF; t.K = D; t.k0 = 128 * kb; t.n0 = n0;
        t.dst = ws + WS_WGU + (size_t)layer * WGU_LSTRIDE + (size_t)e * 1024 * D; t.drow0 = (n0 >> 7) * 256 + which * 128 + (n0 & 127); t.osc = SC_W;
    } else {
        const int kb = q / 64, nb = q % 64;
        t.src = a.in[I_W_DOWN] + eo * (size_t)FF * D; t.N = D; t.K = FF; t.k0 = 128 * kb; t.n0 = nb * 32;
        t.dst = ws + WS_WD + (size_t)layer * WD_LSTRIDE + (size_t)e * D * FF; t.drow0 = nb * 32; t.osc = SC_WD;
    }
    return t;
}
__device__ __forceinline__ void rms_row_to_bf16(const float* xrow, bf16* orow, int lane) {
    const f32x4* xr = (const f32x4*)xrow + lane;
    f32x4 v[8]; float s = 0.f;
#pragma unroll
    for (int j = 0; j < 8; ++j) { v[j] = xr[64 * j]; s += (v[j].x * v[j].x + v[j].y * v[j].y) + (v[j].z * v[j].z + v[j].w * v[j].w); }
    const float rstd = __builtin_amdgcn_rsqf(wave_sum(s) * (1.f / D) + RMS_EPS);
    u32x2* o8 = (u32x2*)orow + lane;
#pragma unroll
    for (int j = 0; j < 8; ++j) { u32x2 w; w.x = pk2(v[j].x * rstd, v[j].y * rstd); w.y = pk2(v[j].z * rstd, v[j].w * rstd); o8[64 * j] = w; }
}

__device__ __forceinline__ int moe_tables(Frame& F, int layer) {
    LAS int* blk_e = (LAS int*)(F.lds + LT_BLKE); LAS int* blkstart = (LAS int*)(F.lds + LT_BLKSTART); LAS int* cntl = (LAS int*)(F.lds + LT_CNT);
    __syncthreads();
    if (F.wave == 0) {
        const int e = F.lane & 31;
        const int c = (int)__hip_atomic_load(F.ctl + CW_CNT_AT(layer, e), __ATOMIC_RELAXED, __HIP_MEMORY_SCOPE_AGENT);
        const int nb = (c + 255) >> 8;
        int incl = nb;
#pragma unroll
        for (int o = 1; o < 32; o <<= 1) { const int t = __shfl_up(incl, o, 32); if ((F.lane & 31) >= o) incl += t; }
        const int excl = incl - nb;
        if (F.lane < 32) { blkstart[e] = excl; cntl[e] = c; for (int r = 0; r < nb; ++r) blk_e[excl + r] = e; if (e == 31) blkstart[32] = incl; }
    }
    __syncthreads();
    return blkstart[32];
}

typedef const GAS char* gcptr;
__device__ __forceinline__ gcptr opaque_s(const void* p) { asm volatile("" : "+s"(p)); return (gcptr)p; }
__device__ __forceinline__ float wave_reduce4(const float (&p)[4], int lane) {
    const bool b0 = lane & 1, b1 = lane & 2;
    float a0 = b0 ? p[1] : p[0], x0 = b0 ? p[0] : p[1]; a0 += __shfl_xor(x0, 1);
    float a1 = b0 ? p[3] : p[2], x1 = b0 ? p[2] : p[3]; a1 += __shfl_xor(x1, 1);
    float c = b1 ? a1 : a0, d = b1 ? a0 : a1; c += __shfl_xor(d, 2);
    c += __shfl_xor(c, 4); c += __shfl_xor(c, 8); c += __shfl_xor(c, 16); c += __shfl_xor(c, 32);
    return c;
}
__device__ __forceinline__ float wave_reduce8(const float (&p)[8], int lane) {
    const bool b2 = lane & 4;
    const float lo[4] = {p[0], p[1], p[2], p[3]}, hi[4] = {p[4], p[5], p[6], p[7]};
    float q[4];
#pragma unroll
    for (int i = 0; i < 4; ++i) { const float keep = b2 ? hi[i] : lo[i], give = b2 ? lo[i] : hi[i]; q[i] = keep + __shfl_xor(give, 4); }
    const bool b0 = lane & 1, b1 = lane & 2;
    float a0 = b0 ? q[1] : q[0], x0 = b0 ? q[0] : q[1]; a0 += __shfl_xor(x0, 1);
    float a1 = b0 ? q[3] : q[2], x1 = b0 ? q[2] : q[3]; a1 += __shfl_xor(x1, 1);
    float c = b1 ? a1 : a0, d = b1 ? a0 : a1; c += __shfl_xor(d, 2);
    c += __shfl_xor(c, 8); c += __shfl_xor(c, 16); c += __shfl_xor(c, 32);
    return c;
}
template <bool DRY, bool OUT8> __device__ __forceinline__ void route_token(Frame& F, CArgs& a, int layer, int t) {
    const bf16* xrow = (const bf16*)(F.ws + WS_XR) + (size_t)t * D;
    const unsigned l16 = (unsigned)F.lane * 16u;
    gcptr xb = opaque_s(xrow); gcptr gb = opaque_s(a.in[I_NORM_FFN] + layer * D);
    f32x4 v[8]; float s = 0.f;
#pragma unroll
    for (int j = 0; j < 8; ++j) { const u32x2 xw_ = *(const GAS u32x2*)(xb + j * 512 + (l16 >> 1)); v[j] = (f32x4){bflo(xw_.x), bfhi(xw_.x), bflo(xw_.y), bfhi(xw_.y)}; s += (v[j].x * v[j].x + v[j].y * v[j].y) + (v[j].z * v[j].z + v[j].w * v[j].w); }
    const float rstd = __builtin_amdgcn_rsqf(wave_sum(s) * (1.f / D) + RMS_EPS);
    u32x2* o8 = (u32x2*)((bf16*)(F.ws + (DRY ? WS_OPART : WS_XN)) + (size_t)t * D) + F.lane;
#pragma unroll
    for (int j = 0; j < 8; ++j) { const f32x4 g = *(const GAS f32x4*)(gb + j * 1024 + l16); v[j].x *= rstd * g.x; v[j].y *= rstd * g.y; v[j].z *= rstd * g.z; v[j].w *= rstd * g.w;
        if (OUT8) ((unsigned*)(F.ws + (DRY ? WS_OPART : WS_XN)) + (size_t)t * (D / 4))[64 * j + F.lane] = pk4_fp8(v[j].x * SC_XN, v[j].y * SC_XN, v[j].z * SC_XN, v[j].w * SC_XN);
        else { u32x2 w; w.x = pk2(v[j].x, v[j].y); w.y = pk2(v[j].z, v[j].w); o8[64 * j] = w; } }
    const float* RT = (const float*)(F.ws + WS_RT) + (size_t)layer * 36 * D;
    float gl[4];
    { float pp[4];
#pragma unroll
      for (int r = 0; r < 4; ++r) { gcptr wb = opaque_s(RT + r * D); float p = 0.f;
#pragma unroll
        for (int j = 0; j < 8; ++j) { const f32x4 w = *(const GAS f32x4*)(wb + j * 1024 + l16); p += (v[j].x * w.x + v[j].y * w.y) + (v[j].z * w.z + v[j].w * w.w); }
        pp[r] = p; if (r & 1) __builtin_amdgcn_sched_barrier(0); }
      const float red = wave_reduce4(pp, F.lane);
#pragma unroll
      for (int r = 0; r < 4; ++r) gl[r] = __builtin_bit_cast(float, __builtin_amdgcn_readlane(__builtin_bit_cast(int, red), r)) + a.in[I_B_GROUP][layer * NG + r]; }
    int g = 0; float gm = gl[0];
#pragma unroll
    for (int r = 1; r < 4; ++r) if (gl[r] > gm) { gm = gl[r]; g = r; }
    float gs = 0.f;
#pragma unroll
    for (int r = 0; r < 4; ++r) gs += __expf(gl[r] - gm);
    const float gp = 1.0f / gs;
    g = __builtin_amdgcn_readfirstlane(g);
    float el[8];
    { float pp[8];
#pragma unroll
      for (int r = 0; r < 8; ++r) { gcptr wb = opaque_s(RT + (size_t)(4 + g * 8 + r) * D); float p = 0.f;
#pragma unroll
        for (int j = 0; j < 8; ++j) { const f32x4 w = *(const GAS f32x4*)(wb + j * 1024 + l16); p += (v[j].x * w.x + v[j].y * w.y) + (v[j].z * w.z + v[j].w * w.w); }
        pp[r] = p; if (r & 1) __builtin_amdgcn_sched_barrier(0); }
      const float red = wave_reduce8(pp, F.lane);
#pragma unroll
      for (int r = 0; r < 8; ++r) el[r] = __builtin_bit_cast(float, __builtin_amdgcn_readlane(__builtin_bit_cast(int, red), r)) + a.in[I_B_EXPERT][layer * NE + g * 8 + r]; }
    int i0 = 0; float m0 = el[0];
#pragma unroll
    for (int r = 1; r < 8; ++r) if (el[r] > m0) { m0 = el[r]; i0 = r; }
    int i1 = -1; float m1 = -INFINITY;
#pragma unroll
    for (int r = 0; r < 8; ++r) if (r != i0 && el[r] > m1) { m1 = el[r]; i1 = r; }
    const float q1 = __expf(m1 - m0), w0 = gp / (1.0f + q1), w1 = gp * q1 / (1.0f + q1);
    if (DRY && w0 + w1 < -1.0f) ((float*)(F.ws + WS_OPART))[0] = w0;
    if (F.lane == 0 && !DRY) {
        const int e0 = g * 8 + i0, e1 = g * 8 + i1;
        const int r0 = (int)atomicAdd(F.ctl + CW_CNT_AT(layer, e0), 1u), r1 = (int)atomicAdd(F.ctl + CW_CNT_AT(layer, e1), 1u);
        int* lists = (int*)(F.ws + WS_LISTS); lists[e0 * LIST_CAP + r0] = t; lists[e1 * LIST_CAP + r1] = t;
        int* rec = (int*)(F.ws + WS_TOKREC) + (size_t)t * 8;
        rec[0] = e0; rec[1] = r0; rec[2] = __builtin_bit_cast(int, w0); rec[3] = e1; rec[4] = r1; rec[5] = __builtin_bit_cast(int, w1);
    }
}

template <bool OUT8> __device__ __forceinline__ void route_pair(Frame& F, CArgs& a, int layer, int ta, int tb) {
    const unsigned l16 = (unsigned)F.lane * 16u;
    gcptr xb0 = opaque_s((const bf16*)(F.ws + WS_XR) + (size_t)ta * D), xb1 = opaque_s((const bf16*)(F.ws + WS_XR) + (size_t)tb * D); gcptr gb = opaque_s(a.in[I_NORM_FFN] + layer * D);
    f32x4 v0[8], v1[8]; float s0 = 0.f, s1 = 0.f;
#pragma unroll
    for (int j = 0; j < 8; ++j) { const u32x2 x0 = *(const GAS u32x2*)(xb0 + j * 512 + (l16 >> 1)), x1 = *(const GAS u32x2*)(xb1 + j * 512 + (l16 >> 1));
        v0[j] = (f32x4){bflo(x0.x), bfhi(x0.x), bflo(x0.y), bfhi(x0.y)}; v1[j] = (f32x4){bflo(x1.x), bfhi(x1.x), bflo(x1.y), bfhi(x1.y)};
        s0 += (v0[j].x * v0[j].x + v0[j].y * v0[j].y) + (v0[j].z * v0[j].z + v0[j].w * v0[j].w); s1 += (v1[j].x * v1[j].x + v1[j].y * v1[j].y) + (v1[j].z * v1[j].z + v1[j].w * v1[j].w); }
    const float rstd0 = __builtin_amdgcn_rsqf(wave_sum(s0) * (1.f / D) + RMS_EPS), rstd1 = __builtin_amdgcn_rsqf(wave_sum(s1) * (1.f / D) + RMS_EPS);
#pragma unroll
    for (int j = 0; j < 8; ++j) { const f32x4 g = *(const GAS f32x4*)(gb + j * 1024 + l16);
        v0[j].x *= rstd0 * g.x; v0[j].y *= rstd0 * g.y; v0[j].z *= rstd0 * g.z; v0[j].w *= rstd0 * g.w; v1[j].x *= rstd1 * g.x; v1[j].y *= rstd1 * g.y; v1[j].z *= rstd1 * g.z; v1[j].w *= rstd1 * g.w;
        if (OUT8) { ((unsigned*)(F.ws + WS_XN) + (size_t)ta * (D / 4))[64 * j + F.lane] = pk4_fp8(v0[j].x * SC_XN, v0[j].y * SC_XN, v0[j].z * SC_XN, v0[j].w * SC_XN);
                    ((unsigned*)(F.ws + WS_XN) + (size_t)tb * (D / 4))[64 * j + F.lane] = pk4_fp8(v1[j].x * SC_XN, v1[j].y * SC_XN, v1[j].z * SC_XN, v1[j].w * SC_XN); }
        else { u32x2 w; w.x = pk2(v0[j].x, v0[j].y); w.y = pk2(v0[j].z, v0[j].w); ((u32x2*)((bf16*)(F.ws + WS_XN) + (size_t)ta * D) + F.lane)[64 * j] = w;
               w.x = pk2(v1[j].x, v1[j].y); w.y = pk2(v1[j].z, v1[j].w); ((u32x2*)((bf16*)(F.ws + WS_XN) + (size_t)tb * D) + F.lane)[64 * j] = w; } }
    const float* RT = (const float*)(F.ws + WS_RT) + (size_t)layer * 36 * D;
    float gla[4], glb[4];
    { float pa_[4], pb_[4];
#pragma unroll
      for (int r = 0; r < 4; ++r) { gcptr wb = opaque_s(RT + r * D); float p0 = 0.f, p1 = 0.f;
#pragma unroll
        for (int j = 0; j < 8; ++j) { const f32x4 w = *(const GAS f32x4*)(wb + j * 1024 + l16);
            p0 += (v0[j].x * w.x + v0[j].y * w.y) + (v0[j].z * w.z + v0[j].w * w.w); p1 += (v1[j].x * w.x + v1[j].y * w.y) + (v1[j].z * w.z + v1[j].w * w.w); }
        pa_[r] = p0; pb_[r] = p1; if (r & 1) __builtin_amdgcn_sched_barrier(0); }
      const float reda = wave_reduce4(pa_, F.lane), redb = wave_reduce4(pb_, F.lane);
#pragma unroll
      for (int r = 0; r < 4; ++r) { const float bg = a.in[I_B_GROUP][layer * NG + r];
          gla[r] = __builtin_bit_cast(float, __builtin_amdgcn_readlane(__builtin_bit_cast(int, reda), r)) + bg; glb[r] = __builtin_bit_cast(float, __builtin_amdgcn_readlane(__builtin_bit_cast(int, redb), r)) + bg; } }
    int ga = 0, gb_ = 0; float gma = gla[0], gmb = glb[0];
#pragma unroll
    for (int r = 1; r < 4; ++r) { if (gla[r] > gma) { gma = gla[r]; ga = r; } if (glb[r] > gmb) { gmb = glb[r]; gb_ = r; } }
    float gsa = 0.f, gsb = 0.f;
#pragma unroll
    for (int r = 0; r < 4; ++r) { gsa += __expf(gla[r] - gma); gsb += __expf(glb[r] - gmb); }
    const float gpa = 1.0f / gsa, gpb = 1.0f / gsb;
    ga = __builtin_amdgcn_readfirstlane(ga); gb_ = __builtin_amdgcn_readfirstlane(gb_);
    float ela[8], elb[8];
    { float pa_[8], pb_[8];
#pragma unroll
      for (int r = 0; r < 8; ++r) { gcptr wa = opaque_s(RT + (size_t)(4 + ga * 8 + r) * D), wb = opaque_s(RT + (size_t)(4 + gb_ * 8 + r) * D); float p0 = 0.f, p1 = 0.f;
#pragma unroll
        for (int j = 0; j < 8; ++j) { const f32x4 w0 = *(const GAS f32x4*)(wa + j * 1024 + l16), w1 = *(const GAS f32x4*)(wb + j * 1024 + l16);
            p0 += (v0[j].x * w0.x + v0[j].y * w0.y) + (v0[j].z * w0.z + v0[j].w * w0.w); p1 += (v1[j].x * w1.x + v1[j].y * w1.y) + (v1[j].z * w1.z + v1[j].w * w1.w); }
        pa_[r] = p0; pb_[r] = p1; if (r & 1) __builtin_amdgcn_sched_barrier(0); }
      const float reda = wave_reduce8(pa_, F.lane), redb = wave_reduce8(pb_, F.lane);
#pragma unroll
      for (int r = 0; r < 8; ++r) { ela[r] = __builtin_bit_cast(float, __builtin_amdgcn_readlane(__builtin_bit_cast(int, reda), r)) + a.in[I_B_EXPERT][layer * NE + ga * 8 + r];
                                    elb[r] = __builtin_bit_cast(float, __builtin_amdgcn_readlane(__builtin_bit_cast(int, redb), r)) + a.in[I_B_EXPERT][layer * NE + gb_ * 8 + r]; } }
    int ia0 = 0, ib0 = 0; float ma0 = ela[0], mb0 = elb[0];
#pragma unroll
    for (int r = 1; r < 8; ++r) { if (ela[r] > ma0) { ma0 = ela[r]; ia0 = r; } if (elb[r] > mb0) { mb0 = elb[r]; ib0 = r; } }
    int ia1 = -1, ib1 = -1; float ma1 = -INFINITY, mb1 = -INFINITY;
#pragma unroll
    for (int r = 0; r < 8; ++r) { if (r != ia0 && ela[r] > ma1) { ma1 = ela[r]; ia1 = r; } if (r != ib0 && elb[r] > mb1) { mb1 = elb[r]; ib1 = r; } }
    const float qa = __expf(ma1 - ma0), wa0 = gpa / (1.0f + qa), wa1 = gpa * qa / (1.0f + qa);
    const float qb = __expf(mb1 - mb0), wb0 = gpb / (1.0f + qb), wb1 = gpb * qb / (1.0f + qb);
    if (F.lane == 0) {
        const int ea0 = ga * 8 + ia0, ea1 = ga * 8 + ia1, eb0 = gb_ * 8 + ib0, eb1 = gb_ * 8 + ib1;
        const int ra0 = (int)atomicAdd(F.ctl + CW_CNT_AT(layer, ea0), 1u), ra1 = (int)atomicAdd(F.ctl + CW_CNT_AT(layer, ea1), 1u);
        const int rb0 = (int)atomicAdd(F.ctl + CW_CNT_AT(layer, eb0), 1u), rb1 = (int)atomicAdd(F.ctl + CW_CNT_AT(layer, eb1), 1u);
        int* lists = (int*)(F.ws + WS_LISTS); lists[ea0 * LIST_CAP + ra0] = ta; lists[ea1 * LIST_CAP + ra1] = ta; lists[eb0 * LIST_CAP + rb0] = tb; lists[eb1 * LIST_CAP + rb1] = tb;
        int* rec = (int*)(F.ws + WS_TOKREC) + (size_t)ta * 8;
        rec[0] = ea0; rec[1] = ra0; rec[2] = __builtin_bit_cast(int, wa0); rec[3] = ea1; rec[4] = ra1; rec[5] = __builtin_bit_cast(int, wa1);
        rec = (int*)(F.ws + WS_TOKREC) + (size_t)tb * 8;
        rec[0] = eb0; rec[1] = rb0; rec[2] = __builtin_bit_cast(int, wb0); rec[3] = eb1; rec[4] = rb1; rec[5] = __builtin_bit_cast(int, wb1);
    }
}

template <bool NORM, bool DRY, bool OUT8> __device__ __forceinline__ void combine_token(Frame& F, CArgs& a, int t) {
    const LAS int* blkstart = (const LAS int*)(F.lds + LT_BLKSTART);
    const int* rec = (const int*)(F.ws + WS_TOKREC) + (size_t)t * 8;
    const int e0 = rec[0], r0 = rec[1], e1 = rec[3], r1 = rec[4]; const float w0 = __builtin_bit_cast(float, rec[2]), w1 = __builtin_bit_cast(float, rec[5]);
    const size_t row0 = (size_t)blkstart[e0] * 256 + r0, row1 = (size_t)blkstart[e1] * 256 + r1;
    const u32x2* p0 = (const u32x2*)((const bf16*)(F.ws + WS_OUTB) + row0 * D) + F.lane; const u32x2* p1 = (const u32x2*)((const bf16*)(F.ws + WS_OUTB) + row1 * D) + F.lane;
    const unsigned* q0 = (const unsigned*)(F.ws + WS_OUTB + row0 * D) + F.lane; const unsigned* q1 = (const unsigned*)(F.ws + WS_OUTB + row1 * D) + F.lane;
    u32x2* xr = (u32x2*)((bf16*)(F.ws + WS_XR) + (size_t)t * D) + F.lane; f32x4* xo = (f32x4*)(a.out + (size_t)t * D) + F.lane;
    f32x4 v[8]; float s = 0.f;
#pragma unroll
    for (int j = 0; j < 8; ++j) { const u32x2 xb_ = xr[64 * j]; f32x4 x = (f32x4){bflo(xb_.x), bfhi(xb_.x), bflo(xb_.y), bfhi(xb_.y)};
        if (OUT8) { const unsigned b0 = q0[64 * j], b1 = q1[64 * j]; const float u0 = w0 * (1.0f / SC_OUT), u1 = w1 * (1.0f / SC_OUT);
            const f32x2 l0 = __builtin_amdgcn_cvt_pk_f32_fp8((int)b0, false), h0 = __builtin_amdgcn_cvt_pk_f32_fp8((int)b0, true), l1 = __builtin_amdgcn_cvt_pk_f32_fp8((int)b1, false), h1 = __builtin_amdgcn_cvt_pk_f32_fp8((int)b1, true);
            x.x += u0 * l0.x + u1 * l1.x; x.y += u0 * l0.y + u1 * l1.y; x.z += u0 * h0.x + u1 * h1.x; x.w += u0 * h0.y + u1 * h1.y; }
        else { const u32x2 a0 = p0[64 * j], a1 = p1[64 * j];
            x.x += w0 * bflo(a0.x) + w1 * bflo(a1.x); x.y += w0 * bfhi(a0.x) + w1 * bfhi(a1.x); x.z += w0 * bflo(a0.y) + w1 * bflo(a1.y); x.w += w0 * bfhi(a0.y) + w1 * bfhi(a1.y); }
        v[j] = x; if (NORM) { if (!DRY) { u32x2 w_; w_.x = pk2(x.x, x.y); w_.y = pk2(x.z, x.w); xr[64 * j] = w_; } } else xo[64 * j] = x; s += (x.x * x.x + x.y * x.y) + (x.z * x.z + x.w * x.w); }
    if (NORM) {
        const float rstd = __builtin_amdgcn_rsqf(wave_sum(s) * (1.f / D) + RMS_EPS);
        u32x2* o8 = (u32x2*)((bf16*)(F.ws + (DRY ? WS_OPART + 128 * MiB : WS_XN)) + (size_t)t * D) + F.lane;
#pragma unroll
        for (int j = 0; j < 8; ++j) {
            if (FP8_QKV) ((unsigned*)(F.ws + (DRY ? WS_OPART + 128 * MiB : WS_XN)) + (size_t)t * (D / 4))[64 * j + F.lane] = pk4_fp8(v[j].x * (rstd * SC_XN), v[j].y * (rstd * SC_XN), v[j].z * (rstd * SC_XN), v[j].w * (rstd * SC_XN));
            else { u32x2 w; w.x = pk2(v[j].x * rstd, v[j].y * rstd); w.y = pk2(v[j].z * rstd, v[j].w * rstd); o8[64 * j] = w; } }
    }
}

typedef int ci32x4 __attribute__((ext_vector_type(4)));
struct CombRows { u32x2 x[8]; unsigned b0[8], b1[8]; float w0, w1; };
template <bool NORM> __device__ __forceinline__ void combine_tokens(Frame& F, CArgs& a, int t0, int stride) {
    static_assert(OUT8_L0 && OUT8_L1 && FP8_QKV, "pipelined combine: e4m3 expert rows and e4m3 XN");
    const LAS int* blkstart = (const LAS int*)(F.lds + LT_BLKSTART);
    LAS ci32x4* lrec = (LAS ci32x4*)(F.lds + F.wave * 256);
    const int lane = F.lane;
    auto issue = [&](int k, int t, CombRows& R) {
        const ci32x4 r0 = lrec[2 * k], r1 = lrec[2 * k + 1];
        const int e0 = __builtin_amdgcn_readfirstlane(r0.x), rr0 = __builtin_amdgcn_readfirstlane(r0.y), e1 = __builtin_amdgcn_readfirstlane(r0.w), rr1 = __builtin_amdgcn_readfirstlane(r1.x);
        const LAS float* wf = (const LAS float*)lrec + 8 * k; R.w0 = wf[2] * (1.0f / SC_OUT); R.w1 = wf[5] * (1.0f / SC_OUT);
        const size_t row0 = (size_t)blkstart[e0] * 256 + rr0, row1 = (size_t)blkstart[e1] * 256 + rr1;
        const unsigned* q0 = (const unsigned*)(F.ws + WS_OUTB + row0 * D) + lane; const unsigned* q1 = (const unsigned*)(F.ws + WS_OUTB + row1 * D) + lane;
        const u32x2* xr = (const u32x2*)((const bf16*)(F.ws + WS_XR) + (size_t)t * D) + lane;
#pragma unroll
        for (int j = 0; j < 8; ++j) { R.x[j] = xr[64 * j]; R.b0[j] = q0[64 * j]; R.b1[j] = q1[64 * j]; }
    };
    auto finish = [&](int t, const CombRows& R) {
        u32x2* xr = (u32x2*)((bf16*)(F.ws + WS_XR) + (size_t)t * D) + lane; f32x4* xo = (f32x4*)(a.out + (size_t)t * D) + lane;
        f32x4 v[8]; float s = 0.f;
#pragma unroll
        for (int j = 0; j < 8; ++j) { f32x4 x = (f32x4){bflo(R.x[j].x), bfhi(R.x[j].x), bflo(R.x[j].y), bfhi(R.x[j].y)};
            const f32x2 l0 = __builtin_amdgcn_cvt_pk_f32_fp8((int)R.b0[j], false), h0 = __builtin_amdgcn_cvt_pk_f32_fp8((int)R.b0[j], true), l1 = __builtin_amdgcn_cvt_pk_f32_fp8((int)R.b1[j], false), h1 = __builtin_amdgcn_cvt_pk_f32_fp8((int)R.b1[j], true);
            x.x += R.w0 * l0.x + R.w1 * l1.x; x.y += R.w0 * l0.y + R.w1 * l1.y; x.z += R.w0 * h0.x + R.w1 * h1.x; x.w += R.w0 * h0.y + R.w1 * h1.y;
            v[j] = x; if (NORM) { u32x2 w_; w_.x = pk2(x.x, x.y); w_.y = pk2(x.z, x.w); xr[64 * j] = w_; } else xo[64 * j] = x; s += (x.x * x.x + x.y * x.y) + (x.z * x.z + x.w * x.w); }
        if (NORM) {
            const float rstd = __builtin_amdgcn_rsqf(wave_sum(s) * (1.f / D) + RMS_EPS) * SC_XN;
            unsigned* o = (unsigned*)(F.ws + WS_XN) + (size_t)t * (D / 4) + lane;
#pragma unroll
            for (int j = 0; j < 8; ++j) o[64 * j] = pk4_fp8(v[j].x * rstd, v[j].y * rstd, v[j].z * rstd, v[j].w * rstd);
        }
    };
    for (int base = t0; base < M; base += 8 * stride) {
        const int nt = min(8, (M - base + stride - 1) / stride);
        if (lane < 2 * nt) lrec[lane] = ((const ci32x4*)(F.ws + WS_TOKREC))[2 * (size_t)(base + (lane >> 1) * stride) + (lane & 1)];
        LDS_WAIT(); asm volatile("s_waitcnt vmcnt(0)" ::: "memory"); LDS_WAIT();
        CombRows cur, nxt; issue(0, base, cur);
        for (int k = 0; k < nt; ++k) {
            if (k + 1 < nt) issue(k + 1, base + (k + 1) * stride, nxt);
            finish(base + k * stride, cur);
            cur = nxt;
        }
        LDS_WAIT();
    }
}
__device__ __forceinline__ void hgrn_naive_item(Frame& F, int item) {
    const int b = item >> 6, h = (item >> 2) & 15, sl = item & 3;
    const bf16* Zq = (const bf16*)(F.ws + WS_ZQ); const bf16* Zk = (const bf16*)(F.ws + WS_ZK); const _Float16* Zg = (const _Float16*)(F.ws + WS_ZG); const bf16* Zv = (const bf16*)(F.ws + WS_ZV);
    float* Oraw = (float*)(F.ws + WS_ORAW);
    LAS float* fq = (LAS float*)F.lds; LAS float* fk = fq + 16 * 128; LAS float* ff = fk + 16 * 128; LAS float* fv = ff + 16 * 128; LAS float* part = fv + 16 * 32;
    const int dv = F.tid & 31, dkg = F.tid >> 5;
    float S[8];
#pragma unroll
    for (int j = 0; j < 8; ++j) S[j] = 0.f;
    const size_t tok0 = (size_t)b * T;
    for (int c = 0; c < T / 16; ++c) {
        __syncthreads();
#pragma unroll
        for (int i = 0; i < 4; ++i) { const int idx = F.tid + i * 512, st = idx >> 7, dk = idx & 127; const size_t g = (tok0 + c * 16 + st) * D + h * HD + dk;
            fq[idx] = bf2f(Zq[g]); fk[idx] = bf2f(Zk[g]); ff[idx] = __expf((float)Zg[g]); }
        { const int st = F.tid >> 5; fv[F.tid] = bf2f(Zv[(tok0 + c * 16 + st) * D + h * HD + sl * 32 + dv]); }
        __syncthreads();
#pragma unroll 4
        for (int st = 0; st < 16; ++st) {
            const float v = fv[st * 32 + dv];
            const f32x4 q0 = *(const LAS f32x4*)(fq + st * 128 + dkg * 8), q1 = *(const LAS f32x4*)(fq + st * 128 + dkg * 8 + 4);
            const f32x4 k0 = *(const LAS f32x4*)(fk + st * 128 + dkg * 8), k1 = *(const LAS f32x4*)(fk + st * 128 + dkg * 8 + 4);
            const f32x4 f0 = *(const LAS f32x4*)(ff + st * 128 + dkg * 8), f1 = *(const LAS f32x4*)(ff + st * 128 + dkg * 8 + 4);
            float po = 0.f;
#pragma unroll
            for (int j = 0; j < 4; ++j) { S[j] = f0[j] * S[j] + k0[j] * v; po += q0[j] * S[j]; S[4 + j] = f1[j] * S[4 + j] + k1[j] * v; po += q1[j] * S[4 + j]; }
            part[(st * 16 + dkg) * 32 + dv] = po;
        }
        __syncthreads();
        { const int st = F.tid >> 5; float o = 0.f;
#pragma unroll
            for (int g = 0; g < 16; ++g) o += part[(st * 16 + g) * 32 + dv];
            Oraw[(tok0 + c * 16 + st) * D + h * HD + sl * 32 + dv] = o; }
    }
    __syncthreads();
}
__device__ __forceinline__ void hgrn_norm_token(Frame& F, CArgs& a, int t) {
    const float* o = (const float*)(F.ws + WS_ORAW) + (size_t)t * D + F.lane * 32;
    const bf16* zg = (const bf16*)(F.ws + WS_ZGATE) + (size_t)t * D + F.lane * 32;
    const float* gain = a.in[I_A_OGAIN] + (F.lane & 3) * 32;
    f32x4 v[8]; float s = 0.f;
#pragma unroll
    for (int j = 0; j < 8; ++j) { v[j] = ((const f32x4*)o)[j]; s += (v[j].x * v[j].x + v[j].y * v[j].y) + (v[j].z * v[j].z + v[j].w * v[j].w); }
    s += __shfl_xor(s, 1); s += __shfl_xor(s, 2);
    const float rstd = 1.0f / sqrtf(s * (1.f / HD) + RMS_EPS);
    bf16* out = (bf16*)(F.ws + WS_OH) + (size_t)t * D + F.lane * 32;
#pragma unroll
    for (int j = 0; j < 4; ++j) { const u32x4 g = ((const u32x4*)zg)[j]; const f32x4 ga = ((const f32x4*)gain)[2 * j], gb = ((const f32x4*)gain)[2 * j + 1]; const f32x4 va = v[2 * j], vb = v[2 * j + 1];
        u32x4 w; w.x = pk2(va.x * rstd * ga.x * bflo(g.x), va.y * rstd * ga.y * bfhi(g.x)); w.y = pk2(va.z * rstd * ga.z * bflo(g.y), va.w * rstd * ga.w * bfhi(g.y));
        w.z = pk2(vb.x * rstd * gb.x * bflo(g.z), vb.y * rstd * gb.y * bfhi(g.z)); w.w = pk2(vb.z * rstd * gb.z * bflo(g.w), vb.w * rstd * gb.w * bfhi(g.w));
        ((u32x4*)out)[j] = w; }
}

template <bool DRY> __device__ __forceinline__ void qk_post_item(Frame& F, CArgs& a, int item) {
    const int b = item >> 6, n = (item >> 2) & 15, hq = item & 3;
    const int hl = F.lane >> 4, sb = F.lane & 15, h = hq * 4 + hl;
    bf16* Q = (bf16*)(F.ws + WS_Q); bf16* Kb = (bf16*)(F.ws + WS_K);
    const f32x2* rope = (const f32x2*)(F.ws + WS_ROPE);
    const f32x4 gq0 = *(const f32x4*)(a.in[I_B_Q_NORM] + 4 * sb), gq1 = *(const f32x4*)(a.in[I_B_Q_NORM] + 64 + 4 * sb);
    const f32x4 gk0 = *(const f32x4*)(a.in[I_K_NORM] + 4 * sb), gk1 = *(const f32x4*)(a.in[I_K_NORM] + 64 + 4 * sb);
    float ks[8];
#pragma unroll
    for (int j = 0; j < 8; ++j) ks[j] = 0.f;
    for (int i = 0; i < 32; ++i) {
        const int pos = n * MBLK + F.wave * 32 + i; const size_t tok = (size_t)b * T + pos;
        f32x2 cs[4];
#pragma unroll
        for (int j = 0; j < 4; ++j) cs[j] = rope[pos * 64 + 4 * sb + j];
#pragma unroll
        for (int which = 0; which < 2; ++which) {
            bf16* p = (which ? Kb : Q) + tok * D + h * HD + 4 * sb;
            const u32x2 lo = *(const u32x2*)p, hi = *(const u32x2*)(p + 64);
            float x1[4] = {bflo(lo.x), bfhi(lo.x), bflo(lo.y), bfhi(lo.y)}, x2[4] = {bflo(hi.x), bfhi(hi.x), bflo(hi.y), bfhi(hi.y)};
            float s = 0.f;
#pragma unroll
            for (int j = 0; j < 4; ++j) s += x1[j] * x1[j] + x2[j] * x2[j];
            s += __shfl_xor(s, 1); s += __shfl_xor(s, 2); s += __shfl_xor(s, 4); s += __shfl_xor(s, 8);
            const float rstd = 1.0f / sqrtf(s * (1.f / HD) + RMS_EPS);
            const f32x4 g0 = which ? gk0 : gq0, g1 = which ? gk1 : gq1;
            float o1[4], o2[4];
#pragma unroll
            for (int j = 0; j < 4; ++j) { const float y1 = x1[j] * rstd * g0[j], y2 = x2[j] * rstd * g1[j]; o1[j] = y1 * cs[j].x - y2 * cs[j].y; o2[j] = y2 * cs[j].x + y1 * cs[j].y; }
            u32x2 wlo, whi; wlo.x = pk2(o1[0], o1[1]); wlo.y = pk2(o1[2], o1[3]); whi.x = pk2(o2[0], o2[1]); whi.y = pk2(o2[2], o2[3]);
            { bf16* pw = DRY ? p + (WS_OPART - WS_Q) / 2 : p; *(u32x2*)pw = wlo; *(u32x2*)(pw + 64) = whi; }
            if (which) {
#pragma unroll
                for (int j = 0; j < 4; ++j) { ks[j] += o1[j]; ks[4 + j] += o2[j]; } }
        }
    }
    LAS float* red = (LAS float*)F.lds;
    __syncthreads();
#pragma unroll
    for (int j = 0; j < 8; ++j) red[(F.wave * 64 + F.lane) * 8 + j] = ks[j];
    __syncthreads();
    { const int l = F.tid >> 3, j = F.tid & 7; float s = 0.f;
#pragma unroll
        for (int w = 0; w < 8; ++w) s += red[(w * 64 + l) * 8 + j];
        const int hh = hq * 4 + (l >> 4), s2 = l & 15, d = (j < 4) ? 4 * s2 + j : 64 + 4 * s2 + (j - 4);
        ((float*)(F.ws + (DRY ? WS_OPART + 200 * MiB : WS_KMEAN)))[(((size_t)b * H + hh) * NBLK + n) * HD + d] = s * (1.0f / MBLK); }
    const bf16* V = (const bf16*)(F.ws + WS_V); bf16* Vt = (bf16*)(F.ws + (DRY ? WS_OPART + 128 * MiB : WS_VT));
    LAS bf16* vl = (LAS bf16*)(F.lds + 32768);
    for (int hh = 0; hh < 4; ++hh) {
        const int hv = hq * 4 + hh;
        __syncthreads();
#pragma unroll
        for (int i = 0; i < 8; ++i) { const int ch = F.tid + i * 512, r = ch >> 4, cc = ch & 15;
            const u32x4 w = *(const u32x4*)(V + ((size_t)b * T + n * MBLK + r) * D + hv * HD + cc * 8);
            *(LAS u32x4*)(vl + r * 136 + cc * 8) = w; }
        __syncthreads();
#pragma unroll
        for (int i = 0; i < 8; ++i) { const int idx = F.tid + i * 512, d = idx & 127, tg = idx >> 7;
            unsigned short e[8];
#pragma unroll
            for (int j = 0; j < 8; ++j) e[j] = vl[(tg * 8 + j) * 136 + d];
            u32x4 w; w.x = e[0] | ((unsigned)e[1] << 16); w.y = e[2] | ((unsigned)e[3] << 16); w.z = e[4] | ((unsigned)e[5] << 16); w.w = e[6] | ((unsigned)e[7] << 16);
            *(u32x4*)(Vt + (((size_t)b * H + hv) * HD + d) * T + n * MBLK + tg * 8) = w; }
    }
    __syncthreads();
}

__device__ __forceinline__ void attn_v0_item(Frame& F, int item) {
    const int b = item >> 8, h = (item >> 4) & 15, jb = item & 15;
    const bf16* Q = (const bf16*)(F.ws + WS_Q); const bf16* Kb = (const bf16*)(F.ws + WS_K); const bf16* Vt = (const bf16*)(F.ws + WS_VT); bf16* OA = (bf16*)(F.ws + WS_OA);
    const float* kmean = (const float*)(F.ws + WS_KMEAN) + ((size_t)b * H + h) * NBLK * HD;
    const int lane = F.lane, fr = lane & 15, fq = lane >> 4;
    const size_t tokw = (size_t)b * T + jb * MBLK + F.wave * 32;
    LAS unsigned* maskl = (LAS unsigned*)(F.lds + F.wave * 8192);
    LAS bf16* pl = (LAS bf16*)(F.lds + F.wave * 8192 + 256);
    {
        const int row = lane & 31, half = lane >> 5;
        float g[8];
#pragma unroll
        for (int i = 0; i < 8; ++i) g[i] = 0.f;
        const bf16* qrow = Q + (tokw + row) * D + h * HD;
        for (int dc = 0; dc < 16; ++dc) {
            const u32x4 w = *(const u32x4*)(qrow + dc * 8);
            const float qv[8] = {bflo(w.x), bfhi(w.x), bflo(w.y), bfhi(w.y), bflo(w.z), bfhi(w.z), bflo(w.w), bfhi(w.w)};
#pragma unroll
            for (int i = 0; i < 8; ++i) { const float* km = kmean + (2 * i + half) * HD + dc * 8;
#pragma unroll
                for (int e = 0; e < 8; ++e) g[i] += qv[e] * km[e]; }
        }
        float ga[16];
#pragma unroll
        for (int i = 0; i < 8; ++i) { const float o = __shfl_xor(g[i], 32); ga[2 * i] = half ? o : g[i]; ga[2 * i + 1] = half ? g[i] : o; }
        unsigned mask = 0u;
#pragma unroll
        for (int pick = 0; pick < 3; ++pick) { float best = -INFINITY; int bi = -1;
#pragma unroll
            for (int n = 0; n < 16; ++n) { const bool ok = (n < jb) && !((mask >> n) & 1u); if (ok && ga[n] > best) { best = ga[n]; bi = n; } }
            if (bi >= 0) mask |= 1u << bi; }
        if (half == 0) maskl[row] = mask;
    }
    LDS_WAIT(); __builtin_amdgcn_wave_barrier();
    unsigned rmask[2][4]; unsigned anym = 0u;
#pragma unroll
    for (int rt = 0; rt < 2; ++rt)
#pragma unroll
        for (int r = 0; r < 4; ++r) { rmask[rt][r] = maskl[rt * 16 + 4 * fq + r]; }
    { unsigned m = maskl[lane & 31];
#pragma unroll
      for (int o = 1; o < 32; o <<= 1) m |= __shfl_xor(m, o);
      anym = __builtin_amdgcn_readfirstlane(m); }
    bf16x8 qf[2][4];
#pragma unroll
    for (int rt = 0; rt < 2; ++rt)
#pragma unroll
        for (int ks = 0; ks < 4; ++ks) qf[rt][ks] = *(const bf16x8*)(Q + (tokw + rt * 16 + fr) * D + h * HD + ks * 32 + 8 * fq);
    f32x4 oacc[2][8];
#pragma unroll
    for (int rt = 0; rt < 2; ++rt)
#pragma unroll
        for (int dt = 0; dt < 8; ++dt) oacc[rt][dt] = (f32x4){0.f, 0.f, 0.f, 0.f};
    float lsum[2][4];
#pragma unroll
    for (int rt = 0; rt < 2; ++rt)
#pragma unroll
        for (int r = 0; r < 4; ++r) lsum[rt][r] = 0.f;
    const float c2 = 0.08838834764831845f * 1.4426950408889634f;
    const int nkt = 4 * jb + 4;
    for (int kt = 0; kt < nkt; ++kt) {
        const int n = kt >> 2; const bool own = (n == jb);
        if (!own && !((anym >> n) & 1u)) continue;
        if (own && (kt & 3) * 64 > F.wave * 32 + 31) continue;
        const size_t key0 = (size_t)b * T + kt * 64;
        f32x4 sacc[2][4];
#pragma unroll
        for (int ct = 0; ct < 4; ++ct) {
            bf16x8 kf[4];
#pragma unroll
            for (int ks = 0; ks < 4; ++ks) kf[ks] = *(const bf16x8*)(Kb + (key0 + ct * 16 + fr) * D + h * HD + ks * 32 + 8 * fq);
#pragma unroll
            for (int rt = 0; rt < 2; ++rt) { f32x4 s = (f32x4){0.f, 0.f, 0.f, 0.f};
#pragma unroll
                for (int ks = 0; ks < 4; ++ks) s = __builtin_amdgcn_mfma_f32_16x16x32_bf16(qf[rt][ks], kf[ks], s, 0, 0, 0);
                sacc[rt][ct] = s; }
        }
#pragma unroll
        for (int rt = 0; rt < 2; ++rt)
#pragma unroll
            for (int ct = 0; ct < 4; ++ct)
#pragma unroll
                for (int r = 0; r < 4; ++r) {
                    const int qrow = rt * 16 + 4 * fq + r, kcol = ct * 16 + fr;
                    const bool ok = own ? ((kt & 3) * 64 + kcol <= F.wave * 32 + qrow) : ((rmask[rt][r] >> n) & 1u);
                    const float p = ok ? __builtin_amdgcn_exp2f(sacc[rt][ct][r] * c2) : 0.f;
                    lsum[rt][r] += p;
                    pl[qrow * 72 + kcol] = (bf16)f2bf(p);
                }
        LDS_WAIT(); __builtin_amdgcn_wave_barrier();
        bf16x8 pf[2][2];
#pragma unroll
        for (int rt = 0; rt < 2; ++rt)
#pragma unroll
            for (int k2 = 0; k2 < 2; ++k2) pf[rt][k2] = *(const LAS bf16x8*)(pl + (rt * 16 + fr) * 72 + k2 * 32 + 8 * fq);
#pragma unroll
        for (int dt = 0; dt < 8; ++dt) {
            bf16x8 vf[2];
#pragma unroll
            for (int k2 = 0; k2 < 2; ++k2) vf[k2] = *(const bf16x8*)(Vt + (((size_t)b * H + h) * HD + dt * 16 + fr) * T + kt * 64 + k2 * 32 + 8 * fq);
#pragma unroll
            for (int rt = 0; rt < 2; ++rt)
#pragma unroll
                for (int k2 = 0; k2 < 2; ++k2) oacc[rt][dt] = __builtin_amdgcn_mfma_f32_16x16x32_bf16(pf[rt][k2], vf[k2], oacc[rt][dt], 0, 0, 0);
        }
        LDS_WAIT(); __builtin_amdgcn_wave_barrier();
    }
#pragma unroll
    for (int rt = 0; rt < 2; ++rt)
#pragma unroll
        for (int r = 0; r < 4; ++r) { float s = lsum[rt][r]; s += __shfl_xor(s, 1); s += __shfl_xor(s, 2); s += __shfl_xor(s, 4); s += __shfl_xor(s, 8); const float inv = 1.0f / s;
            bf16* orow = OA + (tokw + rt * 16 + 4 * fq + r) * D + h * HD + fr;
#pragma unroll
            for (int dt = 0; dt < 8; ++dt) orow[dt * 16] = (bf16)f2bf(oacc[rt][dt][r] * inv); }
}

typedef float f32x16 __attribute__((ext_vector_type(16)));
template <bool DRY> __device__ __forceinline__ void moba_gate_item(Frame& F, int item) {
    const int bh = item >> 3, p = item & 7, b = bh >> 4, h = bh & 15;
    LAS float* km = (LAS float*)F.lds;
    __syncthreads();
    { const f32x4 v = ((const f32x4*)((const float*)(F.ws + WS_KMEAN) + (size_t)bh * NBLK * HD))[F.tid]; ((LAS f32x4*)km)[F.tid] = v; }
    __syncthreads();
    const int j = 2 * p + (F.wave >> 2), t = j * MBLK + (F.wave & 3) * 64 + F.lane;
    if (j == 0) return;
    const unsigned char* qrow = F.ws + WS_Q + ((size_t)b * T + t) * D + h * HD;
    float g[16];
#pragma unroll
    for (int n = 0; n < 16; ++n) g[n] = 0.f;
    for (int dc = 0; dc < 8; ++dc) {
        const u32x4 w = *(const u32x4*)(qrow + dc * 16);
        float qv[16]; { float t4[4]; fp8x4_to_f32(w.x, t4); qv[0] = t4[0]; qv[1] = t4[1]; qv[2] = t4[2]; qv[3] = t4[3]; fp8x4_to_f32(w.y, t4); qv[4] = t4[0]; qv[5] = t4[1]; qv[6] = t4[2]; qv[7] = t4[3];
            fp8x4_to_f32(w.z, t4); qv[8] = t4[0]; qv[9] = t4[1]; qv[10] = t4[2]; qv[11] = t4[3]; fp8x4_to_f32(w.w, t4); qv[12] = t4[0]; qv[13] = t4[1]; qv[14] = t4[2]; qv[15] = t4[3]; }
#pragma unroll
        for (int n = 0; n < 15; ++n) if (n < j) {
#pragma unroll
            for (int q4 = 0; q4 < 4; ++q4) { const f32x4 k0 = *(const LAS f32x4*)(km + n * HD + dc * 16 + 4 * q4);
                g[n] += (qv[4 * q4] * k0.x + qv[4 * q4 + 1] * k0.y) + (qv[4 * q4 + 2] * k0.z + qv[4 * q4 + 3] * k0.w); } }
    }
    int pk[3];
    unsigned mask = 0u;
#pragma unroll
    for (int pick = 0; pick < 3; ++pick) { float best = -INFINITY; int bi = -1;
#pragma unroll
        for (int n = 0; n < 15; ++n) { const bool ok = (n < j) && !((mask >> n) & 1u); if (ok && g[n] > best) { best = g[n]; bi = n; } }
        if (bi >= 0) mask |= 1u << bi;
        pk[pick] = bi; }
    unsigned* acnt = F.ctl + CW_ACNT + bh * 16; int* alist = (int*)(F.ws + WS_ALIST) + (size_t)bh * 16 * ALIST_CAP;
    unsigned mycnt = 0u;
#pragma unroll
    for (int n = 0; n < 15; ++n) if (n < j) { const unsigned long long bal = __ballot((mask >> n) & 1u); mycnt = (F.lane == n) ? (unsigned)__popcll(bal) : mycnt; }
    unsigned mybase = 0u;
    if (F.lane < 15 && mycnt > 0u && !DRY) mybase = atomicAdd(acnt + F.lane, mycnt);
#pragma unroll
    for (int n = 0; n < 15; ++n) if (n < j) {
        const bool sel = (mask >> n) & 1u; const int slot = (pk[0] == n) ? 0 : ((pk[1] == n) ? 1 : 2);
        const unsigned long long bal = __ballot(sel);
        if (bal) { const unsigned base = (unsigned)__builtin_amdgcn_readlane((int)mybase, n);
            const int rank = __popcll(bal & ((1ull << F.lane) - 1ull));
            if (sel) (DRY ? (int*)(F.ws + WS_OPART) : alist)[n * ALIST_CAP + base + rank] = t | (slot << 16); }
    }
}

constexpr int AL_K = 0, AL_V = 36864; constexpr float SC_P = 4.f;
typedef int i32x8v __attribute__((ext_vector_type(8)));
__device__ __forceinline__ i32x8v ld32(const LAS unsigned char* p) { const u32x4 a = *(const LAS u32x4*)p, b = *(const LAS u32x4*)(p + 16); i32x8v r; r[0] = a.x; r[1] = a.y; r[2] = a.z; r[3] = a.w; r[4] = b.x; r[5] = b.y; r[6] = b.z; r[7] = b.w; return r; }
template <bool OWN> __device__ __forceinline__ void attn_chunk(Frame& F, int b, int h, int n, int c, int cnt, const int* lst) {
    const int lane = F.lane, qi = lane & 31, hh = lane >> 5, w = F.wave;
    const int rem = OWN ? MBLK : cnt - c * 256;
    if (w * 32 >= rem) return;
    int t, slot; bool valid = true;
    if (OWN) { t = n * MBLK + w * 32 + qi; slot = 3; }
    else { const int idx = w * 32 + qi; valid = idx < rem; const int e = lst[c * 256 + (valid ? idx : 0)]; t = e & 0xffff; slot = e >> 16; }
    const size_t tok = (size_t)b * T + t;
    const unsigned char* qrow = F.ws + WS_Q + tok * D + h * HD;
    i32x8v qf[2];
#pragma unroll
    for (int ks = 0; ks < 2; ++ks) { const u32x4 a = *(const u32x4*)(qrow + 64 * ks + 32 * hh), bq = *(const u32x4*)(qrow + 64 * ks + 32 * hh + 16);
        qf[ks][0] = a.x; qf[ks][1] = a.y; qf[ks][2] = a.z; qf[ks][3] = a.w; qf[ks][4] = bq.x; qf[ks][5] = bq.y; qf[ks][6] = bq.z; qf[ks][7] = bq.w; }
    const LAS unsigned char* Kl = F.lds + AL_K; const LAS unsigned char* Vl = F.lds + AL_V;
    f32x16 oacc[4];
#pragma unroll
    for (int dt = 0; dt < 4; ++dt)
#pragma unroll
        for (int r = 0; r < 16; ++r) oacc[dt][r] = 0.f;
    float lsum = 0.f, mrun = -1e30f;
    const float c2 = 0.08838834764831845f * 1.4426950408889634f / (SC_QKV * SC_QKV);
    const int ngrp = OWN ? ((w >> 1) + 1) : 4;
#pragma unroll
    for (int G = 0; G < 4; ++G) {
        if (G >= ngrp) break;
        f32x16 sa, sb;
#pragma unroll
        for (int r = 0; r < 16; ++r) { sa[r] = 0.f; sb[r] = 0.f; }
#pragma unroll
        for (int ks = 0; ks < 2; ++ks) {
            const i32x8v ka = ld32(Kl + (64 * G + qi) * 144 + 64 * ks + 32 * hh), kb = ld32(Kl + (64 * G + 32 + qi) * 144 + 64 * ks + 32 * hh);
            sa = __builtin_amdgcn_mfma_scale_f32_32x32x64_f8f6f4(ka, qf[ks], sa, 0, 0, 0, 0, 0, 0);
            sb = __builtin_amdgcn_mfma_scale_f32_32x32x64_f8f6f4(kb, qf[ks], sb, 0, 0, 0, 0, 0, 0);
        }
        float tv[32];
#pragma unroll
        for (int r = 0; r < 16; ++r) { tv[r] = sa[r]; tv[16 + r] = sb[r]; }
        if (OWN && G == (w >> 1)) {
#pragma unroll
            for (int p = 0; p < 32; ++p) { const int key = 64 * G + 32 * (p >> 4) + (p & 3) + 8 * ((p >> 2) & 3) + 4 * hh; tv[p] = (key <= w * 32 + qi) ? tv[p] : -3e38f; }
        }
        float ml = tv[0];
#pragma unroll
        for (int p = 1; p < 32; ++p) ml = fmaxf(ml, tv[p]);
        ml = fmaxf(ml, __shfl_xor(ml, 32)) * c2;
        const float mnew = (ml > mrun + 6.0f) ? ml : mrun;
        const bool moved = (mnew != mrun);
        const float alpha = __builtin_amdgcn_exp2f(mrun - mnew);
        mrun = mnew;
        float ps = 0.f; i32x8v pf;
#pragma unroll
        for (int q4 = 0; q4 < 8; ++q4) { float e4[4];
#pragma unroll
            for (int j = 0; j < 4; ++j) { e4[j] = __builtin_amdgcn_exp2f(__builtin_fmaf(tv[4 * q4 + j], c2, -mnew)); ps += e4[j]; }
            int pw_ = __builtin_amdgcn_cvt_pk_fp8_f32(e4[0] * SC_P, e4[1] * SC_P, 0, false); pw_ = __builtin_amdgcn_cvt_pk_fp8_f32(e4[2] * SC_P, e4[3] * SC_P, pw_, true); pf[q4] = pw_; }
        lsum = lsum * alpha + ps;
        if (G > 0 && __any(moved)) {
#pragma unroll
            for (int dt = 0; dt < 4; ++dt)
#pragma unroll
                for (int r = 0; r < 16; ++r) oacc[dt][r] *= alpha;
        }
#pragma unroll
        for (int dt = 0; dt < 4; ++dt) {
            const i32x8v vf = ld32(Vl + (32 * dt + qi) * 272 + 64 * G + 32 * hh);
            oacc[dt] = __builtin_amdgcn_mfma_scale_f32_32x32x64_f8f6f4(vf, pf, oacc[dt], 0, 0, 0, 0, 0, 0);
        }
    }
    lsum += __shfl_xor(lsum, 32);
    if (valid) {
        unsigned char* op = F.ws + WS_OPART + ((size_t)slot * M + tok) * D + h * HD;
        const float pinv = __builtin_amdgcn_rcpf(lsum) * (SC_PART / (SC_QKV * SC_P));
        unsigned wq[4][4];
#pragma unroll
        for (int dt = 0; dt < 4; ++dt)
#pragma unroll
            for (int g4 = 0; g4 < 4; ++g4) wq[dt][g4] = pk4_fp8(oacc[dt][4 * g4 + 0] * pinv, oacc[dt][4 * g4 + 1] * pinv, oacc[dt][4 * g4 + 2] * pinv, oacc[dt][4 * g4 + 3] * pinv);
        u32x4 st[4];
#pragma unroll
        for (int d2 = 0; d2 < 2; ++d2)
#pragma unroll
            for (int g4 = 0; g4 < 4; ++g4) { const unsigned give = hh ? wq[d2][g4] : wq[2 + d2][g4], keep = hh ? wq[2 + d2][g4] : wq[d2][g4];
                const unsigned got = (unsigned)__shfl_xor((int)give, 32);
                const unsigned w_even = hh ? got : keep, w_odd = hh ? keep : got;
                st[2 * d2 + (g4 >> 1)][2 * (g4 & 1)] = w_even; st[2 * d2 + (g4 >> 1)][2 * (g4 & 1) + 1] = w_odd; }
#pragma unroll
        for (int q = 0; q < 4; ++q) *(u32x4*)(op + 64 * hh + 16 * q) = st[q];
        if (hh == 0) { f32x2 lm; lm.x = lsum; lm.y = mrun; ((f32x2*)(F.ws + WS_LPART))[((size_t)slot * M + tok) * H + h] = lm; }
    }
}
__device__ __forceinline__ void attn_group(Frame& F, int bh, int n) {
    const int b = bh >> 4, h = bh & 15;
    const gcptr Kg = opaque_s(F.ws + WS_K + ((size_t)b * T + n * MBLK) * D + h * HD);
    const gcptr Vg = opaque_s(F.ws + WS_V + ((size_t)b * T + n * MBLK) * D + h * HD);
    const int tg = make_tid(F.wave);
    __syncthreads();
#pragma unroll
    for (int i = 0; i < 4; ++i) { const int ch = tg + i * 512;
        { const int r = ch >> 3, cc = ch & 7; *(LAS u32x4*)(F.lds + AL_K + r * 144 + cc * 16) = *(const GAS u32x4*)(Kg + (unsigned)(r * D + cc * 16)); }
        { const int rl = ch & 63, cc = (ch >> 6) & 7, G = ch >> 9, r = 64 * G + rl;
          const u32x4 vv = *(const GAS u32x4*)(Vg + (unsigned)(r * D + cc * 16)); const unsigned vw[4] = {vv.x, vv.y, vv.z, vv.w};
          LAS unsigned char* vd = F.lds + AL_V + (16 * cc) * 272 + 64 * G + 32 * ((rl >> 2) & 1) + 4 * (rl >> 3) + (rl & 3);
#pragma unroll
          for (int e = 0; e < 16; ++e) vd[e * 272] = (unsigned char)(vw[e >> 2] >> (8 * (e & 3))); }
    }
    __syncthreads();
    attn_chunk<true>(F, b, h, n, 0, 0, nullptr);
    if (n < 15) {
        const int cnt = (int)__hip_atomic_load(F.ctl + CW_ACNT + bh * 16 + n, __ATOMIC_RELAXED, __HIP_MEMORY_SCOPE_AGENT);
        const int* lst = (const int*)(F.ws + WS_ALIST) + ((size_t)bh * 16 + n) * ALIST_CAP;
        for (int c = 0; c * 256 < cnt; ++c) attn_chunk<false>(F, b, h, n, c, cnt, lst);
    }
}
struct AttnCombRegs { f32x2 lm[4]; u32x4 w[4][2]; };
__device__ __forceinline__ void attn_combine_load(Frame& F, int tok, AttnCombRegs& R) {
    const int j = (tok & (T - 1)) >> 8, nsl = j < 3 ? j : 3, hd = F.lane >> 2;
#pragma unroll
    for (int s4 = 0; s4 < 4; ++s4) { const bool valid = (s4 == 0) || (s4 - 1 < nsl); const int s_ = valid ? ((s4 == 0) ? 3 : s4 - 1) : 3;
        R.lm[s4] = ((const f32x2*)(F.ws + WS_LPART))[((size_t)s_ * M + tok) * H + hd];
        const u32x4* p = (const u32x4*)(F.ws + WS_OPART + ((size_t)s_ * M + tok) * D + F.lane * 32); R.w[s4][0] = p[0]; R.w[s4][1] = p[1]; }
}
__device__ __forceinline__ void attn_combine_finish(Frame& F, int tok, const AttnCombRegs& R) {
    const int j = (tok & (T - 1)) >> 8, nsl = j < 3 ? j : 3;
    f32x2 lm[4]; float mx = -1e30f;
#pragma unroll
    for (int s4 = 0; s4 < 4; ++s4) { const bool valid = (s4 == 0) || (s4 - 1 < nsl); lm[s4] = valid ? R.lm[s4] : (f32x2){0.f, -1e30f}; mx = fmaxf(mx, lm[s4].y); }
    float acc[32]; float l = 0.f;
#pragma unroll
    for (int i = 0; i < 32; ++i) acc[i] = 0.f;
#pragma unroll
    for (int s4 = 0; s4 < 4; ++s4) {
        const float ls = lm[s4].x * __builtin_amdgcn_exp2f(lm[s4].y - mx);
        const u32x4 w0 = R.w[s4][0], w1 = R.w[s4][1]; const unsigned wd[8] = {w0.x, w0.y, w0.z, w0.w, w1.x, w1.y, w1.z, w1.w};
#pragma unroll
        for (int i = 0; i < 8; ++i) { const f32x2 lo = __builtin_amdgcn_cvt_pk_f32_fp8((int)wd[i], false), hi = __builtin_amdgcn_cvt_pk_f32_fp8((int)wd[i], true);
            acc[4 * i] += lo.x * ls; acc[4 * i + 1] += lo.y * ls; acc[4 * i + 2] += hi.x * ls; acc[4 * i + 3] += hi.y * ls; }
        l += ls; }
    const float inv = __builtin_amdgcn_rcpf(l) * (1.0f / SC_PART);
    if (FP8_OUTB) { const float iv = inv * SC_OA; u32x4* o8 = (u32x4*)(F.ws + WS_OA + (size_t)tok * D + F.lane * 32);
#pragma unroll
        for (int i = 0; i < 2; ++i) { u32x4 w; w.x = pk4_fp8(acc[16 * i] * iv, acc[16 * i + 1] * iv, acc[16 * i + 2] * iv, acc[16 * i + 3] * iv); w.y = pk4_fp8(acc[16 * i + 4] * iv, acc[16 * i + 5] * iv, acc[16 * i + 6] * iv, acc[16 * i + 7] * iv);
            w.z = pk4_fp8(acc[16 * i + 8] * iv, acc[16 * i + 9] * iv, acc[16 * i + 10] * iv, acc[16 * i + 11] * iv); w.w = pk4_fp8(acc[16 * i + 12] * iv, acc[16 * i + 13] * iv, acc[16 * i + 14] * iv, acc[16 * i + 15] * iv); o8[i] = w; }
        return; }
    u32x4* o = (u32x4*)((bf16*)(F.ws + WS_OA) + (size_t)tok * D + F.lane * 32);
#pragma unroll
    for (int i = 0; i < 4; ++i) { u32x4 w; w.x = pk2(acc[8 * i] * inv, acc[8 * i + 1] * inv); w.y = pk2(acc[8 * i + 2] * inv, acc[8 * i + 3] * inv); w.z = pk2(acc[8 * i + 4] * inv, acc[8 * i + 5] * inv); w.w = pk2(acc[8 * i + 6] * inv, acc[8 * i + 7] * inv); o[i] = w; }
}
__device__ __forceinline__ void attn_combine_tokens(Frame& F, int t0, int stride) {
    static_assert(SC_PART > 0, "");
    AttnCombRegs A, B;
    int t = t0; if (t >= M) return;
    attn_combine_load(F, t, A);
    for (;;) {
        const int tn = t + stride; const bool more = tn < M;
        if (more) attn_combine_load(F, tn, B);
        attn_combine_finish(F, t, A);
        if (!more) break;
        A = B; t = tn;
    }
}
constexpr size_t WS_SLOC = WS_ORAW;
constexpr size_t WS_DLOG = WS_ORAW + 16 * MiB;
constexpr int HL_A = 0, HL_BM = 17408, HL_BMT = 34816, HL_VT = 53248, HL_SPT = 71680, HL_P = 106496, HL_EGR = 115712, HL_EEND = 116224, HL_QSUM = 116736, HL_SSQ = 118784,
              HL_STQ = HL_SPT, HL_STK = HL_SPT + 17408, HL_STG = 119808, HL_STV = 119808 + 17408;
#define HG_BAR() do { asm volatile("s_waitcnt lgkmcnt(0)" ::: "memory"); __builtin_amdgcn_s_barrier(); asm volatile("" ::: "memory"); } while (0)
template <bool FULL> __device__ __forceinline__ void hgrn_item(Frame& F, CArgs& a, int item) {
    const int bh = item >> 2, seg = item & 3, b = bh >> 4, h = bh & 15;
    if (!FULL && seg == 3) return;
    const int lane = F.lane, qi = lane & 31, hh = lane >> 5, w = F.wave;
    const int kk = F.tid & 127, tq = F.tid >> 7;
    const int vt = w & 3, ktb = 2 * (w >> 2);
    const bf16* Zq = (const bf16*)(F.ws + WS_ZQ); const bf16* Zk = (const bf16*)(F.ws + WS_ZK); const _Float16* Zg = (const _Float16*)(F.ws + WS_ZG); const bf16* Zv = (const bf16*)(F.ws + WS_ZV);
    LAS unsigned char* L = F.lds;
    LAS float* eGr = (LAS float*)(L + HL_EGR); LAS float* eEnd = (LAS float*)(L + HL_EEND); LAS float* qsum = (LAS float*)(L + HL_QSUM); LAS float* ssq = (LAS float*)(L + HL_SSQ);
    f32x16 S[2];
#pragma unroll
    for (int i = 0; i < 2; ++i)
#pragma unroll
        for (int r = 0; r < 16; ++r) S[i][r] = 0.f;
    if (FULL && seg > 0) {
        const float* sl = (const float*)(F.ws + WS_SLOC) + (size_t)bh * 3 * HD * HD; const float* dl = (const float*)(F.ws + WS_DLOG) + (size_t)bh * 3 * HD;
        LAS float* fac = (LAS float*)(L + 65536);
        __syncthreads();
        if (F.tid < 128) { float dsum = 0.f;
#pragma unroll
            for (int s_ = 2; s_ >= 0; --s_) { const bool v_ = s_ < seg; fac[s_ * HD + F.tid] = v_ ? __expf(dsum) : 0.f; if (v_) dsum += dl[s_ * HD + F.tid]; } }
        __syncthreads();
#pragma unroll 1
        for (int s_ = 0; s_ < seg; ++s_) {
            const int se = s_;
            gcptr tb = opaque_s(sl + (size_t)se * HD * HD); const unsigned vo = (unsigned)(((4 * hh) * HD + 32 * vt + qi) * 4); const LAS float* fl = fac + s_ * HD + 4 * hh;
#pragma unroll
            for (int i = 0; i < 2; ++i)
#pragma unroll
                for (int r = 0; r < 16; ++r) { const int dkc = 32 * (ktb + i) + (r & 3) + 8 * (r >> 2); S[i][r] += fl[dkc] * *(const GAS float*)(tb + vo + (unsigned)(dkc * HD * 4)); }
            asm volatile("" ::: "memory"); __builtin_amdgcn_sched_barrier(0);
        }
    }
    float gtot = 0.f;
    u32x4 rq[2], rk[2], rg[2], rv[2];
#define HG_PREFETCH(cc) do { const size_t tk_ = (size_t)b * T + (size_t)(seg * 16 + (cc)) * 64; _Pragma("unroll") for (int i_ = 0; i_ < 2; ++i_) { const int row_ = 16 * (w >> 1) + (lane >> 3) + 8 * i_, ch_ = 8 * (w & 1) + (lane & 7); const size_t go_ = (tk_ + row_) * D + h * HD + ch_ * 8; \
        rk[i_] = *(const u32x4*)(Zk + go_); rg[i_] = *(const u32x4*)((const bf16*)Zg + go_); rv[i_] = *(const u32x4*)(Zv + go_); if (FULL) rq[i_] = *(const u32x4*)(Zq + go_); } } while (0)
    HG_PREFETCH(0);
    __syncthreads();
    for (int c = 0; c < 16; ++c) {
        const size_t tok0 = (size_t)b * T + (size_t)(seg * 16 + c) * 64;
#pragma unroll
        for (int i = 0; i < 2; ++i) { const int so = (16 * (w >> 1) + (lane >> 3) + 8 * i) * 272 + (8 * (w & 1) + (lane & 7)) * 16;
            *(LAS u32x4*)(L + HL_STK + so) = rk[i]; *(LAS u32x4*)(L + HL_STG + so) = rg[i]; *(LAS u32x4*)(L + HL_STV + so) = rv[i]; if (FULL) *(LAS u32x4*)(L + HL_STQ + so) = rq[i]; }
        LDS_WAIT();
        float gl[16];
        { float run = 0.f;
#pragma unroll
            for (int i = 0; i < 16; ++i) { run += (float)*(const LAS _Float16*)(L + HL_STG + (16 * tq + i) * 272 + kk * 2); gl[i] = run; }
            qsum[tq * 128 + kk] = run; }
        HG_BAR();
        {
            const float q0 = qsum[kk], q1 = qsum[128 + kk], q2 = qsum[256 + kk], q3 = qsum[384 + kk];
            const float pre = (tq > 0 ? q0 : 0.f) + (tq > 1 ? q1 : 0.f) + (tq > 2 ? q2 : 0.f), Gr = q0 + q1, Gend = (q0 + q1) + (q2 + q3);
            unsigned bt[8], vtw[8];
#pragma unroll
            for (int i = 0; i < 16; i += 2) {
                const int t0 = 16 * tq + i;
                const float G0 = pre + gl[i], G1 = pre + gl[i + 1];
                const float eb0 = __expf(Gr - G0), eb1 = __expf(Gr - G1);
                const float b0 = bf2f(*(const LAS bf16*)(L + HL_STK + t0 * 272 + kk * 2)) * eb0, b1 = bf2f(*(const LAS bf16*)(L + HL_STK + (t0 + 1) * 272 + kk * 2)) * eb1;
                bt[i >> 1] = pk2(b0, b1);
                vtw[i >> 1] = (unsigned)*(const LAS bf16*)(L + HL_STV + t0 * 272 + kk * 2) | ((unsigned)*(const LAS bf16*)(L + HL_STV + (t0 + 1) * 272 + kk * 2) << 16);
                if (FULL) { const float ea0 = __expf(G0 - Gr), ea1 = __expf(G1 - Gr);
                    const float qa = bf2f(*(const LAS bf16*)(L + HL_STQ + t0 * 272 + kk * 2)), qb = bf2f(*(const LAS bf16*)(L + HL_STQ + (t0 + 1) * 272 + kk * 2));
                    *(LAS bf16*)(L + HL_A + t0 * 272 + kk * 2) = (bf16)f2bf(qa * ea0); *(LAS bf16*)(L + HL_A + (t0 + 1) * 272 + kk * 2) = (bf16)f2bf(qb * ea1);
                    *(LAS bf16*)(L + HL_BM + t0 * 272 + kk * 2) = (bf16)(bt[i >> 1] & 0xffffu); *(LAS bf16*)(L + HL_BM + (t0 + 1) * 272 + kk * 2) = (bf16)(bt[i >> 1] >> 16); }
                __builtin_amdgcn_sched_barrier(0);
            }
            *(LAS u32x4*)(L + HL_BMT + kk * 144 + tq * 32) = (u32x4){bt[0], bt[1], bt[2], bt[3]}; *(LAS u32x4*)(L + HL_BMT + kk * 144 + tq * 32 + 16) = (u32x4){bt[4], bt[5], bt[6], bt[7]};
            *(LAS u32x4*)(L + HL_VT + kk * 144 + tq * 32) = (u32x4){vtw[0], vtw[1], vtw[2], vtw[3]}; *(LAS u32x4*)(L + HL_VT + kk * 144 + tq * 32 + 16) = (u32x4){vtw[4], vtw[5], vtw[6], vtw[7]};
            if (tq == 0) { eGr[kk] = __expf(Gr); eEnd[kk] = __expf(Gend - Gr); }
            gtot += Gend;
        }
        HG_BAR();
        if (c + 1 < 16) HG_PREFETCH(c + 1);
#pragma unroll
        for (int i = 0; i < 2; ++i)
#pragma unroll
            for (int g4 = 0; g4 < 4; ++g4) { const int dk0 = 32 * (ktb + i) + 8 * g4 + 4 * hh; const f32x4 e = *(const LAS f32x4*)(eGr + dk0);
#pragma unroll
                for (int j = 0; j < 4; ++j) S[i][4 * g4 + j] *= e[j];
                if (FULL) { u32x2 wv; wv.x = pg8::cvt_pk_bf16_n(S[i][4 * g4], S[i][4 * g4 + 1]); wv.y = pg8::cvt_pk_bf16_n(S[i][4 * g4 + 2], S[i][4 * g4 + 3]);
                    *(LAS u32x2*)(L + HL_SPT + (32 * vt + qi) * 272 + dk0 * 2) = wv; } }
        if (FULL && w < 3) {
            const int st = (w == 2) ? 1 : 0, tt = (w == 0) ? 0 : 1;
            f32x16 sc;
#pragma unroll
            for (int r = 0; r < 16; ++r) sc[r] = 0.f;
#pragma unroll
            for (int ks = 0; ks < 8; ++ks) { const bf16x8 af = *(const LAS bf16x8*)(L + HL_BM + (32 * st + qi) * 272 + (16 * ks + 8 * hh) * 2); const bf16x8 bfr = *(const LAS bf16x8*)(L + HL_A + (32 * tt + qi) * 272 + (16 * ks + 8 * hh) * 2);
                sc = __builtin_amdgcn_mfma_f32_32x32x16_bf16(af, bfr, sc, 0, 0, 0); }
#pragma unroll
            for (int g4 = 0; g4 < 4; ++g4) { const int s0 = 32 * st + 8 * g4 + 4 * hh, t = 32 * tt + qi; float p[4];
#pragma unroll
                for (int j = 0; j < 4; ++j) p[j] = sc[4 * g4 + j] * __builtin_amdgcn_fmed3f((float)(t - (s0 + j) + 1), 0.f, 1.f);
                u32x2 wv; wv.x = pg8::cvt_pk_bf16_n(p[0], p[1]); wv.y = pg8::cvt_pk_bf16_n(p[2], p[3]);
                *(LAS u32x2*)(L + HL_P + t * 144 + s0 * 2) = wv; }
        }
#pragma unroll
        for (int ks2 = 0; ks2 < 4; ++ks2) { const bf16x8 vf = *(const LAS bf16x8*)(L + HL_VT + (32 * vt + qi) * 144 + (16 * ks2 + 8 * hh) * 2);
#pragma unroll
            for (int i = 0; i < 2; ++i) { const bf16x8 bf_ = *(const LAS bf16x8*)(L + HL_BMT + (32 * (ktb + i) + qi) * 144 + (16 * ks2 + 8 * hh) * 2);
                S[i] = __builtin_amdgcn_mfma_f32_32x32x16_bf16(bf_, vf, S[i], 0, 0, 0); } }
#pragma unroll
        for (int i = 0; i < 2; ++i)
#pragma unroll
            for (int g4 = 0; g4 < 4; ++g4) { const int dk0 = 32 * (ktb + i) + 8 * g4 + 4 * hh; const f32x4 e = *(const LAS f32x4*)(eEnd + dk0);
#pragma unroll
                for (int j = 0; j < 4; ++j) S[i][4 * g4 + j] *= e[j]; }
        if (FULL) {
            HG_BAR();
            const int tt = w & 1, dt = w >> 1, t = 32 * tt + qi;
            u32x2 gtv[4];
            { const size_t ro_ = (tok0 + t) * D + h * HD;
#pragma unroll
              for (int g4 = 0; g4 < 4; ++g4) gtv[g4] = *(const u32x2*)((const bf16*)(F.ws + WS_ZGATE) + ro_ + 32 * dt + 8 * g4 + 4 * hh); }
            f32x16 o;
#pragma unroll
            for (int r = 0; r < 16; ++r) o[r] = 0.f;
#pragma unroll
            for (int ks = 0; ks < 8; ++ks) { const bf16x8 af = *(const LAS bf16x8*)(L + HL_SPT + (32 * dt + qi) * 272 + (16 * ks + 8 * hh) * 2); const bf16x8 bfr = *(const LAS bf16x8*)(L + HL_A + t * 272 + (16 * ks + 8 * hh) * 2);
                o = __builtin_amdgcn_mfma_f32_32x32x16_bf16(af, bfr, o, 0, 0, 0); }
#pragma unroll
            for (int ks2 = 0; ks2 < 4; ++ks2) if (ks2 < 2 * (tt + 1)) { const bf16x8 af = *(const LAS bf16x8*)(L + HL_VT + (32 * dt + qi) * 144 + (16 * ks2 + 8 * hh) * 2); const bf16x8 bfr = *(const LAS bf16x8*)(L + HL_P + t * 144 + (16 * ks2 + 8 * hh) * 2);
                o = __builtin_amdgcn_mfma_f32_32x32x16_bf16(af, bfr, o, 0, 0, 0); }
            float sq = 0.f;
#pragma unroll
            for (int r = 0; r < 16; ++r) sq += o[r] * o[r];
            sq += __shfl_xor(sq, 32);
            if (hh == 0) ssq[dt * 64 + t] = sq;
            HG_BAR();
            const float tot = (ssq[t] + ssq[64 + t]) + (ssq[128 + t] + ssq[192 + t]);
            const float rstd = __builtin_amdgcn_rsqf(tot * (1.f / HD) + RMS_EPS);
            const size_t ro = (tok0 + t) * D + h * HD;
#pragma unroll
            for (int g4 = 0; g4 < 4; ++g4) { const int dv0 = 32 * dt + 8 * g4 + 4 * hh;
                const u32x2 gt = gtv[g4]; const f32x4 gn = *(const f32x4*)(a.in[I_A_OGAIN] + dv0);
                const float r8 = rstd * SC_OH;
                *(unsigned*)(F.ws + WS_OH + ro + dv0) = pk4_fp8(o[4 * g4] * r8 * gn.x * bflo(gt.x), o[4 * g4 + 1] * r8 * gn.y * bfhi(gt.x), o[4 * g4 + 2] * r8 * gn.z * bflo(gt.y), o[4 * g4 + 3] * r8 * gn.w * bfhi(gt.y)); }
        }
    }
#undef HG_PREFETCH
    if (!FULL) {
        float* sl = (float*)(F.ws + WS_SLOC) + ((size_t)bh * 3 + seg) * HD * HD;
#pragma unroll
        for (int i = 0; i < 2; ++i)
#pragma unroll
            for (int r = 0; r < 16; ++r) { const int dk = 32 * (ktb + i) + (r & 3) + 8 * (r >> 2) + 4 * hh; sl[(size_t)dk * HD + 32 * vt + qi] = S[i][r]; }
        if (tq == 0) ((float*)(F.ws + WS_DLOG))[((size_t)bh * 3 + seg) * HD + kk] = gtot;
    }
    __syncthreads();
}

constexpr int N_PHASES = 19;
#ifndef CV_TAIL1
#define CV_TAIL1 8192
#endif
#ifndef REP_MASK
#define REP_MASK 0
#endif
#define NREP(k) ((((REP_MASK) >> (k)) & 1) ? 2 : 1)
__global__ void __launch_bounds__(NTHR, 2) fwd(Args args_kernarg) {
    extern __shared__ __attribute__((aligned(16))) unsigned char lds_raw[];
    Frame F;
    CArgs* pa = (CArgs*)__builtin_amdgcn_kernarg_segment_ptr();
#define args (*pa)
    F.lds = (LAS unsigned char*)lds_raw; F.ws = args.ws; F.ctl = (unsigned*)(args.ws + WS_CTL);
    F.wave = __builtin_amdgcn_readfirstlane((int)threadIdx.x >> 6); F.tid = make_tid(F.wave); F.lane = F.tid & 63;
    F.G = gridDim.x; { const int bx = blockIdx.x; F.vcu = (F.G % 8 == 0) ? (bx % 8) * (F.G / 8) + bx / 8 : bx; }
    F.gw = F.vcu * NWAVES + F.wave; F.NGW = F.G * NWAVES;
    for (int u = F.tid; u < (LDS_BYTES - LDSCTL_OFF) / 4; u += NTHR) ((LAS unsigned*)(F.lds + LDSCTL_OFF))[u] = 0u;
    __syncthreads();
    const int lo = args.ph_lo, hi = args.ph_hi;
    const bool multi = (hi - lo) > 1;
    XcdBarrier bar; bar.bar = F.ctl + CW_BAR; bar.x = 0; bar.st = nullptr;
    if (multi) bar = xcd_barrier_post(F.ctl + CW_BAR, (volatile LAS unsigned*)(F.lds + LDSCTL_OFF), F.tid);
#define REFRESH() do { pa = (CArgs*)__builtin_amdgcn_kernarg_segment_ptr(); asm volatile("" : "+s"(pa)); ws = args.ws; F.ws = ws; F.ctl = (unsigned*)(ws + WS_CTL); const int t_ = make_tid(F.wave); F.tid = t_; F.lane = t_ & 63; F.gw = F.vcu * NWAVES + F.wave; } while (0)
#define IN(k) (lo <= (k) && (k) < hi)
#define SEAM(k) do { if (IN(k) && IN((k) + 1)) xcd_barrier(bar, make_tid(F.wave)); } while (0)
    unsigned char* ws = args.ws;
    (void)args_kernarg;
    const int GT = F.NGW * 64;

    if (IN(0)) _Pragma("unroll") for (int rep_ = 0; rep_ < NREP(0); ++rep_) { REFRESH();
        const int gtid = F.gw * 64 + F.lane;
        LAS float* scr = (LAS float*)(F.lds + F.wave * TR_SCR_BYTES);
        constexpr int J0 = 16 * 256;
        tr_run([&](int it) { TrItem t; t.src = args.in[I_A_W_IN]; t.ksc = args.in[I_NORM_MIX]; t.dst = ws + WS_WIN; t.N = 4 * D; t.K = D; t.k0 = 128 * (it / 256); t.n0 = 32 * (it % 256); t.drow0 = t.n0; t.flags = 0; t.osc = 1.f; return t; },
               F.gw, J0, F.NGW, scr, F.lane);
        for (int c = gtid; c < D; c += GT) { const float* L = args.in[I_A_LB]; const float l0 = L[c], l1 = L[D + c], l2 = L[2 * D + c]; const float mx = fmaxf(l0, fmaxf(l1, l2));
            const float e0 = expf(l0 - mx), e1 = expf(l1 - mx), e2 = expf(l2 - mx); ((float*)(ws + WS_LB))[c] = e0 / (e0 + e1 + e2); }
        for (int i = gtid; i < 2 * 36 * D; i += GT) { const int l = i / (36 * D), r = (i / D) % 36, k = i % D;
            ((float*)(ws + WS_RT))[i] = r < 4 ? args.in[I_W_GROUP][((size_t)l * D + k) * NG + r] : args.in[I_W_EXPERT][((size_t)l * D + k) * NE + (r - 4)]; }
        { const int fi = gtid & 63; const float inv = exp2f(-(float)fi * (13.287712379549449f / 64.0f));
          for (int i = gtid; i < T * 64; i += GT) { const float ang = (float)(i >> 6) * inv; float sn_, cs_; sincosf(ang, &sn_, &cs_); ((f32x2*)(ws + WS_ROPE))[i] = (f32x2){cs_, sn_}; } }
        for (int m = F.gw; m < M; m += F.NGW) rms_row_to_bf16(args.in[I_X] + (size_t)m * D, (bf16*)(ws + WS_XN) + (size_t)m * D, F.lane);
    }
    SEAM(0);
    if (IN(1)) _Pragma("unroll") for (int rep_ = 0; rep_ < NREP(1); ++rep_) { REFRESH();
        constexpr int NCV = 112, J1 = 16 * 64, J2 = 16 * 128, J3 = 16 * 64, J4 = 16 * 64, J5 = MOE_CV_ITEMS;
        if ((int)blockIdx.x < NCV) {
            LAS float* scr = (LAS float*)(F.lds + F.wave * TR_SCR_BYTES);
            tr_run([&](int r) { TrItem t; t.osc = 1.f; t.ksc = nullptr; t.flags = 0; t.N = D; t.K = D;
                    if (r < J1) { t.src = args.in[I_A_W_OUT]; t.dst = ws + WS_WOA; t.k0 = 128 * (r / 64); t.n0 = 32 * (r % 64); t.drow0 = t.n0; t.flags = 2; t.osc = SC_W; return t; } r -= J1;
                    if (r < J2) { const int nb = r % 128; t.src = args.in[I_KV_W]; t.ksc = args.in[I_KV_NORM]; t.dst = ws + WS_WQKV; t.N = 2 * D; t.k0 = 128 * (r / 128); t.n0 = 32 * nb; t.drow0 = D + t.n0;
                                  t.flags = (FP8_QKV ? 2 : 0) | (nb < 64 ? 1 : 0); t.osc = FP8_QKV ? SC_W : 1.f; return t; } r -= J2;
                    if (r < J3) { t.src = args.in[I_B_W_Q]; t.ksc = args.in[I_NORM_MIX] + D; t.dst = ws + WS_WQKV; t.k0 = 128 * (r / 64); t.n0 = 32 * (r % 64); t.drow0 = t.n0; t.flags = (FP8_QKV ? 2 : 0) | 1; t.osc = FP8_QKV ? SC_W : 1.f; return t; } r -= J3;
                    if (r < J4) { t.src = args.in[I_B_W_OUT]; t.dst = ws + WS_WOB; t.k0 = 128 * (r / 64); t.n0 = 32 * (r % 64); t.drow0 = t.n0; t.flags = FP8_OUTB ? 2 : 0; t.osc = FP8_OUTB ? SC_W : 1.f; return t; } r -= J4;
                    return moe_cv_item(args, ws, 0, r); },
                   (int)blockIdx.x * NWAVES + F.wave, J1 + J2 + J3 + J4 + J5 - CV_TAIL1, NCV * NWAVES, scr, F.lane);
            __syncthreads();
        }
        pg8::DynOrder S; S.init(ws + WS_XN, ws + WS_WIN, M, 4 * D, D, F.wave, F.ctl + CW_DYN + 1024, (LAS int*)(F.lds + LDSCTL_OFF + 32), false, (int)xb_xcc_id());
        pg8::EpiHgrnIn E{ws + WS_R, (const float*)(ws + WS_LB)};
        pg8::gemm_phase<pg8::EpiHgrnIn, pg8::DynOrder, true>(F.lds, S, E);
        { REFRESH(); __syncthreads(); volatile LAS int* slot = (volatile LAS int*)(F.lds + LDSCTL_OFF + 8); LAS float* scr = (LAS float*)(F.lds + F.wave * TR_SCR_BYTES);
          for (int rnd = 0;; ++rnd) {
              if (F.wave == 0 && F.lane == 0) slot[rnd & 1] = (int)xb_add(F.ctl + CW_DYN + 128, (unsigned)NWAVES);
              __syncthreads();
              const int base = __builtin_amdgcn_readfirstlane(slot[rnd & 1]);
              if (base >= CV_TAIL1) break;
              const int r = MOE_CV_ITEMS - CV_TAIL1 + base + F.wave;
              if (base + F.wave < CV_TAIL1) tr_run([&](int i) { return moe_cv_item(args, ws, 0, i); }, r, r + 1, 1, scr, F.lane);
          } }
    }
    SEAM(1);
    if (IN(2)) { REFRESH(); for (int it = F.vcu; it < 256; it += F.G) hgrn_item<false>(F, args, it); }
    SEAM(2);
    if (IN(3)) _Pragma("unroll") for (int rep_ = 0; rep_ < NREP(3); ++rep_) { REFRESH(); for (int it = F.vcu; it < 256; it += F.G) hgrn_item<true>(F, args, it); }
    SEAM(3);
    if (IN(4)) _Pragma("unroll") for (int rep_ = 0; rep_ < NREP(4); ++rep_) { REFRESH();
        pg8::DenseOrder S; S.init(ws + WS_OH, ws + WS_WOA, M, D, D, F.G, (int)blockIdx.x, F.wave, true);
        pg8::EpiRes16<true> E{(bf16*)(ws + WS_XR), args.in[I_X], 1.0f / (SC_OH * SC_W)};
        pg8::gemm_phase<pg8::EpiRes16<true>, pg8::DenseOrder, true, true>(F.lds, S, E);
    }
    SEAM(4);
#define MOE_LAYER(P, layer, F8, O8) \
    if (IN(P)) { REFRESH(); for (int t = F.gw; t < M; t += 2 * F.NGW) { if (t + F.NGW < M) route_pair<F8>(F, args, layer, t, t + F.NGW); else route_token<false, F8>(F, args, layer, t); } } \
    SEAM(P); \
    if (IN((P) + 1)) _Pragma("unroll") for (int rep_ = 0; rep_ < NREP((P) + 1); ++rep_) { REFRESH(); const int nrb = __builtin_amdgcn_readfirstlane(moe_tables(F, layer)); \
        pg8::MoeOrder<true> S; S.A = (const char*)(ws + WS_XN); S.B = (const char*)(ws + WS_WGU + (size_t)(layer) * WGU_LSTRIDE); S.estride = (size_t)1024 * D * (F8 ? 1 : 2); S.K = D; S.RB = F8 ? D : 2 * D; S.NT = 4; S.total = nrb * 4; S.G = F.G; S.c = F.vcu; S.wv = F.wave; \
        S.blk_e = (const LAS int*)(F.lds + LT_BLKE); S.blkstart = (const LAS int*)(F.lds + LT_BLKSTART); S.cnt = (const LAS int*)(F.lds + LT_CNT); S.list = (const int*)(ws + WS_LISTS); \
        pg8::EpiSwiGLU<F8> E{(bf16*)(ws + WS_ACT), F8 ? 1.0f / (SC_XN * SC_W) : 1.0f, F.ctl + CW_RDY + 16384 * (layer)}; \
        pg8::gemm_phase<pg8::EpiSwiGLU<F8>, pg8::MoeOrder<true>, true, F8>(F.lds, S, E); } \
      \
    if (IN((P) + 2)) { REFRESH(); const int nrb = __builtin_amdgcn_readfirstlane(IN((P) + 1) ? ((const LAS int*)(F.lds + LT_BLKSTART))[32] : moe_tables(F, layer)); \
        static_assert(F8 && O8, "merged MoE phases: e4m3 operands and outputs"); \
        pg8::DynMoeOrder S; S.A = (const char*)(ws + WS_ACT); S.B = (const char*)(ws + WS_WD + (size_t)(layer) * WD_LSTRIDE); S.estride = (size_t)D * FF; S.K = FF; S.RB = FF; S.nwg = nrb * 8; S.wv = F.wave; \
        S.counter = F.ctl + CW_DYN + 256 + 64 * (layer); S.slot = (LAS int*)(F.lds + LDSCTL_OFF + 32); S.ready = F.ctl + CW_RDY + 16384 * (layer); \
        S.blk_e = (const LAS int*)(F.lds + LT_BLKE); \
        pg8::EpiOut8 E{ws + WS_OUTB, D, (1.0f / (SC_ACT * SC_WD)) * SC_OUT}; pg8::gemm_phase<pg8::EpiOut8, pg8::DynMoeOrder, true, true>(F.lds, S, E); } \
    SEAM((P) + 2);
    MOE_LAYER(5, 0, FP8_MOE0, OUT8_L0)
    if (IN(8)) { REFRESH();
        if (!IN(6)) (void)moe_tables(F, 0);
        combine_tokens<true>(F, args, F.gw, F.NGW);
    }
    SEAM(8);
    if (IN(9)) _Pragma("unroll") for (int rep_ = 0; rep_ < NREP(9); ++rep_) { REFRESH();
        constexpr int NCV2 = 128;
        if ((int)blockIdx.x < NCV2) {
            LAS float* scr = (LAS float*)(F.lds + F.wave * TR_SCR_BYTES);
            tr_run([&](int it) { return moe_cv_item(args, ws, 1, it); }, (int)blockIdx.x * NWAVES + F.wave, MOE_CV_ITEMS, NCV2 * NWAVES, scr, F.lane);
            __syncthreads();
        }
        pg8::DynOrder S; S.init(ws + WS_XN, ws + WS_WQKV, M, 3 * D, D, F.wave, F.ctl + CW_DYN + 2048, (LAS int*)(F.lds + LDSCTL_OFF + 32), FP8_QKV, (int)xb_xcc_id());
        pg8::EpiQKV E{(bf16*)(ws + WS_Q), (bf16*)(ws + WS_K), (bf16*)(ws + WS_V), args.in[I_B_Q_NORM], args.in[I_K_NORM], (const f32x2*)(ws + WS_ROPE), (float*)(ws + WS_KMEAN), F.lds + 131072, FP8_QKV ? 1.0f / (SC_XN * SC_W) : 1.0f, F.wave};
        pg8::gemm_phase<pg8::EpiQKV, pg8::DynOrder, true, FP8_QKV>(F.lds, S, E);
    }
    SEAM(9);
    if (IN(11)) { REFRESH(); if (NREP(11) == 2) { for (int it = F.vcu; it < 64 * 8; it += F.G) moba_gate_item<true>(F, it); } for (int it = F.vcu; it < 64 * 8; it += F.G) moba_gate_item<false>(F, it); }
    SEAM(11);
    if (IN(12)) _Pragma("unroll") for (int rep_ = 0; rep_ < NREP(12); ++rep_) { REFRESH();
        for (int v = F.vcu; v < 256; v += F.G) { const int bh = v >> 2, q = v & 3;
            _Pragma("unroll 1") for (int gi = 0; gi < 4; ++gi) { const int n = (gi == 0) ? q : ((gi == 1) ? 7 - q : ((gi == 2) ? 8 + q : 15 - q)); attn_group(F, bh, n); } }
    }
    SEAM(12);
    if (IN(13)) _Pragma("unroll") for (int rep_ = 0; rep_ < NREP(13); ++rep_) { REFRESH(); attn_combine_tokens(F, F.gw, F.NGW); }
    SEAM(13);
    if (IN(14)) { REFRESH();
        pg8::DenseOrder S; S.init(ws + WS_OA, ws + WS_WOB, M, D, D, F.G, (int)blockIdx.x, F.wave, FP8_OUTB);
        pg8::EpiRes16<false> E{(bf16*)(ws + WS_XR), nullptr, FP8_OUTB ? 1.0f / (SC_OA * SC_W) : 1.0f};
        pg8::gemm_phase<pg8::EpiRes16<false>, pg8::DenseOrder, true, FP8_OUTB>(F.lds, S, E);
    }
    SEAM(14);
    MOE_LAYER(15, 1, FP8_MOE1, OUT8_L1)
    if (IN(18)) { REFRESH(); if (!IN(16)) (void)moe_tables(F, 1); combine_tokens<false>(F, args, F.gw, F.NGW); }
#undef IN
#undef SEAM
#undef MOE_LAYER
#undef args
}

#ifndef MK_N_LAUNCHES
#define MK_N_LAUNCHES 1
#endif
#ifndef DBG_STOP
#define DBG_STOP N_PHASES
#endif
extern "C" void kernel_launch(void* const* d_in, const int* in_sizes, int n_in, void* d_out, int out_size, void* d_ws, size_t ws_size, hipStream_t stream) {
    static int grid = 0;
    if (grid == 0) {
        if (n_in != 20 || in_sizes[0] != M * D || out_size != M * D || ws_size < WS_END) { fprintf(stderr, "kernel_launch: unexpected shapes (n_in %d, in0 %d, out %d, ws %zu < %zu); nothing launched\n", n_in, n_in > 0 ? in_sizes[0] : -1, out_size, ws_size, (size_t)WS_END); grid = -1; return; }
        int dev = 0, cus = 0, per_cu = 0;
        if (hipGetDevice(&dev) != hipSuccess || hipDeviceGetAttribute(&cus, hipDeviceAttributeMultiprocessorCount, dev) != hipSuccess) { grid = -1; return; }
        if (hipFuncSetAttribute((const void*)fwd, hipFuncAttributeMaxDynamicSharedMemorySize, LDS_BYTES) != hipSuccess) { fprintf(stderr, "kernel_launch: hipFuncSetAttribute failed\n"); grid = -1; return; }
        if (hipOccupancyMaxActiveBlocksPerMultiprocessor(&per_cu, (const void*)fwd, NTHR, LDS_BYTES) != hipSuccess || per_cu < 1) { fprintf(stderr, "kernel_launch: occupancy query says %d blocks per CU\n", per_cu); }
        (void)hipGetLastError();
        grid = cus;
    }
    if (grid < 0) return;
    (void)hipMemsetAsync((char*)d_ws + WS_CTL, 0, CTL_ZERO_BYTES, stream);
    Args a{};
    for (int i = 0; i < 20; ++i) a.in[i] = (const float*)d_in[i];
    a.out = (float*)d_out; a.ws = (unsigned char*)d_ws;
    if (MK_N_LAUNCHES == 1) { a.ph_lo = 0; a.ph_hi = N_PHASES; hipLaunchKernelGGL(fwd, dim3(grid), dim3(NTHR), LDS_BYTES, stream, a); }
    else for (int p = 0; p < DBG_STOP; ++p) { a.ph_lo = p; a.ph_hi = p + 1; hipLaunchKernelGGL(fwd, dim3(grid), dim3(NTHR), LDS_BYTES, stream, a); }
}
```
